# Optimizing an MI355X kernel written in HIP

```python
import math
import jax
import jax.numpy as jnp
from jax import lax
import numpy as np

D_MODEL = 1024
BATCH = 2
SEQ = 8192
DEPTH = 4

CTX_LEN = 256
GRID_W = 64
NORM_EPS = 1e-6
MIX_WIDTH = D_MODEL // 2

S5_WIDTH = MIX_WIDTH
S5_GROUP = 16
S5_GROUPS = S5_WIDTH // S5_GROUP
S5_STATE = 64

MLSTM_HEADS = 4
MLSTM_DV = MIX_WIDTH // MLSTM_HEADS
MLSTM_DK = MLSTM_DV // 2
MLSTM_QK = MLSTM_HEADS * MLSTM_DK
MLSTM_WIDTH = MLSTM_HEADS * MLSTM_DV
MLSTM_CHUNK = 128
MLSTM_COLS = 2 * MLSTM_QK + 2 * MLSTM_WIDTH + 4 * MLSTM_HEADS
M_INIT = -1e30

RWKV_N = 64
RWKV_WIDTH = MIX_WIDTH
RWKV_HEADS = RWKV_WIDTH // RWKV_N
RWKV_LORA_W = 64
RWKV_LORA_A = 64
RWKV_LORA_G = 128
RWKV_COLS = 3 * RWKV_WIDTH + RWKV_LORA_W + RWKV_LORA_A + RWKV_LORA_G
RWKV_GN_EPS = 64e-5

N_BRANCH = 3
D_IN = S5_WIDTH + MLSTM_COLS + RWKV_COLS + N_BRANCH * D_MODEL
MLP_HIDDEN = 4 * D_MODEL

kernel_name = 'hybrid_s5_mlstm_rwkv7_prefix_trunk'


def _split(z, sizes):
    cuts = [int(v) for v in np.cumsum(sizes)[:-1]]
    return jnp.split(z, cuts, axis=-1)


def _rmsnorm(x, g):
    xf = x.astype(jnp.float32)
    y = xf * lax.rsqrt(jnp.mean(xf * xf, axis=-1, keepdims=True) + NORM_EPS)
    return (y * g.astype(jnp.float32)).astype(x.dtype)


def _modulate(h, shift, scale):
    return h * (1.0 + scale) + shift


def _depthwise_conv3x3(z, w, b, rows, cols):
    n, l, ch = z.shape
    img = z.reshape(n, rows, cols, ch)
    out = lax.conv_general_dilated(img, w[:, :, None, :].astype(img.dtype), window_strides=(1, 1),
                                   padding='SAME', dimension_numbers=('NHWC', 'HWIO', 'NHWC'),
                                   feature_group_count=ch)
    return out.reshape(n, l, ch) + b


def _token_shift(z, mu_prev, mu_next):
    prev = jnp.pad(z[:, :-1], ((0, 0), (1, 0), (0, 0)))
    nxt = jnp.pad(z[:, 1:], ((0, 0), (0, 1), (0, 0)))
    return z + mu_prev * (prev - z) + mu_next * (nxt - z)


def _s5_discretise(a_re, a_im, log_dt, b_re, b_im):
    f32 = jnp.float32
    lam_re = jnp.minimum(a_re.astype(f32), -1e-4)
    lam_im = a_im.astype(f32)
    dt = jnp.exp(log_dt.astype(f32))[:, None]
    mag = jnp.exp(lam_re * dt)
    ar = mag * jnp.cos(lam_im * dt)
    ai = mag * jnp.sin(lam_im * dt)
    den = lam_re * lam_re + lam_im * lam_im
    nr = ar - 1.0
    cr = (nr * lam_re + ai * lam_im) / den
    ci = (ai * lam_re - nr * lam_im) / den
    b_re = b_re.astype(f32)
    b_im = b_im.astype(f32)
    br = cr[..., None] * b_re - ci[..., None] * b_im
    bi = cr[..., None] * b_im + ci[..., None] * b_re
    return ar, ai, br, bi


def _complex_affine_combine(e1, e2):
    ar1, ai1, br1, bi1 = e1
    ar2, ai2, br2, bi2 = e2
    return (ar2 * ar1 - ai2 * ai1, ar2 * ai1 + ai2 * ar1,
            ar2 * br1 - ai2 * bi1 + br2, ar2 * bi1 + ai2 * br1 + bi2)


def _s5_scan(u, ar, ai, br, bi, h0, reverse):
    n, l, _ = u.shape
    ug = u.reshape(n, l, S5_GROUPS, S5_GROUP)
    bur = jnp.einsum('blgc,gpc->blgp', ug, br)
    bui = jnp.einsum('blgc,gpc->blgp', ug, bi)
    if h0 is not None:
        hr0, hi0 = h0
        first = l - 1 if reverse else 0
        bur = bur.at[:, first].add(ar * hr0 - ai * hi0)
        bui = bui.at[:, first].add(ar * hi0 + ai * hr0)
    a_r = jnp.broadcast_to(ar, (1, l) + ar.shape)
    a_i = jnp.broadcast_to(ai, (1, l) + ai.shape)
    _, _, hr, hi = lax.associative_scan(_complex_affine_combine, (a_r, a_i, bur, bui),
                                        reverse=reverse, axis=1)
    return hr, hi


def _s5_readout(hr, hi, cr, ci):
    n, l = hr.shape[:2]
    y = jnp.einsum('blgp,gcp->blgc', hr, cr) - jnp.einsum('blgp,gcp->blgc', hi, ci)
    return y.reshape(n, l, S5_WIDTH)


def _s5_branch(uc, ul, a_re, a_im, log_dt, b_re, b_im, c_re, c_im, d_skip, w_glu, b_glu):
    f32 = jnp.float32
    uc = uc.astype(f32)
    ul = ul.astype(f32)
    d_skip = d_skip.astype(f32)
    yc = uc * d_skip
    yl = ul * d_skip
    for direction in range(2):
        reverse = direction == 1
        ar, ai, br, bi = _s5_discretise(a_re[direction], a_im[direction], log_dt[direction],
                                        b_re[direction], b_im[direction])
        cr = c_re[direction].astype(f32)
        ci = c_im[direction].astype(f32)
        hr, hi = _s5_scan(uc, ar, ai, br, bi, None, reverse)
        end = 0 if reverse else -1
        yc = yc + _s5_readout(hr, hi, cr, ci)
        hr, hi = _s5_scan(ul, ar, ai, br, bi, (hr[:, end], hi[:, end]), reverse)
        yl = yl + _s5_readout(hr, hi, cr, ci)

    def glu(y):
        z = jax.nn.gelu(y)
        return z * jax.nn.sigmoid(z @ w_glu + b_glu)

    return glu(yc), glu(yl)


def _mlstm_chunkwise(q, k, v, i_pre, f_pre, state0):
    n, h, l, dk = q.shape
    dv = v.shape[-1]
    cs = MLSTM_CHUNK
    nc = l // cs
    q = q.reshape(n, h, nc, cs, dk) * (dk ** -0.5)
    k = k.reshape(n, h, nc, cs, dk)
    v = v.reshape(n, h, nc, cs, dv)
    ig = i_pre.reshape(n, h, nc, cs)
    g = jnp.cumsum(jax.nn.log_sigmoid(f_pre).reshape(n, h, nc, cs), axis=-1)
    g_last = g[..., -1]
    a = g_last[..., None] - g + ig
    a_max = jnp.max(a, axis=-1)
    wgt = jnp.exp(a - a_max[..., None])
    c_loc = jnp.einsum('nhcs,nhcsv,nhcsk->nhcvk', wgt, v, k)
    n_loc = jnp.einsum('nhcs,nhcsk->nhck', wgt, k)

    def step(carry, inp):
        c_m, n_m, m = carry
        cl, nl, am, gl = inp
        m_new = jnp.maximum(gl + m, am)
        s_old = jnp.exp(gl + m - m_new)
        s_loc = jnp.exp(am - m_new)
        new = (s_old[..., None, None] * c_m + s_loc[..., None, None] * cl,
               s_old[..., None] * n_m + s_loc[..., None] * nl, m_new)
        return new, carry

    xs = (jnp.moveaxis(c_loc, 2, 0), jnp.moveaxis(n_loc, 2, 0),
          jnp.moveaxis(a_max, 2, 0), jnp.moveaxis(g_last, 2, 0))
    state_end, (c_in, n_in, m_in) = lax.scan(step, state0, xs)
    c_in = jnp.moveaxis(c_in, 0, 2)
    n_in = jnp.moveaxis(n_in, 0, 2)
    m_in = jnp.moveaxis(m_in, 0, 2)

    log_inter = g + m_in[..., None]
    log_intra = g[..., :, None] - g[..., None, :] + ig[..., None, :]
    order_mask = jnp.tril(jnp.ones((cs, cs), dtype=bool))
    log_intra = jnp.where(order_mask, log_intra, -jnp.inf)
    m_t = jnp.maximum(log_inter, jnp.max(log_intra, axis=-1))
    dmat = jnp.exp(log_intra - m_t[..., None])
    w_inter = jnp.exp(log_inter - m_t)
    s = jnp.einsum('nhctk,nhcsk->nhcts', q, k) * dmat
    num = (jnp.einsum('nhcts,nhcsv->nhctv', s, v)
           + w_inter[..., None] * jnp.einsum('nhctk,nhcvk->nhctv', q, c_in))
    den = jnp.sum(s, axis=-1) + w_inter * jnp.einsum('nhctk,nhck->nhct', q, n_in)
    hid = num / jnp.maximum(jnp.abs(den), jnp.exp(-m_t))[..., None]
    return hid.reshape(n, h, l, dv), state_end


def _mlstm_heads(t, d):
    n, l, _ = t.shape
    return t.reshape(n, l, -1, d).transpose(0, 2, 1, 3)


def _mlstm_features(z, conv_w, conv_b, gate_b, rows, cols):
    z = z.astype(jnp.float32)
    n, l, _ = z.shape
    qk_cols, v_cols, o_cols, g_cols = _split(z, (2 * MLSTM_QK, MLSTM_WIDTH, MLSTM_WIDTH, 4 * MLSTM_HEADS))
    qk = jax.nn.silu(_depthwise_conv3x3(qk_cols, conv_w, conv_b, rows, cols))
    q = _mlstm_heads(qk[..., :MLSTM_QK], MLSTM_DK)
    k = _mlstm_heads(qk[..., MLSTM_QK:], MLSTM_DK)
    v = _mlstm_heads(v_cols, MLSTM_DV)
    gates = (g_cols + gate_b).reshape(n, l, 4, MLSTM_HEADS).transpose(2, 0, 3, 1)

    def two_dir(fwd, bwd):
        return jnp.concatenate([fwd, jnp.flip(bwd, axis=2)], axis=0)

    return (two_dir(q, q), two_dir(k, k), two_dir(v, v),
            two_dir(gates[0], gates[1]), two_dir(gates[2], gates[3]), o_cols)


def _mlstm_branch(zc, zl, rows, conv_w, conv_b, gate_b, norm_g):
    f32 = jnp.float32
    n = zl.shape[0]
    qc, kc, vc, ic, fc, oc = _mlstm_features(zc, conv_w, conv_b, gate_b, 1, zc.shape[1])
    ql, kl, vl, il, fl, ol = _mlstm_features(zl, conv_w, conv_b, gate_b, rows, GRID_W)
    state0 = (jnp.zeros((2 * n, MLSTM_HEADS, MLSTM_DV, MLSTM_DK), f32),
              jnp.zeros((2 * n, MLSTM_HEADS, MLSTM_DK), f32),
              jnp.full((2 * n, MLSTM_HEADS), M_INIT, f32))
    hc, state_ctx = _mlstm_chunkwise(qc, kc, vc, ic, fc, state0)
    hl, _ = _mlstm_chunkwise(ql, kl, vl, il, fl, state_ctx)

    def readout(h2, o):
        hid = h2[:n] + jnp.flip(h2[n:], axis=2)
        hid = hid * lax.rsqrt(jnp.mean(hid * hid, axis=-1, keepdims=True) + NORM_EPS)
        b_, hh, l, dv = hid.shape
        hid = hid.transpose(0, 2, 1, 3).reshape(b_, l, hh * dv) * norm_g
        return hid * jax.nn.sigmoid(o)

    return readout(hc, oc), readout(hl, ol)


def _rwkv_heads(t):
    n, l, _ = t.shape
    return t.reshape(n, l, RWKV_HEADS, RWKV_N).transpose(1, 0, 2, 3)


def _rwkv_features(z, mu_prev, mu_next, w0, w_up, a0, a_up, g_up, k_k, k_a, r_k):
    z = _token_shift(z.astype(jnp.float32), mu_prev, mu_next)
    r, k, v, w_lo, a_lo, g_lo = _split(z, (RWKV_WIDTH,) * 3 + (RWKV_LORA_W, RWKV_LORA_A, RWKV_LORA_G))
    gate = jax.nn.sigmoid(g_lo) @ g_up
    kk = _rwkv_heads(k * k_k)
    kk = kk / jnp.maximum(jnp.sqrt(jnp.sum(kk * kk, axis=-1, keepdims=True)), 1e-12)
    w_lo = jnp.tanh(w_lo)
    decays, iclrs, keys = [], [], []
    for d in range(2):
        w_log = -jax.nn.softplus(-(w0[d] + w_lo @ w_up[d])) - 0.5
        decays.append(_rwkv_heads(jnp.exp(-jnp.exp(w_log))))
        a = jax.nn.sigmoid(a0[d] + a_lo @ a_up[d])
        iclrs.append(_rwkv_heads(a))
        keys.append(_rwkv_heads(k * (1.0 + (a - 1.0) * k_a)))
    r_h = _rwkv_heads(r)
    v_h = _rwkv_heads(v)
    bonus = jnp.sum(r_h * (keys[0] + keys[1]) * r_k, axis=-1, keepdims=True) * v_h

    def two_dir(fwd, bwd):
        return jnp.stack([fwd, bwd[::-1]], axis=1)

    xs = (two_dir(r_h, r_h), two_dir(decays[0], decays[1]), two_dir(keys[0], keys[1]),
          two_dir(v_h, v_h), two_dir(kk, kk), two_dir(iclrs[0], iclrs[1]))
    return xs, bonus, gate


def _rwkv7_scan(xs, s0):
    def step(s, inp):
        r_t, w_t, k_t, v_t, kk_t, a_t = inp
        sk = jnp.einsum('dbhvk,dbhk->dbhv', s, kk_t)
        s = (s * w_t[..., None, :] - sk[..., None] * (kk_t * a_t)[..., None, :]
             + v_t[..., None] * k_t[..., None, :])
        return s, jnp.einsum('dbhvk,dbhk->dbhv', s, r_t)

    return lax.scan(step, s0, xs)


def _rwkv_branch(zc, zl, mu_prev, mu_next, w0, w_up, a0, a_up, g_up, k_k, k_a, r_k, ln_g, ln_b):
    params = (mu_prev, mu_next, w0, w_up, a0, a_up, g_up, k_k, k_a, r_k)
    xs_c, bonus_c, gate_c = _rwkv_features(zc, *params)
    xs_l, bonus_l, gate_l = _rwkv_features(zl, *params)
    n = zl.shape[0]
    s0 = jnp.zeros((2, n, RWKV_HEADS, RWKV_N, RWKV_N), jnp.float32)
    s_ctx, y_c = _rwkv7_scan(xs_c, s0)
    _, y_l = _rwkv7_scan(xs_l, s_ctx)

    def readout(y2, bonus, gate):
        y = y2[:, 0] + y2[::-1, 1]
        mu = jnp.mean(y, axis=-1, keepdims=True)
        var = jnp.mean(jnp.square(y - mu), axis=-1, keepdims=True)
        y = (y - mu) * lax.rsqrt(var + RWKV_GN_EPS)
        l = y.shape[0]
        y = y.transpose(1, 0, 2, 3).reshape(n, l, RWKV_WIDTH) * ln_g + ln_b
        bonus = bonus.transpose(1, 0, 2, 3).reshape(n, l, RWKV_WIDTH)
        return (y + bonus) * gate

    return readout(y_c, bonus_c, gate_c), readout(y_l, bonus_l, gate_l)


def _merge(ya, yb, yc, gate_cols, w_pa, w_pb, w_pc, w_out):
    ga, gb, gc = jnp.split(jax.nn.sigmoid(gate_cols), N_BRANCH, axis=-1)
    y = ga * (ya @ w_pa) + gb * (yb @ w_pb) + gc * (yc @ w_pc)
    return y @ w_out


def _sq_relu_mlp(h, w1, w2):
    return jnp.square(jax.nn.relu(h @ w1)) @ w2


def setup_inputs(seed: int = 0) -> dict:
    key = jax.random.key(seed)
    keys = iter(jax.random.split(key, 64))
    f32 = jnp.float32

    def nrm(shape, scale):
        return scale * jax.random.normal(next(keys), shape, f32)

    def unif(shape, lo, hi):
        return jax.random.uniform(next(keys), shape, f32, lo, hi)

    D, L, G, P, H = D_MODEL, DEPTH, S5_GROUPS, S5_STATE, MLSTM_HEADS
    f_bias = jnp.tile(jnp.linspace(3.0, 6.0, H), 2)
    return {
        'x': nrm((BATCH, SEQ, D), 1.0),
        'c': nrm((BATCH, D), 1.0),
        'ctx': nrm((BATCH, CTX_LEN, D), 1.0),
        'c_ctx': nrm((D,), 1.0),
        'w_mod': nrm((L, D, 6 * D), 0.5 * D ** -0.5),
        'b_mod': nrm((L, 6 * D), 0.01),
        'norm1_g': 1.0 + nrm((L, D), 0.05),
        'norm2_g': 1.0 + nrm((L, D), 0.05),
        'w_in': nrm((L, D, D_IN), D ** -0.5),
        's5_a_re': -0.5 + nrm((L, 2, G, P), 0.01),
        's5_a_im': math.pi * jnp.arange(P, dtype=f32) + nrm((L, 2, G, P), 0.01),
        's5_log_dt': unif((L, 2, G), math.log(1e-3), math.log(1e-1)),
        's5_b_re': nrm((L, 2, G, P, S5_GROUP), S5_GROUP ** -0.5),
        's5_b_im': nrm((L, 2, G, P, S5_GROUP), S5_GROUP ** -0.5),
        's5_c_re': nrm((L, 2, G, S5_GROUP, P), P ** -0.5),
        's5_c_im': nrm((L, 2, G, S5_GROUP, P), P ** -0.5),
        's5_d': nrm((L, S5_WIDTH), 1.0),
        's5_w_glu': nrm((L, S5_WIDTH, S5_WIDTH), S5_WIDTH ** -0.5),
        's5_b_glu': nrm((L, S5_WIDTH), 0.01),
        'ml_conv_w': nrm((L, 3, 3, 2 * MLSTM_QK), 1.0 / 3.0),
        'ml_conv_b': nrm((L, 2 * MLSTM_QK), 0.01),
        'ml_gate_b': jnp.concatenate([nrm((L, 2 * H), 0.1), f_bias + nrm((L, 2 * H), 0.1)], axis=-1),
        'ml_norm_g': 1.0 + nrm((L, MLSTM_WIDTH), 0.05),
        'rw_mu_prev': unif((L, RWKV_COLS), 0.0, 0.5),
        'rw_mu_next': unif((L, RWKV_COLS), 0.0, 0.5),
        'rw_w0': jnp.linspace(-6.0, -1.0, RWKV_WIDTH) + nrm((L, 2, RWKV_WIDTH), 0.1),
        'rw_w_up': nrm((L, 2, RWKV_LORA_W, RWKV_WIDTH), 0.5 * RWKV_LORA_W ** -0.5),
        'rw_a0': nrm((L, 2, RWKV_WIDTH), 0.1),
        'rw_a_up': nrm((L, 2, RWKV_LORA_A, RWKV_WIDTH), 0.5 * RWKV_LORA_A ** -0.5),
        'rw_g_up': nrm((L, RWKV_LORA_G, RWKV_WIDTH), RWKV_LORA_G ** -0.5),
        'rw_k_k': 0.85 + nrm((L, RWKV_WIDTH), 0.05),
        'rw_k_a': 1.0 + nrm((L, RWKV_WIDTH), 0.05),
        'rw_r_k': nrm((L, RWKV_HEADS, RWKV_N), 0.1),
        'rw_ln_g': 1.0 + nrm((L, RWKV_WIDTH), 0.05),
        'rw_ln_b': nrm((L, RWKV_WIDTH), 0.01),
        'w_pa': nrm((L, S5_WIDTH, D), S5_WIDTH ** -0.5),
        'w_pb': nrm((L, MLSTM_WIDTH, D), MLSTM_WIDTH ** -0.5),
        'w_pc': nrm((L, RWKV_WIDTH, D), RWKV_WIDTH ** -0.5),
        'w_out': nrm((L, D, D), D ** -0.5),
        'mlp_w1': nrm((L, D, MLP_HIDDEN), D ** -0.5),
        'mlp_w2': nrm((L, MLP_HIDDEN, D), MLP_HIDDEN ** -0.5),
        'final_g': 1.0 + nrm((D,), 0.05),
    }


def reference(x, c, ctx, c_ctx, w_mod, b_mod, norm1_g, norm2_g, w_in,
              s5_a_re, s5_a_im, s5_log_dt, s5_b_re, s5_b_im, s5_c_re, s5_c_im, s5_d, s5_w_glu, s5_b_glu,
              ml_conv_w, ml_conv_b, ml_gate_b, ml_norm_g,
              rw_mu_prev, rw_mu_next, rw_w0, rw_w_up, rw_a0, rw_a_up, rw_g_up, rw_k_k, rw_k_a, rw_r_k,
              rw_ln_g, rw_ln_b,
              w_pa, w_pb, w_pc, w_out, mlp_w1, mlp_w2, final_g):
    rows = x.shape[1] // GRID_W
    xc = ctx
    sc = jax.nn.silu(c)
    scc = jax.nn.silu(c_ctx)
    top_split = (S5_WIDTH, MLSTM_COLS, RWKV_COLS, N_BRANCH * D_MODEL)
    for l in range(DEPTH):
        last = l == DEPTH - 1
        mod = jnp.split((sc @ w_mod[l] + b_mod[l])[:, None, :], 6, axis=-1)
        modc = jnp.split(scc @ w_mod[l] + b_mod[l], 6, axis=-1)

        h = _modulate(_rmsnorm(x, norm1_g[l]), mod[0], mod[1])
        hc = _modulate(_rmsnorm(xc, norm1_g[l]), modc[0], modc[1])
        s5_l, ml_l, rw_l, gate_l = _split(h @ w_in[l], top_split)
        s5_c, ml_c, rw_c, gate_c = _split(hc @ w_in[l], top_split)
        ya_c, ya_l = _s5_branch(s5_c, s5_l, s5_a_re[l], s5_a_im[l], s5_log_dt[l], s5_b_re[l], s5_b_im[l],
                                s5_c_re[l], s5_c_im[l], s5_d[l], s5_w_glu[l], s5_b_glu[l])
        yb_c, yb_l = _mlstm_branch(ml_c, ml_l, rows, ml_conv_w[l], ml_conv_b[l], ml_gate_b[l], ml_norm_g[l])
        yc_c, yc_l = _rwkv_branch(rw_c, rw_l, rw_mu_prev[l], rw_mu_next[l], rw_w0[l], rw_w_up[l], rw_a0[l],
                                  rw_a_up[l], rw_g_up[l], rw_k_k[l], rw_k_a[l], rw_r_k[l], rw_ln_g[l], rw_ln_b[l])
        x = x + mod[2] * _merge(ya_l, yb_l, yc_l, gate_l, w_pa[l], w_pb[l], w_pc[l], w_out[l])

        h = _modulate(_rmsnorm(x, norm2_g[l]), mod[3], mod[4])
        x = x + mod[5] * _sq_relu_mlp(h, mlp_w1[l], mlp_w2[l])

        if not last:
            xc = xc + modc[2] * _merge(ya_c, yb_c, yc_c, gate_c, w_pa[l], w_pb[l], w_pc[l], w_out[l])
            hc = _modulate(_rmsnorm(xc, norm2_g[l]), modc[3], modc[4])
            xc = xc + modc[5] * _sq_relu_mlp(hc, mlp_w1[l], mlp_w2[l])
    return _rmsnorm(x, final_g)
```

```cpp
#include <hip/hip_runtime.h>
#include <hip/hip_cooperative_groups.h>
#include <cstdio>
namespace cg = cooperative_groups;

#define LAS __attribute__((address_space(3)))
typedef unsigned short bf16_t;
typedef short bf16x8 __attribute__((ext_vector_type(8)));
typedef float f32x4 __attribute__((ext_vector_type(4)));
typedef unsigned u32x4 __attribute__((ext_vector_type(4)));
typedef unsigned u32x2 __attribute__((ext_vector_type(2)));

constexpr int T_TOK = 16896, SEQA = 8448, NCTX = 256;
constexpr int NLAYER = 4;
constexpr int LDS_BYTES = 143360;
constexpr size_t OFF_X = 0;
constexpr size_t OFF_H = 69206016;
constexpr size_t OFF_Z = 103809024;
constexpr size_t OFF_ZRW = OFF_Z + 69206016;
constexpr size_t OFF_MLG = 242221056;
constexpr size_t OFF_W = 243302400;
constexpr size_t OFF_YA = 281837568;
constexpr size_t OFF_YB = 299139072;
constexpr size_t OFF_YC = 316440576;
constexpr size_t OFF_F1 = 333742080;
constexpr size_t OFF_MOD = 402948096;
constexpr size_t OFF_S5P = 403243008;
constexpr size_t OFF_MLS = OFF_S5P + 4 * 589824;
constexpr size_t WS_END = OFF_MLS + 16384;
constexpr size_t OFF_CLOC = OFF_F1;
constexpr size_t OFF_S5ST = OFF_F1 + 34873344;
constexpr size_t OFF_QKC = OFF_F1 + 43524096;
constexpr size_t OFF_ZG = OFF_H;
constexpr size_t OFF_LORAIN = OFF_H + 17301504;
constexpr size_t W_MIX = 0, W_GATE = 8388608, W_GLU = 14680064, W_LORA = 15204352, W_PA = 16515072, W_PB = 17563648, W_PC = 18612224, W_OUT = 19660800, W_1 = 21757952, W_2 = 30146560;

struct Params {
    const float* in[42];
    float* out;
    unsigned char* ws;
};

typedef const __attribute__((address_space(4))) Params CParams;
__device__ __forceinline__ CParams& KPL() {
    unsigned long long a = (unsigned long long)__builtin_amdgcn_kernarg_segment_ptr();
    asm volatile("" : "+s"(a));
    return *(CParams*)a;
}
struct Ctx { int tid, bid, nb; };
__device__ __forceinline__ Ctx mkctx() { Ctx c; c.tid = threadIdx.x; c.bid = blockIdx.x; c.nb = gridDim.x; asm volatile("" : "+v"(c.tid), "+s"(c.bid), "+s"(c.nb)); return c; }
__device__ __forceinline__ float bf2f(unsigned v) { return __uint_as_float(v << 16); }
__device__ __forceinline__ float bflo(unsigned w) { return __uint_as_float(w << 16); }
__device__ __forceinline__ float bfhi(unsigned w) { return __uint_as_float(w & 0xffff0000u); }
__device__ __forceinline__ bf16_t f2bf(float f) { unsigned u = __float_as_uint(f); u += 0x7FFFu + ((u >> 16) & 1u); return (bf16_t)(u >> 16); }
__device__ __forceinline__ unsigned pk2(float lo, float hi) { return (unsigned)f2bf(lo) | ((unsigned)f2bf(hi) << 16); }
__device__ __forceinline__ void store4bf(bf16_t* p, f32x4 v) { u32x2 r; r.x = pk2(v[0], v[1]); r.y = pk2(v[2], v[3]); *(u32x2*)p = r; }
__device__ __forceinline__ float sigmoidf_(float x) { return 1.f / (1.f + __expf(-x)); }

#define DPP_F(x, ctrl, rmask) __int_as_float(__builtin_amdgcn_update_dpp(0, __float_as_int(x), ctrl, rmask, 0xF, false))
__device__ __forceinline__ float row8_sum(float x) {
    x += DPP_F(x, 0xB1, 0xF); x += DPP_F(x, 0x4E, 0xF); x += DPP_F(x, 0x141, 0xF); return x;
}
__device__ __forceinline__ float row16_sum(float x) {
    x += DPP_F(x, 0xB1, 0xF); x += DPP_F(x, 0x4E, 0xF); x += DPP_F(x, 0x141, 0xF); x += DPP_F(x, 0x140, 0xF); return x;
}
__device__ __forceinline__ float wave_sum(float x) {
    x = row16_sum(x);
    x += DPP_F(x, 0x142, 0xA);
    x += DPP_F(x, 0x143, 0xC);
    return __int_as_float(__builtin_amdgcn_readlane(__float_as_int(x), 63));
}

namespace pg8 {
constexpr int BM = 256, BK = 64, HALF = 128, HTB = HALF * BK * 2, NXCD = 8, WGM = 8;
__device__ __forceinline__ int lds_byte(int r, int c) { const int st = (r >> 4) * 2 + (c >> 5), rr = r & 15, cc = c & 31, ob = rr * 64 + cc * 2; return st * 1024 + (ob ^ (((ob >> 9) & 1) << 5)); }
__device__ __forceinline__ void stage_rc(int b, int& R, int& C) { const int st = b / 1024, sb = b % 1024, swz = sb ^ (((sb >> 9) & 1) << 5); R = (st >> 1) * 16 + swz / 64; C = (st & 1) * 32 + (swz % 64) / 2; }
struct Unit { int pm, pn; };
struct Gemm { const bf16_t* A; const bf16_t* Bt; int M, N, K; };
struct StaticOrder {
    int nM, nN, nwg, G, c;
    __device__ void init(int M, int N, int G_, int c_) { nM = M / BM; nN = N / BM; nwg = nM * nN; G = G_; c = c_; }
    __device__ bool next(int i, Unit& u) const {
        const long L = (long)i * G + c; if (L >= nwg) return false;
        int wgid = (int)L; { const int q = nwg / NXCD, r = nwg % NXCD, xcd = wgid % NXCD, off = wgid / NXCD; wgid = (xcd < r ? xcd * (q + 1) : r * (q + 1) + (xcd - r) * q) + off; }
        const int nig = WGM * nN, gid = wgid / nig, fm = gid * WGM, gsz = (nM - fm) < WGM ? (nM - fm) : WGM;
        u.pm = fm + ((wgid % nig) % gsz); u.pn = (wgid % nig) / gsz; return true;
    }
};

template <class Epi>
__device__ __forceinline__ void gemm_phase(int tid_in, LAS unsigned char* lds, const Gemm g, const StaticOrder& S, const Epi& E) {
    const int tid = tid_in, wid = __builtin_amdgcn_readfirstlane(tid >> 6), lane = tid & 63, wr = wid >> 2, wc = wid & 3, fr = lane & 15, fq = lane >> 4;
    const int K = g.K, nt = K / BK;
    unsigned voffA[2], voffB[2];
#pragma unroll
    for (int i = 0; i < 2; ++i) { int R, C; stage_rc(tid * 16 + i * 8192, R, C); voffA[i] = (unsigned)(R * K + C) * 2u; voffB[i] = voffA[i]; }
    const size_t kstep = (size_t)(BK * 2);
    const size_t hstep = (size_t)HALF * K * 2;
    const size_t tstep = 2 * hstep;
    const unsigned ldsw = (unsigned)wid * 1024u;
    const int aoff = lds_byte(wr * 64 + fr, fq * 8), boff = lds_byte(wc * 32 + fr, fq * 8);
#define PG8_SA(b, h) (((b) * 2 + (h)) * HTB)
#define PG8_SB(b, h) ((4 + (b) * 2 + (h)) * HTB)
#define PG8_STAGE(bufoff, gbase, voff) do { _Pragma("unroll") for (int _i = 0; _i < 2; ++_i) \
        __builtin_amdgcn_global_load_lds((const unsigned*)((const char*)(gbase) + (voff)[_i]), (LAS unsigned*)(lds + (bufoff) + ldsw + _i * 8192), 16, 0, 0); } while (0)
#define PG8_LDA(dst, b, h) do { _Pragma("unroll") for (int m = 0; m < 4; ++m) _Pragma("unroll") for (int k = 0; k < 2; ++k) dst[m][k] = *(const LAS bf16x8*)(lds + PG8_SA(b, h) + aoff + m * 2048 + k * 1024); } while (0)
#define PG8_LDB(dst, b, h) do { _Pragma("unroll") for (int n = 0; n < 2; ++n) _Pragma("unroll") for (int k = 0; k < 2; ++k) dst[n][k] = *(const LAS bf16x8*)(lds + PG8_SB(b, h) + boff + n * 2048 + k * 1024); } while (0)
#define PG8_MMA(ai, bj, At, Bt) do { __builtin_amdgcn_s_setprio(1); _Pragma("unroll") for (int m = 0; m < 4; ++m) _Pragma("unroll") for (int n = 0; n < 2; ++n) _Pragma("unroll") for (int k = 0; k < 2; ++k) \
        acc[ai][bj][m][n] = __builtin_amdgcn_mfma_f32_16x16x32_bf16(Bt[n][k], At[m][k], acc[ai][bj][m][n], 0, 0, 0); __builtin_amdgcn_s_setprio(0); } while (0)
#define PG8_WAIT_V(n) asm volatile("s_waitcnt vmcnt(" #n ")" ::: "memory")
#define PG8_WAIT_L(n) asm volatile("s_waitcnt lgkmcnt(" #n ")" ::: "memory")
#define PG8_BAR __builtin_amdgcn_s_barrier()
#define PG8_SCHED __builtin_amdgcn_sched_barrier(0)
    Unit cur, nxt; int ui = 0;
    if (!S.next(0, cur)) return;
    f32x4 acc[2][2][4][2];
#pragma unroll
    for (int a = 0; a < 2; ++a)
#pragma unroll
        for (int b = 0; b < 2; ++b)
#pragma unroll
            for (int m = 0; m < 4; ++m)
#pragma unroll
                for (int n = 0; n < 2; ++n) acc[a][b][m][n] = (f32x4){0.f, 0.f, 0.f, 0.f};
    bf16x8 At[4][2], B0[2][2], B1[2][2];
    const char* cA = (const char*)g.A + (size_t)cur.pm * tstep; const char* cB = (const char*)g.Bt + (size_t)cur.pn * tstep;
    PG8_STAGE(PG8_SB(0, 0), cB, voffB); PG8_STAGE(PG8_SA(0, 0), cA, voffA); PG8_STAGE(PG8_SB(0, 1), cB + hstep, voffB); PG8_STAGE(PG8_SA(0, 1), cA + hstep, voffA);
    if (wr == 1) PG8_BAR;
    PG8_WAIT_V(4); PG8_BAR;
    PG8_STAGE(PG8_SB(1, 0), cB + kstep, voffB); PG8_STAGE(PG8_SA(1, 0), cA + kstep, voffA); PG8_STAGE(PG8_SB(1, 1), cB + hstep + kstep, voffB);
    PG8_WAIT_V(6); PG8_BAR;
    for (;;) {
        const bool has_next = S.next(ui + 1, nxt);
        const char* nA = has_next ? (const char*)g.A + (size_t)nxt.pm * tstep : cA; const char* nB = has_next ? (const char*)g.Bt + (size_t)nxt.pn * tstep : cB;
        for (int t = 0; t < nt; t += 2) {
            const bool last = (t == nt - 2);
            const char* a1 = cA + (size_t)(t + 1) * kstep;
            const char* a2 = last ? nA : cA + (size_t)(t + 2) * kstep; const char* b2 = last ? nB : cB + (size_t)(t + 2) * kstep;
            const char* a3 = a2 + kstep; const char* b3 = b2 + kstep;
            PG8_LDB(B0, 0, 0); PG8_SCHED; PG8_LDA(At, 0, 0); PG8_STAGE(PG8_SA(1, 1), a1 + hstep, voffA);
            PG8_WAIT_L(8); PG8_BAR; PG8_WAIT_L(0); PG8_MMA(0, 0, At, B0); PG8_BAR; PG8_SCHED;
            PG8_LDB(B1, 0, 1); PG8_STAGE(PG8_SB(0, 0), b2, voffB);
            PG8_BAR; PG8_WAIT_L(0); PG8_MMA(0, 1, At, B1); PG8_BAR;
            PG8_LDA(At, 0, 1); PG8_STAGE(PG8_SA(0, 0), a2, voffA);
            PG8_BAR; PG8_WAIT_L(0); PG8_MMA(1, 0, At, B0); PG8_BAR; PG8_SCHED;
            PG8_STAGE(PG8_SB(0, 1), b2 + hstep, voffB);
            PG8_WAIT_V(6); PG8_BAR; PG8_MMA(1, 1, At, B1); PG8_BAR;
            PG8_LDB(B0, 1, 0); PG8_SCHED; PG8_LDA(At, 1, 0); PG8_STAGE(PG8_SA(0, 1), a2 + hstep, voffA);
            PG8_WAIT_L(8); PG8_BAR; PG8_WAIT_L(0); PG8_MMA(0, 0, At, B0); PG8_BAR; PG8_SCHED;
            PG8_LDB(B1, 1, 1); PG8_STAGE(PG8_SB(1, 0), b3, voffB);
            PG8_BAR; PG8_WAIT_L(0); PG8_MMA(0, 1, At, B1); PG8_BAR;
            PG8_LDA(At, 1, 1); PG8_STAGE(PG8_SA(1, 0), a3, voffA);
            PG8_BAR; PG8_WAIT_L(0); PG8_MMA(1, 0, At, B0); PG8_BAR; PG8_SCHED;
            PG8_STAGE(PG8_SB(1, 1), b3 + hstep, voffB);
            PG8_WAIT_V(6); PG8_BAR; PG8_MMA(1, 1, At, B1); PG8_BAR;
        }
        E(acc, cur, wr, wc, fr, fq);
        if (!has_next) break;
#pragma unroll
        for (int a = 0; a < 2; ++a)
#pragma unroll
            for (int b = 0; b < 2; ++b)
#pragma unroll
                for (int m = 0; m < 4; ++m)
#pragma unroll
                    for (int n = 0; n < 2; ++n) acc[a][b][m][n] = (f32x4){0.f, 0.f, 0.f, 0.f};
        cur = nxt; cA = nA; cB = nB; ++ui;
    }
    PG8_WAIT_V(0);
    if (wr == 0) PG8_BAR;
    PG8_BAR;
#undef PG8_SA
#undef PG8_SB
#undef PG8_STAGE
#undef PG8_LDA
#undef PG8_LDB
#undef PG8_MMA
#undef PG8_WAIT_V
#undef PG8_WAIT_L
#undef PG8_BAR
#undef PG8_SCHED
}

template <class F> struct EpiT {
    F f;
    __device__ __forceinline__ void operator()(const f32x4 (&acc)[2][2][4][2], const Unit& u, int wr, int wc, int fr, int fq) const {
        const int row0 = u.pm * BM + wr * 64 + fr, col0 = u.pn * BM + wc * 32 + 4 * fq;
#pragma unroll
        for (int ai = 0; ai < 2; ++ai)
#pragma unroll
            for (int m = 0; m < 4; ++m) {
                const int row = row0 + ai * HALF + m * 16;
#pragma unroll
                for (int bj = 0; bj < 2; ++bj)
#pragma unroll
                    for (int n = 0; n < 2; ++n) f(row, col0 + bj * HALF + n * 16, acc[ai][bj][m][n]);
            }
    }
};
}

template <class F>
__device__ __forceinline__ void run_gemm(const Ctx& cx, LAS unsigned char* lds, const bf16_t* A, const bf16_t* Bt, int N, int K, const F& f) {
    pg8::Gemm g; g.A = A; g.Bt = Bt; g.M = T_TOK; g.N = N; g.K = K;
    pg8::StaticOrder S; S.init(T_TOK, N, cx.nb, cx.bid);
    pg8::EpiT<F> E{f};
    pg8::gemm_phase(cx.tid, lds, g, S, E);
}

template <class E>
__device__ __forceinline__ void run_gemm_epi(const Ctx& cx, LAS unsigned char* lds, const bf16_t* A, const bf16_t* Bt, int N, int K, const E& e) {
    pg8::Gemm g; g.A = A; g.Bt = Bt; g.M = T_TOK; g.N = N; g.K = K;
    pg8::StaticOrder S; S.init(T_TOK, N, cx.nb, cx.bid);
    pg8::gemm_phase(cx.tid, lds, g, S, e);
}
__device__ __forceinline__ int row_vec(int row) { const int b = row >= SEQA ? 1 : 0; const int t = row - b * SEQA; return t < NCTX ? 2 : b; }

struct FInproj { bf16_t* za; float* mlg; bf16_t* zrw;
    __device__ __forceinline__ void operator()(int row, int col, f32x4 v) const {
        if (col < 2048) store4bf(za + (size_t)row * 2048 + col, v);
        else if (col < 2064) *(f32x4*)(mlg + (size_t)row * 16 + (col - 2048)) = v;
        else if (col < 3856) store4bf(zrw + (size_t)row * 1792 + (col - 2064), v);
    } };
struct FGlu { const bf16_t* zg; const float* bglu; bf16_t* ya;
    __device__ __forceinline__ void operator()(int row, int col, f32x4 v) const {
        const u32x2 z = *(const u32x2*)(zg + (size_t)row * 512 + col); const f32x4 b = *(const f32x4*)(bglu + col);
        f32x4 o; o[0] = bflo(z.x) * sigmoidf_(v[0] + b[0]); o[1] = bfhi(z.x) * sigmoidf_(v[1] + b[1]); o[2] = bflo(z.y) * sigmoidf_(v[2] + b[2]); o[3] = bfhi(z.y) * sigmoidf_(v[3] + b[3]);
        store4bf(ya + (size_t)row * 512 + col, o);
    } };
struct EpiLora { const float* w0; const float* a0; bf16_t* f2; bf16_t* grw;
    __device__ __forceinline__ void operator()(const f32x4 (&acc)[2][2][4][2], const pg8::Unit& u, int wr, int wc, int fr, int fq) const {
        const int row0 = u.pm * 256 + wr * 64 + fr, col0 = u.pn * 256 + wc * 32 + 4 * fq;
        const int pn = __builtin_amdgcn_readfirstlane(u.pn);
        if (pn < 8) {
            const float* bias = pn < 4 ? w0 : a0 - 1024;
#pragma unroll
            for (int bj = 0; bj < 2; ++bj)
#pragma unroll
                for (int n = 0; n < 2; ++n) {
                    const int col = col0 + bj * 128 + n * 16;
                    const f32x4 b = *(const f32x4*)(bias + col);
#pragma unroll
                    for (int ai = 0; ai < 2; ++ai)
#pragma unroll
                        for (int m = 0; m < 4; ++m) {
                            const int row = row0 + ai * 128 + m * 16; f32x4 o;
#pragma unroll
                            for (int e = 0; e < 4; ++e) { const float s = sigmoidf_(acc[ai][bj][m][n][e] + b[e]); o[e] = pn < 4 ? 1.f - __expf(-0.60653065971f * s) : s; }
                            store4bf(f2 + (size_t)row * 2048 + col, o);
                        }
                }
        } else {
#pragma unroll
            for (int ai = 0; ai < 2; ++ai)
#pragma unroll
                for (int m = 0; m < 4; ++m) { const int row = row0 + ai * 128 + m * 16;
#pragma unroll
                    for (int bj = 0; bj < 2; ++bj)
#pragma unroll
                        for (int n = 0; n < 2; ++n) store4bf(grw + (size_t)row * 512 + (col0 + bj * 128 + n * 16 - 2048), acc[ai][bj][m][n]); }
        }
    } };
struct FGate { bf16_t* g;
    __device__ __forceinline__ void operator()(int row, int col, f32x4 v) const {
        f32x4 o; o[0] = sigmoidf_(v[0]); o[1] = sigmoidf_(v[1]); o[2] = sigmoidf_(v[2]); o[3] = sigmoidf_(v[3]);
        store4bf(g + (size_t)row * 3072 + col, o);
    } };
template <int J> struct FMerge { const bf16_t* g; float* y32; bf16_t* ybf;
    __device__ __forceinline__ void operator()(int row, int col, f32x4 v) const {
        const u32x2 z = *(const u32x2*)(g + (size_t)row * 3072 + J * 1024 + col);
        f32x4 o; o[0] = bflo(z.x) * v[0]; o[1] = bfhi(z.x) * v[1]; o[2] = bflo(z.y) * v[2]; o[3] = bfhi(z.y) * v[3];
        float* yp = y32 + (size_t)row * 1024 + col;
        if (J == 0) *(f32x4*)yp = o;
        else if (J == 1) { f32x4 t = *(f32x4*)yp; *(f32x4*)yp = t + o; }
        else { f32x4 t = *(f32x4*)yp; store4bf(ybf + (size_t)row * 1024 + col, t + o); }
    } };
struct FResid { float* x; const float* modl; int chunk;
    __device__ __forceinline__ void operator()(int row, int col, f32x4 v) const {
        const f32x4 mg = *(const f32x4*)(modl + row_vec(row) * 6144 + chunk * 1024 + col);
        float* xp = x + (size_t)row * 1024 + col; f32x4 t = *(f32x4*)xp; *(f32x4*)xp = t + mg * v;
    } };
struct FMlp1 { bf16_t* hid;
    __device__ __forceinline__ void operator()(int row, int col, f32x4 v) const {
        f32x4 o;
#pragma unroll
        for (int e = 0; e < 4; ++e) { const float r = fmaxf(v[e], 0.f); o[e] = r * r; }
        store4bf(hid + (size_t)row * 4096 + col, o);
    } };

__device__ __forceinline__ void phase_mod(float* smf) {
    CParams& p = KPL(); const Ctx cx = mkctx();
    const int tid = cx.tid, lane = tid & 63, wid = tid >> 6;
    float* sc = smf; float* red = smf + 3072;
    float* MOD = (float*)(p.ws + OFF_MOD);
    for (int i = tid; i < 3072; i += 512) { const int v = i >> 10, j = i & 1023; const float c = v < 2 ? p.in[1][v * 1024 + j] : p.in[3][j]; sc[i] = c / (1.f + expf(-c)); }
    __syncthreads();
    for (int item = cx.bid; item < 4 * 96; item += cx.nb) {
        const int l = item / 96, jt = item % 96, j = jt * 64 + lane;
        const float* w = p.in[4] + (size_t)l * 1024 * 6144 + j;
        float a0 = 0.f, a1 = 0.f, a2 = 0.f;
#pragma unroll 8
        for (int i = wid * 128; i < wid * 128 + 128; ++i) { const float wv = w[(size_t)i * 6144]; a0 += sc[i] * wv; a1 += sc[1024 + i] * wv; a2 += sc[2048 + i] * wv; }
        red[(wid * 3 + 0) * 64 + lane] = a0; red[(wid * 3 + 1) * 64 + lane] = a1; red[(wid * 3 + 2) * 64 + lane] = a2;
        __syncthreads();
        if (tid < 192) { const int v = tid >> 6; float s = 0.f;
            for (int w8 = 0; w8 < 8; ++w8) s += red[(w8 * 3 + v) * 64 + lane];
            MOD[(l * 3 + v) * 6144 + j] = s + p.in[5][l * 6144 + j]; }
        __syncthreads();
    }
}

__device__ __forceinline__ void dsincos(double x, double& s, double& c) {
    const double k = rint(x * 0.63661977236758134308);
    double r = fma(-k, 1.57079632679489655800, x); r = fma(-k, 6.12323399573676603587e-17, r);
    const double r2 = r * r;
    double ps = -1.0 / 355687428096000.0;
    ps = fma(ps, r2, 1.0 / 1307674368000.0); ps = fma(ps, r2, -1.0 / 6227020800.0); ps = fma(ps, r2, 1.0 / 39916800.0); ps = fma(ps, r2, -1.0 / 362880.0);
    ps = fma(ps, r2, 1.0 / 5040.0); ps = fma(ps, r2, -1.0 / 120.0); ps = fma(ps, r2, 1.0 / 6.0); ps = fma(ps, r2, -1.0); ps = -ps * r;
    double pc = 1.0 / 20922789888000.0;
    pc = fma(pc, r2, -1.0 / 87178291200.0); pc = fma(pc, r2, 1.0 / 479001600.0); pc = fma(pc, r2, -1.0 / 3628800.0); pc = fma(pc, r2, 1.0 / 40320.0);
    pc = fma(pc, r2, -1.0 / 720.0); pc = fma(pc, r2, 1.0 / 24.0); pc = fma(pc, r2, -0.5); pc = fma(pc, r2, 1.0);
    const int q = ((int)k) & 3;
    s = (q == 0) ? ps : (q == 1) ? pc : (q == 2) ? -ps : -pc;
    c = (q == 0) ? pc : (q == 1) ? -ps : (q == 2) ? -pc : ps;
}
__device__ __forceinline__ double dexp_neg(double x) {
    const double k = rint(x * 1.44269504088896338700);
    double r = fma(-k, 0.693147180369123816490, x); r = fma(-k, 1.90821492927058770002e-10, r);
    double pe = 1.0 / 6227020800.0;
    pe = fma(pe, r, 1.0 / 479001600.0); pe = fma(pe, r, 1.0 / 39916800.0); pe = fma(pe, r, 1.0 / 3628800.0); pe = fma(pe, r, 1.0 / 362880.0); pe = fma(pe, r, 1.0 / 40320.0);
    pe = fma(pe, r, 1.0 / 5040.0); pe = fma(pe, r, 1.0 / 720.0); pe = fma(pe, r, 1.0 / 120.0); pe = fma(pe, r, 1.0 / 24.0); pe = fma(pe, r, 1.0 / 6.0); pe = fma(pe, r, 0.5);
    pe = fma(pe, r, 1.0); pe = fma(pe, r, 1.0);
    int ki = (int)k; if (ki < -1000) return 0.0;
    return pe * __longlong_as_double((long long)(1023 + ki) << 52);
}

__device__ __forceinline__ void wconv_tile(const Ctx& cx, const float* src, int ld, int K, int c0, int ncols, bf16_t* dst, int kt, int nt, float* tile) {
    const int tid = cx.tid, j = tid & 63, i0 = tid >> 6;
#pragma unroll
    for (int e = 0; e < 8; ++e) { const int i = i0 + 8 * e; const int n = nt * 64 + j;
        tile[i * 65 + j] = (n < ncols) ? src[(size_t)(kt * 64 + i) * ld + c0 + n] : 0.f; }
    __syncthreads();
#pragma unroll
    for (int e = 0; e < 8; ++e) { const int jj = i0 + 8 * e;
        dst[(size_t)(nt * 64 + jj) * K + kt * 64 + j] = f2bf(tile[j * 65 + jj]); }
    __syncthreads();
}

__device__ __forceinline__ void phase_wconv(int l, float* smf) {
    CParams& p = KPL(); const Ctx cx = mkctx();
    bf16_t* W = (bf16_t*)(p.ws + OFF_W);
    const int tid = cx.tid;
    for (int item = cx.bid; item < 5184; item += cx.nb) {
        if (item < 4544) {
            const float* src; int ld, K, c0, ncols, nN; bf16_t* dst; int t = item;
            if (t < 1024) { src = p.in[8] + (size_t)l * 1024 * 6928; ld = 6928; K = 1024; c0 = 0; ncols = 3856; nN = 64; dst = W + W_MIX / 2; }
            else if (t < 1792) { t -= 1024; src = p.in[8] + (size_t)l * 1024 * 6928; ld = 6928; K = 1024; c0 = 3856; ncols = 3072; nN = 48; dst = W + W_GATE / 2; }
            else if (t < 1856) { t -= 1792; src = p.in[17] + (size_t)l * 512 * 512; ld = 512; K = 512; c0 = 0; ncols = 512; nN = 8; dst = W + W_GLU / 2; }
            else if (t < 1984) { t -= 1856; src = p.in[35] + (size_t)l * 512 * 1024; ld = 1024; K = 512; c0 = 0; ncols = 1024; nN = 16; dst = W + W_PA / 2; }
            else if (t < 2112) { t -= 1984; src = p.in[36] + (size_t)l * 512 * 1024; ld = 1024; K = 512; c0 = 0; ncols = 1024; nN = 16; dst = W + W_PB / 2; }
            else if (t < 2240) { t -= 2112; src = p.in[37] + (size_t)l * 512 * 1024; ld = 1024; K = 512; c0 = 0; ncols = 1024; nN = 16; dst = W + W_PC / 2; }
            else if (t < 2496) { t -= 2240; src = p.in[38] + (size_t)l * 1024 * 1024; ld = 1024; K = 1024; c0 = 0; ncols = 1024; nN = 16; dst = W + W_OUT / 2; }
            else if (t < 3520) { t -= 2496; src = p.in[39] + (size_t)l * 1024 * 4096; ld = 4096; K = 1024; c0 = 0; ncols = 4096; nN = 64; dst = W + W_1 / 2; }
            else { t -= 3520; src = p.in[40] + (size_t)l * 4096 * 1024; ld = 1024; K = 4096; c0 = 0; ncols = 1024; nN = 16; dst = W + W_2 / 2; }
            const int nt = t % nN, kt = t / nN;
            wconv_tile(cx, src, ld, K, c0, ncols, dst, kt, nt, smf);
        } else {
            bf16_t* dst = W + W_LORA / 2;
#pragma unroll
            for (int q = 0; q < 2; ++q) {
                const int e = (item - 4544) * 1024 + q * 512 + tid; const int n = e >> 8, k = e & 255;
                float v = 0.f;
                if (n < 1024) { if (k < 64) v = p.in[26][(((size_t)l * 2 + (n >> 9)) * 64 + k) * 512 + (n & 511)]; }
                else if (n < 2048) { if (k >= 64 && k < 128) v = p.in[28][(((size_t)l * 2 + ((n - 1024) >> 9)) * 64 + (k - 64)) * 512 + (n & 511)]; }
                else { if (k >= 128) v = p.in[29][((size_t)l * 128 + (k - 128)) * 512 + (n - 2048)]; }
                dst[e] = f2bf(v);
            }
        }
    }
}

__device__ __forceinline__ void phase_s5_params() {
    CParams& p = KPL(); const Ctx cx = mkctx();
    for (int item = cx.bid; item < 32; item += cx.nb) {
        const int l = item >> 3;
        const int idx = (item & 7) * 512 + cx.tid;
        const int dir = idx >> 11, g = (idx >> 6) & 31;
        float* S5P = (float*)(p.ws + OFF_S5P) + (size_t)l * 147456;
        const size_t pi = (size_t)l * 4096 + idx;
        const double lre = fmin((double)p.in[9][pi], -1e-4), lim = (double)p.in[10][pi];
        const double dt = dexp_neg((double)p.in[11][(l * 2 + dir) * 32 + g]);
        const double mag = dexp_neg(lre * dt); double sn, cs; dsincos(lim * dt, sn, cs);
        const double ar = mag * cs, ai = mag * sn;
        const double den = lre * lre + lim * lim, nr = ar - 1.0;
        const double cr = (nr * lre + ai * lim) / den, ci = (ai * lre - nr * lim) / den;
        const double mag64 = dexp_neg(64.0 * lre * dt); dsincos(64.0 * lim * dt, sn, cs);
        S5P[idx] = (float)ar; S5P[4096 + idx] = (float)ai; S5P[8192 + idx] = (float)(mag64 * cs); S5P[12288 + idx] = (float)(mag64 * sn);
        float* BR = S5P + 16384; float* BI = BR + 65536;
        for (int c = 0; c < 16; ++c) { const double bre = p.in[12][pi * 16 + c], bim = p.in[13][pi * 16 + c];
            BR[(size_t)idx * 16 + c] = (float)(cr * bre - ci * bim); BI[(size_t)idx * 16 + c] = (float)(cr * bim + ci * bre); }
    }
}

__device__ __forceinline__ void phase_norm(int l, int which, bool init) {
    CParams& p = KPL(); const Ctx cx = mkctx();
    const int lane = cx.tid & 63, gw = cx.bid * 8 + (cx.tid >> 6), nw = cx.nb * 8;
    float* X = (float*)(p.ws + OFF_X); bf16_t* H = (bf16_t*)(p.ws + OFF_H);
    const float* MODL = (const float*)(p.ws + OFF_MOD) + (size_t)l * 3 * 6144;
    const float* gam = p.in[which ? 7 : 6] + l * 1024;
    for (int row = gw; row < T_TOK; row += nw) {
        const int b = row >= SEQA ? 1 : 0, t = row - b * SEQA;
        const float* src = init ? (t < NCTX ? p.in[2] + ((size_t)b * NCTX + t) * 1024 : p.in[0] + ((size_t)b * 8192 + (t - NCTX)) * 1024) : X + (size_t)row * 1024;
        f32x4 v[4]; float ss = 0.f;
#pragma unroll
        for (int i = 0; i < 4; ++i) { v[i] = *(const f32x4*)(src + (lane + 64 * i) * 4); ss += v[i][0] * v[i][0] + v[i][1] * v[i][1] + v[i][2] * v[i][2] + v[i][3] * v[i][3]; }
        if (init) {
#pragma unroll
            for (int i = 0; i < 4; ++i) *(f32x4*)(X + (size_t)row * 1024 + (lane + 64 * i) * 4) = v[i];
        }
        ss = wave_sum(ss);
        const float inv = rsqrtf(ss * (1.f / 1024.f) + 1e-6f);
        const float* mv = MODL + (t < NCTX ? 2 : b) * 6144 + (which ? 3 : 0) * 1024;
#pragma unroll
        for (int i = 0; i < 4; ++i) { const int c = (lane + 64 * i) * 4;
            const f32x4 g4 = *(const f32x4*)(gam + c), sh = *(const f32x4*)(mv + c), scl = *(const f32x4*)(mv + 1024 + c);
            f32x4 o;
#pragma unroll
            for (int e = 0; e < 4; ++e) o[e] = v[i][e] * inv * g4[e] * (1.f + scl[e]) + sh[e];
            store4bf(H + (size_t)row * 1024 + c, o); }
    }
}

__device__ __forceinline__ int s5_order(int dir, int i) { return dir == 0 ? i : (i < 4 ? 3 - i : 135 - i); }

__device__ __forceinline__ void phase_s5_local(int l) {
    CParams& p = KPL(); const Ctx cx = mkctx();
    const int lane = cx.tid & 63, gw = cx.bid * 8 + (cx.tid >> 6), nw = cx.nb * 8;
    const bf16_t* ZA = (const bf16_t*)(p.ws + OFF_Z);
    const float* S5P = (const float*)(p.ws + OFF_S5P) + (size_t)l * 147456; const float* BR = S5P + 16384; const float* BI = BR + 65536;
    float* ST = (float*)(p.ws + OFF_S5ST);
    for (int item0 = gw; item0 < 16896; item0 += nw) {
        const int item = __builtin_amdgcn_readfirstlane(item0);
        const int chunk = item % 132, g = (item / 132) & 31, dir = (item / 4224) & 1, b = item / 8448;
        const int idx = dir * 2048 + g * 64 + lane;
        const float ar = S5P[idx], ai = S5P[4096 + idx];
        float br[16], bi[16];
#pragma unroll
        for (int q = 0; q < 4; ++q) { const f32x4 t0 = *(const f32x4*)(BR + (size_t)idx * 16 + q * 4), t1 = *(const f32x4*)(BI + (size_t)idx * 16 + q * 4);
#pragma unroll
            for (int e = 0; e < 4; ++e) { br[q * 4 + e] = t0[e]; bi[q * 4 + e] = t1[e]; } }
        const int row = b * SEQA + chunk * 64 + lane;
        const u32x4 u0 = *(const u32x4*)(ZA + (size_t)row * 2048 + g * 16), u1 = *(const u32x4*)(ZA + (size_t)row * 2048 + g * 16 + 8);
        unsigned ur[8] = {u0.x, u0.y, u0.z, u0.w, u1.x, u1.y, u1.z, u1.w};
        float hr = 0.f, hi = 0.f;
#pragma unroll 8
        for (int j = 0; j < 64; ++j) {
            const int tok = dir ? 63 - j : j;
            float bur = 0.f, bui = 0.f;
#pragma unroll
            for (int q = 0; q < 8; ++q) { const unsigned w = (unsigned)__builtin_amdgcn_readlane((int)ur[q], tok); const float x0 = bflo(w), x1 = bfhi(w);
                bur += br[2 * q] * x0 + br[2 * q + 1] * x1; bui += bi[2 * q] * x0 + bi[2 * q + 1] * x1; }
            const float nr = ar * hr - ai * hi + bur, ni = ar * hi + ai * hr + bui; hr = nr; hi = ni;
        }
        float* st = ST + ((((size_t)b * 2 + dir) * 32 + g) * 132 + chunk) * 128;
        st[lane] = hr; st[64 + lane] = hi;
    }
}

__device__ __forceinline__ void phase_s5_carry(int l) {
    CParams& p = KPL(); const Ctx cx = mkctx();
    const int lane = cx.tid & 63, gw = cx.bid * 8 + (cx.tid >> 6), nw = cx.nb * 8;
    const float* S5P = (const float*)(p.ws + OFF_S5P) + (size_t)l * 147456;
    float* ST = (float*)(p.ws + OFF_S5ST);
    for (int item0 = gw; item0 < 128; item0 += nw) {
        const int item = __builtin_amdgcn_readfirstlane(item0);
        const int g = item & 31, dir = (item >> 5) & 1, b = item >> 6;
        const int idx = dir * 2048 + g * 64 + lane;
        const float ar = S5P[8192 + idx], ai = S5P[12288 + idx];
        float* st = ST + (((size_t)b * 2 + dir) * 32 + g) * 132 * 128;
        float hr = 0.f, hi = 0.f;
        for (int i0 = 0; i0 < 132; i0 += 12) {
            float lr[12], li[12];
#pragma unroll
            for (int e = 0; e < 12; ++e) { const int c = s5_order(dir, i0 + e); lr[e] = st[c * 128 + lane]; li[e] = st[c * 128 + 64 + lane]; }
#pragma unroll
            for (int e = 0; e < 12; ++e) { const int c = s5_order(dir, i0 + e); st[c * 128 + lane] = hr; st[c * 128 + 64 + lane] = hi;
                const float nr = ar * hr - ai * hi + lr[e], ni = ar * hi + ai * hr + li[e]; hr = nr; hi = ni; }
        }
    }
}

template <int DIR>
__device__ __forceinline__ void s5_final_dir(CParams& p, int l, int b, int g, int chunk, int lane, const unsigned (&ur)[8], float* hst, f32x4* ybuf, int row0, float dsk, bf16_t* ZG) {
    const float* S5P = (const float*)(p.ws + OFF_S5P) + (size_t)l * 147456; const float* BR = S5P + 16384; const float* BI = BR + 65536;
    const float* ST = (const float*)(p.ws + OFF_S5ST);
    const bf16_t* ZA = (const bf16_t*)(p.ws + OFF_Z);
    const int idx = DIR * 2048 + g * 64 + lane;
    const float ar = S5P[idx], ai = S5P[4096 + idx];
    float br[16], bi[16];
#pragma unroll
    for (int q = 0; q < 4; ++q) { const f32x4 t0 = *(const f32x4*)(BR + (size_t)idx * 16 + q * 4), t1 = *(const f32x4*)(BI + (size_t)idx * 16 + q * 4);
#pragma unroll
        for (int e = 0; e < 4; ++e) { br[q * 4 + e] = t0[e]; bi[q * 4 + e] = t1[e]; } }
    float cbr[16], cbi[16];
    { const size_t cb = ((((size_t)l * 2 + DIR) * 32 + g) * 16 + (lane & 15)) * 64 + (lane >> 4);
#pragma unroll
      for (int i = 0; i < 16; ++i) { cbr[i] = p.in[14][cb + 4 * i]; cbi[i] = -p.in[15][cb + 4 * i]; } }
    const float* st = ST + ((((size_t)b * 2 + DIR) * 32 + g) * 132 + chunk) * 128;
    float hr = st[lane], hi = st[64 + lane];
    const int ch = g * 16 + (lane & 15);
#pragma unroll 1
    for (int si = 0; si < 4; ++si) {
        const int sc = DIR ? 3 - si : si;
#pragma unroll
        for (int jj = 0; jj < 16; ++jj) {
            const int tt = DIR ? 15 - jj : jj; const int tok = sc * 16 + tt;
            float bur = 0.f, bui = 0.f;
#pragma unroll
            for (int q = 0; q < 8; ++q) { const unsigned w = (unsigned)__builtin_amdgcn_readlane((int)ur[q], tok); const float x0 = bflo(w), x1 = bfhi(w);
                bur += br[2 * q] * x0 + br[2 * q + 1] * x1; bui += bi[2 * q] * x0 + bi[2 * q + 1] * x1; }
            const float nr = ar * hr - ai * hi + bur, ni = ar * hi + ai * hr + bui; hr = nr; hi = ni;
            hst[tt * 68 + lane] = hr; hst[1088 + tt * 68 + lane] = hi;
        }
        f32x4 a = (f32x4){0.f, 0.f, 0.f, 0.f};
        if (DIR) a = ybuf[sc * 64 + lane];
#pragma unroll
        for (int i = 0; i < 16; ++i) {
            const float xr = hst[(lane & 15) * 68 + 4 * i + (lane >> 4)], xi = hst[1088 + (lane & 15) * 68 + 4 * i + (lane >> 4)];
            a = __builtin_amdgcn_mfma_f32_16x16x4f32(xr, cbr[i], a, 0, 0, 0);
            a = __builtin_amdgcn_mfma_f32_16x16x4f32(xi, cbi[i], a, 0, 0, 0);
        }
        if (!DIR) ybuf[sc * 64 + lane] = a;
        else {
#pragma unroll
            for (int j = 0; j < 4; ++j) {
                const int row = row0 + sc * 16 + (lane >> 4) * 4 + j;
                const float u = bf2f(ZA[(size_t)row * 2048 + ch]);
                const float y = u * dsk + a[j];
                const float z = 0.5f * y * (1.f + tanhf(0.7978845608028654f * (y + 0.044715f * y * y * y)));
                ZG[(size_t)row * 512 + ch] = f2bf(z);
            }
        }
    }
}

__device__ __forceinline__ void phase_s5_final(int l, float* smf) {
    CParams& p = KPL(); const Ctx cx = mkctx();
    const int lane = cx.tid & 63, wid = cx.tid >> 6, gw = cx.bid * 8 + wid, nw = cx.nb * 8;
    const bf16_t* ZA = (const bf16_t*)(p.ws + OFF_Z);
    bf16_t* ZG = (bf16_t*)(p.ws + OFF_ZG);
    float* hst = smf + wid * 3200;
    f32x4* ybuf = (f32x4*)(hst + 2176);
    for (int item0 = gw; item0 < 8448; item0 += nw) {
        const int item = __builtin_amdgcn_readfirstlane(item0);
        const int chunk = item % 132, g = (item / 132) & 31, b = item / 4224;
        const int row0 = b * SEQA + chunk * 64;
        const u32x4 u0 = *(const u32x4*)(ZA + (size_t)(row0 + lane) * 2048 + g * 16), u1 = *(const u32x4*)(ZA + (size_t)(row0 + lane) * 2048 + g * 16 + 8);
        const unsigned ur[8] = {u0.x, u0.y, u0.z, u0.w, u1.x, u1.y, u1.z, u1.w};
        const float dsk = p.in[16][l * 512 + g * 16 + (lane & 15)];
        s5_final_dir<0>(p, l, b, g, chunk, lane, ur, hst, ybuf, row0, dsk, ZG);
        s5_final_dir<1>(p, l, b, g, chunk, lane, ur, hst, ybuf, row0, dsk, ZG);
    }
}

__device__ __forceinline__ int ml_row0(int b, int nc) { return b * SEQA + nc * 128; }
__device__ __forceinline__ int ml_order(int dir, int i) { return dir == 0 ? i : (i < 2 ? 1 - i : 67 - i); }

__device__ __forceinline__ void phase_ml_conv(int l) {
    CParams& p = KPL(); const Ctx cx = mkctx();
    const bf16_t* ZA = (const bf16_t*)(p.ws + OFF_Z);
    bf16_t* QKC = (bf16_t*)(p.ws + OFF_QKC);
    const float* cw = p.in[19] + (size_t)l * 9 * 512; const float* cb = p.in[20] + l * 512;
    for (int idx = cx.bid * 512 + cx.tid; idx < T_TOK * 64; idx += cx.nb * 512) {
        const int row = idx >> 6, c8 = (idx & 63) * 8;
        const int b = row >= SEQA ? 1 : 0, t = row - b * SEQA;
        const bool isctx = t < NCTX;
        const int tt = isctx ? t : t - NCTX, W = isctx ? 256 : 64, Hh = isctx ? 1 : 128;
        const int y = tt / W, x = tt % W;
        const int segrow0 = row - tt;
        float acc[8];
#pragma unroll
        for (int e = 0; e < 8; ++e) acc[e] = cb[c8 + e];
#pragma unroll
        for (int dy = 0; dy < 3; ++dy)
#pragma unroll
            for (int dx = 0; dx < 3; ++dx) {
                const int yy = y + dy - 1, xx = x + dx - 1;
                if (yy >= 0 && yy < Hh && xx >= 0 && xx < W) {
                    const u32x4 z = *(const u32x4*)(ZA + (size_t)(segrow0 + yy * W + xx) * 2048 + 512 + c8);
                    const float* w = cw + (dy * 3 + dx) * 512 + c8;
                    const f32x4 w0 = *(const f32x4*)w, w1 = *(const f32x4*)(w + 4);
                    acc[0] += bflo(z.x) * w0[0]; acc[1] += bfhi(z.x) * w0[1]; acc[2] += bflo(z.y) * w0[2]; acc[3] += bfhi(z.y) * w0[3];
                    acc[4] += bflo(z.z) * w1[0]; acc[5] += bfhi(z.z) * w1[1]; acc[6] += bflo(z.w) * w1[2]; acc[7] += bfhi(z.w) * w1[3];
                }
            }
        u32x4 o;
#pragma unroll
        for (int e = 0; e < 8; ++e) acc[e] = acc[e] * sigmoidf_(acc[e]);
        o.x = pk2(acc[0], acc[1]); o.y = pk2(acc[2], acc[3]); o.z = pk2(acc[4], acc[5]); o.w = pk2(acc[6], acc[7]);
        *(u32x4*)(QKC + (size_t)row * 512 + c8) = o;
    }
}

constexpr int ML_QS = 0, ML_KS = 18432, ML_VT = 36864, ML_CS = 71680, ML_PS = 92416, ML_GV = 127232, ML_BV = 127744, ML_MV = 128256, ML_LF = 128768, ML_IG = 129280, ML_SC = 129792;

__device__ __forceinline__ void ml_gate_vectors(const Ctx& cx, CParams& p, int l, int dir, int b, int h, int nc, unsigned char* sm, float m_in) {
    const int tid = cx.tid, lane = tid & 63;
    float* lf = (float*)(sm + ML_LF); float* ig = (float*)(sm + ML_IG); float* gv = (float*)(sm + ML_GV); float* bv = (float*)(sm + ML_BV); float* mv = (float*)(sm + ML_MV); float* sc = (float*)(sm + ML_SC);
    const float* MLG = (const float*)(p.ws + OFF_MLG);
    const float* gb = p.in[21] + l * 16;
    if (tid < 128) {
        const int row = ml_row0(b, nc) + tid;
        const float ip = MLG[(size_t)row * 16 + dir * 4 + h] + gb[dir * 4 + h];
        const float fp = MLG[(size_t)row * 16 + 8 + dir * 4 + h] + gb[8 + dir * 4 + h];
        ig[tid] = ip; lf[tid] = fminf(fp, 0.f) - log1pf(expf(-fabsf(fp)));
    }
    __syncthreads();
    if (tid < 64) {
        const int pp0 = 2 * lane, pp1 = 2 * lane + 1; const int s0 = dir ? 127 - pp0 : pp0, s1 = dir ? 127 - pp1 : pp1;
        const float x0 = lf[s0], x1 = lf[s1];
        float incl = x0 + x1;
#pragma unroll
        for (int d = 1; d < 64; d <<= 1) { const float t = __shfl_up(incl, d); if (lane >= d) incl += t; }
        const float g1 = incl, g0 = incl - x1;
        const float gtot = __shfl(incl, 63);
        const float b0 = ig[s0] - g0, b1 = ig[s1] - g1;
        float mx = fmaxf(b0, b1);
#pragma unroll
        for (int d = 1; d < 64; d <<= 1) { const float t = __shfl_up(mx, d); if (lane >= d) mx = fmaxf(mx, t); }
        const float prev = __shfl_up(mx, 1);
        const float pm0 = lane > 0 ? fmaxf(prev, b0) : b0, pm1 = mx;
        const float bmax = __shfl(mx, 63);
        gv[s0] = g0; gv[s1] = g1; bv[s0] = b0; bv[s1] = b1; mv[s0] = fmaxf(m_in, pm0); mv[s1] = fmaxf(m_in, pm1);
        if (lane == 0) { sc[0] = gtot; sc[1] = bmax; }
    }
    __syncthreads();
}

__device__ __forceinline__ void phase_ml_local(int l, unsigned char* sm) {
    CParams& p = KPL(); const Ctx cx = mkctx();
    const int tid = cx.tid, lane = tid & 63, wid = tid >> 6;
    const bf16_t* ZA = (const bf16_t*)(p.ws + OFF_Z); const bf16_t* QKC = (const bf16_t*)(p.ws + OFF_QKC);
    float* CLOC = (float*)(p.ws + OFF_CLOC); float* MLS = (float*)(p.ws + OFF_MLS);
    bf16_t* VT = (bf16_t*)(sm + ML_VT); bf16_t* KT = (bf16_t*)(sm + ML_KS);
    const float* bv = (const float*)(sm + ML_BV); const float* sc = (const float*)(sm + ML_SC);
    float* wg = (float*)(sm + ML_LF);
    for (int item = cx.bid; item < 1056; item += cx.nb) {
        const int chain = item / 66, nc = item % 66; const int dir = chain >> 3, b = (chain >> 2) & 1, h = chain & 3;
        ml_gate_vectors(cx, p, l, dir, b, h, nc, sm, -1e30f);
        const float gtot = sc[0], bmax = sc[1];
        __syncthreads();
        if (tid < 128) wg[tid] = expf(bv[tid] - bmax);
        __syncthreads();
        const int row0 = ml_row0(b, nc);
#pragma unroll
        for (int q = 0; q < 4; ++q) { const int ci = q * 512 + tid; const int s = ci >> 4, v8 = (ci & 15) * 8;
            const u32x4 z = *(const u32x4*)(ZA + (size_t)(row0 + s) * 2048 + 1024 + h * 128 + v8); const float w = wg[s];
            const unsigned zz[4] = {z.x, z.y, z.z, z.w};
#pragma unroll
            for (int e = 0; e < 4; ++e) { VT[(v8 + 2 * e) * 136 + s] = f2bf(bflo(zz[e]) * w); VT[(v8 + 2 * e + 1) * 136 + s] = f2bf(bfhi(zz[e]) * w); } }
#pragma unroll
        for (int q = 0; q < 2; ++q) { const int ci = q * 512 + tid; const int s = ci >> 3, k8 = (ci & 7) * 8;
            const u32x4 z = *(const u32x4*)(QKC + (size_t)(row0 + s) * 512 + 256 + h * 64 + k8);
            const unsigned zz[4] = {z.x, z.y, z.z, z.w};
#pragma unroll
            for (int e = 0; e < 4; ++e) { KT[(k8 + 2 * e) * 136 + s] = (bf16_t)(zz[e] & 0xffff); KT[(k8 + 2 * e + 1) * 136 + s] = (bf16_t)(zz[e] >> 16); } }
        __syncthreads();
        float* dst = CLOC + ((size_t)chain * 66 + nc) * 8256;
        f32x4 acc[4];
#pragma unroll
        for (int n = 0; n < 4; ++n) acc[n] = (f32x4){0.f, 0.f, 0.f, 0.f};
#pragma unroll
        for (int ks = 0; ks < 4; ++ks) {
            const bf16x8 a = *(const bf16x8*)(VT + (16 * wid + (lane & 15)) * 136 + ks * 32 + (lane >> 4) * 8);
#pragma unroll
            for (int n = 0; n < 4; ++n) { const bf16x8 bb = *(const bf16x8*)(KT + (16 * n + (lane & 15)) * 136 + ks * 32 + (lane >> 4) * 8);
                acc[n] = __builtin_amdgcn_mfma_f32_16x16x32_bf16(a, bb, acc[n], 0, 0, 0); }
        }
#pragma unroll
        for (int n = 0; n < 4; ++n)
#pragma unroll
            for (int j = 0; j < 4; ++j) dst[(16 * wid + (lane >> 4) * 4 + j) * 64 + 16 * n + (lane & 15)] = acc[n][j];
        if (tid < 64) { float s = 0.f; for (int t = 0; t < 128; ++t) s += wg[t] * bf2f(KT[tid * 136 + t]); dst[8192 + tid] = s; }
        if (tid == 0) { MLS[chain * 66 + nc] = gtot; MLS[1056 + chain * 66 + nc] = gtot + bmax; }
        __syncthreads();
    }
}

__device__ __forceinline__ void phase_ml_carry() {
    CParams& p = KPL(); const Ctx cx = mkctx();
    float* CLOC = (float*)(p.ws + OFF_CLOC); float* MLS = (float*)(p.ws + OFF_MLS);
    for (int idx = cx.bid * 512 + cx.tid; idx < 16 * 8256; idx += cx.nb * 512) {
        const int chain = idx / 8256, e = idx % 8256; const int dir = chain >> 3;
        float* base = CLOC + (size_t)chain * 66 * 8256 + e;
        float m = -1e30f, C = 0.f;
        for (int i0 = 0; i0 < 66; i0 += 6) {
            float cl[6];
#pragma unroll
            for (int q = 0; q < 6; ++q) cl[q] = base[(size_t)ml_order(dir, i0 + q) * 8256];
#pragma unroll
            for (int q = 0; q < 6; ++q) { const int nc = ml_order(dir, i0 + q);
                const float gt = MLS[chain * 66 + nc], am = MLS[1056 + chain * 66 + nc];
                base[(size_t)nc * 8256] = C;
                if (e == 0) MLS[2112 + chain * 66 + nc] = m;
                const float mn = fmaxf(gt + m, am); const float so = expf(gt + m - mn), sl = expf(am - mn);
                C = so * C + sl * cl[q]; m = mn; }
        }
    }
}

__device__ __forceinline__ void phase_ml_out(int l, unsigned char* sm) {
    CParams& p = KPL(); const Ctx cx = mkctx();
    const int tid = cx.tid, lane = tid & 63, wid = tid >> 6;
    const bf16_t* ZA = (const bf16_t*)(p.ws + OFF_Z); const bf16_t* QKC = (const bf16_t*)(p.ws + OFF_QKC);
    const float* CLOC = (const float*)(p.ws + OFF_CLOC); const float* MLS = (const float*)(p.ws + OFF_MLS);
    bf16_t* YB = (bf16_t*)(p.ws + OFF_YB);
    bf16_t* QS = (bf16_t*)(sm + ML_QS); bf16_t* KS = (bf16_t*)(sm + ML_KS); bf16_t* VT = (bf16_t*)(sm + ML_VT); bf16_t* CS = (bf16_t*)(sm + ML_CS); bf16_t* PS = (bf16_t*)(sm + ML_PS);
    const float* gv = (const float*)(sm + ML_GV); const float* bv = (const float*)(sm + ML_BV); const float* mv = (const float*)(sm + ML_MV);
    for (int item = cx.bid; item < 528; item += cx.nb) {
        const int b = item / 264, h = (item / 66) & 3, nc = item % 66;
        const int row0 = ml_row0(b, nc);
        __syncthreads();
#pragma unroll
        for (int q = 0; q < 2; ++q) { const int ci = q * 512 + tid; const int s = ci >> 3, k8 = (ci & 7) * 8;
            const u32x4 zq = *(const u32x4*)(QKC + (size_t)(row0 + s) * 512 + h * 64 + k8);
            u32x4 o; o.x = pk2(bflo(zq.x) * 0.125f, bfhi(zq.x) * 0.125f); o.y = pk2(bflo(zq.y) * 0.125f, bfhi(zq.y) * 0.125f); o.z = pk2(bflo(zq.z) * 0.125f, bfhi(zq.z) * 0.125f); o.w = pk2(bflo(zq.w) * 0.125f, bfhi(zq.w) * 0.125f);
            *(u32x4*)(QS + s * 72 + k8) = o;
            *(u32x4*)(KS + s * 72 + k8) = *(const u32x4*)(QKC + (size_t)(row0 + s) * 512 + 256 + h * 64 + k8); }
#pragma unroll
        for (int q = 0; q < 4; ++q) { const int ci = q * 512 + tid; const int s = ci >> 4, v8 = (ci & 15) * 8;
            const u32x4 z = *(const u32x4*)(ZA + (size_t)(row0 + s) * 2048 + 1024 + h * 128 + v8);
            const unsigned zz[4] = {z.x, z.y, z.z, z.w};
#pragma unroll
            for (int e = 0; e < 4; ++e) { VT[(v8 + 2 * e) * 136 + s] = (bf16_t)(zz[e] & 0xffff); VT[(v8 + 2 * e + 1) * 136 + s] = (bf16_t)(zz[e] >> 16); } }
        f32x4 hsum[8];
#pragma unroll
        for (int v = 0; v < 8; ++v) hsum[v] = (f32x4){0.f, 0.f, 0.f, 0.f};
#pragma unroll 1
        for (int dir = 0; dir < 2; ++dir) {
            const int chain = dir * 8 + b * 4 + h;
            const float m_in = MLS[2112 + chain * 66 + nc];
            __syncthreads();
            ml_gate_vectors(cx, p, l, dir, b, h, nc, sm, m_in);
            const float* cin = CLOC + ((size_t)chain * 66 + nc) * 8256;
#pragma unroll
            for (int q = 0; q < 4; ++q) { const int ci = q * 512 + tid; const int v = ci >> 4, k4 = (ci & 15) * 4;
                const f32x4 c = *(const f32x4*)(cin + v * 64 + k4); store4bf(CS + v * 72 + k4, c); }
            if (tid < 16) { const f32x4 c = *(const f32x4*)(cin + 8192 + tid * 4); store4bf(CS + 128 * 72 + tid * 4, c); }
            else if (tid < 256) { const int r = 129 + (tid - 16) / 16, k4 = ((tid - 16) & 15) * 4; store4bf(CS + r * 72 + k4, (f32x4){0.f, 0.f, 0.f, 0.f}); }
            __syncthreads();
            const int tr = 16 * wid + (lane >> 4) * 4;
            float Mt[4], rs[4] = {0.f, 0.f, 0.f, 0.f};
#pragma unroll
            for (int j = 0; j < 4; ++j) Mt[j] = mv[tr + j];
            bf16x8 qa[2];
#pragma unroll
            for (int ks = 0; ks < 2; ++ks) qa[ks] = *(const bf16x8*)(QS + (16 * wid + (lane & 15)) * 72 + ks * 32 + (lane >> 4) * 8);
#pragma unroll
            for (int nt = 0; nt < 8; ++nt) {
                f32x4 s4 = (f32x4){0.f, 0.f, 0.f, 0.f};
#pragma unroll
                for (int ks = 0; ks < 2; ++ks) { const bf16x8 kb = *(const bf16x8*)(KS + (16 * nt + (lane & 15)) * 72 + ks * 32 + (lane >> 4) * 8);
                    s4 = __builtin_amdgcn_mfma_f32_16x16x32_bf16(qa[ks], kb, s4, 0, 0, 0); }
                const int s = 16 * nt + (lane & 15); const float bs = bv[s];
#pragma unroll
                for (int j = 0; j < 4; ++j) { const int t = tr + j; const bool valid = dir ? (s >= t) : (s <= t);
                    const float pv = valid ? s4[j] * expf(bs - Mt[j]) : 0.f; rs[j] += pv; PS[t * 136 + s] = f2bf(pv); }
            }
#pragma unroll
            for (int j = 0; j < 4; ++j) rs[j] = row16_sum(rs[j]);
            __syncthreads();
            f32x4 qn = (f32x4){0.f, 0.f, 0.f, 0.f};
#pragma unroll
            for (int ks = 0; ks < 2; ++ks) { const bf16x8 cb = *(const bf16x8*)(CS + (128 + (lane & 15)) * 72 + ks * 32 + (lane >> 4) * 8);
                qn = __builtin_amdgcn_mfma_f32_16x16x32_bf16(qa[ks], cb, qn, 0, 0, 0); }
            float wi[4], dn[4];
#pragma unroll
            for (int j = 0; j < 4; ++j) { const float qnj = row16_sum(qn[j]); wi[j] = expf(m_in - Mt[j]);
                const float den = rs[j] + wi[j] * qnj; const float mt = gv[tr + j] + Mt[j]; dn[j] = 1.f / fmaxf(fabsf(den), expf(-mt)); }
            bf16x8 pa[4];
#pragma unroll
            for (int ks = 0; ks < 4; ++ks) pa[ks] = *(const bf16x8*)(PS + (16 * wid + (lane & 15)) * 136 + ks * 32 + (lane >> 4) * 8);
#pragma unroll
            for (int vt = 0; vt < 8; ++vt) {
                f32x4 a1 = (f32x4){0.f, 0.f, 0.f, 0.f}, a2 = (f32x4){0.f, 0.f, 0.f, 0.f};
#pragma unroll
                for (int ks = 0; ks < 4; ++ks) { const bf16x8 vb = *(const bf16x8*)(VT + (16 * vt + (lane & 15)) * 136 + ks * 32 + (lane >> 4) * 8);
                    a1 = __builtin_amdgcn_mfma_f32_16x16x32_bf16(pa[ks], vb, a1, 0, 0, 0); }
#pragma unroll
                for (int ks = 0; ks < 2; ++ks) { const bf16x8 cb = *(const bf16x8*)(CS + (16 * vt + (lane & 15)) * 72 + ks * 32 + (lane >> 4) * 8);
                    a2 = __builtin_amdgcn_mfma_f32_16x16x32_bf16(qa[ks], cb, a2, 0, 0, 0); }
#pragma unroll
                for (int j = 0; j < 4; ++j) hsum[vt][j] += (a1[j] + wi[j] * a2[j]) * dn[j];
            }
        }
        const int tr = 16 * wid + (lane >> 4) * 4;
        float rinv[4];
#pragma unroll
        for (int j = 0; j < 4; ++j) { float ss = 0.f;
#pragma unroll
            for (int vt = 0; vt < 8; ++vt) ss += hsum[vt][j] * hsum[vt][j];
            ss = row16_sum(ss); rinv[j] = rsqrtf(ss * (1.f / 128.f) + 1e-6f); }
#pragma unroll
        for (int vt = 0; vt < 8; ++vt) { const int ch = h * 128 + 16 * vt + (lane & 15); const float ng = p.in[22][l * 512 + ch];
#pragma unroll
            for (int j = 0; j < 4; ++j) { const int row = row0 + tr + j;
                const float o = bf2f(ZA[(size_t)row * 2048 + 1536 + ch]);
                YB[(size_t)row * 512 + ch] = f2bf(hsum[vt][j] * rinv[j] * ng * sigmoidf_(o)); } }
    }
}

__device__ __forceinline__ void phase_rw_feat(int l) {
    CParams& p = KPL(); const Ctx cx = mkctx();
    const int lane = cx.tid & 63, gw = cx.bid * 8 + (cx.tid >> 6), nw = cx.nb * 8;
    const bf16_t* ZRW = (const bf16_t*)(p.ws + OFF_ZRW);
    bf16_t* F1 = (bf16_t*)(p.ws + OFF_F1); bf16_t* LIN = (bf16_t*)(p.ws + OFF_LORAIN);
    const float* mup = p.in[23] + (size_t)l * 1792; const float* mun = p.in[24] + (size_t)l * 1792;
    const float* kk_w = p.in[30] + l * 512;
    for (int row = gw; row < T_TOK; row += nw) {
        const int b = row >= SEQA ? 1 : 0, t = row - b * SEQA;
        const bool hasp = !(t == 0 || t == NCTX), hasn = !(t == NCTX - 1 || t == SEQA - 1);
        const bf16_t* zc = ZRW + (size_t)row * 1792;
#pragma unroll
        for (int q = 0; q < 3; ++q) {
            const int col = q * 512 + lane * 8;
            const u32x4 c4 = *(const u32x4*)(zc + col);
            u32x4 p4 = (u32x4){0u, 0u, 0u, 0u}, n4 = (u32x4){0u, 0u, 0u, 0u};
            if (hasp) p4 = *(const u32x4*)(zc - 1792 + col);
            if (hasn) n4 = *(const u32x4*)(zc + 1792 + col);
            const unsigned cc[4] = {c4.x, c4.y, c4.z, c4.w}, pp[4] = {p4.x, p4.y, p4.z, p4.w}, nn[4] = {n4.x, n4.y, n4.z, n4.w};
            float zs[8];
#pragma unroll
            for (int e = 0; e < 8; ++e) { const float z = (e & 1) ? bfhi(cc[e >> 1]) : bflo(cc[e >> 1]); const float pv = (e & 1) ? bfhi(pp[e >> 1]) : bflo(pp[e >> 1]); const float nx = (e & 1) ? bfhi(nn[e >> 1]) : bflo(nn[e >> 1]);
                zs[e] = z + mup[col + e] * (pv - z) + mun[col + e] * (nx - z); }
            u32x4 o; o.x = pk2(zs[0], zs[1]); o.y = pk2(zs[2], zs[3]); o.z = pk2(zs[4], zs[5]); o.w = pk2(zs[6], zs[7]);
            *(u32x4*)(F1 + (size_t)row * 2048 + q * 512 + lane * 8) = o;
            if (q == 1) {
                float kr[8], ssq = 0.f;
#pragma unroll
                for (int e = 0; e < 8; ++e) { kr[e] = zs[e] * kk_w[lane * 8 + e]; ssq += kr[e] * kr[e]; }
                ssq = row8_sum(ssq);
                const float inv = 1.f / fmaxf(sqrtf(ssq), 1e-12f);
                u32x4 o2; o2.x = pk2(kr[0] * inv, kr[1] * inv); o2.y = pk2(kr[2] * inv, kr[3] * inv); o2.z = pk2(kr[4] * inv, kr[5] * inv); o2.w = pk2(kr[6] * inv, kr[7] * inv);
                *(u32x4*)(F1 + (size_t)row * 2048 + 1536 + lane * 8) = o2;
            }
        }
        {
            const int col = 1536 + lane * 4;
            const u32x2 c2 = *(const u32x2*)(zc + col);
            u32x2 p2 = (u32x2){0u, 0u}, n2 = (u32x2){0u, 0u};
            if (hasp) p2 = *(const u32x2*)(zc - 1792 + col);
            if (hasn) n2 = *(const u32x2*)(zc + 1792 + col);
            const unsigned cc[2] = {c2.x, c2.y}, pp[2] = {p2.x, p2.y}, nn[2] = {n2.x, n2.y};
            float zs[4];
#pragma unroll
            for (int e = 0; e < 4; ++e) { const float z = (e & 1) ? bfhi(cc[e >> 1]) : bflo(cc[e >> 1]); const float pv = (e & 1) ? bfhi(pp[e >> 1]) : bflo(pp[e >> 1]); const float nx = (e & 1) ? bfhi(nn[e >> 1]) : bflo(nn[e >> 1]);
                const float s = z + mup[col + e] * (pv - z) + mun[col + e] * (nx - z);
                zs[e] = lane < 16 ? tanhf(s) : (lane < 32 ? s : sigmoidf_(s)); }
            u32x2 o; o.x = pk2(zs[0], zs[1]); o.y = pk2(zs[2], zs[3]);
            *(u32x2*)(LIN + (size_t)row * 256 + lane * 4) = o;
        }
    }
}

__device__ __forceinline__ int rw_tok(int dir, int i) { return dir == 0 ? i : (i < NCTX ? NCTX - 1 - i : 8703 - i); }

__device__ __forceinline__ void phase_rw_scan(int l) {
    CParams& p = KPL(); const Ctx cx = mkctx();
    const int lane = cx.tid & 63, wid = cx.tid >> 6;
    const bf16_t* F1 = (const bf16_t*)(p.ws + OFF_F1); const bf16_t* F2 = (const bf16_t*)(p.ws + OFF_Z);
    bf16_t* YRAW = (bf16_t*)(p.ws + OFF_H);
    for (int item = cx.bid; item < 256; item += cx.nb) {
        const int chain = item >> 3, rg = item & 7; const int dir = chain >> 4, b = (chain >> 3) & 1, h = chain & 7;
        const int vrow = rg * 8 + wid;
        const float ka = p.in[31][l * 512 + h * 64 + lane];
        const bf16_t* f1 = F1 + (size_t)b * SEQA * 2048 + h * 64; const bf16_t* f2 = F2 + (size_t)b * SEQA * 2048 + dir * 512 + h * 64;
        bf16_t* yr = YRAW + ((size_t)dir * T_TOK + (size_t)b * SEQA) * 512 + h * 64 + vrow;
        float S = 0.f;
        bf16_t cur[8][6], nxt[8][6];
#pragma unroll
        for (int j = 0; j < 8; ++j) { const size_t t = (size_t)rw_tok(dir, j);
            cur[j][0] = f1[t * 2048 + lane]; cur[j][1] = f1[t * 2048 + 512 + lane]; cur[j][2] = f1[t * 2048 + 1024 + vrow]; cur[j][3] = f1[t * 2048 + 1536 + lane];
            cur[j][4] = f2[t * 2048 + lane]; cur[j][5] = f2[t * 2048 + 1024 + lane]; }
        for (int g0 = 0; g0 < SEQA; g0 += 8) {
            const int gn = (g0 + 8 < SEQA) ? g0 + 8 : g0;
#pragma unroll
            for (int j = 0; j < 8; ++j) { const size_t t = (size_t)rw_tok(dir, gn + j);
                nxt[j][0] = f1[t * 2048 + lane]; nxt[j][1] = f1[t * 2048 + 512 + lane]; nxt[j][2] = f1[t * 2048 + 1024 + vrow]; nxt[j][3] = f1[t * 2048 + 1536 + lane];
                nxt[j][4] = f2[t * 2048 + lane]; nxt[j][5] = f2[t * 2048 + 1024 + lane]; }
            float ybuf = 0.f;
#pragma unroll
            for (int j = 0; j < 8; ++j) {
                const float r = bf2f(cur[j][0]), k = bf2f(cur[j][1]), v = bf2f(cur[j][2]), kk = bf2f(cur[j][3]), u = bf2f(cur[j][4]), a = bf2f(cur[j][5]);
                const float w = 1.f - u, key = k * (1.f + (a - 1.f) * ka), kka = kk * a;
                const float sk = wave_sum(S * kk);
                S = S * w + (v * key - sk * kka);
                const float y = wave_sum(S * r);
                if (lane == j) ybuf = y;
            }
            if (lane < 8) yr[(size_t)rw_tok(dir, g0 + lane) * 512] = f2bf(ybuf);
#pragma unroll
            for (int j = 0; j < 8; ++j)
#pragma unroll
                for (int q = 0; q < 6; ++q) cur[j][q] = nxt[j][q];
        }
    }
}

__device__ __forceinline__ void phase_rw_out(int l) {
    CParams& p = KPL(); const Ctx cx = mkctx();
    const int lane = cx.tid & 63, gw = cx.bid * 8 + (cx.tid >> 6), nw = cx.nb * 8;
    const bf16_t* F1 = (const bf16_t*)(p.ws + OFF_F1); const bf16_t* F2 = (const bf16_t*)(p.ws + OFF_Z); const bf16_t* GRW = (const bf16_t*)(p.ws + OFF_ZRW);
    const bf16_t* YRAW = (const bf16_t*)(p.ws + OFF_H);
    bf16_t* YC = (bf16_t*)(p.ws + OFF_YC);
    const int c0 = lane * 8;
    float ka[8], rk[8], lg[8], lb[8];
#pragma unroll
    for (int e = 0; e < 8; ++e) { ka[e] = p.in[31][l * 512 + c0 + e]; rk[e] = p.in[32][l * 512 + c0 + e]; lg[e] = p.in[33][l * 512 + c0 + e]; lb[e] = p.in[34][l * 512 + c0 + e]; }
    for (int row = gw; row < T_TOK; row += nw) {
        const u32x4 y0 = *(const u32x4*)(YRAW + (size_t)row * 512 + c0), y1 = *(const u32x4*)(YRAW + ((size_t)T_TOK + row) * 512 + c0);
        const u32x4 r4 = *(const u32x4*)(F1 + (size_t)row * 2048 + c0), k4 = *(const u32x4*)(F1 + (size_t)row * 2048 + 512 + c0), v4 = *(const u32x4*)(F1 + (size_t)row * 2048 + 1024 + c0);
        const u32x4 a04 = *(const u32x4*)(F2 + (size_t)row * 2048 + 1024 + c0), a14 = *(const u32x4*)(F2 + (size_t)row * 2048 + 1536 + c0);
        const u32x4 g4 = *(const u32x4*)(GRW + (size_t)row * 512 + c0);
        const unsigned ya[4] = {y0.x, y0.y, y0.z, y0.w}, yb[4] = {y1.x, y1.y, y1.z, y1.w}, rr[4] = {r4.x, r4.y, r4.z, r4.w}, kx[4] = {k4.x, k4.y, k4.z, k4.w}, vv[4] = {v4.x, v4.y, v4.z, v4.w};
        const unsigned aa[4] = {a04.x, a04.y, a04.z, a04.w}, ab[4] = {a14.x, a14.y, a14.z, a14.w}, gg[4] = {g4.x, g4.y, g4.z, g4.w};
        float y[8], sum = 0.f, bs = 0.f;
#pragma unroll
        for (int e = 0; e < 8; ++e) {
            const int w = e >> 1; const bool hi = e & 1;
            y[e] = (hi ? bfhi(ya[w]) : bflo(ya[w])) + (hi ? bfhi(yb[w]) : bflo(yb[w])); sum += y[e];
            const float r = hi ? bfhi(rr[w]) : bflo(rr[w]), k = hi ? bfhi(kx[w]) : bflo(kx[w]), a0 = hi ? bfhi(aa[w]) : bflo(aa[w]), a1 = hi ? bfhi(ab[w]) : bflo(ab[w]);
            bs += r * k * (2.f + (a0 + a1 - 2.f) * ka[e]) * rk[e];
        }
        sum = row8_sum(sum); bs = row8_sum(bs);
        const float mu = sum * (1.f / 64.f);
        float var = 0.f;
#pragma unroll
        for (int e = 0; e < 8; ++e) { const float d = y[e] - mu; var += d * d; }
        var = row8_sum(var) * (1.f / 64.f);
        const float rstd = rsqrtf(var + 64e-5f);
        float o[8];
#pragma unroll
        for (int e = 0; e < 8; ++e) { const int w = e >> 1; const bool hi = e & 1;
            const float v = hi ? bfhi(vv[w]) : bflo(vv[w]), g = hi ? bfhi(gg[w]) : bflo(gg[w]);
            o[e] = ((y[e] - mu) * rstd * lg[e] + lb[e] + bs * v) * g; }
        u32x4 o4; o4.x = pk2(o[0], o[1]); o4.y = pk2(o[2], o[3]); o4.z = pk2(o[4], o[5]); o4.w = pk2(o[6], o[7]);
        *(u32x4*)(YC + (size_t)row * 512 + c0) = o4;
    }
}

__device__ __forceinline__ void phase_final() {
    CParams& p = KPL(); const Ctx cx = mkctx();
    const int lane = cx.tid & 63, gw = cx.bid * 8 + (cx.tid >> 6), nw = cx.nb * 8;
    const float* X = (const float*)(p.ws + OFF_X);
    for (int r = gw; r < 2 * 8192; r += nw) {
        const int b = r >> 13, t = r & 8191;
        const float* src = X + ((size_t)b * SEQA + NCTX + t) * 1024;
        f32x4 v[4]; float ss = 0.f;
#pragma unroll
        for (int i = 0; i < 4; ++i) { v[i] = *(const f32x4*)(src + (lane + 64 * i) * 4); ss += v[i][0] * v[i][0] + v[i][1] * v[i][1] + v[i][2] * v[i][2] + v[i][3] * v[i][3]; }
        ss = wave_sum(ss);
        const float inv = rsqrtf(ss * (1.f / 1024.f) + 1e-6f);
#pragma unroll
        for (int i = 0; i < 4; ++i) { const int c = (lane + 64 * i) * 4; const f32x4 g4 = *(const f32x4*)(p.in[41] + c);
            *(f32x4*)(p.out + (size_t)r * 1024 + c) = v[i] * inv * g4; }
    }
}

#ifndef PHM
#define PHM 0xFFFFFFFFull
#endif
template <int WHICH>
__device__ __forceinline__ void gemm_stage(int l, LAS unsigned char* lds) {
    CParams& p = KPL(); const Ctx cx = mkctx();
    unsigned char* ws = p.ws;
    float* X = (float*)(ws + OFF_X); bf16_t* H = (bf16_t*)(ws + OFF_H); bf16_t* ZA = (bf16_t*)(ws + OFF_Z); bf16_t* ZRW = (bf16_t*)(ws + OFF_ZRW);
    bf16_t* W = (bf16_t*)(ws + OFF_W);
    const float* MODL = (const float*)(ws + OFF_MOD) + (size_t)l * 3 * 6144;
    if constexpr (WHICH == 0) run_gemm(cx, lds, H, W + W_MIX / 2, 4096, 1024, FInproj{ZA, (float*)(ws + OFF_MLG), ZRW});
    else if constexpr (WHICH == 1) run_gemm(cx, lds, (const bf16_t*)(ws + OFF_ZG), W + W_GLU / 2, 512, 512, FGlu{(const bf16_t*)(ws + OFF_ZG), p.in[18] + l * 512, (bf16_t*)(ws + OFF_YA)});
    else if constexpr (WHICH == 2) run_gemm_epi(cx, lds, (const bf16_t*)(ws + OFF_LORAIN), W + W_LORA / 2, 2560, 256, EpiLora{p.in[25] + l * 1024, p.in[27] + l * 1024, ZA, ZRW});
    else if constexpr (WHICH == 3) run_gemm(cx, lds, H, W + W_GATE / 2, 3072, 1024, FGate{ZA});
    else if constexpr (WHICH == 4) run_gemm(cx, lds, (const bf16_t*)(ws + OFF_YA), W + W_PA / 2, 1024, 512, FMerge<0>{ZA, (float*)(ws + OFF_F1), H});
    else if constexpr (WHICH == 5) run_gemm(cx, lds, (const bf16_t*)(ws + OFF_YB), W + W_PB / 2, 1024, 512, FMerge<1>{ZA, (float*)(ws + OFF_F1), H});
    else if constexpr (WHICH == 6) run_gemm(cx, lds, (const bf16_t*)(ws + OFF_YC), W + W_PC / 2, 1024, 512, FMerge<2>{ZA, (float*)(ws + OFF_F1), H});
    else if constexpr (WHICH == 7) run_gemm(cx, lds, H, W + W_OUT / 2, 1024, 1024, FResid{X, MODL, 2});
    else if constexpr (WHICH == 8) run_gemm(cx, lds, H, W + W_1 / 2, 4096, 1024, FMlp1{ZA});
    else run_gemm(cx, lds, ZA, W + W_2 / 2, 1024, 4096, FResid{X, MODL, 5});
}

template <int l>
__device__ __forceinline__ void run_layer(cg::grid_group& grid, LAS unsigned char* lds, float* smf, unsigned char* smem) {
        if constexpr ((PHM >> 1) & 1) { phase_wconv(l, smf); }
        grid.sync();
        if constexpr ((PHM >> 2) & 1) { phase_norm(l, 0, l == 0); }
        grid.sync();
        if constexpr ((PHM >> 3) & 1) { gemm_stage<0>(l, lds); }
        grid.sync();
        if constexpr ((PHM >> 4) & 1) { phase_s5_local(l); }
        if constexpr ((PHM >> 5) & 1) { phase_ml_conv(l); }
        grid.sync();
        if constexpr ((PHM >> 6) & 1) { phase_s5_carry(l); }
        if constexpr ((PHM >> 7) & 1) { phase_ml_local(l, smem); }
        grid.sync();
        if constexpr ((PHM >> 8) & 1) { phase_s5_final(l, smf); }
        if constexpr ((PHM >> 9) & 1) { phase_ml_carry(); }
        grid.sync();
        if constexpr ((PHM >> 10) & 1) { gemm_stage<1>(l, lds); }
        if constexpr ((PHM >> 11) & 1) { phase_ml_out(l, smem); }
        grid.sync();
        if constexpr ((PHM >> 12) & 1) { phase_rw_feat(l); }
        grid.sync();
        if constexpr ((PHM >> 13) & 1) { gemm_stage<2>(l, lds); }
        grid.sync();
        if constexpr ((PHM >> 14) & 1) { phase_rw_scan(l); }
        grid.sync();
        if constexpr ((PHM >> 15) & 1) { phase_rw_out(l); }
        grid.sync();
        if constexpr ((PHM >> 16) & 1) { phase_norm(l, 0, false); }
        grid.sync();
        if constexpr ((PHM >> 17) & 1) { gemm_stage<3>(l, lds); }
        grid.sync();
        if constexpr ((PHM >> 18) & 1) { gemm_stage<4>(l, lds); }
        grid.sync();
        if constexpr ((PHM >> 19) & 1) { gemm_stage<5>(l, lds); }
        grid.sync();
        if constexpr ((PHM >> 20) & 1) { gemm_stage<6>(l, lds); }
        grid.sync();
        if constexpr ((PHM >> 21) & 1) { gemm_stage<7>(l, lds); }
        grid.sync();
        if constexpr ((PHM >> 22) & 1) { phase_norm(l, 1, false); }
        grid.sync();
        if constexpr ((PHM >> 23) & 1) { gemm_stage<8>(l, lds); }
        grid.sync();
        if constexpr ((PHM >> 24) & 1) { gemm_stage<9>(l, lds); }
        grid.sync();
    }

__global__ void __launch_bounds__(512, 2) fwd_megakernel(Params p_unused) {
    extern __shared__ __attribute__((aligned(16))) unsigned char smem[];
    cg::grid_group grid = cg::this_grid();
    LAS unsigned char* lds = (LAS unsigned char*)smem;
    float* smf = (float*)smem;

    if constexpr ((PHM >> 0) & 1) { phase_mod(smf); phase_s5_params(); }
    run_layer<0>(grid, lds, smf, smem);
    run_layer<1>(grid, lds, smf, smem);
    run_layer<2>(grid, lds, smf, smem);
    run_layer<3>(grid, lds, smf, smem);
    phase_final();
}

extern "C" void kernel_launch(void* const* d_in, const int* in_sizes, int n_in, void* d_out, int out_size, void* d_ws, size_t ws_size, hipStream_t stream) {
    static int grid_blocks = 0;
    if (grid_blocks == 0) {
        if (n_in != 42 || ws_size < WS_END) { fprintf(stderr, "kernel_launch: unexpected n_in %d / ws_size %zu\n", n_in, ws_size); grid_blocks = -1; return; }
        int dev = 0, cus = 0, per_cu = 0;
        (void)hipGetDevice(&dev);
        (void)hipDeviceGetAttribute(&cus, hipDeviceAttributeMultiprocessorCount, dev);
        if (hipFuncSetAttribute((const void*)fwd_megakernel, hipFuncAttributeMaxDynamicSharedMemorySize, LDS_BYTES) != hipSuccess) { fprintf(stderr, "kernel_launch: hipFuncSetAttribute failed\n"); grid_blocks = -1; return; }
        if (hipOccupancyMaxActiveBlocksPerMultiprocessor(&per_cu, (const void*)fwd_megakernel, 512, LDS_BYTES) != hipSuccess || per_cu < 1) { fprintf(stderr, "kernel_launch: occupancy query says %d\n", per_cu); per_cu = 1; (void)hipGetLastError(); }
        grid_blocks = cus * 1;
    }
    if (grid_blocks < 0) return;
    Params p{};
    for (int i = 0; i < 42; ++i) p.in[i] = (const float*)d_in[i];
    p.out = (float*)d_out; p.ws = (unsigned char*)d_ws;
    void* args[] = {&p};
    hipError_t e = hipLaunchCooperativeKernel((const void*)fwd_megakernel, dim3(grid_blocks), dim3(512), args, LDS_BYTES, stream);
    if (e != hipSuccess) fprintf(stderr, "cooperative launch failed: %s (grid %d)\n", hipGetErrorString(e), grid_blocks);
}
```

```cpp
#include <hip/hip_runtime.h>
#include <hip/hip_cooperative_groups.h>
#include <cstdio>
namespace cg = cooperative_groups;

#define LAS __attribute__((address_space(3)))
typedef unsigned short bf16_t;
typedef short bf16x8 __attribute__((ext_vector_type(8)));
typedef float f32x4 __attribute__((ext_vector_type(4)));
typedef unsigned u32x4 __attribute__((ext_vector_type(4)));
typedef unsigned u32x2 __attribute__((ext_vector_type(2)));

constexpr int T_TOK = 16896, SEQA = 8448, NCTX = 256;
constexpr int NLAYER = 4;
constexpr int LDS_BYTES = 143360;
constexpr size_t OFF_X = 0;
constexpr size_t OFF_H = 69206016;
constexpr size_t OFF_Z = 103809024;
constexpr size_t OFF_ZRW = OFF_Z + 69206016;
constexpr size_t OFF_MLG = 242221056;
constexpr size_t OFF_W = 243302400;
constexpr size_t OFF_YA = 281837568;
constexpr size_t OFF_YB = 299139072;
constexpr size_t OFF_YC = 316440576;
constexpr size_t OFF_F1 = 333742080;
constexpr size_t OFF_MOD = 402948096;
constexpr size_t OFF_S5P = 403243008;
constexpr size_t OFF_MLS = OFF_S5P + 4 * 589824;
constexpr size_t WS_END = OFF_MLS + 16384;
constexpr size_t OFF_CLOC = OFF_F1;
constexpr size_t OFF_S5ST = OFF_F1 + 34873344;
constexpr size_t OFF_QKC = OFF_F1 + 43524096;
constexpr size_t OFF_ZG = OFF_H;
constexpr size_t OFF_LORAIN = OFF_H + 17301504;
constexpr size_t W_MIX = 0, W_GATE = 8388608, W_GLU = 14680064, W_LORA = 15204352, W_PA = 16515072, W_PB = 17563648, W_PC = 18612224, W_OUT = 19660800, W_1 = 21757952, W_2 = 30146560;

struct Params {
    const float* in[42];
    float* out;
    unsigned char* ws;
};

typedef const __attribute__((address_space(4))) Params CParams;
__device__ __forceinline__ CParams& KPL() {
    unsigned long long a = (unsigned long long)__builtin_amdgcn_kernarg_segment_ptr();
    asm volatile("" : "+s"(a));
    return *(CParams*)a;
}
struct Ctx { int tid, bid, nb; };
__device__ __forceinline__ Ctx mkctx() { Ctx c; c.tid = threadIdx.x; c.bid = blockIdx.x; c.nb = gridDim.x; asm volatile("" : "+v"(c.tid), "+s"(c.bid), "+s"(c.nb)); return c; }
__device__ __forceinline__ float bf2f(unsigned v) { return __uint_as_float(v << 16); }
__device__ __forceinline__ float bflo(unsigned w) { return __uint_as_float(w << 16); }
__device__ __forceinline__ float bfhi(unsigned w) { return __uint_as_float(w & 0xffff0000u); }
__device__ __forceinline__ bf16_t f2bf(float f) { unsigned u = __float_as_uint(f); u += 0x7FFFu + ((u >> 16) & 1u); return (bf16_t)(u >> 16); }
__device__ __forceinline__ unsigned pk2(float lo, float hi) { return (unsigned)f2bf(lo) | ((unsigned)f2bf(hi) << 16); }
__device__ __forceinline__ void store4bf(bf16_t* p, f32x4 v) { u32x2 r; r.x = pk2(v[0], v[1]); r.y = pk2(v[2], v[3]); *(u32x2*)p = r; }
__device__ __forceinline__ float sigmoidf_(float x) { return 1.f / (1.f + __expf(-x)); }

#define DPP_F(x, ctrl, rmask) __int_as_float(__builtin_amdgcn_update_dpp(0, __float_as_int(x), ctrl, rmask, 0xF, false))
__device__ __forceinline__ float row8_sum(float x) {
    x += DPP_F(x, 0xB1, 0xF); x += DPP_F(x, 0x4E, 0xF); x += DPP_F(x, 0x141, 0xF); return x;
}
__device__ __forceinline__ float row16_sum(float x) {
    x += DPP_F(x, 0xB1, 0xF); x += DPP_F(x, 0x4E, 0xF); x += DPP_F(x, 0x141, 0xF); x += DPP_F(x, 0x140, 0xF); return x;
}
__device__ __forceinline__ float wave_sum(float x) {
    x = row16_sum(x);
    x += DPP_F(x, 0x142, 0xA);
    x += DPP_F(x, 0x143, 0xC);
    return __int_as_float(__builtin_amdgcn_readlane(__float_as_int(x), 63));
}

namespace pg8 {
constexpr int BM = 256, BK = 64, HALF = 128, HTB = HALF * BK * 2, NXCD = 8, WGM = 8;
__device__ __forceinline__ int lds_byte(int r, int c) { const int st = (r >> 4) * 2 + (c >> 5), rr = r & 15, cc = c & 31, ob = rr * 64 + cc * 2; return st * 1024 + (ob ^ (((ob >> 9) & 1) << 5)); }
__device__ __forceinline__ void stage_rc(int b, int& R, int& C) { const int st = b / 1024, sb = b % 1024, swz = sb ^ (((sb >> 9) & 1) << 5); R = (st >> 1) * 16 + swz / 64; C = (st & 1) * 32 + (swz % 64) / 2; }
struct Unit { int pm, pn; };
struct Gemm { const bf16_t* A; const bf16_t* Bt; int M, N, K; };
struct StaticOrder {
    int nM, nN, nwg, G, c;
    __device__ void init(int M, int N, int G_, int c_) { nM = M / BM; nN = N / BM; nwg = nM * nN; G = G_; c = c_; }
    __device__ bool next(int i, Unit& u) const {
        const long L = (long)i * G + c; if (L >= nwg) return false;
        int wgid = (int)L; { const int q = nwg / NXCD, r = nwg % NXCD, xcd = wgid % NXCD, off = wgid / NXCD; wgid = (xcd < r ? xcd * (q + 1) : r * (q + 1) + (xcd - r) * q) + off; }
        const int nig = WGM * nN, gid = wgid / nig, fm = gid * WGM, gsz = (nM - fm) < WGM ? (nM - fm) : WGM;
        u.pm = fm + ((wgid % nig) % gsz); u.pn = (wgid % nig) / gsz; return true;
    }
};

template <class Epi>
__device__ __forceinline__ void gemm_phase(int tid_in, LAS unsigned char* lds, const Gemm g, const StaticOrder& S, const Epi& E) {
    const int tid = tid_in, wid = __builtin_amdgcn_readfirstlane(tid >> 6), lane = tid & 63, wr = wid >> 2, wc = wid & 3, fr = lane & 15, fq = lane >> 4;
    const int K = g.K, nt = K / BK;
    unsigned voffA[2], voffB[2];
#pragma unroll
    for (int i = 0; i < 2; ++i) { int R, C; stage_rc(tid * 16 + i * 8192, R, C); voffA[i] = (unsigned)(R * K + C) * 2u; voffB[i] = voffA[i]; }
    const size_t kstep = (size_t)(BK * 2);
    const size_t hstep = (size_t)HALF * K * 2;
    const size_t tstep = 2 * hstep;
    const unsigned ldsw = (unsigned)wid * 1024u;
    const int aoff = lds_byte(wr * 64 + fr, fq * 8), boff = lds_byte(wc * 32 + fr, fq * 8);
#define PG8_SA(b, h) (((b) * 2 + (h)) * HTB)
#define PG8_SB(b, h) ((4 + (b) * 2 + (h)) * HTB)
#define PG8_STAGE(bufoff, gbase, voff) do { _Pragma("unroll") for (int _i = 0; _i < 2; ++_i) \
        __builtin_amdgcn_global_load_lds((const unsigned*)((const char*)(gbase) + (voff)[_i]), (LAS unsigned*)(lds + (bufoff) + ldsw + _i * 8192), 16, 0, 0); } while (0)
#define PG8_LDA(dst, b, h) do { _Pragma("unroll") for (int m = 0; m < 4; ++m) _Pragma("unroll") for (int k = 0; k < 2; ++k) dst[m][k] = *(const LAS bf16x8*)(lds + PG8_SA(b, h) + aoff + m * 2048 + k * 1024); } while (0)
#define PG8_LDB(dst, b, h) do { _Pragma("unroll") for (int n = 0; n < 2; ++n) _Pragma("unroll") for (int k = 0; k < 2; ++k) dst[n][k] = *(const LAS bf16x8*)(lds + PG8_SB(b, h) + boff + n * 2048 + k * 1024); } while (0)
#define PG8_MMA(ai, bj, At, Bt) do { __builtin_amdgcn_s_setprio(1); _Pragma("unroll") for (int m = 0; m < 4; ++m) _Pragma("unroll") for (int n = 0; n < 2; ++n) _Pragma("unroll") for (int k = 0; k < 2; ++k) \
        acc[ai][bj][m][n] = __builtin_amdgcn_mfma_f32_16x16x32_bf16(Bt[n][k], At[m][k], acc[ai][bj][m][n], 0, 0, 0); __builtin_amdgcn_s_setprio(0); } while (0)
#define PG8_WAIT_V(n) asm volatile("s_waitcnt vmcnt(" #n ")" ::: "memory")
#define PG8_WAIT_L(n) asm volatile("s_waitcnt lgkmcnt(" #n ")" ::: "memory")
#define PG8_BAR __builtin_amdgcn_s_barrier()
#define PG8_SCHED __builtin_amdgcn_sched_barrier(0)
    Unit cur, nxt; int ui = 0;
    if (!S.next(0, cur)) return;
    f32x4 acc[2][2][4][2];
#pragma unroll
    for (int a = 0; a < 2; ++a)
#pragma unroll
        for (int b = 0; b < 2; ++b)
#pragma unroll
            for (int m = 0; m < 4; ++m)
#pragma unroll
                for (int n = 0; n < 2; ++n) acc[a][b][m][n] = (f32x4){0.f, 0.f, 0.f, 0.f};
    bf16x8 At[4][2], B0[2][2], B1[2][2];
    const char* cA = (const char*)g.A + (size_t)cur.pm * tstep; const char* cB = (const char*)g.Bt + (size_t)cur.pn * tstep;
    PG8_STAGE(PG8_SB(0, 0), cB, voffB); PG8_STAGE(PG8_SA(0, 0), cA, voffA); PG8_STAGE(PG8_SB(0, 1), cB + hstep, voffB); PG8_STAGE(PG8_SA(0, 1), cA + hstep, voffA);
    if (wr == 1) PG8_BAR;
    PG8_WAIT_V(4); PG8_BAR;
    PG8_STAGE(PG8_SB(1, 0), cB + kstep, voffB); PG8_STAGE(PG8_SA(1, 0), cA + kstep, voffA); PG8_STAGE(PG8_SB(1, 1), cB + hstep + kstep, voffB);
    PG8_WAIT_V(6); PG8_BAR;
    for (;;) {
        const bool has_next = S.next(ui + 1, nxt);
        const char* nA = has_next ? (const char*)g.A + (size_t)nxt.pm * tstep : cA; const char* nB = has_next ? (const char*)g.Bt + (size_t)nxt.pn * tstep : cB;
        for (int t = 0; t < nt; t += 2) {
            const bool last = (t == nt - 2);
            const char* a1 = cA + (size_t)(t + 1) * kstep;
            const char* a2 = last ? nA : cA + (size_t)(t + 2) * kstep; const char* b2 = last ? nB : cB + (size_t)(t + 2) * kstep;
            const char* a3 = a2 + kstep; const char* b3 = b2 + kstep;
            PG8_LDB(B0, 0, 0); PG8_SCHED; PG8_LDA(At, 0, 0); PG8_STAGE(PG8_SA(1, 1), a1 + hstep, voffA);
            PG8_WAIT_L(8); PG8_BAR; PG8_WAIT_L(0); PG8_MMA(0, 0, At, B0); PG8_BAR; PG8_SCHED;
            PG8_LDB(B1, 0, 1); PG8_STAGE(PG8_SB(0, 0), b2, voffB);
            PG8_BAR; PG8_WAIT_L(0); PG8_MMA(0, 1, At, B1); PG8_BAR;
            PG8_LDA(At, 0, 1); PG8_STAGE(PG8_SA(0, 0), a2, voffA);
            PG8_BAR; PG8_WAIT_L(0); PG8_MMA(1, 0, At, B0); PG8_BAR; PG8_SCHED;
            PG8_STAGE(PG8_SB(0, 1), b2 + hstep, voffB);
            PG8_WAIT_V(6); PG8_BAR; PG8_MMA(1, 1, At, B1); PG8_BAR;
            PG8_LDB(B0, 1, 0); PG8_SCHED; PG8_LDA(At, 1, 0); PG8_STAGE(PG8_SA(0, 1), a2 + hstep, voffA);
            PG8_WAIT_L(8); PG8_BAR; PG8_WAIT_L(0); PG8_MMA(0, 0, At, B0); PG8_BAR; PG8_SCHED;
            PG8_LDB(B1, 1, 1); PG8_STAGE(PG8_SB(1, 0), b3, voffB);
            PG8_BAR; PG8_WAIT_L(0); PG8_MMA(0, 1, At, B1); PG8_BAR;
            PG8_LDA(At, 1, 1); PG8_STAGE(PG8_SA(1, 0), a3, voffA);
            PG8_BAR; PG8_WAIT_L(0); PG8_MMA(1, 0, At, B0); PG8_BAR; PG8_SCHED;
            PG8_STAGE(PG8_SB(1, 1), b3 + hstep, voffB);
            PG8_WAIT_V(6); PG8_BAR; PG8_MMA(1, 1, At, B1); PG8_BAR;
        }
        E(acc, cur, wr, wc, fr, fq);
        if (!has_next) break;
#pragma unroll
        for (int a = 0; a < 2; ++a)
#pragma unroll
            for (int b = 0; b < 2; ++b)
#pragma unroll
                for (int m = 0; m < 4; ++m)
#pragma unroll
                    for (int n = 0; n < 2; ++n) acc[a][b][m][n] = (f32x4){0.f, 0.f, 0.f, 0.f};
        cur = nxt; cA = nA; cB = nB; ++ui;
    }
    PG8_WAIT_V(0);
    if (wr == 0) PG8_BAR;
    PG8_BAR;
#undef PG8_SA
#undef PG8_SB
#undef PG8_STAGE
#undef PG8_LDA
#undef PG8_LDB
#undef PG8_MMA
#undef PG8_WAIT_V
#undef PG8_WAIT_L
#undef PG8_BAR
#undef PG8_SCHED
}

template <class F> struct EpiT {
    F f;
    __device__ __forceinline__ void operator()(const f32x4 (&acc)[2][2][4][2], const Unit& u, int wr, int wc, int fr, int fq) const {
        const int row0 = u.pm * BM + wr * 64 + fr, col0 = u.pn * BM + wc * 32 + 4 * fq;
#pragma unroll
        for (int ai = 0; ai < 2; ++ai)
#pragma unroll
            for (int m = 0; m < 4; ++m) {
                const int row = row0 + ai * HALF + m * 16;
#pragma unroll
                for (int bj = 0; bj < 2; ++bj)
#pragma unroll
                    for (int n = 0; n < 2; ++n) f(row, col0 + bj * HALF + n * 16, acc[ai][bj][m][n]);
            }
    }
};
}

template <class F>
__device__ __forceinline__ void run_gemm(const Ctx& cx, LAS unsigned char* lds, const bf16_t* A, const bf16_t* Bt, int N, int K, const F& f) {
    pg8::Gemm g; g.A = A; g.Bt = Bt; g.M = T_TOK; g.N = N; g.K = K;
    pg8::StaticOrder S; S.init(T_TOK, N, cx.nb, cx.bid);
    pg8::EpiT<F> E{f};
    pg8::gemm_phase(cx.tid, lds, g, S, E);
}

template <class E>
__device__ __forceinline__ void run_gemm_epi(const Ctx& cx, LAS unsigned char* lds, const bf16_t* A, const bf16_t* Bt, int N, int K, const E& e) {
    pg8::Gemm g; g.A = A; g.Bt = Bt; g.M = T_TOK; g.N = N; g.K = K;
    pg8::StaticOrder S; S.init(T_TOK, N, cx.nb, cx.bid);
    pg8::gemm_phase(cx.tid, lds, g, S, e);
}
__device__ __forceinline__ int row_vec(int row) { const int b = row >= SEQA ? 1 : 0; const int t = row - b * SEQA; return t < NCTX ? 2 : b; }

struct FInproj { bf16_t* za; float* mlg; bf16_t* zrw;
    __device__ __forceinline__ void operator()(int row, int col, f32x4 v) const {
        if (col < 2048) store4bf(za + (size_t)row * 2048 + col, v);
        else if (col < 2064) *(f32x4*)(mlg + (size_t)row * 16 + (col - 2048)) = v;
        else if (col < 3856) store4bf(zrw + (size_t)row * 1792 + (col - 2064), v);
    } };
struct FGlu { const bf16_t* zg; const float* bglu; bf16_t* ya;
    __device__ __forceinline__ void operator()(int row, int col, f32x4 v) const {
        const u32x2 z = *(const u32x2*)(zg + (size_t)row * 512 + col); const f32x4 b = *(const f32x4*)(bglu + col);
        f32x4 o; o[0] = bflo(z.x) * sigmoidf_(v[0] + b[0]); o[1] = bfhi(z.x) * sigmoidf_(v[1] + b[1]); o[2] = bflo(z.y) * sigmoidf_(v[2] + b[2]); o[3] = bfhi(z.y) * sigmoidf_(v[3] + b[3]);
        store4bf(ya + (size_t)row * 512 + col, o);
    } };
struct EpiLora { const float* w0; const float* a0; bf16_t* f2; bf16_t* grw;
    __device__ __forceinline__ void operator()(const f32x4 (&acc)[2][2][4][2], const pg8::Unit& u, int wr, int wc, int fr, int fq) const {
        const int row0 = u.pm * 256 + wr * 64 + fr, col0 = u.pn * 256 + wc * 32 + 4 * fq;
        const int pn = __builtin_amdgcn_readfirstlane(u.pn);
        if (pn < 8) {
            const float* bias = pn < 4 ? w0 : a0 - 1024;
#pragma unroll
            for (int bj = 0; bj < 2; ++bj)
#pragma unroll
                for (int n = 0; n < 2; ++n) {
                    const int col = col0 + bj * 128 + n * 16;
                    const f32x4 b = *(const f32x4*)(bias + col);
#pragma unroll
                    for (int ai = 0; ai < 2; ++ai)
#pragma unroll
                        for (int m = 0; m < 4; ++m) {
                            const int row = row0 + ai * 128 + m * 16; f32x4 o;
#pragma unroll
                            for (int e = 0; e < 4; ++e) { const float s = sigmoidf_(acc[ai][bj][m][n][e] + b[e]); o[e] = pn < 4 ? 1.f - __expf(-0.60653065971f * s) : s; }
                            store4bf(f2 + (size_t)row * 2048 + col, o);
                        }
                }
        } else {
#pragma unroll
            for (int ai = 0; ai < 2; ++ai)
#pragma unroll
                for (int m = 0; m < 4; ++m) { const int row = row0 + ai * 128 + m * 16;
#pragma unroll
                    for (int bj = 0; bj < 2; ++bj)
#pragma unroll
                        for (int n = 0; n < 2; ++n) store4bf(grw + (size_t)row * 512 + (col0 + bj * 128 + n * 16 - 2048), acc[ai][bj][m][n]); }
        }
    } };
struct FGate { bf16_t* g;
    __device__ __forceinline__ void operator()(int row, int col, f32x4 v) const {
        f32x4 o; o[0] = sigmoidf_(v[0]); o[1] = sigmoidf_(v[1]); o[2] = sigmoidf_(v[2]); o[3] = sigmoidf_(v[3]);
        store4bf(g + (size_t)row * 3072 + col, o);
    } };
template <int J> struct FMerge { const bf16_t* g; float* y32; bf16_t* ybf;
    __device__ __forceinline__ void operator()(int row, int col, f32x4 v) const {
        const u32x2 z = *(const u32x2*)(g + (size_t)row * 3072 + J * 1024 + col);
        f32x4 o; o[0] = bflo(z.x) * v[0]; o[1] = bfhi(z.x) * v[1]; o[2] = bflo(z.y) * v[2]; o[3] = bfhi(z.y) * v[3];
        float* yp = y32 + (size_t)row * 1024 + col;
        if (J == 0) *(f32x4*)yp = o;
        else if (J == 1) { f32x4 t = *(f32x4*)yp; *(f32x4*)yp = t + o; }
        else { f32x4 t = *(f32x4*)yp; store4bf(ybf + (size_t)row * 1024 + col, t + o); }
    } };
struct FResid { float* x; const float* modl; int chunk;
    __device__ __forceinline__ void operator()(int row, int col, f32x4 v) const {
        const f32x4 mg = *(const f32x4*)(modl + row_vec(row) * 6144 + chunk * 1024 + col);
        float* xp = x + (size_t)row * 1024 + col; f32x4 t = *(f32x4*)xp; *(f32x4*)xp = t + mg * v;
    } };
struct FMlp1 { bf16_t* hid;
    __device__ __forceinline__ void operator()(int row, int col, f32x4 v) const {
        f32x4 o;
#pragma unroll
        for (int e = 0; e < 4; ++e) { const float r = fmaxf(v[e], 0.f); o[e] = r * r; }
        store4bf(hid + (size_t)row * 4096 + col, o);
    } };

__device__ __forceinline__ void phase_mod(float* smf) {
    CParams& p = KPL(); const Ctx cx = mkctx();
    const int tid = cx.tid, lane = tid & 63, wid = tid >> 6;
    float* sc = smf; float* red = smf + 3072;
    float* MOD = (float*)(p.ws + OFF_MOD);
    for (int i = tid; i < 3072; i += 512) { const int v = i >> 10, j = i & 1023; const float c = v < 2 ? p.in[1][v * 1024 + j] : p.in[3][j]; sc[i] = c / (1.f + expf(-c)); }
    __syncthreads();
    for (int item = cx.bid; item < 4 * 96; item += cx.nb) {
        const int l = item / 96, jt = item % 96, j = jt * 64 + lane;
        const float* w = p.in[4] + (size_t)l * 1024 * 6144 + j;
        float a0 = 0.f, a1 = 0.f, a2 = 0.f;
#pragma unroll 8
        for (int i = wid * 128; i < wid * 128 + 128; ++i) { const float wv = w[(size_t)i * 6144]; a0 += sc[i] * wv; a1 += sc[1024 + i] * wv; a2 += sc[2048 + i] * wv; }
        red[(wid * 3 + 0) * 64 + lane] = a0; red[(wid * 3 + 1) * 64 + lane] = a1; red[(wid * 3 + 2) * 64 + lane] = a2;
        __syncthreads();
        if (tid < 192) { const int v = tid >> 6; float s = 0.f;
            for (int w8 = 0; w8 < 8; ++w8) s += red[(w8 * 3 + v) * 64 + lane];
            MOD[(l * 3 + v) * 6144 + j] = s + p.in[5][l * 6144 + j]; }
        __syncthreads();
    }
}

__device__ __forceinline__ void dsincos(double x, double& s, double& c) {
    const double k = rint(x * 0.63661977236758134308);
    double r = fma(-k, 1.57079632679489655800, x); r = fma(-k, 6.12323399573676603587e-17, r);
    const double r2 = r * r;
    double ps = -1.0 / 355687428096000.0;
    ps = fma(ps, r2, 1.0 / 1307674368000.0); ps = fma(ps, r2, -1.0 / 6227020800.0); ps = fma(ps, r2, 1.0 / 39916800.0); ps = fma(ps, r2, -1.0 / 362880.0);
    ps = fma(ps, r2, 1.0 / 5040.0); ps = fma(ps, r2, -1.0 / 120.0); ps = fma(ps, r2, 1.0 / 6.0); ps = fma(ps, r2, -1.0); ps = -ps * r;
    double pc = 1.0 / 20922789888000.0;
    pc = fma(pc, r2, -1.0 / 87178291200.0); pc = fma(pc, r2, 1.0 / 479001600.0); pc = fma(pc, r2, -1.0 / 3628800.0); pc = fma(pc, r2, 1.0 / 40320.0);
    pc = fma(pc, r2, -1.0 / 720.0); pc = fma(pc, r2, 1.0 / 24.0); pc = fma(pc, r2, -0.5); pc = fma(pc, r2, 1.0);
    const int q = ((int)k) & 3;
    s = (q == 0) ? ps : (q == 1) ? pc : (q == 2) ? -ps : -pc;
    c = (q == 0) ? pc : (q == 1) ? -ps : (q == 2) ? -pc : ps;
}
__device__ __forceinline__ double dexp_neg(double x) {
    const double k = rint(x * 1.44269504088896338700);
    double r = fma(-k, 0.693147180369123816490, x); r = fma(-k, 1.90821492927058770002e-10, r);
    double pe = 1.0 / 6227020800.0;
    pe = fma(pe, r, 1.0 / 479001600.0); pe = fma(pe, r, 1.0 / 39916800.0); pe = fma(pe, r, 1.0 / 3628800.0); pe = fma(pe, r, 1.0 / 362880.0); pe = fma(pe, r, 1.0 / 40320.0);
    pe = fma(pe, r, 1.0 / 5040.0); pe = fma(pe, r, 1.0 / 720.0); pe = fma(pe, r, 1.0 / 120.0); pe = fma(pe, r, 1.0 / 24.0); pe = fma(pe, r, 1.0 / 6.0); pe = fma(pe, r, 0.5);
    pe = fma(pe, r, 1.0); pe = fma(pe, r, 1.0);
    int ki = (int)k; if (ki < -1000) return 0.0;
    return pe * __longlong_as_double((long long)(1023 + ki) << 52);
}

__device__ __forceinline__ void wconv_tile(const Ctx& cx, const float* src, int ld, int K, int c0, int ncols, bf16_t* dst, int kt, int nt, float* tile) {
    const int tid = cx.tid, j = tid & 63, i0 = tid >> 6;
#pragma unroll
    for (int e = 0; e < 8; ++e) { const int i = i0 + 8 * e; const int n = nt * 64 + j;
        tile[i * 65 + j] = (n < ncols) ? src[(size_t)(kt * 64 + i) * ld + c0 + n] : 0.f; }
    __syncthreads();
#pragma unroll
    for (int e = 0; e < 8; ++e) { const int jj = i0 + 8 * e;
        dst[(size_t)(nt * 64 + jj) * K + kt * 64 + j] = f2bf(tile[j * 65 + jj]); }
    __syncthreads();
}

__device__ __forceinline__ void phase_wconv(int l, float* smf) {
    CParams& p = KPL(); const Ctx cx = mkctx();
    bf16_t* W = (bf16_t*)(p.ws + OFF_W);
    const int tid = cx.tid;
    for (int item = cx.bid; item < 5184; item += cx.nb) {
        if (item < 4544) {
            const float* src; int ld, K, c0, ncols, nN; bf16_t* dst; int t = item;
            if (t < 1024) { src = p.in[8] + (size_t)l * 1024 * 6928; ld = 6928; K = 1024; c0 = 0; ncols = 3856; nN = 64; dst = W + W_MIX / 2; }
            else if (t < 1792) { t -= 1024; src = p.in[8] + (size_t)l * 1024 * 6928; ld = 6928; K = 1024; c0 = 3856; ncols = 3072; nN = 48; dst = W + W_GATE / 2; }
            else if (t < 1856) { t -= 1792; src = p.in[17] + (size_t)l * 512 * 512; ld = 512; K = 512; c0 = 0; ncols = 512; nN = 8; dst = W + W_GLU / 2; }
            else if (t < 1984) { t -= 1856; src = p.in[35] + (size_t)l * 512 * 1024; ld = 1024; K = 512; c0 = 0; ncols = 1024; nN = 16; dst = W + W_PA / 2; }
            else if (t < 2112) { t -= 1984; src = p.in[36] + (size_t)l * 512 * 1024; ld = 1024; K = 512; c0 = 0; ncols = 1024; nN = 16; dst = W + W_PB / 2; }
            else if (t < 2240) { t -= 2112; src = p.in[37] + (size_t)l * 512 * 1024; ld = 1024; K = 512; c0 = 0; ncols = 1024; nN = 16; dst = W + W_PC / 2; }
            else if (t < 2496) { t -= 2240; src = p.in[38] + (size_t)l * 1024 * 1024; ld = 1024; K = 1024; c0 = 0; ncols = 1024; nN = 16; dst = W + W_OUT / 2; }
            else if (t < 3520) { t -= 2496; src = p.in[39] + (size_t)l * 1024 * 4096; ld = 4096; K = 1024; c0 = 0; ncols = 4096; nN = 64; dst = W + W_1 / 2; }
            else { t -= 3520; src = p.in[40] + (size_t)l * 4096 * 1024; ld = 1024; K = 4096; c0 = 0; ncols = 1024; nN = 16; dst = W + W_2 / 2; }
            const int nt = t % nN, kt = t / nN;
            wconv_tile(cx, src, ld, K, c0, ncols, dst, kt, nt, smf);
        } else {
            bf16_t* dst = W + W_LORA / 2;
#pragma unroll
            for (int q = 0; q < 2; ++q) {
                const int e = (item - 4544) * 1024 + q * 512 + tid; const int n = e >> 8, k = e & 255;
                float v = 0.f;
                if (n < 1024) { if (k < 64) v = p.in[26][(((size_t)l * 2 + (n >> 9)) * 64 + k) * 512 + (n & 511)]; }
                else if (n < 2048) { if (k >= 64 && k < 128) v = p.in[28][(((size_t)l * 2 + ((n - 1024) >> 9)) * 64 + (k - 64)) * 512 + (n & 511)]; }
                else { if (k >= 128) v = p.in[29][((size_t)l * 128 + (k - 128)) * 512 + (n - 2048)]; }
                dst[e] = f2bf(v);
            }
        }
    }
}

__device__ __forceinline__ void phase_s5_params() {
    CParams& p = KPL(); const Ctx cx = mkctx();
    for (int item = cx.bid; item < 32; item += cx.nb) {
        const int l = item >> 3;
        const int idx = (item & 7) * 512 + cx.tid;
        const int dir = idx >> 11, g = (idx >> 6) & 31;
        float* S5P = (float*)(p.ws + OFF_S5P) + (size_t)l * 147456;
        const size_t pi = (size_t)l * 4096 + idx;
        const double lre = fmin((double)p.in[9][pi], -1e-4), lim = (double)p.in[10][pi];
        const double dt = dexp_neg((double)p.in[11][(l * 2 + dir) * 32 + g]);
        const double mag = dexp_neg(lre * dt); double sn, cs; dsincos(lim * dt, sn, cs);
        const double ar = mag * cs, ai = mag * sn;
        const double den = lre * lre + lim * lim, nr = ar - 1.0;
        const double cr = (nr * lre + ai * lim) / den, ci = (ai * lre - nr * lim) / den;
        const double mag64 = dexp_neg(64.0 * lre * dt); dsincos(64.0 * lim * dt, sn, cs);
        S5P[idx] = (float)ar; S5P[4096 + idx] = (float)ai; S5P[8192 + idx] = (float)(mag64 * cs); S5P[12288 + idx] = (float)(mag64 * sn);
        float* BR = S5P + 16384; float* BI = BR + 65536;
        for (int c = 0; c < 16; ++c) { const double bre = p.in[12][pi * 16 + c], bim = p.in[13][pi * 16 + c];
            BR[(size_t)idx * 16 + c] = (float)(cr * bre - ci * bim); BI[(size_t)idx * 16 + c] = (float)(cr * bim + ci * bre); }
    }
}

__device__ __forceinline__ void phase_norm(int l, int which, bool init) {
    CParams& p = KPL(); const Ctx cx = mkctx();
    const int lane = cx.tid & 63, gw = cx.bid * 8 + (cx.tid >> 6), nw = cx.nb * 8;
    float* X = (float*)(p.ws + OFF_X); bf16_t* H = (bf16_t*)(p.ws + OFF_H);
    const float* MODL = (const float*)(p.ws + OFF_MOD) + (size_t)l * 3 * 6144;
    const float* gam = p.in[which ? 7 : 6] + l * 1024;
    for (int row = gw; row < T_TOK; row += nw) {
        const int b = row >= SEQA ? 1 : 0, t = row - b * SEQA;
        const float* src = init ? (t < NCTX ? p.in[2] + ((size_t)b * NCTX + t) * 1024 : p.in[0] + ((size_t)b * 8192 + (t - NCTX)) * 1024) : X + (size_t)row * 1024;
        f32x4 v[4]; float ss = 0.f;
#pragma unroll
        for (int i = 0; i < 4; ++i) { v[i] = *(const f32x4*)(src + (lane + 64 * i) * 4); ss += v[i][0] * v[i][0] + v[i][1] * v[i][1] + v[i][2] * v[i][2] + v[i][3] * v[i][3]; }
        if (init) {
#pragma unroll
            for (int i = 0; i < 4; ++i) *(f32x4*)(X + (size_t)row * 1024 + (lane + 64 * i) * 4) = v[i];
        }
        ss = wave_sum(ss);
        const float inv = rsqrtf(ss * (1.f / 1024.f) + 1e-6f);
        const float* mv = MODL + (t < NCTX ? 2 : b) * 6144 + (which ? 3 : 0) * 1024;
#pragma unroll
        for (int i = 0; i < 4; ++i) { const int c = (lane + 64 * i) * 4;
            const f32x4 g4 = *(const f32x4*)(gam + c), sh = *(const f32x4*)(mv + c), scl = *(const f32x4*)(mv + 1024 + c);
            f32x4 o;
#pragma unroll
            for (int e = 0; e < 4; ++e) o[e] = v[i][e] * inv * g4[e] * (1.f + scl[e]) + sh[e];
            store4bf(H + (size_t)row * 1024 + c, o); }
    }
}

__device__ __forceinline__ int s5_order(int dir, int i) { return dir == 0 ? i : (i < 4 ? 3 - i : 135 - i); }

__device__ __forceinline__ void phase_s5_local(int l) {
    CParams& p = KPL(); const Ctx cx = mkctx();
    const int lane = cx.tid & 63, gw = cx.bid * 8 + (cx.tid >> 6), nw = cx.nb * 8;
    const bf16_t* ZA = (const bf16_t*)(p.ws + OFF_Z);
    const float* S5P = (const float*)(p.ws + OFF_S5P) + (size_t)l * 147456; const float* BR = S5P + 16384; const float* BI = BR + 65536;
    float* ST = (float*)(p.ws + OFF_S5ST);
    for (int item0 = gw; item0 < 16896; item0 += nw) {
        const int item = __builtin_amdgcn_readfirstlane(item0);
        const int chunk = item % 132, g = (item / 132) & 31, dir = (item / 4224) & 1, b = item / 8448;
        const int idx = dir * 2048 + g * 64 + lane;
        const float ar = S5P[idx], ai = S5P[4096 + idx];
        float br[16], bi[16];
#pragma unroll
        for (int q = 0; q < 4; ++q) { const f32x4 t0 = *(const f32x4*)(BR + (size_t)idx * 16 + q * 4), t1 = *(const f32x4*)(BI + (size_t)idx * 16 + q * 4);
#pragma unroll
            for (int e = 0; e < 4; ++e) { br[q * 4 + e] = t0[e]; bi[q * 4 + e] = t1[e]; } }
        const int row = b * SEQA + chunk * 64 + lane;
        const u32x4 u0 = *(const u32x4*)(ZA + (size_t)row * 2048 + g * 16), u1 = *(const u32x4*)(ZA + (size_t)row * 2048 + g * 16 + 8);
        unsigned ur[8] = {u0.x, u0.y, u0.z, u0.w, u1.x, u1.y, u1.z, u1.w};
        float hr = 0.f, hi = 0.f;
#pragma unroll 8
        for (int j = 0; j < 64; ++j) {
            const int tok = dir ? 63 - j : j;
            float bur = 0.f, bui = 0.f;
#pragma unroll
            for (int q = 0; q < 8; ++q) { const unsigned w = (unsigned)__builtin_amdgcn_readlane((int)ur[q], tok); const float x0 = bflo(w), x1 = bfhi(w);
                bur += br[2 * q] * x0 + br[2 * q + 1] * x1; bui += bi[2 * q] * x0 + bi[2 * q + 1] * x1; }
            const float nr = ar * hr - ai * hi + bur, ni = ar * hi + ai * hr + bui; hr = nr; hi = ni;
        }
        float* st = ST + ((((size_t)b * 2 + dir) * 32 + g) * 132 + chunk) * 128;
        st[lane] = hr; st[64 + lane] = hi;
    }
}

__device__ __forceinline__ void phase_s5_carry(int l) {
    CParams& p = KPL(); const Ctx cx = mkctx();
    const int lane = cx.tid & 63, gw = cx.bid * 8 + (cx.tid >> 6), nw = cx.nb * 8;
    const float* S5P = (const float*)(p.ws + OFF_S5P) + (size_t)l * 147456;
    float* ST = (float*)(p.ws + OFF_S5ST);
    for (int item0 = gw; item0 < 128; item0 += nw) {
        const int item = __builtin_amdgcn_readfirstlane(item0);
        const int g = item & 31, dir = (item >> 5) & 1, b = item >> 6;
        const int idx = dir * 2048 + g * 64 + lane;
        const float ar = S5P[8192 + idx], ai = S5P[12288 + idx];
        float* st = ST + (((size_t)b * 2 + dir) * 32 + g) * 132 * 128;
        float hr = 0.f, hi = 0.f;
        for (int i0 = 0; i0 < 132; i0 += 12) {
            float lr[12], li[12];
#pragma unroll
            for (int e = 0; e < 12; ++e) { const int c = s5_order(dir, i0 + e); lr[e] = st[c * 128 + lane]; li[e] = st[c * 128 + 64 + lane]; }
#pragma unroll
            for (int e = 0; e < 12; ++e) { const int c = s5_order(dir, i0 + e); st[c * 128 + lane] = hr; st[c * 128 + 64 + lane] = hi;
                const float nr = ar * hr - ai * hi + lr[e], ni = ar * hi + ai * hr + li[e]; hr = nr; hi = ni; }
        }
    }
}

template <int DIR>
__device__ __forceinline__ void s5_final_dir(CParams& p, int l, int b, int g, int chunk, int lane, const unsigned (&ur)[8], float* hst, f32x4* ybuf, int row0, float dsk, bf16_t* ZG) {
    const float* S5P = (const float*)(p.ws + OFF_S5P) + (size_t)l * 147456; const float* BR = S5P + 16384; const float* BI = BR + 65536;
    const float* ST = (const float*)(p.ws + OFF_S5ST);
    const bf16_t* ZA = (const bf16_t*)(p.ws + OFF_Z);
    const int idx = DIR * 2048 + g * 64 + lane;
    const float ar = S5P[idx], ai = S5P[4096 + idx];
    float br[16], bi[16];
#pragma unroll
    for (int q = 0; q < 4; ++q) { const f32x4 t0 = *(const f32x4*)(BR + (size_t)idx * 16 + q * 4), t1 = *(const f32x4*)(BI + (size_t)idx * 16 + q * 4);
#pragma unroll
        for (int e = 0; e < 4; ++e) { br[q * 4 + e] = t0[e]; bi[q * 4 + e] = t1[e]; } }
    float cbr[16], cbi[16];
    { const size_t cb = ((((size_t)l * 2 + DIR) * 32 + g) * 16 + (lane & 15)) * 64 + (lane >> 4);
#pragma unroll
      for (int i = 0; i < 16; ++i) { cbr[i] = p.in[14][cb + 4 * i]; cbi[i] = -p.in[15][cb + 4 * i]; } }
    const float* st = ST + ((((size_t)b * 2 + DIR) * 32 + g) * 132 + chunk) * 128;
    float hr = st[lane], hi = st[64 + lane];
    const int ch = g * 16 + (lane & 15);
#pragma unroll 1
    for (int si = 0; si < 4; ++si) {
        const int sc = DIR ? 3 - si : si;
#pragma unroll
        for (int jj = 0; jj < 16; ++jj) {
            const int tt = DIR ? 15 - jj : jj; const int tok = sc * 16 + tt;
            float bur = 0.f, bui = 0.f;
#pragma unroll
            for (int q = 0; q < 8; ++q) { const unsigned w = (unsigned)__builtin_amdgcn_readlane((int)ur[q], tok); const float x0 = bflo(w), x1 = bfhi(w);
                bur += br[2 * q] * x0 + br[2 * q + 1] * x1; bui += bi[2 * q] * x0 + bi[2 * q + 1] * x1; }
            const float nr = ar * hr - ai * hi + bur, ni = ar * hi + ai * hr + bui; hr = nr; hi = ni;
            hst[tt * 68 + lane] = hr; hst[1088 + tt * 68 + lane] = hi;
        }
        f32x4 a = (f32x4){0.f, 0.f, 0.f, 0.f};
        if (DIR) a = ybuf[sc * 64 + lane];
#pragma unroll
        for (int i = 0; i < 16; ++i) {
            const float xr = hst[(lane & 15) * 68 + 4 * i + (lane >> 4)], xi = hst[1088 + (lane & 15) * 68 + 4 * i + (lane >> 4)];
            a = __builtin_amdgcn_mfma_f32_16x16x4f32(xr, cbr[i], a, 0, 0, 0);
            a = __builtin_amdgcn_mfma_f32_16x16x4f32(xi, cbi[i], a, 0, 0, 0);
        }
        if (!DIR) ybuf[sc * 64 + lane] = a;
        else {
#pragma unroll
            for (int j = 0; j < 4; ++j) {
                const int row = row0 + sc * 16 + (lane >> 4) * 4 + j;
                const float u = bf2f(ZA[(size_t)row * 2048 + ch]);
                const float y = u * dsk + a[j];
                const float z = 0.5f * y * (1.f + tanhf(0.7978845608028654f * (y + 0.044715f * y * y * y)));
                ZG[(size_t)row * 512 + ch] = f2bf(z);
            }
        }
    }
}

__device__ __forceinline__ void phase_s5_final(int l, float* smf) {
    CParams& p = KPL(); const Ctx cx = mkctx();
    const int lane = cx.tid & 63, wid = cx.tid >> 6, gw = cx.bid * 8 + wid, nw = cx.nb * 8;
    const bf16_t* ZA = (const bf16_t*)(p.ws + OFF_Z);
    bf16_t* ZG = (bf16_t*)(p.ws + OFF_ZG);
    float* hst = smf + wid * 3200;
    f32x4* ybuf = (f32x4*)(hst + 2176);
    for (int item0 = gw; item0 < 8448; item0 += nw) {
        const int item = __builtin_amdgcn_readfirstlane(item0);
        const int chunk = item % 132, g = (item / 132) & 31, b = item / 4224;
        const int row0 = b * SEQA + chunk * 64;
        const u32x4 u0 = *(const u32x4*)(ZA + (size_t)(row0 + lane) * 2048 + g * 16), u1 = *(const u32x4*)(ZA + (size_t)(row0 + lane) * 2048 + g * 16 + 8);
        const unsigned ur[8] = {u0.x, u0.y, u0.z, u0.w, u1.x, u1.y, u1.z, u1.w};
        const float dsk = p.in[16][l * 512 + g * 16 + (lane & 15)];
        s5_final_dir<0>(p, l, b, g, chunk, lane, ur, hst, ybuf, row0, dsk, ZG);
        s5_final_dir<1>(p, l, b, g, chunk, lane, ur, hst, ybuf, row0, dsk, ZG);
    }
}

__device__ __forceinline__ int ml_row0(int b, int nc) { return b * SEQA + nc * 128; }
__device__ __forceinline__ int ml_order(int dir, int i) { return dir == 0 ? i : (i < 2 ? 1 - i : 67 - i); }

__device__ __forceinline__ void phase_ml_conv(int l) {
    CParams& p = KPL(); const Ctx cx = mkctx();
    const bf16_t* ZA = (const bf16_t*)(p.ws + OFF_Z);
    bf16_t* QKC = (bf16_t*)(p.ws + OFF_QKC);
    const float* cw = p.in[19] + (size_t)l * 9 * 512; const float* cb = p.in[20] + l * 512;
    for (int idx = cx.bid * 512 + cx.tid; idx < T_TOK * 64; idx += cx.nb * 512) {
        const int row = idx >> 6, c8 = (idx & 63) * 8;
        const int b = row >= SEQA ? 1 : 0, t = row - b * SEQA;
        const bool isctx = t < NCTX;
        const int tt = isctx ? t : t - NCTX, W = isctx ? 256 : 64, Hh = isctx ? 1 : 128;
        const int y = tt / W, x = tt % W;
        const int segrow0 = row - tt;
        float acc[8];
#pragma unroll
        for (int e = 0; e < 8; ++e) acc[e] = cb[c8 + e];
#pragma unroll
        for (int dy = 0; dy < 3; ++dy)
#pragma unroll
            for (int dx = 0; dx < 3; ++dx) {
                const int yy = y + dy - 1, xx = x + dx - 1;
                if (yy >= 0 && yy < Hh && xx >= 0 && xx < W) {
                    const u32x4 z = *(const u32x4*)(ZA + (size_t)(segrow0 + yy * W + xx) * 2048 + 512 + c8);
                    const float* w = cw + (dy * 3 + dx) * 512 + c8;
                    const f32x4 w0 = *(const f32x4*)w, w1 = *(const f32x4*)(w + 4);
                    acc[0] += bflo(z.x) * w0[0]; acc[1] += bfhi(z.x) * w0[1]; acc[2] += bflo(z.y) * w0[2]; acc[3] += bfhi(z.y) * w0[3];
                    acc[4] += bflo(z.z) * w1[0]; acc[5] += bfhi(z.z) * w1[1]; acc[6] += bflo(z.w) * w1[2]; acc[7] += bfhi(z.w) * w1[3];
                }
            }
        u32x4 o;
#pragma unroll
        for (int e = 0; e < 8; ++e) acc[e] = acc[e] * sigmoidf_(acc[e]);
        o.x = pk2(acc[0], acc[1]); o.y = pk2(acc[2], acc[3]); o.z = pk2(acc[4], acc[5]); o.w = pk2(acc[6], acc[7]);
        *(u32x4*)(QKC + (size_t)row * 512 + c8) = o;
    }
}

constexpr int ML_QS = 0, ML_KS = 18432, ML_VT = 36864, ML_CS = 71680, ML_PS = 92416, ML_GV = 127232, ML_BV = 127744, ML_MV = 128256, ML_LF = 128768, ML_IG = 129280, ML_SC = 129792;

__device__ __forceinline__ void ml_gate_vectors(const Ctx& cx, CParams& p, int l, int dir, int b, int h, int nc, unsigned char* sm, float m_in) {
    const int tid = cx.tid, lane = tid & 63;
    float* lf = (float*)(sm + ML_LF); float* ig = (float*)(sm + ML_IG); float* gv = (float*)(sm + ML_GV); float* bv = (float*)(sm + ML_BV); float* mv = (float*)(sm + ML_MV); float* sc = (float*)(sm + ML_SC);
    const float* MLG = (const float*)(p.ws + OFF_MLG);
    const float* gb = p.in[21] + l * 16;
    if (tid < 128) {
        const int row = ml_row0(b, nc) + tid;
        const float ip = MLG[(size_t)row * 16 + dir * 4 + h] + gb[dir * 4 + h];
        const float fp = MLG[(size_t)row * 16 + 8 + dir * 4 + h] + gb[8 + dir * 4 + h];
        ig[tid] = ip; lf[tid] = fminf(fp, 0.f) - log1pf(expf(-fabsf(fp)));
    }
    __syncthreads();
    if (tid < 64) {
        const int pp0 = 2 * lane, pp1 = 2 * lane + 1; const int s0 = dir ? 127 - pp0 : pp0, s1 = dir ? 127 - pp1 : pp1;
        const float x0 = lf[s0], x1 = lf[s1];
        float incl = x0 + x1;
#pragma unroll
        for (int d = 1; d < 64; d <<= 1) { const float t = __shfl_up(incl, d); if (lane >= d) incl += t; }
        const float g1 = incl, g0 = incl - x1;
        const float gtot = __shfl(incl, 63);
        const float b0 = ig[s0] - g0, b1 = ig[s1] - g1;
        float mx = fmaxf(b0, b1);
#pragma unroll
        for (int d = 1; d < 64; d <<= 1) { const float t = __shfl_up(mx, d); if (lane >= d) mx = fmaxf(mx, t); }
        const float prev = __shfl_up(mx, 1);
        const float pm0 = lane > 0 ? fmaxf(prev, b0) : b0, pm1 = mx;
        const float bmax = __shfl(mx, 63);
        gv[s0] = g0; gv[s1] = g1; bv[s0] = b0; bv[s1] = b1; mv[s0] = fmaxf(m_in, pm0); mv[s1] = fmaxf(m_in, pm1);
        if (lane == 0) { sc[0] = gtot; sc[1] = bmax; }
    }
    __syncthreads();
}

__device__ __forceinline__ void phase_ml_local(int l, unsigned char* sm) {
    CParams& p = KPL(); const Ctx cx = mkctx();
    const int tid = cx.tid, lane = tid & 63, wid = tid >> 6;
    const bf16_t* ZA = (const bf16_t*)(p.ws + OFF_Z); const bf16_t* QKC = (const bf16_t*)(p.ws + OFF_QKC);
    float* CLOC = (float*)(p.ws + OFF_CLOC); float* MLS = (float*)(p.ws + OFF_MLS);
    bf16_t* VT = (bf16_t*)(sm + ML_VT); bf16_t* KT = (bf16_t*)(sm + ML_KS);
    const float* bv = (const float*)(sm + ML_BV); const float* sc = (const float*)(sm + ML_SC);
    float* wg = (float*)(sm + ML_LF);
    for (int item = cx.bid; item < 1056; item += cx.nb) {
        const int chain = item / 66, nc = item % 66; const int dir = chain >> 3, b = (chain >> 2) & 1, h = chain & 3;
        ml_gate_vectors(cx, p, l, dir, b, h, nc, sm, -1e30f);
        const float gtot = sc[0], bmax = sc[1];
        __syncthreads();
        if (tid < 128) wg[tid] = expf(bv[tid] - bmax);
        __syncthreads();
        const int row0 = ml_row0(b, nc);
#pragma unroll
        for (int q = 0; q < 4; ++q) { const int ci = q * 512 + tid; const int s = ci >> 4, v8 = (ci & 15) * 8;
            const u32x4 z = *(const u32x4*)(ZA + (size_t)(row0 + s) * 2048 + 1024 + h * 128 + v8); const float w = wg[s];
            const unsigned zz[4] = {z.x, z.y, z.z, z.w};
#pragma unroll
            for (int e = 0; e < 4; ++e) { VT[(v8 + 2 * e) * 136 + s] = f2bf(bflo(zz[e]) * w); VT[(v8 + 2 * e + 1) * 136 + s] = f2bf(bfhi(zz[e]) * w); } }
#pragma unroll
        for (int q = 0; q < 2; ++q) { const int ci = q * 512 + tid; const int s = ci >> 3, k8 = (ci & 7) * 8;
            const u32x4 z = *(const u32x4*)(QKC + (size_t)(row0 + s) * 512 + 256 + h * 64 + k8);
            const unsigned zz[4] = {z.x, z.y, z.z, z.w};
#pragma unroll
            for (int e = 0; e < 4; ++e) { KT[(k8 + 2 * e) * 136 + s] = (bf16_t)(zz[e] & 0xffff); KT[(k8 + 2 * e + 1) * 136 + s] = (bf16_t)(zz[e] >> 16); } }
        __syncthreads();
        float* dst = CLOC + ((size_t)chain * 66 + nc) * 8256;
        f32x4 acc[4];
#pragma unroll
        for (int n = 0; n < 4; ++n) acc[n] = (f32x4){0.f, 0.f, 0.f, 0.f};
#pragma unroll
        for (int ks = 0; ks < 4; ++ks) {
            const bf16x8 a = *(const bf16x8*)(VT + (16 * wid + (lane & 15)) * 136 + ks * 32 + (lane >> 4) * 8);
#pragma unroll
            for (int n = 0; n < 4; ++n) { const bf16x8 bb = *(const bf16x8*)(KT + (16 * n + (lane & 15)) * 136 + ks * 32 + (lane >> 4) * 8);
                acc[n] = __builtin_amdgcn_mfma_f32_16x16x32_bf16(a, bb, acc[n], 0, 0, 0); }
        }
#pragma unroll
        for (int n = 0; n < 4; ++n)
#pragma unroll
            for (int j = 0; j < 4; ++j) dst[(16 * wid + (lane >> 4) * 4 + j) * 64 + 16 * n + (lane & 15)] = acc[n][j];
        if (tid < 64) { float s = 0.f; for (int t = 0; t < 128; ++t) s += wg[t] * bf2f(KT[tid * 136 + t]); dst[8192 + tid] = s; }
        if (tid == 0) { MLS[chain * 66 + nc] = gtot; MLS[1056 + chain * 66 + nc] = gtot + bmax; }
        __syncthreads();
    }
}

__device__ __forceinline__ void phase_ml_carry() {
    CParams& p = KPL(); const Ctx cx = mkctx();
    float* CLOC = (float*)(p.ws + OFF_CLOC); float* MLS = (float*)(p.ws + OFF_MLS);
    for (int idx = cx.bid * 512 + cx.tid; idx < 16 * 8256; idx += cx.nb * 512) {
        const int chain = idx / 8256, e = idx % 8256; const int dir = chain >> 3;
        float* base = CLOC + (size_t)chain * 66 * 8256 + e;
        float m = -1e30f, C = 0.f;
        for (int i0 = 0; i0 < 66; i0 += 6) {
            float cl[6];
#pragma unroll
            for (int q = 0; q < 6; ++q) cl[q] = base[(size_t)ml_order(dir, i0 + q) * 8256];
#pragma unroll
            for (int q = 0; q < 6; ++q) { const int nc = ml_order(dir, i0 + q);
                const float gt = MLS[chain * 66 + nc], am = MLS[1056 + chain * 66 + nc];
                base[(size_t)nc * 8256] = C;
                if (e == 0) MLS[2112 + chain * 66 + nc] = m;
                const float mn = fmaxf(gt + m, am); const float so = expf(gt + m - mn), sl = expf(am - mn);
                C = so * C + sl * cl[q]; m = mn; }
        }
    }
}

__device__ __forceinline__ void phase_ml_out(int l, unsigned char* sm) {
    CParams& p = KPL(); const Ctx cx = mkctx();
    const int tid = cx.tid, lane = tid & 63, wid = tid >> 6;
    const bf16_t* ZA = (const bf16_t*)(p.ws + OFF_Z); const bf16_t* QKC = (const bf16_t*)(p.ws + OFF_QKC);
    const float* CLOC = (const float*)(p.ws + OFF_CLOC); const float* MLS = (const float*)(p.ws + OFF_MLS);
    bf16_t* YB = (bf16_t*)(p.ws + OFF_YB);
    bf16_t* QS = (bf16_t*)(sm + ML_QS); bf16_t* KS = (bf16_t*)(sm + ML_KS); bf16_t* VT = (bf16_t*)(sm + ML_VT); bf16_t* CS = (bf16_t*)(sm + ML_CS); bf16_t* PS = (bf16_t*)(sm + ML_PS);
    const float* gv = (const float*)(sm + ML_GV); const float* bv = (const float*)(sm + ML_BV); const float* mv = (const float*)(sm + ML_MV);
    for (int item = cx.bid; item < 528; item += cx.nb) {
        const int b = item / 264, h = (item / 66) & 3, nc = item % 66;
        const int row0 = ml_row0(b, nc);
        __syncthreads();
#pragma unroll
        for (int q = 0; q < 2; ++q) { const int ci = q * 512 + tid; const int s = ci >> 3, k8 = (ci & 7) * 8;
            const u32x4 zq = *(const u32x4*)(QKC + (size_t)(row0 + s) * 512 + h * 64 + k8);
            u32x4 o; o.x = pk2(bflo(zq.x) * 0.125f, bfhi(zq.x) * 0.125f); o.y = pk2(bflo(zq.y) * 0.125f, bfhi(zq.y) * 0.125f); o.z = pk2(bflo(zq.z) * 0.125f, bfhi(zq.z) * 0.125f); o.w = pk2(bflo(zq.w) * 0.125f, bfhi(zq.w) * 0.125f);
            *(u32x4*)(QS + s * 72 + k8) = o;
            *(u32x4*)(KS + s * 72 + k8) = *(const u32x4*)(QKC + (size_t)(row0 + s) * 512 + 256 + h * 64 + k8); }
#pragma unroll
        for (int q = 0; q < 4; ++q) { const int ci = q * 512 + tid; const int s = ci >> 4, v8 = (ci & 15) * 8;
            const u32x4 z = *(const u32x4*)(ZA + (size_t)(row0 + s) * 2048 + 1024 + h * 128 + v8);
            const unsigned zz[4] = {z.x, z.y, z.z, z.w};
#pragma unroll
            for (int e = 0; e < 4; ++e) { VT[(v8 + 2 * e) * 136 + s] = (bf16_t)(zz[e] & 0xffff); VT[(v8 + 2 * e + 1) * 136 + s] = (bf16_t)(zz[e] >> 16); } }
        f32x4 hsum[8];
#pragma unroll
        for (int v = 0; v < 8; ++v) hsum[v] = (f32x4){0.f, 0.f, 0.f, 0.f};
#pragma unroll 1
        for (int dir = 0; dir < 2; ++dir) {
            const int chain = dir * 8 + b * 4 + h;
            const float m_in = MLS[2112 + chain * 66 + nc];
            __syncthreads();
            ml_gate_vectors(cx, p, l, dir, b, h, nc, sm, m_in);
            const float* cin = CLOC + ((size_t)chain * 66 + nc) * 8256;
#pragma unroll
            for (int q = 0; q < 4; ++q) { const int ci = q * 512 + tid; const int v = ci >> 4, k4 = (ci & 15) * 4;
                const f32x4 c = *(const f32x4*)(cin + v * 64 + k4); store4bf(CS + v * 72 + k4, c); }
            if (tid < 16) { const f32x4 c = *(const f32x4*)(cin + 8192 + tid * 4); store4bf(CS + 128 * 72 + tid * 4, c); }
            else if (tid < 256) { const int r = 129 + (tid - 16) / 16, k4 = ((tid - 16) & 15) * 4; store4bf(CS + r * 72 + k4, (f32x4){0.f, 0.f, 0.f, 0.f}); }
            __syncthreads();
            const int tr = 16 * wid + (lane >> 4) * 4;
            float Mt[4], rs[4] = {0.f, 0.f, 0.f, 0.f};
#pragma unroll
            for (int j = 0; j < 4; ++j) Mt[j] = mv[tr + j];
            bf16x8 qa[2];
#pragma unroll
            for (int ks = 0; ks < 2; ++ks) qa[ks] = *(const bf16x8*)(QS + (16 * wid + (lane & 15)) * 72 + ks * 32 + (lane >> 4) * 8);
#pragma unroll
            for (int nt = 0; nt < 8; ++nt) {
                f32x4 s4 = (f32x4){0.f, 0.f, 0.f, 0.f};
#pragma unroll
                for (int ks = 0; ks < 2; ++ks) { const bf16x8 kb = *(const bf16x8*)(KS + (16 * nt + (lane & 15)) * 72 + ks * 32 + (lane >> 4) * 8);
                    s4 = __builtin_amdgcn_mfma_f32_16x16x32_bf16(qa[ks], kb, s4, 0, 0, 0); }
                const int s = 16 * nt + (lane & 15); const float bs = bv[s];
#pragma unroll
                for (int j = 0; j < 4; ++j) { const int t = tr + j; const bool valid = dir ? (s >= t) : (s <= t);
                    const float pv = valid ? s4[j] * expf(bs - Mt[j]) : 0.f; rs[j] += pv; PS[t * 136 + s] = f2bf(pv); }
            }
#pragma unroll
            for (int j = 0; j < 4; ++j) rs[j] = row16_sum(rs[j]);
            __syncthreads();
            f32x4 qn = (f32x4){0.f, 0.f, 0.f, 0.f};
#pragma unroll
            for (int ks = 0; ks < 2; ++ks) { const bf16x8 cb = *(const bf16x8*)(CS + (128 + (lane & 15)) * 72 + ks * 32 + (lane >> 4) * 8);
                qn = __builtin_amdgcn_mfma_f32_16x16x32_bf16(qa[ks], cb, qn, 0, 0, 0); }
            float wi[4], dn[4];
#pragma unroll
            for (int j = 0; j < 4; ++j) { const float qnj = row16_sum(qn[j]); wi[j] = expf(m_in - Mt[j]);
                const float den = rs[j] + wi[j] * qnj; const float mt = gv[tr + j] + Mt[j]; dn[j] = 1.f / fmaxf(fabsf(den), expf(-mt)); }
            bf16x8 pa[4];
#pragma unroll
            for (int ks = 0; ks < 4; ++ks) pa[ks] = *(const bf16x8*)(PS + (16 * wid + (lane & 15)) * 136 + ks * 32 + (lane >> 4) * 8);
#pragma unroll
            for (int vt = 0; vt < 8; ++vt) {
                f32x4 a1 = (f32x4){0.f, 0.f, 0.f, 0.f}, a2 = (f32x4){0.f, 0.f, 0.f, 0.f};
#pragma unroll
                for (int ks = 0; ks < 4; ++ks) { const bf16x8 vb = *(const bf16x8*)(VT + (16 * vt + (lane & 15)) * 136 + ks * 32 + (lane >> 4) * 8);
                    a1 = __builtin_amdgcn_mfma_f32_16x16x32_bf16(pa[ks], vb, a1, 0, 0, 0); }
#pragma unroll
                for (int ks = 0; ks < 2; ++ks) { const bf16x8 cb = *(const bf16x8*)(CS + (16 * vt + (lane & 15)) * 72 + ks * 32 + (lane >> 4) * 8);
                    a2 = __builtin_amdgcn_mfma_f32_16x16x32_bf16(qa[ks], cb, a2, 0, 0, 0); }
#pragma unroll
                for (int j = 0; j < 4; ++j) hsum[vt][j] += (a1[j] + wi[j] * a2[j]) * dn[j];
            }
        }
        const int tr = 16 * wid + (lane >> 4) * 4;
        float rinv[4];
#pragma unroll
        for (int j = 0; j < 4; ++j) { float ss = 0.f;
#pragma unroll
            for (int vt = 0; vt < 8; ++vt) ss += hsum[vt][j] * hsum[vt][j];
            ss = row16_sum(ss); rinv[j] = rsqrtf(ss * (1.f / 128.f) + 1e-6f); }
#pragma unroll
        for (int vt = 0; vt < 8; ++vt) { const int ch = h * 128 + 16 * vt + (lane & 15); const float ng = p.in[22][l * 512 + ch];
#pragma unroll
            for (int j = 0; j < 4; ++j) { const int row = row0 + tr + j;
                const float o = bf2f(ZA[(size_t)row * 2048 + 1536 + ch]);
                YB[(size_t)row * 512 + ch] = f2bf(hsum[vt][j] * rinv[j] * ng * sigmoidf_(o)); } }
    }
}

__device__ __forceinline__ void phase_rw_feat(int l) {
    CParams& p = KPL(); const Ctx cx = mkctx();
    const int lane = cx.tid & 63, gw = cx.bid * 8 + (cx.tid >> 6), nw = cx.nb * 8;
    const bf16_t* ZRW = (const bf16_t*)(p.ws + OFF_ZRW);
    bf16_t* F1 = (bf16_t*)(p.ws + OFF_F1); bf16_t* LIN = (bf16_t*)(p.ws + OFF_LORAIN);
    const float* mup = p.in[23] + (size_t)l * 1792; const float* mun = p.in[24] + (size_t)l * 1792;
    const float* kk_w = p.in[30] + l * 512;
    for (int row = gw; row < T_TOK; row += nw) {
        const int b = row >= SEQA ? 1 : 0, t = row - b * SEQA;
        const bool hasp = !(t == 0 || t == NCTX), hasn = !(t == NCTX - 1 || t == SEQA - 1);
        const bf16_t* zc = ZRW + (size_t)row * 1792;
#pragma unroll
        for (int q = 0; q < 3; ++q) {
            const int col = q * 512 + lane * 8;
            const u32x4 c4 = *(const u32x4*)(zc + col);
            u32x4 p4 = (u32x4){0u, 0u, 0u, 0u}, n4 = (u32x4){0u, 0u, 0u, 0u};
            if (hasp) p4 = *(const u32x4*)(zc - 1792 + col);
            if (hasn) n4 = *(const u32x4*)(zc + 1792 + col);
            const unsigned cc[4] = {c4.x, c4.y, c4.z, c4.w}, pp[4] = {p4.x, p4.y, p4.z, p4.w}, nn[4] = {n4.x, n4.y, n4.z, n4.w};
            float zs[8];
#pragma unroll
            for (int e = 0; e < 8; ++e) { const float z = (e & 1) ? bfhi(cc[e >> 1]) : bflo(cc[e >> 1]); const float pv = (e & 1) ? bfhi(pp[e >> 1]) : bflo(pp[e >> 1]); const float nx = (e & 1) ? bfhi(nn[e >> 1]) : bflo(nn[e >> 1]);
                zs[e] = z + mup[col + e] * (pv - z) + mun[col + e] * (nx - z); }
            u32x4 o; o.x = pk2(zs[0], zs[1]); o.y = pk2(zs[2], zs[3]); o.z = pk2(zs[4], zs[5]); o.w = pk2(zs[6], zs[7]);
            *(u32x4*)(F1 + (size_t)row * 2048 + q * 512 + lane * 8) = o;
            if (q == 1) {
                float kr[8], ssq = 0.f;
#pragma unroll
                for (int e = 0; e < 8; ++e) { kr[e] = zs[e] * kk_w[lane * 8 + e]; ssq += kr[e] * kr[e]; }
                ssq = row8_sum(ssq);
                const float inv = 1.f / fmaxf(sqrtf(ssq), 1e-12f);
                u32x4 o2; o2.x = pk2(kr[0] * inv, kr[1] * inv); o2.y = pk2(kr[2] * inv, kr[3] * inv); o2.z = pk2(kr[4] * inv, kr[5] * inv); o2.w = pk2(kr[6] * inv, kr[7] * inv);
                *(u32x4*)(F1 + (size_t)row * 2048 + 1536 + lane * 8) = o2;
            }
        }
        {
            const int col = 1536 + lane * 4;
            const u32x2 c2 = *(const u32x2*)(zc + col);
            u32x2 p2 = (u32x2){0u, 0u}, n2 = (u32x2){0u, 0u};
            if (hasp) p2 = *(const u32x2*)(zc - 1792 + col);
            if (hasn) n2 = *(const u32x2*)(zc + 1792 + col);
            const unsigned cc[2] = {c2.x, c2.y}, pp[2] = {p2.x, p2.y}, nn[2] = {n2.x, n2.y};
            float zs[4];
#pragma unroll
            for (int e = 0; e < 4; ++e) { const float z = (e & 1) ? bfhi(cc[e >> 1]) : bflo(cc[e >> 1]); const float pv = (e & 1) ? bfhi(pp[e >> 1]) : bflo(pp[e >> 1]); const float nx = (e & 1) ? bfhi(nn[e >> 1]) : bflo(nn[e >> 1]);
                const float s = z + mup[col + e] * (pv - z) + mun[col + e] * (nx - z);
                zs[e] = lane < 16 ? tanhf(s) : (lane < 32 ? s : sigmoidf_(s)); }
            u32x2 o; o.x = pk2(zs[0], zs[1]); o.y = pk2(zs[2], zs[3]);
            *(u32x2*)(LIN + (size_t)row * 256 + lane * 4) = o;
        }
    }
}

__device__ __forceinline__ int rw_tok(int dir, int i) { return dir == 0 ? i : (i < NCTX ? NCTX - 1 - i : 8703 - i); }

typedef float f32x2 __attribute__((ext_vector_type(2)));
constexpr int RW_REC = 352;
__device__ __forceinline__ void rw_produce(CParams& p, const bf16_t* f1, const bf16_t* f2, int dir, int rg, int c, int pw, int lane, float ka, float* buf) {
    bf16_t in[8][5]; bf16_t vin[8];
#pragma unroll
    for (int q = 0; q < 8; ++q) { const size_t t = (size_t)rw_tok(dir, c * 32 + pw * 8 + q);
        in[q][0] = f1[t * 2048 + lane]; in[q][1] = f1[t * 2048 + 512 + lane]; in[q][2] = f1[t * 2048 + 1536 + lane]; in[q][3] = f2[t * 2048 + lane]; in[q][4] = f2[t * 2048 + 1024 + lane];
        vin[q] = f1[t * 2048 + 1024 + rg * 8 + (lane & 7)]; }
#pragma unroll
    for (int q = 0; q < 8; ++q) {
        const float r = bf2f(in[q][0]), k = bf2f(in[q][1]), kk = bf2f(in[q][2]), u = bf2f(in[q][3]), a = bf2f(in[q][4]);
        const float w = 1.f - u, key = k * (1.f + (a - 1.f) * ka), kka = kk * a, wr = w * r;
        const float c1 = wave_sum(kka * r), c2 = wave_sum(key * r);
        float* rec = buf + (pw * 8 + q) * RW_REC;
        rec[lane] = kk; rec[64 + lane] = wr; rec[128 + lane] = w; rec[192 + lane] = kka; rec[256 + lane] = key;
        if (lane < 8) rec[320 + lane] = bf2f(vin[q]);
        if (lane == 8) rec[328] = c1;
        if (lane == 9) rec[329] = c2;
    }
}

__device__ __forceinline__ void phase_rw_scan(int l, unsigned char* sm) {
    CParams& p = KPL(); const Ctx cx = mkctx();
    const int tid = cx.tid, lane = tid & 63, wid = __builtin_amdgcn_readfirstlane(tid >> 6);
    const bf16_t* F1 = (const bf16_t*)(p.ws + OFF_F1); const bf16_t* F2 = (const bf16_t*)(p.ws + OFF_Z);
    bf16_t* YRAW = (bf16_t*)(p.ws + OFF_H);
    float* ring = (float*)sm;
    const bool is_scan = wid < 2, is_prod = (wid & 2) != 0;
    const int pw = (wid & 1) + ((wid >> 2) << 1);
    for (int item = cx.bid; item < 256; item += cx.nb) {
        const int chain = item >> 3, rg = item & 7; const int dir = chain >> 4, b = (chain >> 3) & 1, h = chain & 7;
        const float ka = p.in[31][l * 512 + h * 64 + lane];
        const bf16_t* f1 = F1 + (size_t)b * SEQA * 2048 + h * 64; const bf16_t* f2 = F2 + (size_t)b * SEQA * 2048 + dir * 512 + h * 64;
        const int row = rg * 8 + (wid & 1) * 4 + (lane >> 4);
        bf16_t* yr = YRAW + ((size_t)dir * T_TOK + (size_t)b * SEQA) * 512 + h * 64 + row;
        __syncthreads();
        if (is_prod) rw_produce(p, f1, f2, dir, rg, 0, pw, lane, ka, ring);
        __syncthreads();
        f32x2 S01 = (f32x2){0.f, 0.f}, S23 = (f32x2){0.f, 0.f};
        if (is_scan) __builtin_amdgcn_s_setprio(3);
#pragma unroll 1
        for (int c = 0; c < 264; ++c) {
            float* buf = ring + (c & 1) * (32 * RW_REC);
            if (is_prod) { if (c + 1 < 264) rw_produce(p, f1, f2, dir, rg, c + 1, pw, lane, ka, ring + ((c + 1) & 1) * (32 * RW_REC)); }
            else if (is_scan) {
                const float* rb = buf + (lane & 15) * 4;
                const float* vb = buf + 320 + (wid & 1) * 4 + (lane >> 4);
#pragma unroll 1
                for (int hf = 0; hf < 2; ++hf) {
                    float ybuf = 0.f;
#pragma unroll
                    for (int j = 0; j < 16; ++j) {
                        const int s = hf * 16 + j;
                        const f32x4 kk4 = *(const f32x4*)(rb + s * RW_REC), wr4 = *(const f32x4*)(rb + s * RW_REC + 64), w4 = *(const f32x4*)(rb + s * RW_REC + 128);
                        const f32x4 ka4 = *(const f32x4*)(rb + s * RW_REC + 192), ky4 = *(const f32x4*)(rb + s * RW_REC + 256);
                        const float vv = vb[s * RW_REC]; const f32x2 cc = *(const f32x2*)(buf + s * RW_REC + 328);
                        f32x2 p1 = S01 * (f32x2){kk4[0], kk4[1]}; p1 = S23 * (f32x2){kk4[2], kk4[3]} + p1;
                        f32x2 p2 = S01 * (f32x2){wr4[0], wr4[1]}; p2 = S23 * (f32x2){wr4[2], wr4[3]} + p2;
                        const float sk = row16_sum(p1[0] + p1[1]);
                        const float q2 = row16_sum(p2[0] + p2[1]);
                        const f32x2 vv2 = (f32x2){vv, vv}, sk2 = (f32x2){sk, sk};
                        f32x2 t01 = (f32x2){ky4[0], ky4[1]} * vv2; t01 = t01 - (f32x2){ka4[0], ka4[1]} * sk2;
                        f32x2 t23 = (f32x2){ky4[2], ky4[3]} * vv2; t23 = t23 - (f32x2){ka4[2], ka4[3]} * sk2;
                        S01 = S01 * (f32x2){w4[0], w4[1]} + t01; S23 = S23 * (f32x2){w4[2], w4[3]} + t23;
                        const float y = q2 - sk * cc[0] + vv * cc[1];
                        if ((lane & 15) == j) ybuf = y;
                    }
                    yr[(size_t)rw_tok(dir, c * 32 + hf * 16 + (lane & 15)) * 512] = f2bf(ybuf);
                }
            }
            __syncthreads();
        }
        if (is_scan) __builtin_amdgcn_s_setprio(0);
    }
}

__device__ __forceinline__ void phase_rw_out(int l) {
    CParams& p = KPL(); const Ctx cx = mkctx();
    const int lane = cx.tid & 63, gw = cx.bid * 8 + (cx.tid >> 6), nw = cx.nb * 8;
    const bf16_t* F1 = (const bf16_t*)(p.ws + OFF_F1); const bf16_t* F2 = (const bf16_t*)(p.ws + OFF_Z); const bf16_t* GRW = (const bf16_t*)(p.ws + OFF_ZRW);
    const bf16_t* YRAW = (const bf16_t*)(p.ws + OFF_H);
    bf16_t* YC = (bf16_t*)(p.ws + OFF_YC);
    const int c0 = lane * 8;
    float ka[8], rk[8], lg[8], lb[8];
#pragma unroll
    for (int e = 0; e < 8; ++e) { ka[e] = p.in[31][l * 512 + c0 + e]; rk[e] = p.in[32][l * 512 + c0 + e]; lg[e] = p.in[33][l * 512 + c0 + e]; lb[e] = p.in[34][l * 512 + c0 + e]; }
    for (int row = gw; row < T_TOK; row += nw) {
        const u32x4 y0 = *(const u32x4*)(YRAW + (size_t)row * 512 + c0), y1 = *(const u32x4*)(YRAW + ((size_t)T_TOK + row) * 512 + c0);
        const u32x4 r4 = *(const u32x4*)(F1 + (size_t)row * 2048 + c0), k4 = *(const u32x4*)(F1 + (size_t)row * 2048 + 512 + c0), v4 = *(const u32x4*)(F1 + (size_t)row * 2048 + 1024 + c0);
        const u32x4 a04 = *(const u32x4*)(F2 + (size_t)row * 2048 + 1024 + c0), a14 = *(const u32x4*)(F2 + (size_t)row * 2048 + 1536 + c0);
        const u32x4 g4 = *(const u32x4*)(GRW + (size_t)row * 512 + c0);
        const unsigned ya[4] = {y0.x, y0.y, y0.z, y0.w}, yb[4] = {y1.x, y1.y, y1.z, y1.w}, rr[4] = {r4.x, r4.y, r4.z, r4.w}, kx[4] = {k4.x, k4.y, k4.z, k4.w}, vv[4] = {v4.x, v4.y, v4.z, v4.w};
        const unsigned aa[4] = {a04.x, a04.y, a04.z, a04.w}, ab[4] = {a14.x, a14.y, a14.z, a14.w}, gg[4] = {g4.x, g4.y, g4.z, g4.w};
        float y[8], sum = 0.f, bs = 0.f;
#pragma unroll
        for (int e = 0; e < 8; ++e) {
            const int w = e >> 1; const bool hi = e & 1;
            y[e] = (hi ? bfhi(ya[w]) : bflo(ya[w])) + (hi ? bfhi(yb[w]) : bflo(yb[w])); sum += y[e];
            const float r = hi ? bfhi(rr[w]) : bflo(rr[w]), k = hi ? bfhi(kx[w]) : bflo(kx[w]), a0 = hi ? bfhi(aa[w]) : bflo(aa[w]), a1 = hi ? bfhi(ab[w]) : bflo(ab[w]);
            bs += r * k * (2.f + (a0 + a1 - 2.f) * ka[e]) * rk[e];
        }
        sum = row8_sum(sum); bs = row8_sum(bs);
        const float mu = sum * (1.f / 64.f);
        float var = 0.f;
#pragma unroll
        for (int e = 0; e < 8; ++e) { const float d = y[e] - mu; var += d * d; }
        var = row8_sum(var) * (1.f / 64.f);
        const float rstd = rsqrtf(var + 64e-5f);
        float o[8];
#pragma unroll
        for (int e = 0; e < 8; ++e) { const int w = e >> 1; const bool hi = e & 1;
            const float v = hi ? bfhi(vv[w]) : bflo(vv[w]), g = hi ? bfhi(gg[w]) : bflo(gg[w]);
            o[e] = ((y[e] - mu) * rstd * lg[e] + lb[e] + bs * v) * g; }
        u32x4 o4; o4.x = pk2(o[0], o[1]); o4.y = pk2(o[2], o[3]); o4.z = pk2(o[4], o[5]); o4.w = pk2(o[6], o[7]);
        *(u32x4*)(YC + (size_t)row * 512 + c0) = o4;
    }
}

__device__ __forceinline__ void phase_final() {
    CParams& p = KPL(); const Ctx cx = mkctx();
    const int lane = cx.tid & 63, gw = cx.bid * 8 + (cx.tid >> 6), nw = cx.nb * 8;
    const float* X = (const float*)(p.ws + OFF_X);
    for (int r = gw; r < 2 * 8192; r += nw) {
        const int b = r >> 13, t = r & 8191;
        const float* src = X + ((size_t)b * SEQA + NCTX + t) * 1024;
        f32x4 v[4]; float ss = 0.f;
#pragma unroll
        for (int i = 0; i < 4; ++i) { v[i] = *(const f32x4*)(src + (lane + 64 * i) * 4); ss += v[i][0] * v[i][0] + v[i][1] * v[i][1] + v[i][2] * v[i][2] + v[i][3] * v[i][3]; }
        ss = wave_sum(ss);
        const float inv = rsqrtf(ss * (1.f / 1024.f) + 1e-6f);
#pragma unroll
        for (int i = 0; i < 4; ++i) { const int c = (lane + 64 * i) * 4; const f32x4 g4 = *(const f32x4*)(p.in[41] + c);
            *(f32x4*)(p.out + (size_t)r * 1024 + c) = v[i] * inv * g4; }
    }
}

#ifndef PHM
#define PHM 0xFFFFFFFFull
#endif
#ifndef PHR
#define PHR 0ull
#endif
#ifndef SYNCREP
#define SYNCREP 1
#endif
template <int WHICH>
__device__ __forceinline__ void gemm_stage(int l, LAS unsigned char* lds) {
    CParams& p = KPL(); const Ctx cx = mkctx();
    unsigned char* ws = p.ws;
    float* X = (float*)(ws + OFF_X); bf16_t* H = (bf16_t*)(ws + OFF_H); bf16_t* ZA = (bf16_t*)(ws + OFF_Z); bf16_t* ZRW = (bf16_t*)(ws + OFF_ZRW);
    bf16_t* W = (bf16_t*)(ws + OFF_W);
    const float* MODL = (const float*)(ws + OFF_MOD) + (size_t)l * 3 * 6144;
    if constexpr (WHICH == 0) run_gemm(cx, lds, H, W + W_MIX / 2, 4096, 1024, FInproj{ZA, (float*)(ws + OFF_MLG), ZRW});
    else if constexpr (WHICH == 1) run_gemm(cx, lds, (const bf16_t*)(ws + OFF_ZG), W + W_GLU / 2, 512, 512, FGlu{(const bf16_t*)(ws + OFF_ZG), p.in[18] + l * 512, (bf16_t*)(ws + OFF_YA)});
    else if constexpr (WHICH == 2) run_gemm_epi(cx, lds, (const bf16_t*)(ws + OFF_LORAIN), W + W_LORA / 2, 2560, 256, EpiLora{p.in[25] + l * 1024, p.in[27] + l * 1024, ZA, ZRW});
    else if constexpr (WHICH == 3) run_gemm(cx, lds, H, W + W_GATE / 2, 3072, 1024, FGate{ZA});
    else if constexpr (WHICH == 4) run_gemm(cx, lds, (const bf16_t*)(ws + OFF_YA), W + W_PA / 2, 1024, 512, FMerge<0>{ZA, (float*)(ws + OFF_F1), H});
    else if constexpr (WHICH == 5) run_gemm(cx, lds, (const bf16_t*)(ws + OFF_YB), W + W_PB / 2, 1024, 512, FMerge<1>{ZA, (float*)(ws + OFF_F1), H});
    else if constexpr (WHICH == 6) run_gemm(cx, lds, (const bf16_t*)(ws + OFF_YC), W + W_PC / 2, 1024, 512, FMerge<2>{ZA, (float*)(ws + OFF_F1), H});
    else if constexpr (WHICH == 7) run_gemm(cx, lds, H, W + W_OUT / 2, 1024, 1024, FResid{X, MODL, 2});
    else if constexpr (WHICH == 8) run_gemm(cx, lds, H, W + W_1 / 2, 4096, 1024, FMlp1{ZA});
    else run_gemm(cx, lds, ZA, W + W_2 / 2, 1024, 4096, FResid{X, MODL, 5});
}

template <int l>
__device__ __forceinline__ void run_layer(cg::grid_group& grid, LAS unsigned char* lds, float* smf, unsigned char* smem) {
        if constexpr ((PHM >> 1) & 1) { phase_wconv(l, smf); if constexpr ((PHR >> 1) & 1) { __syncthreads(); phase_wconv(l, smf); } }
        for (int sr = 0; sr < SYNCREP; ++sr) grid.sync();
        if constexpr ((PHM >> 2) & 1) { phase_norm(l, 0, l == 0); if constexpr ((PHR >> 2) & 1) { __syncthreads(); phase_norm(l, 0, l == 0); } }
        for (int sr = 0; sr < SYNCREP; ++sr) grid.sync();
        if constexpr ((PHM >> 3) & 1) { gemm_stage<0>(l, lds); if constexpr ((PHR >> 3) & 1) { __syncthreads(); gemm_stage<0>(l, lds); } }
        for (int sr = 0; sr < SYNCREP; ++sr) grid.sync();
        if constexpr ((PHM >> 4) & 1) { phase_s5_local(l); if constexpr ((PHR >> 4) & 1) { __syncthreads(); phase_s5_local(l); } }
        if constexpr ((PHM >> 5) & 1) { phase_ml_conv(l); if constexpr ((PHR >> 5) & 1) { __syncthreads(); phase_ml_conv(l); } }
        for (int sr = 0; sr < SYNCREP; ++sr) grid.sync();
        if constexpr ((PHM >> 6) & 1) { phase_s5_carry(l); if constexpr ((PHR >> 6) & 1) { __syncthreads(); phase_s5_carry(l); } }
        if constexpr ((PHM >> 7) & 1) { phase_ml_local(l, smem); if constexpr ((PHR >> 7) & 1) { __syncthreads(); phase_ml_local(l, smem); } }
        for (int sr = 0; sr < SYNCREP; ++sr) grid.sync();
        if constexpr ((PHM >> 8) & 1) { phase_s5_final(l, smf); if constexpr ((PHR >> 8) & 1) { __syncthreads(); phase_s5_final(l, smf); } }
        if constexpr ((PHM >> 9) & 1) { phase_ml_carry(); if constexpr ((PHR >> 9) & 1) { __syncthreads(); phase_ml_carry(); } }
        for (int sr = 0; sr < SYNCREP; ++sr) grid.sync();
        if constexpr ((PHM >> 10) & 1) { gemm_stage<1>(l, lds); if constexpr ((PHR >> 10) & 1) { __syncthreads(); gemm_stage<1>(l, lds); } }
        if constexpr ((PHM >> 11) & 1) { phase_ml_out(l, smem); if constexpr ((PHR >> 11) & 1) { __syncthreads(); phase_ml_out(l, smem); } }
        for (int sr = 0; sr < SYNCREP; ++sr) grid.sync();
        if constexpr ((PHM >> 12) & 1) { phase_rw_feat(l); if constexpr ((PHR >> 12) & 1) { __syncthreads(); phase_rw_feat(l); } }
        for (int sr = 0; sr < SYNCREP; ++sr) grid.sync();
        if constexpr ((PHM >> 13) & 1) { gemm_stage<2>(l, lds); if constexpr ((PHR >> 13) & 1) { __syncthreads(); gemm_stage<2>(l, lds); } }
        for (int sr = 0; sr < SYNCREP; ++sr) grid.sync();
        if constexpr ((PHM >> 14) & 1) { phase_rw_scan(l, smem); if constexpr ((PHR >> 14) & 1) { __syncthreads(); phase_rw_scan(l, smem); } }
        for (int sr = 0; sr < SYNCREP; ++sr) grid.sync();
        if constexpr ((PHM >> 15) & 1) { phase_rw_out(l); if constexpr ((PHR >> 15) & 1) { __syncthreads(); phase_rw_out(l); } }
        for (int sr = 0; sr < SYNCREP; ++sr) grid.sync();
        if constexpr ((PHM >> 16) & 1) { phase_norm(l, 0, false); if constexpr ((PHR >> 16) & 1) { __syncthreads(); phase_norm(l, 0, false); } }
        for (int sr = 0; sr < SYNCREP; ++sr) grid.sync();
        if constexpr ((PHM >> 17) & 1) { gemm_stage<3>(l, lds); if constexpr ((PHR >> 17) & 1) { __syncthreads(); gemm_stage<3>(l, lds); } }
        for (int sr = 0; sr < SYNCREP; ++sr) grid.sync();
        if constexpr ((PHM >> 18) & 1) { gemm_stage<4>(l, lds); if constexpr ((PHR >> 18) & 1) { __syncthreads(); gemm_stage<4>(l, lds); } }
        for (int sr = 0; sr < SYNCREP; ++sr) grid.sync();
        if constexpr ((PHM >> 19) & 1) { gemm_stage<5>(l, lds); if constexpr ((PHR >> 19) & 1) { __syncthreads(); gemm_stage<5>(l, lds); } }
        for (int sr = 0; sr < SYNCREP; ++sr) grid.sync();
        if constexpr ((PHM >> 20) & 1) { gemm_stage<6>(l, lds); if constexpr ((PHR >> 20) & 1) { __syncthreads(); gemm_stage<6>(l, lds); } }
        for (int sr = 0; sr < SYNCREP; ++sr) grid.sync();
        if constexpr ((PHM >> 21) & 1) { gemm_stage<7>(l, lds); if constexpr ((PHR >> 21) & 1) { __syncthreads(); gemm_stage<7>(l, lds); } }
        for (int sr = 0; sr < SYNCREP; ++sr) grid.sync();
        if constexpr ((PHM >> 22) & 1) { phase_norm(l, 1, false); if constexpr ((PHR >> 22) & 1) { __syncthreads(); phase_norm(l, 1, false); } }
        for (int sr = 0; sr < SYNCREP; ++sr) grid.sync();
        if constexpr ((PHM >> 23) & 1) { gemm_stage<8>(l, lds); if constexpr ((PHR >> 23) & 1) { __syncthreads(); gemm_stage<8>(l, lds); } }
        for (int sr = 0; sr < SYNCREP; ++sr) grid.sync();
        if constexpr ((PHM >> 24) & 1) { gemm_stage<9>(l, lds); if constexpr ((PHR >> 24) & 1) { __syncthreads(); gemm_stage<9>(l, lds); } }
        for (int sr = 0; sr < SYNCREP; ++sr) grid.sync();
    }

__global__ void __launch_bounds__(512, 2) fwd_megakernel(Params p_unused) {
    extern __shared__ __attribute__((aligned(16))) unsigned char smem[];
    cg::grid_group grid = cg::this_grid();
    LAS unsigned char* lds = (LAS unsigned char*)smem;
    float* smf = (float*)smem;

    if constexpr ((PHM >> 0) & 1) { phase_mod(smf); phase_s5_params(); if constexpr ((PHR >> 0) & 1) { __syncthreads(); phase_mod(smf); phase_s5_params(); } }
    run_layer<0>(grid, lds, smf, smem);
    run_layer<1>(grid, lds, smf, smem);
    run_layer<2>(grid, lds, smf, smem);
    run_layer<3>(grid, lds, smf, smem);
    phase_final();
}

extern "C" void kernel_launch(void* const* d_in, const int* in_sizes, int n_in, void* d_out, int out_size, void* d_ws, size_t ws_size, hipStream_t stream) {
    static int grid_blocks = 0;
    if (grid_blocks == 0) {
        if (n_in != 42 || ws_size < WS_END) { fprintf(stderr, "kernel_launch: unexpected n_in %d / ws_size %zu\n", n_in, ws_size); grid_blocks = -1; return; }
        int dev = 0, cus = 0, per_cu = 0;
        (void)hipGetDevice(&dev);
        (void)hipDeviceGetAttribute(&cus, hipDeviceAttributeMultiprocessorCount, dev);
        if (hipFuncSetAttribute((const void*)fwd_megakernel, hipFuncAttributeMaxDynamicSharedMemorySize, LDS_BYTES) != hipSuccess) { fprintf(stderr, "kernel_launch: hipFuncSetAttribute failed\n"); grid_blocks = -1; return; }
        if (hipOccupancyMaxActiveBlocksPerMultiprocessor(&per_cu, (const void*)fwd_megakernel, 512, LDS_BYTES) != hipSuccess || per_cu < 1) { fprintf(stderr, "kernel_launch: occupancy query says %d\n", per_cu); per_cu = 1; (void)hipGetLastError(); }
        grid_blocks = cus * 1;
    }
    if (grid_blocks < 0) return;
    Params p{};
    for (int i = 0; i < 42; ++i) p.in[i] = (const float*)d_in[i];
    p.out = (float*)d_out; p.ws = (unsigned char*)d_ws;
    void* args[] = {&p};
    hipError_t e = hipLaunchCooperativeKernel((const void*)fwd_megakernel, dim3(grid_blocks), dim3(512), args, LDS_BYTES, stream);
    if (e != hipSuccess) fprintf(stderr, "cooperative launch failed: %s (grid %d)\n", hipGetErrorString(e), grid_blocks);
}
```

```cpp
#include <hip/hip_runtime.h>
#include <hip/hip_cooperative_groups.h>
#include <cstdio>
namespace cg = cooperative_groups;

#define LAS __attribute__((address_space(3)))
typedef unsigned short bf16_t;
typedef short bf16x8 __attribute__((ext_vector_type(8)));
typedef float f32x4 __attribute__((ext_vector_type(4)));
typedef unsigned u32x4 __attribute__((ext_vector_type(4)));
typedef unsigned u32x2 __attribute__((ext_vector_type(2)));

constexpr int T_TOK = 16896, SEQA = 8448, NCTX = 256;
constexpr int NLAYER = 4;
constexpr int LDS_BYTES = 143360;
constexpr size_t OFF_X = 0;
constexpr size_t OFF_H = 69206016;
constexpr size_t OFF_Z = 103809024;
constexpr size_t OFF_ZRW = OFF_Z + 69206016;
constexpr size_t OFF_MLG = 242221056;
constexpr size_t OFF_W = 243302400;
constexpr size_t OFF_YA = 281837568;
constexpr size_t OFF_YB = 299139072;
constexpr size_t OFF_YC = 316440576;
constexpr size_t OFF_F1 = 333742080;
constexpr size_t OFF_MOD = 402948096;
constexpr size_t OFF_S5P = 403243008;
constexpr size_t OFF_MLS = OFF_S5P + 4 * 589824;
constexpr size_t OFF_R2 = OFF_MLS + 16384;
constexpr size_t OFF_BAR = OFF_R2 + 34603008;
constexpr size_t WS_END = OFF_BAR + 16384;
constexpr size_t OFF_CLOC = OFF_F1;
constexpr size_t OFF_S5ST = OFF_F1 + 34873344;
constexpr size_t OFF_QKC = OFF_F1 + 43524096;
constexpr size_t OFF_ZG = OFF_R2;
constexpr size_t OFF_LORAIN = OFF_R2 + 17301504;
constexpr size_t W_MIX = 0, W_GATE = 8388608, W_GLU = 14680064, W_LORA = 15204352, W_PA = 16515072, W_PB = 17563648, W_PC = 18612224, W_OUT = 19660800, W_1 = 21757952, W_2 = 30146560;

struct Params {
    const float* in[42];
    float* out;
    unsigned char* ws;
};

typedef const __attribute__((address_space(4))) Params CParams;
__device__ __forceinline__ CParams& KPL() {
    unsigned long long a = (unsigned long long)__builtin_amdgcn_kernarg_segment_ptr();
    asm volatile("" : "+s"(a));
    return *(CParams*)a;
}
struct Ctx { int tid, bid, nb; };
__device__ __forceinline__ Ctx mkctx() { Ctx c; c.tid = threadIdx.x; c.bid = blockIdx.x; c.nb = gridDim.x; asm volatile("" : "+v"(c.tid), "+s"(c.bid), "+s"(c.nb)); return c; }
__device__ __forceinline__ float bf2f(unsigned v) { return __uint_as_float(v << 16); }
__device__ __forceinline__ float bflo(unsigned w) { return __uint_as_float(w << 16); }
__device__ __forceinline__ float bfhi(unsigned w) { return __uint_as_float(w & 0xffff0000u); }
__device__ __forceinline__ bf16_t f2bf(float f) { unsigned u = __float_as_uint(f); u += 0x7FFFu + ((u >> 16) & 1u); return (bf16_t)(u >> 16); }
__device__ __forceinline__ unsigned pk2(float lo, float hi) { return (unsigned)f2bf(lo) | ((unsigned)f2bf(hi) << 16); }
__device__ __forceinline__ void store4bf(bf16_t* p, f32x4 v) { u32x2 r; r.x = pk2(v[0], v[1]); r.y = pk2(v[2], v[3]); *(u32x2*)p = r; }
__device__ __forceinline__ float sigmoidf_(float x) { return 1.f / (1.f + __expf(-x)); }

#define DPP_F(x, ctrl, rmask) __int_as_float(__builtin_amdgcn_update_dpp(0, __float_as_int(x), ctrl, rmask, 0xF, false))
__device__ __forceinline__ float row8_sum(float x) {
    x += DPP_F(x, 0xB1, 0xF); x += DPP_F(x, 0x4E, 0xF); x += DPP_F(x, 0x141, 0xF); return x;
}
__device__ __forceinline__ float row16_sum(float x) {
    x += DPP_F(x, 0xB1, 0xF); x += DPP_F(x, 0x4E, 0xF); x += DPP_F(x, 0x141, 0xF); x += DPP_F(x, 0x140, 0xF); return x;
}
__device__ __forceinline__ float wave_sum(float x) {
    x = row16_sum(x);
    x += DPP_F(x, 0x142, 0xA);
    x += DPP_F(x, 0x143, 0xC);
    return __int_as_float(__builtin_amdgcn_readlane(__float_as_int(x), 63));
}

namespace pg8 {
constexpr int BM = 256, BK = 64, HALF = 128, HTB = HALF * BK * 2, NXCD = 8, WGM = 8;
__device__ __forceinline__ int lds_byte(int r, int c) { const int st = (r >> 4) * 2 + (c >> 5), rr = r & 15, cc = c & 31, ob = rr * 64 + cc * 2; return st * 1024 + (ob ^ (((ob >> 9) & 1) << 5)); }
__device__ __forceinline__ void stage_rc(int b, int& R, int& C) { const int st = b / 1024, sb = b % 1024, swz = sb ^ (((sb >> 9) & 1) << 5); R = (st >> 1) * 16 + swz / 64; C = (st & 1) * 32 + (swz % 64) / 2; }
struct Unit { int pm, pn; };
struct Gemm { const bf16_t* A; const bf16_t* Bt; int M, N, K; };
struct StaticOrder {
    int nM, nN, nwg, G, c;
    __device__ void init(int M, int N, int G_, int c_) { nM = M / BM; nN = N / BM; nwg = nM * nN; G = G_; c = c_; }
    __device__ bool next(int i, Unit& u) const {
        const long L = (long)i * G + c; if (L >= nwg) return false;
        int wgid = (int)L; { const int q = nwg / NXCD, r = nwg % NXCD, xcd = wgid % NXCD, off = wgid / NXCD; wgid = (xcd < r ? xcd * (q + 1) : r * (q + 1) + (xcd - r) * q) + off; }
        const int nig = WGM * nN, gid = wgid / nig, fm = gid * WGM, gsz = (nM - fm) < WGM ? (nM - fm) : WGM;
        u.pm = fm + ((wgid % nig) % gsz); u.pn = (wgid % nig) / gsz; return true;
    }
};

template <class Epi>
__device__ __forceinline__ void gemm_phase(int tid_in, LAS unsigned char* lds, const Gemm g, const StaticOrder& S, const Epi& E) {
    const int tid = tid_in, wid = __builtin_amdgcn_readfirstlane(tid >> 6), lane = tid & 63, wr = wid >> 2, wc = wid & 3, fr = lane & 15, fq = lane >> 4;
    const int K = g.K, nt = K / BK;
    unsigned voffA[2], voffB[2];
#pragma unroll
    for (int i = 0; i < 2; ++i) { int R, C; stage_rc(tid * 16 + i * 8192, R, C); voffA[i] = (unsigned)(R * K + C) * 2u; voffB[i] = voffA[i]; }
    const size_t kstep = (size_t)(BK * 2);
    const size_t hstep = (size_t)HALF * K * 2;
    const size_t tstep = 2 * hstep;
    const unsigned ldsw = (unsigned)wid * 1024u;
    const int aoff = lds_byte(wr * 64 + fr, fq * 8), boff = lds_byte(wc * 32 + fr, fq * 8);
#define PG8_SA(b, h) (((b) * 2 + (h)) * HTB)
#define PG8_SB(b, h) ((4 + (b) * 2 + (h)) * HTB)
#define PG8_STAGE(bufoff, gbase, voff) do { _Pragma("unroll") for (int _i = 0; _i < 2; ++_i) \
        __builtin_amdgcn_global_load_lds((const unsigned*)((const char*)(gbase) + (voff)[_i]), (LAS unsigned*)(lds + (bufoff) + ldsw + _i * 8192), 16, 0, 0); } while (0)
#define PG8_LDA(dst, b, h) do { _Pragma("unroll") for (int m = 0; m < 4; ++m) _Pragma("unroll") for (int k = 0; k < 2; ++k) dst[m][k] = *(const LAS bf16x8*)(lds + PG8_SA(b, h) + aoff + m * 2048 + k * 1024); } while (0)
#define PG8_LDB(dst, b, h) do { _Pragma("unroll") for (int n = 0; n < 2; ++n) _Pragma("unroll") for (int k = 0; k < 2; ++k) dst[n][k] = *(const LAS bf16x8*)(lds + PG8_SB(b, h) + boff + n * 2048 + k * 1024); } while (0)
#define PG8_MMA(ai, bj, At, Bt) do { __builtin_amdgcn_s_setprio(1); _Pragma("unroll") for (int m = 0; m < 4; ++m) _Pragma("unroll") for (int n = 0; n < 2; ++n) _Pragma("unroll") for (int k = 0; k < 2; ++k) \
        acc[ai][bj][m][n] = __builtin_amdgcn_mfma_f32_16x16x32_bf16(Bt[n][k], At[m][k], acc[ai][bj][m][n], 0, 0, 0); __builtin_amdgcn_s_setprio(0); } while (0)
#define PG8_WAIT_V(n) asm volatile("s_waitcnt vmcnt(" #n ")" ::: "memory")
#define PG8_WAIT_L(n) asm volatile("s_waitcnt lgkmcnt(" #n ")" ::: "memory")
#define PG8_BAR __builtin_amdgcn_s_barrier()
#define PG8_SCHED __builtin_amdgcn_sched_barrier(0)
    Unit cur, nxt; int ui = 0;
    if (!S.next(0, cur)) return;
    f32x4 acc[2][2][4][2];
#pragma unroll
    for (int a = 0; a < 2; ++a)
#pragma unroll
        for (int b = 0; b < 2; ++b)
#pragma unroll
            for (int m = 0; m < 4; ++m)
#pragma unroll
                for (int n = 0; n < 2; ++n) acc[a][b][m][n] = (f32x4){0.f, 0.f, 0.f, 0.f};
    bf16x8 At[4][2], B0[2][2], B1[2][2];
    const char* cA = (const char*)g.A + (size_t)cur.pm * tstep; const char* cB = (const char*)g.Bt + (size_t)cur.pn * tstep;
    PG8_STAGE(PG8_SB(0, 0), cB, voffB); PG8_STAGE(PG8_SA(0, 0), cA, voffA); PG8_STAGE(PG8_SB(0, 1), cB + hstep, voffB); PG8_STAGE(PG8_SA(0, 1), cA + hstep, voffA);
    if (wr == 1) PG8_BAR;
    PG8_WAIT_V(4); PG8_BAR;
    PG8_STAGE(PG8_SB(1, 0), cB + kstep, voffB); PG8_STAGE(PG8_SA(1, 0), cA + kstep, voffA); PG8_STAGE(PG8_SB(1, 1), cB + hstep + kstep, voffB);
    PG8_WAIT_V(6); PG8_BAR;
    for (;;) {
        const bool has_next = S.next(ui + 1, nxt);
        const char* nA = has_next ? (const char*)g.A + (size_t)nxt.pm * tstep : cA; const char* nB = has_next ? (const char*)g.Bt + (size_t)nxt.pn * tstep : cB;
        for (int t = 0; t < nt; t += 2) {
            const bool last = (t == nt - 2);
            const char* a1 = cA + (size_t)(t + 1) * kstep;
            const char* a2 = last ? nA : cA + (size_t)(t + 2) * kstep; const char* b2 = last ? nB : cB + (size_t)(t + 2) * kstep;
            const char* a3 = a2 + kstep; const char* b3 = b2 + kstep;
            PG8_LDB(B0, 0, 0); PG8_SCHED; PG8_LDA(At, 0, 0); PG8_STAGE(PG8_SA(1, 1), a1 + hstep, voffA);
            PG8_WAIT_L(8); PG8_BAR; PG8_WAIT_L(0); PG8_MMA(0, 0, At, B0); PG8_BAR; PG8_SCHED;
            PG8_LDB(B1, 0, 1); PG8_STAGE(PG8_SB(0, 0), b2, voffB);
            PG8_BAR; PG8_WAIT_L(0); PG8_MMA(0, 1, At, B1); PG8_BAR;
            PG8_LDA(At, 0, 1); PG8_STAGE(PG8_SA(0, 0), a2, voffA);
            PG8_BAR; PG8_WAIT_L(0); PG8_MMA(1, 0, At, B0); PG8_BAR; PG8_SCHED;
            PG8_STAGE(PG8_SB(0, 1), b2 + hstep, voffB);
            PG8_WAIT_V(6); PG8_BAR; PG8_MMA(1, 1, At, B1); PG8_BAR;
            PG8_LDB(B0, 1, 0); PG8_SCHED; PG8_LDA(At, 1, 0); PG8_STAGE(PG8_SA(0, 1), a2 + hstep, voffA);
            PG8_WAIT_L(8); PG8_BAR; PG8_WAIT_L(0); PG8_MMA(0, 0, At, B0); PG8_BAR; PG8_SCHED;
            PG8_LDB(B1, 1, 1); PG8_STAGE(PG8_SB(1, 0), b3, voffB);
            PG8_BAR; PG8_WAIT_L(0); PG8_MMA(0, 1, At, B1); PG8_BAR;
            PG8_LDA(At, 1, 1); PG8_STAGE(PG8_SA(1, 0), a3, voffA);
            PG8_BAR; PG8_WAIT_L(0); PG8_MMA(1, 0, At, B0); PG8_BAR; PG8_SCHED;
            PG8_STAGE(PG8_SB(1, 1), b3 + hstep, voffB);
            PG8_WAIT_V(6); PG8_BAR; PG8_MMA(1, 1, At, B1); PG8_BAR;
        }
        E(acc, cur, wr, wc, fr, fq);
        if (!has_next) break;
#pragma unroll
        for (int a = 0; a < 2; ++a)
#pragma unroll
            for (int b = 0; b < 2; ++b)
#pragma unroll
                for (int m = 0; m < 4; ++m)
#pragma unroll
                    for (int n = 0; n < 2; ++n) acc[a][b][m][n] = (f32x4){0.f, 0.f, 0.f, 0.f};
        cur = nxt; cA = nA; cB = nB; ++ui;
    }
    PG8_WAIT_V(0);
    if (wr == 0) PG8_BAR;
    PG8_BAR;
#undef PG8_SA
#undef PG8_SB
#undef PG8_STAGE
#undef PG8_LDA
#undef PG8_LDB
#undef PG8_MMA
#undef PG8_WAIT_V
#undef PG8_WAIT_L
#undef PG8_BAR
#undef PG8_SCHED
}

template <class F> struct EpiT {
    F f;
    __device__ __forceinline__ void operator()(const f32x4 (&acc)[2][2][4][2], const Unit& u, int wr, int wc, int fr, int fq) const {
        const int row0 = u.pm * BM + wr * 64 + fr, col0 = u.pn * BM + wc * 32 + 4 * fq;
#pragma unroll
        for (int ai = 0; ai < 2; ++ai)
#pragma unroll
            for (int m = 0; m < 4; ++m) {
                const int row = row0 + ai * HALF + m * 16;
#pragma unroll
                for (int bj = 0; bj < 2; ++bj)
#pragma unroll
                    for (int n = 0; n < 2; ++n) f(row, col0 + bj * HALF + n * 16, acc[ai][bj][m][n]);
            }
    }
};
}

template <class F>
__device__ __forceinline__ void run_gemm(const Ctx& cx, LAS unsigned char* lds, const bf16_t* A, const bf16_t* Bt, int N, int K, const F& f) {
    pg8::Gemm g; g.A = A; g.Bt = Bt; g.M = T_TOK; g.N = N; g.K = K;
    pg8::StaticOrder S; S.init(T_TOK, N, cx.nb, cx.bid);
    pg8::EpiT<F> E{f};
    pg8::gemm_phase(cx.tid, lds, g, S, E);
}

template <class E>
__device__ __forceinline__ void run_gemm_epi(const Ctx& cx, LAS unsigned char* lds, const bf16_t* A, const bf16_t* Bt, int N, int K, const E& e) {
    pg8::Gemm g; g.A = A; g.Bt = Bt; g.M = T_TOK; g.N = N; g.K = K;
    pg8::StaticOrder S; S.init(T_TOK, N, cx.nb, cx.bid);
    pg8::gemm_phase(cx.tid, lds, g, S, e);
}
__device__ __forceinline__ int row_vec(int row) { const int b = row >= SEQA ? 1 : 0; const int t = row - b * SEQA; return t < NCTX ? 2 : b; }

struct FInproj { bf16_t* za; float* mlg; bf16_t* zrw;
    __device__ __forceinline__ void operator()(int row, int col, f32x4 v) const {
        if (col < 2048) store4bf(za + (size_t)row * 2048 + col, v);
        else if (col < 2064) *(f32x4*)(mlg + (size_t)row * 16 + (col - 2048)) = v;
        else if (col < 3856) store4bf(zrw + (size_t)row * 1792 + (col - 2064), v);
    } };
struct FGlu { const bf16_t* zg; const float* bglu; bf16_t* ya;
    __device__ __forceinline__ void operator()(int row, int col, f32x4 v) const {
        const u32x2 z = *(const u32x2*)(zg + (size_t)row * 512 + col); const f32x4 b = *(const f32x4*)(bglu + col);
        f32x4 o; o[0] = bflo(z.x) * sigmoidf_(v[0] + b[0]); o[1] = bfhi(z.x) * sigmoidf_(v[1] + b[1]); o[2] = bflo(z.y) * sigmoidf_(v[2] + b[2]); o[3] = bfhi(z.y) * sigmoidf_(v[3] + b[3]);
        store4bf(ya + (size_t)row * 512 + col, o);
    } };
struct EpiLora { const float* w0; const float* a0; bf16_t* f2; bf16_t* grw;
    __device__ __forceinline__ void operator()(const f32x4 (&acc)[2][2][4][2], const pg8::Unit& u, int wr, int wc, int fr, int fq) const {
        const int row0 = u.pm * 256 + wr * 64 + fr, col0 = u.pn * 256 + wc * 32 + 4 * fq;
        const int pn = __builtin_amdgcn_readfirstlane(u.pn);
        if (pn < 8) {
            const float* bias = pn < 4 ? w0 : a0 - 1024;
#pragma unroll
            for (int bj = 0; bj < 2; ++bj)
#pragma unroll
                for (int n = 0; n < 2; ++n) {
                    const int col = col0 + bj * 128 + n * 16;
                    const f32x4 b = *(const f32x4*)(bias + col);
#pragma unroll
                    for (int ai = 0; ai < 2; ++ai)
#pragma unroll
                        for (int m = 0; m < 4; ++m) {
                            const int row = row0 + ai * 128 + m * 16; f32x4 o;
#pragma unroll
                            for (int e = 0; e < 4; ++e) { const float s = sigmoidf_(acc[ai][bj][m][n][e] + b[e]); o[e] = pn < 4 ? 1.f - __expf(-0.60653065971f * s) : s; }
                            store4bf(f2 + (size_t)row * 2048 + col, o);
                        }
                }
        } else {
#pragma unroll
            for (int ai = 0; ai < 2; ++ai)
#pragma unroll
                for (int m = 0; m < 4; ++m) { const int row = row0 + ai * 128 + m * 16;
#pragma unroll
                    for (int bj = 0; bj < 2; ++bj)
#pragma unroll
                        for (int n = 0; n < 2; ++n) store4bf(grw + (size_t)row * 512 + (col0 + bj * 128 + n * 16 - 2048), acc[ai][bj][m][n]); }
        }
    } };
struct FGate { bf16_t* g;
    __device__ __forceinline__ void operator()(int row, int col, f32x4 v) const {
        f32x4 o; o[0] = sigmoidf_(v[0]); o[1] = sigmoidf_(v[1]); o[2] = sigmoidf_(v[2]); o[3] = sigmoidf_(v[3]);
        store4bf(g + (size_t)row * 3072 + col, o);
    } };
template <int J> struct FMerge { const bf16_t* g; float* y32; bf16_t* ybf;
    __device__ __forceinline__ void operator()(int row, int col, f32x4 v) const {
        const u32x2 z = *(const u32x2*)(g + (size_t)row * 3072 + J * 1024 + col);
        f32x4 o; o[0] = bflo(z.x) * v[0]; o[1] = bfhi(z.x) * v[1]; o[2] = bflo(z.y) * v[2]; o[3] = bfhi(z.y) * v[3];
        float* yp = y32 + (size_t)row * 1024 + col;
        if (J == 0) *(f32x4*)yp = o;
        else if (J == 1) { f32x4 t = *(f32x4*)yp; *(f32x4*)yp = t + o; }
        else { f32x4 t = *(f32x4*)yp; store4bf(ybf + (size_t)row * 1024 + col, t + o); }
    } };
struct FResid { float* x; const float* modl; int chunk;
    __device__ __forceinline__ void operator()(int row, int col, f32x4 v) const {
        const f32x4 mg = *(const f32x4*)(modl + row_vec(row) * 6144 + chunk * 1024 + col);
        float* xp = x + (size_t)row * 1024 + col; f32x4 t = *(f32x4*)xp; *(f32x4*)xp = t + mg * v;
    } };
struct FMlp1 { bf16_t* hid;
    __device__ __forceinline__ void operator()(int row, int col, f32x4 v) const {
        f32x4 o;
#pragma unroll
        for (int e = 0; e < 4; ++e) { const float r = fmaxf(v[e], 0.f); o[e] = r * r; }
        store4bf(hid + (size_t)row * 4096 + col, o);
    } };

__device__ __forceinline__ void phase_mod(float* smf) {
    CParams& p = KPL(); const Ctx cx = mkctx();
    const int tid = cx.tid, lane = tid & 63, wid = tid >> 6;
    float* sc = smf; float* red = smf + 3072;
    float* MOD = (float*)(p.ws + OFF_MOD);
    for (int i = tid; i < 3072; i += 512) { const int v = i >> 10, j = i & 1023; const float c = v < 2 ? p.in[1][v * 1024 + j] : p.in[3][j]; sc[i] = c / (1.f + expf(-c)); }
    __syncthreads();
    for (int item = cx.bid; item < 4 * 96; item += cx.nb) {
        const int l = item / 96, jt = item % 96, j = jt * 64 + lane;
        const float* w = p.in[4] + (size_t)l * 1024 * 6144 + j;
        float a0 = 0.f, a1 = 0.f, a2 = 0.f;
#pragma unroll 8
        for (int i = wid * 128; i < wid * 128 + 128; ++i) { const float wv = w[(size_t)i * 6144]; a0 += sc[i] * wv; a1 += sc[1024 + i] * wv; a2 += sc[2048 + i] * wv; }
        red[(wid * 3 + 0) * 64 + lane] = a0; red[(wid * 3 + 1) * 64 + lane] = a1; red[(wid * 3 + 2) * 64 + lane] = a2;
        __syncthreads();
        if (tid < 192) { const int v = tid >> 6; float s = 0.f;
            for (int w8 = 0; w8 < 8; ++w8) s += red[(w8 * 3 + v) * 64 + lane];
            MOD[(l * 3 + v) * 6144 + j] = s + p.in[5][l * 6144 + j]; }
        __syncthreads();
    }
}

__device__ __forceinline__ void dsincos(double x, double& s, double& c) {
    const double k = rint(x * 0.63661977236758134308);
    double r = fma(-k, 1.57079632679489655800, x); r = fma(-k, 6.12323399573676603587e-17, r);
    const double r2 = r * r;
    double ps = -1.0 / 355687428096000.0;
    ps = fma(ps, r2, 1.0 / 1307674368000.0); ps = fma(ps, r2, -1.0 / 6227020800.0); ps = fma(ps, r2, 1.0 / 39916800.0); ps = fma(ps, r2, -1.0 / 362880.0);
    ps = fma(ps, r2, 1.0 / 5040.0); ps = fma(ps, r2, -1.0 / 120.0); ps = fma(ps, r2, 1.0 / 6.0); ps = fma(ps, r2, -1.0); ps = -ps * r;
    double pc = 1.0 / 20922789888000.0;
    pc = fma(pc, r2, -1.0 / 87178291200.0); pc = fma(pc, r2, 1.0 / 479001600.0); pc = fma(pc, r2, -1.0 / 3628800.0); pc = fma(pc, r2, 1.0 / 40320.0);
    pc = fma(pc, r2, -1.0 / 720.0); pc = fma(pc, r2, 1.0 / 24.0); pc = fma(pc, r2, -0.5); pc = fma(pc, r2, 1.0);
    const int q = ((int)k) & 3;
    s = (q == 0) ? ps : (q == 1) ? pc : (q == 2) ? -ps : -pc;
    c = (q == 0) ? pc : (q == 1) ? -ps : (q == 2) ? -pc : ps;
}
__device__ __forceinline__ double dexp_neg(double x) {
    const double k = rint(x * 1.44269504088896338700);
    double r = fma(-k, 0.693147180369123816490, x); r = fma(-k, 1.90821492927058770002e-10, r);
    double pe = 1.0 / 6227020800.0;
    pe = fma(pe, r, 1.0 / 479001600.0); pe = fma(pe, r, 1.0 / 39916800.0); pe = fma(pe, r, 1.0 / 3628800.0); pe = fma(pe, r, 1.0 / 362880.0); pe = fma(pe, r, 1.0 / 40320.0);
    pe = fma(pe, r, 1.0 / 5040.0); pe = fma(pe, r, 1.0 / 720.0); pe = fma(pe, r, 1.0 / 120.0); pe = fma(pe, r, 1.0 / 24.0); pe = fma(pe, r, 1.0 / 6.0); pe = fma(pe, r, 0.5);
    pe = fma(pe, r, 1.0); pe = fma(pe, r, 1.0);
    int ki = (int)k; if (ki < -1000) return 0.0;
    return pe * __longlong_as_double((long long)(1023 + ki) << 52);
}

__device__ __forceinline__ void wconv_tile(const Ctx& cx, const float* src, int ld, int K, int c0, int ncols, bf16_t* dst, int kt, int nt, float* tile) {
    const int tid = cx.tid, j = tid & 63, i0 = tid >> 6;
#pragma unroll
    for (int e = 0; e < 8; ++e) { const int i = i0 + 8 * e; const int n = nt * 64 + j;
        tile[i * 65 + j] = (n < ncols) ? src[(size_t)(kt * 64 + i) * ld + c0 + n] : 0.f; }
    __syncthreads();
#pragma unroll
    for (int e = 0; e < 8; ++e) { const int jj = i0 + 8 * e;
        dst[(size_t)(nt * 64 + jj) * K + kt * 64 + j] = f2bf(tile[j * 65 + jj]); }
    __syncthreads();
}

__device__ __forceinline__ void phase_wconv(int l, float* smf) {
    CParams& p = KPL(); const Ctx cx = mkctx();
    bf16_t* W = (bf16_t*)(p.ws + OFF_W);
    const int tid = cx.tid;
    for (int item = cx.bid; item < 5184; item += cx.nb) {
        if (item < 4544) {
            const float* src; int ld, K, c0, ncols, nN; bf16_t* dst; int t = item;
            if (t < 1024) { src = p.in[8] + (size_t)l * 1024 * 6928; ld = 6928; K = 1024; c0 = 0; ncols = 3856; nN = 64; dst = W + W_MIX / 2; }
            else if (t < 1792) { t -= 1024; src = p.in[8] + (size_t)l * 1024 * 6928; ld = 6928; K = 1024; c0 = 3856; ncols = 3072; nN = 48; dst = W + W_GATE / 2; }
            else if (t < 1856) { t -= 1792; src = p.in[17] + (size_t)l * 512 * 512; ld = 512; K = 512; c0 = 0; ncols = 512; nN = 8; dst = W + W_GLU / 2; }
            else if (t < 1984) { t -= 1856; src = p.in[35] + (size_t)l * 512 * 1024; ld = 1024; K = 512; c0 = 0; ncols = 1024; nN = 16; dst = W + W_PA / 2; }
            else if (t < 2112) { t -= 1984; src = p.in[36] + (size_t)l * 512 * 1024; ld = 1024; K = 512; c0 = 0; ncols = 1024; nN = 16; dst = W + W_PB / 2; }
            else if (t < 2240) { t -= 2112; src = p.in[37] + (size_t)l * 512 * 1024; ld = 1024; K = 512; c0 = 0; ncols = 1024; nN = 16; dst = W + W_PC / 2; }
            else if (t < 2496) { t -= 2240; src = p.in[38] + (size_t)l * 1024 * 1024; ld = 1024; K = 1024; c0 = 0; ncols = 1024; nN = 16; dst = W + W_OUT / 2; }
            else if (t < 3520) { t -= 2496; src = p.in[39] + (size_t)l * 1024 * 4096; ld = 4096; K = 1024; c0 = 0; ncols = 4096; nN = 64; dst = W + W_1 / 2; }
            else { t -= 3520; src = p.in[40] + (size_t)l * 4096 * 1024; ld = 1024; K = 4096; c0 = 0; ncols = 1024; nN = 16; dst = W + W_2 / 2; }
            const int nt = t % nN, kt = t / nN;
            wconv_tile(cx, src, ld, K, c0, ncols, dst, kt, nt, smf);
        } else {
            bf16_t* dst = W + W_LORA / 2;
#pragma unroll
            for (int q = 0; q < 2; ++q) {
                const int e = (item - 4544) * 1024 + q * 512 + tid; const int n = e >> 8, k = e & 255;
                float v = 0.f;
                if (n < 1024) { if (k < 64) v = p.in[26][(((size_t)l * 2 + (n >> 9)) * 64 + k) * 512 + (n & 511)]; }
                else if (n < 2048) { if (k >= 64 && k < 128) v = p.in[28][(((size_t)l * 2 + ((n - 1024) >> 9)) * 64 + (k - 64)) * 512 + (n & 511)]; }
                else { if (k >= 128) v = p.in[29][((size_t)l * 128 + (k - 128)) * 512 + (n - 2048)]; }
                dst[e] = f2bf(v);
            }
        }
    }
}

__device__ __forceinline__ void phase_s5_params() {
    CParams& p = KPL(); const Ctx cx = mkctx();
    for (int item = cx.bid; item < 32; item += cx.nb) {
        const int l = item >> 3;
        const int idx = (item & 7) * 512 + cx.tid;
        const int dir = idx >> 11, g = (idx >> 6) & 31;
        float* S5P = (float*)(p.ws + OFF_S5P) + (size_t)l * 147456;
        const size_t pi = (size_t)l * 4096 + idx;
        const double lre = fmin((double)p.in[9][pi], -1e-4), lim = (double)p.in[10][pi];
        const double dt = dexp_neg((double)p.in[11][(l * 2 + dir) * 32 + g]);
        const double mag = dexp_neg(lre * dt); double sn, cs; dsincos(lim * dt, sn, cs);
        const double ar = mag * cs, ai = mag * sn;
        const double den = lre * lre + lim * lim, nr = ar - 1.0;
        const double cr = (nr * lre + ai * lim) / den, ci = (ai * lre - nr * lim) / den;
        const double mag64 = dexp_neg(64.0 * lre * dt); dsincos(64.0 * lim * dt, sn, cs);
        S5P[idx] = (float)ar; S5P[4096 + idx] = (float)ai; S5P[8192 + idx] = (float)(mag64 * cs); S5P[12288 + idx] = (float)(mag64 * sn);
        float* BR = S5P + 16384; float* BI = BR + 65536;
        for (int c = 0; c < 16; ++c) { const double bre = p.in[12][pi * 16 + c], bim = p.in[13][pi * 16 + c];
            BR[(size_t)idx * 16 + c] = (float)(cr * bre - ci * bim); BI[(size_t)idx * 16 + c] = (float)(cr * bim + ci * bre); }
    }
}

__device__ __forceinline__ void phase_norm(int l, int which, bool init) {
    CParams& p = KPL(); const Ctx cx = mkctx();
    const int lane = cx.tid & 63, gw = cx.bid * 8 + (cx.tid >> 6), nw = cx.nb * 8;
    float* X = (float*)(p.ws + OFF_X); bf16_t* H = (bf16_t*)(p.ws + OFF_H);
    const float* MODL = (const float*)(p.ws + OFF_MOD) + (size_t)l * 3 * 6144;
    const float* gam = p.in[which ? 7 : 6] + l * 1024;
    for (int row = gw; row < T_TOK; row += nw) {
        const int b = row >= SEQA ? 1 : 0, t = row - b * SEQA;
        const float* src = init ? (t < NCTX ? p.in[2] + ((size_t)b * NCTX + t) * 1024 : p.in[0] + ((size_t)b * 8192 + (t - NCTX)) * 1024) : X + (size_t)row * 1024;
        f32x4 v[4]; float ss = 0.f;
#pragma unroll
        for (int i = 0; i < 4; ++i) { v[i] = *(const f32x4*)(src + (lane + 64 * i) * 4); ss += v[i][0] * v[i][0] + v[i][1] * v[i][1] + v[i][2] * v[i][2] + v[i][3] * v[i][3]; }
        if (init) {
#pragma unroll
            for (int i = 0; i < 4; ++i) *(f32x4*)(X + (size_t)row * 1024 + (lane + 64 * i) * 4) = v[i];
        }
        ss = wave_sum(ss);
        const float inv = rsqrtf(ss * (1.f / 1024.f) + 1e-6f);
        const float* mv = MODL + (t < NCTX ? 2 : b) * 6144 + (which ? 3 : 0) * 1024;
#pragma unroll
        for (int i = 0; i < 4; ++i) { const int c = (lane + 64 * i) * 4;
            const f32x4 g4 = *(const f32x4*)(gam + c), sh = *(const f32x4*)(mv + c), scl = *(const f32x4*)(mv + 1024 + c);
            f32x4 o;
#pragma unroll
            for (int e = 0; e < 4; ++e) o[e] = v[i][e] * inv * g4[e] * (1.f + scl[e]) + sh[e];
            store4bf(H + (size_t)row * 1024 + c, o); }
    }
}

__device__ __forceinline__ int s5_order(int dir, int i) { return dir == 0 ? i : (i < 4 ? 3 - i : 135 - i); }

__device__ __forceinline__ void phase_s5_local(int l) {
    CParams& p = KPL(); const Ctx cx = mkctx();
    const int lane = cx.tid & 63, gw = cx.bid * 8 + (cx.tid >> 6), nw = cx.nb * 8;
    const bf16_t* ZA = (const bf16_t*)(p.ws + OFF_Z);
    const float* S5P = (const float*)(p.ws + OFF_S5P) + (size_t)l * 147456; const float* BR = S5P + 16384; const float* BI = BR + 65536;
    float* ST = (float*)(p.ws + OFF_S5ST);
    for (int item0 = gw; item0 < 16896; item0 += nw) {
        const int item = __builtin_amdgcn_readfirstlane(item0);
        const int chunk = item % 132, g = (item / 132) & 31, dir = (item / 4224) & 1, b = item / 8448;
        const int idx = dir * 2048 + g * 64 + lane;
        const float ar = S5P[idx], ai = S5P[4096 + idx];
        float br[16], bi[16];
#pragma unroll
        for (int q = 0; q < 4; ++q) { const f32x4 t0 = *(const f32x4*)(BR + (size_t)idx * 16 + q * 4), t1 = *(const f32x4*)(BI + (size_t)idx * 16 + q * 4);
#pragma unroll
            for (int e = 0; e < 4; ++e) { br[q * 4 + e] = t0[e]; bi[q * 4 + e] = t1[e]; } }
        const int row = b * SEQA + chunk * 64 + lane;
        const u32x4 u0 = *(const u32x4*)(ZA + (size_t)row * 2048 + g * 16), u1 = *(const u32x4*)(ZA + (size_t)row * 2048 + g * 16 + 8);
        unsigned ur[8] = {u0.x, u0.y, u0.z, u0.w, u1.x, u1.y, u1.z, u1.w};
        float hr = 0.f, hi = 0.f;
#pragma unroll 8
        for (int j = 0; j < 64; ++j) {
            const int tok = dir ? 63 - j : j;
            float bur = 0.f, bui = 0.f;
#pragma unroll
            for (int q = 0; q < 8; ++q) { const unsigned w = (unsigned)__builtin_amdgcn_readlane((int)ur[q], tok); const float x0 = bflo(w), x1 = bfhi(w);
                bur += br[2 * q] * x0 + br[2 * q + 1] * x1; bui += bi[2 * q] * x0 + bi[2 * q + 1] * x1; }
            const float nr = ar * hr - ai * hi + bur, ni = ar * hi + ai * hr + bui; hr = nr; hi = ni;
        }
        float* st = ST + ((((size_t)b * 2 + dir) * 32 + g) * 132 + chunk) * 128;
        st[lane] = hr; st[64 + lane] = hi;
    }
}

__device__ __forceinline__ void phase_s5_carry(int l) {
    CParams& p = KPL(); const Ctx cx = mkctx();
    const int lane = cx.tid & 63, gw = cx.bid * 8 + (cx.tid >> 6), nw = cx.nb * 8;
    const float* S5P = (const float*)(p.ws + OFF_S5P) + (size_t)l * 147456;
    float* ST = (float*)(p.ws + OFF_S5ST);
    for (int item0 = gw; item0 < 128; item0 += nw) {
        const int item = __builtin_amdgcn_readfirstlane(item0);
        const int g = item & 31, dir = (item >> 5) & 1, b = item >> 6;
        const int idx = dir * 2048 + g * 64 + lane;
        const float ar = S5P[8192 + idx], ai = S5P[12288 + idx];
        float* st = ST + (((size_t)b * 2 + dir) * 32 + g) * 132 * 128;
        float hr = 0.f, hi = 0.f;
        for (int i0 = 0; i0 < 132; i0 += 12) {
            float lr[12], li[12];
#pragma unroll
            for (int e = 0; e < 12; ++e) { const int c = s5_order(dir, i0 + e); lr[e] = st[c * 128 + lane]; li[e] = st[c * 128 + 64 + lane]; }
#pragma unroll
            for (int e = 0; e < 12; ++e) { const int c = s5_order(dir, i0 + e); st[c * 128 + lane] = hr; st[c * 128 + 64 + lane] = hi;
                const float nr = ar * hr - ai * hi + lr[e], ni = ar * hi + ai * hr + li[e]; hr = nr; hi = ni; }
        }
    }
}

template <int DIR>
__device__ __forceinline__ void s5_final_dir(CParams& p, int l, int b, int g, int chunk, int lane, const unsigned (&ur)[8], float* hst, f32x4* ybuf, int row0, float dsk, bf16_t* ZG) {
    const float* S5P = (const float*)(p.ws + OFF_S5P) + (size_t)l * 147456; const float* BR = S5P + 16384; const float* BI = BR + 65536;
    const float* ST = (const float*)(p.ws + OFF_S5ST);
    const bf16_t* ZA = (const bf16_t*)(p.ws + OFF_Z);
    const int idx = DIR * 2048 + g * 64 + lane;
    const float ar = S5P[idx], ai = S5P[4096 + idx];
    float br[16], bi[16];
#pragma unroll
    for (int q = 0; q < 4; ++q) { const f32x4 t0 = *(const f32x4*)(BR + (size_t)idx * 16 + q * 4), t1 = *(const f32x4*)(BI + (size_t)idx * 16 + q * 4);
#pragma unroll
        for (int e = 0; e < 4; ++e) { br[q * 4 + e] = t0[e]; bi[q * 4 + e] = t1[e]; } }
    float cbr[16], cbi[16];
    { const size_t cb = ((((size_t)l * 2 + DIR) * 32 + g) * 16 + (lane & 15)) * 64 + (lane >> 4);
#pragma unroll
      for (int i = 0; i < 16; ++i) { cbr[i] = p.in[14][cb + 4 * i]; cbi[i] = -p.in[15][cb + 4 * i]; } }
    const float* st = ST + ((((size_t)b * 2 + DIR) * 32 + g) * 132 + chunk) * 128;
    float hr = st[lane], hi = st[64 + lane];
    const int ch = g * 16 + (lane & 15);
#pragma unroll 1
    for (int si = 0; si < 4; ++si) {
        const int sc = DIR ? 3 - si : si;
#pragma unroll
        for (int jj = 0; jj < 16; ++jj) {
            const int tt = DIR ? 15 - jj : jj; const int tok = sc * 16 + tt;
            float bur = 0.f, bui = 0.f;
#pragma unroll
            for (int q = 0; q < 8; ++q) { const unsigned w = (unsigned)__builtin_amdgcn_readlane((int)ur[q], tok); const float x0 = bflo(w), x1 = bfhi(w);
                bur += br[2 * q] * x0 + br[2 * q + 1] * x1; bui += bi[2 * q] * x0 + bi[2 * q + 1] * x1; }
            const float nr = ar * hr - ai * hi + bur, ni = ar * hi + ai * hr + bui; hr = nr; hi = ni;
            hst[tt * 68 + lane] = hr; hst[1088 + tt * 68 + lane] = hi;
        }
        f32x4 a = (f32x4){0.f, 0.f, 0.f, 0.f};
        if (DIR) a = ybuf[sc * 64 + lane];
#pragma unroll
        for (int i = 0; i < 16; ++i) {
            const float xr = hst[(lane & 15) * 68 + 4 * i + (lane >> 4)], xi = hst[1088 + (lane & 15) * 68 + 4 * i + (lane >> 4)];
            a = __builtin_amdgcn_mfma_f32_16x16x4f32(xr, cbr[i], a, 0, 0, 0);
            a = __builtin_amdgcn_mfma_f32_16x16x4f32(xi, cbi[i], a, 0, 0, 0);
        }
        if (!DIR) ybuf[sc * 64 + lane] = a;
        else {
#pragma unroll
            for (int j = 0; j < 4; ++j) {
                const int row = row0 + sc * 16 + (lane >> 4) * 4 + j;
                const float u = bf2f(ZA[(size_t)row * 2048 + ch]);
                const float y = u * dsk + a[j];
                const float z = 0.5f * y * (1.f + tanhf(0.7978845608028654f * (y + 0.044715f * y * y * y)));
                ZG[(size_t)row * 512 + ch] = f2bf(z);
            }
        }
    }
}

__device__ __forceinline__ void phase_s5_final(int l, float* smf) {
    CParams& p = KPL(); const Ctx cx = mkctx();
    const int lane = cx.tid & 63, wid = cx.tid >> 6, gw = cx.bid * 8 + wid, nw = cx.nb * 8;
    const bf16_t* ZA = (const bf16_t*)(p.ws + OFF_Z);
    bf16_t* ZG = (bf16_t*)(p.ws + OFF_ZG);
    float* hst = smf + wid * 3200;
    f32x4* ybuf = (f32x4*)(hst + 2176);
    for (int item0 = gw; item0 < 8448; item0 += nw) {
        const int item = __builtin_amdgcn_readfirstlane(item0);
        const int chunk = item % 132, g = (item / 132) & 31, b = item / 4224;
        const int row0 = b * SEQA + chunk * 64;
        const u32x4 u0 = *(const u32x4*)(ZA + (size_t)(row0 + lane) * 2048 + g * 16), u1 = *(const u32x4*)(ZA + (size_t)(row0 + lane) * 2048 + g * 16 + 8);
        const unsigned ur[8] = {u0.x, u0.y, u0.z, u0.w, u1.x, u1.y, u1.z, u1.w};
        const float dsk = p.in[16][l * 512 + g * 16 + (lane & 15)];
        s5_final_dir<0>(p, l, b, g, chunk, lane, ur, hst, ybuf, row0, dsk, ZG);
        s5_final_dir<1>(p, l, b, g, chunk, lane, ur, hst, ybuf, row0, dsk, ZG);
    }
}

__device__ __forceinline__ int ml_row0(int b, int nc) { return b * SEQA + nc * 128; }
__device__ __forceinline__ int ml_order(int dir, int i) { return dir == 0 ? i : (i < 2 ? 1 - i : 67 - i); }

__device__ __forceinline__ void phase_ml_conv(int l) {
    CParams& p = KPL(); const Ctx cx = mkctx();
    const bf16_t* ZA = (const bf16_t*)(p.ws + OFF_Z);
    bf16_t* QKC = (bf16_t*)(p.ws + OFF_QKC);
    const float* cw = p.in[19] + (size_t)l * 9 * 512; const float* cb = p.in[20] + l * 512;
    for (int idx = cx.bid * 512 + cx.tid; idx < T_TOK * 64; idx += cx.nb * 512) {
        const int row = idx >> 6, c8 = (idx & 63) * 8;
        const int b = row >= SEQA ? 1 : 0, t = row - b * SEQA;
        const bool isctx = t < NCTX;
        const int tt = isctx ? t : t - NCTX, W = isctx ? 256 : 64, Hh = isctx ? 1 : 128;
        const int y = tt / W, x = tt % W;
        const int segrow0 = row - tt;
        float acc[8];
#pragma unroll
        for (int e = 0; e < 8; ++e) acc[e] = cb[c8 + e];
#pragma unroll
        for (int dy = 0; dy < 3; ++dy)
#pragma unroll
            for (int dx = 0; dx < 3; ++dx) {
                const int yy = y + dy - 1, xx = x + dx - 1;
                if (yy >= 0 && yy < Hh && xx >= 0 && xx < W) {
                    const u32x4 z = *(const u32x4*)(ZA + (size_t)(segrow0 + yy * W + xx) * 2048 + 512 + c8);
                    const float* w = cw + (dy * 3 + dx) * 512 + c8;
                    const f32x4 w0 = *(const f32x4*)w, w1 = *(const f32x4*)(w + 4);
                    acc[0] += bflo(z.x) * w0[0]; acc[1] += bfhi(z.x) * w0[1]; acc[2] += bflo(z.y) * w0[2]; acc[3] += bfhi(z.y) * w0[3];
                    acc[4] += bflo(z.z) * w1[0]; acc[5] += bfhi(z.z) * w1[1]; acc[6] += bflo(z.w) * w1[2]; acc[7] += bfhi(z.w) * w1[3];
                }
            }
        u32x4 o;
#pragma unroll
        for (int e = 0; e < 8; ++e) acc[e] = acc[e] * sigmoidf_(acc[e]);
        o.x = pk2(acc[0], acc[1]); o.y = pk2(acc[2], acc[3]); o.z = pk2(acc[4], acc[5]); o.w = pk2(acc[6], acc[7]);
        *(u32x4*)(QKC + (size_t)row * 512 + c8) = o;
    }
}

constexpr int ML_QS = 0, ML_KS = 18432, ML_VT = 36864, ML_CS = 71680, ML_PS = 92416, ML_GV = 127232, ML_BV = 127744, ML_MV = 128256, ML_LF = 128768, ML_IG = 129280, ML_SC = 129792;

__device__ __forceinline__ void ml_gate_vectors(const Ctx& cx, CParams& p, int l, int dir, int b, int h, int nc, unsigned char* sm, float m_in) {
    const int tid = cx.tid, lane = tid & 63;
    float* lf = (float*)(sm + ML_LF); float* ig = (float*)(sm + ML_IG); float* gv = (float*)(sm + ML_GV); float* bv = (float*)(sm + ML_BV); float* mv = (float*)(sm + ML_MV); float* sc = (float*)(sm + ML_SC);
    const float* MLG = (const float*)(p.ws + OFF_MLG);
    const float* gb = p.in[21] + l * 16;
    if (tid < 128) {
        const int row = ml_row0(b, nc) + tid;
        const float ip = MLG[(size_t)row * 16 + dir * 4 + h] + gb[dir * 4 + h];
        const float fp = MLG[(size_t)row * 16 + 8 + dir * 4 + h] + gb[8 + dir * 4 + h];
        ig[tid] = ip; lf[tid] = fminf(fp, 0.f) - log1pf(expf(-fabsf(fp)));
    }
    __syncthreads();
    if (tid < 64) {
        const int pp0 = 2 * lane, pp1 = 2 * lane + 1; const int s0 = dir ? 127 - pp0 : pp0, s1 = dir ? 127 - pp1 : pp1;
        const float x0 = lf[s0], x1 = lf[s1];
        float incl = x0 + x1;
#pragma unroll
        for (int d = 1; d < 64; d <<= 1) { const float t = __shfl_up(incl, d); if (lane >= d) incl += t; }
        const float g1 = incl, g0 = incl - x1;
        const float gtot = __shfl(incl, 63);
        const float b0 = ig[s0] - g0, b1 = ig[s1] - g1;
        float mx = fmaxf(b0, b1);
#pragma unroll
        for (int d = 1; d < 64; d <<= 1) { const float t = __shfl_up(mx, d); if (lane >= d) mx = fmaxf(mx, t); }
        const float prev = __shfl_up(mx, 1);
        const float pm0 = lane > 0 ? fmaxf(prev, b0) : b0, pm1 = mx;
        const float bmax = __shfl(mx, 63);
        gv[s0] = g0; gv[s1] = g1; bv[s0] = b0; bv[s1] = b1; mv[s0] = fmaxf(m_in, pm0); mv[s1] = fmaxf(m_in, pm1);
        if (lane == 0) { sc[0] = gtot; sc[1] = bmax; }
    }
    __syncthreads();
}

__device__ __forceinline__ void phase_ml_local(int l, unsigned char* sm) {
    CParams& p = KPL(); const Ctx cx = mkctx();
    const int tid = cx.tid, lane = tid & 63, wid = tid >> 6;
    const bf16_t* ZA = (const bf16_t*)(p.ws + OFF_Z); const bf16_t* QKC = (const bf16_t*)(p.ws + OFF_QKC);
    float* CLOC = (float*)(p.ws + OFF_CLOC); float* MLS = (float*)(p.ws + OFF_MLS);
    bf16_t* VT = (bf16_t*)(sm + ML_VT); bf16_t* KT = (bf16_t*)(sm + ML_KS);
    const float* bv = (const float*)(sm + ML_BV); const float* sc = (const float*)(sm + ML_SC);
    float* wg = (float*)(sm + ML_LF);
    for (int item = cx.bid; item < 1056; item += cx.nb) {
        const int chain = item / 66, nc = item % 66; const int dir = chain >> 3, b = (chain >> 2) & 1, h = chain & 3;
        ml_gate_vectors(cx, p, l, dir, b, h, nc, sm, -1e30f);
        const float gtot = sc[0], bmax = sc[1];
        __syncthreads();
        if (tid < 128) wg[tid] = expf(bv[tid] - bmax);
        __syncthreads();
        const int row0 = ml_row0(b, nc);
#pragma unroll
        for (int q = 0; q < 4; ++q) { const int ci = q * 512 + tid; const int s = ci >> 4, v8 = (ci & 15) * 8;
            const u32x4 z = *(const u32x4*)(ZA + (size_t)(row0 + s) * 2048 + 1024 + h * 128 + v8); const float w = wg[s];
            const unsigned zz[4] = {z.x, z.y, z.z, z.w};
#pragma unroll
            for (int e = 0; e < 4; ++e) { VT[(v8 + 2 * e) * 136 + s] = f2bf(bflo(zz[e]) * w); VT[(v8 + 2 * e + 1) * 136 + s] = f2bf(bfhi(zz[e]) * w); } }
#pragma unroll
        for (int q = 0; q < 2; ++q) { const int ci = q * 512 + tid; const int s = ci >> 3, k8 = (ci & 7) * 8;
            const u32x4 z = *(const u32x4*)(QKC + (size_t)(row0 + s) * 512 + 256 + h * 64 + k8);
            const unsigned zz[4] = {z.x, z.y, z.z, z.w};
#pragma unroll
            for (int e = 0; e < 4; ++e) { KT[(k8 + 2 * e) * 136 + s] = (bf16_t)(zz[e] & 0xffff); KT[(k8 + 2 * e + 1) * 136 + s] = (bf16_t)(zz[e] >> 16); } }
        __syncthreads();
        float* dst = CLOC + ((size_t)chain * 66 + nc) * 8256;
        f32x4 acc[4];
#pragma unroll
        for (int n = 0; n < 4; ++n) acc[n] = (f32x4){0.f, 0.f, 0.f, 0.f};
#pragma unroll
        for (int ks = 0; ks < 4; ++ks) {
            const bf16x8 a = *(const bf16x8*)(VT + (16 * wid + (lane & 15)) * 136 + ks * 32 + (lane >> 4) * 8);
#pragma unroll
            for (int n = 0; n < 4; ++n) { const bf16x8 bb = *(const bf16x8*)(KT + (16 * n + (lane & 15)) * 136 + ks * 32 + (lane >> 4) * 8);
                acc[n] = __builtin_amdgcn_mfma_f32_16x16x32_bf16(a, bb, acc[n], 0, 0, 0); }
        }
#pragma unroll
        for (int n = 0; n < 4; ++n)
#pragma unroll
            for (int j = 0; j < 4; ++j) dst[(16 * wid + (lane >> 4) * 4 + j) * 64 + 16 * n + (lane & 15)] = acc[n][j];
        if (tid < 64) { float s = 0.f; for (int t = 0; t < 128; ++t) s += wg[t] * bf2f(KT[tid * 136 + t]); dst[8192 + tid] = s; }
        if (tid == 0) { MLS[chain * 66 + nc] = gtot; MLS[1056 + chain * 66 + nc] = gtot + bmax; }
        __syncthreads();
    }
}

__device__ __forceinline__ void phase_ml_carry() {
    CParams& p = KPL(); const Ctx cx = mkctx();
    float* CLOC = (float*)(p.ws + OFF_CLOC); float* MLS = (float*)(p.ws + OFF_MLS);
    for (int idx = cx.bid * 512 + cx.tid; idx < 16 * 8256; idx += cx.nb * 512) {
        const int chain = idx / 8256, e = idx % 8256; const int dir = chain >> 3;
        float* base = CLOC + (size_t)chain * 66 * 8256 + e;
        float m = -1e30f, C = 0.f;
        for (int i0 = 0; i0 < 66; i0 += 6) {
            float cl[6];
#pragma unroll
            for (int q = 0; q < 6; ++q) cl[q] = base[(size_t)ml_order(dir, i0 + q) * 8256];
#pragma unroll
            for (int q = 0; q < 6; ++q) { const int nc = ml_order(dir, i0 + q);
                const float gt = MLS[chain * 66 + nc], am = MLS[1056 + chain * 66 + nc];
                base[(size_t)nc * 8256] = C;
                if (e == 0) MLS[2112 + chain * 66 + nc] = m;
                const float mn = fmaxf(gt + m, am); const float so = expf(gt + m - mn), sl = expf(am - mn);
                C = so * C + sl * cl[q]; m = mn; }
        }
    }
}

__device__ __forceinline__ void phase_ml_out(int l, unsigned char* sm) {
    CParams& p = KPL(); const Ctx cx = mkctx();
    const int tid = cx.tid, lane = tid & 63, wid = tid >> 6;
    const bf16_t* ZA = (const bf16_t*)(p.ws + OFF_Z); const bf16_t* QKC = (const bf16_t*)(p.ws + OFF_QKC);
    const float* CLOC = (const float*)(p.ws + OFF_CLOC); const float* MLS = (const float*)(p.ws + OFF_MLS);
    bf16_t* YB = (bf16_t*)(p.ws + OFF_YB);
    bf16_t* QS = (bf16_t*)(sm + ML_QS); bf16_t* KS = (bf16_t*)(sm + ML_KS); bf16_t* VT = (bf16_t*)(sm + ML_VT); bf16_t* CS = (bf16_t*)(sm + ML_CS); bf16_t* PS = (bf16_t*)(sm + ML_PS);
    const float* gv = (const float*)(sm + ML_GV); const float* bv = (const float*)(sm + ML_BV); const float* mv = (const float*)(sm + ML_MV);
    for (int item = cx.bid; item < 528; item += cx.nb) {
        const int b = item / 264, h = (item / 66) & 3, nc = item % 66;
        const int row0 = ml_row0(b, nc);
        __syncthreads();
#pragma unroll
        for (int q = 0; q < 2; ++q) { const int ci = q * 512 + tid; const int s = ci >> 3, k8 = (ci & 7) * 8;
            const u32x4 zq = *(const u32x4*)(QKC + (size_t)(row0 + s) * 512 + h * 64 + k8);
            u32x4 o; o.x = pk2(bflo(zq.x) * 0.125f, bfhi(zq.x) * 0.125f); o.y = pk2(bflo(zq.y) * 0.125f, bfhi(zq.y) * 0.125f); o.z = pk2(bflo(zq.z) * 0.125f, bfhi(zq.z) * 0.125f); o.w = pk2(bflo(zq.w) * 0.125f, bfhi(zq.w) * 0.125f);
            *(u32x4*)(QS + s * 72 + k8) = o;
            *(u32x4*)(KS + s * 72 + k8) = *(const u32x4*)(QKC + (size_t)(row0 + s) * 512 + 256 + h * 64 + k8); }
#pragma unroll
        for (int q = 0; q < 4; ++q) { const int ci = q * 512 + tid; const int s = ci >> 4, v8 = (ci & 15) * 8;
            const u32x4 z = *(const u32x4*)(ZA + (size_t)(row0 + s) * 2048 + 1024 + h * 128 + v8);
            const unsigned zz[4] = {z.x, z.y, z.z, z.w};
#pragma unroll
            for (int e = 0; e < 4; ++e) { VT[(v8 + 2 * e) * 136 + s] = (bf16_t)(zz[e] & 0xffff); VT[(v8 + 2 * e + 1) * 136 + s] = (bf16_t)(zz[e] >> 16); } }
        f32x4 hsum[8];
#pragma unroll
        for (int v = 0; v < 8; ++v) hsum[v] = (f32x4){0.f, 0.f, 0.f, 0.f};
#pragma unroll 1
        for (int dir = 0; dir < 2; ++dir) {
            const int chain = dir * 8 + b * 4 + h;
            const float m_in = MLS[2112 + chain * 66 + nc];
            __syncthreads();
            ml_gate_vectors(cx, p, l, dir, b, h, nc, sm, m_in);
            const float* cin = CLOC + ((size_t)chain * 66 + nc) * 8256;
#pragma unroll
            for (int q = 0; q < 4; ++q) { const int ci = q * 512 + tid; const int v = ci >> 4, k4 = (ci & 15) * 4;
                const f32x4 c = *(const f32x4*)(cin + v * 64 + k4); store4bf(CS + v * 72 + k4, c); }
            if (tid < 16) { const f32x4 c = *(const f32x4*)(cin + 8192 + tid * 4); store4bf(CS + 128 * 72 + tid * 4, c); }
            else if (tid < 256) { const int r = 129 + (tid - 16) / 16, k4 = ((tid - 16) & 15) * 4; store4bf(CS + r * 72 + k4, (f32x4){0.f, 0.f, 0.f, 0.f}); }
            __syncthreads();
            const int tr = 16 * wid + (lane >> 4) * 4;
            float Mt[4], rs[4] = {0.f, 0.f, 0.f, 0.f};
#pragma unroll
            for (int j = 0; j < 4; ++j) Mt[j] = mv[tr + j];
            bf16x8 qa[2];
#pragma unroll
            for (int ks = 0; ks < 2; ++ks) qa[ks] = *(const bf16x8*)(QS + (16 * wid + (lane & 15)) * 72 + ks * 32 + (lane >> 4) * 8);
#pragma unroll
            for (int nt = 0; nt < 8; ++nt) {
                f32x4 s4 = (f32x4){0.f, 0.f, 0.f, 0.f};
#pragma unroll
                for (int ks = 0; ks < 2; ++ks) { const bf16x8 kb = *(const bf16x8*)(KS + (16 * nt + (lane & 15)) * 72 + ks * 32 + (lane >> 4) * 8);
                    s4 = __builtin_amdgcn_mfma_f32_16x16x32_bf16(qa[ks], kb, s4, 0, 0, 0); }
                const int s = 16 * nt + (lane & 15); const float bs = bv[s];
#pragma unroll
                for (int j = 0; j < 4; ++j) { const int t = tr + j; const bool valid = dir ? (s >= t) : (s <= t);
                    const float pv = valid ? s4[j] * expf(bs - Mt[j]) : 0.f; rs[j] += pv; PS[t * 136 + s] = f2bf(pv); }
            }
#pragma unroll
            for (int j = 0; j < 4; ++j) rs[j] = row16_sum(rs[j]);
            __syncthreads();
            f32x4 qn = (f32x4){0.f, 0.f, 0.f, 0.f};
#pragma unroll
            for (int ks = 0; ks < 2; ++ks) { const bf16x8 cb = *(const bf16x8*)(CS + (128 + (lane & 15)) * 72 + ks * 32 + (lane >> 4) * 8);
                qn = __builtin_amdgcn_mfma_f32_16x16x32_bf16(qa[ks], cb, qn, 0, 0, 0); }
            float wi[4], dn[4];
#pragma unroll
            for (int j = 0; j < 4; ++j) { const float qnj = row16_sum(qn[j]); wi[j] = expf(m_in - Mt[j]);
                const float den = rs[j] + wi[j] * qnj; const float mt = gv[tr + j] + Mt[j]; dn[j] = 1.f / fmaxf(fabsf(den), expf(-mt)); }
            bf16x8 pa[4];
#pragma unroll
            for (int ks = 0; ks < 4; ++ks) pa[ks] = *(const bf16x8*)(PS + (16 * wid + (lane & 15)) * 136 + ks * 32 + (lane >> 4) * 8);
#pragma unroll
            for (int vt = 0; vt < 8; ++vt) {
                f32x4 a1 = (f32x4){0.f, 0.f, 0.f, 0.f}, a2 = (f32x4){0.f, 0.f, 0.f, 0.f};
#pragma unroll
                for (int ks = 0; ks < 4; ++ks) { const bf16x8 vb = *(const bf16x8*)(VT + (16 * vt + (lane & 15)) * 136 + ks * 32 + (lane >> 4) * 8);
                    a1 = __builtin_amdgcn_mfma_f32_16x16x32_bf16(pa[ks], vb, a1, 0, 0, 0); }
#pragma unroll
                for (int ks = 0; ks < 2; ++ks) { const bf16x8 cb = *(const bf16x8*)(CS + (16 * vt + (lane & 15)) * 72 + ks * 32 + (lane >> 4) * 8);
                    a2 = __builtin_amdgcn_mfma_f32_16x16x32_bf16(qa[ks], cb, a2, 0, 0, 0); }
#pragma unroll
                for (int j = 0; j < 4; ++j) hsum[vt][j] += (a1[j] + wi[j] * a2[j]) * dn[j];
            }
        }
        const int tr = 16 * wid + (lane >> 4) * 4;
        float rinv[4];
#pragma unroll
        for (int j = 0; j < 4; ++j) { float ss = 0.f;
#pragma unroll
            for (int vt = 0; vt < 8; ++vt) ss += hsum[vt][j] * hsum[vt][j];
            ss = row16_sum(ss); rinv[j] = rsqrtf(ss * (1.f / 128.f) + 1e-6f); }
#pragma unroll
        for (int vt = 0; vt < 8; ++vt) { const int ch = h * 128 + 16 * vt + (lane & 15); const float ng = p.in[22][l * 512 + ch];
#pragma unroll
            for (int j = 0; j < 4; ++j) { const int row = row0 + tr + j;
                const float o = bf2f(ZA[(size_t)row * 2048 + 1536 + ch]);
                YB[(size_t)row * 512 + ch] = f2bf(hsum[vt][j] * rinv[j] * ng * sigmoidf_(o)); } }
    }
}

__device__ __forceinline__ void phase_rw_feat(int l) {
    CParams& p = KPL(); const Ctx cx = mkctx();
    const int lane = cx.tid & 63, gw = cx.bid * 8 + (cx.tid >> 6), nw = cx.nb * 8;
    const bf16_t* ZRW = (const bf16_t*)(p.ws + OFF_ZRW);
    bf16_t* F1 = (bf16_t*)(p.ws + OFF_F1); bf16_t* LIN = (bf16_t*)(p.ws + OFF_LORAIN);
    const float* mup = p.in[23] + (size_t)l * 1792; const float* mun = p.in[24] + (size_t)l * 1792;
    const float* kk_w = p.in[30] + l * 512;
    for (int row = gw; row < T_TOK; row += nw) {
        const int b = row >= SEQA ? 1 : 0, t = row - b * SEQA;
        const bool hasp = !(t == 0 || t == NCTX), hasn = !(t == NCTX - 1 || t == SEQA - 1);
        const bf16_t* zc = ZRW + (size_t)row * 1792;
#pragma unroll
        for (int q = 0; q < 3; ++q) {
            const int col = q * 512 + lane * 8;
            const u32x4 c4 = *(const u32x4*)(zc + col);
            u32x4 p4 = (u32x4){0u, 0u, 0u, 0u}, n4 = (u32x4){0u, 0u, 0u, 0u};
            if (hasp) p4 = *(const u32x4*)(zc - 1792 + col);
            if (hasn) n4 = *(const u32x4*)(zc + 1792 + col);
            const unsigned cc[4] = {c4.x, c4.y, c4.z, c4.w}, pp[4] = {p4.x, p4.y, p4.z, p4.w}, nn[4] = {n4.x, n4.y, n4.z, n4.w};
            float zs[8];
#pragma unroll
            for (int e = 0; e < 8; ++e) { const float z = (e & 1) ? bfhi(cc[e >> 1]) : bflo(cc[e >> 1]); const float pv = (e & 1) ? bfhi(pp[e >> 1]) : bflo(pp[e >> 1]); const float nx = (e & 1) ? bfhi(nn[e >> 1]) : bflo(nn[e >> 1]);
                zs[e] = z + mup[col + e] * (pv - z) + mun[col + e] * (nx - z); }
            u32x4 o; o.x = pk2(zs[0], zs[1]); o.y = pk2(zs[2], zs[3]); o.z = pk2(zs[4], zs[5]); o.w = pk2(zs[6], zs[7]);
            *(u32x4*)(F1 + (size_t)row * 2048 + q * 512 + lane * 8) = o;
            if (q == 1) {
                float kr[8], ssq = 0.f;
#pragma unroll
                for (int e = 0; e < 8; ++e) { kr[e] = zs[e] * kk_w[lane * 8 + e]; ssq += kr[e] * kr[e]; }
                ssq = row8_sum(ssq);
                const float inv = 1.f / fmaxf(sqrtf(ssq), 1e-12f);
                u32x4 o2; o2.x = pk2(kr[0] * inv, kr[1] * inv); o2.y = pk2(kr[2] * inv, kr[3] * inv); o2.z = pk2(kr[4] * inv, kr[5] * inv); o2.w = pk2(kr[6] * inv, kr[7] * inv);
                *(u32x4*)(F1 + (size_t)row * 2048 + 1536 + lane * 8) = o2;
            }
        }
        {
            const int col = 1536 + lane * 4;
            const u32x2 c2 = *(const u32x2*)(zc + col);
            u32x2 p2 = (u32x2){0u, 0u}, n2 = (u32x2){0u, 0u};
            if (hasp) p2 = *(const u32x2*)(zc - 1792 + col);
            if (hasn) n2 = *(const u32x2*)(zc + 1792 + col);
            const unsigned cc[2] = {c2.x, c2.y}, pp[2] = {p2.x, p2.y}, nn[2] = {n2.x, n2.y};
            float zs[4];
#pragma unroll
            for (int e = 0; e < 4; ++e) { const float z = (e & 1) ? bfhi(cc[e >> 1]) : bflo(cc[e >> 1]); const float pv = (e & 1) ? bfhi(pp[e >> 1]) : bflo(pp[e >> 1]); const float nx = (e & 1) ? bfhi(nn[e >> 1]) : bflo(nn[e >> 1]);
                const float s = z + mup[col + e] * (pv - z) + mun[col + e] * (nx - z);
                zs[e] = lane < 16 ? tanhf(s) : (lane < 32 ? s : sigmoidf_(s)); }
            u32x2 o; o.x = pk2(zs[0], zs[1]); o.y = pk2(zs[2], zs[3]);
            *(u32x2*)(LIN + (size_t)row * 256 + lane * 4) = o;
        }
    }
}

__device__ __forceinline__ int rw_tok(int dir, int i) { return dir == 0 ? i : (i < NCTX ? NCTX - 1 - i : 8703 - i); }

typedef float f32x2 __attribute__((ext_vector_type(2)));
constexpr int RW_REC = 352;
__device__ __forceinline__ void rw_load(const bf16_t* f1, const bf16_t* f2, int dir, int rg, int c, int pw, int lane, bf16_t (&in)[8][5], bf16_t (&vin)[8]) {
#pragma unroll
    for (int q = 0; q < 8; ++q) { const size_t t = (size_t)rw_tok(dir, c * 32 + pw * 8 + q);
        in[q][0] = f1[t * 2048 + lane]; in[q][1] = f1[t * 2048 + 512 + lane]; in[q][2] = f1[t * 2048 + 1536 + lane]; in[q][3] = f2[t * 2048 + lane]; in[q][4] = f2[t * 2048 + 1024 + lane];
        vin[q] = f1[t * 2048 + 1024 + rg * 8 + (lane & 7)]; }
}
__device__ __forceinline__ void rw_emit(const bf16_t (&in)[8][5], const bf16_t (&vin)[8], int pw, int lane, float ka, float* buf) {
#pragma unroll
    for (int q = 0; q < 8; ++q) {
        const float r = bf2f(in[q][0]), k = bf2f(in[q][1]), kk = bf2f(in[q][2]), u = bf2f(in[q][3]), a = bf2f(in[q][4]);
        const float w = 1.f - u, key = k * (1.f + (a - 1.f) * ka), kka = kk * a, wr = w * r;
        const float c1 = wave_sum(kka * r), c2 = wave_sum(key * r);
        float* rec = buf + (pw * 8 + q) * RW_REC;
        rec[lane] = kk; rec[64 + lane] = wr; rec[128 + lane] = w; rec[192 + lane] = kka; rec[256 + lane] = key;
        if (lane < 8) { f32x4 vc; vc[0] = bf2f(vin[q]); vc[1] = c1; vc[2] = c2; vc[3] = 0.f; *(f32x4*)(rec + 320 + lane * 4) = vc; }
    }
}

__device__ __forceinline__ void phase_rw_scan(int l, unsigned char* sm) {
    CParams& p = KPL(); const Ctx cx = mkctx();
    const int tid = cx.tid, lane = tid & 63, wid = __builtin_amdgcn_readfirstlane(tid >> 6);
    const bf16_t* F1 = (const bf16_t*)(p.ws + OFF_F1); const bf16_t* F2 = (const bf16_t*)(p.ws + OFF_Z);
    bf16_t* YRAW = (bf16_t*)(p.ws + OFF_R2);
    float* ring = (float*)sm;
    const bool is_scan = wid < 2, is_prod = (wid & 2) != 0;
    const int pw = (wid & 1) + ((wid >> 2) << 1);
    for (int item = cx.bid; item < 256; item += cx.nb) {
        const int chain = item >> 3, rg = item & 7; const int dir = chain >> 4, b = (chain >> 3) & 1, h = chain & 7;
        const float ka = p.in[31][l * 512 + h * 64 + lane];
        const bf16_t* f1 = F1 + (size_t)b * SEQA * 2048 + h * 64; const bf16_t* f2 = F2 + (size_t)b * SEQA * 2048 + dir * 512 + h * 64;
        const int row = rg * 8 + (wid & 1) * 4 + (lane >> 4);
        bf16_t* yr = YRAW + ((size_t)dir * T_TOK + (size_t)b * SEQA) * 512 + h * 64 + row;
        bf16_t pin[8][5], pvin[8];
        __syncthreads();
        if (is_prod) { rw_load(f1, f2, dir, rg, 0, pw, lane, pin, pvin); rw_emit(pin, pvin, pw, lane, ka, ring); rw_load(f1, f2, dir, rg, 1, pw, lane, pin, pvin); }
        __syncthreads();
        f32x2 S01 = (f32x2){0.f, 0.f}, S23 = (f32x2){0.f, 0.f};
        if (is_scan) __builtin_amdgcn_s_setprio(3);
#pragma unroll 1
        for (int c = 0; c < 264; ++c) {
            float* buf = ring + (c & 1) * (32 * RW_REC);
            if (is_prod) { if (c + 1 < 264) { rw_emit(pin, pvin, pw, lane, ka, ring + ((c + 1) & 1) * (32 * RW_REC)); rw_load(f1, f2, dir, rg, c + 2 < 264 ? c + 2 : c + 1, pw, lane, pin, pvin); } }
            else if (is_scan) {
                const float* rb = buf + (lane & 15) * 4;
                const float* vb = buf + 320 + ((wid & 1) * 4 + (lane >> 4)) * 4;
#pragma unroll 1
                for (int hf = 0; hf < 2; ++hf) {
                    const float* rh = rb + hf * 16 * RW_REC; const float* vh = vb + hf * 16 * RW_REC;
                    f32x4 kk4 = *(const f32x4*)(rh), wr4 = *(const f32x4*)(rh + 64), w4 = *(const f32x4*)(rh + 128), ka4 = *(const f32x4*)(rh + 192), ky4 = *(const f32x4*)(rh + 256), vc4 = *(const f32x4*)(vh);
                    f32x4 nkk = *(const f32x4*)(rh + RW_REC), nwr = *(const f32x4*)(rh + RW_REC + 64), nw = *(const f32x4*)(rh + RW_REC + 128), nka = *(const f32x4*)(rh + RW_REC + 192), nky = *(const f32x4*)(rh + RW_REC + 256), nvc = *(const f32x4*)(vh + RW_REC);
                    float ybuf = 0.f;
#pragma unroll
                    for (int j = 0; j < 16; ++j) {
                        f32x4 mkk, mwr, mw, mka, mky, mvc;
                        if (j < 14) { const int o = (j + 2) * RW_REC;
                            mkk = *(const f32x4*)(rh + o); mwr = *(const f32x4*)(rh + o + 64); mw = *(const f32x4*)(rh + o + 128); mka = *(const f32x4*)(rh + o + 192); mky = *(const f32x4*)(rh + o + 256); mvc = *(const f32x4*)(vh + o); }
                        const float vv = vc4[0];
                        f32x2 p1 = S01 * (f32x2){kk4[0], kk4[1]}; p1 = S23 * (f32x2){kk4[2], kk4[3]} + p1;
                        f32x2 p2 = S01 * (f32x2){wr4[0], wr4[1]}; p2 = S23 * (f32x2){wr4[2], wr4[3]} + p2;
                        const float sk = row16_sum(p1[0] + p1[1]);
                        const float q2 = row16_sum(p2[0] + p2[1]);
                        const f32x2 vv2 = (f32x2){vv, vv}, sk2 = (f32x2){sk, sk};
                        f32x2 t01 = (f32x2){ky4[0], ky4[1]} * vv2; t01 = t01 - (f32x2){ka4[0], ka4[1]} * sk2;
                        f32x2 t23 = (f32x2){ky4[2], ky4[3]} * vv2; t23 = t23 - (f32x2){ka4[2], ka4[3]} * sk2;
                        S01 = S01 * (f32x2){w4[0], w4[1]} + t01; S23 = S23 * (f32x2){w4[2], w4[3]} + t23;
                        const float y = q2 - sk * vc4[1] + vv * vc4[2];
                        if ((lane & 15) == j) ybuf = y;
                        kk4 = nkk; wr4 = nwr; w4 = nw; ka4 = nka; ky4 = nky; vc4 = nvc;
                        if (j < 14) { nkk = mkk; nwr = mwr; nw = mw; nka = mka; nky = mky; nvc = mvc; }
                        __builtin_amdgcn_sched_barrier(0);
                    }
                    yr[(size_t)rw_tok(dir, c * 32 + hf * 16 + (lane & 15)) * 512] = f2bf(ybuf);
                }
            }
            asm volatile("s_waitcnt lgkmcnt(0)" ::: "memory"); __builtin_amdgcn_s_barrier(); asm volatile("" ::: "memory");
        }
        if (is_scan) __builtin_amdgcn_s_setprio(0);
    }
}

__device__ __forceinline__ void phase_rw_out(int l) {
    CParams& p = KPL(); const Ctx cx = mkctx();
    const int lane = cx.tid & 63, gw = cx.bid * 8 + (cx.tid >> 6), nw = cx.nb * 8;
    const bf16_t* F1 = (const bf16_t*)(p.ws + OFF_F1); const bf16_t* F2 = (const bf16_t*)(p.ws + OFF_Z); const bf16_t* GRW = (const bf16_t*)(p.ws + OFF_ZRW);
    const bf16_t* YRAW = (const bf16_t*)(p.ws + OFF_R2);
    bf16_t* YC = (bf16_t*)(p.ws + OFF_YC);
    const int c0 = lane * 8;
    float ka[8], rk[8], lg[8], lb[8];
#pragma unroll
    for (int e = 0; e < 8; ++e) { ka[e] = p.in[31][l * 512 + c0 + e]; rk[e] = p.in[32][l * 512 + c0 + e]; lg[e] = p.in[33][l * 512 + c0 + e]; lb[e] = p.in[34][l * 512 + c0 + e]; }
    for (int row = gw; row < T_TOK; row += nw) {
        const u32x4 y0 = *(const u32x4*)(YRAW + (size_t)row * 512 + c0), y1 = *(const u32x4*)(YRAW + ((size_t)T_TOK + row) * 512 + c0);
        const u32x4 r4 = *(const u32x4*)(F1 + (size_t)row * 2048 + c0), k4 = *(const u32x4*)(F1 + (size_t)row * 2048 + 512 + c0), v4 = *(const u32x4*)(F1 + (size_t)row * 2048 + 1024 + c0);
        const u32x4 a04 = *(const u32x4*)(F2 + (size_t)row * 2048 + 1024 + c0), a14 = *(const u32x4*)(F2 + (size_t)row * 2048 + 1536 + c0);
        const u32x4 g4 = *(const u32x4*)(GRW + (size_t)row * 512 + c0);
        const unsigned ya[4] = {y0.x, y0.y, y0.z, y0.w}, yb[4] = {y1.x, y1.y, y1.z, y1.w}, rr[4] = {r4.x, r4.y, r4.z, r4.w}, kx[4] = {k4.x, k4.y, k4.z, k4.w}, vv[4] = {v4.x, v4.y, v4.z, v4.w};
        const unsigned aa[4] = {a04.x, a04.y, a04.z, a04.w}, ab[4] = {a14.x, a14.y, a14.z, a14.w}, gg[4] = {g4.x, g4.y, g4.z, g4.w};
        float y[8], sum = 0.f, bs = 0.f;
#pragma unroll
        for (int e = 0; e < 8; ++e) {
            const int w = e >> 1; const bool hi = e & 1;
            y[e] = (hi ? bfhi(ya[w]) : bflo(ya[w])) + (hi ? bfhi(yb[w]) : bflo(yb[w])); sum += y[e];
            const float r = hi ? bfhi(rr[w]) : bflo(rr[w]), k = hi ? bfhi(kx[w]) : bflo(kx[w]), a0 = hi ? bfhi(aa[w]) : bflo(aa[w]), a1 = hi ? bfhi(ab[w]) : bflo(ab[w]);
            bs += r * k * (2.f + (a0 + a1 - 2.f) * ka[e]) * rk[e];
        }
        sum = row8_sum(sum); bs = row8_sum(bs);
        const float mu = sum * (1.f / 64.f);
        float var = 0.f;
#pragma unroll
        for (int e = 0; e < 8; ++e) { const float d = y[e] - mu; var += d * d; }
        var = row8_sum(var) * (1.f / 64.f);
        const float rstd = rsqrtf(var + 64e-5f);
        float o[8];
#pragma unroll
        for (int e = 0; e < 8; ++e) { const int w = e >> 1; const bool hi = e & 1;
            const float v = hi ? bfhi(vv[w]) : bflo(vv[w]), g = hi ? bfhi(gg[w]) : bflo(gg[w]);
            o[e] = ((y[e] - mu) * rstd * lg[e] + lb[e] + bs * v) * g; }
        u32x4 o4; o4.x = pk2(o[0], o[1]); o4.y = pk2(o[2], o[3]); o4.z = pk2(o[4], o[5]); o4.w = pk2(o[6], o[7]);
        *(u32x4*)(YC + (size_t)row * 512 + c0) = o4;
    }
}

__device__ __forceinline__ void phase_final() {
    CParams& p = KPL(); const Ctx cx = mkctx();
    const int lane = cx.tid & 63, gw = cx.bid * 8 + (cx.tid >> 6), nw = cx.nb * 8;
    const float* X = (const float*)(p.ws + OFF_X);
    for (int r = gw; r < 2 * 8192; r += nw) {
        const int b = r >> 13, t = r & 8191;
        const float* src = X + ((size_t)b * SEQA + NCTX + t) * 1024;
        f32x4 v[4]; float ss = 0.f;
#pragma unroll
        for (int i = 0; i < 4; ++i) { v[i] = *(const f32x4*)(src + (lane + 64 * i) * 4); ss += v[i][0] * v[i][0] + v[i][1] * v[i][1] + v[i][2] * v[i][2] + v[i][3] * v[i][3]; }
        ss = wave_sum(ss);
        const float inv = rsqrtf(ss * (1.f / 1024.f) + 1e-6f);
#pragma unroll
        for (int i = 0; i < 4; ++i) { const int c = (lane + 64 * i) * 4; const f32x4 g4 = *(const f32x4*)(p.in[41] + c);
            *(f32x4*)(p.out + (size_t)r * 1024 + c) = v[i] * inv * g4; }
    }
}

#define XB_TMO      128
#define XB_XCNT(j)  (256  + 64 * (j))
#define XB_XSUB(j)  (1280 + 64 * (j))
#define XB_XGEN(j)  (2304 + 64 * (j))
#define XB_TOP      3328
#define XB_TOPGEN   3392
#define XCD_BAR_WORDS 3456
#define XB_SPIN_CAP (1u << 22)
constexpr int XB_LDS_OFF = 143344;
__device__ __forceinline__ unsigned xb_ld(unsigned* p)              { return __hip_atomic_load(p, __ATOMIC_RELAXED, __HIP_MEMORY_SCOPE_AGENT); }
__device__ __forceinline__ unsigned xb_add(unsigned* p, unsigned v) { return __hip_atomic_fetch_add(p, v, __ATOMIC_RELAXED, __HIP_MEMORY_SCOPE_AGENT); }
__device__ __forceinline__ unsigned xb_xcc_id() { return (unsigned)__builtin_amdgcn_s_getreg((3 << 11) | 20) & 0xFu; }
#define XB_SPIN(cond, bar) do { unsigned _sp = 0; while (cond) { __builtin_amdgcn_s_sleep(1); \
    if ((++_sp & 255u) == 0u) { if (xb_ld(&(bar)[XB_TMO])) break; if (_sp > XB_SPIN_CAP) { atomicAdd(&(bar)[XB_TMO], 1u); break; } } } } while (0)
__device__ __forceinline__ void xb_complete(unsigned* bar, unsigned x, unsigned G, unsigned& nloc, unsigned& nx) {
    unsigned sum, cnt, mine, sp = 0u;
    for (;;) {
        sum = 0u; cnt = 0u; mine = 0u;
#pragma unroll
        for (unsigned j = 0; j < 16; ++j) { const unsigned c = xb_ld(&bar[XB_XCNT(j)]); sum += c; cnt += (c > 0u) ? 1u : 0u; mine = (j == x) ? c : mine; }
        if (sum == G) break;
        __builtin_amdgcn_s_sleep(1);
        if ((++sp & 255u) == 0u) { if (xb_ld(&bar[XB_TMO])) break; if (sp > XB_SPIN_CAP) { atomicAdd(&bar[XB_TMO], 1u); break; } }
    }
    nloc = mine > 0u ? mine : 1u; nx = cnt > 0u ? cnt : 1u;
}
__device__ __forceinline__ void xb_post(unsigned char* smem) {
    CParams& p = KPL(); const Ctx cx = mkctx();
    volatile LAS unsigned* st = (volatile LAS unsigned*)((LAS unsigned char*)smem + XB_LDS_OFF);
    if (cx.tid == 0) { st[0] = 0u; st[1] = 0u; (void)xb_add(&((unsigned*)(p.ws + OFF_BAR))[XB_XCNT(xb_xcc_id())], 1u); }
    __syncthreads();
}
__device__ __forceinline__ void xsync(unsigned char* smem) {
    CParams& p = KPL(); const Ctx cx = mkctx();
    asm volatile("s_waitcnt vmcnt(0)" ::: "memory");
    __syncthreads();
    if (cx.tid == 0) {
        unsigned* bar = (unsigned*)(p.ws + OFF_BAR);
        volatile LAS unsigned* st = (volatile LAS unsigned*)((LAS unsigned char*)smem + XB_LDS_OFF);
        const unsigned x = xb_xcc_id();
        __builtin_amdgcn_s_waitcnt(0);
        unsigned nloc = st[0], nx = st[1];
        if (nloc == 0u) { xb_complete(bar, x, (unsigned)cx.nb, nloc, nx); st[0] = nloc; st[1] = nx; }
        const unsigned old = xb_add(&bar[XB_XSUB(x)], 1u);
        const unsigned gen = old / nloc;
        if (old + 1u == (gen + 1u) * nloc) {
            __builtin_amdgcn_fence(__ATOMIC_RELEASE, "agent");
            asm volatile("s_waitcnt vmcnt(0)" ::: "memory");
            const unsigned og = xb_add(&bar[XB_TOP], 1u);
            const unsigned tg = og / nx;
            if (og + 1u == (tg + 1u) * nx) xb_add(&bar[XB_TOPGEN], 1u);
            else XB_SPIN(xb_ld(&bar[XB_TOPGEN]) == tg, bar);
            __builtin_amdgcn_fence(__ATOMIC_ACQUIRE, "agent");
            xb_add(&bar[XB_XGEN(x)], 1u);
            asm volatile("s_waitcnt vmcnt(0)" ::: "memory");
        } else {
            XB_SPIN(xb_ld(&bar[XB_XGEN(x)]) == gen, bar);
            __builtin_amdgcn_fence(__ATOMIC_ACQUIRE, "agent");
            asm volatile("s_waitcnt vmcnt(0)" ::: "memory");
        }
    }
    __syncthreads();
}

#ifndef PHM
#define PHM 0xFFFFFFFFull
#endif
#ifndef PHR
#define PHR 0ull
#endif
#ifndef SYNCREP
#define SYNCREP 1
#endif
template <int WHICH>
__device__ __forceinline__ void gemm_stage(int l, LAS unsigned char* lds) {
    CParams& p = KPL(); const Ctx cx = mkctx();
    unsigned char* ws = p.ws;
    float* X = (float*)(ws + OFF_X); bf16_t* H = (bf16_t*)(ws + OFF_H); bf16_t* ZA = (bf16_t*)(ws + OFF_Z); bf16_t* ZRW = (bf16_t*)(ws + OFF_ZRW);
    bf16_t* W = (bf16_t*)(ws + OFF_W);
    const float* MODL = (const float*)(ws + OFF_MOD) + (size_t)l * 3 * 6144;
    if constexpr (WHICH == 0) run_gemm(cx, lds, H, W + W_MIX / 2, 4096, 1024, FInproj{ZA, (float*)(ws + OFF_MLG), ZRW});
    else if constexpr (WHICH == 1) run_gemm(cx, lds, (const bf16_t*)(ws + OFF_ZG), W + W_GLU / 2, 512, 512, FGlu{(const bf16_t*)(ws + OFF_ZG), p.in[18] + l * 512, (bf16_t*)(ws + OFF_YA)});
    else if constexpr (WHICH == 2) run_gemm_epi(cx, lds, (const bf16_t*)(ws + OFF_LORAIN), W + W_LORA / 2, 2560, 256, EpiLora{p.in[25] + l * 1024, p.in[27] + l * 1024, ZA, ZRW});
    else if constexpr (WHICH == 3) run_gemm(cx, lds, H, W + W_GATE / 2, 3072, 1024, FGate{ZA});
    else if constexpr (WHICH == 4) run_gemm(cx, lds, (const bf16_t*)(ws + OFF_YA), W + W_PA / 2, 1024, 512, FMerge<0>{ZA, (float*)(ws + OFF_F1), H});
    else if constexpr (WHICH == 5) run_gemm(cx, lds, (const bf16_t*)(ws + OFF_YB), W + W_PB / 2, 1024, 512, FMerge<1>{ZA, (float*)(ws + OFF_F1), H});
    else if constexpr (WHICH == 6) run_gemm(cx, lds, (const bf16_t*)(ws + OFF_YC), W + W_PC / 2, 1024, 512, FMerge<2>{ZA, (float*)(ws + OFF_F1), H});
    else if constexpr (WHICH == 7) run_gemm(cx, lds, H, W + W_OUT / 2, 1024, 1024, FResid{X, MODL, 2});
    else if constexpr (WHICH == 8) run_gemm(cx, lds, H, W + W_1 / 2, 4096, 1024, FMlp1{ZA});
    else run_gemm(cx, lds, ZA, W + W_2 / 2, 1024, 4096, FResid{X, MODL, 5});
}

template <int l>
__device__ __forceinline__ void run_layer(cg::grid_group& grid, LAS unsigned char* lds, float* smf, unsigned char* smem) {
        if constexpr ((PHM >> 1) & 1) { phase_wconv(l, smf); if constexpr ((PHR >> 1) & 1) { __syncthreads(); phase_wconv(l, smf); } }
        __syncthreads();
        if constexpr ((PHM >> 2) & 1) { phase_norm(l, 0, l == 0); if constexpr ((PHR >> 2) & 1) { __syncthreads(); phase_norm(l, 0, l == 0); } }
        for (int sr = 0; sr < SYNCREP; ++sr) xsync(smem);
        if constexpr ((PHM >> 3) & 1) { gemm_stage<0>(l, lds); if constexpr ((PHR >> 3) & 1) { __syncthreads(); gemm_stage<0>(l, lds); } }
        for (int sr = 0; sr < SYNCREP; ++sr) xsync(smem);
        if constexpr ((PHM >> 4) & 1) { phase_s5_local(l); if constexpr ((PHR >> 4) & 1) { __syncthreads(); phase_s5_local(l); } }
        if constexpr ((PHM >> 5) & 1) { phase_ml_conv(l); if constexpr ((PHR >> 5) & 1) { __syncthreads(); phase_ml_conv(l); } }
        for (int sr = 0; sr < SYNCREP; ++sr) xsync(smem);
        if constexpr ((PHM >> 6) & 1) { phase_s5_carry(l); if constexpr ((PHR >> 6) & 1) { __syncthreads(); phase_s5_carry(l); } }
        if constexpr ((PHM >> 7) & 1) { phase_ml_local(l, smem); if constexpr ((PHR >> 7) & 1) { __syncthreads(); phase_ml_local(l, smem); } }
        for (int sr = 0; sr < SYNCREP; ++sr) xsync(smem);
        if constexpr ((PHM >> 8) & 1) { phase_s5_final(l, smf); if constexpr ((PHR >> 8) & 1) { __syncthreads(); phase_s5_final(l, smf); } }
        if constexpr ((PHM >> 9) & 1) { phase_ml_carry(); if constexpr ((PHR >> 9) & 1) { __syncthreads(); phase_ml_carry(); } }
        for (int sr = 0; sr < SYNCREP; ++sr) xsync(smem);
        if constexpr ((PHM >> 10) & 1) { gemm_stage<1>(l, lds); if constexpr ((PHR >> 10) & 1) { __syncthreads(); gemm_stage<1>(l, lds); } }
        if constexpr ((PHM >> 11) & 1) { phase_ml_out(l, smem); if constexpr ((PHR >> 11) & 1) { __syncthreads(); phase_ml_out(l, smem); } }
        for (int sr = 0; sr < SYNCREP; ++sr) xsync(smem);
        if constexpr ((PHM >> 12) & 1) { phase_rw_feat(l); if constexpr ((PHR >> 12) & 1) { __syncthreads(); phase_rw_feat(l); } }
        for (int sr = 0; sr < SYNCREP; ++sr) xsync(smem);
        if constexpr ((PHM >> 13) & 1) { gemm_stage<2>(l, lds); if constexpr ((PHR >> 13) & 1) { __syncthreads(); gemm_stage<2>(l, lds); } }
        for (int sr = 0; sr < SYNCREP; ++sr) xsync(smem);
        if constexpr ((PHM >> 14) & 1) { phase_rw_scan(l, smem); if constexpr ((PHR >> 14) & 1) { __syncthreads(); phase_rw_scan(l, smem); } }
        for (int sr = 0; sr < SYNCREP; ++sr) xsync(smem);
        if constexpr ((PHM >> 15) & 1) { phase_rw_out(l); if constexpr ((PHR >> 15) & 1) { __syncthreads(); phase_rw_out(l); } }
        for (int sr = 0; sr < SYNCREP; ++sr) xsync(smem);
        if constexpr ((PHM >> 17) & 1) { gemm_stage<3>(l, lds); if constexpr ((PHR >> 17) & 1) { __syncthreads(); gemm_stage<3>(l, lds); } }
        for (int sr = 0; sr < SYNCREP; ++sr) xsync(smem);
        if constexpr ((PHM >> 18) & 1) { gemm_stage<4>(l, lds); if constexpr ((PHR >> 18) & 1) { __syncthreads(); gemm_stage<4>(l, lds); } }
        if constexpr ((PHM >> 19) & 1) { gemm_stage<5>(l, lds); if constexpr ((PHR >> 19) & 1) { __syncthreads(); gemm_stage<5>(l, lds); } }
        if constexpr ((PHM >> 20) & 1) { gemm_stage<6>(l, lds); if constexpr ((PHR >> 20) & 1) { __syncthreads(); gemm_stage<6>(l, lds); } }
        for (int sr = 0; sr < SYNCREP; ++sr) xsync(smem);
        if constexpr ((PHM >> 21) & 1) { gemm_stage<7>(l, lds); if constexpr ((PHR >> 21) & 1) { __syncthreads(); gemm_stage<7>(l, lds); } }
        for (int sr = 0; sr < SYNCREP; ++sr) xsync(smem);
        if constexpr ((PHM >> 22) & 1) { phase_norm(l, 1, false); if constexpr ((PHR >> 22) & 1) { __syncthreads(); phase_norm(l, 1, false); } }
        for (int sr = 0; sr < SYNCREP; ++sr) xsync(smem);
        if constexpr ((PHM >> 23) & 1) { gemm_stage<8>(l, lds); if constexpr ((PHR >> 23) & 1) { __syncthreads(); gemm_stage<8>(l, lds); } }
        for (int sr = 0; sr < SYNCREP; ++sr) xsync(smem);
        if constexpr ((PHM >> 24) & 1) { gemm_stage<9>(l, lds); if constexpr ((PHR >> 24) & 1) { __syncthreads(); gemm_stage<9>(l, lds); } }
        for (int sr = 0; sr < SYNCREP; ++sr) xsync(smem);
    }

__global__ void __launch_bounds__(512, 2) fwd_megakernel(Params p_unused) {
    extern __shared__ __attribute__((aligned(16))) unsigned char smem[];
    cg::grid_group grid = cg::this_grid();
    LAS unsigned char* lds = (LAS unsigned char*)smem;
    float* smf = (float*)smem;

    xb_post(smem);
    phase_mod(smf); phase_s5_params();
    grid.sync();
    run_layer<0>(grid, lds, smf, smem);
    run_layer<1>(grid, lds, smf, smem);
    run_layer<2>(grid, lds, smf, smem);
    run_layer<3>(grid, lds, smf, smem);
    phase_final();
}

extern "C" void kernel_launch(void* const* d_in, const int* in_sizes, int n_in, void* d_out, int out_size, void* d_ws, size_t ws_size, hipStream_t stream) {
    static int grid_blocks = 0;
    if (grid_blocks == 0) {
        if (n_in != 42 || ws_size < WS_END) { fprintf(stderr, "kernel_launch: unexpected n_in %d / ws_size %zu\n", n_in, ws_size); grid_blocks = -1; return; }
        int dev = 0, cus = 0, per_cu = 0;
        (void)hipGetDevice(&dev);
        (void)hipDeviceGetAttribute(&cus, hipDeviceAttributeMultiprocessorCount, dev);
        if (hipFuncSetAttribute((const void*)fwd_megakernel, hipFuncAttributeMaxDynamicSharedMemorySize, LDS_BYTES) != hipSuccess) { fprintf(stderr, "kernel_launch: hipFuncSetAttribute failed\n"); grid_blocks = -1; return; }
        if (hipOccupancyMaxActiveBlocksPerMultiprocessor(&per_cu, (const void*)fwd_megakernel, 512, LDS_BYTES) != hipSuccess || per_cu < 1) { fprintf(stderr, "kernel_launch: occupancy query says %d\n", per_cu); per_cu = 1; (void)hipGetLastError(); }
        grid_blocks = cus * 1;
    }
    if (grid_blocks < 0) return;
    if (hipMemsetAsync((unsigned char*)d_ws + OFF_BAR, 0, 16384, stream) != hipSuccess) { fprintf(stderr, "kernel_launch: memset failed\n"); return; }
    Params p{};
    for (int i = 0; i < 42; ++i) p.in[i] = (const float*)d_in[i];
    p.out = (float*)d_out; p.ws = (unsigned char*)d_ws;
    void* args[] = {&p};
    hipError_t e = hipLaunchCooperativeKernel((const void*)fwd_megakernel, dim3(grid_blocks), dim3(512), args, LDS_BYTES, stream);
    if (e != hipSuccess) fprintf(stderr, "cooperative launch failed: %s (grid %d)\n", hipGetErrorString(e), grid_blocks);
}
```

```cpp
#include <hip/hip_runtime.h>
#include <hip/hip_cooperative_groups.h>
#include <cstdio>
namespace cg = cooperative_groups;

#define LAS __attribute__((address_space(3)))
typedef unsigned short bf16_t;
typedef short bf16x8 __attribute__((ext_vector_type(8)));
typedef float f32x4 __attribute__((ext_vector_type(4)));
typedef unsigned u32x4 __attribute__((ext_vector_type(4)));
typedef unsigned u32x2 __attribute__((ext_vector_type(2)));

constexpr int T_TOK = 16896, SEQA = 8448, NCTX = 256;
constexpr int NLAYER = 4;
constexpr int LDS_BYTES = 143360;
constexpr size_t OFF_X = 0;
constexpr size_t OFF_H = 69206016;
constexpr size_t OFF_Z = 103809024;
constexpr size_t OFF_ZRW = OFF_Z + 69206016;
constexpr size_t OFF_MLG = 242221056;
constexpr size_t OFF_W = 243302400;
constexpr size_t OFF_YA = 281837568;
constexpr size_t OFF_YB = 299139072;
constexpr size_t OFF_YC = 316440576;
constexpr size_t OFF_F1 = 333742080;
constexpr size_t OFF_MOD = 402948096;
constexpr size_t OFF_S5P = 403243008;
constexpr size_t OFF_MLS = OFF_S5P + 4 * 589824;
constexpr size_t OFF_R2 = OFF_MLS + 16384;
constexpr size_t OFF_BAR = OFF_R2 + 34603008;
constexpr size_t WS_END = OFF_BAR + 16384;
constexpr size_t OFF_CLOC = OFF_F1;
constexpr size_t OFF_S5ST = OFF_F1 + 34873344;
constexpr size_t OFF_QKC = OFF_F1 + 43524096;
constexpr size_t OFF_ZG = OFF_R2;
constexpr size_t OFF_LORAIN = OFF_R2 + 17301504;
constexpr size_t W_MIX = 0, W_GATE = 8388608, W_GLU = 14680064, W_LORA = 15204352, W_PA = 16515072, W_PB = 17563648, W_PC = 18612224, W_OUT = 19660800, W_1 = 21757952, W_2 = 30146560;

struct Params {
    const float* in[42];
    float* out;
    unsigned char* ws;
};

typedef const __attribute__((address_space(4))) Params CParams;
__device__ __forceinline__ CParams& KPL() {
    unsigned long long a = (unsigned long long)__builtin_amdgcn_kernarg_segment_ptr();
    asm volatile("" : "+s"(a));
    return *(CParams*)a;
}
struct Ctx { int tid, bid, nb; };
__device__ __forceinline__ Ctx mkctx() { Ctx c; c.tid = threadIdx.x; c.bid = blockIdx.x; c.nb = gridDim.x; asm volatile("" : "+v"(c.tid), "+s"(c.bid), "+s"(c.nb)); return c; }
__device__ __forceinline__ float bf2f(unsigned v) { return __uint_as_float(v << 16); }
__device__ __forceinline__ float bflo(unsigned w) { return __uint_as_float(w << 16); }
__device__ __forceinline__ float bfhi(unsigned w) { return __uint_as_float(w & 0xffff0000u); }
__device__ __forceinline__ bf16_t f2bf(float f) { unsigned u = __float_as_uint(f); u += 0x7FFFu + ((u >> 16) & 1u); return (bf16_t)(u >> 16); }
__device__ __forceinline__ unsigned pk2(float lo, float hi) { return (unsigned)f2bf(lo) | ((unsigned)f2bf(hi) << 16); }
__device__ __forceinline__ void store4bf(bf16_t* p, f32x4 v) { u32x2 r; r.x = pk2(v[0], v[1]); r.y = pk2(v[2], v[3]); *(u32x2*)p = r; }
__device__ __forceinline__ float sigmoidf_(float x) { return 1.f / (1.f + __expf(-x)); }

#define DPP_F(x, ctrl, rmask) __int_as_float(__builtin_amdgcn_update_dpp(0, __float_as_int(x), ctrl, rmask, 0xF, false))
__device__ __forceinline__ float row8_sum(float x) {
    x += DPP_F(x, 0xB1, 0xF); x += DPP_F(x, 0x4E, 0xF); x += DPP_F(x, 0x141, 0xF); return x;
}
__device__ __forceinline__ float row16_sum(float x) {
    x += DPP_F(x, 0xB1, 0xF); x += DPP_F(x, 0x4E, 0xF); x += DPP_F(x, 0x141, 0xF); x += DPP_F(x, 0x140, 0xF); return x;
}
__device__ __forceinline__ float wave_sum(float x) {
    x = row16_sum(x);
    x += DPP_F(x, 0x142, 0xA);
    x += DPP_F(x, 0x143, 0xC);
    return __int_as_float(__builtin_amdgcn_readlane(__float_as_int(x), 63));
}

namespace pg8 {
constexpr int BM = 256, BK = 64, HALF = 128, HTB = HALF * BK * 2, NXCD = 8, WGM = 8;
__device__ __forceinline__ int lds_byte(int r, int c) { const int st = (r >> 4) * 2 + (c >> 5), rr = r & 15, cc = c & 31, ob = rr * 64 + cc * 2; return st * 1024 + (ob ^ (((ob >> 9) & 1) << 5)); }
__device__ __forceinline__ void stage_rc(int b, int& R, int& C) { const int st = b / 1024, sb = b % 1024, swz = sb ^ (((sb >> 9) & 1) << 5); R = (st >> 1) * 16 + swz / 64; C = (st & 1) * 32 + (swz % 64) / 2; }
struct Unit { int pm, pn; };
struct Gemm { const bf16_t* A; const bf16_t* Bt; int M, N, K; };
struct StaticOrder {
    int nM, nN, nwg, G, c, skipctx;
    __device__ void init(int M, int N, int G_, int c_, int skip_ = 0) { nM = M / BM - 2 * skip_; nN = N / BM; nwg = nM * nN; G = G_; c = c_; skipctx = skip_; }
    __device__ bool next(int i, Unit& u) const {
        const long L = (long)i * G + c; if (L >= nwg) return false;
        int wgid = (int)L; { const int q = nwg / NXCD, r = nwg % NXCD, xcd = wgid % NXCD, off = wgid / NXCD; wgid = (xcd < r ? xcd * (q + 1) : r * (q + 1) + (xcd - r) * q) + off; }
        const int nig = WGM * nN, gid = wgid / nig, fm = gid * WGM, gsz = (nM - fm) < WGM ? (nM - fm) : WGM;
        u.pm = fm + ((wgid % nig) % gsz); u.pn = (wgid % nig) / gsz;
        if (skipctx) u.pm += (u.pm >= 32) ? 2 : 1;
        return true;
    }
};

template <class Epi>
__device__ __forceinline__ void gemm_phase(int tid_in, LAS unsigned char* lds, const Gemm g, const StaticOrder& S, const Epi& E) {
    const int tid = tid_in, wid = __builtin_amdgcn_readfirstlane(tid >> 6), lane = tid & 63, wr = wid >> 2, wc = wid & 3, fr = lane & 15, fq = lane >> 4;
    const int K = g.K, nt = K / BK;
    unsigned voffA[2], voffB[2];
#pragma unroll
    for (int i = 0; i < 2; ++i) { int R, C; stage_rc(tid * 16 + i * 8192, R, C); voffA[i] = (unsigned)(R * K + C) * 2u; voffB[i] = voffA[i]; }
    const size_t kstep = (size_t)(BK * 2);
    const size_t hstep = (size_t)HALF * K * 2;
    const size_t tstep = 2 * hstep;
    const unsigned ldsw = (unsigned)wid * 1024u;
    const int aoff = lds_byte(wr * 64 + fr, fq * 8), boff = lds_byte(wc * 32 + fr, fq * 8);
#define PG8_SA(b, h) (((b) * 2 + (h)) * HTB)
#define PG8_SB(b, h) ((4 + (b) * 2 + (h)) * HTB)
#define PG8_STAGE(bufoff, gbase, voff) do { _Pragma("unroll") for (int _i = 0; _i < 2; ++_i) \
        __builtin_amdgcn_global_load_lds((const unsigned*)((const char*)(gbase) + (voff)[_i]), (LAS unsigned*)(lds + (bufoff) + ldsw + _i * 8192), 16, 0, 0); } while (0)
#define PG8_LDA(dst, b, h) do { _Pragma("unroll") for (int m = 0; m < 4; ++m) _Pragma("unroll") for (int k = 0; k < 2; ++k) dst[m][k] = *(const LAS bf16x8*)(lds + PG8_SA(b, h) + aoff + m * 2048 + k * 1024); } while (0)
#define PG8_LDB(dst, b, h) do { _Pragma("unroll") for (int n = 0; n < 2; ++n) _Pragma("unroll") for (int k = 0; k < 2; ++k) dst[n][k] = *(const LAS bf16x8*)(lds + PG8_SB(b, h) + boff + n * 2048 + k * 1024); } while (0)
#define PG8_MMA(ai, bj, At, Bt) do { __builtin_amdgcn_s_setprio(1); _Pragma("unroll") for (int m = 0; m < 4; ++m) _Pragma("unroll") for (int n = 0; n < 2; ++n) _Pragma("unroll") for (int k = 0; k < 2; ++k) \
        acc[ai][bj][m][n] = __builtin_amdgcn_mfma_f32_16x16x32_bf16(Bt[n][k], At[m][k], acc[ai][bj][m][n], 0, 0, 0); __builtin_amdgcn_s_setprio(0); } while (0)
#define PG8_WAIT_V(n) asm volatile("s_waitcnt vmcnt(" #n ")" ::: "memory")
#define PG8_WAIT_L(n) asm volatile("s_waitcnt lgkmcnt(" #n ")" ::: "memory")
#define PG8_BAR __builtin_amdgcn_s_barrier()
#define PG8_SCHED __builtin_amdgcn_sched_barrier(0)
    Unit cur, nxt; int ui = 0;
    if (!S.next(0, cur)) return;
    f32x4 acc[2][2][4][2];
#pragma unroll
    for (int a = 0; a < 2; ++a)
#pragma unroll
        for (int b = 0; b < 2; ++b)
#pragma unroll
            for (int m = 0; m < 4; ++m)
#pragma unroll
                for (int n = 0; n < 2; ++n) acc[a][b][m][n] = (f32x4){0.f, 0.f, 0.f, 0.f};
    bf16x8 At[4][2], B0[2][2], B1[2][2];
    const char* cA = (const char*)g.A + (size_t)cur.pm * tstep; const char* cB = (const char*)g.Bt + (size_t)cur.pn * tstep;
    PG8_STAGE(PG8_SB(0, 0), cB, voffB); PG8_STAGE(PG8_SA(0, 0), cA, voffA); PG8_STAGE(PG8_SB(0, 1), cB + hstep, voffB); PG8_STAGE(PG8_SA(0, 1), cA + hstep, voffA);
    if (wr == 1) PG8_BAR;
    PG8_WAIT_V(4); PG8_BAR;
    PG8_STAGE(PG8_SB(1, 0), cB + kstep, voffB); PG8_STAGE(PG8_SA(1, 0), cA + kstep, voffA); PG8_STAGE(PG8_SB(1, 1), cB + hstep + kstep, voffB);
    PG8_WAIT_V(6); PG8_BAR;
    for (;;) {
        const bool has_next = S.next(ui + 1, nxt);
        const char* nA = has_next ? (const char*)g.A + (size_t)nxt.pm * tstep : cA; const char* nB = has_next ? (const char*)g.Bt + (size_t)nxt.pn * tstep : cB;
        for (int t = 0; t < nt; t += 2) {
            const bool last = (t == nt - 2);
            const char* a1 = cA + (size_t)(t + 1) * kstep;
            const char* a2 = last ? nA : cA + (size_t)(t + 2) * kstep; const char* b2 = last ? nB : cB + (size_t)(t + 2) * kstep;
            const char* a3 = a2 + kstep; const char* b3 = b2 + kstep;
            PG8_LDB(B0, 0, 0); PG8_SCHED; PG8_LDA(At, 0, 0); PG8_STAGE(PG8_SA(1, 1), a1 + hstep, voffA);
            PG8_WAIT_L(8); PG8_BAR; PG8_WAIT_L(0); PG8_MMA(0, 0, At, B0); PG8_BAR; PG8_SCHED;
            PG8_LDB(B1, 0, 1); PG8_STAGE(PG8_SB(0, 0), b2, voffB);
            PG8_BAR; PG8_WAIT_L(0); PG8_MMA(0, 1, At, B1); PG8_BAR;
            PG8_LDA(At, 0, 1); PG8_STAGE(PG8_SA(0, 0), a2, voffA);
            PG8_BAR; PG8_WAIT_L(0); PG8_MMA(1, 0, At, B0); PG8_BAR; PG8_SCHED;
            PG8_STAGE(PG8_SB(0, 1), b2 + hstep, voffB);
            PG8_WAIT_V(6); PG8_BAR; PG8_MMA(1, 1, At, B1); PG8_BAR;
            PG8_LDB(B0, 1, 0); PG8_SCHED; PG8_LDA(At, 1, 0); PG8_STAGE(PG8_SA(0, 1), a2 + hstep, voffA);
            PG8_WAIT_L(8); PG8_BAR; PG8_WAIT_L(0); PG8_MMA(0, 0, At, B0); PG8_BAR; PG8_SCHED;
            PG8_LDB(B1, 1, 1); PG8_STAGE(PG8_SB(1, 0), b3, voffB);
            PG8_BAR; PG8_WAIT_L(0); PG8_MMA(0, 1, At, B1); PG8_BAR;
            PG8_LDA(At, 1, 1); PG8_STAGE(PG8_SA(1, 0), a3, voffA);
            PG8_BAR; PG8_WAIT_L(0); PG8_MMA(1, 0, At, B0); PG8_BAR; PG8_SCHED;
            PG8_STAGE(PG8_SB(1, 1), b3 + hstep, voffB);
            PG8_WAIT_V(6); PG8_BAR; PG8_MMA(1, 1, At, B1); PG8_BAR;
        }
        E(acc, cur, wr, wc, fr, fq);
        if (!has_next) break;
#pragma unroll
        for (int a = 0; a < 2; ++a)
#pragma unroll
            for (int b = 0; b < 2; ++b)
#pragma unroll
                for (int m = 0; m < 4; ++m)
#pragma unroll
                    for (int n = 0; n < 2; ++n) acc[a][b][m][n] = (f32x4){0.f, 0.f, 0.f, 0.f};
        cur = nxt; cA = nA; cB = nB; ++ui;
    }
    PG8_WAIT_V(0);
    if (wr == 0) PG8_BAR;
    PG8_BAR;
#undef PG8_SA
#undef PG8_SB
#undef PG8_STAGE
#undef PG8_LDA
#undef PG8_LDB
#undef PG8_MMA
#undef PG8_WAIT_V
#undef PG8_WAIT_L
#undef PG8_BAR
#undef PG8_SCHED
}

template <class F> struct EpiT {
    F f;
    __device__ __forceinline__ void operator()(const f32x4 (&acc)[2][2][4][2], const Unit& u, int wr, int wc, int fr, int fq) const {
        const int row0 = u.pm * BM + wr * 64 + fr, col0 = u.pn * BM + wc * 32 + 4 * fq;
#pragma unroll
        for (int ai = 0; ai < 2; ++ai)
#pragma unroll
            for (int m = 0; m < 4; ++m) {
                const int row = row0 + ai * HALF + m * 16;
#pragma unroll
                for (int bj = 0; bj < 2; ++bj)
#pragma unroll
                    for (int n = 0; n < 2; ++n) f(row, col0 + bj * HALF + n * 16, acc[ai][bj][m][n]);
            }
    }
};
}

template <class F>
__device__ __forceinline__ void run_gemm(const Ctx& cx, LAS unsigned char* lds, const bf16_t* A, const bf16_t* Bt, int N, int K, const F& f, int skip = 0) {
    pg8::Gemm g; g.A = A; g.Bt = Bt; g.M = T_TOK; g.N = N; g.K = K;
    pg8::StaticOrder S; S.init(T_TOK, N, cx.nb, cx.bid, skip);
    pg8::EpiT<F> E{f};
    pg8::gemm_phase(cx.tid, lds, g, S, E);
}

template <class E>
__device__ __forceinline__ void run_gemm_epi(const Ctx& cx, LAS unsigned char* lds, const bf16_t* A, const bf16_t* Bt, int N, int K, const E& e) {
    pg8::Gemm g; g.A = A; g.Bt = Bt; g.M = T_TOK; g.N = N; g.K = K;
    pg8::StaticOrder S; S.init(T_TOK, N, cx.nb, cx.bid);
    pg8::gemm_phase(cx.tid, lds, g, S, e);
}
__device__ __forceinline__ int row_vec(int row) { const int b = row >= SEQA ? 1 : 0; const int t = row - b * SEQA; return t < NCTX ? 2 : b; }

struct FInproj { bf16_t* za; float* mlg; bf16_t* zrw;
    __device__ __forceinline__ void operator()(int row, int col, f32x4 v) const {
        if (col < 2048) store4bf(za + (size_t)row * 2048 + col, v);
        else if (col < 2064) *(f32x4*)(mlg + (size_t)row * 16 + (col - 2048)) = v;
        else if (col < 3856) store4bf(zrw + (size_t)row * 1792 + (col - 2064), v);
    } };
struct FGlu { const bf16_t* zg; const float* bglu; bf16_t* ya;
    __device__ __forceinline__ void operator()(int row, int col, f32x4 v) const {
        const u32x2 z = *(const u32x2*)(zg + (size_t)row * 512 + col); const f32x4 b = *(const f32x4*)(bglu + col);
        f32x4 o; o[0] = bflo(z.x) * sigmoidf_(v[0] + b[0]); o[1] = bfhi(z.x) * sigmoidf_(v[1] + b[1]); o[2] = bflo(z.y) * sigmoidf_(v[2] + b[2]); o[3] = bfhi(z.y) * sigmoidf_(v[3] + b[3]);
        store4bf(ya + (size_t)row * 512 + col, o);
    } };
struct EpiLora { const float* w0; const float* a0; bf16_t* f2; bf16_t* grw;
    __device__ __forceinline__ void operator()(const f32x4 (&acc)[2][2][4][2], const pg8::Unit& u, int wr, int wc, int fr, int fq) const {
        const int row0 = u.pm * 256 + wr * 64 + fr, col0 = u.pn * 256 + wc * 32 + 4 * fq;
        const int pn = __builtin_amdgcn_readfirstlane(u.pn);
        if (pn < 8) {
            const float* bias = pn < 4 ? w0 : a0 - 1024;
#pragma unroll
            for (int bj = 0; bj < 2; ++bj)
#pragma unroll
                for (int n = 0; n < 2; ++n) {
                    const int col = col0 + bj * 128 + n * 16;
                    const f32x4 b = *(const f32x4*)(bias + col);
#pragma unroll
                    for (int ai = 0; ai < 2; ++ai)
#pragma unroll
                        for (int m = 0; m < 4; ++m) {
                            const int row = row0 + ai * 128 + m * 16; f32x4 o;
#pragma unroll
                            for (int e = 0; e < 4; ++e) { const float s = sigmoidf_(acc[ai][bj][m][n][e] + b[e]); o[e] = pn < 4 ? 1.f - __expf(-0.60653065971f * s) : s; }
                            store4bf(f2 + (size_t)row * 2048 + col, o);
                        }
                }
        } else {
#pragma unroll
            for (int ai = 0; ai < 2; ++ai)
#pragma unroll
                for (int m = 0; m < 4; ++m) { const int row = row0 + ai * 128 + m * 16;
#pragma unroll
                    for (int bj = 0; bj < 2; ++bj)
#pragma unroll
                        for (int n = 0; n < 2; ++n) store4bf(grw + (size_t)row * 512 + (col0 + bj * 128 + n * 16 - 2048), acc[ai][bj][m][n]); }
        }
    } };
struct FGate { bf16_t* g;
    __device__ __forceinline__ void operator()(int row, int col, f32x4 v) const {
        f32x4 o; o[0] = sigmoidf_(v[0]); o[1] = sigmoidf_(v[1]); o[2] = sigmoidf_(v[2]); o[3] = sigmoidf_(v[3]);
        store4bf(g + (size_t)row * 3072 + col, o);
    } };
template <int J> struct FMerge { const bf16_t* g; float* y32; bf16_t* ybf;
    __device__ __forceinline__ void operator()(int row, int col, f32x4 v) const {
        const u32x2 z = *(const u32x2*)(g + (size_t)row * 3072 + J * 1024 + col);
        f32x4 o; o[0] = bflo(z.x) * v[0]; o[1] = bfhi(z.x) * v[1]; o[2] = bflo(z.y) * v[2]; o[3] = bfhi(z.y) * v[3];
        float* yp = y32 + (size_t)row * 1024 + col;
        if (J == 0) *(f32x4*)yp = o;
        else if (J == 1) { f32x4 t = *(f32x4*)yp; *(f32x4*)yp = t + o; }
        else { f32x4 t = *(f32x4*)yp; store4bf(ybf + (size_t)row * 1024 + col, t + o); }
    } };
struct FResid { float* x; const float* modl; int chunk;
    __device__ __forceinline__ void operator()(int row, int col, f32x4 v) const {
        const f32x4 mg = *(const f32x4*)(modl + row_vec(row) * 6144 + chunk * 1024 + col);
        float* xp = x + (size_t)row * 1024 + col; f32x4 t = *(f32x4*)xp; *(f32x4*)xp = t + mg * v;
    } };
struct FMlp1 { bf16_t* hid;
    __device__ __forceinline__ void operator()(int row, int col, f32x4 v) const {
        f32x4 o;
#pragma unroll
        for (int e = 0; e < 4; ++e) { const float r = fmaxf(v[e], 0.f); o[e] = r * r; }
        store4bf(hid + (size_t)row * 4096 + col, o);
    } };

__device__ __forceinline__ void phase_mod(float* smf) {
    CParams& p = KPL(); const Ctx cx = mkctx();
    const int tid = cx.tid, lane = tid & 63, wid = tid >> 6;
    float* sc = smf; float* red = smf + 3072;
    float* MOD = (float*)(p.ws + OFF_MOD);
    for (int i = tid; i < 3072; i += 512) { const int v = i >> 10, j = i & 1023; const float c = v < 2 ? p.in[1][v * 1024 + j] : p.in[3][j]; sc[i] = c / (1.f + expf(-c)); }
    __syncthreads();
    for (int item = cx.bid; item < 4 * 96; item += cx.nb) {
        const int l = item / 96, jt = item % 96, j = jt * 64 + lane;
        const float* w = p.in[4] + (size_t)l * 1024 * 6144 + j;
        float a0 = 0.f, a1 = 0.f, a2 = 0.f;
#pragma unroll 8
        for (int i = wid * 128; i < wid * 128 + 128; ++i) { const float wv = w[(size_t)i * 6144]; a0 += sc[i] * wv; a1 += sc[1024 + i] * wv; a2 += sc[2048 + i] * wv; }
        red[(wid * 3 + 0) * 64 + lane] = a0; red[(wid * 3 + 1) * 64 + lane] = a1; red[(wid * 3 + 2) * 64 + lane] = a2;
        __syncthreads();
        if (tid < 192) { const int v = tid >> 6; float s = 0.f;
            for (int w8 = 0; w8 < 8; ++w8) s += red[(w8 * 3 + v) * 64 + lane];
            MOD[(l * 3 + v) * 6144 + j] = s + p.in[5][l * 6144 + j]; }
        __syncthreads();
    }
}

__device__ __forceinline__ void dsincos(double x, double& s, double& c) {
    const double k = rint(x * 0.63661977236758134308);
    double r = fma(-k, 1.57079632679489655800, x); r = fma(-k, 6.12323399573676603587e-17, r);
    const double r2 = r * r;
    double ps = -1.0 / 355687428096000.0;
    ps = fma(ps, r2, 1.0 / 1307674368000.0); ps = fma(ps, r2, -1.0 / 6227020800.0); ps = fma(ps, r2, 1.0 / 39916800.0); ps = fma(ps, r2, -1.0 / 362880.0);
    ps = fma(ps, r2, 1.0 / 5040.0); ps = fma(ps, r2, -1.0 / 120.0); ps = fma(ps, r2, 1.0 / 6.0); ps = fma(ps, r2, -1.0); ps = -ps * r;
    double pc = 1.0 / 20922789888000.0;
    pc = fma(pc, r2, -1.0 / 87178291200.0); pc = fma(pc, r2, 1.0 / 479001600.0); pc = fma(pc, r2, -1.0 / 3628800.0); pc = fma(pc, r2, 1.0 / 40320.0);
    pc = fma(pc, r2, -1.0 / 720.0); pc = fma(pc, r2, 1.0 / 24.0); pc = fma(pc, r2, -0.5); pc = fma(pc, r2, 1.0);
    const int q = ((int)k) & 3;
    s = (q == 0) ? ps : (q == 1) ? pc : (q == 2) ? -ps : -pc;
    c = (q == 0) ? pc : (q == 1) ? -ps : (q == 2) ? -pc : ps;
}
__device__ __forceinline__ double dexp_neg(double x) {
    const double k = rint(x * 1.44269504088896338700);
    double r = fma(-k, 0.693147180369123816490, x); r = fma(-k, 1.90821492927058770002e-10, r);
    double pe = 1.0 / 6227020800.0;
    pe = fma(pe, r, 1.0 / 479001600.0); pe = fma(pe, r, 1.0 / 39916800.0); pe = fma(pe, r, 1.0 / 3628800.0); pe = fma(pe, r, 1.0 / 362880.0); pe = fma(pe, r, 1.0 / 40320.0);
    pe = fma(pe, r, 1.0 / 5040.0); pe = fma(pe, r, 1.0 / 720.0); pe = fma(pe, r, 1.0 / 120.0); pe = fma(pe, r, 1.0 / 24.0); pe = fma(pe, r, 1.0 / 6.0); pe = fma(pe, r, 0.5);
    pe = fma(pe, r, 1.0); pe = fma(pe, r, 1.0);
    int ki = (int)k; if (ki < -1000) return 0.0;
    return pe * __longlong_as_double((long long)(1023 + ki) << 52);
}

__device__ __forceinline__ void wconv_tile(const Ctx& cx, const float* src, int ld, int K, int c0, int ncols, bf16_t* dst, int kt, int nt, float* tile) {
    const int tid = cx.tid, j = tid & 63, i0 = tid >> 6;
#pragma unroll
    for (int e = 0; e < 8; ++e) { const int i = i0 + 8 * e; const int n = nt * 64 + j;
        tile[i * 65 + j] = (n < ncols) ? src[(size_t)(kt * 64 + i) * ld + c0 + n] : 0.f; }
    __syncthreads();
#pragma unroll
    for (int e = 0; e < 8; ++e) { const int jj = i0 + 8 * e;
        dst[(size_t)(nt * 64 + jj) * K + kt * 64 + j] = f2bf(tile[j * 65 + jj]); }
    __syncthreads();
}

template <int MODE>
__device__ __forceinline__ void phase_wconv(int l, float* smf) {
    CParams& p = KPL(); const Ctx cx = mkctx();
    bf16_t* W = (bf16_t*)(p.ws + OFF_W);
    const int tid = cx.tid;
    unsigned* ticket = (unsigned*)(p.ws + OFF_BAR) + 3520 + l * 16;
    int* tslot = (int*)smf + 8192;
    for (int it = (MODE == 2 ? 0 : cx.bid); ; it += cx.nb) {
        int item;
        if (MODE == 0) { item = it; if (item >= 5184) break; }
        else if (MODE == 1) { item = 3520 + it; if (item >= 4544) break; }
        else {
            if (tid == 0) *tslot = (int)__hip_atomic_fetch_add(ticket, 1u, __ATOMIC_RELAXED, __HIP_MEMORY_SCOPE_AGENT);
            __syncthreads();
            const int q = *tslot;
            __syncthreads();
            if (q >= 4160) break;
            item = q < 3520 ? q : q + 1024;
        }
        if (item < 4544) {
            const float* src; int ld, K, c0, ncols, nN; bf16_t* dst; int t = item;
            if (t < 1024) { src = p.in[8] + (size_t)l * 1024 * 6928; ld = 6928; K = 1024; c0 = 0; ncols = 3856; nN = 64; dst = W + W_MIX / 2; }
            else if (t < 1792) { t -= 1024; src = p.in[8] + (size_t)l * 1024 * 6928; ld = 6928; K = 1024; c0 = 3856; ncols = 3072; nN = 48; dst = W + W_GATE / 2; }
            else if (t < 1856) { t -= 1792; src = p.in[17] + (size_t)l * 512 * 512; ld = 512; K = 512; c0 = 0; ncols = 512; nN = 8; dst = W + W_GLU / 2; }
            else if (t < 1984) { t -= 1856; src = p.in[35] + (size_t)l * 512 * 1024; ld = 1024; K = 512; c0 = 0; ncols = 1024; nN = 16; dst = W + W_PA / 2; }
            else if (t < 2112) { t -= 1984; src = p.in[36] + (size_t)l * 512 * 1024; ld = 1024; K = 512; c0 = 0; ncols = 1024; nN = 16; dst = W + W_PB / 2; }
            else if (t < 2240) { t -= 2112; src = p.in[37] + (size_t)l * 512 * 1024; ld = 1024; K = 512; c0 = 0; ncols = 1024; nN = 16; dst = W + W_PC / 2; }
            else if (t < 2496) { t -= 2240; src = p.in[38] + (size_t)l * 1024 * 1024; ld = 1024; K = 1024; c0 = 0; ncols = 1024; nN = 16; dst = W + W_OUT / 2; }
            else if (t < 3520) { t -= 2496; src = p.in[39] + (size_t)l * 1024 * 4096; ld = 4096; K = 1024; c0 = 0; ncols = 4096; nN = 64; dst = W + W_1 / 2; }
            else { t -= 3520; src = p.in[40] + (size_t)l * 4096 * 1024; ld = 1024; K = 4096; c0 = 0; ncols = 1024; nN = 16; dst = W + W_2 / 2; }
            const int nt = t % nN, kt = t / nN;
            wconv_tile(cx, src, ld, K, c0, ncols, dst, kt, nt, smf);
        } else {
            bf16_t* dst = W + W_LORA / 2;
#pragma unroll
            for (int q = 0; q < 2; ++q) {
                const int e = (item - 4544) * 1024 + q * 512 + tid; const int n = e >> 8, k = e & 255;
                float v = 0.f;
                if (n < 1024) { if (k < 64) v = p.in[26][(((size_t)l * 2 + (n >> 9)) * 64 + k) * 512 + (n & 511)]; }
                else if (n < 2048) { if (k >= 64 && k < 128) v = p.in[28][(((size_t)l * 2 + ((n - 1024) >> 9)) * 64 + (k - 64)) * 512 + (n & 511)]; }
                else { if (k >= 128) v = p.in[29][((size_t)l * 128 + (k - 128)) * 512 + (n - 2048)]; }
                dst[e] = f2bf(v);
            }
        }
    }
}

__device__ __forceinline__ void phase_s5_params() {
    CParams& p = KPL(); const Ctx cx = mkctx();
    for (int item = cx.bid; item < 32; item += cx.nb) {
        const int l = item >> 3;
        const int idx = (item & 7) * 512 + cx.tid;
        const int dir = idx >> 11, g = (idx >> 6) & 31;
        float* S5P = (float*)(p.ws + OFF_S5P) + (size_t)l * 147456;
        const size_t pi = (size_t)l * 4096 + idx;
        const double lre = fmin((double)p.in[9][pi], -1e-4), lim = (double)p.in[10][pi];
        const double dt = dexp_neg((double)p.in[11][(l * 2 + dir) * 32 + g]);
        const double mag = dexp_neg(lre * dt); double sn, cs; dsincos(lim * dt, sn, cs);
        const double ar = mag * cs, ai = mag * sn;
        const double den = lre * lre + lim * lim, nr = ar - 1.0;
        const double cr = (nr * lre + ai * lim) / den, ci = (ai * lre - nr * lim) / den;
        const double mag64 = dexp_neg(64.0 * lre * dt); dsincos(64.0 * lim * dt, sn, cs);
        S5P[idx] = (float)ar; S5P[4096 + idx] = (float)ai; S5P[8192 + idx] = (float)(mag64 * cs); S5P[12288 + idx] = (float)(mag64 * sn);
        float* BR = S5P + 16384; float* BI = BR + 65536;
        for (int c = 0; c < 16; ++c) { const double bre = p.in[12][pi * 16 + c], bim = p.in[13][pi * 16 + c];
            BR[(size_t)idx * 16 + c] = (float)(cr * bre - ci * bim); BI[(size_t)idx * 16 + c] = (float)(cr * bim + ci * bre); }
    }
}

__device__ __forceinline__ void phase_norm(int l, int which, bool init) {
    CParams& p = KPL(); const Ctx cx = mkctx();
    const int lane = cx.tid & 63, gw = cx.bid * 8 + (cx.tid >> 6), nw = cx.nb * 8;
    float* X = (float*)(p.ws + OFF_X); bf16_t* H = (bf16_t*)(p.ws + OFF_H);
    const float* MODL = (const float*)(p.ws + OFF_MOD) + (size_t)l * 3 * 6144;
    const float* gam = p.in[which ? 7 : 6] + l * 1024;
    for (int row = gw; row < T_TOK; row += nw) {
        const int b = row >= SEQA ? 1 : 0, t = row - b * SEQA;
        const float* src = init ? (t < NCTX ? p.in[2] + ((size_t)b * NCTX + t) * 1024 : p.in[0] + ((size_t)b * 8192 + (t - NCTX)) * 1024) : X + (size_t)row * 1024;
        f32x4 v[4]; float ss = 0.f;
#pragma unroll
        for (int i = 0; i < 4; ++i) { v[i] = *(const f32x4*)(src + (lane + 64 * i) * 4); ss += v[i][0] * v[i][0] + v[i][1] * v[i][1] + v[i][2] * v[i][2] + v[i][3] * v[i][3]; }
        if (init) {
#pragma unroll
            for (int i = 0; i < 4; ++i) *(f32x4*)(X + (size_t)row * 1024 + (lane + 64 * i) * 4) = v[i];
        }
        ss = wave_sum(ss);
        const float inv = rsqrtf(ss * (1.f / 1024.f) + 1e-6f);
        const float* mv = MODL + (t < NCTX ? 2 : b) * 6144 + (which ? 3 : 0) * 1024;
#pragma unroll
        for (int i = 0; i < 4; ++i) { const int c = (lane + 64 * i) * 4;
            const f32x4 g4 = *(const f32x4*)(gam + c), sh = *(const f32x4*)(mv + c), scl = *(const f32x4*)(mv + 1024 + c);
            f32x4 o;
#pragma unroll
            for (int e = 0; e < 4; ++e) o[e] = v[i][e] * inv * g4[e] * (1.f + scl[e]) + sh[e];
            store4bf(H + (size_t)row * 1024 + c, o); }
    }
}

__device__ __forceinline__ int s5_order(int dir, int i) { return dir == 0 ? i : (i < 4 ? 3 - i : 135 - i); }

__device__ __forceinline__ void phase_s5_local(int l) {
    CParams& p = KPL(); const Ctx cx = mkctx();
    const int lane = cx.tid & 63, gw = cx.bid * 8 + (cx.tid >> 6), nw = cx.nb * 8;
    const bf16_t* ZA = (const bf16_t*)(p.ws + OFF_Z);
    const float* S5P = (const float*)(p.ws + OFF_S5P) + (size_t)l * 147456; const float* BR = S5P + 16384; const float* BI = BR + 65536;
    float* ST = (float*)(p.ws + OFF_S5ST);
    for (int item0 = gw; item0 < 16896; item0 += nw) {
        const int item = __builtin_amdgcn_readfirstlane(item0);
        const int chunk = item % 132, g = (item / 132) & 31, dir = (item / 4224) & 1, b = item / 8448;
        const int idx = dir * 2048 + g * 64 + lane;
        const float ar = S5P[idx], ai = S5P[4096 + idx];
        float br[16], bi[16];
#pragma unroll
        for (int q = 0; q < 4; ++q) { const f32x4 t0 = *(const f32x4*)(BR + (size_t)idx * 16 + q * 4), t1 = *(const f32x4*)(BI + (size_t)idx * 16 + q * 4);
#pragma unroll
            for (int e = 0; e < 4; ++e) { br[q * 4 + e] = t0[e]; bi[q * 4 + e] = t1[e]; } }
        const int row = b * SEQA + chunk * 64 + lane;
        const u32x4 u0 = *(const u32x4*)(ZA + (size_t)row * 2048 + g * 16), u1 = *(const u32x4*)(ZA + (size_t)row * 2048 + g * 16 + 8);
        unsigned ur[8] = {u0.x, u0.y, u0.z, u0.w, u1.x, u1.y, u1.z, u1.w};
        float hr = 0.f, hi = 0.f;
#pragma unroll 8
        for (int j = 0; j < 64; ++j) {
            const int tok = dir ? 63 - j : j;
            float bur = 0.f, bui = 0.f;
#pragma unroll
            for (int q = 0; q < 8; ++q) { const unsigned w = (unsigned)__builtin_amdgcn_readlane((int)ur[q], tok); const float x0 = bflo(w), x1 = bfhi(w);
                bur += br[2 * q] * x0 + br[2 * q + 1] * x1; bui += bi[2 * q] * x0 + bi[2 * q + 1] * x1; }
            const float nr = ar * hr - ai * hi + bur, ni = ar * hi + ai * hr + bui; hr = nr; hi = ni;
        }
        float* st = ST + ((((size_t)b * 2 + dir) * 32 + g) * 132 + chunk) * 128;
        st[lane] = hr; st[64 + lane] = hi;
    }
}

__device__ __forceinline__ void phase_s5_carry(int l) {
    CParams& p = KPL(); const Ctx cx = mkctx();
    const int lane = cx.tid & 63, gw = cx.bid * 8 + (cx.tid >> 6), nw = cx.nb * 8;
    const float* S5P = (const float*)(p.ws + OFF_S5P) + (size_t)l * 147456;
    float* ST = (float*)(p.ws + OFF_S5ST);
    for (int item0 = gw; item0 < 128; item0 += nw) {
        const int item = __builtin_amdgcn_readfirstlane(item0);
        const int g = item & 31, dir = (item >> 5) & 1, b = item >> 6;
        const int idx = dir * 2048 + g * 64 + lane;
        const float ar = S5P[8192 + idx], ai = S5P[12288 + idx];
        float* st = ST + (((size_t)b * 2 + dir) * 32 + g) * 132 * 128;
        float hr = 0.f, hi = 0.f;
        for (int i0 = 0; i0 < 132; i0 += 12) {
            float lr[12], li[12];
#pragma unroll
            for (int e = 0; e < 12; ++e) { const int c = s5_order(dir, i0 + e); lr[e] = st[c * 128 + lane]; li[e] = st[c * 128 + 64 + lane]; }
#pragma unroll
            for (int e = 0; e < 12; ++e) { const int c = s5_order(dir, i0 + e); st[c * 128 + lane] = hr; st[c * 128 + 64 + lane] = hi;
                const float nr = ar * hr - ai * hi + lr[e], ni = ar * hi + ai * hr + li[e]; hr = nr; hi = ni; }
        }
    }
}

template <int DIR>
__device__ __forceinline__ void s5_final_dir(CParams& p, int l, int b, int g, int chunk, int lane, const unsigned (&ur)[8], float* hst, f32x4* ybuf, int row0, float dsk, bf16_t* ZG) {
    const float* S5P = (const float*)(p.ws + OFF_S5P) + (size_t)l * 147456; const float* BR = S5P + 16384; const float* BI = BR + 65536;
    const float* ST = (const float*)(p.ws + OFF_S5ST);
    const bf16_t* ZA = (const bf16_t*)(p.ws + OFF_Z);
    const int idx = DIR * 2048 + g * 64 + lane;
    const float ar = S5P[idx], ai = S5P[4096 + idx];
    float br[16], bi[16];
#pragma unroll
    for (int q = 0; q < 4; ++q) { const f32x4 t0 = *(const f32x4*)(BR + (size_t)idx * 16 + q * 4), t1 = *(const f32x4*)(BI + (size_t)idx * 16 + q * 4);
#pragma unroll
        for (int e = 0; e < 4; ++e) { br[q * 4 + e] = t0[e]; bi[q * 4 + e] = t1[e]; } }
    float cbr[16], cbi[16];
    { const size_t cb = ((((size_t)l * 2 + DIR) * 32 + g) * 16 + (lane & 15)) * 64 + (lane >> 4);
#pragma unroll
      for (int i = 0; i < 16; ++i) { cbr[i] = p.in[14][cb + 4 * i]; cbi[i] = -p.in[15][cb + 4 * i]; } }
    const float* st = ST + ((((size_t)b * 2 + DIR) * 32 + g) * 132 + chunk) * 128;
    float hr = st[lane], hi = st[64 + lane];
    const int ch = g * 16 + (lane & 15);
#pragma unroll 1
    for (int si = 0; si < 4; ++si) {
        const int sc = DIR ? 3 - si : si;
#pragma unroll
        for (int jj = 0; jj < 16; ++jj) {
            const int tt = DIR ? 15 - jj : jj; const int tok = sc * 16 + tt;
            float bur = 0.f, bui = 0.f;
#pragma unroll
            for (int q = 0; q < 8; ++q) { const unsigned w = (unsigned)__builtin_amdgcn_readlane((int)ur[q], tok); const float x0 = bflo(w), x1 = bfhi(w);
                bur += br[2 * q] * x0 + br[2 * q + 1] * x1; bui += bi[2 * q] * x0 + bi[2 * q + 1] * x1; }
            const float nr = ar * hr - ai * hi + bur, ni = ar * hi + ai * hr + bui; hr = nr; hi = ni;
            hst[tt * 68 + lane] = hr; hst[1088 + tt * 68 + lane] = hi;
        }
        f32x4 a = (f32x4){0.f, 0.f, 0.f, 0.f};
        if (DIR) a = ybuf[sc * 64 + lane];
#pragma unroll
        for (int i = 0; i < 16; ++i) {
            const float xr = hst[(lane & 15) * 68 + 4 * i + (lane >> 4)], xi = hst[1088 + (lane & 15) * 68 + 4 * i + (lane >> 4)];
            a = __builtin_amdgcn_mfma_f32_16x16x4f32(xr, cbr[i], a, 0, 0, 0);
            a = __builtin_amdgcn_mfma_f32_16x16x4f32(xi, cbi[i], a, 0, 0, 0);
        }
        if (!DIR) ybuf[sc * 64 + lane] = a;
        else {
#pragma unroll
            for (int j = 0; j < 4; ++j) {
                const int row = row0 + sc * 16 + (lane >> 4) * 4 + j;
                const float u = bf2f(ZA[(size_t)row * 2048 + ch]);
                const float y = u * dsk + a[j];
                const float z = 0.5f * y * (1.f + tanhf(0.7978845608028654f * (y + 0.044715f * y * y * y)));
                ZG[(size_t)row * 512 + ch] = f2bf(z);
            }
        }
    }
}

__device__ __forceinline__ void phase_s5_final(int l, float* smf) {
    CParams& p = KPL(); const Ctx cx = mkctx();
    const int lane = cx.tid & 63, wid = cx.tid >> 6, gw = cx.bid * 8 + wid, nw = cx.nb * 8;
    const bf16_t* ZA = (const bf16_t*)(p.ws + OFF_Z);
    bf16_t* ZG = (bf16_t*)(p.ws + OFF_ZG);
    float* hst = smf + wid * 3200;
    f32x4* ybuf = (f32x4*)(hst + 2176);
    for (int item0 = gw; item0 < 8448; item0 += nw) {
        const int item = __builtin_amdgcn_readfirstlane(item0);
        const int chunk = item % 132, g = (item / 132) & 31, b = item / 4224;
        const int row0 = b * SEQA + chunk * 64;
        const u32x4 u0 = *(const u32x4*)(ZA + (size_t)(row0 + lane) * 2048 + g * 16), u1 = *(const u32x4*)(ZA + (size_t)(row0 + lane) * 2048 + g * 16 + 8);
        const unsigned ur[8] = {u0.x, u0.y, u0.z, u0.w, u1.x, u1.y, u1.z, u1.w};
        const float dsk = p.in[16][l * 512 + g * 16 + (lane & 15)];
        s5_final_dir<0>(p, l, b, g, chunk, lane, ur, hst, ybuf, row0, dsk, ZG);
        s5_final_dir<1>(p, l, b, g, chunk, lane, ur, hst, ybuf, row0, dsk, ZG);
    }
}

__device__ __forceinline__ int ml_row0(int b, int nc) { return b * SEQA + nc * 128; }
__device__ __forceinline__ int ml_order(int dir, int i) { return dir == 0 ? i : (i < 2 ? 1 - i : 67 - i); }

__device__ __forceinline__ void phase_ml_conv(int l) {
    CParams& p = KPL(); const Ctx cx = mkctx();
    const bf16_t* ZA = (const bf16_t*)(p.ws + OFF_Z);
    bf16_t* QKC = (bf16_t*)(p.ws + OFF_QKC);
    const float* cw = p.in[19] + (size_t)l * 9 * 512; const float* cb = p.in[20] + l * 512;
    for (int idx = cx.bid * 512 + cx.tid; idx < T_TOK * 64; idx += cx.nb * 512) {
        const int row = idx >> 6, c8 = (idx & 63) * 8;
        const int b = row >= SEQA ? 1 : 0, t = row - b * SEQA;
        const bool isctx = t < NCTX;
        const int tt = isctx ? t : t - NCTX, W = isctx ? 256 : 64, Hh = isctx ? 1 : 128;
        const int y = tt / W, x = tt % W;
        const int segrow0 = row - tt;
        float acc[8];
#pragma unroll
        for (int e = 0; e < 8; ++e) acc[e] = cb[c8 + e];
#pragma unroll
        for (int dy = 0; dy < 3; ++dy)
#pragma unroll
            for (int dx = 0; dx < 3; ++dx) {
                const int yy = y + dy - 1, xx = x + dx - 1;
                if (yy >= 0 && yy < Hh && xx >= 0 && xx < W) {
                    const u32x4 z = *(const u32x4*)(ZA + (size_t)(segrow0 + yy * W + xx) * 2048 + 512 + c8);
                    const float* w = cw + (dy * 3 + dx) * 512 + c8;
                    const f32x4 w0 = *(const f32x4*)w, w1 = *(const f32x4*)(w + 4);
                    acc[0] += bflo(z.x) * w0[0]; acc[1] += bfhi(z.x) * w0[1]; acc[2] += bflo(z.y) * w0[2]; acc[3] += bfhi(z.y) * w0[3];
                    acc[4] += bflo(z.z) * w1[0]; acc[5] += bfhi(z.z) * w1[1]; acc[6] += bflo(z.w) * w1[2]; acc[7] += bfhi(z.w) * w1[3];
                }
            }
        u32x4 o;
#pragma unroll
        for (int e = 0; e < 8; ++e) acc[e] = acc[e] * sigmoidf_(acc[e]);
        o.x = pk2(acc[0], acc[1]); o.y = pk2(acc[2], acc[3]); o.z = pk2(acc[4], acc[5]); o.w = pk2(acc[6], acc[7]);
        *(u32x4*)(QKC + (size_t)row * 512 + c8) = o;
    }
}

constexpr int ML_QS = 0, ML_KS = 18432, ML_VT = 36864, ML_CS = 71680, ML_PS = 92416, ML_GV = 127232, ML_BV = 127744, ML_MV = 128256, ML_LF = 128768, ML_IG = 129280, ML_SC = 129792;

__device__ __forceinline__ void ml_gate_vectors(const Ctx& cx, CParams& p, int l, int dir, int b, int h, int nc, unsigned char* sm, float m_in) {
    const int tid = cx.tid, lane = tid & 63;
    float* lf = (float*)(sm + ML_LF); float* ig = (float*)(sm + ML_IG); float* gv = (float*)(sm + ML_GV); float* bv = (float*)(sm + ML_BV); float* mv = (float*)(sm + ML_MV); float* sc = (float*)(sm + ML_SC);
    const float* MLG = (const float*)(p.ws + OFF_MLG);
    const float* gb = p.in[21] + l * 16;
    if (tid < 128) {
        const int row = ml_row0(b, nc) + tid;
        const float ip = MLG[(size_t)row * 16 + dir * 4 + h] + gb[dir * 4 + h];
        const float fp = MLG[(size_t)row * 16 + 8 + dir * 4 + h] + gb[8 + dir * 4 + h];
        ig[tid] = ip; lf[tid] = fminf(fp, 0.f) - log1pf(expf(-fabsf(fp)));
    }
    __syncthreads();
    if (tid < 64) {
        const int pp0 = 2 * lane, pp1 = 2 * lane + 1; const int s0 = dir ? 127 - pp0 : pp0, s1 = dir ? 127 - pp1 : pp1;
        const float x0 = lf[s0], x1 = lf[s1];
        float incl = x0 + x1;
#pragma unroll
        for (int d = 1; d < 64; d <<= 1) { const float t = __shfl_up(incl, d); if (lane >= d) incl += t; }
        const float g1 = incl, g0 = incl - x1;
        const float gtot = __shfl(incl, 63);
        const float b0 = ig[s0] - g0, b1 = ig[s1] - g1;
        float mx = fmaxf(b0, b1);
#pragma unroll
        for (int d = 1; d < 64; d <<= 1) { const float t = __shfl_up(mx, d); if (lane >= d) mx = fmaxf(mx, t); }
        const float prev = __shfl_up(mx, 1);
        const float pm0 = lane > 0 ? fmaxf(prev, b0) : b0, pm1 = mx;
        const float bmax = __shfl(mx, 63);
        gv[s0] = g0; gv[s1] = g1; bv[s0] = b0; bv[s1] = b1; mv[s0] = fmaxf(m_in, pm0); mv[s1] = fmaxf(m_in, pm1);
        if (lane == 0) { sc[0] = gtot; sc[1] = bmax; }
    }
    __syncthreads();
}

__device__ __forceinline__ void phase_ml_local(int l, unsigned char* sm) {
    CParams& p = KPL(); const Ctx cx = mkctx();
    const int tid = cx.tid, lane = tid & 63, wid = tid >> 6;
    const bf16_t* ZA = (const bf16_t*)(p.ws + OFF_Z); const bf16_t* QKC = (const bf16_t*)(p.ws + OFF_QKC);
    float* CLOC = (float*)(p.ws + OFF_CLOC); float* MLS = (float*)(p.ws + OFF_MLS);
    bf16_t* VT = (bf16_t*)(sm + ML_VT); bf16_t* KT = (bf16_t*)(sm + ML_KS);
    const float* bv = (const float*)(sm + ML_BV); const float* sc = (const float*)(sm + ML_SC);
    float* wg = (float*)(sm + ML_LF);
    for (int item = cx.bid; item < 1056; item += cx.nb) {
        const int chain = item / 66, nc = item % 66; const int dir = chain >> 3, b = (chain >> 2) & 1, h = chain & 3;
        ml_gate_vectors(cx, p, l, dir, b, h, nc, sm, -1e30f);
        const float gtot = sc[0], bmax = sc[1];
        __syncthreads();
        if (tid < 128) wg[tid] = expf(bv[tid] - bmax);
        __syncthreads();
        const int row0 = ml_row0(b, nc);
#pragma unroll
        for (int q = 0; q < 4; ++q) { const int ci = q * 512 + tid; const int s = ci >> 4, v8 = (ci & 15) * 8;
            const u32x4 z = *(const u32x4*)(ZA + (size_t)(row0 + s) * 2048 + 1024 + h * 128 + v8); const float w = wg[s];
            const unsigned zz[4] = {z.x, z.y, z.z, z.w};
#pragma unroll
            for (int e = 0; e < 4; ++e) { VT[(v8 + 2 * e) * 136 + s] = f2bf(bflo(zz[e]) * w); VT[(v8 + 2 * e + 1) * 136 + s] = f2bf(bfhi(zz[e]) * w); } }
#pragma unroll
        for (int q = 0; q < 2; ++q) { const int ci = q * 512 + tid; const int s = ci >> 3, k8 = (ci & 7) * 8;
            const u32x4 z = *(const u32x4*)(QKC + (size_t)(row0 + s) * 512 + 256 + h * 64 + k8);
            const unsigned zz[4] = {z.x, z.y, z.z, z.w};
#pragma unroll
            for (int e = 0; e < 4; ++e) { KT[(k8 + 2 * e) * 136 + s] = (bf16_t)(zz[e] & 0xffff); KT[(k8 + 2 * e + 1) * 136 + s] = (bf16_t)(zz[e] >> 16); } }
        __syncthreads();
        float* dst = CLOC + ((size_t)chain * 66 + nc) * 8256;
        f32x4 acc[4];
#pragma unroll
        for (int n = 0; n < 4; ++n) acc[n] = (f32x4){0.f, 0.f, 0.f, 0.f};
#pragma unroll
        for (int ks = 0; ks < 4; ++ks) {
            const bf16x8 a = *(const bf16x8*)(VT + (16 * wid + (lane & 15)) * 136 + ks * 32 + (lane >> 4) * 8);
#pragma unroll
            for (int n = 0; n < 4; ++n) { const bf16x8 bb = *(const bf16x8*)(KT + (16 * n + (lane & 15)) * 136 + ks * 32 + (lane >> 4) * 8);
                acc[n] = __builtin_amdgcn_mfma_f32_16x16x32_bf16(a, bb, acc[n], 0, 0, 0); }
        }
#pragma unroll
        for (int n = 0; n < 4; ++n)
#pragma unroll
            for (int j = 0; j < 4; ++j) dst[(16 * wid + (lane >> 4) * 4 + j) * 64 + 16 * n + (lane & 15)] = acc[n][j];
        if (tid < 64) { float s = 0.f; for (int t = 0; t < 128; ++t) s += wg[t] * bf2f(KT[tid * 136 + t]); dst[8192 + tid] = s; }
        if (tid == 0) { MLS[chain * 66 + nc] = gtot; MLS[1056 + chain * 66 + nc] = gtot + bmax; }
        __syncthreads();
    }
}

__device__ __forceinline__ void phase_ml_carry() {
    CParams& p = KPL(); const Ctx cx = mkctx();
    float* CLOC = (float*)(p.ws + OFF_CLOC); float* MLS = (float*)(p.ws + OFF_MLS);
    for (int idx = cx.bid * 512 + cx.tid; idx < 16 * 8256; idx += cx.nb * 512) {
        const int chain = idx / 8256, e = idx % 8256; const int dir = chain >> 3;
        float* base = CLOC + (size_t)chain * 66 * 8256 + e;
        float m = -1e30f, C = 0.f;
        for (int i0 = 0; i0 < 66; i0 += 6) {
            float cl[6];
#pragma unroll
            for (int q = 0; q < 6; ++q) cl[q] = base[(size_t)ml_order(dir, i0 + q) * 8256];
#pragma unroll
            for (int q = 0; q < 6; ++q) { const int nc = ml_order(dir, i0 + q);
                const float gt = MLS[chain * 66 + nc], am = MLS[1056 + chain * 66 + nc];
                base[(size_t)nc * 8256] = C;
                if (e == 0) MLS[2112 + chain * 66 + nc] = m;
                const float mn = fmaxf(gt + m, am); const float so = expf(gt + m - mn), sl = expf(am - mn);
                C = so * C + sl * cl[q]; m = mn; }
        }
    }
}

__device__ __forceinline__ void phase_ml_out(int l, unsigned char* sm) {
    CParams& p = KPL(); const Ctx cx = mkctx();
    const int tid = cx.tid, lane = tid & 63, wid = tid >> 6;
    const bf16_t* ZA = (const bf16_t*)(p.ws + OFF_Z); const bf16_t* QKC = (const bf16_t*)(p.ws + OFF_QKC);
    const float* CLOC = (const float*)(p.ws + OFF_CLOC); const float* MLS = (const float*)(p.ws + OFF_MLS);
    bf16_t* YB = (bf16_t*)(p.ws + OFF_YB);
    bf16_t* QS = (bf16_t*)(sm + ML_QS); bf16_t* KS = (bf16_t*)(sm + ML_KS); bf16_t* VT = (bf16_t*)(sm + ML_VT); bf16_t* CS = (bf16_t*)(sm + ML_CS); bf16_t* PS = (bf16_t*)(sm + ML_PS);
    const float* gv = (const float*)(sm + ML_GV); const float* bv = (const float*)(sm + ML_BV); const float* mv = (const float*)(sm + ML_MV);
    for (int item = cx.bid; item < 528; item += cx.nb) {
        const int b = item / 264, h = (item / 66) & 3, nc = item % 66;
        const int row0 = ml_row0(b, nc);
        __syncthreads();
#pragma unroll
        for (int q = 0; q < 2; ++q) { const int ci = q * 512 + tid; const int s = ci >> 3, k8 = (ci & 7) * 8;
            const u32x4 zq = *(const u32x4*)(QKC + (size_t)(row0 + s) * 512 + h * 64 + k8);
            u32x4 o; o.x = pk2(bflo(zq.x) * 0.125f, bfhi(zq.x) * 0.125f); o.y = pk2(bflo(zq.y) * 0.125f, bfhi(zq.y) * 0.125f); o.z = pk2(bflo(zq.z) * 0.125f, bfhi(zq.z) * 0.125f); o.w = pk2(bflo(zq.w) * 0.125f, bfhi(zq.w) * 0.125f);
            *(u32x4*)(QS + s * 72 + k8) = o;
            *(u32x4*)(KS + s * 72 + k8) = *(const u32x4*)(QKC + (size_t)(row0 + s) * 512 + 256 + h * 64 + k8); }
#pragma unroll
        for (int q = 0; q < 4; ++q) { const int ci = q * 512 + tid; const int s = ci >> 4, v8 = (ci & 15) * 8;
            const u32x4 z = *(const u32x4*)(ZA + (size_t)(row0 + s) * 2048 + 1024 + h * 128 + v8);
            const unsigned zz[4] = {z.x, z.y, z.z, z.w};
#pragma unroll
            for (int e = 0; e < 4; ++e) { VT[(v8 + 2 * e) * 136 + s] = (bf16_t)(zz[e] & 0xffff); VT[(v8 + 2 * e + 1) * 136 + s] = (bf16_t)(zz[e] >> 16); } }
        f32x4 hsum[8];
#pragma unroll
        for (int v = 0; v < 8; ++v) hsum[v] = (f32x4){0.f, 0.f, 0.f, 0.f};
#pragma unroll 1
        for (int dir = 0; dir < 2; ++dir) {
            const int chain = dir * 8 + b * 4 + h;
            const float m_in = MLS[2112 + chain * 66 + nc];
            __syncthreads();
            ml_gate_vectors(cx, p, l, dir, b, h, nc, sm, m_in);
            const float* cin = CLOC + ((size_t)chain * 66 + nc) * 8256;
#pragma unroll
            for (int q = 0; q < 4; ++q) { const int ci = q * 512 + tid; const int v = ci >> 4, k4 = (ci & 15) * 4;
                const f32x4 c = *(const f32x4*)(cin + v * 64 + k4); store4bf(CS + v * 72 + k4, c); }
            if (tid < 16) { const f32x4 c = *(const f32x4*)(cin + 8192 + tid * 4); store4bf(CS + 128 * 72 + tid * 4, c); }
            else if (tid < 256) { const int r = 129 + (tid - 16) / 16, k4 = ((tid - 16) & 15) * 4; store4bf(CS + r * 72 + k4, (f32x4){0.f, 0.f, 0.f, 0.f}); }
            __syncthreads();
            const int tr = 16 * wid + (lane >> 4) * 4;
            float Mt[4], rs[4] = {0.f, 0.f, 0.f, 0.f};
#pragma unroll
            for (int j = 0; j < 4; ++j) Mt[j] = mv[tr + j];
            bf16x8 qa[2];
#pragma unroll
            for (int ks = 0; ks < 2; ++ks) qa[ks] = *(const bf16x8*)(QS + (16 * wid + (lane & 15)) * 72 + ks * 32 + (lane >> 4) * 8);
#pragma unroll
            for (int nt = 0; nt < 8; ++nt) {
                f32x4 s4 = (f32x4){0.f, 0.f, 0.f, 0.f};
#pragma unroll
                for (int ks = 0; ks < 2; ++ks) { const bf16x8 kb = *(const bf16x8*)(KS + (16 * nt + (lane & 15)) * 72 + ks * 32 + (lane >> 4) * 8);
                    s4 = __builtin_amdgcn_mfma_f32_16x16x32_bf16(qa[ks], kb, s4, 0, 0, 0); }
                const int s = 16 * nt + (lane & 15); const float bs = bv[s];
#pragma unroll
                for (int j = 0; j < 4; ++j) { const int t = tr + j; const bool valid = dir ? (s >= t) : (s <= t);
                    const float pv = valid ? s4[j] * expf(bs - Mt[j]) : 0.f; rs[j] += pv; PS[t * 136 + s] = f2bf(pv); }
            }
#pragma unroll
            for (int j = 0; j < 4; ++j) rs[j] = row16_sum(rs[j]);
            __syncthreads();
            f32x4 qn = (f32x4){0.f, 0.f, 0.f, 0.f};
#pragma unroll
            for (int ks = 0; ks < 2; ++ks) { const bf16x8 cb = *(const bf16x8*)(CS + (128 + (lane & 15)) * 72 + ks * 32 + (lane >> 4) * 8);
                qn = __builtin_amdgcn_mfma_f32_16x16x32_bf16(qa[ks], cb, qn, 0, 0, 0); }
            float wi[4], dn[4];
#pragma unroll
            for (int j = 0; j < 4; ++j) { const float qnj = row16_sum(qn[j]); wi[j] = expf(m_in - Mt[j]);
                const float den = rs[j] + wi[j] * qnj; const float mt = gv[tr + j] + Mt[j]; dn[j] = 1.f / fmaxf(fabsf(den), expf(-mt)); }
            bf16x8 pa[4];
#pragma unroll
            for (int ks = 0; ks < 4; ++ks) pa[ks] = *(const bf16x8*)(PS + (16 * wid + (lane & 15)) * 136 + ks * 32 + (lane >> 4) * 8);
#pragma unroll
            for (int vt = 0; vt < 8; ++vt) {
                f32x4 a1 = (f32x4){0.f, 0.f, 0.f, 0.f}, a2 = (f32x4){0.f, 0.f, 0.f, 0.f};
#pragma unroll
                for (int ks = 0; ks < 4; ++ks) { const bf16x8 vb = *(const bf16x8*)(VT + (16 * vt + (lane & 15)) * 136 + ks * 32 + (lane >> 4) * 8);
                    a1 = __builtin_amdgcn_mfma_f32_16x16x32_bf16(pa[ks], vb, a1, 0, 0, 0); }
#pragma unroll
                for (int ks = 0; ks < 2; ++ks) { const bf16x8 cb = *(const bf16x8*)(CS + (16 * vt + (lane & 15)) * 72 + ks * 32 + (lane >> 4) * 8);
                    a2 = __builtin_amdgcn_mfma_f32_16x16x32_bf16(qa[ks], cb, a2, 0, 0, 0); }
#pragma unroll
                for (int j = 0; j < 4; ++j) hsum[vt][j] += (a1[j] + wi[j] * a2[j]) * dn[j];
            }
        }
        const int tr = 16 * wid + (lane >> 4) * 4;
        float rinv[4];
#pragma unroll
        for (int j = 0; j < 4; ++j) { float ss = 0.f;
#pragma unroll
            for (int vt = 0; vt < 8; ++vt) ss += hsum[vt][j] * hsum[vt][j];
            ss = row16_sum(ss); rinv[j] = rsqrtf(ss * (1.f / 128.f) + 1e-6f); }
#pragma unroll
        for (int vt = 0; vt < 8; ++vt) { const int ch = h * 128 + 16 * vt + (lane & 15); const float ng = p.in[22][l * 512 + ch];
#pragma unroll
            for (int j = 0; j < 4; ++j) { const int row = row0 + tr + j;
                const float o = bf2f(ZA[(size_t)row * 2048 + 1536 + ch]);
                YB[(size_t)row * 512 + ch] = f2bf(hsum[vt][j] * rinv[j] * ng * sigmoidf_(o)); } }
    }
}

__device__ __forceinline__ void phase_rw_feat(int l) {
    CParams& p = KPL(); const Ctx cx = mkctx();
    const int lane = cx.tid & 63, gw = cx.bid * 8 + (cx.tid >> 6), nw = cx.nb * 8;
    const bf16_t* ZRW = (const bf16_t*)(p.ws + OFF_ZRW);
    bf16_t* F1 = (bf16_t*)(p.ws + OFF_F1); bf16_t* LIN = (bf16_t*)(p.ws + OFF_LORAIN);
    const float* mup = p.in[23] + (size_t)l * 1792; const float* mun = p.in[24] + (size_t)l * 1792;
    const float* kk_w = p.in[30] + l * 512;
    for (int row = gw; row < T_TOK; row += nw) {
        const int b = row >= SEQA ? 1 : 0, t = row - b * SEQA;
        const bool hasp = !(t == 0 || t == NCTX), hasn = !(t == NCTX - 1 || t == SEQA - 1);
        const bf16_t* zc = ZRW + (size_t)row * 1792;
#pragma unroll
        for (int q = 0; q < 3; ++q) {
            const int col = q * 512 + lane * 8;
            const u32x4 c4 = *(const u32x4*)(zc + col);
            u32x4 p4 = (u32x4){0u, 0u, 0u, 0u}, n4 = (u32x4){0u, 0u, 0u, 0u};
            if (hasp) p4 = *(const u32x4*)(zc - 1792 + col);
            if (hasn) n4 = *(const u32x4*)(zc + 1792 + col);
            const unsigned cc[4] = {c4.x, c4.y, c4.z, c4.w}, pp[4] = {p4.x, p4.y, p4.z, p4.w}, nn[4] = {n4.x, n4.y, n4.z, n4.w};
            float zs[8];
#pragma unroll
            for (int e = 0; e < 8; ++e) { const float z = (e & 1) ? bfhi(cc[e >> 1]) : bflo(cc[e >> 1]); const float pv = (e & 1) ? bfhi(pp[e >> 1]) : bflo(pp[e >> 1]); const float nx = (e & 1) ? bfhi(nn[e >> 1]) : bflo(nn[e >> 1]);
                zs[e] = z + mup[col + e] * (pv - z) + mun[col + e] * (nx - z); }
            u32x4 o; o.x = pk2(zs[0], zs[1]); o.y = pk2(zs[2], zs[3]); o.z = pk2(zs[4], zs[5]); o.w = pk2(zs[6], zs[7]);
            *(u32x4*)(F1 + (size_t)row * 2048 + q * 512 + lane * 8) = o;
            if (q == 1) {
                float kr[8], ssq = 0.f;
#pragma unroll
                for (int e = 0; e < 8; ++e) { kr[e] = zs[e] * kk_w[lane * 8 + e]; ssq += kr[e] * kr[e]; }
                ssq = row8_sum(ssq);
                const float inv = 1.f / fmaxf(sqrtf(ssq), 1e-12f);
                u32x4 o2; o2.x = pk2(kr[0] * inv, kr[1] * inv); o2.y = pk2(kr[2] * inv, kr[3] * inv); o2.z = pk2(kr[4] * inv, kr[5] * inv); o2.w = pk2(kr[6] * inv, kr[7] * inv);
                *(u32x4*)(F1 + (size_t)row * 2048 + 1536 + lane * 8) = o2;
            }
        }
        {
            const int col = 1536 + lane * 4;
            const u32x2 c2 = *(const u32x2*)(zc + col);
            u32x2 p2 = (u32x2){0u, 0u}, n2 = (u32x2){0u, 0u};
            if (hasp) p2 = *(const u32x2*)(zc - 1792 + col);
            if (hasn) n2 = *(const u32x2*)(zc + 1792 + col);
            const unsigned cc[2] = {c2.x, c2.y}, pp[2] = {p2.x, p2.y}, nn[2] = {n2.x, n2.y};
            float zs[4];
#pragma unroll
            for (int e = 0; e < 4; ++e) { const float z = (e & 1) ? bfhi(cc[e >> 1]) : bflo(cc[e >> 1]); const float pv = (e & 1) ? bfhi(pp[e >> 1]) : bflo(pp[e >> 1]); const float nx = (e & 1) ? bfhi(nn[e >> 1]) : bflo(nn[e >> 1]);
                const float s = z + mup[col + e] * (pv - z) + mun[col + e] * (nx - z);
                zs[e] = lane < 16 ? tanhf(s) : (lane < 32 ? s : sigmoidf_(s)); }
            u32x2 o; o.x = pk2(zs[0], zs[1]); o.y = pk2(zs[2], zs[3]);
            *(u32x2*)(LIN + (size_t)row * 256 + lane * 4) = o;
        }
    }
}

__device__ __forceinline__ int rw_tok(int dir, int i) { return dir == 0 ? i : (i < NCTX ? NCTX - 1 - i : 8703 - i); }

typedef float f32x2 __attribute__((ext_vector_type(2)));
constexpr int RW_REC = 352;
__device__ __forceinline__ void rw_load(const bf16_t* f1, const bf16_t* f2, int dir, int rg, int c, int pw, int lane, bf16_t (&in)[8][5], bf16_t (&vin)[8]) {
#pragma unroll
    for (int q = 0; q < 8; ++q) { const size_t t = (size_t)rw_tok(dir, c * 32 + pw * 8 + q);
        in[q][0] = f1[t * 2048 + lane]; in[q][1] = f1[t * 2048 + 512 + lane]; in[q][2] = f1[t * 2048 + 1536 + lane]; in[q][3] = f2[t * 2048 + lane]; in[q][4] = f2[t * 2048 + 1024 + lane];
        vin[q] = f1[t * 2048 + 1024 + rg * 8 + (lane & 7)]; }
}
__device__ __forceinline__ void rw_emit(const bf16_t (&in)[8][5], const bf16_t (&vin)[8], int pw, int lane, float ka, float* buf) {
#pragma unroll
    for (int q = 0; q < 8; ++q) {
        const float r = bf2f(in[q][0]), k = bf2f(in[q][1]), kk = bf2f(in[q][2]), u = bf2f(in[q][3]), a = bf2f(in[q][4]);
        const float w = 1.f - u, key = k * (1.f + (a - 1.f) * ka), kka = kk * a, wr = w * r;
        const float c1 = wave_sum(kka * r), c2 = wave_sum(key * r);
        float* rec = buf + (pw * 8 + q) * RW_REC;
        rec[lane] = kk; rec[64 + lane] = wr; rec[128 + lane] = w; rec[192 + lane] = kka; rec[256 + lane] = key;
        if (lane < 8) { f32x4 vc; vc[0] = bf2f(vin[q]); vc[1] = c1; vc[2] = c2; vc[3] = 0.f; *(f32x4*)(rec + 320 + lane * 4) = vc; }
    }
}

__device__ __forceinline__ void phase_rw_scan(int l, unsigned char* sm) {
    CParams& p = KPL(); const Ctx cx = mkctx();
    const int tid = cx.tid, lane = tid & 63, wid = __builtin_amdgcn_readfirstlane(tid >> 6);
    const bf16_t* F1 = (const bf16_t*)(p.ws + OFF_F1); const bf16_t* F2 = (const bf16_t*)(p.ws + OFF_Z);
    bf16_t* YRAW = (bf16_t*)(p.ws + OFF_R2);
    float* ring = (float*)sm;
    const bool is_scan = wid < 2, is_prod = (wid & 2) != 0;
    const int pw = (wid & 1) + ((wid >> 2) << 1);
    for (int item = cx.bid; item < 256; item += cx.nb) {
        const int chain = item >> 3, rg = item & 7; const int dir = chain >> 4, b = (chain >> 3) & 1, h = chain & 7;
        const float ka = p.in[31][l * 512 + h * 64 + lane];
        const bf16_t* f1 = F1 + (size_t)b * SEQA * 2048 + h * 64; const bf16_t* f2 = F2 + (size_t)b * SEQA * 2048 + dir * 512 + h * 64;
        const int row = rg * 8 + (wid & 1) * 4 + (lane >> 4);
        bf16_t* yr = YRAW + ((size_t)dir * T_TOK + (size_t)b * SEQA) * 512 + h * 64 + row;
        bf16_t pin[8][5], pvin[8];
        __syncthreads();
        if (is_prod) { rw_load(f1, f2, dir, rg, 0, pw, lane, pin, pvin); rw_emit(pin, pvin, pw, lane, ka, ring); rw_load(f1, f2, dir, rg, 1, pw, lane, pin, pvin); }
        __syncthreads();
        f32x2 S01 = (f32x2){0.f, 0.f}, S23 = (f32x2){0.f, 0.f};
        if (is_scan) __builtin_amdgcn_s_setprio(3);
#pragma unroll 1
        for (int c = 0; c < 264; ++c) {
            float* buf = ring + (c & 1) * (32 * RW_REC);
            if (is_prod) { if (c + 1 < 264) { rw_emit(pin, pvin, pw, lane, ka, ring + ((c + 1) & 1) * (32 * RW_REC)); rw_load(f1, f2, dir, rg, c + 2 < 264 ? c + 2 : c + 1, pw, lane, pin, pvin); } }
            else if (is_scan) {
                const float* rb = buf + (lane & 15) * 4;
                const float* vb = buf + 320 + ((wid & 1) * 4 + (lane >> 4)) * 4;
#pragma unroll 1
                for (int hf = 0; hf < 2; ++hf) {
                    const float* rh = rb + hf * 16 * RW_REC; const float* vh = vb + hf * 16 * RW_REC;
                    f32x4 kk4 = *(const f32x4*)(rh), wr4 = *(const f32x4*)(rh + 64), w4 = *(const f32x4*)(rh + 128), ka4 = *(const f32x4*)(rh + 192), ky4 = *(const f32x4*)(rh + 256), vc4 = *(const f32x4*)(vh);
                    f32x4 nkk = *(const f32x4*)(rh + RW_REC), nwr = *(const f32x4*)(rh + RW_REC + 64), nw = *(const f32x4*)(rh + RW_REC + 128), nka = *(const f32x4*)(rh + RW_REC + 192), nky = *(const f32x4*)(rh + RW_REC + 256), nvc = *(const f32x4*)(vh + RW_REC);
                    float ybuf = 0.f;
#pragma unroll
                    for (int j = 0; j < 16; ++j) {
                        f32x4 mkk, mwr, mw, mka, mky, mvc;
                        if (j < 14) { const int o = (j + 2) * RW_REC;
                            mkk = *(const f32x4*)(rh + o); mwr = *(const f32x4*)(rh + o + 64); mw = *(const f32x4*)(rh + o + 128); mka = *(const f32x4*)(rh + o + 192); mky = *(const f32x4*)(rh + o + 256); mvc = *(const f32x4*)(vh + o); }
                        const float vv = vc4[0];
                        f32x2 p1 = S01 * (f32x2){kk4[0], kk4[1]}; p1 = S23 * (f32x2){kk4[2], kk4[3]} + p1;
                        f32x2 p2 = S01 * (f32x2){wr4[0], wr4[1]}; p2 = S23 * (f32x2){wr4[2], wr4[3]} + p2;
                        const float sk = row16_sum(p1[0] + p1[1]);
                        const float q2 = row16_sum(p2[0] + p2[1]);
                        const f32x2 vv2 = (f32x2){vv, vv}, sk2 = (f32x2){sk, sk};
                        f32x2 t01 = (f32x2){ky4[0], ky4[1]} * vv2; t01 = t01 - (f32x2){ka4[0], ka4[1]} * sk2;
                        f32x2 t23 = (f32x2){ky4[2], ky4[3]} * vv2; t23 = t23 - (f32x2){ka4[2], ka4[3]} * sk2;
                        S01 = S01 * (f32x2){w4[0], w4[1]} + t01; S23 = S23 * (f32x2){w4[2], w4[3]} + t23;
                        const float y = q2 - sk * vc4[1] + vv * vc4[2];
                        if ((lane & 15) == j) ybuf = y;
                        kk4 = nkk; wr4 = nwr; w4 = nw; ka4 = nka; ky4 = nky; vc4 = nvc;
                        if (j < 14) { nkk = mkk; nwr = mwr; nw = mw; nka = mka; nky = mky; nvc = mvc; }
                        __builtin_amdgcn_sched_barrier(0);
                    }
                    yr[(size_t)rw_tok(dir, c * 32 + hf * 16 + (lane & 15)) * 512] = f2bf(ybuf);
                }
            }
            asm volatile("s_waitcnt lgkmcnt(0)" ::: "memory"); __builtin_amdgcn_s_barrier(); asm volatile("" ::: "memory");
        }
        if (is_scan) __builtin_amdgcn_s_setprio(0);
    }
}

__device__ __forceinline__ void phase_rw_out(int l) {
    CParams& p = KPL(); const Ctx cx = mkctx();
    const int lane = cx.tid & 63, gw = cx.bid * 8 + (cx.tid >> 6), nw = cx.nb * 8;
    const bf16_t* F1 = (const bf16_t*)(p.ws + OFF_F1); const bf16_t* F2 = (const bf16_t*)(p.ws + OFF_Z); const bf16_t* GRW = (const bf16_t*)(p.ws + OFF_ZRW);
    const bf16_t* YRAW = (const bf16_t*)(p.ws + OFF_R2);
    bf16_t* YC = (bf16_t*)(p.ws + OFF_YC);
    const int c0 = lane * 8;
    float ka[8], rk[8], lg[8], lb[8];
#pragma unroll
    for (int e = 0; e < 8; ++e) { ka[e] = p.in[31][l * 512 + c0 + e]; rk[e] = p.in[32][l * 512 + c0 + e]; lg[e] = p.in[33][l * 512 + c0 + e]; lb[e] = p.in[34][l * 512 + c0 + e]; }
    for (int row = gw; row < T_TOK; row += nw) {
        const u32x4 y0 = *(const u32x4*)(YRAW + (size_t)row * 512 + c0), y1 = *(const u32x4*)(YRAW + ((size_t)T_TOK + row) * 512 + c0);
        const u32x4 r4 = *(const u32x4*)(F1 + (size_t)row * 2048 + c0), k4 = *(const u32x4*)(F1 + (size_t)row * 2048 + 512 + c0), v4 = *(const u32x4*)(F1 + (size_t)row * 2048 + 1024 + c0);
        const u32x4 a04 = *(const u32x4*)(F2 + (size_t)row * 2048 + 1024 + c0), a14 = *(const u32x4*)(F2 + (size_t)row * 2048 + 1536 + c0);
        const u32x4 g4 = *(const u32x4*)(GRW + (size_t)row * 512 + c0);
        const unsigned ya[4] = {y0.x, y0.y, y0.z, y0.w}, yb[4] = {y1.x, y1.y, y1.z, y1.w}, rr[4] = {r4.x, r4.y, r4.z, r4.w}, kx[4] = {k4.x, k4.y, k4.z, k4.w}, vv[4] = {v4.x, v4.y, v4.z, v4.w};
        const unsigned aa[4] = {a04.x, a04.y, a04.z, a04.w}, ab[4] = {a14.x, a14.y, a14.z, a14.w}, gg[4] = {g4.x, g4.y, g4.z, g4.w};
        float y[8], sum = 0.f, bs = 0.f;
#pragma unroll
        for (int e = 0; e < 8; ++e) {
            const int w = e >> 1; const bool hi = e & 1;
            y[e] = (hi ? bfhi(ya[w]) : bflo(ya[w])) + (hi ? bfhi(yb[w]) : bflo(yb[w])); sum += y[e];
            const float r = hi ? bfhi(rr[w]) : bflo(rr[w]), k = hi ? bfhi(kx[w]) : bflo(kx[w]), a0 = hi ? bfhi(aa[w]) : bflo(aa[w]), a1 = hi ? bfhi(ab[w]) : bflo(ab[w]);
            bs += r * k * (2.f + (a0 + a1 - 2.f) * ka[e]) * rk[e];
        }
        sum = row8_sum(sum); bs = row8_sum(bs);
        const float mu = sum * (1.f / 64.f);
        float var = 0.f;
#pragma unroll
        for (int e = 0; e < 8; ++e) { const float d = y[e] - mu; var += d * d; }
        var = row8_sum(var) * (1.f / 64.f);
        const float rstd = rsqrtf(var + 64e-5f);
        float o[8];
#pragma unroll
        for (int e = 0; e < 8; ++e) { const int w = e >> 1; const bool hi = e & 1;
            const float v = hi ? bfhi(vv[w]) : bflo(vv[w]), g = hi ? bfhi(gg[w]) : bflo(gg[w]);
            o[e] = ((y[e] - mu) * rstd * lg[e] + lb[e] + bs * v) * g; }
        u32x4 o4; o4.x = pk2(o[0], o[1]); o4.y = pk2(o[2], o[3]); o4.z = pk2(o[4], o[5]); o4.w = pk2(o[6], o[7]);
        *(u32x4*)(YC + (size_t)row * 512 + c0) = o4;
    }
}

__device__ __forceinline__ void phase_final() {
    CParams& p = KPL(); const Ctx cx = mkctx();
    const int lane = cx.tid & 63, gw = cx.bid * 8 + (cx.tid >> 6), nw = cx.nb * 8;
    const float* X = (const float*)(p.ws + OFF_X);
    for (int r = gw; r < 2 * 8192; r += nw) {
        const int b = r >> 13, t = r & 8191;
        const float* src = X + ((size_t)b * SEQA + NCTX + t) * 1024;
        f32x4 v[4]; float ss = 0.f;
#pragma unroll
        for (int i = 0; i < 4; ++i) { v[i] = *(const f32x4*)(src + (lane + 64 * i) * 4); ss += v[i][0] * v[i][0] + v[i][1] * v[i][1] + v[i][2] * v[i][2] + v[i][3] * v[i][3]; }
        ss = wave_sum(ss);
        const float inv = rsqrtf(ss * (1.f / 1024.f) + 1e-6f);
#pragma unroll
        for (int i = 0; i < 4; ++i) { const int c = (lane + 64 * i) * 4; const f32x4 g4 = *(const f32x4*)(p.in[41] + c);
            *(f32x4*)(p.out + (size_t)r * 1024 + c) = v[i] * inv * g4; }
    }
}

#define XB_TMO      128
#define XB_XCNT(j)  (256  + 64 * (j))
#define XB_XSUB(j)  (1280 + 64 * (j))
#define XB_XGEN(j)  (2304 + 64 * (j))
#define XB_TOP      3328
#define XB_TOPGEN   3392
#define XCD_BAR_WORDS 3456
#define XB_SPIN_CAP (1u << 22)
constexpr int XB_LDS_OFF = 143344;
__device__ __forceinline__ unsigned xb_ld(unsigned* p)              { return __hip_atomic_load(p, __ATOMIC_RELAXED, __HIP_MEMORY_SCOPE_AGENT); }
__device__ __forceinline__ unsigned xb_add(unsigned* p, unsigned v) { return __hip_atomic_fetch_add(p, v, __ATOMIC_RELAXED, __HIP_MEMORY_SCOPE_AGENT); }
__device__ __forceinline__ unsigned xb_xcc_id() { return (unsigned)__builtin_amdgcn_s_getreg((3 << 11) | 20) & 0xFu; }
#define XB_SPIN(cond, bar) do { unsigned _sp = 0; while (cond) { __builtin_amdgcn_s_sleep(1); \
    if ((++_sp & 255u) == 0u) { if (xb_ld(&(bar)[XB_TMO])) break; if (_sp > XB_SPIN_CAP) { atomicAdd(&(bar)[XB_TMO], 1u); break; } } } } while (0)
__device__ __forceinline__ void xb_complete(unsigned* bar, unsigned x, unsigned G, unsigned& nloc, unsigned& nx) {
    unsigned sum, cnt, mine, sp = 0u;
    for (;;) {
        sum = 0u; cnt = 0u; mine = 0u;
#pragma unroll
        for (unsigned j = 0; j < 16; ++j) { const unsigned c = xb_ld(&bar[XB_XCNT(j)]); sum += c; cnt += (c > 0u) ? 1u : 0u; mine = (j == x) ? c : mine; }
        if (sum == G) break;
        __builtin_amdgcn_s_sleep(1);
        if ((++sp & 255u) == 0u) { if (xb_ld(&bar[XB_TMO])) break; if (sp > XB_SPIN_CAP) { atomicAdd(&bar[XB_TMO], 1u); break; } }
    }
    nloc = mine > 0u ? mine : 1u; nx = cnt > 0u ? cnt : 1u;
}
__device__ __forceinline__ void xb_post(unsigned char* smem) {
    CParams& p = KPL(); const Ctx cx = mkctx();
    volatile LAS unsigned* st = (volatile LAS unsigned*)((LAS unsigned char*)smem + XB_LDS_OFF);
    if (cx.tid == 0) { st[0] = 0u; st[1] = 0u; (void)xb_add(&((unsigned*)(p.ws + OFF_BAR))[XB_XCNT(xb_xcc_id())], 1u); }
    __syncthreads();
}
__device__ __forceinline__ void xsync(unsigned char* smem) {
    CParams& p = KPL(); const Ctx cx = mkctx();
    asm volatile("s_waitcnt vmcnt(0)" ::: "memory");
    __syncthreads();
    if (cx.tid == 0) {
        unsigned* bar = (unsigned*)(p.ws + OFF_BAR);
        volatile LAS unsigned* st = (volatile LAS unsigned*)((LAS unsigned char*)smem + XB_LDS_OFF);
        const unsigned x = xb_xcc_id();
        __builtin_amdgcn_s_waitcnt(0);
        unsigned nloc = st[0], nx = st[1];
        if (nloc == 0u) { xb_complete(bar, x, (unsigned)cx.nb, nloc, nx); st[0] = nloc; st[1] = nx; }
        const unsigned old = xb_add(&bar[XB_XSUB(x)], 1u);
        const unsigned gen = old / nloc;
        if (old + 1u == (gen + 1u) * nloc) {
            __builtin_amdgcn_fence(__ATOMIC_RELEASE, "agent");
            asm volatile("s_waitcnt vmcnt(0)" ::: "memory");
            const unsigned og = xb_add(&bar[XB_TOP], 1u);
            const unsigned tg = og / nx;
            if (og + 1u == (tg + 1u) * nx) xb_add(&bar[XB_TOPGEN], 1u);
            else XB_SPIN(xb_ld(&bar[XB_TOPGEN]) == tg, bar);
            __builtin_amdgcn_fence(__ATOMIC_ACQUIRE, "agent");
            xb_add(&bar[XB_XGEN(x)], 1u);
            asm volatile("s_waitcnt vmcnt(0)" ::: "memory");
        } else {
            XB_SPIN(xb_ld(&bar[XB_XGEN(x)]) == gen, bar);
            __builtin_amdgcn_fence(__ATOMIC_ACQUIRE, "agent");
            asm volatile("s_waitcnt vmcnt(0)" ::: "memory");
        }
    }
    __syncthreads();
}

#ifndef PHM
#define PHM 0xFFFFFFFFull
#endif
#ifndef PHR
#define PHR 0ull
#endif
#ifndef SYNCREP
#define SYNCREP 1
#endif
template <int WHICH>
__device__ __forceinline__ void gemm_stage(int l, LAS unsigned char* lds) {
    CParams& p = KPL(); const Ctx cx = mkctx();
    const int sk = (l == NLAYER - 1) ? 1 : 0;
    unsigned char* ws = p.ws;
    float* X = (float*)(ws + OFF_X); bf16_t* H = (bf16_t*)(ws + OFF_H); bf16_t* ZA = (bf16_t*)(ws + OFF_Z); bf16_t* ZRW = (bf16_t*)(ws + OFF_ZRW);
    bf16_t* W = (bf16_t*)(ws + OFF_W);
    const float* MODL = (const float*)(ws + OFF_MOD) + (size_t)l * 3 * 6144;
    if constexpr (WHICH == 0) run_gemm(cx, lds, H, W + W_MIX / 2, 4096, 1024, FInproj{ZA, (float*)(ws + OFF_MLG), ZRW});
    else if constexpr (WHICH == 1) run_gemm(cx, lds, (const bf16_t*)(ws + OFF_ZG), W + W_GLU / 2, 512, 512, FGlu{(const bf16_t*)(ws + OFF_ZG), p.in[18] + l * 512, (bf16_t*)(ws + OFF_YA)});
    else if constexpr (WHICH == 2) run_gemm_epi(cx, lds, (const bf16_t*)(ws + OFF_LORAIN), W + W_LORA / 2, 2560, 256, EpiLora{p.in[25] + l * 1024, p.in[27] + l * 1024, ZA, ZRW});
    else if constexpr (WHICH == 3) run_gemm(cx, lds, H, W + W_GATE / 2, 3072, 1024, FGate{ZA}, sk);
    else if constexpr (WHICH == 4) run_gemm(cx, lds, (const bf16_t*)(ws + OFF_YA), W + W_PA / 2, 1024, 512, FMerge<0>{ZA, (float*)(ws + OFF_F1), H}, sk);
    else if constexpr (WHICH == 5) run_gemm(cx, lds, (const bf16_t*)(ws + OFF_YB), W + W_PB / 2, 1024, 512, FMerge<1>{ZA, (float*)(ws + OFF_F1), H}, sk);
    else if constexpr (WHICH == 6) run_gemm(cx, lds, (const bf16_t*)(ws + OFF_YC), W + W_PC / 2, 1024, 512, FMerge<2>{ZA, (float*)(ws + OFF_F1), H}, sk);
    else if constexpr (WHICH == 7) run_gemm(cx, lds, H, W + W_OUT / 2, 1024, 1024, FResid{X, MODL, 2}, sk);
    else if constexpr (WHICH == 8) run_gemm(cx, lds, H, W + W_1 / 2, 4096, 1024, FMlp1{ZA}, sk);
    else run_gemm(cx, lds, ZA, W + W_2 / 2, 1024, 4096, FResid{X, MODL, 5}, sk);
}

template <int l>
__device__ __forceinline__ void run_layer(cg::grid_group& grid, LAS unsigned char* lds, float* smf, unsigned char* smem) {
        if constexpr (l == 0) phase_wconv<0>(l, smf); else phase_wconv<1>(l, smf);
        __syncthreads();
        if constexpr ((PHM >> 2) & 1) { phase_norm(l, 0, l == 0); if constexpr ((PHR >> 2) & 1) { __syncthreads(); phase_norm(l, 0, l == 0); } }
        for (int sr = 0; sr < SYNCREP; ++sr) xsync(smem);
        if constexpr ((PHM >> 3) & 1) { gemm_stage<0>(l, lds); if constexpr ((PHR >> 3) & 1) { __syncthreads(); gemm_stage<0>(l, lds); } }
        for (int sr = 0; sr < SYNCREP; ++sr) xsync(smem);
        if constexpr ((PHM >> 4) & 1) { phase_s5_local(l); if constexpr ((PHR >> 4) & 1) { __syncthreads(); phase_s5_local(l); } }
        if constexpr ((PHM >> 5) & 1) { phase_ml_conv(l); if constexpr ((PHR >> 5) & 1) { __syncthreads(); phase_ml_conv(l); } }
        for (int sr = 0; sr < SYNCREP; ++sr) xsync(smem);
        if constexpr ((PHM >> 6) & 1) { phase_s5_carry(l); if constexpr ((PHR >> 6) & 1) { __syncthreads(); phase_s5_carry(l); } }
        if constexpr ((PHM >> 7) & 1) { phase_ml_local(l, smem); if constexpr ((PHR >> 7) & 1) { __syncthreads(); phase_ml_local(l, smem); } }
        for (int sr = 0; sr < SYNCREP; ++sr) xsync(smem);
        if constexpr ((PHM >> 8) & 1) { phase_s5_final(l, smf); if constexpr ((PHR >> 8) & 1) { __syncthreads(); phase_s5_final(l, smf); } }
        if constexpr ((PHM >> 9) & 1) { phase_ml_carry(); if constexpr ((PHR >> 9) & 1) { __syncthreads(); phase_ml_carry(); } }
        for (int sr = 0; sr < SYNCREP; ++sr) xsync(smem);
        if constexpr ((PHM >> 10) & 1) { gemm_stage<1>(l, lds); if constexpr ((PHR >> 10) & 1) { __syncthreads(); gemm_stage<1>(l, lds); } }
        if constexpr ((PHM >> 11) & 1) { phase_ml_out(l, smem); if constexpr ((PHR >> 11) & 1) { __syncthreads(); phase_ml_out(l, smem); } }
        for (int sr = 0; sr < SYNCREP; ++sr) xsync(smem);
        if constexpr ((PHM >> 12) & 1) { phase_rw_feat(l); if constexpr ((PHR >> 12) & 1) { __syncthreads(); phase_rw_feat(l); } }
        for (int sr = 0; sr < SYNCREP; ++sr) xsync(smem);
        if constexpr ((PHM >> 13) & 1) { gemm_stage<2>(l, lds); if constexpr ((PHR >> 13) & 1) { __syncthreads(); gemm_stage<2>(l, lds); } }
        for (int sr = 0; sr < SYNCREP; ++sr) xsync(smem);
        if constexpr ((PHM >> 14) & 1) { phase_rw_scan(l, smem); if constexpr ((PHR >> 14) & 1) { __syncthreads(); phase_rw_scan(l, smem); } }
        for (int sr = 0; sr < SYNCREP; ++sr) xsync(smem);
        if constexpr ((PHM >> 15) & 1) { phase_rw_out(l); if constexpr ((PHR >> 15) & 1) { __syncthreads(); phase_rw_out(l); } }
        for (int sr = 0; sr < SYNCREP; ++sr) xsync(smem);
        if constexpr ((PHM >> 17) & 1) { gemm_stage<3>(l, lds); if constexpr ((PHR >> 17) & 1) { __syncthreads(); gemm_stage<3>(l, lds); } }
        for (int sr = 0; sr < SYNCREP; ++sr) xsync(smem);
        if constexpr ((PHM >> 18) & 1) { gemm_stage<4>(l, lds); if constexpr ((PHR >> 18) & 1) { __syncthreads(); gemm_stage<4>(l, lds); } }
        if constexpr ((PHM >> 19) & 1) { gemm_stage<5>(l, lds); if constexpr ((PHR >> 19) & 1) { __syncthreads(); gemm_stage<5>(l, lds); } }
        if constexpr ((PHM >> 20) & 1) { gemm_stage<6>(l, lds); if constexpr ((PHR >> 20) & 1) { __syncthreads(); gemm_stage<6>(l, lds); } }
        for (int sr = 0; sr < SYNCREP; ++sr) xsync(smem);
        if constexpr ((PHM >> 21) & 1) { gemm_stage<7>(l, lds); if constexpr ((PHR >> 21) & 1) { __syncthreads(); gemm_stage<7>(l, lds); } }
        for (int sr = 0; sr < SYNCREP; ++sr) xsync(smem);
        if constexpr ((PHM >> 22) & 1) { phase_norm(l, 1, false); if constexpr ((PHR >> 22) & 1) { __syncthreads(); phase_norm(l, 1, false); } }
        for (int sr = 0; sr < SYNCREP; ++sr) xsync(smem);
        if constexpr ((PHM >> 23) & 1) { gemm_stage<8>(l, lds); if constexpr ((PHR >> 23) & 1) { __syncthreads(); gemm_stage<8>(l, lds); } }
        for (int sr = 0; sr < SYNCREP; ++sr) xsync(smem);
        gemm_stage<9>(l, lds);
        if constexpr (l < NLAYER - 1) { __syncthreads(); phase_wconv<2>(l + 1, smf); }
        for (int sr = 0; sr < SYNCREP; ++sr) xsync(smem);
    }

__global__ void __launch_bounds__(512, 2) fwd_megakernel(Params p_unused) {
    extern __shared__ __attribute__((aligned(16))) unsigned char smem[];
    cg::grid_group grid = cg::this_grid();
    LAS unsigned char* lds = (LAS unsigned char*)smem;
    float* smf = (float*)smem;

    xb_post(smem);
    phase_mod(smf); phase_s5_params();
    grid.sync();
    run_layer<0>(grid, lds, smf, smem);
    run_layer<1>(grid, lds, smf, smem);
    run_layer<2>(grid, lds, smf, smem);
    run_layer<3>(grid, lds, smf, smem);
    phase_final();
}

extern "C" void kernel_launch(void* const* d_in, const int* in_sizes, int n_in, void* d_out, int out_size, void* d_ws, size_t ws_size, hipStream_t stream) {
    static int grid_blocks = 0;
    if (grid_blocks == 0) {
        if (n_in != 42 || ws_size < WS_END) { fprintf(stderr, "kernel_launch: unexpected n_in %d / ws_size %zu\n", n_in, ws_size); grid_blocks = -1; return; }
        int dev = 0, cus = 0, per_cu = 0;
        (void)hipGetDevice(&dev);
        (void)hipDeviceGetAttribute(&cus, hipDeviceAttributeMultiprocessorCount, dev);
        if (hipFuncSetAttribute((const void*)fwd_megakernel, hipFuncAttributeMaxDynamicSharedMemorySize, LDS_BYTES) != hipSuccess) { fprintf(stderr, "kernel_launch: hipFuncSetAttribute failed\n"); grid_blocks = -1; return; }
        if (hipOccupancyMaxActiveBlocksPerMultiprocessor(&per_cu, (const void*)fwd_megakernel, 512, LDS_BYTES) != hipSuccess || per_cu < 1) { fprintf(stderr, "kernel_launch: occupancy query says %d\n", per_cu); per_cu = 1; (void)hipGetLastError(); }
        grid_blocks = cus * 1;
    }
    if (grid_blocks < 0) return;
    if (hipMemsetAsync((unsigned char*)d_ws + OFF_BAR, 0, 16384, stream) != hipSuccess) { fprintf(stderr, "kernel_launch: memset failed\n"); return; }
    Params p{};
    for (int i = 0; i < 42; ++i) p.in[i] = (const float*)d_in[i];
    p.out = (float*)d_out; p.ws = (unsigned char*)d_ws;
    void* args[] = {&p};
    hipError_t e = hipLaunchCooperativeKernel((const void*)fwd_megakernel, dim3(grid_blocks), dim3(512), args, LDS_BYTES, stream);
    if (e != hipSuccess) fprintf(stderr, "cooperative launch failed: %s (grid %d)\n", hipGetErrorString(e), grid_blocks);
}
```

```cpp
#include <hip/hip_runtime.h>
#include <hip/hip_cooperative_groups.h>
#include <cstdio>
namespace cg = cooperative_groups;

#define LAS __attribute__((address_space(3)))
typedef unsigned short bf16_t;
typedef short bf16x8 __attribute__((ext_vector_type(8)));
typedef float f32x4 __attribute__((ext_vector_type(4)));
typedef unsigned u32x4 __attribute__((ext_vector_type(4)));
typedef unsigned u32x2 __attribute__((ext_vector_type(2)));

constexpr int T_TOK = 16896, SEQA = 8448, NCTX = 256;
constexpr int NLAYER = 4;
constexpr int LDS_BYTES = 143360;
constexpr size_t OFF_X = 0;
constexpr size_t OFF_H = 69206016;
constexpr size_t OFF_Z = 103809024;
constexpr size_t OFF_ZRW = OFF_Z + 69206016;
constexpr size_t OFF_MLG = 242221056;
constexpr size_t OFF_W = 243302400;
constexpr size_t OFF_YA = 281837568;
constexpr size_t OFF_YB = 299139072;
constexpr size_t OFF_YC = 316440576;
constexpr size_t OFF_F1 = 333742080;
constexpr size_t OFF_MOD = 402948096;
constexpr size_t OFF_S5P = 403243008;
constexpr size_t OFF_MLS = OFF_S5P + 4 * 589824;
constexpr size_t OFF_R2 = OFF_MLS + 16384;
constexpr size_t OFF_BAR = OFF_R2 + 34603008;
constexpr size_t WS_END = OFF_BAR + 16384;
constexpr size_t OFF_CLOC = OFF_F1;
constexpr size_t OFF_S5ST = OFF_F1 + 34873344;
constexpr size_t OFF_QKC = OFF_F1 + 43524096;
constexpr size_t OFF_ZG = OFF_R2;
constexpr size_t OFF_LORAIN = OFF_R2 + 17301504;
constexpr size_t W_MIX = 0, W_GATE = 8388608, W_GLU = 14680064, W_LORA = 15204352, W_PA = 16515072, W_PB = 17563648, W_PC = 18612224, W_OUT = 19660800, W_1 = 21757952, W_2 = 30146560;

struct Params {
    const float* in[42];
    float* out;
    unsigned char* ws;
};

typedef const __attribute__((address_space(4))) Params CParams;
__device__ __forceinline__ CParams& KPL() {
    unsigned long long a = (unsigned long long)__builtin_amdgcn_kernarg_segment_ptr();
    asm volatile("" : "+s"(a));
    return *(CParams*)a;
}
struct Ctx { int tid, bid, nb; };
__device__ __forceinline__ Ctx mkctx() { Ctx c; c.tid = threadIdx.x; c.bid = blockIdx.x; c.nb = gridDim.x; asm volatile("" : "+v"(c.tid), "+s"(c.bid), "+s"(c.nb)); return c; }
__device__ __forceinline__ float bf2f(unsigned v) { return __uint_as_float(v << 16); }
__device__ __forceinline__ float bflo(unsigned w) { return __uint_as_float(w << 16); }
__device__ __forceinline__ float bfhi(unsigned w) { return __uint_as_float(w & 0xffff0000u); }
__device__ __forceinline__ bf16_t f2bf(float f) { unsigned u = __float_as_uint(f); u += 0x7FFFu + ((u >> 16) & 1u); return (bf16_t)(u >> 16); }
__device__ __forceinline__ unsigned pk2(float lo, float hi) { return (unsigned)f2bf(lo) | ((unsigned)f2bf(hi) << 16); }
__device__ __forceinline__ void store4bf(bf16_t* p, f32x4 v) { u32x2 r; r.x = pk2(v[0], v[1]); r.y = pk2(v[2], v[3]); *(u32x2*)p = r; }
__device__ __forceinline__ float sigmoidf_(float x) { return 1.f / (1.f + __expf(-x)); }

#define DPP_F(x, ctrl, rmask) __int_as_float(__builtin_amdgcn_update_dpp(0, __float_as_int(x), ctrl, rmask, 0xF, false))
__device__ __forceinline__ float row8_sum(float x) {
    x += DPP_F(x, 0xB1, 0xF); x += DPP_F(x, 0x4E, 0xF); x += DPP_F(x, 0x141, 0xF); return x;
}
__device__ __forceinline__ float row16_sum(float x) {
    x += DPP_F(x, 0xB1, 0xF); x += DPP_F(x, 0x4E, 0xF); x += DPP_F(x, 0x141, 0xF); x += DPP_F(x, 0x140, 0xF); return x;
}
__device__ __forceinline__ float wave_sum(float x) {
    x = row16_sum(x);
    x += DPP_F(x, 0x142, 0xA);
    x += DPP_F(x, 0x143, 0xC);
    return __int_as_float(__builtin_amdgcn_readlane(__float_as_int(x), 63));
}

namespace pg8 {
constexpr int BM = 256, BK = 64, HALF = 128, HTB = HALF * BK * 2, NXCD = 8, WGM = 8;
__device__ __forceinline__ int lds_byte(int r, int c) { const int st = (r >> 4) * 2 + (c >> 5), rr = r & 15, cc = c & 31, ob = rr * 64 + cc * 2; return st * 1024 + (ob ^ (((ob >> 9) & 1) << 5)); }
__device__ __forceinline__ void stage_rc(int b, int& R, int& C) { const int st = b / 1024, sb = b % 1024, swz = sb ^ (((sb >> 9) & 1) << 5); R = (st >> 1) * 16 + swz / 64; C = (st & 1) * 32 + (swz % 64) / 2; }
struct Unit { int pm, pn; };
struct Gemm { const bf16_t* A; const bf16_t* Bt; int M, N, K; };
struct StaticOrder {
    int nM, nN, nwg, G, c, skipctx;
    __device__ void init(int M, int N, int G_, int c_, int skip_ = 0) { nM = M / BM - 2 * skip_; nN = N / BM; nwg = nM * nN; G = G_; c = c_; skipctx = skip_; }
    __device__ bool next(int i, Unit& u) const {
        const long L = (long)i * G + c; if (L >= nwg) return false;
        int wgid = (int)L; { const int q = nwg / NXCD, r = nwg % NXCD, xcd = wgid % NXCD, off = wgid / NXCD; wgid = (xcd < r ? xcd * (q + 1) : r * (q + 1) + (xcd - r) * q) + off; }
        const int nig = WGM * nN, gid = wgid / nig, fm = gid * WGM, gsz = (nM - fm) < WGM ? (nM - fm) : WGM;
        u.pm = fm + ((wgid % nig) % gsz); u.pn = (wgid % nig) / gsz;
        if (skipctx) u.pm += (u.pm >= 32) ? 2 : 1;
        return true;
    }
};

template <class Epi>
__device__ __forceinline__ void gemm_phase(int tid_in, LAS unsigned char* lds, const Gemm g, const StaticOrder& S, const Epi& E) {
    const int tid = tid_in, wid = __builtin_amdgcn_readfirstlane(tid >> 6), lane = tid & 63, wr = wid >> 2, wc = wid & 3, fr = lane & 15, fq = lane >> 4;
    const int K = g.K, nt = K / BK;
    unsigned voffA[2], voffB[2];
#pragma unroll
    for (int i = 0; i < 2; ++i) { int R, C; stage_rc(tid * 16 + i * 8192, R, C); voffA[i] = (unsigned)(R * K + C) * 2u; voffB[i] = voffA[i]; }
    const size_t kstep = (size_t)(BK * 2);
    const size_t hstep = (size_t)HALF * K * 2;
    const size_t tstep = 2 * hstep;
    const unsigned ldsw = (unsigned)wid * 1024u;
    const int aoff = lds_byte(wr * 64 + fr, fq * 8), boff = lds_byte(wc * 32 + fr, fq * 8);
#define PG8_SA(b, h) (((b) * 2 + (h)) * HTB)
#define PG8_SB(b, h) ((4 + (b) * 2 + (h)) * HTB)
#define PG8_STAGE(bufoff, gbase, voff) do { _Pragma("unroll") for (int _i = 0; _i < 2; ++_i) \
        __builtin_amdgcn_global_load_lds((const unsigned*)((const char*)(gbase) + (voff)[_i]), (LAS unsigned*)(lds + (bufoff) + ldsw + _i * 8192), 16, 0, 0); } while (0)
#define PG8_LDA(dst, b, h) do { _Pragma("unroll") for (int m = 0; m < 4; ++m) _Pragma("unroll") for (int k = 0; k < 2; ++k) dst[m][k] = *(const LAS bf16x8*)(lds + PG8_SA(b, h) + aoff + m * 2048 + k * 1024); } while (0)
#define PG8_LDB(dst, b, h) do { _Pragma("unroll") for (int n = 0; n < 2; ++n) _Pragma("unroll") for (int k = 0; k < 2; ++k) dst[n][k] = *(const LAS bf16x8*)(lds + PG8_SB(b, h) + boff + n * 2048 + k * 1024); } while (0)
#define PG8_MMA(ai, bj, At, Bt) do { __builtin_amdgcn_s_setprio(1); _Pragma("unroll") for (int m = 0; m < 4; ++m) _Pragma("unroll") for (int n = 0; n < 2; ++n) _Pragma("unroll") for (int k = 0; k < 2; ++k) \
        acc[ai][bj][m][n] = __builtin_amdgcn_mfma_f32_16x16x32_bf16(Bt[n][k], At[m][k], acc[ai][bj][m][n], 0, 0, 0); __builtin_amdgcn_s_setprio(0); } while (0)
#define PG8_WAIT_V(n) asm volatile("s_waitcnt vmcnt(" #n ")" ::: "memory")
#define PG8_WAIT_L(n) asm volatile("s_waitcnt lgkmcnt(" #n ")" ::: "memory")
#define PG8_BAR __builtin_amdgcn_s_barrier()
#define PG8_SCHED __builtin_amdgcn_sched_barrier(0)
    Unit cur, nxt; int ui = 0;
    if (!S.next(0, cur)) return;
    f32x4 acc[2][2][4][2];
#pragma unroll
    for (int a = 0; a < 2; ++a)
#pragma unroll
        for (int b = 0; b < 2; ++b)
#pragma unroll
            for (int m = 0; m < 4; ++m)
#pragma unroll
                for (int n = 0; n < 2; ++n) acc[a][b][m][n] = (f32x4){0.f, 0.f, 0.f, 0.f};
    bf16x8 At[4][2], B0[2][2], B1[2][2];
    const char* cA = (const char*)g.A + (size_t)cur.pm * tstep; const char* cB = (const char*)g.Bt + (size_t)cur.pn * tstep;
    PG8_STAGE(PG8_SB(0, 0), cB, voffB); PG8_STAGE(PG8_SA(0, 0), cA, voffA); PG8_STAGE(PG8_SB(0, 1), cB + hstep, voffB); PG8_STAGE(PG8_SA(0, 1), cA + hstep, voffA);
    if (wr == 1) PG8_BAR;
    PG8_WAIT_V(4); PG8_BAR;
    PG8_STAGE(PG8_SB(1, 0), cB + kstep, voffB); PG8_STAGE(PG8_SA(1, 0), cA + kstep, voffA); PG8_STAGE(PG8_SB(1, 1), cB + hstep + kstep, voffB);
    PG8_WAIT_V(6); PG8_BAR;
    for (;;) {
        const bool has_next = S.next(ui + 1, nxt);
        const char* nA = has_next ? (const char*)g.A + (size_t)nxt.pm * tstep : cA; const char* nB = has_next ? (const char*)g.Bt + (size_t)nxt.pn * tstep : cB;
        for (int t = 0; t < nt; t += 2) {
            const bool last = (t == nt - 2);
            const char* a1 = cA + (size_t)(t + 1) * kstep;
            const char* a2 = last ? nA : cA + (size_t)(t + 2) * kstep; const char* b2 = last ? nB : cB + (size_t)(t + 2) * kstep;
            const char* a3 = a2 + kstep; const char* b3 = b2 + kstep;
            PG8_LDB(B0, 0, 0); PG8_SCHED; PG8_LDA(At, 0, 0); PG8_STAGE(PG8_SA(1, 1), a1 + hstep, voffA);
            PG8_WAIT_L(8); PG8_BAR; PG8_WAIT_L(0); PG8_MMA(0, 0, At, B0); PG8_BAR; PG8_SCHED;
            PG8_LDB(B1, 0, 1); PG8_STAGE(PG8_SB(0, 0), b2, voffB);
            PG8_BAR; PG8_WAIT_L(0); PG8_MMA(0, 1, At, B1); PG8_BAR;
            PG8_LDA(At, 0, 1); PG8_STAGE(PG8_SA(0, 0), a2, voffA);
            PG8_BAR; PG8_WAIT_L(0); PG8_MMA(1, 0, At, B0); PG8_BAR; PG8_SCHED;
            PG8_STAGE(PG8_SB(0, 1), b2 + hstep, voffB);
            PG8_WAIT_V(6); PG8_BAR; PG8_MMA(1, 1, At, B1); PG8_BAR;
            PG8_LDB(B0, 1, 0); PG8_SCHED; PG8_LDA(At, 1, 0); PG8_STAGE(PG8_SA(0, 1), a2 + hstep, voffA);
            PG8_WAIT_L(8); PG8_BAR; PG8_WAIT_L(0); PG8_MMA(0, 0, At, B0); PG8_BAR; PG8_SCHED;
            PG8_LDB(B1, 1, 1); PG8_STAGE(PG8_SB(1, 0), b3, voffB);
            PG8_BAR; PG8_WAIT_L(0); PG8_MMA(0, 1, At, B1); PG8_BAR;
            PG8_LDA(At, 1, 1); PG8_STAGE(PG8_SA(1, 0), a3, voffA);
            PG8_BAR; PG8_WAIT_L(0); PG8_MMA(1, 0, At, B0); PG8_BAR; PG8_SCHED;
            PG8_STAGE(PG8_SB(1, 1), b3 + hstep, voffB);
            PG8_WAIT_V(6); PG8_BAR; PG8_MMA(1, 1, At, B1); PG8_BAR;
        }
        E(acc, cur, wr, wc, fr, fq);
        if (!has_next) break;
#pragma unroll
        for (int a = 0; a < 2; ++a)
#pragma unroll
            for (int b = 0; b < 2; ++b)
#pragma unroll
                for (int m = 0; m < 4; ++m)
#pragma unroll
                    for (int n = 0; n < 2; ++n) acc[a][b][m][n] = (f32x4){0.f, 0.f, 0.f, 0.f};
        cur = nxt; cA = nA; cB = nB; ++ui;
    }
    PG8_WAIT_V(0);
    if (wr == 0) PG8_BAR;
    PG8_BAR;
#undef PG8_SA
#undef PG8_SB
#undef PG8_STAGE
#undef PG8_LDA
#undef PG8_LDB
#undef PG8_MMA
#undef PG8_WAIT_V
#undef PG8_WAIT_L
#undef PG8_BAR
#undef PG8_SCHED
}

template <class F> struct EpiT {
    F f;
    __device__ __forceinline__ void operator()(const f32x4 (&acc)[2][2][4][2], const Unit& u, int wr, int wc, int fr, int fq) const {
        const int row0 = u.pm * BM + wr * 64 + fr, col0 = u.pn * BM + wc * 32 + 4 * fq;
#pragma unroll
        for (int ai = 0; ai < 2; ++ai)
#pragma unroll
            for (int m = 0; m < 4; ++m) {
                const int row = row0 + ai * HALF + m * 16;
#pragma unroll
                for (int bj = 0; bj < 2; ++bj)
#pragma unroll
                    for (int n = 0; n < 2; ++n) f(row, col0 + bj * HALF + n * 16, acc[ai][bj][m][n]);
            }
    }
};
}

template <class F>
__device__ __forceinline__ void run_gemm(const Ctx& cx, LAS unsigned char* lds, const bf16_t* A, const bf16_t* Bt, int N, int K, const F& f, int skip = 0) {
    pg8::Gemm g; g.A = A; g.Bt = Bt; g.M = T_TOK; g.N = N; g.K = K;
    pg8::StaticOrder S; S.init(T_TOK, N, cx.nb, cx.bid, skip);
    pg8::EpiT<F> E{f};
    pg8::gemm_phase(cx.tid, lds, g, S, E);
}

template <class E>
__device__ __forceinline__ void run_gemm_epi(const Ctx& cx, LAS unsigned char* lds, const bf16_t* A, const bf16_t* Bt, int N, int K, const E& e) {
    pg8::Gemm g; g.A = A; g.Bt = Bt; g.M = T_TOK; g.N = N; g.K = K;
    pg8::StaticOrder S; S.init(T_TOK, N, cx.nb, cx.bid);
    pg8::gemm_phase(cx.tid, lds, g, S, e);
}
__device__ __forceinline__ int row_vec(int row) { const int b = row >= SEQA ? 1 : 0; const int t = row - b * SEQA; return t < NCTX ? 2 : b; }

struct FInproj { bf16_t* za; float* mlg; bf16_t* zrw;
    __device__ __forceinline__ void operator()(int row, int col, f32x4 v) const {
        if (col < 2048) store4bf(za + (size_t)row * 2048 + col, v);
        else if (col < 2064) *(f32x4*)(mlg + (size_t)row * 16 + (col - 2048)) = v;
        else if (col < 3856) store4bf(zrw + (size_t)row * 1792 + (col - 2064), v);
    } };
struct FGlu { const bf16_t* zg; const float* bglu; bf16_t* ya;
    __device__ __forceinline__ void operator()(int row, int col, f32x4 v) const {
        const u32x2 z = *(const u32x2*)(zg + (size_t)row * 512 + col); const f32x4 b = *(const f32x4*)(bglu + col);
        f32x4 o; o[0] = bflo(z.x) * sigmoidf_(v[0] + b[0]); o[1] = bfhi(z.x) * sigmoidf_(v[1] + b[1]); o[2] = bflo(z.y) * sigmoidf_(v[2] + b[2]); o[3] = bfhi(z.y) * sigmoidf_(v[3] + b[3]);
        store4bf(ya + (size_t)row * 512 + col, o);
    } };
struct EpiLora { const float* w0; const float* a0; bf16_t* f2; bf16_t* grw;
    __device__ __forceinline__ void operator()(const f32x4 (&acc)[2][2][4][2], const pg8::Unit& u, int wr, int wc, int fr, int fq) const {
        const int row0 = u.pm * 256 + wr * 64 + fr, col0 = u.pn * 256 + wc * 32 + 4 * fq;
        const int pn = __builtin_amdgcn_readfirstlane(u.pn);
        if (pn < 8) {
            const float* bias = pn < 4 ? w0 : a0 - 1024;
#pragma unroll
            for (int bj = 0; bj < 2; ++bj)
#pragma unroll
                for (int n = 0; n < 2; ++n) {
                    const int col = col0 + bj * 128 + n * 16;
                    const f32x4 b = *(const f32x4*)(bias + col);
#pragma unroll
                    for (int ai = 0; ai < 2; ++ai)
#pragma unroll
                        for (int m = 0; m < 4; ++m) {
                            const int row = row0 + ai * 128 + m * 16; f32x4 o;
#pragma unroll
                            for (int e = 0; e < 4; ++e) { const float s = sigmoidf_(acc[ai][bj][m][n][e] + b[e]); o[e] = pn < 4 ? 1.f - __expf(-0.60653065971f * s) : s; }
                            store4bf(f2 + (size_t)row * 2048 + col, o);
                        }
                }
        } else {
#pragma unroll
            for (int ai = 0; ai < 2; ++ai)
#pragma unroll
                for (int m = 0; m < 4; ++m) { const int row = row0 + ai * 128 + m * 16;
#pragma unroll
                    for (int bj = 0; bj < 2; ++bj)
#pragma unroll
                        for (int n = 0; n < 2; ++n) store4bf(grw + (size_t)row * 512 + (col0 + bj * 128 + n * 16 - 2048), acc[ai][bj][m][n]); }
        }
    } };
struct FGate { bf16_t* g;
    __device__ __forceinline__ void operator()(int row, int col, f32x4 v) const {
        f32x4 o; o[0] = sigmoidf_(v[0]); o[1] = sigmoidf_(v[1]); o[2] = sigmoidf_(v[2]); o[3] = sigmoidf_(v[3]);
        store4bf(g + (size_t)row * 3072 + col, o);
    } };
template <int J> struct FMerge { const bf16_t* g; float* y32; bf16_t* ybf;
    __device__ __forceinline__ void operator()(int row, int col, f32x4 v) const {
        const u32x2 z = *(const u32x2*)(g + (size_t)row * 3072 + J * 1024 + col);
        f32x4 o; o[0] = bflo(z.x) * v[0]; o[1] = bfhi(z.x) * v[1]; o[2] = bflo(z.y) * v[2]; o[3] = bfhi(z.y) * v[3];
        float* yp = y32 + (size_t)row * 1024 + col;
        if (J == 0) *(f32x4*)yp = o;
        else if (J == 1) { f32x4 t = *(f32x4*)yp; *(f32x4*)yp = t + o; }
        else { f32x4 t = *(f32x4*)yp; store4bf(ybf + (size_t)row * 1024 + col, t + o); }
    } };
struct FResid { float* x; const float* modl; int chunk;
    __device__ __forceinline__ void operator()(int row, int col, f32x4 v) const {
        const f32x4 mg = *(const f32x4*)(modl + row_vec(row) * 6144 + chunk * 1024 + col);
        float* xp = x + (size_t)row * 1024 + col; f32x4 t = *(f32x4*)xp; *(f32x4*)xp = t + mg * v;
    } };
struct FMlp1 { bf16_t* hid;
    __device__ __forceinline__ void operator()(int row, int col, f32x4 v) const {
        f32x4 o;
#pragma unroll
        for (int e = 0; e < 4; ++e) { const float r = fmaxf(v[e], 0.f); o[e] = r * r; }
        store4bf(hid + (size_t)row * 4096 + col, o);
    } };

__device__ __forceinline__ void phase_mod(float* smf) {
    CParams& p = KPL(); const Ctx cx = mkctx();
    const int tid = cx.tid, lane = tid & 63, wid = tid >> 6;
    float* sc = smf; float* red = smf + 3072;
    float* MOD = (float*)(p.ws + OFF_MOD);
    for (int i = tid; i < 3072; i += 512) { const int v = i >> 10, j = i & 1023; const float c = v < 2 ? p.in[1][v * 1024 + j] : p.in[3][j]; sc[i] = c / (1.f + expf(-c)); }
    __syncthreads();
    for (int item = cx.bid; item < 4 * 96; item += cx.nb) {
        const int l = item / 96, jt = item % 96, j = jt * 64 + lane;
        const float* w = p.in[4] + (size_t)l * 1024 * 6144 + j;
        float a0 = 0.f, a1 = 0.f, a2 = 0.f;
#pragma unroll 8
        for (int i = wid * 128; i < wid * 128 + 128; ++i) { const float wv = w[(size_t)i * 6144]; a0 += sc[i] * wv; a1 += sc[1024 + i] * wv; a2 += sc[2048 + i] * wv; }
        red[(wid * 3 + 0) * 64 + lane] = a0; red[(wid * 3 + 1) * 64 + lane] = a1; red[(wid * 3 + 2) * 64 + lane] = a2;
        __syncthreads();
        if (tid < 192) { const int v = tid >> 6; float s = 0.f;
            for (int w8 = 0; w8 < 8; ++w8) s += red[(w8 * 3 + v) * 64 + lane];
            MOD[(l * 3 + v) * 6144 + j] = s + p.in[5][l * 6144 + j]; }
        __syncthreads();
    }
}

__device__ __forceinline__ void dsincos(double x, double& s, double& c) {
    const double k = rint(x * 0.63661977236758134308);
    double r = fma(-k, 1.57079632679489655800, x); r = fma(-k, 6.12323399573676603587e-17, r);
    const double r2 = r * r;
    double ps = -1.0 / 355687428096000.0;
    ps = fma(ps, r2, 1.0 / 1307674368000.0); ps = fma(ps, r2, -1.0 / 6227020800.0); ps = fma(ps, r2, 1.0 / 39916800.0); ps = fma(ps, r2, -1.0 / 362880.0);
    ps = fma(ps, r2, 1.0 / 5040.0); ps = fma(ps, r2, -1.0 / 120.0); ps = fma(ps, r2, 1.0 / 6.0); ps = fma(ps, r2, -1.0); ps = -ps * r;
    double pc = 1.0 / 20922789888000.0;
    pc = fma(pc, r2, -1.0 / 87178291200.0); pc = fma(pc, r2, 1.0 / 479001600.0); pc = fma(pc, r2, -1.0 / 3628800.0); pc = fma(pc, r2, 1.0 / 40320.0);
    pc = fma(pc, r2, -1.0 / 720.0); pc = fma(pc, r2, 1.0 / 24.0); pc = fma(pc, r2, -0.5); pc = fma(pc, r2, 1.0);
    const int q = ((int)k) & 3;
    s = (q == 0) ? ps : (q == 1) ? pc : (q == 2) ? -ps : -pc;
    c = (q == 0) ? pc : (q == 1) ? -ps : (q == 2) ? -pc : ps;
}
__device__ __forceinline__ double dexp_neg(double x) {
    const double k = rint(x * 1.44269504088896338700);
    double r = fma(-k, 0.693147180369123816490, x); r = fma(-k, 1.90821492927058770002e-10, r);
    double pe = 1.0 / 6227020800.0;
    pe = fma(pe, r, 1.0 / 479001600.0); pe = fma(pe, r, 1.0 / 39916800.0); pe = fma(pe, r, 1.0 / 3628800.0); pe = fma(pe, r, 1.0 / 362880.0); pe = fma(pe, r, 1.0 / 40320.0);
    pe = fma(pe, r, 1.0 / 5040.0); pe = fma(pe, r, 1.0 / 720.0); pe = fma(pe, r, 1.0 / 120.0); pe = fma(pe, r, 1.0 / 24.0); pe = fma(pe, r, 1.0 / 6.0); pe = fma(pe, r, 0.5);
    pe = fma(pe, r, 1.0); pe = fma(pe, r, 1.0);
    int ki = (int)k; if (ki < -1000) return 0.0;
    return pe * __longlong_as_double((long long)(1023 + ki) << 52);
}

__device__ __forceinline__ void wconv_tile(const Ctx& cx, const float* src, int ld, int K, int c0, int ncols, bf16_t* dst, int kt, int nt, float* tile) {
    const int tid = cx.tid, j = tid & 63, i0 = tid >> 6;
#pragma unroll
    for (int e = 0; e < 8; ++e) { const int i = i0 + 8 * e; const int n = nt * 64 + j;
        tile[i * 65 + j] = (n < ncols) ? src[(size_t)(kt * 64 + i) * ld + c0 + n] : 0.f; }
    __syncthreads();
#pragma unroll
    for (int e = 0; e < 8; ++e) { const int jj = i0 + 8 * e;
        dst[(size_t)(nt * 64 + jj) * K + kt * 64 + j] = f2bf(tile[j * 65 + jj]); }
    __syncthreads();
}

template <int MODE>
__device__ __forceinline__ void phase_wconv(int l, float* smf) {
    CParams& p = KPL(); const Ctx cx = mkctx();
    bf16_t* W = (bf16_t*)(p.ws + OFF_W);
    const int tid = cx.tid;
    unsigned* ticket = (unsigned*)(p.ws + OFF_BAR) + 3520 + l * 16;
    int* tslot = (int*)smf + 8192;
    for (int it = (MODE == 2 ? 0 : cx.bid); ; it += cx.nb) {
        int item;
        if (MODE == 0) { item = it; if (item >= 5184) break; }
        else if (MODE == 1) { item = 3520 + it; if (item >= 4544) break; }
        else {
            if (tid == 0) *tslot = (int)__hip_atomic_fetch_add(ticket, 1u, __ATOMIC_RELAXED, __HIP_MEMORY_SCOPE_AGENT);
            __syncthreads();
            const int q = *tslot;
            __syncthreads();
            if (q >= 4160) break;
            item = q < 3520 ? q : q + 1024;
        }
        if (item < 4544) {
            const float* src; int ld, K, c0, ncols, nN; bf16_t* dst; int t = item;
            if (t < 1024) { src = p.in[8] + (size_t)l * 1024 * 6928; ld = 6928; K = 1024; c0 = 0; ncols = 3856; nN = 64; dst = W + W_MIX / 2; }
            else if (t < 1792) { t -= 1024; src = p.in[8] + (size_t)l * 1024 * 6928; ld = 6928; K = 1024; c0 = 3856; ncols = 3072; nN = 48; dst = W + W_GATE / 2; }
            else if (t < 1856) { t -= 1792; src = p.in[17] + (size_t)l * 512 * 512; ld = 512; K = 512; c0 = 0; ncols = 512; nN = 8; dst = W + W_GLU / 2; }
            else if (t < 1984) { t -= 1856; src = p.in[35] + (size_t)l * 512 * 1024; ld = 1024; K = 512; c0 = 0; ncols = 1024; nN = 16; dst = W + W_PA / 2; }
            else if (t < 2112) { t -= 1984; src = p.in[36] + (size_t)l * 512 * 1024; ld = 1024; K = 512; c0 = 0; ncols = 1024; nN = 16; dst = W + W_PB / 2; }
            else if (t < 2240) { t -= 2112; src = p.in[37] + (size_t)l * 512 * 1024; ld = 1024; K = 512; c0 = 0; ncols = 1024; nN = 16; dst = W + W_PC / 2; }
            else if (t < 2496) { t -= 2240; src = p.in[38] + (size_t)l * 1024 * 1024; ld = 1024; K = 1024; c0 = 0; ncols = 1024; nN = 16; dst = W + W_OUT / 2; }
            else if (t < 3520) { t -= 2496; src = p.in[39] + (size_t)l * 1024 * 4096; ld = 4096; K = 1024; c0 = 0; ncols = 4096; nN = 64; dst = W + W_1 / 2; }
            else { t -= 3520; src = p.in[40] + (size_t)l * 4096 * 1024; ld = 1024; K = 4096; c0 = 0; ncols = 1024; nN = 16; dst = W + W_2 / 2; }
            const int nt = t % nN, kt = t / nN;
            wconv_tile(cx, src, ld, K, c0, ncols, dst, kt, nt, smf);
        } else {
            bf16_t* dst = W + W_LORA / 2;
#pragma unroll
            for (int q = 0; q < 2; ++q) {
                const int e = (item - 4544) * 1024 + q * 512 + tid; const int n = e >> 8, k = e & 255;
                float v = 0.f;
                if (n < 1024) { if (k < 64) v = p.in[26][(((size_t)l * 2 + (n >> 9)) * 64 + k) * 512 + (n & 511)]; }
                else if (n < 2048) { if (k >= 64 && k < 128) v = p.in[28][(((size_t)l * 2 + ((n - 1024) >> 9)) * 64 + (k - 64)) * 512 + (n & 511)]; }
                else { if (k >= 128) v = p.in[29][((size_t)l * 128 + (k - 128)) * 512 + (n - 2048)]; }
                dst[e] = f2bf(v);
            }
        }
    }
}

__device__ __forceinline__ void phase_s5_params() {
    CParams& p = KPL(); const Ctx cx = mkctx();
    for (int item = cx.bid; item < 32; item += cx.nb) {
        const int l = item >> 3;
        const int idx = (item & 7) * 512 + cx.tid;
        const int dir = idx >> 11, g = (idx >> 6) & 31;
        float* S5P = (float*)(p.ws + OFF_S5P) + (size_t)l * 147456;
        const size_t pi = (size_t)l * 4096 + idx;
        const double lre = fmin((double)p.in[9][pi], -1e-4), lim = (double)p.in[10][pi];
        const double dt = dexp_neg((double)p.in[11][(l * 2 + dir) * 32 + g]);
        const double mag = dexp_neg(lre * dt); double sn, cs; dsincos(lim * dt, sn, cs);
        const double ar = mag * cs, ai = mag * sn;
        const double den = lre * lre + lim * lim, nr = ar - 1.0;
        const double cr = (nr * lre + ai * lim) / den, ci = (ai * lre - nr * lim) / den;
        const double mag64 = dexp_neg(64.0 * lre * dt); dsincos(64.0 * lim * dt, sn, cs);
        S5P[idx] = (float)ar; S5P[4096 + idx] = (float)ai; S5P[8192 + idx] = (float)(mag64 * cs); S5P[12288 + idx] = (float)(mag64 * sn);
        float* BR = S5P + 16384; float* BI = BR + 65536;
        for (int c = 0; c < 16; ++c) { const double bre = p.in[12][pi * 16 + c], bim = p.in[13][pi * 16 + c];
            BR[(size_t)idx * 16 + c] = (float)(cr * bre - ci * bim); BI[(size_t)idx * 16 + c] = (float)(cr * bim + ci * bre); }
    }
}

__device__ __forceinline__ void phase_norm(int l, int which, bool init) {
    CParams& p = KPL(); const Ctx cx = mkctx();
    const int lane = cx.tid & 63, gw = cx.bid * 8 + (cx.tid >> 6), nw = cx.nb * 8;
    float* X = (float*)(p.ws + OFF_X); bf16_t* H = (bf16_t*)(p.ws + OFF_H);
    const float* MODL = (const float*)(p.ws + OFF_MOD) + (size_t)l * 3 * 6144;
    const float* gam = p.in[which ? 7 : 6] + l * 1024;
    for (int row = gw; row < T_TOK; row += nw) {
        const int b = row >= SEQA ? 1 : 0, t = row - b * SEQA;
        const float* src = init ? (t < NCTX ? p.in[2] + ((size_t)b * NCTX + t) * 1024 : p.in[0] + ((size_t)b * 8192 + (t - NCTX)) * 1024) : X + (size_t)row * 1024;
        f32x4 v[4]; float ss = 0.f;
#pragma unroll
        for (int i = 0; i < 4; ++i) { v[i] = *(const f32x4*)(src + (lane + 64 * i) * 4); ss += v[i][0] * v[i][0] + v[i][1] * v[i][1] + v[i][2] * v[i][2] + v[i][3] * v[i][3]; }
        if (init) {
#pragma unroll
            for (int i = 0; i < 4; ++i) *(f32x4*)(X + (size_t)row * 1024 + (lane + 64 * i) * 4) = v[i];
        }
        ss = wave_sum(ss);
        const float inv = rsqrtf(ss * (1.f / 1024.f) + 1e-6f);
        const float* mv = MODL + (t < NCTX ? 2 : b) * 6144 + (which ? 3 : 0) * 1024;
#pragma unroll
        for (int i = 0; i < 4; ++i) { const int c = (lane + 64 * i) * 4;
            const f32x4 g4 = *(const f32x4*)(gam + c), sh = *(const f32x4*)(mv + c), scl = *(const f32x4*)(mv + 1024 + c);
            f32x4 o;
#pragma unroll
            for (int e = 0; e < 4; ++e) o[e] = v[i][e] * inv * g4[e] * (1.f + scl[e]) + sh[e];
            store4bf(H + (size_t)row * 1024 + c, o); }
    }
}

__device__ __forceinline__ int s5_order(int dir, int i) { return dir == 0 ? i : (i < 4 ? 3 - i : 135 - i); }

__device__ __forceinline__ void phase_s5_local(int l) {
    CParams& p = KPL(); const Ctx cx = mkctx();
    const int lane = cx.tid & 63, gw = cx.bid * 8 + (cx.tid >> 6), nw = cx.nb * 8;
    const bf16_t* ZA = (const bf16_t*)(p.ws + OFF_Z);
    const float* S5P = (const float*)(p.ws + OFF_S5P) + (size_t)l * 147456; const float* BR = S5P + 16384; const float* BI = BR + 65536;
    float* ST = (float*)(p.ws + OFF_S5ST);
    for (int item0 = gw; item0 < 16896; item0 += nw) {
        const int item = __builtin_amdgcn_readfirstlane(item0);
        const int chunk = item % 132, g = (item / 132) & 31, dir = (item / 4224) & 1, b = item / 8448;
        const int idx = dir * 2048 + g * 64 + lane;
        const float ar = S5P[idx], ai = S5P[4096 + idx];
        float br[16], bi[16];
#pragma unroll
        for (int q = 0; q < 4; ++q) { const f32x4 t0 = *(const f32x4*)(BR + (size_t)idx * 16 + q * 4), t1 = *(const f32x4*)(BI + (size_t)idx * 16 + q * 4);
#pragma unroll
            for (int e = 0; e < 4; ++e) { br[q * 4 + e] = t0[e]; bi[q * 4 + e] = t1[e]; } }
        const int row = b * SEQA + chunk * 64 + lane;
        const u32x4 u0 = *(const u32x4*)(ZA + (size_t)row * 2048 + g * 16), u1 = *(const u32x4*)(ZA + (size_t)row * 2048 + g * 16 + 8);
        unsigned ur[8] = {u0.x, u0.y, u0.z, u0.w, u1.x, u1.y, u1.z, u1.w};
        float hr = 0.f, hi = 0.f;
#pragma unroll 8
        for (int j = 0; j < 64; ++j) {
            const int tok = dir ? 63 - j : j;
            float bur = 0.f, bui = 0.f;
#pragma unroll
            for (int q = 0; q < 8; ++q) { const unsigned w = (unsigned)__builtin_amdgcn_readlane((int)ur[q], tok); const float x0 = bflo(w), x1 = bfhi(w);
                bur += br[2 * q] * x0 + br[2 * q + 1] * x1; bui += bi[2 * q] * x0 + bi[2 * q + 1] * x1; }
            const float nr = ar * hr - ai * hi + bur, ni = ar * hi + ai * hr + bui; hr = nr; hi = ni;
        }
        float* st = ST + ((((size_t)b * 2 + dir) * 32 + g) * 132 + chunk) * 128;
        st[lane] = hr; st[64 + lane] = hi;
    }
}

__device__ __forceinline__ void phase_s5_carry(int l) {
    CParams& p = KPL(); const Ctx cx = mkctx();
    const int lane = cx.tid & 63, gw = cx.bid * 8 + (cx.tid >> 6), nw = cx.nb * 8;
    const float* S5P = (const float*)(p.ws + OFF_S5P) + (size_t)l * 147456;
    float* ST = (float*)(p.ws + OFF_S5ST);
    for (int item0 = gw; item0 < 128; item0 += nw) {
        const int item = __builtin_amdgcn_readfirstlane(item0);
        const int g = item & 31, dir = (item >> 5) & 1, b = item >> 6;
        const int idx = dir * 2048 + g * 64 + lane;
        const float ar = S5P[8192 + idx], ai = S5P[12288 + idx];
        float* st = ST + (((size_t)b * 2 + dir) * 32 + g) * 132 * 128;
        float hr = 0.f, hi = 0.f;
        for (int i0 = 0; i0 < 132; i0 += 12) {
            float lr[12], li[12];
#pragma unroll
            for (int e = 0; e < 12; ++e) { const int c = s5_order(dir, i0 + e); lr[e] = st[c * 128 + lane]; li[e] = st[c * 128 + 64 + lane]; }
#pragma unroll
            for (int e = 0; e < 12; ++e) { const int c = s5_order(dir, i0 + e); st[c * 128 + lane] = hr; st[c * 128 + 64 + lane] = hi;
                const float nr = ar * hr - ai * hi + lr[e], ni = ar * hi + ai * hr + li[e]; hr = nr; hi = ni; }
        }
    }
}

template <int DIR>
__device__ __forceinline__ void s5_final_dir(CParams& p, int l, int b, int g, int chunk, int lane, const unsigned (&ur)[8], float* hst, f32x4* ybuf, int row0, float dsk, bf16_t* ZG) {
    const float* S5P = (const float*)(p.ws + OFF_S5P) + (size_t)l * 147456; const float* BR = S5P + 16384; const float* BI = BR + 65536;
    const float* ST = (const float*)(p.ws + OFF_S5ST);
    const bf16_t* ZA = (const bf16_t*)(p.ws + OFF_Z);
    const int idx = DIR * 2048 + g * 64 + lane;
    const float ar = S5P[idx], ai = S5P[4096 + idx];
    float br[16], bi[16];
#pragma unroll
    for (int q = 0; q < 4; ++q) { const f32x4 t0 = *(const f32x4*)(BR + (size_t)idx * 16 + q * 4), t1 = *(const f32x4*)(BI + (size_t)idx * 16 + q * 4);
#pragma unroll
        for (int e = 0; e < 4; ++e) { br[q * 4 + e] = t0[e]; bi[q * 4 + e] = t1[e]; } }
    float cbr[16], cbi[16];
    { const size_t cb = ((((size_t)l * 2 + DIR) * 32 + g) * 16 + (lane & 15)) * 64 + (lane >> 4);
#pragma unroll
      for (int i = 0; i < 16; ++i) { cbr[i] = p.in[14][cb + 4 * i]; cbi[i] = -p.in[15][cb + 4 * i]; } }
    const float* st = ST + ((((size_t)b * 2 + DIR) * 32 + g) * 132 + chunk) * 128;
    float hr = st[lane], hi = st[64 + lane];
    const int ch = g * 16 + (lane & 15);
#pragma unroll 1
    for (int si = 0; si < 4; ++si) {
        const int sc = DIR ? 3 - si : si;
#pragma unroll
        for (int jj = 0; jj < 16; ++jj) {
            const int tt = DIR ? 15 - jj : jj; const int tok = sc * 16 + tt;
            float bur = 0.f, bui = 0.f;
#pragma unroll
            for (int q = 0; q < 8; ++q) { const unsigned w = (unsigned)__builtin_amdgcn_readlane((int)ur[q], tok); const float x0 = bflo(w), x1 = bfhi(w);
                bur += br[2 * q] * x0 + br[2 * q + 1] * x1; bui += bi[2 * q] * x0 + bi[2 * q + 1] * x1; }
            const float nr = ar * hr - ai * hi + bur, ni = ar * hi + ai * hr + bui; hr = nr; hi = ni;
            hst[tt * 68 + lane] = hr; hst[1088 + tt * 68 + lane] = hi;
        }
        f32x4 a = (f32x4){0.f, 0.f, 0.f, 0.f};
        if (DIR) a = ybuf[sc * 64 + lane];
#pragma unroll
        for (int i = 0; i < 16; ++i) {
            const float xr = hst[(lane & 15) * 68 + 4 * i + (lane >> 4)], xi = hst[1088 + (lane & 15) * 68 + 4 * i + (lane >> 4)];
            a = __builtin_amdgcn_mfma_f32_16x16x4f32(xr, cbr[i], a, 0, 0, 0);
            a = __builtin_amdgcn_mfma_f32_16x16x4f32(xi, cbi[i], a, 0, 0, 0);
        }
        if (!DIR) ybuf[sc * 64 + lane] = a;
        else {
#pragma unroll
            for (int j = 0; j < 4; ++j) {
                const int row = row0 + sc * 16 + (lane >> 4) * 4 + j;
                const float u = bf2f(ZA[(size_t)row * 2048 + ch]);
                const float y = u * dsk + a[j];
                const float z = 0.5f * y * (1.f + tanhf(0.7978845608028654f * (y + 0.044715f * y * y * y)));
                ZG[(size_t)row * 512 + ch] = f2bf(z);
            }
        }
    }
}

__device__ __forceinline__ void phase_s5_final(int l, float* smf) {
    CParams& p = KPL(); const Ctx cx = mkctx();
    const int lane = cx.tid & 63, wid = cx.tid >> 6, gw = cx.bid * 8 + wid, nw = cx.nb * 8;
    const bf16_t* ZA = (const bf16_t*)(p.ws + OFF_Z);
    bf16_t* ZG = (bf16_t*)(p.ws + OFF_ZG);
    float* hst = smf + wid * 3200;
    f32x4* ybuf = (f32x4*)(hst + 2176);
    for (int item0 = gw; item0 < 8448; item0 += nw) {
        const int item = __builtin_amdgcn_readfirstlane(item0);
        const int chunk = item % 132, g = (item / 132) & 31, b = item / 4224;
        const int row0 = b * SEQA + chunk * 64;
        const u32x4 u0 = *(const u32x4*)(ZA + (size_t)(row0 + lane) * 2048 + g * 16), u1 = *(const u32x4*)(ZA + (size_t)(row0 + lane) * 2048 + g * 16 + 8);
        const unsigned ur[8] = {u0.x, u0.y, u0.z, u0.w, u1.x, u1.y, u1.z, u1.w};
        const float dsk = p.in[16][l * 512 + g * 16 + (lane & 15)];
        s5_final_dir<0>(p, l, b, g, chunk, lane, ur, hst, ybuf, row0, dsk, ZG);
        s5_final_dir<1>(p, l, b, g, chunk, lane, ur, hst, ybuf, row0, dsk, ZG);
    }
}

__device__ __forceinline__ int ml_row0(int b, int nc) { return b * SEQA + nc * 128; }
__device__ __forceinline__ int ml_order(int dir, int i) { return dir == 0 ? i : (i < 2 ? 1 - i : 67 - i); }

__device__ __forceinline__ void phase_ml_conv(int l) {
    CParams& p = KPL(); const Ctx cx = mkctx();
    const bf16_t* ZA = (const bf16_t*)(p.ws + OFF_Z);
    bf16_t* QKC = (bf16_t*)(p.ws + OFF_QKC);
    const float* cw = p.in[19] + (size_t)l * 9 * 512; const float* cb = p.in[20] + l * 512;
    for (int idx = cx.bid * 512 + cx.tid; idx < T_TOK * 64; idx += cx.nb * 512) {
        const int row = idx >> 6, c8 = (idx & 63) * 8;
        const int b = row >= SEQA ? 1 : 0, t = row - b * SEQA;
        const bool isctx = t < NCTX;
        const int tt = isctx ? t : t - NCTX, W = isctx ? 256 : 64, Hh = isctx ? 1 : 128;
        const int y = tt / W, x = tt % W;
        const int segrow0 = row - tt;
        float acc[8];
#pragma unroll
        for (int e = 0; e < 8; ++e) acc[e] = cb[c8 + e];
#pragma unroll
        for (int dy = 0; dy < 3; ++dy)
#pragma unroll
            for (int dx = 0; dx < 3; ++dx) {
                const int yy = y + dy - 1, xx = x + dx - 1;
                if (yy >= 0 && yy < Hh && xx >= 0 && xx < W) {
                    const u32x4 z = *(const u32x4*)(ZA + (size_t)(segrow0 + yy * W + xx) * 2048 + 512 + c8);
                    const float* w = cw + (dy * 3 + dx) * 512 + c8;
                    const f32x4 w0 = *(const f32x4*)w, w1 = *(const f32x4*)(w + 4);
                    acc[0] += bflo(z.x) * w0[0]; acc[1] += bfhi(z.x) * w0[1]; acc[2] += bflo(z.y) * w0[2]; acc[3] += bfhi(z.y) * w0[3];
                    acc[4] += bflo(z.z) * w1[0]; acc[5] += bfhi(z.z) * w1[1]; acc[6] += bflo(z.w) * w1[2]; acc[7] += bfhi(z.w) * w1[3];
                }
            }
        u32x4 o;
#pragma unroll
        for (int e = 0; e < 8; ++e) acc[e] = acc[e] * sigmoidf_(acc[e]);
        o.x = pk2(acc[0], acc[1]); o.y = pk2(acc[2], acc[3]); o.z = pk2(acc[4], acc[5]); o.w = pk2(acc[6], acc[7]);
        *(u32x4*)(QKC + (size_t)row * 512 + c8) = o;
    }
}

constexpr int ML_QS = 0, ML_KS = 18432, ML_VT = 36864, ML_CS = 71680, ML_PS = 92416, ML_GV = 127232, ML_BV = 127744, ML_MV = 128256, ML_LF = 128768, ML_IG = 129280, ML_SC = 129792;

__device__ __forceinline__ void ml_gate_vectors(const Ctx& cx, CParams& p, int l, int dir, int b, int h, int nc, unsigned char* sm, float m_in) {
    const int tid = cx.tid, lane = tid & 63;
    float* lf = (float*)(sm + ML_LF); float* ig = (float*)(sm + ML_IG); float* gv = (float*)(sm + ML_GV); float* bv = (float*)(sm + ML_BV); float* mv = (float*)(sm + ML_MV); float* sc = (float*)(sm + ML_SC);
    const float* MLG = (const float*)(p.ws + OFF_MLG);
    const float* gb = p.in[21] + l * 16;
    if (tid < 128) {
        const int row = ml_row0(b, nc) + tid;
        const float ip = MLG[(size_t)row * 16 + dir * 4 + h] + gb[dir * 4 + h];
        const float fp = MLG[(size_t)row * 16 + 8 + dir * 4 + h] + gb[8 + dir * 4 + h];
        ig[tid] = ip; lf[tid] = fminf(fp, 0.f) - log1pf(expf(-fabsf(fp)));
    }
    __syncthreads();
    if (tid < 64) {
        const int pp0 = 2 * lane, pp1 = 2 * lane + 1; const int s0 = dir ? 127 - pp0 : pp0, s1 = dir ? 127 - pp1 : pp1;
        const float x0 = lf[s0], x1 = lf[s1];
        float incl = x0 + x1;
#pragma unroll
        for (int d = 1; d < 64; d <<= 1) { const float t = __shfl_up(incl, d); if (lane >= d) incl += t; }
        const float g1 = incl, g0 = incl - x1;
        const float gtot = __shfl(incl, 63);
        const float b0 = ig[s0] - g0, b1 = ig[s1] - g1;
        float mx = fmaxf(b0, b1);
#pragma unroll
        for (int d = 1; d < 64; d <<= 1) { const float t = __shfl_up(mx, d); if (lane >= d) mx = fmaxf(mx, t); }
        const float prev = __shfl_up(mx, 1);
        const float pm0 = lane > 0 ? fmaxf(prev, b0) : b0, pm1 = mx;
        const float bmax = __shfl(mx, 63);
        gv[s0] = g0; gv[s1] = g1; bv[s0] = b0; bv[s1] = b1; mv[s0] = fmaxf(m_in, pm0); mv[s1] = fmaxf(m_in, pm1);
        if (lane == 0) { sc[0] = gtot; sc[1] = bmax; }
    }
    __syncthreads();
}

__device__ __forceinline__ void phase_ml_local(int l, unsigned char* sm) {
    CParams& p = KPL(); const Ctx cx = mkctx();
    const int tid = cx.tid, lane = tid & 63, wid = tid >> 6;
    const bf16_t* ZA = (const bf16_t*)(p.ws + OFF_Z); const bf16_t* QKC = (const bf16_t*)(p.ws + OFF_QKC);
    float* CLOC = (float*)(p.ws + OFF_CLOC); float* MLS = (float*)(p.ws + OFF_MLS);
    bf16_t* VT = (bf16_t*)(sm + ML_VT); bf16_t* KT = (bf16_t*)(sm + ML_KS);
    const float* bv = (const float*)(sm + ML_BV); const float* sc = (const float*)(sm + ML_SC);
    float* wg = (float*)(sm + ML_LF);
    for (int item = cx.bid; item < 1056; item += cx.nb) {
        const int chain = item / 66, nc = item % 66; const int dir = chain >> 3, b = (chain >> 2) & 1, h = chain & 3;
        ml_gate_vectors(cx, p, l, dir, b, h, nc, sm, -1e30f);
        const float gtot = sc[0], bmax = sc[1];
        __syncthreads();
        if (tid < 128) wg[tid] = expf(bv[tid] - bmax);
        __syncthreads();
        const int row0 = ml_row0(b, nc);
#pragma unroll
        for (int q = 0; q < 4; ++q) { const int ci = q * 512 + tid; const int s = ci >> 4, v8 = (ci & 15) * 8;
            const u32x4 z = *(const u32x4*)(ZA + (size_t)(row0 + s) * 2048 + 1024 + h * 128 + v8); const float w = wg[s];
            const unsigned zz[4] = {z.x, z.y, z.z, z.w};
#pragma unroll
            for (int e = 0; e < 4; ++e) { VT[(v8 + 2 * e) * 136 + s] = f2bf(bflo(zz[e]) * w); VT[(v8 + 2 * e + 1) * 136 + s] = f2bf(bfhi(zz[e]) * w); } }
#pragma unroll
        for (int q = 0; q < 2; ++q) { const int ci = q * 512 + tid; const int s = ci >> 3, k8 = (ci & 7) * 8;
            const u32x4 z = *(const u32x4*)(QKC + (size_t)(row0 + s) * 512 + 256 + h * 64 + k8);
            const unsigned zz[4] = {z.x, z.y, z.z, z.w};
#pragma unroll
            for (int e = 0; e < 4; ++e) { KT[(k8 + 2 * e) * 136 + s] = (bf16_t)(zz[e] & 0xffff); KT[(k8 + 2 * e + 1) * 136 + s] = (bf16_t)(zz[e] >> 16); } }
        __syncthreads();
        float* dst = CLOC + ((size_t)chain * 66 + nc) * 8256;
        f32x4 acc[4];
#pragma unroll
        for (int n = 0; n < 4; ++n) acc[n] = (f32x4){0.f, 0.f, 0.f, 0.f};
#pragma unroll
        for (int ks = 0; ks < 4; ++ks) {
            const bf16x8 a = *(const bf16x8*)(VT + (16 * wid + (lane & 15)) * 136 + ks * 32 + (lane >> 4) * 8);
#pragma unroll
            for (int n = 0; n < 4; ++n) { const bf16x8 bb = *(const bf16x8*)(KT + (16 * n + (lane & 15)) * 136 + ks * 32 + (lane >> 4) * 8);
                acc[n] = __builtin_amdgcn_mfma_f32_16x16x32_bf16(a, bb, acc[n], 0, 0, 0); }
        }
#pragma unroll
        for (int n = 0; n < 4; ++n)
#pragma unroll
            for (int j = 0; j < 4; ++j) dst[(16 * wid + (lane >> 4) * 4 + j) * 64 + 16 * n + (lane & 15)] = acc[n][j];
        if (tid < 64) { float s0 = 0.f, s1 = 0.f, s2 = 0.f, s3 = 0.f;
#pragma unroll 4
            for (int t = 0; t < 128; t += 4) { const u32x2 kq = *(const u32x2*)(KT + tid * 136 + t); const f32x4 w4 = *(const f32x4*)(wg + t);
                s0 += w4[0] * bflo(kq.x); s1 += w4[1] * bfhi(kq.x); s2 += w4[2] * bflo(kq.y); s3 += w4[3] * bfhi(kq.y); }
            dst[8192 + tid] = (s0 + s1) + (s2 + s3); }
        if (tid == 0) { MLS[chain * 66 + nc] = gtot; MLS[1056 + chain * 66 + nc] = gtot + bmax; }
        __syncthreads();
    }
}

__device__ __forceinline__ void phase_ml_carry() {
    CParams& p = KPL(); const Ctx cx = mkctx();
    float* CLOC = (float*)(p.ws + OFF_CLOC); float* MLS = (float*)(p.ws + OFF_MLS);
    for (int idx = cx.bid * 512 + cx.tid; idx < 16 * 8256; idx += cx.nb * 512) {
        const int chain = idx / 8256, e = idx % 8256; const int dir = chain >> 3;
        float* base = CLOC + (size_t)chain * 66 * 8256 + e;
        float m = -1e30f, C = 0.f;
        for (int i0 = 0; i0 < 66; i0 += 6) {
            float cl[6];
#pragma unroll
            for (int q = 0; q < 6; ++q) cl[q] = base[(size_t)ml_order(dir, i0 + q) * 8256];
#pragma unroll
            for (int q = 0; q < 6; ++q) { const int nc = ml_order(dir, i0 + q);
                const float gt = MLS[chain * 66 + nc], am = MLS[1056 + chain * 66 + nc];
                base[(size_t)nc * 8256] = C;
                if (e == 0) MLS[2112 + chain * 66 + nc] = m;
                const float mn = fmaxf(gt + m, am); const float so = expf(gt + m - mn), sl = expf(am - mn);
                C = so * C + sl * cl[q]; m = mn; }
        }
    }
}

__device__ __forceinline__ void phase_ml_out(int l, unsigned char* sm) {
    CParams& p = KPL(); const Ctx cx = mkctx();
    const int tid = cx.tid, lane = tid & 63, wid = tid >> 6;
    const bf16_t* ZA = (const bf16_t*)(p.ws + OFF_Z); const bf16_t* QKC = (const bf16_t*)(p.ws + OFF_QKC);
    const float* CLOC = (const float*)(p.ws + OFF_CLOC); const float* MLS = (const float*)(p.ws + OFF_MLS);
    bf16_t* YB = (bf16_t*)(p.ws + OFF_YB);
    bf16_t* QS = (bf16_t*)(sm + ML_QS); bf16_t* KS = (bf16_t*)(sm + ML_KS); bf16_t* VT = (bf16_t*)(sm + ML_VT); bf16_t* CS = (bf16_t*)(sm + ML_CS); bf16_t* PS = (bf16_t*)(sm + ML_PS);
    const float* gv = (const float*)(sm + ML_GV); const float* bv = (const float*)(sm + ML_BV); const float* mv = (const float*)(sm + ML_MV);
    for (int item = cx.bid; item < 528; item += cx.nb) {
        const int b = item / 264, h = (item / 66) & 3, nc = item % 66;
        const int row0 = ml_row0(b, nc);
        __syncthreads();
#pragma unroll
        for (int q = 0; q < 2; ++q) { const int ci = q * 512 + tid; const int s = ci >> 3, k8 = (ci & 7) * 8;
            const u32x4 zq = *(const u32x4*)(QKC + (size_t)(row0 + s) * 512 + h * 64 + k8);
            u32x4 o; o.x = pk2(bflo(zq.x) * 0.125f, bfhi(zq.x) * 0.125f); o.y = pk2(bflo(zq.y) * 0.125f, bfhi(zq.y) * 0.125f); o.z = pk2(bflo(zq.z) * 0.125f, bfhi(zq.z) * 0.125f); o.w = pk2(bflo(zq.w) * 0.125f, bfhi(zq.w) * 0.125f);
            *(u32x4*)(QS + s * 72 + k8) = o;
            *(u32x4*)(KS + s * 72 + k8) = *(const u32x4*)(QKC + (size_t)(row0 + s) * 512 + 256 + h * 64 + k8); }
#pragma unroll
        for (int q = 0; q < 4; ++q) { const int ci = q * 512 + tid; const int s = ci >> 4, v8 = (ci & 15) * 8;
            const u32x4 z = *(const u32x4*)(ZA + (size_t)(row0 + s) * 2048 + 1024 + h * 128 + v8);
            const unsigned zz[4] = {z.x, z.y, z.z, z.w};
#pragma unroll
            for (int e = 0; e < 4; ++e) { VT[(v8 + 2 * e) * 136 + s] = (bf16_t)(zz[e] & 0xffff); VT[(v8 + 2 * e + 1) * 136 + s] = (bf16_t)(zz[e] >> 16); } }
        f32x4 hsum[8];
#pragma unroll
        for (int v = 0; v < 8; ++v) hsum[v] = (f32x4){0.f, 0.f, 0.f, 0.f};
#pragma unroll 1
        for (int dir = 0; dir < 2; ++dir) {
            const int chain = dir * 8 + b * 4 + h;
            const float m_in = MLS[2112 + chain * 66 + nc];
            __syncthreads();
            ml_gate_vectors(cx, p, l, dir, b, h, nc, sm, m_in);
            const float* cin = CLOC + ((size_t)chain * 66 + nc) * 8256;
#pragma unroll
            for (int q = 0; q < 4; ++q) { const int ci = q * 512 + tid; const int v = ci >> 4, k4 = (ci & 15) * 4;
                const f32x4 c = *(const f32x4*)(cin + v * 64 + k4); store4bf(CS + v * 72 + k4, c); }
            if (tid < 16) { const f32x4 c = *(const f32x4*)(cin + 8192 + tid * 4); store4bf(CS + 128 * 72 + tid * 4, c); }
            else if (tid < 256) { const int r = 129 + (tid - 16) / 16, k4 = ((tid - 16) & 15) * 4; store4bf(CS + r * 72 + k4, (f32x4){0.f, 0.f, 0.f, 0.f}); }
            __syncthreads();
            const int tr = 16 * wid + (lane >> 4) * 4;
            float Mt[4], rs[4] = {0.f, 0.f, 0.f, 0.f};
#pragma unroll
            for (int j = 0; j < 4; ++j) Mt[j] = mv[tr + j];
            bf16x8 qa[2];
#pragma unroll
            for (int ks = 0; ks < 2; ++ks) qa[ks] = *(const bf16x8*)(QS + (16 * wid + (lane & 15)) * 72 + ks * 32 + (lane >> 4) * 8);
#pragma unroll
            for (int nt = 0; nt < 8; ++nt) {
                f32x4 s4 = (f32x4){0.f, 0.f, 0.f, 0.f};
#pragma unroll
                for (int ks = 0; ks < 2; ++ks) { const bf16x8 kb = *(const bf16x8*)(KS + (16 * nt + (lane & 15)) * 72 + ks * 32 + (lane >> 4) * 8);
                    s4 = __builtin_amdgcn_mfma_f32_16x16x32_bf16(qa[ks], kb, s4, 0, 0, 0); }
                const int s = 16 * nt + (lane & 15); const float bs = bv[s];
#pragma unroll
                for (int j = 0; j < 4; ++j) { const int t = tr + j; const bool valid = dir ? (s >= t) : (s <= t);
                    const float pv = valid ? s4[j] * __expf(bs - Mt[j]) : 0.f; rs[j] += pv; PS[t * 136 + s] = f2bf(pv); }
            }
#pragma unroll
            for (int j = 0; j < 4; ++j) rs[j] = row16_sum(rs[j]);
            __syncthreads();
            f32x4 qn = (f32x4){0.f, 0.f, 0.f, 0.f};
#pragma unroll
            for (int ks = 0; ks < 2; ++ks) { const bf16x8 cb = *(const bf16x8*)(CS + (128 + (lane & 15)) * 72 + ks * 32 + (lane >> 4) * 8);
                qn = __builtin_amdgcn_mfma_f32_16x16x32_bf16(qa[ks], cb, qn, 0, 0, 0); }
            float wi[4], dn[4];
#pragma unroll
            for (int j = 0; j < 4; ++j) { const float qnj = row16_sum(qn[j]); wi[j] = expf(m_in - Mt[j]);
                const float den = rs[j] + wi[j] * qnj; const float mt = gv[tr + j] + Mt[j]; dn[j] = 1.f / fmaxf(fabsf(den), expf(-mt)); }
            bf16x8 pa[4];
#pragma unroll
            for (int ks = 0; ks < 4; ++ks) pa[ks] = *(const bf16x8*)(PS + (16 * wid + (lane & 15)) * 136 + ks * 32 + (lane >> 4) * 8);
#pragma unroll
            for (int vt = 0; vt < 8; ++vt) {
                f32x4 a1 = (f32x4){0.f, 0.f, 0.f, 0.f}, a2 = (f32x4){0.f, 0.f, 0.f, 0.f};
#pragma unroll
                for (int ks = 0; ks < 4; ++ks) { const bf16x8 vb = *(const bf16x8*)(VT + (16 * vt + (lane & 15)) * 136 + ks * 32 + (lane >> 4) * 8);
                    a1 = __builtin_amdgcn_mfma_f32_16x16x32_bf16(pa[ks], vb, a1, 0, 0, 0); }
#pragma unroll
                for (int ks = 0; ks < 2; ++ks) { const bf16x8 cb = *(const bf16x8*)(CS + (16 * vt + (lane & 15)) * 72 + ks * 32 + (lane >> 4) * 8);
                    a2 = __builtin_amdgcn_mfma_f32_16x16x32_bf16(qa[ks], cb, a2, 0, 0, 0); }
#pragma unroll
                for (int j = 0; j < 4; ++j) hsum[vt][j] += (a1[j] + wi[j] * a2[j]) * dn[j];
            }
        }
        const int tr = 16 * wid + (lane >> 4) * 4;
        float rinv[4];
#pragma unroll
        for (int j = 0; j < 4; ++j) { float ss = 0.f;
#pragma unroll
            for (int vt = 0; vt < 8; ++vt) ss += hsum[vt][j] * hsum[vt][j];
            ss = row16_sum(ss); rinv[j] = rsqrtf(ss * (1.f / 128.f) + 1e-6f); }
#pragma unroll
        for (int vt = 0; vt < 8; ++vt) { const int ch = h * 128 + 16 * vt + (lane & 15); const float ng = p.in[22][l * 512 + ch];
#pragma unroll
            for (int j = 0; j < 4; ++j) { const int row = row0 + tr + j;
                const float o = bf2f(ZA[(size_t)row * 2048 + 1536 + ch]);
                YB[(size_t)row * 512 + ch] = f2bf(hsum[vt][j] * rinv[j] * ng * sigmoidf_(o)); } }
    }
}

__device__ __forceinline__ void phase_rw_feat(int l) {
    CParams& p = KPL(); const Ctx cx = mkctx();
    const int lane = cx.tid & 63, gw = cx.bid * 8 + (cx.tid >> 6), nw = cx.nb * 8;
    const bf16_t* ZRW = (const bf16_t*)(p.ws + OFF_ZRW);
    bf16_t* F1 = (bf16_t*)(p.ws + OFF_F1); bf16_t* LIN = (bf16_t*)(p.ws + OFF_LORAIN);
    const float* mup = p.in[23] + (size_t)l * 1792; const float* mun = p.in[24] + (size_t)l * 1792;
    const float* kk_w = p.in[30] + l * 512;
    for (int row = gw; row < T_TOK; row += nw) {
        const int b = row >= SEQA ? 1 : 0, t = row - b * SEQA;
        const bool hasp = !(t == 0 || t == NCTX), hasn = !(t == NCTX - 1 || t == SEQA - 1);
        const bf16_t* zc = ZRW + (size_t)row * 1792;
#pragma unroll
        for (int q = 0; q < 3; ++q) {
            const int col = q * 512 + lane * 8;
            const u32x4 c4 = *(const u32x4*)(zc + col);
            u32x4 p4 = (u32x4){0u, 0u, 0u, 0u}, n4 = (u32x4){0u, 0u, 0u, 0u};
            if (hasp) p4 = *(const u32x4*)(zc - 1792 + col);
            if (hasn) n4 = *(const u32x4*)(zc + 1792 + col);
            const unsigned cc[4] = {c4.x, c4.y, c4.z, c4.w}, pp[4] = {p4.x, p4.y, p4.z, p4.w}, nn[4] = {n4.x, n4.y, n4.z, n4.w};
            float zs[8];
#pragma unroll
            for (int e = 0; e < 8; ++e) { const float z = (e & 1) ? bfhi(cc[e >> 1]) : bflo(cc[e >> 1]); const float pv = (e & 1) ? bfhi(pp[e >> 1]) : bflo(pp[e >> 1]); const float nx = (e & 1) ? bfhi(nn[e >> 1]) : bflo(nn[e >> 1]);
                zs[e] = z + mup[col + e] * (pv - z) + mun[col + e] * (nx - z); }
            u32x4 o; o.x = pk2(zs[0], zs[1]); o.y = pk2(zs[2], zs[3]); o.z = pk2(zs[4], zs[5]); o.w = pk2(zs[6], zs[7]);
            *(u32x4*)(F1 + (size_t)row * 2048 + q * 512 + lane * 8) = o;
            if (q == 1) {
                float kr[8], ssq = 0.f;
#pragma unroll
                for (int e = 0; e < 8; ++e) { kr[e] = zs[e] * kk_w[lane * 8 + e]; ssq += kr[e] * kr[e]; }
                ssq = row8_sum(ssq);
                const float inv = 1.f / fmaxf(sqrtf(ssq), 1e-12f);
                u32x4 o2; o2.x = pk2(kr[0] * inv, kr[1] * inv); o2.y = pk2(kr[2] * inv, kr[3] * inv); o2.z = pk2(kr[4] * inv, kr[5] * inv); o2.w = pk2(kr[6] * inv, kr[7] * inv);
                *(u32x4*)(F1 + (size_t)row * 2048 + 1536 + lane * 8) = o2;
            }
        }
        {
            const int col = 1536 + lane * 4;
            const u32x2 c2 = *(const u32x2*)(zc + col);
            u32x2 p2 = (u32x2){0u, 0u}, n2 = (u32x2){0u, 0u};
            if (hasp) p2 = *(const u32x2*)(zc - 1792 + col);
            if (hasn) n2 = *(const u32x2*)(zc + 1792 + col);
            const unsigned cc[2] = {c2.x, c2.y}, pp[2] = {p2.x, p2.y}, nn[2] = {n2.x, n2.y};
            float zs[4];
#pragma unroll
            for (int e = 0; e < 4; ++e) { const float z = (e & 1) ? bfhi(cc[e >> 1]) : bflo(cc[e >> 1]); const float pv = (e & 1) ? bfhi(pp[e >> 1]) : bflo(pp[e >> 1]); const float nx = (e & 1) ? bfhi(nn[e >> 1]) : bflo(nn[e >> 1]);
                const float s = z + mup[col + e] * (pv - z) + mun[col + e] * (nx - z);
                zs[e] = lane < 16 ? tanhf(s) : (lane < 32 ? s : sigmoidf_(s)); }
            u32x2 o; o.x = pk2(zs[0], zs[1]); o.y = pk2(zs[2], zs[3]);
            *(u32x2*)(LIN + (size_t)row * 256 + lane * 4) = o;
        }
    }
}

__device__ __forceinline__ int rw_tok(int dir, int i) { return dir == 0 ? i : (i < NCTX ? NCTX - 1 - i : 8703 - i); }

typedef float f32x2 __attribute__((ext_vector_type(2)));
constexpr int RW_REC = 352;
__device__ __forceinline__ void rw_load(const bf16_t* f1, const bf16_t* f2, int dir, int rg, int c, int pw, int lane, bf16_t (&in)[8][5], bf16_t (&vin)[8]) {
#pragma unroll
    for (int q = 0; q < 8; ++q) { const size_t t = (size_t)rw_tok(dir, c * 32 + pw * 8 + q);
        in[q][0] = f1[t * 2048 + lane]; in[q][1] = f1[t * 2048 + 512 + lane]; in[q][2] = f1[t * 2048 + 1536 + lane]; in[q][3] = f2[t * 2048 + lane]; in[q][4] = f2[t * 2048 + 1024 + lane];
        vin[q] = f1[t * 2048 + 1024 + rg * 8 + (lane & 7)]; }
}
__device__ __forceinline__ void rw_emit(const bf16_t (&in)[8][5], const bf16_t (&vin)[8], int pw, int lane, float ka, float* buf) {
#pragma unroll
    for (int q = 0; q < 8; ++q) {
        const float r = bf2f(in[q][0]), k = bf2f(in[q][1]), kk = bf2f(in[q][2]), u = bf2f(in[q][3]), a = bf2f(in[q][4]);
        const float w = 1.f - u, key = k * (1.f + (a - 1.f) * ka), kka = kk * a, wr = w * r;
        const float c1 = wave_sum(kka * r), c2 = wave_sum(key * r);
        float* rec = buf + (pw * 8 + q) * RW_REC;
        rec[lane] = kk; rec[64 + lane] = wr; rec[128 + lane] = w; rec[192 + lane] = kka; rec[256 + lane] = key;
        if (lane < 8) { f32x4 vc; vc[0] = bf2f(vin[q]); vc[1] = c1; vc[2] = c2; vc[3] = 0.f; *(f32x4*)(rec + 320 + lane * 4) = vc; }
    }
}

__device__ __forceinline__ void phase_rw_scan(int l, unsigned char* sm) {
    CParams& p = KPL(); const Ctx cx = mkctx();
    const int tid = cx.tid, lane = tid & 63, wid = __builtin_amdgcn_readfirstlane(tid >> 6);
    const bf16_t* F1 = (const bf16_t*)(p.ws + OFF_F1); const bf16_t* F2 = (const bf16_t*)(p.ws + OFF_Z);
    bf16_t* YRAW = (bf16_t*)(p.ws + OFF_R2);
    float* ring = (float*)sm;
    const bool is_scan = wid < 2, is_prod = (wid & 2) != 0;
    const int pw = (wid & 1) + ((wid >> 2) << 1);
    for (int item = cx.bid; item < 256; item += cx.nb) {
        const int chain = item >> 3, rg = item & 7; const int dir = chain >> 4, b = (chain >> 3) & 1, h = chain & 7;
        const float ka = p.in[31][l * 512 + h * 64 + lane];
        const bf16_t* f1 = F1 + (size_t)b * SEQA * 2048 + h * 64; const bf16_t* f2 = F2 + (size_t)b * SEQA * 2048 + dir * 512 + h * 64;
        const int row = rg * 8 + (wid & 1) * 4 + (lane >> 4);
        bf16_t* yr = YRAW + ((size_t)dir * T_TOK + (size_t)b * SEQA) * 512 + h * 64 + row;
        bf16_t pin[8][5], pvin[8];
        __syncthreads();
        if (is_prod) { rw_load(f1, f2, dir, rg, 0, pw, lane, pin, pvin); rw_emit(pin, pvin, pw, lane, ka, ring); rw_load(f1, f2, dir, rg, 1, pw, lane, pin, pvin); }
        __syncthreads();
        f32x2 S01 = (f32x2){0.f, 0.f}, S23 = (f32x2){0.f, 0.f};
        if (is_scan) __builtin_amdgcn_s_setprio(3);
#pragma unroll 1
        for (int c = 0; c < 264; ++c) {
            float* buf = ring + (c & 1) * (32 * RW_REC);
            if (is_prod) { if (c + 1 < 264) { rw_emit(pin, pvin, pw, lane, ka, ring + ((c + 1) & 1) * (32 * RW_REC)); rw_load(f1, f2, dir, rg, c + 2 < 264 ? c + 2 : c + 1, pw, lane, pin, pvin); } }
            else if (is_scan) {
                const float* rb = buf + (lane & 15) * 4;
                const float* vb = buf + 320 + ((wid & 1) * 4 + (lane >> 4)) * 4;
#pragma unroll 1
                for (int hf = 0; hf < 2; ++hf) {
                    const float* rh = rb + hf * 16 * RW_REC; const float* vh = vb + hf * 16 * RW_REC;
                    f32x4 kk4 = *(const f32x4*)(rh), wr4 = *(const f32x4*)(rh + 64), w4 = *(const f32x4*)(rh + 128), ka4 = *(const f32x4*)(rh + 192), ky4 = *(const f32x4*)(rh + 256), vc4 = *(const f32x4*)(vh);
                    f32x4 nkk = *(const f32x4*)(rh + RW_REC), nwr = *(const f32x4*)(rh + RW_REC + 64), nw = *(const f32x4*)(rh + RW_REC + 128), nka = *(const f32x4*)(rh + RW_REC + 192), nky = *(const f32x4*)(rh + RW_REC + 256), nvc = *(const f32x4*)(vh + RW_REC);
                    float ybuf = 0.f;
#pragma unroll
                    for (int j = 0; j < 16; ++j) {
                        f32x4 mkk, mwr, mw, mka, mky, mvc;
                        if (j < 14) { const int o = (j + 2) * RW_REC;
                            mkk = *(const f32x4*)(rh + o); mwr = *(const f32x4*)(rh + o + 64); mw = *(const f32x4*)(rh + o + 128); mka = *(const f32x4*)(rh + o + 192); mky = *(const f32x4*)(rh + o + 256); mvc = *(const f32x4*)(vh + o); }
                        const float vv = vc4[0];
                        f32x2 p1 = S01 * (f32x2){kk4[0], kk4[1]}; p1 = S23 * (f32x2){kk4[2], kk4[3]} + p1;
                        f32x2 p2 = S01 * (f32x2){wr4[0], wr4[1]}; p2 = S23 * (f32x2){wr4[2], wr4[3]} + p2;
                        const f32x2 vv2 = (f32x2){vv, vv};
                        f32x2 u01 = (f32x2){ky4[0], ky4[1]} * vv2; u01 = S01 * (f32x2){w4[0], w4[1]} + u01;
                        f32x2 u23 = (f32x2){ky4[2], ky4[3]} * vv2; u23 = S23 * (f32x2){w4[2], w4[3]} + u23;
                        const float sk = row16_sum(p1[0] + p1[1]);
                        const float q2 = row16_sum(p2[0] + p2[1]);
                        const f32x2 nsk2 = (f32x2){-sk, -sk};
                        S01 = (f32x2){ka4[0], ka4[1]} * nsk2 + u01; S23 = (f32x2){ka4[2], ka4[3]} * nsk2 + u23;
                        const float y = q2 - sk * vc4[1] + vv * vc4[2];
                        if ((lane & 15) == j) ybuf = y;
                        kk4 = nkk; wr4 = nwr; w4 = nw; ka4 = nka; ky4 = nky; vc4 = nvc;
                        if (j < 14) { nkk = mkk; nwr = mwr; nw = mw; nka = mka; nky = mky; nvc = mvc; }
                        __builtin_amdgcn_sched_barrier(0);
                    }
                    yr[(size_t)rw_tok(dir, c * 32 + hf * 16 + (lane & 15)) * 512] = f2bf(ybuf);
                }
            }
            asm volatile("s_waitcnt lgkmcnt(0)" ::: "memory"); __builtin_amdgcn_s_barrier(); asm volatile("" ::: "memory");
        }
        if (is_scan) __builtin_amdgcn_s_setprio(0);
    }
}

__device__ __forceinline__ void phase_rw_out(int l) {
    CParams& p = KPL(); const Ctx cx = mkctx();
    const int lane = cx.tid & 63, gw = cx.bid * 8 + (cx.tid >> 6), nw = cx.nb * 8;
    const bf16_t* F1 = (const bf16_t*)(p.ws + OFF_F1); const bf16_t* F2 = (const bf16_t*)(p.ws + OFF_Z); const bf16_t* GRW = (const bf16_t*)(p.ws + OFF_ZRW);
    const bf16_t* YRAW = (const bf16_t*)(p.ws + OFF_R2);
    bf16_t* YC = (bf16_t*)(p.ws + OFF_YC);
    const int c0 = lane * 8;
    float ka[8], rk[8], lg[8], lb[8];
#pragma unroll
    for (int e = 0; e < 8; ++e) { ka[e] = p.in[31][l * 512 + c0 + e]; rk[e] = p.in[32][l * 512 + c0 + e]; lg[e] = p.in[33][l * 512 + c0 + e]; lb[e] = p.in[34][l * 512 + c0 + e]; }
    for (int row = gw; row < T_TOK; row += nw) {
        const u32x4 y0 = *(const u32x4*)(YRAW + (size_t)row * 512 + c0), y1 = *(const u32x4*)(YRAW + ((size_t)T_TOK + row) * 512 + c0);
        const u32x4 r4 = *(const u32x4*)(F1 + (size_t)row * 2048 + c0), k4 = *(const u32x4*)(F1 + (size_t)row * 2048 + 512 + c0), v4 = *(const u32x4*)(F1 + (size_t)row * 2048 + 1024 + c0);
        const u32x4 a04 = *(const u32x4*)(F2 + (size_t)row * 2048 + 1024 + c0), a14 = *(const u32x4*)(F2 + (size_t)row * 2048 + 1536 + c0);
        const u32x4 g4 = *(const u32x4*)(GRW + (size_t)row * 512 + c0);
        const unsigned ya[4] = {y0.x, y0.y, y0.z, y0.w}, yb[4] = {y1.x, y1.y, y1.z, y1.w}, rr[4] = {r4.x, r4.y, r4.z, r4.w}, kx[4] = {k4.x, k4.y, k4.z, k4.w}, vv[4] = {v4.x, v4.y, v4.z, v4.w};
        const unsigned aa[4] = {a04.x, a04.y, a04.z, a04.w}, ab[4] = {a14.x, a14.y, a14.z, a14.w}, gg[4] = {g4.x, g4.y, g4.z, g4.w};
        float y[8], sum = 0.f, bs = 0.f;
#pragma unroll
        for (int e = 0; e < 8; ++e) {
            const int w = e >> 1; const bool hi = e & 1;
            y[e] = (hi ? bfhi(ya[w]) : bflo(ya[w])) + (hi ? bfhi(yb[w]) : bflo(yb[w])); sum += y[e];
            const float r = hi ? bfhi(rr[w]) : bflo(rr[w]), k = hi ? bfhi(kx[w]) : bflo(kx[w]), a0 = hi ? bfhi(aa[w]) : bflo(aa[w]), a1 = hi ? bfhi(ab[w]) : bflo(ab[w]);
            bs += r * k * (2.f + (a0 + a1 - 2.f) * ka[e]) * rk[e];
        }
        sum = row8_sum(sum); bs = row8_sum(bs);
        const float mu = sum * (1.f / 64.f);
        float var = 0.f;
#pragma unroll
        for (int e = 0; e < 8; ++e) { const float d = y[e] - mu; var += d * d; }
        var = row8_sum(var) * (1.f / 64.f);
        const float rstd = rsqrtf(var + 64e-5f);
        float o[8];
#pragma unroll
        for (int e = 0; e < 8; ++e) { const int w = e >> 1; const bool hi = e & 1;
            const float v = hi ? bfhi(vv[w]) : bflo(vv[w]), g = hi ? bfhi(gg[w]) : bflo(gg[w]);
            o[e] = ((y[e] - mu) * rstd * lg[e] + lb[e] + bs * v) * g; }
        u32x4 o4; o4.x = pk2(o[0], o[1]); o4.y = pk2(o[2], o[3]); o4.z = pk2(o[4], o[5]); o4.w = pk2(o[6], o[7]);
        *(u32x4*)(YC + (size_t)row * 512 + c0) = o4;
    }
}

__device__ __forceinline__ void phase_final() {
    CParams& p = KPL(); const Ctx cx = mkctx();
    const int lane = cx.tid & 63, gw = cx.bid * 8 + (cx.tid >> 6), nw = cx.nb * 8;
    const float* X = (const float*)(p.ws + OFF_X);
    for (int r = gw; r < 2 * 8192; r += nw) {
        const int b = r >> 13, t = r & 8191;
        const float* src = X + ((size_t)b * SEQA + NCTX + t) * 1024;
        f32x4 v[4]; float ss = 0.f;
#pragma unroll
        for (int i = 0; i < 4; ++i) { v[i] = *(const f32x4*)(src + (lane + 64 * i) * 4); ss += v[i][0] * v[i][0] + v[i][1] * v[i][1] + v[i][2] * v[i][2] + v[i][3] * v[i][3]; }
        ss = wave_sum(ss);
        const float inv = rsqrtf(ss * (1.f / 1024.f) + 1e-6f);
#pragma unroll
        for (int i = 0; i < 4; ++i) { const int c = (lane + 64 * i) * 4; const f32x4 g4 = *(const f32x4*)(p.in[41] + c);
            *(f32x4*)(p.out + (size_t)r * 1024 + c) = v[i] * inv * g4; }
    }
}

#define XB_TMO      128
#define XB_XCNT(j)  (256  + 64 * (j))
#define XB_XSUB(j)  (1280 + 64 * (j))
#define XB_XGEN(j)  (2304 + 64 * (j))
#define XB_TOP      3328
#define XB_TOPGEN   3392
#define XCD_BAR_WORDS 3456
#define XB_SPIN_CAP (1u << 22)
constexpr int XB_LDS_OFF = 143344;
__device__ __forceinline__ unsigned xb_ld(unsigned* p)              { return __hip_atomic_load(p, __ATOMIC_RELAXED, __HIP_MEMORY_SCOPE_AGENT); }
__device__ __forceinline__ unsigned xb_add(unsigned* p, unsigned v) { return __hip_atomic_fetch_add(p, v, __ATOMIC_RELAXED, __HIP_MEMORY_SCOPE_AGENT); }
__device__ __forceinline__ unsigned xb_xcc_id() { return (unsigned)__builtin_amdgcn_s_getreg((3 << 11) | 20) & 0xFu; }
#define XB_SPIN(cond, bar) do { unsigned _sp = 0; while (cond) { __builtin_amdgcn_s_sleep(1); \
    if ((++_sp & 255u) == 0u) { if (xb_ld(&(bar)[XB_TMO])) break; if (_sp > XB_SPIN_CAP) { atomicAdd(&(bar)[XB_TMO], 1u); break; } } } } while (0)
__device__ __forceinline__ void xb_complete(unsigned* bar, unsigned x, unsigned G, unsigned& nloc, unsigned& nx) {
    unsigned sum, cnt, mine, sp = 0u;
    for (;;) {
        sum = 0u; cnt = 0u; mine = 0u;
#pragma unroll
        for (unsigned j = 0; j < 16; ++j) { const unsigned c = xb_ld(&bar[XB_XCNT(j)]); sum += c; cnt += (c > 0u) ? 1u : 0u; mine = (j == x) ? c : mine; }
        if (sum == G) break;
        __builtin_amdgcn_s_sleep(1);
        if ((++sp & 255u) == 0u) { if (xb_ld(&bar[XB_TMO])) break; if (sp > XB_SPIN_CAP) { atomicAdd(&bar[XB_TMO], 1u); break; } }
    }
    nloc = mine > 0u ? mine : 1u; nx = cnt > 0u ? cnt : 1u;
}
__device__ __forceinline__ void xb_post(unsigned char* smem) {
    CParams& p = KPL(); const Ctx cx = mkctx();
    volatile LAS unsigned* st = (volatile LAS unsigned*)((LAS unsigned char*)smem + XB_LDS_OFF);
    if (cx.tid == 0) { st[0] = 0u; st[1] = 0u; (void)xb_add(&((unsigned*)(p.ws + OFF_BAR))[XB_XCNT(xb_xcc_id())], 1u); }
    __syncthreads();
}
__device__ __forceinline__ void xsync(unsigned char* smem) {
    CParams& p = KPL(); const Ctx cx = mkctx();
    asm volatile("s_waitcnt vmcnt(0)" ::: "memory");
    __syncthreads();
    if (cx.tid == 0) {
        unsigned* bar = (unsigned*)(p.ws + OFF_BAR);
        volatile LAS unsigned* st = (volatile LAS unsigned*)((LAS unsigned char*)smem + XB_LDS_OFF);
        const unsigned x = xb_xcc_id();
        __builtin_amdgcn_s_waitcnt(0);
        unsigned nloc = st[0], nx = st[1];
        if (nloc == 0u) { xb_complete(bar, x, (unsigned)cx.nb, nloc, nx); st[0] = nloc; st[1] = nx; }
        const unsigned old = xb_add(&bar[XB_XSUB(x)], 1u);
        const unsigned gen = old / nloc;
        if (old + 1u == (gen + 1u) * nloc) {
            __builtin_amdgcn_fence(__ATOMIC_RELEASE, "agent");
            asm volatile("s_waitcnt vmcnt(0)" ::: "memory");
            const unsigned og = xb_add(&bar[XB_TOP], 1u);
            const unsigned tg = og / nx;
            if (og + 1u == (tg + 1u) * nx) xb_add(&bar[XB_TOPGEN], 1u);
            else XB_SPIN(xb_ld(&bar[XB_TOPGEN]) == tg, bar);
            __builtin_amdgcn_fence(__ATOMIC_ACQUIRE, "agent");
            xb_add(&bar[XB_XGEN(x)], 1u);
            asm volatile("s_waitcnt vmcnt(0)" ::: "memory");
        } else {
            XB_SPIN(xb_ld(&bar[XB_XGEN(x)]) == gen, bar);
            __builtin_amdgcn_fence(__ATOMIC_ACQUIRE, "agent");
            asm volatile("s_waitcnt vmcnt(0)" ::: "memory");
        }
    }
    __syncthreads();
}

#ifndef PHM
#define PHM 0xFFFFFFFFull
#endif
#ifndef PHR
#define PHR 0ull
#endif
#ifndef SYNCREP
#define SYNCREP 1
#endif
template <int WHICH>
__device__ __forceinline__ void gemm_stage(int l, LAS unsigned char* lds) {
    CParams& p = KPL(); const Ctx cx = mkctx();
    const int sk = (l == NLAYER - 1) ? 1 : 0;
    unsigned char* ws = p.ws;
    float* X = (float*)(ws + OFF_X); bf16_t* H = (bf16_t*)(ws + OFF_H); bf16_t* ZA = (bf16_t*)(ws + OFF_Z); bf16_t* ZRW = (bf16_t*)(ws + OFF_ZRW);
    bf16_t* W = (bf16_t*)(ws + OFF_W);
    const float* MODL = (const float*)(ws + OFF_MOD) + (size_t)l * 3 * 6144;
    if constexpr (WHICH == 0) run_gemm(cx, lds, H, W + W_MIX / 2, 4096, 1024, FInproj{ZA, (float*)(ws + OFF_MLG), ZRW});
    else if constexpr (WHICH == 1) run_gemm(cx, lds, (const bf16_t*)(ws + OFF_ZG), W + W_GLU / 2, 512, 512, FGlu{(const bf16_t*)(ws + OFF_ZG), p.in[18] + l * 512, (bf16_t*)(ws + OFF_YA)});
    else if constexpr (WHICH == 2) run_gemm_epi(cx, lds, (const bf16_t*)(ws + OFF_LORAIN), W + W_LORA / 2, 2560, 256, EpiLora{p.in[25] + l * 1024, p.in[27] + l * 1024, ZA, ZRW});
    else if constexpr (WHICH == 3) run_gemm(cx, lds, H, W + W_GATE / 2, 3072, 1024, FGate{ZA}, sk);
    else if constexpr (WHICH == 4) run_gemm(cx, lds, (const bf16_t*)(ws + OFF_YA), W + W_PA / 2, 1024, 512, FMerge<0>{ZA, (float*)(ws + OFF_F1), H}, sk);
    else if constexpr (WHICH == 5) run_gemm(cx, lds, (const bf16_t*)(ws + OFF_YB), W + W_PB / 2, 1024, 512, FMerge<1>{ZA, (float*)(ws + OFF_F1), H}, sk);
    else if constexpr (WHICH == 6) run_gemm(cx, lds, (const bf16_t*)(ws + OFF_YC), W + W_PC / 2, 1024, 512, FMerge<2>{ZA, (float*)(ws + OFF_F1), H}, sk);
    else if constexpr (WHICH == 7) run_gemm(cx, lds, H, W + W_OUT / 2, 1024, 1024, FResid{X, MODL, 2}, sk);
    else if constexpr (WHICH == 8) run_gemm(cx, lds, H, W + W_1 / 2, 4096, 1024, FMlp1{ZA}, sk);
    else run_gemm(cx, lds, ZA, W + W_2 / 2, 1024, 4096, FResid{X, MODL, 5}, sk);
}

template <int l>
__device__ __forceinline__ void run_layer(cg::grid_group& grid, LAS unsigned char* lds, float* smf, unsigned char* smem) {
        if constexpr (l == 0) phase_wconv<0>(l, smf); else phase_wconv<1>(l, smf);
        __syncthreads();
        if constexpr ((PHM >> 2) & 1) { phase_norm(l, 0, l == 0); if constexpr ((PHR >> 2) & 1) { __syncthreads(); phase_norm(l, 0, l == 0); } }
        for (int sr = 0; sr < SYNCREP; ++sr) xsync(smem);
        if constexpr ((PHM >> 3) & 1) { gemm_stage<0>(l, lds); if constexpr ((PHR >> 3) & 1) { __syncthreads(); gemm_stage<0>(l, lds); } }
        for (int sr = 0; sr < SYNCREP; ++sr) xsync(smem);
        if constexpr ((PHM >> 4) & 1) { phase_s5_local(l); if constexpr ((PHR >> 4) & 1) { __syncthreads(); phase_s5_local(l); } }
        if constexpr ((PHM >> 5) & 1) { phase_ml_conv(l); if constexpr ((PHR >> 5) & 1) { __syncthreads(); phase_ml_conv(l); } }
        for (int sr = 0; sr < SYNCREP; ++sr) xsync(smem);
        if constexpr ((PHM >> 6) & 1) { phase_s5_carry(l); if constexpr ((PHR >> 6) & 1) { __syncthreads(); phase_s5_carry(l); } }
        if constexpr ((PHM >> 7) & 1) { phase_ml_local(l, smem); if constexpr ((PHR >> 7) & 1) { __syncthreads(); phase_ml_local(l, smem); } }
        for (int sr = 0; sr < SYNCREP; ++sr) xsync(smem);
        if constexpr ((PHM >> 8) & 1) { phase_s5_final(l, smf); if constexpr ((PHR >> 8) & 1) { __syncthreads(); phase_s5_final(l, smf); } }
        if constexpr ((PHM >> 9) & 1) { phase_ml_carry(); if constexpr ((PHR >> 9) & 1) { __syncthreads(); phase_ml_carry(); } }
        for (int sr = 0; sr < SYNCREP; ++sr) xsync(smem);
        if constexpr ((PHM >> 10) & 1) { gemm_stage<1>(l, lds); if constexpr ((PHR >> 10) & 1) { __syncthreads(); gemm_stage<1>(l, lds); } }
        if constexpr ((PHM >> 11) & 1) { phase_ml_out(l, smem); if constexpr ((PHR >> 11) & 1) { __syncthreads(); phase_ml_out(l, smem); } }
        for (int sr = 0; sr < SYNCREP; ++sr) xsync(smem);
        if constexpr ((PHM >> 12) & 1) { phase_rw_feat(l); if constexpr ((PHR >> 12) & 1) { __syncthreads(); phase_rw_feat(l); } }
        for (int sr = 0; sr < SYNCREP; ++sr) xsync(smem);
        if constexpr ((PHM >> 13) & 1) { gemm_stage<2>(l, lds); if constexpr ((PHR >> 13) & 1) { __syncthreads(); gemm_stage<2>(l, lds); } }
        for (int sr = 0; sr < SYNCREP; ++sr) xsync(smem);
        if constexpr ((PHM >> 14) & 1) { phase_rw_scan(l, smem); if constexpr ((PHR >> 14) & 1) { __syncthreads(); phase_rw_scan(l, smem); } }
        for (int sr = 0; sr < SYNCREP; ++sr) xsync(smem);
        if constexpr ((PHM >> 15) & 1) { phase_rw_out(l); if constexpr ((PHR >> 15) & 1) { __syncthreads(); phase_rw_out(l); } }
        for (int sr = 0; sr < SYNCREP; ++sr) xsync(smem);
        if constexpr ((PHM >> 17) & 1) { gemm_stage<3>(l, lds); if constexpr ((PHR >> 17) & 1) { __syncthreads(); gemm_stage<3>(l, lds); } }
        for (int sr = 0; sr < SYNCREP; ++sr) xsync(smem);
        if constexpr ((PHM >> 18) & 1) { gemm_stage<4>(l, lds); if constexpr ((PHR >> 18) & 1) { __syncthreads(); gemm_stage<4>(l, lds); } }
        if constexpr ((PHM >> 19) & 1) { gemm_stage<5>(l, lds); if constexpr ((PHR >> 19) & 1) { __syncthreads(); gemm_stage<5>(l, lds); } }
        if constexpr ((PHM >> 20) & 1) { gemm_stage<6>(l, lds); if constexpr ((PHR >> 20) & 1) { __syncthreads(); gemm_stage<6>(l, lds); } }
        for (int sr = 0; sr < SYNCREP; ++sr) xsync(smem);
        if constexpr ((PHM >> 21) & 1) { gemm_stage<7>(l, lds); if constexpr ((PHR >> 21) & 1) { __syncthreads(); gemm_stage<7>(l, lds); } }
        for (int sr = 0; sr < SYNCREP; ++sr) xsync(smem);
        if constexpr ((PHM >> 22) & 1) { phase_norm(l, 1, false); if constexpr ((PHR >> 22) & 1) { __syncthreads(); phase_norm(l, 1, false); } }
        for (int sr = 0; sr < SYNCREP; ++sr) xsync(smem);
        if constexpr ((PHM >> 23) & 1) { gemm_stage<8>(l, lds); if constexpr ((PHR >> 23) & 1) { __syncthreads(); gemm_stage<8>(l, lds); } }
        for (int sr = 0; sr < SYNCREP; ++sr) xsync(smem);
        gemm_stage<9>(l, lds);
        if constexpr (l < NLAYER - 1) { __syncthreads(); phase_wconv<2>(l + 1, smf); }
        for (int sr = 0; sr < SYNCREP; ++sr) xsync(smem);
    }

__global__ void __launch_bounds__(512, 2) fwd_megakernel(Params p_unused) {
    extern __shared__ __attribute__((aligned(16))) unsigned char smem[];
    cg::grid_group grid = cg::this_grid();
    LAS unsigned char* lds = (LAS unsigned char*)smem;
    float* smf = (float*)smem;

    xb_post(smem);
    phase_mod(smf); phase_s5_params();
    grid.sync();
    run_layer<0>(grid, lds, smf, smem);
    run_layer<1>(grid, lds, smf, smem);
    run_layer<2>(grid, lds, smf, smem);
    run_layer<3>(grid, lds, smf, smem);
    phase_final();
}

extern "C" void kernel_launch(void* const* d_in, const int* in_sizes, int n_in, void* d_out, int out_size, void* d_ws, size_t ws_size, hipStream_t stream) {
    static int grid_blocks = 0;
    if (grid_blocks == 0) {
        if (n_in != 42 || ws_size < WS_END) { fprintf(stderr, "kernel_launch: unexpected n_in %d / ws_size %zu\n", n_in, ws_size); grid_blocks = -1; return; }
        int dev = 0, cus = 0, per_cu = 0;
        (void)hipGetDevice(&dev);
        (void)hipDeviceGetAttribute(&cus, hipDeviceAttributeMultiprocessorCount, dev);
        if (hipFuncSetAttribute((const void*)fwd_megakernel, hipFuncAttributeMaxDynamicSharedMemorySize, LDS_BYTES) != hipSuccess) { fprintf(stderr, "kernel_launch: hipFuncSetAttribute failed\n"); grid_blocks = -1; return; }
        if (hipOccupancyMaxActiveBlocksPerMultiprocessor(&per_cu, (const void*)fwd_megakernel, 512, LDS_BYTES) != hipSuccess || per_cu < 1) { fprintf(stderr, "kernel_launch: occupancy query says %d\n", per_cu); per_cu = 1; (void)hipGetLastError(); }
        grid_blocks = cus * 1;
    }
    if (grid_blocks < 0) return;
    if (hipMemsetAsync((unsigned char*)d_ws + OFF_BAR, 0, 16384, stream) != hipSuccess) { fprintf(stderr, "kernel_launch: memset failed\n"); return; }
    Params p{};
    for (int i = 0; i < 42; ++i) p.in[i] = (const float*)d_in[i];
    p.out = (float*)d_out; p.ws = (unsigned char*)d_ws;
    void* args[] = {&p};
    hipError_t e = hipLaunchCooperativeKernel((const void*)fwd_megakernel, dim3(grid_blocks), dim3(512), args, LDS_BYTES, stream);
    if (e != hipSuccess) fprintf(stderr, "cooperative launch failed: %s (grid %d)\n", hipGetErrorString(e), grid_blocks);
}
```

```cpp
#include <hip/hip_runtime.h>
#include <hip/hip_cooperative_groups.h>
#include <cstdio>
namespace cg = cooperative_groups;

#define LAS __attribute__((address_space(3)))
typedef unsigned short bf16_t;
typedef short bf16x8 __attribute__((ext_vector_type(8)));
typedef float f32x4 __attribute__((ext_vector_type(4)));
typedef unsigned u32x4 __attribute__((ext_vector_type(4)));
typedef unsigned u32x2 __attribute__((ext_vector_type(2)));

constexpr int T_TOK = 16896, SEQA = 8448, NCTX = 256;
constexpr int NLAYER = 4;
constexpr int LDS_BYTES = 143360;
constexpr size_t OFF_X = 0;
constexpr size_t OFF_H = 69206016;
constexpr size_t OFF_Z = 103809024;
constexpr size_t OFF_ZRW = OFF_Z + 69206016;
constexpr size_t OFF_MLG = 242221056;
constexpr size_t OFF_W = 243302400;
constexpr size_t OFF_YA = 281837568;
constexpr size_t OFF_YB = 299139072;
constexpr size_t OFF_YC = 316440576;
constexpr size_t OFF_F1 = 333742080;
constexpr size_t OFF_MOD = 402948096;
constexpr size_t OFF_S5P = 403243008;
constexpr size_t OFF_MLS = OFF_S5P + 4 * 589824;
constexpr size_t OFF_R2 = OFF_MLS + 16384;
constexpr size_t OFF_BAR = OFF_R2 + 34603008;
constexpr size_t WS_END = OFF_BAR + 16384;
constexpr size_t OFF_CLOC = OFF_F1;
constexpr size_t OFF_S5ST = OFF_F1 + 34873344;
constexpr size_t OFF_QKC = OFF_F1 + 43524096;
constexpr size_t OFF_ZG = OFF_R2;
constexpr size_t OFF_LORAIN = OFF_R2 + 17301504;
constexpr size_t W_MIX = 0, W_GATE = 8388608, W_GLU = 14680064, W_LORA = 15204352, W_PA = 16515072, W_PB = 17563648, W_PC = 18612224, W_OUT = 19660800, W_1 = 21757952, W_2 = 30146560;

struct Params {
    const float* in[42];
    float* out;
    unsigned char* ws;
};

typedef const __attribute__((address_space(4))) Params CParams;
__device__ __forceinline__ CParams& KPL() {
    unsigned long long a = (unsigned long long)__builtin_amdgcn_kernarg_segment_ptr();
    asm volatile("" : "+s"(a));
    return *(CParams*)a;
}
struct Ctx { int tid, bid, nb; };
__device__ __forceinline__ Ctx mkctx() { Ctx c; c.tid = threadIdx.x; c.bid = blockIdx.x; c.nb = gridDim.x; asm volatile("" : "+v"(c.tid), "+s"(c.bid), "+s"(c.nb)); return c; }
__device__ __forceinline__ float bf2f(unsigned v) { return __uint_as_float(v << 16); }
__device__ __forceinline__ float bflo(unsigned w) { return __uint_as_float(w << 16); }
__device__ __forceinline__ float bfhi(unsigned w) { return __uint_as_float(w & 0xffff0000u); }
__device__ __forceinline__ bf16_t f2bf(float f) { unsigned u = __float_as_uint(f); u += 0x7FFFu + ((u >> 16) & 1u); return (bf16_t)(u >> 16); }
__device__ __forceinline__ unsigned pk2(float lo, float hi) { return (unsigned)f2bf(lo) | ((unsigned)f2bf(hi) << 16); }
__device__ __forceinline__ void store4bf(bf16_t* p, f32x4 v) { u32x2 r; r.x = pk2(v[0], v[1]); r.y = pk2(v[2], v[3]); *(u32x2*)p = r; }
__device__ __forceinline__ float sigmoidf_(float x) { return 1.f / (1.f + __expf(-x)); }

#define DPP_F(x, ctrl, rmask) __int_as_float(__builtin_amdgcn_update_dpp(0, __float_as_int(x), ctrl, rmask, 0xF, false))
__device__ __forceinline__ float row8_sum(float x) {
    x += DPP_F(x, 0xB1, 0xF); x += DPP_F(x, 0x4E, 0xF); x += DPP_F(x, 0x141, 0xF); return x;
}
__device__ __forceinline__ float row16_sum(float x) {
    x += DPP_F(x, 0xB1, 0xF); x += DPP_F(x, 0x4E, 0xF); x += DPP_F(x, 0x141, 0xF); x += DPP_F(x, 0x140, 0xF); return x;
}
__device__ __forceinline__ float wave_sum(float x) {
    x = row16_sum(x);
    x += DPP_F(x, 0x142, 0xA);
    x += DPP_F(x, 0x143, 0xC);
    return __int_as_float(__builtin_amdgcn_readlane(__float_as_int(x), 63));
}

namespace pg8 {
constexpr int BM = 256, BK = 64, HALF = 128, HTB = HALF * BK * 2, NXCD = 8, WGM = 8;
__device__ __forceinline__ int lds_byte(int r, int c) { const int st = (r >> 4) * 2 + (c >> 5), rr = r & 15, cc = c & 31, ob = rr * 64 + cc * 2; return st * 1024 + (ob ^ (((ob >> 9) & 1) << 5)); }
__device__ __forceinline__ void stage_rc(int b, int& R, int& C) { const int st = b / 1024, sb = b % 1024, swz = sb ^ (((sb >> 9) & 1) << 5); R = (st >> 1) * 16 + swz / 64; C = (st & 1) * 32 + (swz % 64) / 2; }
struct Unit { int pm, pn; };
struct Gemm { const bf16_t* A; const bf16_t* Bt; int M, N, K; };
struct StaticOrder {
    int nM, nN, nwg, G, c, skipctx;
    __device__ void init(int M, int N, int G_, int c_, int skip_ = 0) { nM = M / BM - 2 * skip_; nN = N / BM; nwg = nM * nN; G = G_; c = c_; skipctx = skip_; }
    __device__ bool next(int i, Unit& u) const {
        const long L = (long)i * G + c; if (L >= nwg) return false;
        int wgid = (int)L; { const int q = nwg / NXCD, r = nwg % NXCD, xcd = wgid % NXCD, off = wgid / NXCD; wgid = (xcd < r ? xcd * (q + 1) : r * (q + 1) + (xcd - r) * q) + off; }
        const int nig = WGM * nN, gid = wgid / nig, fm = gid * WGM, gsz = (nM - fm) < WGM ? (nM - fm) : WGM;
        u.pm = fm + ((wgid % nig) % gsz); u.pn = (wgid % nig) / gsz;
        if (skipctx) u.pm += (u.pm >= 32) ? 2 : 1;
        return true;
    }
};

template <class Epi>
__device__ __forceinline__ void gemm_phase(int tid_in, LAS unsigned char* lds, const Gemm g, const StaticOrder& S, const Epi& E) {
    const int tid = tid_in, wid = __builtin_amdgcn_readfirstlane(tid >> 6), lane = tid & 63, wr = wid >> 2, wc = wid & 3, fr = lane & 15, fq = lane >> 4;
    const int K = g.K, nt = K / BK;
    unsigned voffA[2], voffB[2];
#pragma unroll
    for (int i = 0; i < 2; ++i) { int R, C; stage_rc(tid * 16 + i * 8192, R, C); voffA[i] = (unsigned)(R * K + C) * 2u; voffB[i] = voffA[i]; }
    const size_t kstep = (size_t)(BK * 2);
    const size_t hstep = (size_t)HALF * K * 2;
    const size_t tstep = 2 * hstep;
    const unsigned ldsw = (unsigned)wid * 1024u;
    const int aoff = lds_byte(wr * 64 + fr, fq * 8), boff = lds_byte(wc * 32 + fr, fq * 8);
#define PG8_SA(b, h) (((b) * 2 + (h)) * HTB)
#define PG8_SB(b, h) ((4 + (b) * 2 + (h)) * HTB)
#define PG8_STAGE(bufoff, gbase, voff) do { _Pragma("unroll") for (int _i = 0; _i < 2; ++_i) \
        __builtin_amdgcn_global_load_lds((const unsigned*)((const char*)(gbase) + (voff)[_i]), (LAS unsigned*)(lds + (bufoff) + ldsw + _i * 8192), 16, 0, 0); } while (0)
#define PG8_LDA(dst, b, h) do { _Pragma("unroll") for (int m = 0; m < 4; ++m) _Pragma("unroll") for (int k = 0; k < 2; ++k) dst[m][k] = *(const LAS bf16x8*)(lds + PG8_SA(b, h) + aoff + m * 2048 + k * 1024); } while (0)
#define PG8_LDB(dst, b, h) do { _Pragma("unroll") for (int n = 0; n < 2; ++n) _Pragma("unroll") for (int k = 0; k < 2; ++k) dst[n][k] = *(const LAS bf16x8*)(lds + PG8_SB(b, h) + boff + n * 2048 + k * 1024); } while (0)
#define PG8_MMA(ai, bj, At, Bt) do { __builtin_amdgcn_s_setprio(1); _Pragma("unroll") for (int m = 0; m < 4; ++m) _Pragma("unroll") for (int n = 0; n < 2; ++n) _Pragma("unroll") for (int k = 0; k < 2; ++k) \
        acc[ai][bj][m][n] = __builtin_amdgcn_mfma_f32_16x16x32_bf16(Bt[n][k], At[m][k], acc[ai][bj][m][n], 0, 0, 0); __builtin_amdgcn_s_setprio(0); } while (0)
#define PG8_WAIT_V(n) asm volatile("s_waitcnt vmcnt(" #n ")" ::: "memory")
#define PG8_WAIT_L(n) asm volatile("s_waitcnt lgkmcnt(" #n ")" ::: "memory")
#define PG8_BAR __builtin_amdgcn_s_barrier()
#define PG8_SCHED __builtin_amdgcn_sched_barrier(0)
    Unit cur, nxt; int ui = 0;
    if (!S.next(0, cur)) return;
    f32x4 acc[2][2][4][2];
#pragma unroll
    for (int a = 0; a < 2; ++a)
#pragma unroll
        for (int b = 0; b < 2; ++b)
#pragma unroll
            for (int m = 0; m < 4; ++m)
#pragma unroll
                for (int n = 0; n < 2; ++n) acc[a][b][m][n] = (f32x4){0.f, 0.f, 0.f, 0.f};
    bf16x8 At[4][2], B0[2][2], B1[2][2];
    const char* cA = (const char*)g.A + (size_t)cur.pm * tstep; const char* cB = (const char*)g.Bt + (size_t)cur.pn * tstep;
    PG8_STAGE(PG8_SB(0, 0), cB, voffB); PG8_STAGE(PG8_SA(0, 0), cA, voffA); PG8_STAGE(PG8_SB(0, 1), cB + hstep, voffB); PG8_STAGE(PG8_SA(0, 1), cA + hstep, voffA);
    if (wr == 1) PG8_BAR;
    PG8_WAIT_V(4); PG8_BAR;
    PG8_STAGE(PG8_SB(1, 0), cB + kstep, voffB); PG8_STAGE(PG8_SA(1, 0), cA + kstep, voffA); PG8_STAGE(PG8_SB(1, 1), cB + hstep + kstep, voffB);
    PG8_WAIT_V(6); PG8_BAR;
    for (;;) {
        const bool has_next = S.next(ui + 1, nxt);
        const char* nA = has_next ? (const char*)g.A + (size_t)nxt.pm * tstep : cA; const char* nB = has_next ? (const char*)g.Bt + (size_t)nxt.pn * tstep : cB;
        for (int t = 0; t < nt; t += 2) {
            const bool last = (t == nt - 2);
            const char* a1 = cA + (size_t)(t + 1) * kstep;
            const char* a2 = last ? nA : cA + (size_t)(t + 2) * kstep; const char* b2 = last ? nB : cB + (size_t)(t + 2) * kstep;
            const char* a3 = a2 + kstep; const char* b3 = b2 + kstep;
            PG8_LDB(B0, 0, 0); PG8_SCHED; PG8_LDA(At, 0, 0); PG8_STAGE(PG8_SA(1, 1), a1 + hstep, voffA);
            PG8_WAIT_L(8); PG8_BAR; PG8_WAIT_L(0); PG8_MMA(0, 0, At, B0); PG8_BAR; PG8_SCHED;
            PG8_LDB(B1, 0, 1); PG8_STAGE(PG8_SB(0, 0), b2, voffB);
            PG8_BAR; PG8_WAIT_L(0); PG8_MMA(0, 1, At, B1); PG8_BAR;
            PG8_LDA(At, 0, 1); PG8_STAGE(PG8_SA(0, 0), a2, voffA);
            PG8_BAR; PG8_WAIT_L(0); PG8_MMA(1, 0, At, B0); PG8_BAR; PG8_SCHED;
            PG8_STAGE(PG8_SB(0, 1), b2 + hstep, voffB);
            PG8_WAIT_V(6); PG8_BAR; PG8_MMA(1, 1, At, B1); PG8_BAR;
            PG8_LDB(B0, 1, 0); PG8_SCHED; PG8_LDA(At, 1, 0); PG8_STAGE(PG8_SA(0, 1), a2 + hstep, voffA);
            PG8_WAIT_L(8); PG8_BAR; PG8_WAIT_L(0); PG8_MMA(0, 0, At, B0); PG8_BAR; PG8_SCHED;
            PG8_LDB(B1, 1, 1); PG8_STAGE(PG8_SB(1, 0), b3, voffB);
            PG8_BAR; PG8_WAIT_L(0); PG8_MMA(0, 1, At, B1); PG8_BAR;
            PG8_LDA(At, 1, 1); PG8_STAGE(PG8_SA(1, 0), a3, voffA);
            PG8_BAR; PG8_WAIT_L(0); PG8_MMA(1, 0, At, B0); PG8_BAR; PG8_SCHED;
            PG8_STAGE(PG8_SB(1, 1), b3 + hstep, voffB);
            PG8_WAIT_V(6); PG8_BAR; PG8_MMA(1, 1, At, B1); PG8_BAR;
        }
        E(acc, cur, wr, wc, fr, fq);
        if (!has_next) break;
#pragma unroll
        for (int a = 0; a < 2; ++a)
#pragma unroll
            for (int b = 0; b < 2; ++b)
#pragma unroll
                for (int m = 0; m < 4; ++m)
#pragma unroll
                    for (int n = 0; n < 2; ++n) acc[a][b][m][n] = (f32x4){0.f, 0.f, 0.f, 0.f};
        cur = nxt; cA = nA; cB = nB; ++ui;
    }
    PG8_WAIT_V(0);
    if (wr == 0) PG8_BAR;
    PG8_BAR;
#undef PG8_SA
#undef PG8_SB
#undef PG8_STAGE
#undef PG8_LDA
#undef PG8_LDB
#undef PG8_MMA
#undef PG8_WAIT_V
#undef PG8_WAIT_L
#undef PG8_BAR
#undef PG8_SCHED
}

template <class F> struct EpiT {
    F f;
    __device__ __forceinline__ void operator()(const f32x4 (&acc)[2][2][4][2], const Unit& u, int wr, int wc, int fr, int fq) const {
        const int row0 = u.pm * BM + wr * 64 + fr, col0 = u.pn * BM + wc * 32 + 4 * fq;
#pragma unroll
        for (int ai = 0; ai < 2; ++ai)
#pragma unroll
            for (int m = 0; m < 4; ++m) {
                const int row = row0 + ai * HALF + m * 16;
#pragma unroll
                for (int bj = 0; bj < 2; ++bj)
#pragma unroll
                    for (int n = 0; n < 2; ++n) f(row, col0 + bj * HALF + n * 16, acc[ai][bj][m][n]);
            }
    }
};
}

template <class F>
__device__ __forceinline__ void run_gemm(const Ctx& cx, LAS unsigned char* lds, const bf16_t* A, const bf16_t* Bt, int N, int K, const F& f, int skip = 0) {
    pg8::Gemm g; g.A = A; g.Bt = Bt; g.M = T_TOK; g.N = N; g.K = K;
    pg8::StaticOrder S; S.init(T_TOK, N, cx.nb, cx.bid, skip);
    pg8::EpiT<F> E{f};
    pg8::gemm_phase(cx.tid, lds, g, S, E);
}

template <class E>
__device__ __forceinline__ void run_gemm_epi(const Ctx& cx, LAS unsigned char* lds, const bf16_t* A, const bf16_t* Bt, int N, int K, const E& e) {
    pg8::Gemm g; g.A = A; g.Bt = Bt; g.M = T_TOK; g.N = N; g.K = K;
    pg8::StaticOrder S; S.init(T_TOK, N, cx.nb, cx.bid);
    pg8::gemm_phase(cx.tid, lds, g, S, e);
}
__device__ __forceinline__ int row_vec(int row) { const int b = row >= SEQA ? 1 : 0; const int t = row - b * SEQA; return t < NCTX ? 2 : b; }

struct FInproj { bf16_t* za; float* mlg; bf16_t* zrw;
    __device__ __forceinline__ void operator()(int row, int col, f32x4 v) const {
        if (col < 2048) store4bf(za + (size_t)row * 2048 + col, v);
        else if (col < 2064) *(f32x4*)(mlg + (size_t)row * 16 + (col - 2048)) = v;
        else if (col < 3856) store4bf(zrw + (size_t)row * 1792 + (col - 2064), v);
    } };
struct FGlu { const bf16_t* zg; const float* bglu; bf16_t* ya;
    __device__ __forceinline__ void operator()(int row, int col, f32x4 v) const {
        const u32x2 z = *(const u32x2*)(zg + (size_t)row * 512 + col); const f32x4 b = *(const f32x4*)(bglu + col);
        f32x4 o; o[0] = bflo(z.x) * sigmoidf_(v[0] + b[0]); o[1] = bfhi(z.x) * sigmoidf_(v[1] + b[1]); o[2] = bflo(z.y) * sigmoidf_(v[2] + b[2]); o[3] = bfhi(z.y) * sigmoidf_(v[3] + b[3]);
        store4bf(ya + (size_t)row * 512 + col, o);
    } };
struct EpiLora { const float* w0; const float* a0; bf16_t* f2; bf16_t* grw;
    __device__ __forceinline__ void operator()(const f32x4 (&acc)[2][2][4][2], const pg8::Unit& u, int wr, int wc, int fr, int fq) const {
        const int row0 = u.pm * 256 + wr * 64 + fr, col0 = u.pn * 256 + wc * 32 + 4 * fq;
        const int pn = __builtin_amdgcn_readfirstlane(u.pn);
        if (pn < 8) {
            const float* bias = pn < 4 ? w0 : a0 - 1024;
#pragma unroll
            for (int bj = 0; bj < 2; ++bj)
#pragma unroll
                for (int n = 0; n < 2; ++n) {
                    const int col = col0 + bj * 128 + n * 16;
                    const f32x4 b = *(const f32x4*)(bias + col);
#pragma unroll
                    for (int ai = 0; ai < 2; ++ai)
#pragma unroll
                        for (int m = 0; m < 4; ++m) {
                            const int row = row0 + ai * 128 + m * 16; f32x4 o;
#pragma unroll
                            for (int e = 0; e < 4; ++e) { const float s = sigmoidf_(acc[ai][bj][m][n][e] + b[e]); o[e] = pn < 4 ? 1.f - __expf(-0.60653065971f * s) : s; }
                            store4bf(f2 + (size_t)row * 2048 + col, o);
                        }
                }
        } else {
#pragma unroll
            for (int ai = 0; ai < 2; ++ai)
#pragma unroll
                for (int m = 0; m < 4; ++m) { const int row = row0 + ai * 128 + m * 16;
#pragma unroll
                    for (int bj = 0; bj < 2; ++bj)
#pragma unroll
                        for (int n = 0; n < 2; ++n) store4bf(grw + (size_t)row * 512 + (col0 + bj * 128 + n * 16 - 2048), acc[ai][bj][m][n]); }
        }
    } };
struct FGate { bf16_t* g;
    __device__ __forceinline__ void operator()(int row, int col, f32x4 v) const {
        f32x4 o; o[0] = sigmoidf_(v[0]); o[1] = sigmoidf_(v[1]); o[2] = sigmoidf_(v[2]); o[3] = sigmoidf_(v[3]);
        store4bf(g + (size_t)row * 3072 + col, o);
    } };
template <int J> struct FMerge { const bf16_t* g; float* y32; bf16_t* ybf;
    __device__ __forceinline__ void operator()(int row, int col, f32x4 v) const {
        const u32x2 z = *(const u32x2*)(g + (size_t)row * 3072 + J * 1024 + col);
        f32x4 o; o[0] = bflo(z.x) * v[0]; o[1] = bfhi(z.x) * v[1]; o[2] = bflo(z.y) * v[2]; o[3] = bfhi(z.y) * v[3];
        float* yp = y32 + (size_t)row * 1024 + col;
        if (J == 0) *(f32x4*)yp = o;
        else if (J == 1) { f32x4 t = *(f32x4*)yp; *(f32x4*)yp = t + o; }
        else { f32x4 t = *(f32x4*)yp; store4bf(ybf + (size_t)row * 1024 + col, t + o); }
    } };
struct FResid { float* x; const float* modl; int chunk;
    __device__ __forceinline__ void operator()(int row, int col, f32x4 v) const {
        const f32x4 mg = *(const f32x4*)(modl + row_vec(row) * 6144 + chunk * 1024 + col);
        float* xp = x + (size_t)row * 1024 + col; f32x4 t = *(f32x4*)xp; *(f32x4*)xp = t + mg * v;
    } };
struct FMlp1 { bf16_t* hid;
    __device__ __forceinline__ void operator()(int row, int col, f32x4 v) const {
        f32x4 o;
#pragma unroll
        for (int e = 0; e < 4; ++e) { const float r = fmaxf(v[e], 0.f); o[e] = r * r; }
        store4bf(hid + (size_t)row * 4096 + col, o);
    } };

__device__ __forceinline__ void phase_mod(float* smf) {
    CParams& p = KPL(); const Ctx cx = mkctx();
    const int tid = cx.tid, lane = tid & 63, wid = tid >> 6;
    float* sc = smf; float* red = smf + 3072;
    float* MOD = (float*)(p.ws + OFF_MOD);
    for (int i = tid; i < 3072; i += 512) { const int v = i >> 10, j = i & 1023; const float c = v < 2 ? p.in[1][v * 1024 + j] : p.in[3][j]; sc[i] = c / (1.f + expf(-c)); }
    __syncthreads();
    for (int item = cx.bid; item < 4 * 96; item += cx.nb) {
        const int l = item / 96, jt = item % 96, j = jt * 64 + lane;
        const float* w = p.in[4] + (size_t)l * 1024 * 6144 + j;
        float a0 = 0.f, a1 = 0.f, a2 = 0.f;
#pragma unroll 16
        for (int i = wid * 128; i < wid * 128 + 128; ++i) { const float wv = w[(size_t)i * 6144]; a0 += sc[i] * wv; a1 += sc[1024 + i] * wv; a2 += sc[2048 + i] * wv; }
        red[(wid * 3 + 0) * 64 + lane] = a0; red[(wid * 3 + 1) * 64 + lane] = a1; red[(wid * 3 + 2) * 64 + lane] = a2;
        __syncthreads();
        if (tid < 192) { const int v = tid >> 6; float s = 0.f;
            for (int w8 = 0; w8 < 8; ++w8) s += red[(w8 * 3 + v) * 64 + lane];
            MOD[(l * 3 + v) * 6144 + j] = s + p.in[5][l * 6144 + j]; }
        __syncthreads();
    }
}

__device__ __forceinline__ void dsincos(double x, double& s, double& c) {
    const double k = rint(x * 0.63661977236758134308);
    double r = fma(-k, 1.57079632679489655800, x); r = fma(-k, 6.12323399573676603587e-17, r);
    const double r2 = r * r;
    double ps = -1.0 / 355687428096000.0;
    ps = fma(ps, r2, 1.0 / 1307674368000.0); ps = fma(ps, r2, -1.0 / 6227020800.0); ps = fma(ps, r2, 1.0 / 39916800.0); ps = fma(ps, r2, -1.0 / 362880.0);
    ps = fma(ps, r2, 1.0 / 5040.0); ps = fma(ps, r2, -1.0 / 120.0); ps = fma(ps, r2, 1.0 / 6.0); ps = fma(ps, r2, -1.0); ps = -ps * r;
    double pc = 1.0 / 20922789888000.0;
    pc = fma(pc, r2, -1.0 / 87178291200.0); pc = fma(pc, r2, 1.0 / 479001600.0); pc = fma(pc, r2, -1.0 / 3628800.0); pc = fma(pc, r2, 1.0 / 40320.0);
    pc = fma(pc, r2, -1.0 / 720.0); pc = fma(pc, r2, 1.0 / 24.0); pc = fma(pc, r2, -0.5); pc = fma(pc, r2, 1.0);
    const int q = ((int)k) & 3;
    s = (q == 0) ? ps : (q == 1) ? pc : (q == 2) ? -ps : -pc;
    c = (q == 0) ? pc : (q == 1) ? -ps : (q == 2) ? -pc : ps;
}
__device__ __forceinline__ double dexp_neg(double x) {
    const double k = rint(x * 1.44269504088896338700);
    double r = fma(-k, 0.693147180369123816490, x); r = fma(-k, 1.90821492927058770002e-10, r);
    double pe = 1.0 / 6227020800.0;
    pe = fma(pe, r, 1.0 / 479001600.0); pe = fma(pe, r, 1.0 / 39916800.0); pe = fma(pe, r, 1.0 / 3628800.0); pe = fma(pe, r, 1.0 / 362880.0); pe = fma(pe, r, 1.0 / 40320.0);
    pe = fma(pe, r, 1.0 / 5040.0); pe = fma(pe, r, 1.0 / 720.0); pe = fma(pe, r, 1.0 / 120.0); pe = fma(pe, r, 1.0 / 24.0); pe = fma(pe, r, 1.0 / 6.0); pe = fma(pe, r, 0.5);
    pe = fma(pe, r, 1.0); pe = fma(pe, r, 1.0);
    int ki = (int)k; if (ki < -1000) return 0.0;
    return pe * __longlong_as_double((long long)(1023 + ki) << 52);
}

__device__ __forceinline__ void wconv_tile(const Ctx& cx, const float* src, int ld, int K, int c0, int ncols, bf16_t* dst, int kt, int nt, float* tile) {
    const int tid = cx.tid, j = tid & 63, i0 = tid >> 6;
#pragma unroll
    for (int e = 0; e < 8; ++e) { const int i = i0 + 8 * e; const int n = nt * 64 + j;
        tile[i * 65 + j] = (n < ncols) ? src[(size_t)(kt * 64 + i) * ld + c0 + n] : 0.f; }
    __syncthreads();
#pragma unroll
    for (int e = 0; e < 8; ++e) { const int jj = i0 + 8 * e;
        dst[(size_t)(nt * 64 + jj) * K + kt * 64 + j] = f2bf(tile[j * 65 + jj]); }
    __syncthreads();
}

template <int MODE>
__device__ __forceinline__ void phase_wconv(int l, float* smf) {
    CParams& p = KPL(); const Ctx cx = mkctx();
    bf16_t* W = (bf16_t*)(p.ws + OFF_W);
    const int tid = cx.tid;
    unsigned* ticket = (unsigned*)(p.ws + OFF_BAR) + 3520 + l * 16;
    int* tslot = (int*)smf + 8192;
    for (int it = (MODE == 2 ? 0 : cx.bid); ; it += cx.nb) {
        int item;
        if (MODE == 0) { item = it; if (item >= 5184) break; }
        else if (MODE == 1) { item = 3520 + it; if (item >= 4544) break; }
        else {
            if (tid == 0) *tslot = (int)__hip_atomic_fetch_add(ticket, 1u, __ATOMIC_RELAXED, __HIP_MEMORY_SCOPE_AGENT);
            __syncthreads();
            const int q = *tslot;
            __syncthreads();
            if (q >= 4160) break;
            item = q < 3520 ? q : q + 1024;
        }
        if (item < 4544) {
            const float* src; int ld, K, c0, ncols, nN; bf16_t* dst; int t = item;
            if (t < 1024) { src = p.in[8] + (size_t)l * 1024 * 6928; ld = 6928; K = 1024; c0 = 0; ncols = 3856; nN = 64; dst = W + W_MIX / 2; }
            else if (t < 1792) { t -= 1024; src = p.in[8] + (size_t)l * 1024 * 6928; ld = 6928; K = 1024; c0 = 3856; ncols = 3072; nN = 48; dst = W + W_GATE / 2; }
            else if (t < 1856) { t -= 1792; src = p.in[17] + (size_t)l * 512 * 512; ld = 512; K = 512; c0 = 0; ncols = 512; nN = 8; dst = W + W_GLU / 2; }
            else if (t < 1984) { t -= 1856; src = p.in[35] + (size_t)l * 512 * 1024; ld = 1024; K = 512; c0 = 0; ncols = 1024; nN = 16; dst = W + W_PA / 2; }
            else if (t < 2112) { t -= 1984; src = p.in[36] + (size_t)l * 512 * 1024; ld = 1024; K = 512; c0 = 0; ncols = 1024; nN = 16; dst = W + W_PB / 2; }
            else if (t < 2240) { t -= 2112; src = p.in[37] + (size_t)l * 512 * 1024; ld = 1024; K = 512; c0 = 0; ncols = 1024; nN = 16; dst = W + W_PC / 2; }
            else if (t < 2496) { t -= 2240; src = p.in[38] + (size_t)l * 1024 * 1024; ld = 1024; K = 1024; c0 = 0; ncols = 1024; nN = 16; dst = W + W_OUT / 2; }
            else if (t < 3520) { t -= 2496; src = p.in[39] + (size_t)l * 1024 * 4096; ld = 4096; K = 1024; c0 = 0; ncols = 4096; nN = 64; dst = W + W_1 / 2; }
            else { t -= 3520; src = p.in[40] + (size_t)l * 4096 * 1024; ld = 1024; K = 4096; c0 = 0; ncols = 1024; nN = 16; dst = W + W_2 / 2; }
            const int nt = t % nN, kt = t / nN;
            wconv_tile(cx, src, ld, K, c0, ncols, dst, kt, nt, smf);
        } else {
            bf16_t* dst = W + W_LORA / 2;
#pragma unroll
            for (int q = 0; q < 2; ++q) {
                const int e = (item - 4544) * 1024 + q * 512 + tid; const int n = e >> 8, k = e & 255;
                float v = 0.f;
                if (n < 1024) { if (k < 64) v = p.in[26][(((size_t)l * 2 + (n >> 9)) * 64 + k) * 512 + (n & 511)]; }
                else if (n < 2048) { if (k >= 64 && k < 128) v = p.in[28][(((size_t)l * 2 + ((n - 1024) >> 9)) * 64 + (k - 64)) * 512 + (n & 511)]; }
                else { if (k >= 128) v = p.in[29][((size_t)l * 128 + (k - 128)) * 512 + (n - 2048)]; }
                dst[e] = f2bf(v);
            }
        }
    }
}

__device__ __forceinline__ void phase_s5_params() {
    CParams& p = KPL(); const Ctx cx = mkctx();
    for (int item = cx.bid; item < 32; item += cx.nb) {
        const int l = item >> 3;
        const int idx = (item & 7) * 512 + cx.tid;
        const int dir = idx >> 11, g = (idx >> 6) & 31;
        float* S5P = (float*)(p.ws + OFF_S5P) + (size_t)l * 147456;
        const size_t pi = (size_t)l * 4096 + idx;
        const double lre = fmin((double)p.in[9][pi], -1e-4), lim = (double)p.in[10][pi];
        const double dt = dexp_neg((double)p.in[11][(l * 2 + dir) * 32 + g]);
        const double mag = dexp_neg(lre * dt); double sn, cs; dsincos(lim * dt, sn, cs);
        const double ar = mag * cs, ai = mag * sn;
        const double den = lre * lre + lim * lim, nr = ar - 1.0;
        const double cr = (nr * lre + ai * lim) / den, ci = (ai * lre - nr * lim) / den;
        const double mag64 = dexp_neg(64.0 * lre * dt); dsincos(64.0 * lim * dt, sn, cs);
        S5P[idx] = (float)ar; S5P[4096 + idx] = (float)ai; S5P[8192 + idx] = (float)(mag64 * cs); S5P[12288 + idx] = (float)(mag64 * sn);
        float* BR = S5P + 16384; float* BI = BR + 65536;
        for (int c = 0; c < 16; ++c) { const double bre = p.in[12][pi * 16 + c], bim = p.in[13][pi * 16 + c];
            BR[(size_t)idx * 16 + c] = (float)(cr * bre - ci * bim); BI[(size_t)idx * 16 + c] = (float)(cr * bim + ci * bre); }
    }
}

__device__ __forceinline__ void phase_norm(int l, int which, bool init) {
    CParams& p = KPL(); const Ctx cx = mkctx();
    const int lane = cx.tid & 63, gw = cx.bid * 8 + (cx.tid >> 6), nw = cx.nb * 8;
    float* X = (float*)(p.ws + OFF_X); bf16_t* H = (bf16_t*)(p.ws + OFF_H);
    const float* MODL = (const float*)(p.ws + OFF_MOD) + (size_t)l * 3 * 6144;
    const float* gam = p.in[which ? 7 : 6] + l * 1024;
    for (int row = gw; row < T_TOK; row += nw) {
        const int b = row >= SEQA ? 1 : 0, t = row - b * SEQA;
        const float* src = init ? (t < NCTX ? p.in[2] + ((size_t)b * NCTX + t) * 1024 : p.in[0] + ((size_t)b * 8192 + (t - NCTX)) * 1024) : X + (size_t)row * 1024;
        f32x4 v[4]; float ss = 0.f;
#pragma unroll
        for (int i = 0; i < 4; ++i) { v[i] = *(const f32x4*)(src + (lane + 64 * i) * 4); ss += v[i][0] * v[i][0] + v[i][1] * v[i][1] + v[i][2] * v[i][2] + v[i][3] * v[i][3]; }
        if (init) {
#pragma unroll
            for (int i = 0; i < 4; ++i) *(f32x4*)(X + (size_t)row * 1024 + (lane + 64 * i) * 4) = v[i];
        }
        ss = wave_sum(ss);
        const float inv = rsqrtf(ss * (1.f / 1024.f) + 1e-6f);
        const float* mv = MODL + (t < NCTX ? 2 : b) * 6144 + (which ? 3 : 0) * 1024;
#pragma unroll
        for (int i = 0; i < 4; ++i) { const int c = (lane + 64 * i) * 4;
            const f32x4 g4 = *(const f32x4*)(gam + c), sh = *(const f32x4*)(mv + c), scl = *(const f32x4*)(mv + 1024 + c);
            f32x4 o;
#pragma unroll
            for (int e = 0; e < 4; ++e) o[e] = v[i][e] * inv * g4[e] * (1.f + scl[e]) + sh[e];
            store4bf(H + (size_t)row * 1024 + c, o); }
    }
}

__device__ __forceinline__ int s5_order(int dir, int i) { return dir == 0 ? i : (i < 4 ? 3 - i : 135 - i); }

__device__ __forceinline__ void phase_s5_local(int l) {
    CParams& p = KPL(); const Ctx cx = mkctx();
    const int lane = cx.tid & 63, gw = cx.bid * 8 + (cx.tid >> 6), nw = cx.nb * 8;
    const bf16_t* ZA = (const bf16_t*)(p.ws + OFF_Z);
    const float* S5P = (const float*)(p.ws + OFF_S5P) + (size_t)l * 147456; const float* BR = S5P + 16384; const float* BI = BR + 65536;
    float* ST = (float*)(p.ws + OFF_S5ST);
    for (int item0 = gw; item0 < 16896; item0 += nw) {
        const int item = __builtin_amdgcn_readfirstlane(item0);
        const int chunk = item % 132, g = (item / 132) & 31, dir = (item / 4224) & 1, b = item / 8448;
        const int idx = dir * 2048 + g * 64 + lane;
        const float ar = S5P[idx], ai = S5P[4096 + idx];
        float br[16], bi[16];
#pragma unroll
        for (int q = 0; q < 4; ++q) { const f32x4 t0 = *(const f32x4*)(BR + (size_t)idx * 16 + q * 4), t1 = *(const f32x4*)(BI + (size_t)idx * 16 + q * 4);
#pragma unroll
            for (int e = 0; e < 4; ++e) { br[q * 4 + e] = t0[e]; bi[q * 4 + e] = t1[e]; } }
        const int row = b * SEQA + chunk * 64 + lane;
        const u32x4 u0 = *(const u32x4*)(ZA + (size_t)row * 2048 + g * 16), u1 = *(const u32x4*)(ZA + (size_t)row * 2048 + g * 16 + 8);
        unsigned ur[8] = {u0.x, u0.y, u0.z, u0.w, u1.x, u1.y, u1.z, u1.w};
        float hr = 0.f, hi = 0.f;
#pragma unroll 8
        for (int j = 0; j < 64; ++j) {
            const int tok = dir ? 63 - j : j;
            float bur = 0.f, bui = 0.f;
#pragma unroll
            for (int q = 0; q < 8; ++q) { const unsigned w = (unsigned)__builtin_amdgcn_readlane((int)ur[q], tok); const float x0 = bflo(w), x1 = bfhi(w);
                bur += br[2 * q] * x0 + br[2 * q + 1] * x1; bui += bi[2 * q] * x0 + bi[2 * q + 1] * x1; }
            const float nr = ar * hr - ai * hi + bur, ni = ar * hi + ai * hr + bui; hr = nr; hi = ni;
        }
        float* st = ST + ((((size_t)b * 2 + dir) * 32 + g) * 132 + chunk) * 128;
        st[lane] = hr; st[64 + lane] = hi;
    }
}

__device__ __forceinline__ void phase_s5_carry(int l) {
    CParams& p = KPL(); const Ctx cx = mkctx();
    const int lane = cx.tid & 63, gw = cx.bid * 8 + (cx.tid >> 6), nw = cx.nb * 8;
    const float* S5P = (const float*)(p.ws + OFF_S5P) + (size_t)l * 147456;
    float* ST = (float*)(p.ws + OFF_S5ST);
    for (int item0 = gw; item0 < 128; item0 += nw) {
        const int item = __builtin_amdgcn_readfirstlane(item0);
        const int g = item & 31, dir = (item >> 5) & 1, b = item >> 6;
        const int idx = dir * 2048 + g * 64 + lane;
        const float ar = S5P[8192 + idx], ai = S5P[12288 + idx];
        float* st = ST + (((size_t)b * 2 + dir) * 32 + g) * 132 * 128;
        float hr = 0.f, hi = 0.f;
        for (int i0 = 0; i0 < 132; i0 += 12) {
            float lr[12], li[12];
#pragma unroll
            for (int e = 0; e < 12; ++e) { const int c = s5_order(dir, i0 + e); lr[e] = st[c * 128 + lane]; li[e] = st[c * 128 + 64 + lane]; }
#pragma unroll
            for (int e = 0; e < 12; ++e) { const int c = s5_order(dir, i0 + e); st[c * 128 + lane] = hr; st[c * 128 + 64 + lane] = hi;
                const float nr = ar * hr - ai * hi + lr[e], ni = ar * hi + ai * hr + li[e]; hr = nr; hi = ni; }
        }
    }
}

template <int DIR>
__device__ __forceinline__ void s5_final_dir(CParams& p, int l, int b, int g, int chunk, int lane, const unsigned (&ur)[8], float* hst, f32x4* ybuf, int row0, float dsk, bf16_t* ZG) {
    const float* S5P = (const float*)(p.ws + OFF_S5P) + (size_t)l * 147456; const float* BR = S5P + 16384; const float* BI = BR + 65536;
    const float* ST = (const float*)(p.ws + OFF_S5ST);
    const bf16_t* ZA = (const bf16_t*)(p.ws + OFF_Z);
    const int idx = DIR * 2048 + g * 64 + lane;
    const float ar = S5P[idx], ai = S5P[4096 + idx];
    float br[16], bi[16];
#pragma unroll
    for (int q = 0; q < 4; ++q) { const f32x4 t0 = *(const f32x4*)(BR + (size_t)idx * 16 + q * 4), t1 = *(const f32x4*)(BI + (size_t)idx * 16 + q * 4);
#pragma unroll
        for (int e = 0; e < 4; ++e) { br[q * 4 + e] = t0[e]; bi[q * 4 + e] = t1[e]; } }
    float cbr[16], cbi[16];
    { const size_t cb = ((((size_t)l * 2 + DIR) * 32 + g) * 16 + (lane & 15)) * 64 + (lane >> 4);
#pragma unroll
      for (int i = 0; i < 16; ++i) { cbr[i] = p.in[14][cb + 4 * i]; cbi[i] = -p.in[15][cb + 4 * i]; } }
    const float* st = ST + ((((size_t)b * 2 + DIR) * 32 + g) * 132 + chunk) * 128;
    float hr = st[lane], hi = st[64 + lane];
    const int ch = g * 16 + (lane & 15);
#pragma unroll 1
    for (int si = 0; si < 4; ++si) {
        const int sc = DIR ? 3 - si : si;
#pragma unroll
        for (int jj = 0; jj < 16; ++jj) {
            const int tt = DIR ? 15 - jj : jj; const int tok = sc * 16 + tt;
            float bur = 0.f, bui = 0.f;
#pragma unroll
            for (int q = 0; q < 8; ++q) { const unsigned w = (unsigned)__builtin_amdgcn_readlane((int)ur[q], tok); const float x0 = bflo(w), x1 = bfhi(w);
                bur += br[2 * q] * x0 + br[2 * q + 1] * x1; bui += bi[2 * q] * x0 + bi[2 * q + 1] * x1; }
            const float nr = ar * hr - ai * hi + bur, ni = ar * hi + ai * hr + bui; hr = nr; hi = ni;
            hst[tt * 68 + lane] = hr; hst[1088 + tt * 68 + lane] = hi;
        }
        f32x4 a = (f32x4){0.f, 0.f, 0.f, 0.f};
        if (DIR) a = ybuf[sc * 64 + lane];
#pragma unroll
        for (int i = 0; i < 16; ++i) {
            const float xr = hst[(lane & 15) * 68 + 4 * i + (lane >> 4)], xi = hst[1088 + (lane & 15) * 68 + 4 * i + (lane >> 4)];
            a = __builtin_amdgcn_mfma_f32_16x16x4f32(xr, cbr[i], a, 0, 0, 0);
            a = __builtin_amdgcn_mfma_f32_16x16x4f32(xi, cbi[i], a, 0, 0, 0);
        }
        if (!DIR) ybuf[sc * 64 + lane] = a;
        else {
#pragma unroll
            for (int j = 0; j < 4; ++j) {
                const int row = row0 + sc * 16 + (lane >> 4) * 4 + j;
                const float u = bf2f(ZA[(size_t)row * 2048 + ch]);
                const float y = u * dsk + a[j];
                const float z = 0.5f * y * (1.f + tanhf(0.7978845608028654f * (y + 0.044715f * y * y * y)));
                ZG[(size_t)row * 512 + ch] = f2bf(z);
            }
        }
    }
}

__device__ __forceinline__ void phase_s5_final(int l, float* smf) {
    CParams& p = KPL(); const Ctx cx = mkctx();
    const int lane = cx.tid & 63, wid = cx.tid >> 6, gw = cx.bid * 8 + wid, nw = cx.nb * 8;
    const bf16_t* ZA = (const bf16_t*)(p.ws + OFF_Z);
    bf16_t* ZG = (bf16_t*)(p.ws + OFF_ZG);
    float* hst = smf + wid * 3200;
    f32x4* ybuf = (f32x4*)(hst + 2176);
    for (int item0 = gw; item0 < 8448; item0 += nw) {
        const int item = __builtin_amdgcn_readfirstlane(item0);
        const int chunk = item % 132, g = (item / 132) & 31, b = item / 4224;
        const int row0 = b * SEQA + chunk * 64;
        const u32x4 u0 = *(const u32x4*)(ZA + (size_t)(row0 + lane) * 2048 + g * 16), u1 = *(const u32x4*)(ZA + (size_t)(row0 + lane) * 2048 + g * 16 + 8);
        const unsigned ur[8] = {u0.x, u0.y, u0.z, u0.w, u1.x, u1.y, u1.z, u1.w};
        const float dsk = p.in[16][l * 512 + g * 16 + (lane & 15)];
        s5_final_dir<0>(p, l, b, g, chunk, lane, ur, hst, ybuf, row0, dsk, ZG);
        s5_final_dir<1>(p, l, b, g, chunk, lane, ur, hst, ybuf, row0, dsk, ZG);
    }
}

__device__ __forceinline__ int ml_row0(int b, int nc) { return b * SEQA + nc * 128; }
__device__ __forceinline__ int ml_order(int dir, int i) { return dir == 0 ? i : (i < 2 ? 1 - i : 67 - i); }

__device__ __forceinline__ void phase_ml_conv(int l) {
    CParams& p = KPL(); const Ctx cx = mkctx();
    const bf16_t* ZA = (const bf16_t*)(p.ws + OFF_Z);
    bf16_t* QKC = (bf16_t*)(p.ws + OFF_QKC);
    const float* cw = p.in[19] + (size_t)l * 9 * 512; const float* cb = p.in[20] + l * 512;
    for (int idx = cx.bid * 512 + cx.tid; idx < T_TOK * 64; idx += cx.nb * 512) {
        const int row = idx >> 6, c8 = (idx & 63) * 8;
        const int b = row >= SEQA ? 1 : 0, t = row - b * SEQA;
        const bool isctx = t < NCTX;
        const int tt = isctx ? t : t - NCTX, W = isctx ? 256 : 64, Hh = isctx ? 1 : 128;
        const int y = tt / W, x = tt % W;
        const int segrow0 = row - tt;
        float acc[8];
#pragma unroll
        for (int e = 0; e < 8; ++e) acc[e] = cb[c8 + e];
#pragma unroll
        for (int dy = 0; dy < 3; ++dy)
#pragma unroll
            for (int dx = 0; dx < 3; ++dx) {
                const int yy = y + dy - 1, xx = x + dx - 1;
                if (yy >= 0 && yy < Hh && xx >= 0 && xx < W) {
                    const u32x4 z = *(const u32x4*)(ZA + (size_t)(segrow0 + yy * W + xx) * 2048 + 512 + c8);
                    const float* w = cw + (dy * 3 + dx) * 512 + c8;
                    const f32x4 w0 = *(const f32x4*)w, w1 = *(const f32x4*)(w + 4);
                    acc[0] += bflo(z.x) * w0[0]; acc[1] += bfhi(z.x) * w0[1]; acc[2] += bflo(z.y) * w0[2]; acc[3] += bfhi(z.y) * w0[3];
                    acc[4] += bflo(z.z) * w1[0]; acc[5] += bfhi(z.z) * w1[1]; acc[6] += bflo(z.w) * w1[2]; acc[7] += bfhi(z.w) * w1[3];
                }
            }
        u32x4 o;
#pragma unroll
        for (int e = 0; e < 8; ++e) acc[e] = acc[e] * sigmoidf_(acc[e]);
        o.x = pk2(acc[0], acc[1]); o.y = pk2(acc[2], acc[3]); o.z = pk2(acc[4], acc[5]); o.w = pk2(acc[6], acc[7]);
        *(u32x4*)(QKC + (size_t)row * 512 + c8) = o;
    }
}

constexpr int ML_QS = 0, ML_KS = 18432, ML_VT = 36864, ML_CS = 71680, ML_PS = 92416, ML_GV = 127232, ML_BV = 127744, ML_MV = 128256, ML_LF = 128768, ML_IG = 129280, ML_SC = 129792;

__device__ __forceinline__ void ml_gate_vectors(const Ctx& cx, CParams& p, int l, int dir, int b, int h, int nc, unsigned char* sm, float m_in) {
    const int tid = cx.tid, lane = tid & 63;
    float* lf = (float*)(sm + ML_LF); float* ig = (float*)(sm + ML_IG); float* gv = (float*)(sm + ML_GV); float* bv = (float*)(sm + ML_BV); float* mv = (float*)(sm + ML_MV); float* sc = (float*)(sm + ML_SC);
    const float* MLG = (const float*)(p.ws + OFF_MLG);
    const float* gb = p.in[21] + l * 16;
    if (tid < 128) {
        const int row = ml_row0(b, nc) + tid;
        const float ip = MLG[(size_t)row * 16 + dir * 4 + h] + gb[dir * 4 + h];
        const float fp = MLG[(size_t)row * 16 + 8 + dir * 4 + h] + gb[8 + dir * 4 + h];
        ig[tid] = ip; lf[tid] = fminf(fp, 0.f) - log1pf(expf(-fabsf(fp)));
    }
    __syncthreads();
    if (tid < 64) {
        const int pp0 = 2 * lane, pp1 = 2 * lane + 1; const int s0 = dir ? 127 - pp0 : pp0, s1 = dir ? 127 - pp1 : pp1;
        const float x0 = lf[s0], x1 = lf[s1];
        float incl = x0 + x1;
#pragma unroll
        for (int d = 1; d < 64; d <<= 1) { const float t = __shfl_up(incl, d); if (lane >= d) incl += t; }
        const float g1 = incl, g0 = incl - x1;
        const float gtot = __shfl(incl, 63);
        const float b0 = ig[s0] - g0, b1 = ig[s1] - g1;
        float mx = fmaxf(b0, b1);
#pragma unroll
        for (int d = 1; d < 64; d <<= 1) { const float t = __shfl_up(mx, d); if (lane >= d) mx = fmaxf(mx, t); }
        const float prev = __shfl_up(mx, 1);
        const float pm0 = lane > 0 ? fmaxf(prev, b0) : b0, pm1 = mx;
        const float bmax = __shfl(mx, 63);
        gv[s0] = g0; gv[s1] = g1; bv[s0] = b0; bv[s1] = b1; mv[s0] = fmaxf(m_in, pm0); mv[s1] = fmaxf(m_in, pm1);
        if (lane == 0) { sc[0] = gtot; sc[1] = bmax; }
    }
    __syncthreads();
}

__device__ __forceinline__ void phase_ml_local(int l, unsigned char* sm) {
    CParams& p = KPL(); const Ctx cx = mkctx();
    const int tid = cx.tid, lane = tid & 63, wid = tid >> 6;
    const bf16_t* ZA = (const bf16_t*)(p.ws + OFF_Z); const bf16_t* QKC = (const bf16_t*)(p.ws + OFF_QKC);
    float* CLOC = (float*)(p.ws + OFF_CLOC); float* MLS = (float*)(p.ws + OFF_MLS);
    bf16_t* VT = (bf16_t*)(sm + ML_VT); bf16_t* KT = (bf16_t*)(sm + ML_KS);
    const float* bv = (const float*)(sm + ML_BV); const float* sc = (const float*)(sm + ML_SC);
    float* wg = (float*)(sm + ML_LF);
    unsigned* ticket = (unsigned*)(p.ws + OFF_BAR) + 3600 + l * 16;
    int* tslot = (int*)(sm + 143328);
    for (;;) {
        if (tid == 0) *tslot = (int)__hip_atomic_fetch_add(ticket, 1u, __ATOMIC_RELAXED, __HIP_MEMORY_SCOPE_AGENT);
        __syncthreads();
        const int item = *tslot;
        __syncthreads();
        if (item >= 1056) break;
        const int chain = item / 66, nc = item % 66; const int dir = chain >> 3, b = (chain >> 2) & 1, h = chain & 3;
        ml_gate_vectors(cx, p, l, dir, b, h, nc, sm, -1e30f);
        const float gtot = sc[0], bmax = sc[1];
        __syncthreads();
        if (tid < 128) wg[tid] = expf(bv[tid] - bmax);
        __syncthreads();
        const int row0 = ml_row0(b, nc);
#pragma unroll
        for (int q = 0; q < 4; ++q) { const int ci = q * 512 + tid; const int s = ci >> 4, v8 = (ci & 15) * 8;
            const u32x4 z = *(const u32x4*)(ZA + (size_t)(row0 + s) * 2048 + 1024 + h * 128 + v8); const float w = wg[s];
            const unsigned zz[4] = {z.x, z.y, z.z, z.w};
#pragma unroll
            for (int e = 0; e < 4; ++e) { VT[(v8 + 2 * e) * 136 + s] = f2bf(bflo(zz[e]) * w); VT[(v8 + 2 * e + 1) * 136 + s] = f2bf(bfhi(zz[e]) * w); } }
#pragma unroll
        for (int q = 0; q < 2; ++q) { const int ci = q * 512 + tid; const int s = ci >> 3, k8 = (ci & 7) * 8;
            const u32x4 z = *(const u32x4*)(QKC + (size_t)(row0 + s) * 512 + 256 + h * 64 + k8);
            const unsigned zz[4] = {z.x, z.y, z.z, z.w};
#pragma unroll
            for (int e = 0; e < 4; ++e) { KT[(k8 + 2 * e) * 136 + s] = (bf16_t)(zz[e] & 0xffff); KT[(k8 + 2 * e + 1) * 136 + s] = (bf16_t)(zz[e] >> 16); } }
        __syncthreads();
        float* dst = CLOC + ((size_t)chain * 66 + nc) * 8256;
        f32x4 acc[4];
#pragma unroll
        for (int n = 0; n < 4; ++n) acc[n] = (f32x4){0.f, 0.f, 0.f, 0.f};
#pragma unroll
        for (int ks = 0; ks < 4; ++ks) {
            const bf16x8 a = *(const bf16x8*)(VT + (16 * wid + (lane & 15)) * 136 + ks * 32 + (lane >> 4) * 8);
#pragma unroll
            for (int n = 0; n < 4; ++n) { const bf16x8 bb = *(const bf16x8*)(KT + (16 * n + (lane & 15)) * 136 + ks * 32 + (lane >> 4) * 8);
                acc[n] = __builtin_amdgcn_mfma_f32_16x16x32_bf16(a, bb, acc[n], 0, 0, 0); }
        }
#pragma unroll
        for (int n = 0; n < 4; ++n)
#pragma unroll
            for (int j = 0; j < 4; ++j) dst[(16 * wid + (lane >> 4) * 4 + j) * 64 + 16 * n + (lane & 15)] = acc[n][j];
        if (tid < 64) { float s0 = 0.f, s1 = 0.f, s2 = 0.f, s3 = 0.f;
#pragma unroll 4
            for (int t = 0; t < 128; t += 4) { const u32x2 kq = *(const u32x2*)(KT + tid * 136 + t); const f32x4 w4 = *(const f32x4*)(wg + t);
                s0 += w4[0] * bflo(kq.x); s1 += w4[1] * bfhi(kq.x); s2 += w4[2] * bflo(kq.y); s3 += w4[3] * bfhi(kq.y); }
            dst[8192 + tid] = (s0 + s1) + (s2 + s3); }
        if (tid == 0) { MLS[chain * 66 + nc] = gtot; MLS[1056 + chain * 66 + nc] = gtot + bmax; }
        __syncthreads();
    }
}

__device__ __forceinline__ void phase_ml_carry() {
    CParams& p = KPL(); const Ctx cx = mkctx();
    float* CLOC = (float*)(p.ws + OFF_CLOC); float* MLS = (float*)(p.ws + OFF_MLS);
    for (int idx = cx.bid * 512 + cx.tid; idx < 16 * 8192; idx += cx.nb * 512) {
        const int chain = idx >> 13, e = idx & 8191; const int dir = chain >> 3;
        const bool two = e < 64;
        float* base = CLOC + (size_t)chain * 66 * 8256 + e;
        const float* gtp = MLS + chain * 66; const float* amp = MLS + 1056 + chain * 66;
        float m = -1e30f, C = 0.f, N = 0.f;
        for (int i0 = 0; i0 < 66; i0 += 11) {
            float cl[11], nl[11], gt[11], am[11];
#pragma unroll
            for (int q = 0; q < 11; ++q) { const int nc = ml_order(dir, i0 + q); cl[q] = base[(size_t)nc * 8256]; nl[q] = two ? base[(size_t)nc * 8256 + 8192] : 0.f; gt[q] = gtp[nc]; am[q] = amp[nc]; }
#pragma unroll
            for (int q = 0; q < 11; ++q) { const int nc = ml_order(dir, i0 + q);
                base[(size_t)nc * 8256] = C;
                if (two) base[(size_t)nc * 8256 + 8192] = N;
                if (e == 0) MLS[2112 + chain * 66 + nc] = m;
                const float mn = fmaxf(gt[q] + m, am[q]); const float so = __expf(gt[q] + m - mn), sl = __expf(am[q] - mn);
                C = so * C + sl * cl[q]; N = so * N + sl * nl[q]; m = mn; }
        }
    }
}

__device__ __forceinline__ void phase_ml_out(int l, unsigned char* sm) {
    CParams& p = KPL(); const Ctx cx = mkctx();
    const int tid = cx.tid, lane = tid & 63, wid = tid >> 6;
    const bf16_t* ZA = (const bf16_t*)(p.ws + OFF_Z); const bf16_t* QKC = (const bf16_t*)(p.ws + OFF_QKC);
    const float* CLOC = (const float*)(p.ws + OFF_CLOC); const float* MLS = (const float*)(p.ws + OFF_MLS);
    bf16_t* YB = (bf16_t*)(p.ws + OFF_YB);
    bf16_t* QS = (bf16_t*)(sm + ML_QS); bf16_t* KS = (bf16_t*)(sm + ML_KS); bf16_t* VT = (bf16_t*)(sm + ML_VT); bf16_t* CS = (bf16_t*)(sm + ML_CS); bf16_t* PS = (bf16_t*)(sm + ML_PS);
    const float* gv = (const float*)(sm + ML_GV); const float* bv = (const float*)(sm + ML_BV); const float* mv = (const float*)(sm + ML_MV);
    unsigned* ticket = (unsigned*)(p.ws + OFF_BAR) + 3608 + l * 16;
    int* tslot = (int*)(sm + 143328);
    for (;;) {
        if (tid == 0) *tslot = (int)__hip_atomic_fetch_add(ticket, 1u, __ATOMIC_RELAXED, __HIP_MEMORY_SCOPE_AGENT);
        __syncthreads();
        const int item = *tslot;
        __syncthreads();
        if (item >= 528) break;
        const int b = item / 264, h = (item / 66) & 3, nc = item % 66;
        const int row0 = ml_row0(b, nc);
        __syncthreads();
#pragma unroll
        for (int q = 0; q < 2; ++q) { const int ci = q * 512 + tid; const int s = ci >> 3, k8 = (ci & 7) * 8;
            const u32x4 zq = *(const u32x4*)(QKC + (size_t)(row0 + s) * 512 + h * 64 + k8);
            u32x4 o; o.x = pk2(bflo(zq.x) * 0.125f, bfhi(zq.x) * 0.125f); o.y = pk2(bflo(zq.y) * 0.125f, bfhi(zq.y) * 0.125f); o.z = pk2(bflo(zq.z) * 0.125f, bfhi(zq.z) * 0.125f); o.w = pk2(bflo(zq.w) * 0.125f, bfhi(zq.w) * 0.125f);
            *(u32x4*)(QS + s * 72 + k8) = o;
            *(u32x4*)(KS + s * 72 + k8) = *(const u32x4*)(QKC + (size_t)(row0 + s) * 512 + 256 + h * 64 + k8); }
#pragma unroll
        for (int q = 0; q < 4; ++q) { const int ci = q * 512 + tid; const int s = ci >> 4, v8 = (ci & 15) * 8;
            const u32x4 z = *(const u32x4*)(ZA + (size_t)(row0 + s) * 2048 + 1024 + h * 128 + v8);
            const unsigned zz[4] = {z.x, z.y, z.z, z.w};
#pragma unroll
            for (int e = 0; e < 4; ++e) { VT[(v8 + 2 * e) * 136 + s] = (bf16_t)(zz[e] & 0xffff); VT[(v8 + 2 * e + 1) * 136 + s] = (bf16_t)(zz[e] >> 16); } }
        f32x4 hsum[8];
#pragma unroll
        for (int v = 0; v < 8; ++v) hsum[v] = (f32x4){0.f, 0.f, 0.f, 0.f};
#pragma unroll 1
        for (int dir = 0; dir < 2; ++dir) {
            const int chain = dir * 8 + b * 4 + h;
            const float m_in = MLS[2112 + chain * 66 + nc];
            __syncthreads();
            ml_gate_vectors(cx, p, l, dir, b, h, nc, sm, m_in);
            const float* cin = CLOC + ((size_t)chain * 66 + nc) * 8256;
#pragma unroll
            for (int q = 0; q < 4; ++q) { const int ci = q * 512 + tid; const int v = ci >> 4, k4 = (ci & 15) * 4;
                const f32x4 c = *(const f32x4*)(cin + v * 64 + k4); store4bf(CS + v * 72 + k4, c); }
            if (tid < 16) { const f32x4 c = *(const f32x4*)(cin + 8192 + tid * 4); store4bf(CS + 128 * 72 + tid * 4, c); }
            else if (tid < 256) { const int r = 129 + (tid - 16) / 16, k4 = ((tid - 16) & 15) * 4; store4bf(CS + r * 72 + k4, (f32x4){0.f, 0.f, 0.f, 0.f}); }
            __syncthreads();
            const int tr = 16 * wid + (lane >> 4) * 4;
            float Mt[4], rs[4] = {0.f, 0.f, 0.f, 0.f};
#pragma unroll
            for (int j = 0; j < 4; ++j) Mt[j] = mv[tr + j];
            bf16x8 qa[2];
#pragma unroll
            for (int ks = 0; ks < 2; ++ks) qa[ks] = *(const bf16x8*)(QS + (16 * wid + (lane & 15)) * 72 + ks * 32 + (lane >> 4) * 8);
#pragma unroll
            for (int nt = 0; nt < 8; ++nt) {
                f32x4 s4 = (f32x4){0.f, 0.f, 0.f, 0.f};
#pragma unroll
                for (int ks = 0; ks < 2; ++ks) { const bf16x8 kb = *(const bf16x8*)(KS + (16 * nt + (lane & 15)) * 72 + ks * 32 + (lane >> 4) * 8);
                    s4 = __builtin_amdgcn_mfma_f32_16x16x32_bf16(qa[ks], kb, s4, 0, 0, 0); }
                const int s = 16 * nt + (lane & 15); const float bs = bv[s];
#pragma unroll
                for (int j = 0; j < 4; ++j) { const int t = tr + j; const bool valid = dir ? (s >= t) : (s <= t);
                    const float pv = valid ? s4[j] * __expf(bs - Mt[j]) : 0.f; rs[j] += pv; PS[t * 136 + s] = f2bf(pv); }
            }
#pragma unroll
            for (int j = 0; j < 4; ++j) rs[j] = row16_sum(rs[j]);
            __syncthreads();
            f32x4 qn = (f32x4){0.f, 0.f, 0.f, 0.f};
#pragma unroll
            for (int ks = 0; ks < 2; ++ks) { const bf16x8 cb = *(const bf16x8*)(CS + (128 + (lane & 15)) * 72 + ks * 32 + (lane >> 4) * 8);
                qn = __builtin_amdgcn_mfma_f32_16x16x32_bf16(qa[ks], cb, qn, 0, 0, 0); }
            float wi[4], dn[4];
#pragma unroll
            for (int j = 0; j < 4; ++j) { const float qnj = row16_sum(qn[j]); wi[j] = expf(m_in - Mt[j]);
                const float den = rs[j] + wi[j] * qnj; const float mt = gv[tr + j] + Mt[j]; dn[j] = 1.f / fmaxf(fabsf(den), expf(-mt)); }
            bf16x8 pa[4];
#pragma unroll
            for (int ks = 0; ks < 4; ++ks) pa[ks] = *(const bf16x8*)(PS + (16 * wid + (lane & 15)) * 136 + ks * 32 + (lane >> 4) * 8);
#pragma unroll
            for (int vt = 0; vt < 8; ++vt) {
                f32x4 a1 = (f32x4){0.f, 0.f, 0.f, 0.f}, a2 = (f32x4){0.f, 0.f, 0.f, 0.f};
#pragma unroll
                for (int ks = 0; ks < 4; ++ks) { const bf16x8 vb = *(const bf16x8*)(VT + (16 * vt + (lane & 15)) * 136 + ks * 32 + (lane >> 4) * 8);
                    a1 = __builtin_amdgcn_mfma_f32_16x16x32_bf16(pa[ks], vb, a1, 0, 0, 0); }
#pragma unroll
                for (int ks = 0; ks < 2; ++ks) { const bf16x8 cb = *(const bf16x8*)(CS + (16 * vt + (lane & 15)) * 72 + ks * 32 + (lane >> 4) * 8);
                    a2 = __builtin_amdgcn_mfma_f32_16x16x32_bf16(qa[ks], cb, a2, 0, 0, 0); }
#pragma unroll
                for (int j = 0; j < 4; ++j) hsum[vt][j] += (a1[j] + wi[j] * a2[j]) * dn[j];
            }
        }
        const int tr = 16 * wid + (lane >> 4) * 4;
        float rinv[4];
#pragma unroll
        for (int j = 0; j < 4; ++j) { float ss = 0.f;
#pragma unroll
            for (int vt = 0; vt < 8; ++vt) ss += hsum[vt][j] * hsum[vt][j];
            ss = row16_sum(ss); rinv[j] = rsqrtf(ss * (1.f / 128.f) + 1e-6f); }
#pragma unroll
        for (int vt = 0; vt < 8; ++vt) { const int ch = h * 128 + 16 * vt + (lane & 15); const float ng = p.in[22][l * 512 + ch];
#pragma unroll
            for (int j = 0; j < 4; ++j) { const int row = row0 + tr + j;
                const float o = bf2f(ZA[(size_t)row * 2048 + 1536 + ch]);
                YB[(size_t)row * 512 + ch] = f2bf(hsum[vt][j] * rinv[j] * ng * sigmoidf_(o)); } }
    }
}

__device__ __forceinline__ void phase_rw_feat(int l) {
    CParams& p = KPL(); const Ctx cx = mkctx();
    const int lane = cx.tid & 63, gw = cx.bid * 8 + (cx.tid >> 6), nw = cx.nb * 8;
    const bf16_t* ZRW = (const bf16_t*)(p.ws + OFF_ZRW);
    bf16_t* F1 = (bf16_t*)(p.ws + OFF_F1); bf16_t* LIN = (bf16_t*)(p.ws + OFF_LORAIN);
    const float* mup = p.in[23] + (size_t)l * 1792; const float* mun = p.in[24] + (size_t)l * 1792;
    const float* kk_w = p.in[30] + l * 512;
    for (int row = gw; row < T_TOK; row += nw) {
        const int b = row >= SEQA ? 1 : 0, t = row - b * SEQA;
        const bool hasp = !(t == 0 || t == NCTX), hasn = !(t == NCTX - 1 || t == SEQA - 1);
        const bf16_t* zc = ZRW + (size_t)row * 1792;
#pragma unroll
        for (int q = 0; q < 3; ++q) {
            const int col = q * 512 + lane * 8;
            const u32x4 c4 = *(const u32x4*)(zc + col);
            u32x4 p4 = (u32x4){0u, 0u, 0u, 0u}, n4 = (u32x4){0u, 0u, 0u, 0u};
            if (hasp) p4 = *(const u32x4*)(zc - 1792 + col);
            if (hasn) n4 = *(const u32x4*)(zc + 1792 + col);
            const unsigned cc[4] = {c4.x, c4.y, c4.z, c4.w}, pp[4] = {p4.x, p4.y, p4.z, p4.w}, nn[4] = {n4.x, n4.y, n4.z, n4.w};
            float zs[8];
#pragma unroll
            for (int e = 0; e < 8; ++e) { const float z = (e & 1) ? bfhi(cc[e >> 1]) : bflo(cc[e >> 1]); const float pv = (e & 1) ? bfhi(pp[e >> 1]) : bflo(pp[e >> 1]); const float nx = (e & 1) ? bfhi(nn[e >> 1]) : bflo(nn[e >> 1]);
                zs[e] = z + mup[col + e] * (pv - z) + mun[col + e] * (nx - z); }
            u32x4 o; o.x = pk2(zs[0], zs[1]); o.y = pk2(zs[2], zs[3]); o.z = pk2(zs[4], zs[5]); o.w = pk2(zs[6], zs[7]);
            *(u32x4*)(F1 + (size_t)row * 2048 + q * 512 + lane * 8) = o;
            if (q == 1) {
                float kr[8], ssq = 0.f;
#pragma unroll
                for (int e = 0; e < 8; ++e) { kr[e] = zs[e] * kk_w[lane * 8 + e]; ssq += kr[e] * kr[e]; }
                ssq = row8_sum(ssq);
                const float inv = 1.f / fmaxf(sqrtf(ssq), 1e-12f);
                u32x4 o2; o2.x = pk2(kr[0] * inv, kr[1] * inv); o2.y = pk2(kr[2] * inv, kr[3] * inv); o2.z = pk2(kr[4] * inv, kr[5] * inv); o2.w = pk2(kr[6] * inv, kr[7] * inv);
                *(u32x4*)(F1 + (size_t)row * 2048 + 1536 + lane * 8) = o2;
            }
        }
        {
            const int col = 1536 + lane * 4;
            const u32x2 c2 = *(const u32x2*)(zc + col);
            u32x2 p2 = (u32x2){0u, 0u}, n2 = (u32x2){0u, 0u};
            if (hasp) p2 = *(const u32x2*)(zc - 1792 + col);
            if (hasn) n2 = *(const u32x2*)(zc + 1792 + col);
            const unsigned cc[2] = {c2.x, c2.y}, pp[2] = {p2.x, p2.y}, nn[2] = {n2.x, n2.y};
            float zs[4];
#pragma unroll
            for (int e = 0; e < 4; ++e) { const float z = (e & 1) ? bfhi(cc[e >> 1]) : bflo(cc[e >> 1]); const float pv = (e & 1) ? bfhi(pp[e >> 1]) : bflo(pp[e >> 1]); const float nx = (e & 1) ? bfhi(nn[e >> 1]) : bflo(nn[e >> 1]);
                const float s = z + mup[col + e] * (pv - z) + mun[col + e] * (nx - z);
                zs[e] = lane < 16 ? tanhf(s) : (lane < 32 ? s : sigmoidf_(s)); }
            u32x2 o; o.x = pk2(zs[0], zs[1]); o.y = pk2(zs[2], zs[3]);
            *(u32x2*)(LIN + (size_t)row * 256 + lane * 4) = o;
        }
    }
}

__device__ __forceinline__ int rw_tok(int dir, int i) { return dir == 0 ? i : (i < NCTX ? NCTX - 1 - i : 8703 - i); }

typedef float f32x2 __attribute__((ext_vector_type(2)));
constexpr int RW_REC = 352;
__device__ __forceinline__ void rw_load(const bf16_t* f1, const bf16_t* f2, int dir, int rg, int c, int pw, int lane, bf16_t (&in)[8][5], bf16_t (&vin)[8]) {
#pragma unroll
    for (int q = 0; q < 8; ++q) { const size_t t = (size_t)rw_tok(dir, c * 32 + pw * 8 + q);
        in[q][0] = f1[t * 2048 + lane]; in[q][1] = f1[t * 2048 + 512 + lane]; in[q][2] = f1[t * 2048 + 1536 + lane]; in[q][3] = f2[t * 2048 + lane]; in[q][4] = f2[t * 2048 + 1024 + lane];
        vin[q] = f1[t * 2048 + 1024 + rg * 8 + (lane & 7)]; }
}
__device__ __forceinline__ void rw_emit(const bf16_t (&in)[8][5], const bf16_t (&vin)[8], int pw, int lane, float ka, float* buf) {
#pragma unroll
    for (int q = 0; q < 8; ++q) {
        const float r = bf2f(in[q][0]), k = bf2f(in[q][1]), kk = bf2f(in[q][2]), u = bf2f(in[q][3]), a = bf2f(in[q][4]);
        const float w = 1.f - u, key = k * (1.f + (a - 1.f) * ka), kka = kk * a, wr = w * r;
        const float c1 = wave_sum(kka * r), c2 = wave_sum(key * r);
        float* rec = buf + (pw * 8 + q) * RW_REC;
        rec[lane] = kk; rec[64 + lane] = wr; rec[128 + lane] = w; rec[192 + lane] = kka; rec[256 + lane] = key;
        if (lane < 8) { f32x4 vc; vc[0] = bf2f(vin[q]); vc[1] = c1; vc[2] = c2; vc[3] = 0.f; *(f32x4*)(rec + 320 + lane * 4) = vc; }
    }
}

__device__ __forceinline__ void phase_rw_scan(int l, unsigned char* sm) {
    CParams& p = KPL(); const Ctx cx = mkctx();
    const int tid = cx.tid, lane = tid & 63, wid = __builtin_amdgcn_readfirstlane(tid >> 6);
    const bf16_t* F1 = (const bf16_t*)(p.ws + OFF_F1); const bf16_t* F2 = (const bf16_t*)(p.ws + OFF_Z);
    bf16_t* YRAW = (bf16_t*)(p.ws + OFF_R2);
    float* ring = (float*)sm;
    const bool is_scan = wid < 2, is_prod = (wid & 2) != 0;
    const int pw = (wid & 1) + ((wid >> 2) << 1);
    for (int item = cx.bid; item < 256; item += cx.nb) {
        const int chain = item >> 3, rg = item & 7; const int dir = chain >> 4, b = (chain >> 3) & 1, h = chain & 7;
        const float ka = p.in[31][l * 512 + h * 64 + lane];
        const bf16_t* f1 = F1 + (size_t)b * SEQA * 2048 + h * 64; const bf16_t* f2 = F2 + (size_t)b * SEQA * 2048 + dir * 512 + h * 64;
        const int row = rg * 8 + (wid & 1) * 4 + (lane >> 4);
        bf16_t* yr = YRAW + ((size_t)dir * T_TOK + (size_t)b * SEQA) * 512 + h * 64 + row;
        bf16_t pin[8][5], pvin[8];
        __syncthreads();
        if (is_prod) { rw_load(f1, f2, dir, rg, 0, pw, lane, pin, pvin); rw_emit(pin, pvin, pw, lane, ka, ring); rw_load(f1, f2, dir, rg, 1, pw, lane, pin, pvin); }
        __syncthreads();
        f32x2 S01 = (f32x2){0.f, 0.f}, S23 = (f32x2){0.f, 0.f};
        if (is_scan) __builtin_amdgcn_s_setprio(3);
#pragma unroll 1
        for (int c = 0; c < 264; ++c) {
            float* buf = ring + (c & 1) * (32 * RW_REC);
            if (is_prod) { if (c + 1 < 264) { rw_emit(pin, pvin, pw, lane, ka, ring + ((c + 1) & 1) * (32 * RW_REC)); rw_load(f1, f2, dir, rg, c + 2 < 264 ? c + 2 : c + 1, pw, lane, pin, pvin); } }
            else if (is_scan) {
                const float* rb = buf + (lane & 15) * 4;
                const float* vb = buf + 320 + ((wid & 1) * 4 + (lane >> 4)) * 4;
#pragma unroll 1
                for (int hf = 0; hf < 2; ++hf) {
                    const float* rh = rb + hf * 16 * RW_REC; const float* vh = vb + hf * 16 * RW_REC;
                    f32x4 kk4 = *(const f32x4*)(rh), wr4 = *(const f32x4*)(rh + 64), w4 = *(const f32x4*)(rh + 128), ka4 = *(const f32x4*)(rh + 192), ky4 = *(const f32x4*)(rh + 256), vc4 = *(const f32x4*)(vh);
                    f32x4 nkk = *(const f32x4*)(rh + RW_REC), nwr = *(const f32x4*)(rh + RW_REC + 64), nw = *(const f32x4*)(rh + RW_REC + 128), nka = *(const f32x4*)(rh + RW_REC + 192), nky = *(const f32x4*)(rh + RW_REC + 256), nvc = *(const f32x4*)(vh + RW_REC);
                    float ybuf = 0.f;
#pragma unroll
                    for (int j = 0; j < 16; ++j) {
                        f32x4 mkk, mwr, mw, mka, mky, mvc;
                        if (j < 14) { const int o = (j + 2) * RW_REC;
                            mkk = *(const f32x4*)(rh + o); mwr = *(const f32x4*)(rh + o + 64); mw = *(const f32x4*)(rh + o + 128); mka = *(const f32x4*)(rh + o + 192); mky = *(const f32x4*)(rh + o + 256); mvc = *(const f32x4*)(vh + o); }
                        const float vv = vc4[0];
                        f32x2 p1 = S01 * (f32x2){kk4[0], kk4[1]}; p1 = S23 * (f32x2){kk4[2], kk4[3]} + p1;
                        f32x2 p2 = S01 * (f32x2){wr4[0], wr4[1]}; p2 = S23 * (f32x2){wr4[2], wr4[3]} + p2;
                        const f32x2 vv2 = (f32x2){vv, vv};
                        f32x2 u01 = (f32x2){ky4[0], ky4[1]} * vv2; u01 = S01 * (f32x2){w4[0], w4[1]} + u01;
                        f32x2 u23 = (f32x2){ky4[2], ky4[3]} * vv2; u23 = S23 * (f32x2){w4[2], w4[3]} + u23;
                        const float sk = row16_sum(p1[0] + p1[1]);
                        const float q2 = row16_sum(p2[0] + p2[1]);
                        const f32x2 nsk2 = (f32x2){-sk, -sk};
                        S01 = (f32x2){ka4[0], ka4[1]} * nsk2 + u01; S23 = (f32x2){ka4[2], ka4[3]} * nsk2 + u23;
                        const float y = q2 - sk * vc4[1] + vv * vc4[2];
                        if ((lane & 15) == j) ybuf = y;
                        kk4 = nkk; wr4 = nwr; w4 = nw; ka4 = nka; ky4 = nky; vc4 = nvc;
                        if (j < 14) { nkk = mkk; nwr = mwr; nw = mw; nka = mka; nky = mky; nvc = mvc; }
                        __builtin_amdgcn_sched_barrier(0);
                    }
                    yr[(size_t)rw_tok(dir, c * 32 + hf * 16 + (lane & 15)) * 512] = f2bf(ybuf);
                }
            }
            asm volatile("s_waitcnt lgkmcnt(0)" ::: "memory"); __builtin_amdgcn_s_barrier(); asm volatile("" ::: "memory");
        }
        if (is_scan) __builtin_amdgcn_s_setprio(0);
    }
}

__device__ __forceinline__ void phase_rw_out(int l) {
    CParams& p = KPL(); const Ctx cx = mkctx();
    const int lane = cx.tid & 63, gw = cx.bid * 8 + (cx.tid >> 6), nw = cx.nb * 8;
    const bf16_t* F1 = (const bf16_t*)(p.ws + OFF_F1); const bf16_t* F2 = (const bf16_t*)(p.ws + OFF_Z); const bf16_t* GRW = (const bf16_t*)(p.ws + OFF_ZRW);
    const bf16_t* YRAW = (const bf16_t*)(p.ws + OFF_R2);
    bf16_t* YC = (bf16_t*)(p.ws + OFF_YC);
    const int c0 = lane * 8;
    float ka[8], rk[8], lg[8], lb[8];
#pragma unroll
    for (int e = 0; e < 8; ++e) { ka[e] = p.in[31][l * 512 + c0 + e]; rk[e] = p.in[32][l * 512 + c0 + e]; lg[e] = p.in[33][l * 512 + c0 + e]; lb[e] = p.in[34][l * 512 + c0 + e]; }
    for (int row = gw; row < T_TOK; row += nw) {
        const u32x4 y0 = *(const u32x4*)(YRAW + (size_t)row * 512 + c0), y1 = *(const u32x4*)(YRAW + ((size_t)T_TOK + row) * 512 + c0);
        const u32x4 r4 = *(const u32x4*)(F1 + (size_t)row * 2048 + c0), k4 = *(const u32x4*)(F1 + (size_t)row * 2048 + 512 + c0), v4 = *(const u32x4*)(F1 + (size_t)row * 2048 + 1024 + c0);
        const u32x4 a04 = *(const u32x4*)(F2 + (size_t)row * 2048 + 1024 + c0), a14 = *(const u32x4*)(F2 + (size_t)row * 2048 + 1536 + c0);
        const u32x4 g4 = *(const u32x4*)(GRW + (size_t)row * 512 + c0);
        const unsigned ya[4] = {y0.x, y0.y, y0.z, y0.w}, yb[4] = {y1.x, y1.y, y1.z, y1.w}, rr[4] = {r4.x, r4.y, r4.z, r4.w}, kx[4] = {k4.x, k4.y, k4.z, k4.w}, vv[4] = {v4.x, v4.y, v4.z, v4.w};
        const unsigned aa[4] = {a04.x, a04.y, a04.z, a04.w}, ab[4] = {a14.x, a14.y, a14.z, a14.w}, gg[4] = {g4.x, g4.y, g4.z, g4.w};
        float y[8], sum = 0.f, bs = 0.f;
#pragma unroll
        for (int e = 0; e < 8; ++e) {
            const int w = e >> 1; const bool hi = e & 1;
            y[e] = (hi ? bfhi(ya[w]) : bflo(ya[w])) + (hi ? bfhi(yb[w]) : bflo(yb[w])); sum += y[e];
            const float r = hi ? bfhi(rr[w]) : bflo(rr[w]), k = hi ? bfhi(kx[w]) : bflo(kx[w]), a0 = hi ? bfhi(aa[w]) : bflo(aa[w]), a1 = hi ? bfhi(ab[w]) : bflo(ab[w]);
            bs += r * k * (2.f + (a0 + a1 - 2.f) * ka[e]) * rk[e];
        }
        sum = row8_sum(sum); bs = row8_sum(bs);
        const float mu = sum * (1.f / 64.f);
        float var = 0.f;
#pragma unroll
        for (int e = 0; e < 8; ++e) { const float d = y[e] - mu; var += d * d; }
        var = row8_sum(var) * (1.f / 64.f);
        const float rstd = rsqrtf(var + 64e-5f);
        float o[8];
#pragma unroll
        for (int e = 0; e < 8; ++e) { const int w = e >> 1; const bool hi = e & 1;
            const float v = hi ? bfhi(vv[w]) : bflo(vv[w]), g = hi ? bfhi(gg[w]) : bflo(gg[w]);
            o[e] = ((y[e] - mu) * rstd * lg[e] + lb[e] + bs * v) * g; }
        u32x4 o4; o4.x = pk2(o[0], o[1]); o4.y = pk2(o[2], o[3]); o4.z = pk2(o[4], o[5]); o4.w = pk2(o[6], o[7]);
        *(u32x4*)(YC + (size_t)row * 512 + c0) = o4;
    }
}

__device__ __forceinline__ void phase_final() {
    CParams& p = KPL(); const Ctx cx = mkctx();
    const int lane = cx.tid & 63, gw = cx.bid * 8 + (cx.tid >> 6), nw = cx.nb * 8;
    const float* X = (const float*)(p.ws + OFF_X);
    for (int r = gw; r < 2 * 8192; r += nw) {
        const int b = r >> 13, t = r & 8191;
        const float* src = X + ((size_t)b * SEQA + NCTX + t) * 1024;
        f32x4 v[4]; float ss = 0.f;
#pragma unroll
        for (int i = 0; i < 4; ++i) { v[i] = *(const f32x4*)(src + (lane + 64 * i) * 4); ss += v[i][0] * v[i][0] + v[i][1] * v[i][1] + v[i][2] * v[i][2] + v[i][3] * v[i][3]; }
        ss = wave_sum(ss);
        const float inv = rsqrtf(ss * (1.f / 1024.f) + 1e-6f);
#pragma unroll
        for (int i = 0; i < 4; ++i) { const int c = (lane + 64 * i) * 4; const f32x4 g4 = *(const f32x4*)(p.in[41] + c);
            *(f32x4*)(p.out + (size_t)r * 1024 + c) = v[i] * inv * g4; }
    }
}

#define XB_TMO      128
#define XB_XCNT(j)  (256  + 64 * (j))
#define XB_XSUB(j)  (1280 + 64 * (j))
#define XB_XGEN(j)  (2304 + 64 * (j))
#define XB_TOP      3328
#define XB_TOPGEN   3392
#define XCD_BAR_WORDS 3456
#define XB_SPIN_CAP (1u << 22)
constexpr int XB_LDS_OFF = 143344;
__device__ __forceinline__ unsigned xb_ld(unsigned* p)              { return __hip_atomic_load(p, __ATOMIC_RELAXED, __HIP_MEMORY_SCOPE_AGENT); }
__device__ __forceinline__ unsigned xb_add(unsigned* p, unsigned v) { return __hip_atomic_fetch_add(p, v, __ATOMIC_RELAXED, __HIP_MEMORY_SCOPE_AGENT); }
__device__ __forceinline__ unsigned xb_xcc_id() { return (unsigned)__builtin_amdgcn_s_getreg((3 << 11) | 20) & 0xFu; }
#define XB_SPIN(cond, bar) do { unsigned _sp = 0; while (cond) { __builtin_amdgcn_s_sleep(1); \
    if ((++_sp & 255u) == 0u) { if (xb_ld(&(bar)[XB_TMO])) break; if (_sp > XB_SPIN_CAP) { atomicAdd(&(bar)[XB_TMO], 1u); break; } } } } while (0)
__device__ __forceinline__ void xb_complete(unsigned* bar, unsigned x, unsigned G, unsigned& nloc, unsigned& nx) {
    unsigned sum, cnt, mine, sp = 0u;
    for (;;) {
        sum = 0u; cnt = 0u; mine = 0u;
#pragma unroll
        for (unsigned j = 0; j < 16; ++j) { const unsigned c = xb_ld(&bar[XB_XCNT(j)]); sum += c; cnt += (c > 0u) ? 1u : 0u; mine = (j == x) ? c : mine; }
        if (sum == G) break;
        __builtin_amdgcn_s_sleep(1);
        if ((++sp & 255u) == 0u) { if (xb_ld(&bar[XB_TMO])) break; if (sp > XB_SPIN_CAP) { atomicAdd(&bar[XB_TMO], 1u); break; } }
    }
    nloc = mine > 0u ? mine : 1u; nx = cnt > 0u ? cnt : 1u;
}
__device__ __forceinline__ void xb_post(unsigned char* smem) {
    CParams& p = KPL(); const Ctx cx = mkctx();
    volatile LAS unsigned* st = (volatile LAS unsigned*)((LAS unsigned char*)smem + XB_LDS_OFF);
    if (cx.tid == 0) { st[0] = 0u; st[1] = 0u; (void)xb_add(&((unsigned*)(p.ws + OFF_BAR))[XB_XCNT(xb_xcc_id())], 1u); }
    __syncthreads();
}
__device__ __forceinline__ void xsync(unsigned char* smem) {
    CParams& p = KPL(); const Ctx cx = mkctx();
    asm volatile("s_waitcnt vmcnt(0)" ::: "memory");
    __syncthreads();
    if (cx.tid == 0) {
        unsigned* bar = (unsigned*)(p.ws + OFF_BAR);
        volatile LAS unsigned* st = (volatile LAS unsigned*)((LAS unsigned char*)smem + XB_LDS_OFF);
        const unsigned x = xb_xcc_id();
        __builtin_amdgcn_s_waitcnt(0);
        unsigned nloc = st[0], nx = st[1];
        if (nloc == 0u) { xb_complete(bar, x, (unsigned)cx.nb, nloc, nx); st[0] = nloc; st[1] = nx; }
        const unsigned old = xb_add(&bar[XB_XSUB(x)], 1u);
        const unsigned gen = old / nloc;
        if (old + 1u == (gen + 1u) * nloc) {
            __builtin_amdgcn_fence(__ATOMIC_RELEASE, "agent");
            asm volatile("s_waitcnt vmcnt(0)" ::: "memory");
            const unsigned og = xb_add(&bar[XB_TOP], 1u);
            const unsigned tg = og / nx;
            if (og + 1u == (tg + 1u) * nx) xb_add(&bar[XB_TOPGEN], 1u);
            else XB_SPIN(xb_ld(&bar[XB_TOPGEN]) == tg, bar);
            __builtin_amdgcn_fence(__ATOMIC_ACQUIRE, "agent");
            xb_add(&bar[XB_XGEN(x)], 1u);
            asm volatile("s_waitcnt vmcnt(0)" ::: "memory");
        } else {
            XB_SPIN(xb_ld(&bar[XB_XGEN(x)]) == gen, bar);
            __builtin_amdgcn_fence(__ATOMIC_ACQUIRE, "agent");
            asm volatile("s_waitcnt vmcnt(0)" ::: "memory");
        }
    }
    __syncthreads();
}

#ifndef PHM
#define PHM 0xFFFFFFFFull
#endif
#ifndef PHR
#define PHR 0ull
#endif
#ifndef SYNCREP
#define SYNCREP 1
#endif
template <int WHICH>
__device__ __forceinline__ void gemm_stage(int l, LAS unsigned char* lds) {
    CParams& p = KPL(); const Ctx cx = mkctx();
    const int sk = (l == NLAYER - 1) ? 1 : 0;
    unsigned char* ws = p.ws;
    float* X = (float*)(ws + OFF_X); bf16_t* H = (bf16_t*)(ws + OFF_H); bf16_t* ZA = (bf16_t*)(ws + OFF_Z); bf16_t* ZRW = (bf16_t*)(ws + OFF_ZRW);
    bf16_t* W = (bf16_t*)(ws + OFF_W);
    const float* MODL = (const float*)(ws + OFF_MOD) + (size_t)l * 3 * 6144;
    if constexpr (WHICH == 0) run_gemm(cx, lds, H, W + W_MIX / 2, 4096, 1024, FInproj{ZA, (float*)(ws + OFF_MLG), ZRW});
    else if constexpr (WHICH == 1) run_gemm(cx, lds, (const bf16_t*)(ws + OFF_ZG), W + W_GLU / 2, 512, 512, FGlu{(const bf16_t*)(ws + OFF_ZG), p.in[18] + l * 512, (bf16_t*)(ws + OFF_YA)});
    else if constexpr (WHICH == 2) run_gemm_epi(cx, lds, (const bf16_t*)(ws + OFF_LORAIN), W + W_LORA / 2, 2560, 256, EpiLora{p.in[25] + l * 1024, p.in[27] + l * 1024, ZA, ZRW});
    else if constexpr (WHICH == 3) run_gemm(cx, lds, H, W + W_GATE / 2, 3072, 1024, FGate{ZA}, sk);
    else if constexpr (WHICH == 4) run_gemm(cx, lds, (const bf16_t*)(ws + OFF_YA), W + W_PA / 2, 1024, 512, FMerge<0>{ZA, (float*)(ws + OFF_F1), H}, sk);
    else if constexpr (WHICH == 5) run_gemm(cx, lds, (const bf16_t*)(ws + OFF_YB), W + W_PB / 2, 1024, 512, FMerge<1>{ZA, (float*)(ws + OFF_F1), H}, sk);
    else if constexpr (WHICH == 6) run_gemm(cx, lds, (const bf16_t*)(ws + OFF_YC), W + W_PC / 2, 1024, 512, FMerge<2>{ZA, (float*)(ws + OFF_F1), H}, sk);
    else if constexpr (WHICH == 7) run_gemm(cx, lds, H, W + W_OUT / 2, 1024, 1024, FResid{X, MODL, 2}, sk);
    else if constexpr (WHICH == 8) run_gemm(cx, lds, H, W + W_1 / 2, 4096, 1024, FMlp1{ZA}, sk);
    else run_gemm(cx, lds, ZA, W + W_2 / 2, 1024, 4096, FResid{X, MODL, 5}, sk);
}

template <int l>
__device__ __forceinline__ void run_layer(cg::grid_group& grid, LAS unsigned char* lds, float* smf, unsigned char* smem) {
        if constexpr (l == 0) phase_wconv<0>(l, smf); else phase_wconv<1>(l, smf);
        __syncthreads();
        if constexpr ((PHM >> 2) & 1) { phase_norm(l, 0, l == 0); if constexpr ((PHR >> 2) & 1) { __syncthreads(); phase_norm(l, 0, l == 0); } }
        for (int sr = 0; sr < SYNCREP; ++sr) xsync(smem);
        if constexpr ((PHM >> 3) & 1) { gemm_stage<0>(l, lds); if constexpr ((PHR >> 3) & 1) { __syncthreads(); gemm_stage<0>(l, lds); } }
        for (int sr = 0; sr < SYNCREP; ++sr) xsync(smem);
        if constexpr ((PHM >> 4) & 1) { phase_s5_local(l); if constexpr ((PHR >> 4) & 1) { __syncthreads(); phase_s5_local(l); } }
        if constexpr ((PHM >> 5) & 1) { phase_ml_conv(l); if constexpr ((PHR >> 5) & 1) { __syncthreads(); phase_ml_conv(l); } }
        for (int sr = 0; sr < SYNCREP; ++sr) xsync(smem);
        if constexpr ((PHM >> 6) & 1) { phase_s5_carry(l); if constexpr ((PHR >> 6) & 1) { __syncthreads(); phase_s5_carry(l); } }
        if constexpr ((PHM >> 7) & 1) { phase_ml_local(l, smem); if constexpr ((PHR >> 7) & 1) { __syncthreads(); phase_ml_local(l, smem); } }
        for (int sr = 0; sr < SYNCREP; ++sr) xsync(smem);
        if constexpr ((PHM >> 8) & 1) { phase_s5_final(l, smf); if constexpr ((PHR >> 8) & 1) { __syncthreads(); phase_s5_final(l, smf); } }
        if constexpr ((PHM >> 9) & 1) { phase_ml_carry(); if constexpr ((PHR >> 9) & 1) { __syncthreads(); phase_ml_carry(); } }
        for (int sr = 0; sr < SYNCREP; ++sr) xsync(smem);
        if constexpr ((PHM >> 10) & 1) { gemm_stage<1>(l, lds); if constexpr ((PHR >> 10) & 1) { __syncthreads(); gemm_stage<1>(l, lds); } }
        if constexpr ((PHM >> 11) & 1) { phase_ml_out(l, smem); if constexpr ((PHR >> 11) & 1) { __syncthreads(); phase_ml_out(l, smem); } }
        for (int sr = 0; sr < SYNCREP; ++sr) xsync(smem);
        if constexpr ((PHM >> 12) & 1) { phase_rw_feat(l); if constexpr ((PHR >> 12) & 1) { __syncthreads(); phase_rw_feat(l); } }
        for (int sr = 0; sr < SYNCREP; ++sr) xsync(smem);
        if constexpr ((PHM >> 13) & 1) { gemm_stage<2>(l, lds); if constexpr ((PHR >> 13) & 1) { __syncthreads(); gemm_stage<2>(l, lds); } }
        for (int sr = 0; sr < SYNCREP; ++sr) xsync(smem);
        if constexpr ((PHM >> 14) & 1) { phase_rw_scan(l, smem); if constexpr ((PHR >> 14) & 1) { __syncthreads(); phase_rw_scan(l, smem); } }
        for (int sr = 0; sr < SYNCREP; ++sr) xsync(smem);
        if constexpr ((PHM >> 15) & 1) { phase_rw_out(l); if constexpr ((PHR >> 15) & 1) { __syncthreads(); phase_rw_out(l); } }
        for (int sr = 0; sr < SYNCREP; ++sr) xsync(smem);
        if constexpr ((PHM >> 17) & 1) { gemm_stage<3>(l, lds); if constexpr ((PHR >> 17) & 1) { __syncthreads(); gemm_stage<3>(l, lds); } }
        for (int sr = 0; sr < SYNCREP; ++sr) xsync(smem);
        if constexpr ((PHM >> 18) & 1) { gemm_stage<4>(l, lds); if constexpr ((PHR >> 18) & 1) { __syncthreads(); gemm_stage<4>(l, lds); } }
        if constexpr ((PHM >> 19) & 1) { gemm_stage<5>(l, lds); if constexpr ((PHR >> 19) & 1) { __syncthreads(); gemm_stage<5>(l, lds); } }
        if constexpr ((PHM >> 20) & 1) { gemm_stage<6>(l, lds); if constexpr ((PHR >> 20) & 1) { __syncthreads(); gemm_stage<6>(l, lds); } }
        for (int sr = 0; sr < SYNCREP; ++sr) xsync(smem);
        if constexpr ((PHM >> 21) & 1) { gemm_stage<7>(l, lds); if constexpr ((PHR >> 21) & 1) { __syncthreads(); gemm_stage<7>(l, lds); } }
        for (int sr = 0; sr < SYNCREP; ++sr) xsync(smem);
        if constexpr ((PHM >> 22) & 1) { phase_norm(l, 1, false); if constexpr ((PHR >> 22) & 1) { __syncthreads(); phase_norm(l, 1, false); } }
        for (int sr = 0; sr < SYNCREP; ++sr) xsync(smem);
        if constexpr ((PHM >> 23) & 1) { gemm_stage<8>(l, lds); if constexpr ((PHR >> 23) & 1) { __syncthreads(); gemm_stage<8>(l, lds); } }
        for (int sr = 0; sr < SYNCREP; ++sr) xsync(smem);
        gemm_stage<9>(l, lds);
        if constexpr (l < NLAYER - 1) { __syncthreads(); phase_wconv<2>(l + 1, smf); }
        for (int sr = 0; sr < SYNCREP; ++sr) xsync(smem);
    }

__global__ void __launch_bounds__(512, 2) fwd_megakernel(Params p_unused) {
    extern __shared__ __attribute__((aligned(16))) unsigned char smem[];
    cg::grid_group grid = cg::this_grid();
    LAS unsigned char* lds = (LAS unsigned char*)smem;
    float* smf = (float*)smem;

    xb_post(smem);
    phase_mod(smf); phase_s5_params();
    grid.sync();
    run_layer<0>(grid, lds, smf, smem);
    run_layer<1>(grid, lds, smf, smem);
    run_layer<2>(grid, lds, smf, smem);
    run_layer<3>(grid, lds, smf, smem);
    phase_final();
}

extern "C" void kernel_launch(void* const* d_in, const int* in_sizes, int n_in, void* d_out, int out_size, void* d_ws, size_t ws_size, hipStream_t stream) {
    static int grid_blocks = 0;
    if (grid_blocks == 0) {
        if (n_in != 42 || ws_size < WS_END) { fprintf(stderr, "kernel_launch: unexpected n_in %d / ws_size %zu\n", n_in, ws_size); grid_blocks = -1; return; }
        int dev = 0, cus = 0, per_cu = 0;
        (void)hipGetDevice(&dev);
        (void)hipDeviceGetAttribute(&cus, hipDeviceAttributeMultiprocessorCount, dev);
        if (hipFuncSetAttribute((const void*)fwd_megakernel, hipFuncAttributeMaxDynamicSharedMemorySize, LDS_BYTES) != hipSuccess) { fprintf(stderr, "kernel_launch: hipFuncSetAttribute failed\n"); grid_blocks = -1; return; }
        if (hipOccupancyMaxActiveBlocksPerMultiprocessor(&per_cu, (const void*)fwd_megakernel, 512, LDS_BYTES) != hipSuccess || per_cu < 1) { fprintf(stderr, "kernel_launch: occupancy query says %d\n", per_cu); per_cu = 1; (void)hipGetLastError(); }
        grid_blocks = cus * 1;
    }
    if (grid_blocks < 0) return;
    if (hipMemsetAsync((unsigned char*)d_ws + OFF_BAR, 0, 16384, stream) != hipSuccess) { fprintf(stderr, "kernel_launch: memset failed\n"); return; }
    Params p{};
    for (int i = 0; i < 42; ++i) p.in[i] = (const float*)d_in[i];
    p.out = (float*)d_out; p.ws = (unsigned char*)d_ws;
    void* args[] = {&p};
    hipError_t e = hipLaunchCooperativeKernel((const void*)fwd_megakernel, dim3(grid_blocks), dim3(512), args, LDS_BYTES, stream);
    if (e != hipSuccess) fprintf(stderr, "cooperative launch failed: %s (grid %d)\n", hipGetErrorString(e), grid_blocks);
}
```

```cpp
#include <hip/hip_runtime.h>
#include <hip/hip_cooperative_groups.h>
#include <cstdio>
namespace cg = cooperative_groups;

#define LAS __attribute__((address_space(3)))
typedef unsigned short bf16_t;
typedef short bf16x8 __attribute__((ext_vector_type(8)));
typedef float f32x4 __attribute__((ext_vector_type(4)));
typedef unsigned u32x4 __attribute__((ext_vector_type(4)));
typedef unsigned u32x2 __attribute__((ext_vector_type(2)));

constexpr int T_TOK = 16896, SEQA = 8448, NCTX = 256;
constexpr int NLAYER = 4;
constexpr int LDS_BYTES = 143360;
constexpr size_t OFF_X = 0;
constexpr size_t OFF_H = 69206016;
constexpr size_t OFF_Z = 103809024;
constexpr size_t OFF_ZRW = OFF_Z + 69206016;
constexpr size_t OFF_MLG = 242221056;
constexpr size_t OFF_W = 243302400;
constexpr size_t OFF_YA = 281837568;
constexpr size_t OFF_YB = 299139072;
constexpr size_t OFF_YC = 316440576;
constexpr size_t OFF_F1 = 333742080;
constexpr size_t OFF_MOD = 402948096;
constexpr size_t OFF_S5P = 403243008;
constexpr size_t OFF_MLS = OFF_S5P + 4 * 589824;
constexpr size_t OFF_R2 = OFF_MLS + 16384;
constexpr size_t OFF_BAR = OFF_R2 + 34603008;
constexpr size_t OFF_S5ST = OFF_BAR + 16384;
constexpr size_t WS_END = OFF_S5ST + 8650752;
constexpr size_t OFF_CLOC = OFF_F1;
constexpr size_t OFF_U0 = OFF_ZRW + 17301504;
constexpr size_t OFF_QKC = OFF_F1 + 43524096;
constexpr size_t OFF_ZG = OFF_ZRW + 34603008;
constexpr size_t OFF_LORAIN = OFF_R2 + 17301504;
constexpr size_t W_MIX = 0, W_GATE = 8388608, W_GLU = 14680064, W_LORA = 15204352, W_PA = 16515072, W_PB = 17563648, W_PC = 18612224, W_OUT = 19660800, W_1 = 21757952, W_2 = 30146560;

struct Params {
    const float* in[42];
    float* out;
    unsigned char* ws;
};

typedef const __attribute__((address_space(4))) Params CParams;
__device__ __forceinline__ CParams& KPL() {
    unsigned long long a = (unsigned long long)__builtin_amdgcn_kernarg_segment_ptr();
    asm volatile("" : "+s"(a));
    return *(CParams*)a;
}
struct Ctx { int tid, bid, nb; };
__device__ __forceinline__ Ctx mkctx() { Ctx c; c.tid = threadIdx.x; c.bid = blockIdx.x; c.nb = gridDim.x; asm volatile("" : "+v"(c.tid), "+s"(c.bid), "+s"(c.nb)); return c; }
__device__ __forceinline__ float bf2f(unsigned v) { return __uint_as_float(v << 16); }
__device__ __forceinline__ float bflo(unsigned w) { return __uint_as_float(w << 16); }
__device__ __forceinline__ float bfhi(unsigned w) { return __uint_as_float(w & 0xffff0000u); }
__device__ __forceinline__ bf16_t f2bf(float f) { unsigned u = __float_as_uint(f); u += 0x7FFFu + ((u >> 16) & 1u); return (bf16_t)(u >> 16); }
__device__ __forceinline__ unsigned pk2(float lo, float hi) { return (unsigned)f2bf(lo) | ((unsigned)f2bf(hi) << 16); }
__device__ __forceinline__ void store4bf(bf16_t* p, f32x4 v) { u32x2 r; r.x = pk2(v[0], v[1]); r.y = pk2(v[2], v[3]); *(u32x2*)p = r; }
__device__ __forceinline__ float sigmoidf_(float x) { return 1.f / (1.f + __expf(-x)); }

#define DPP_F(x, ctrl, rmask) __int_as_float(__builtin_amdgcn_update_dpp(0, __float_as_int(x), ctrl, rmask, 0xF, false))
__device__ __forceinline__ float row8_sum(float x) {
    x += DPP_F(x, 0xB1, 0xF); x += DPP_F(x, 0x4E, 0xF); x += DPP_F(x, 0x141, 0xF); return x;
}
__device__ __forceinline__ float row16_sum(float x) {
    x += DPP_F(x, 0xB1, 0xF); x += DPP_F(x, 0x4E, 0xF); x += DPP_F(x, 0x141, 0xF); x += DPP_F(x, 0x140, 0xF); return x;
}
__device__ __forceinline__ float wave_sum(float x) {
    x = row16_sum(x);
    x += DPP_F(x, 0x142, 0xA);
    x += DPP_F(x, 0x143, 0xC);
    return __int_as_float(__builtin_amdgcn_readlane(__float_as_int(x), 63));
}

namespace pg8 {
constexpr int BM = 256, BK = 64, HALF = 128, HTB = HALF * BK * 2, NXCD = 8, WGM = 8;
__device__ __forceinline__ int lds_byte(int r, int c) { const int st = (r >> 4) * 2 + (c >> 5), rr = r & 15, cc = c & 31, ob = rr * 64 + cc * 2; return st * 1024 + (ob ^ (((ob >> 9) & 1) << 5)); }
__device__ __forceinline__ void stage_rc(int b, int& R, int& C) { const int st = b / 1024, sb = b % 1024, swz = sb ^ (((sb >> 9) & 1) << 5); R = (st >> 1) * 16 + swz / 64; C = (st & 1) * 32 + (swz % 64) / 2; }
struct Unit { int pm, pn; };
struct Gemm { const bf16_t* A; const bf16_t* Bt; int M, N, K; };
struct StaticOrder {
    int nM, nN, nwg, G, c, skipctx;
    __device__ void init(int M, int N, int G_, int c_, int skip_ = 0) { nM = M / BM - 2 * skip_; nN = N / BM; nwg = nM * nN; G = G_; c = c_; skipctx = skip_; }
    __device__ bool next(int i, Unit& u) const {
        const long L = (long)i * G + c; if (L >= nwg) return false;
        int wgid = (int)L; { const int q = nwg / NXCD, r = nwg % NXCD, xcd = wgid % NXCD, off = wgid / NXCD; wgid = (xcd < r ? xcd * (q + 1) : r * (q + 1) + (xcd - r) * q) + off; }
        const int nig = WGM * nN, gid = wgid / nig, fm = gid * WGM, gsz = (nM - fm) < WGM ? (nM - fm) : WGM;
        u.pm = fm + ((wgid % nig) % gsz); u.pn = (wgid % nig) / gsz;
        if (skipctx) u.pm += (u.pm >= 32) ? 2 : 1;
        return true;
    }
};

template <class Epi>
__device__ __forceinline__ void gemm_phase(int tid_in, LAS unsigned char* lds, const Gemm g, const StaticOrder& S, const Epi& E) {
    const int tid = tid_in, wid = __builtin_amdgcn_readfirstlane(tid >> 6), lane = tid & 63, wr = wid >> 2, wc = wid & 3, fr = lane & 15, fq = lane >> 4;
    const int K = g.K, nt = K / BK;
    unsigned voffA[2], voffB[2];
#pragma unroll
    for (int i = 0; i < 2; ++i) { int R, C; stage_rc(tid * 16 + i * 8192, R, C); voffA[i] = (unsigned)(R * K + C) * 2u; voffB[i] = voffA[i]; }
    const size_t kstep = (size_t)(BK * 2);
    const size_t hstep = (size_t)HALF * K * 2;
    const size_t tstep = 2 * hstep;
    const unsigned ldsw = (unsigned)wid * 1024u;
    const int aoff = lds_byte(wr * 64 + fr, fq * 8), boff = lds_byte(wc * 32 + fr, fq * 8);
#define PG8_SA(b, h) (((b) * 2 + (h)) * HTB)
#define PG8_SB(b, h) ((4 + (b) * 2 + (h)) * HTB)
#define PG8_STAGE(bufoff, gbase, voff) do { _Pragma("unroll") for (int _i = 0; _i < 2; ++_i) \
        __builtin_amdgcn_global_load_lds((const unsigned*)((const char*)(gbase) + (voff)[_i]), (LAS unsigned*)(lds + (bufoff) + ldsw + _i * 8192), 16, 0, 0); } while (0)
#define PG8_LDA(dst, b, h) do { _Pragma("unroll") for (int m = 0; m < 4; ++m) _Pragma("unroll") for (int k = 0; k < 2; ++k) dst[m][k] = *(const LAS bf16x8*)(lds + PG8_SA(b, h) + aoff + m * 2048 + k * 1024); } while (0)
#define PG8_LDB(dst, b, h) do { _Pragma("unroll") for (int n = 0; n < 2; ++n) _Pragma("unroll") for (int k = 0; k < 2; ++k) dst[n][k] = *(const LAS bf16x8*)(lds + PG8_SB(b, h) + boff + n * 2048 + k * 1024); } while (0)
#define PG8_MMA(ai, bj, At, Bt) do { __builtin_amdgcn_s_setprio(1); _Pragma("unroll") for (int m = 0; m < 4; ++m) _Pragma("unroll") for (int n = 0; n < 2; ++n) _Pragma("unroll") for (int k = 0; k < 2; ++k) \
        acc[ai][bj][m][n] = __builtin_amdgcn_mfma_f32_16x16x32_bf16(Bt[n][k], At[m][k], acc[ai][bj][m][n], 0, 0, 0); __builtin_amdgcn_s_setprio(0); } while (0)
#define PG8_WAIT_V(n) asm volatile("s_waitcnt vmcnt(" #n ")" ::: "memory")
#define PG8_WAIT_L(n) asm volatile("s_waitcnt lgkmcnt(" #n ")" ::: "memory")
#define PG8_BAR __builtin_amdgcn_s_barrier()
#define PG8_SCHED __builtin_amdgcn_sched_barrier(0)
    Unit cur, nxt; int ui = 0;
    if (!S.next(0, cur)) return;
    f32x4 acc[2][2][4][2];
#pragma unroll
    for (int a = 0; a < 2; ++a)
#pragma unroll
        for (int b = 0; b < 2; ++b)
#pragma unroll
            for (int m = 0; m < 4; ++m)
#pragma unroll
                for (int n = 0; n < 2; ++n) acc[a][b][m][n] = (f32x4){0.f, 0.f, 0.f, 0.f};
    bf16x8 At[4][2], B0[2][2], B1[2][2];
    const char* cA = (const char*)g.A + (size_t)cur.pm * tstep; const char* cB = (const char*)g.Bt + (size_t)cur.pn * tstep;
    PG8_STAGE(PG8_SB(0, 0), cB, voffB); PG8_STAGE(PG8_SA(0, 0), cA, voffA); PG8_STAGE(PG8_SB(0, 1), cB + hstep, voffB); PG8_STAGE(PG8_SA(0, 1), cA + hstep, voffA);
    if (wr == 1) PG8_BAR;
    PG8_WAIT_V(4); PG8_BAR;
    PG8_STAGE(PG8_SB(1, 0), cB + kstep, voffB); PG8_STAGE(PG8_SA(1, 0), cA + kstep, voffA); PG8_STAGE(PG8_SB(1, 1), cB + hstep + kstep, voffB);
    PG8_WAIT_V(6); PG8_BAR;
    for (;;) {
        const bool has_next = S.next(ui + 1, nxt);
        const char* nA = has_next ? (const char*)g.A + (size_t)nxt.pm * tstep : cA; const char* nB = has_next ? (const char*)g.Bt + (size_t)nxt.pn * tstep : cB;
        for (int t = 0; t < nt; t += 2) {
            const bool last = (t == nt - 2);
            const char* a1 = cA + (size_t)(t + 1) * kstep;
            const char* a2 = last ? nA : cA + (size_t)(t + 2) * kstep; const char* b2 = last ? nB : cB + (size_t)(t + 2) * kstep;
            const char* a3 = a2 + kstep; const char* b3 = b2 + kstep;
            PG8_LDB(B0, 0, 0); PG8_SCHED; PG8_LDA(At, 0, 0); PG8_STAGE(PG8_SA(1, 1), a1 + hstep, voffA);
            PG8_WAIT_L(8); PG8_BAR; PG8_WAIT_L(0); PG8_MMA(0, 0, At, B0); PG8_BAR; PG8_SCHED;
            PG8_LDB(B1, 0, 1); PG8_STAGE(PG8_SB(0, 0), b2, voffB);
            PG8_BAR; PG8_WAIT_L(0); PG8_MMA(0, 1, At, B1); PG8_BAR;
            PG8_LDA(At, 0, 1); PG8_STAGE(PG8_SA(0, 0), a2, voffA);
            PG8_BAR; PG8_WAIT_L(0); PG8_MMA(1, 0, At, B0); PG8_BAR; PG8_SCHED;
            PG8_STAGE(PG8_SB(0, 1), b2 + hstep, voffB);
            PG8_WAIT_V(6); PG8_BAR; PG8_MMA(1, 1, At, B1); PG8_BAR;
            PG8_LDB(B0, 1, 0); PG8_SCHED; PG8_LDA(At, 1, 0); PG8_STAGE(PG8_SA(0, 1), a2 + hstep, voffA);
            PG8_WAIT_L(8); PG8_BAR; PG8_WAIT_L(0); PG8_MMA(0, 0, At, B0); PG8_BAR; PG8_SCHED;
            PG8_LDB(B1, 1, 1); PG8_STAGE(PG8_SB(1, 0), b3, voffB);
            PG8_BAR; PG8_WAIT_L(0); PG8_MMA(0, 1, At, B1); PG8_BAR;
            PG8_LDA(At, 1, 1); PG8_STAGE(PG8_SA(1, 0), a3, voffA);
            PG8_BAR; PG8_WAIT_L(0); PG8_MMA(1, 0, At, B0); PG8_BAR; PG8_SCHED;
            PG8_STAGE(PG8_SB(1, 1), b3 + hstep, voffB);
            PG8_WAIT_V(6); PG8_BAR; PG8_MMA(1, 1, At, B1); PG8_BAR;
        }
        E(acc, cur, wr, wc, fr, fq);
        if (!has_next) break;
#pragma unroll
        for (int a = 0; a < 2; ++a)
#pragma unroll
            for (int b = 0; b < 2; ++b)
#pragma unroll
                for (int m = 0; m < 4; ++m)
#pragma unroll
                    for (int n = 0; n < 2; ++n) acc[a][b][m][n] = (f32x4){0.f, 0.f, 0.f, 0.f};
        cur = nxt; cA = nA; cB = nB; ++ui;
    }
    PG8_WAIT_V(0);
    if (wr == 0) PG8_BAR;
    PG8_BAR;
#undef PG8_SA
#undef PG8_SB
#undef PG8_STAGE
#undef PG8_LDA
#undef PG8_LDB
#undef PG8_MMA
#undef PG8_WAIT_V
#undef PG8_WAIT_L
#undef PG8_BAR
#undef PG8_SCHED
}

template <class F> struct EpiT {
    F f;
    __device__ __forceinline__ void operator()(const f32x4 (&acc)[2][2][4][2], const Unit& u, int wr, int wc, int fr, int fq) const {
        const int row0 = u.pm * BM + wr * 64 + fr, col0 = u.pn * BM + wc * 32 + 4 * fq;
#pragma unroll
        for (int ai = 0; ai < 2; ++ai)
#pragma unroll
            for (int m = 0; m < 4; ++m) {
                const int row = row0 + ai * HALF + m * 16;
#pragma unroll
                for (int bj = 0; bj < 2; ++bj)
#pragma unroll
                    for (int n = 0; n < 2; ++n) f(row, col0 + bj * HALF + n * 16, acc[ai][bj][m][n]);
            }
    }
};
}

template <class F>
__device__ __forceinline__ void run_gemm(const Ctx& cx, LAS unsigned char* lds, const bf16_t* A, const bf16_t* Bt, int N, int K, const F& f, int skip = 0) {
    pg8::Gemm g; g.A = A; g.Bt = Bt; g.M = T_TOK; g.N = N; g.K = K;
    pg8::StaticOrder S; S.init(T_TOK, N, cx.nb, cx.bid, skip);
    pg8::EpiT<F> E{f};
    pg8::gemm_phase(cx.tid, lds, g, S, E);
}

template <class E>
__device__ __forceinline__ void run_gemm_epi(const Ctx& cx, LAS unsigned char* lds, const bf16_t* A, const bf16_t* Bt, int N, int K, const E& e) {
    pg8::Gemm g; g.A = A; g.Bt = Bt; g.M = T_TOK; g.N = N; g.K = K;
    pg8::StaticOrder S; S.init(T_TOK, N, cx.nb, cx.bid);
    pg8::gemm_phase(cx.tid, lds, g, S, e);
}
__device__ __forceinline__ int row_vec(int row) { const int b = row >= SEQA ? 1 : 0; const int t = row - b * SEQA; return t < NCTX ? 2 : b; }

struct FInproj { bf16_t* za; float* mlg; bf16_t* zrw;
    __device__ __forceinline__ void operator()(int row, int col, f32x4 v) const {
        if (col < 2048) store4bf(za + (size_t)row * 2048 + col, v);
        else if (col < 2064) *(f32x4*)(mlg + (size_t)row * 16 + (col - 2048)) = v;
        else if (col < 3856) store4bf(zrw + (size_t)row * 1792 + (col - 2064), v);
    } };
struct FGlu { const bf16_t* zg; const float* bglu; bf16_t* ya;
    __device__ __forceinline__ void operator()(int row, int col, f32x4 v) const {
        const u32x2 z = *(const u32x2*)(zg + (size_t)row * 512 + col); const f32x4 b = *(const f32x4*)(bglu + col);
        f32x4 o; o[0] = bflo(z.x) * sigmoidf_(v[0] + b[0]); o[1] = bfhi(z.x) * sigmoidf_(v[1] + b[1]); o[2] = bflo(z.y) * sigmoidf_(v[2] + b[2]); o[3] = bfhi(z.y) * sigmoidf_(v[3] + b[3]);
        store4bf(ya + (size_t)row * 512 + col, o);
    } };
struct EpiLora { const float* w0; const float* a0; bf16_t* f2; bf16_t* grw; bf16_t* u0;
    __device__ __forceinline__ void operator()(const f32x4 (&acc)[2][2][4][2], const pg8::Unit& u, int wr, int wc, int fr, int fq) const {
        const int row0 = u.pm * 256 + wr * 64 + fr, col0 = u.pn * 256 + wc * 32 + 4 * fq;
        const int pn = __builtin_amdgcn_readfirstlane(u.pn);
        if (pn < 8) {
            const float* bias = pn < 4 ? w0 : a0 - 1024;
#pragma unroll
            for (int bj = 0; bj < 2; ++bj)
#pragma unroll
                for (int n = 0; n < 2; ++n) {
                    const int col = col0 + bj * 128 + n * 16;
                    const f32x4 b = *(const f32x4*)(bias + col);
#pragma unroll
                    for (int ai = 0; ai < 2; ++ai)
#pragma unroll
                        for (int m = 0; m < 4; ++m) {
                            const int row = row0 + ai * 128 + m * 16; f32x4 o;
#pragma unroll
                            for (int e = 0; e < 4; ++e) { const float s = sigmoidf_(acc[ai][bj][m][n][e] + b[e]); o[e] = pn < 4 ? 1.f - __expf(-0.60653065971f * s) : s; }
                            if (pn < 2) store4bf(u0 + (size_t)row * 512 + col, o); else store4bf(f2 + (size_t)row * 2048 + col, o);
                        }
                }
        } else {
#pragma unroll
            for (int ai = 0; ai < 2; ++ai)
#pragma unroll
                for (int m = 0; m < 4; ++m) { const int row = row0 + ai * 128 + m * 16;
#pragma unroll
                    for (int bj = 0; bj < 2; ++bj)
#pragma unroll
                        for (int n = 0; n < 2; ++n) store4bf(grw + (size_t)row * 512 + (col0 + bj * 128 + n * 16 - 2048), acc[ai][bj][m][n]); }
        }
    } };
struct FGate { bf16_t* g;
    __device__ __forceinline__ void operator()(int row, int col, f32x4 v) const {
        f32x4 o; o[0] = sigmoidf_(v[0]); o[1] = sigmoidf_(v[1]); o[2] = sigmoidf_(v[2]); o[3] = sigmoidf_(v[3]);
        store4bf(g + (size_t)row * 3072 + col, o);
    } };
template <int J> struct FMerge { const bf16_t* g; float* y32; bf16_t* ybf;
    __device__ __forceinline__ void operator()(int row, int col, f32x4 v) const {
        const u32x2 z = *(const u32x2*)(g + (size_t)row * 3072 + J * 1024 + col);
        f32x4 o; o[0] = bflo(z.x) * v[0]; o[1] = bfhi(z.x) * v[1]; o[2] = bflo(z.y) * v[2]; o[3] = bfhi(z.y) * v[3];
        float* yp = y32 + (size_t)row * 1024 + col;
        if (J == 0) *(f32x4*)yp = o;
        else if (J == 1) { f32x4 t = *(f32x4*)yp; *(f32x4*)yp = t + o; }
        else { f32x4 t = *(f32x4*)yp; store4bf(ybf + (size_t)row * 1024 + col, t + o); }
    } };
struct FResid { float* x; const float* modl; int chunk;
    __device__ __forceinline__ void operator()(int row, int col, f32x4 v) const {
        const f32x4 mg = *(const f32x4*)(modl + row_vec(row) * 6144 + chunk * 1024 + col);
        float* xp = x + (size_t)row * 1024 + col; f32x4 t = *(f32x4*)xp; *(f32x4*)xp = t + mg * v;
    } };
struct FMlp1 { bf16_t* hid;
    __device__ __forceinline__ void operator()(int row, int col, f32x4 v) const {
        f32x4 o;
#pragma unroll
        for (int e = 0; e < 4; ++e) { const float r = fmaxf(v[e], 0.f); o[e] = r * r; }
        store4bf(hid + (size_t)row * 4096 + col, o);
    } };

__device__ __forceinline__ void phase_mod(float* smf) {
    CParams& p = KPL(); const Ctx cx = mkctx();
    const int tid = cx.tid, lane = tid & 63, wid = tid >> 6;
    float* sc = smf; float* red = smf + 3072;
    float* MOD = (float*)(p.ws + OFF_MOD);
    for (int i = tid; i < 3072; i += 512) { const int v = i >> 10, j = i & 1023; const float c = v < 2 ? p.in[1][v * 1024 + j] : p.in[3][j]; sc[i] = c / (1.f + expf(-c)); }
    __syncthreads();
    for (int item = cx.bid; item < 4 * 96; item += cx.nb) {
        const int l = item / 96, jt = item % 96, j = jt * 64 + lane;
        const float* w = p.in[4] + (size_t)l * 1024 * 6144 + j;
        float a0 = 0.f, a1 = 0.f, a2 = 0.f;
#pragma unroll 16
        for (int i = wid * 128; i < wid * 128 + 128; ++i) { const float wv = w[(size_t)i * 6144]; a0 += sc[i] * wv; a1 += sc[1024 + i] * wv; a2 += sc[2048 + i] * wv; }
        red[(wid * 3 + 0) * 64 + lane] = a0; red[(wid * 3 + 1) * 64 + lane] = a1; red[(wid * 3 + 2) * 64 + lane] = a2;
        __syncthreads();
        if (tid < 192) { const int v = tid >> 6; float s = 0.f;
            for (int w8 = 0; w8 < 8; ++w8) s += red[(w8 * 3 + v) * 64 + lane];
            MOD[(l * 3 + v) * 6144 + j] = s + p.in[5][l * 6144 + j]; }
        __syncthreads();
    }
}

__device__ __forceinline__ void dsincos(double x, double& s, double& c) {
    const double k = rint(x * 0.63661977236758134308);
    double r = fma(-k, 1.57079632679489655800, x); r = fma(-k, 6.12323399573676603587e-17, r);
    const double r2 = r * r;
    double ps = -1.0 / 355687428096000.0;
    ps = fma(ps, r2, 1.0 / 1307674368000.0); ps = fma(ps, r2, -1.0 / 6227020800.0); ps = fma(ps, r2, 1.0 / 39916800.0); ps = fma(ps, r2, -1.0 / 362880.0);
    ps = fma(ps, r2, 1.0 / 5040.0); ps = fma(ps, r2, -1.0 / 120.0); ps = fma(ps, r2, 1.0 / 6.0); ps = fma(ps, r2, -1.0); ps = -ps * r;
    double pc = 1.0 / 20922789888000.0;
    pc = fma(pc, r2, -1.0 / 87178291200.0); pc = fma(pc, r2, 1.0 / 479001600.0); pc = fma(pc, r2, -1.0 / 3628800.0); pc = fma(pc, r2, 1.0 / 40320.0);
    pc = fma(pc, r2, -1.0 / 720.0); pc = fma(pc, r2, 1.0 / 24.0); pc = fma(pc, r2, -0.5); pc = fma(pc, r2, 1.0);
    const int q = ((int)k) & 3;
    s = (q == 0) ? ps : (q == 1) ? pc : (q == 2) ? -ps : -pc;
    c = (q == 0) ? pc : (q == 1) ? -ps : (q == 2) ? -pc : ps;
}
__device__ __forceinline__ double dexp_neg(double x) {
    const double k = rint(x * 1.44269504088896338700);
    double r = fma(-k, 0.693147180369123816490, x); r = fma(-k, 1.90821492927058770002e-10, r);
    double pe = 1.0 / 6227020800.0;
    pe = fma(pe, r, 1.0 / 479001600.0); pe = fma(pe, r, 1.0 / 39916800.0); pe = fma(pe, r, 1.0 / 3628800.0); pe = fma(pe, r, 1.0 / 362880.0); pe = fma(pe, r, 1.0 / 40320.0);
    pe = fma(pe, r, 1.0 / 5040.0); pe = fma(pe, r, 1.0 / 720.0); pe = fma(pe, r, 1.0 / 120.0); pe = fma(pe, r, 1.0 / 24.0); pe = fma(pe, r, 1.0 / 6.0); pe = fma(pe, r, 0.5);
    pe = fma(pe, r, 1.0); pe = fma(pe, r, 1.0);
    int ki = (int)k; if (ki < -1000) return 0.0;
    return pe * __longlong_as_double((long long)(1023 + ki) << 52);
}

__device__ __forceinline__ void wconv_tile(const Ctx& cx, const float* src, int ld, int K, int c0, int ncols, bf16_t* dst, int kt, int nt, float* tile) {
    const int tid = cx.tid, j = tid & 63, i0 = tid >> 6;
#pragma unroll
    for (int e = 0; e < 8; ++e) { const int i = i0 + 8 * e; const int n = nt * 64 + j;
        tile[i * 65 + j] = (n < ncols) ? src[(size_t)(kt * 64 + i) * ld + c0 + n] : 0.f; }
    __syncthreads();
#pragma unroll
    for (int e = 0; e < 8; ++e) { const int jj = i0 + 8 * e;
        dst[(size_t)(nt * 64 + jj) * K + kt * 64 + j] = f2bf(tile[j * 65 + jj]); }
    __syncthreads();
}

template <int MODE>
__device__ __forceinline__ void phase_wconv(int l, float* smf) {
    CParams& p = KPL(); const Ctx cx = mkctx();
    bf16_t* W = (bf16_t*)(p.ws + OFF_W);
    const int tid = cx.tid;
    unsigned* ticket = (unsigned*)(p.ws + OFF_BAR) + 3520 + l * 16;
    int* tslot = (int*)smf + 8192;
    for (int it = (MODE == 2 ? 0 : cx.bid); ; it += cx.nb) {
        int item;
        if (MODE == 0) { item = it; if (item >= 5184) break; }
        else if (MODE == 1) { item = 3520 + it; if (item >= 4544) break; }
        else {
            if (tid == 0) *tslot = (int)__hip_atomic_fetch_add(ticket, 1u, __ATOMIC_RELAXED, __HIP_MEMORY_SCOPE_AGENT);
            __syncthreads();
            const int q = *tslot;
            __syncthreads();
            if (q >= 4160) break;
            item = q < 3520 ? q : q + 1024;
        }
        if (item < 4544) {
            const float* src; int ld, K, c0, ncols, nN; bf16_t* dst; int t = item;
            if (t < 1024) { src = p.in[8] + (size_t)l * 1024 * 6928; ld = 6928; K = 1024; c0 = 0; ncols = 3856; nN = 64; dst = W + W_MIX / 2; }
            else if (t < 1792) { t -= 1024; src = p.in[8] + (size_t)l * 1024 * 6928; ld = 6928; K = 1024; c0 = 3856; ncols = 3072; nN = 48; dst = W + W_GATE / 2; }
            else if (t < 1856) { t -= 1792; src = p.in[17] + (size_t)l * 512 * 512; ld = 512; K = 512; c0 = 0; ncols = 512; nN = 8; dst = W + W_GLU / 2; }
            else if (t < 1984) { t -= 1856; src = p.in[35] + (size_t)l * 512 * 1024; ld = 1024; K = 512; c0 = 0; ncols = 1024; nN = 16; dst = W + W_PA / 2; }
            else if (t < 2112) { t -= 1984; src = p.in[36] + (size_t)l * 512 * 1024; ld = 1024; K = 512; c0 = 0; ncols = 1024; nN = 16; dst = W + W_PB / 2; }
            else if (t < 2240) { t -= 2112; src = p.in[37] + (size_t)l * 512 * 1024; ld = 1024; K = 512; c0 = 0; ncols = 1024; nN = 16; dst = W + W_PC / 2; }
            else if (t < 2496) { t -= 2240; src = p.in[38] + (size_t)l * 1024 * 1024; ld = 1024; K = 1024; c0 = 0; ncols = 1024; nN = 16; dst = W + W_OUT / 2; }
            else if (t < 3520) { t -= 2496; src = p.in[39] + (size_t)l * 1024 * 4096; ld = 4096; K = 1024; c0 = 0; ncols = 4096; nN = 64; dst = W + W_1 / 2; }
            else { t -= 3520; src = p.in[40] + (size_t)l * 4096 * 1024; ld = 1024; K = 4096; c0 = 0; ncols = 1024; nN = 16; dst = W + W_2 / 2; }
            const int nt = t % nN, kt = t / nN;
            wconv_tile(cx, src, ld, K, c0, ncols, dst, kt, nt, smf);
        } else {
            bf16_t* dst = W + W_LORA / 2;
#pragma unroll
            for (int q = 0; q < 2; ++q) {
                const int e = (item - 4544) * 1024 + q * 512 + tid; const int n = e >> 8, k = e & 255;
                float v = 0.f;
                if (n < 1024) { if (k < 64) v = p.in[26][(((size_t)l * 2 + (n >> 9)) * 64 + k) * 512 + (n & 511)]; }
                else if (n < 2048) { if (k >= 64 && k < 128) v = p.in[28][(((size_t)l * 2 + ((n - 1024) >> 9)) * 64 + (k - 64)) * 512 + (n & 511)]; }
                else { if (k >= 128) v = p.in[29][((size_t)l * 128 + (k - 128)) * 512 + (n - 2048)]; }
                dst[e] = f2bf(v);
            }
        }
    }
}

__device__ __forceinline__ void phase_s5_params() {
    CParams& p = KPL(); const Ctx cx = mkctx();
    for (int item = cx.bid; item < 32; item += cx.nb) {
        const int l = item >> 3;
        const int idx = (item & 7) * 512 + cx.tid;
        const int dir = idx >> 11, g = (idx >> 6) & 31;
        float* S5P = (float*)(p.ws + OFF_S5P) + (size_t)l * 147456;
        const size_t pi = (size_t)l * 4096 + idx;
        const double lre = fmin((double)p.in[9][pi], -1e-4), lim = (double)p.in[10][pi];
        const double dt = dexp_neg((double)p.in[11][(l * 2 + dir) * 32 + g]);
        const double mag = dexp_neg(lre * dt); double sn, cs; dsincos(lim * dt, sn, cs);
        const double ar = mag * cs, ai = mag * sn;
        const double den = lre * lre + lim * lim, nr = ar - 1.0;
        const double cr = (nr * lre + ai * lim) / den, ci = (ai * lre - nr * lim) / den;
        const double mag64 = dexp_neg(64.0 * lre * dt); dsincos(64.0 * lim * dt, sn, cs);
        S5P[idx] = (float)ar; S5P[4096 + idx] = (float)ai; S5P[8192 + idx] = (float)(mag64 * cs); S5P[12288 + idx] = (float)(mag64 * sn);
        float* BR = S5P + 16384; float* BI = BR + 65536;
        for (int c = 0; c < 16; ++c) { const double bre = p.in[12][pi * 16 + c], bim = p.in[13][pi * 16 + c];
            BR[(size_t)idx * 16 + c] = (float)(cr * bre - ci * bim); BI[(size_t)idx * 16 + c] = (float)(cr * bim + ci * bre); }
    }
}

__device__ __forceinline__ void phase_norm(int l, int which, bool init) {
    CParams& p = KPL(); const Ctx cx = mkctx();
    const int lane = cx.tid & 63, gw = cx.bid * 8 + (cx.tid >> 6), nw = cx.nb * 8;
    float* X = (float*)(p.ws + OFF_X); bf16_t* H = (bf16_t*)(p.ws + OFF_H);
    const float* MODL = (const float*)(p.ws + OFF_MOD) + (size_t)l * 3 * 6144;
    const float* gam = p.in[which ? 7 : 6] + l * 1024;
    for (int row = gw; row < T_TOK; row += nw) {
        const int b = row >= SEQA ? 1 : 0, t = row - b * SEQA;
        const float* src = init ? (t < NCTX ? p.in[2] + ((size_t)b * NCTX + t) * 1024 : p.in[0] + ((size_t)b * 8192 + (t - NCTX)) * 1024) : X + (size_t)row * 1024;
        f32x4 v[4]; float ss = 0.f;
#pragma unroll
        for (int i = 0; i < 4; ++i) { v[i] = *(const f32x4*)(src + (lane + 64 * i) * 4); ss += v[i][0] * v[i][0] + v[i][1] * v[i][1] + v[i][2] * v[i][2] + v[i][3] * v[i][3]; }
        if (init) {
#pragma unroll
            for (int i = 0; i < 4; ++i) *(f32x4*)(X + (size_t)row * 1024 + (lane + 64 * i) * 4) = v[i];
        }
        ss = wave_sum(ss);
        const float inv = rsqrtf(ss * (1.f / 1024.f) + 1e-6f);
        const float* mv = MODL + (t < NCTX ? 2 : b) * 6144 + (which ? 3 : 0) * 1024;
#pragma unroll
        for (int i = 0; i < 4; ++i) { const int c = (lane + 64 * i) * 4;
            const f32x4 g4 = *(const f32x4*)(gam + c), sh = *(const f32x4*)(mv + c), scl = *(const f32x4*)(mv + 1024 + c);
            f32x4 o;
#pragma unroll
            for (int e = 0; e < 4; ++e) o[e] = v[i][e] * inv * g4[e] * (1.f + scl[e]) + sh[e];
            store4bf(H + (size_t)row * 1024 + c, o); }
    }
}

__device__ __forceinline__ int s5_order(int dir, int i) { return dir == 0 ? i : (i < 4 ? 3 - i : 135 - i); }

__device__ __forceinline__ void phase_s5_local(int l) {
    CParams& p = KPL(); const Ctx cx = mkctx();
    const int lane = cx.tid & 63, gw = cx.bid * 8 + (cx.tid >> 6), nw = cx.nb * 8;
    const bf16_t* ZA = (const bf16_t*)(p.ws + OFF_Z);
    const float* S5P = (const float*)(p.ws + OFF_S5P) + (size_t)l * 147456; const float* BR = S5P + 16384; const float* BI = BR + 65536;
    float* ST = (float*)(p.ws + OFF_S5ST);
    for (int item0 = gw; item0 < 16896; item0 += nw) {
        const int item = __builtin_amdgcn_readfirstlane(item0);
        const int chunk = item % 132, g = (item / 132) & 31, dir = (item / 4224) & 1, b = item / 8448;
        const int idx = dir * 2048 + g * 64 + lane;
        const float ar = S5P[idx], ai = S5P[4096 + idx];
        float br[16], bi[16];
#pragma unroll
        for (int q = 0; q < 4; ++q) { const f32x4 t0 = *(const f32x4*)(BR + (size_t)idx * 16 + q * 4), t1 = *(const f32x4*)(BI + (size_t)idx * 16 + q * 4);
#pragma unroll
            for (int e = 0; e < 4; ++e) { br[q * 4 + e] = t0[e]; bi[q * 4 + e] = t1[e]; } }
        const int row = b * SEQA + chunk * 64 + lane;
        const u32x4 u0 = *(const u32x4*)(ZA + (size_t)row * 2048 + g * 16), u1 = *(const u32x4*)(ZA + (size_t)row * 2048 + g * 16 + 8);
        unsigned ur[8] = {u0.x, u0.y, u0.z, u0.w, u1.x, u1.y, u1.z, u1.w};
        float hr = 0.f, hi = 0.f;
#pragma unroll 8
        for (int j = 0; j < 64; ++j) {
            const int tok = dir ? 63 - j : j;
            float bur = 0.f, bui = 0.f;
#pragma unroll
            for (int q = 0; q < 8; ++q) { const unsigned w = (unsigned)__builtin_amdgcn_readlane((int)ur[q], tok); const float x0 = bflo(w), x1 = bfhi(w);
                bur += br[2 * q] * x0 + br[2 * q + 1] * x1; bui += bi[2 * q] * x0 + bi[2 * q + 1] * x1; }
            const float nr = ar * hr - ai * hi + bur, ni = ar * hi + ai * hr + bui; hr = nr; hi = ni;
        }
        float* st = ST + ((((size_t)b * 2 + dir) * 32 + g) * 132 + chunk) * 128;
        st[lane] = hr; st[64 + lane] = hi;
    }
}

__device__ __forceinline__ void phase_s5_carry(int l) {
    CParams& p = KPL(); const Ctx cx = mkctx();
    const int lane = cx.tid & 63, gw = cx.bid * 8 + (cx.tid >> 6), nw = cx.nb * 8;
    const float* S5P = (const float*)(p.ws + OFF_S5P) + (size_t)l * 147456;
    float* ST = (float*)(p.ws + OFF_S5ST);
    for (int item0 = gw; item0 < 128; item0 += nw) {
        const int item = __builtin_amdgcn_readfirstlane(item0);
        const int g = item & 31, dir = (item >> 5) & 1, b = item >> 6;
        const int idx = dir * 2048 + g * 64 + lane;
        const float ar = S5P[8192 + idx], ai = S5P[12288 + idx];
        float* st = ST + (((size_t)b * 2 + dir) * 32 + g) * 132 * 128;
        float hr = 0.f, hi = 0.f;
        for (int i0 = 0; i0 < 132; i0 += 12) {
            float lr[12], li[12];
#pragma unroll
            for (int e = 0; e < 12; ++e) { const int c = s5_order(dir, i0 + e); lr[e] = st[c * 128 + lane]; li[e] = st[c * 128 + 64 + lane]; }
#pragma unroll
            for (int e = 0; e < 12; ++e) { const int c = s5_order(dir, i0 + e); st[c * 128 + lane] = hr; st[c * 128 + 64 + lane] = hi;
                const float nr = ar * hr - ai * hi + lr[e], ni = ar * hi + ai * hr + li[e]; hr = nr; hi = ni; }
        }
    }
}

template <int DIR>
__device__ __forceinline__ void s5_final_dir(CParams& p, int l, int b, int g, int chunk, int lane, const unsigned (&ur)[8], float* hst, f32x4* ybuf, int row0, float dsk, bf16_t* ZG) {
    const float* S5P = (const float*)(p.ws + OFF_S5P) + (size_t)l * 147456; const float* BR = S5P + 16384; const float* BI = BR + 65536;
    const float* ST = (const float*)(p.ws + OFF_S5ST);
    const bf16_t* ZA = (const bf16_t*)(p.ws + OFF_Z);
    const int idx = DIR * 2048 + g * 64 + lane;
    const float ar = S5P[idx], ai = S5P[4096 + idx];
    float br[16], bi[16];
#pragma unroll
    for (int q = 0; q < 4; ++q) { const f32x4 t0 = *(const f32x4*)(BR + (size_t)idx * 16 + q * 4), t1 = *(const f32x4*)(BI + (size_t)idx * 16 + q * 4);
#pragma unroll
        for (int e = 0; e < 4; ++e) { br[q * 4 + e] = t0[e]; bi[q * 4 + e] = t1[e]; } }
    float cbr[16], cbi[16];
    { const size_t cb = ((((size_t)l * 2 + DIR) * 32 + g) * 16 + (lane & 15)) * 64 + (lane >> 4);
#pragma unroll
      for (int i = 0; i < 16; ++i) { cbr[i] = p.in[14][cb + 4 * i]; cbi[i] = -p.in[15][cb + 4 * i]; } }
    const float* st = ST + ((((size_t)b * 2 + DIR) * 32 + g) * 132 + chunk) * 128;
    float hr = st[lane], hi = st[64 + lane];
    const int ch = g * 16 + (lane & 15);
#pragma unroll 1
    for (int si = 0; si < 4; ++si) {
        const int sc = DIR ? 3 - si : si;
#pragma unroll
        for (int jj = 0; jj < 16; ++jj) {
            const int tt = DIR ? 15 - jj : jj; const int tok = sc * 16 + tt;
            float bur = 0.f, bui = 0.f;
#pragma unroll
            for (int q = 0; q < 8; ++q) { const unsigned w = (unsigned)__builtin_amdgcn_readlane((int)ur[q], tok); const float x0 = bflo(w), x1 = bfhi(w);
                bur += br[2 * q] * x0 + br[2 * q + 1] * x1; bui += bi[2 * q] * x0 + bi[2 * q + 1] * x1; }
            const float nr = ar * hr - ai * hi + bur, ni = ar * hi + ai * hr + bui; hr = nr; hi = ni;
            hst[tt * 68 + lane] = hr; hst[1088 + tt * 68 + lane] = hi;
        }
        f32x4 a = (f32x4){0.f, 0.f, 0.f, 0.f};
        if (DIR) a = ybuf[sc * 64 + lane];
#pragma unroll
        for (int i = 0; i < 16; ++i) {
            const float xr = hst[(lane & 15) * 68 + 4 * i + (lane >> 4)], xi = hst[1088 + (lane & 15) * 68 + 4 * i + (lane >> 4)];
            a = __builtin_amdgcn_mfma_f32_16x16x4f32(xr, cbr[i], a, 0, 0, 0);
            a = __builtin_amdgcn_mfma_f32_16x16x4f32(xi, cbi[i], a, 0, 0, 0);
        }
        if (!DIR) ybuf[sc * 64 + lane] = a;
        else {
#pragma unroll
            for (int j = 0; j < 4; ++j) {
                const int row = row0 + sc * 16 + (lane >> 4) * 4 + j;
                const float u = bf2f(ZA[(size_t)row * 2048 + ch]);
                const float y = u * dsk + a[j];
                const float z = 0.5f * y * (1.f + tanhf(0.7978845608028654f * (y + 0.044715f * y * y * y)));
                ZG[(size_t)row * 512 + ch] = f2bf(z);
            }
        }
    }
}

__device__ __forceinline__ void phase_s5_final(int l, float* smf) {
    CParams& p = KPL(); const Ctx cx = mkctx();
    const int nscan = cx.nb >= 2 ? cx.nb / 2 : 0;
    if (cx.bid < nscan) return;
    const int lane = cx.tid & 63, wid = cx.tid >> 6, gw = (cx.bid - nscan) * 8 + wid, nw = (cx.nb - nscan) * 8;
    const bf16_t* ZA = (const bf16_t*)(p.ws + OFF_Z);
    bf16_t* ZG = (bf16_t*)(p.ws + OFF_ZG);
    float* hst = smf + wid * 3200;
    f32x4* ybuf = (f32x4*)(hst + 2176);
    for (int item0 = gw; item0 < 8448; item0 += nw) {
        const int item = __builtin_amdgcn_readfirstlane(item0);
        const int chunk = item % 132, g = (item / 132) & 31, b = item / 4224;
        const int row0 = b * SEQA + chunk * 64;
        const u32x4 u0 = *(const u32x4*)(ZA + (size_t)(row0 + lane) * 2048 + g * 16), u1 = *(const u32x4*)(ZA + (size_t)(row0 + lane) * 2048 + g * 16 + 8);
        const unsigned ur[8] = {u0.x, u0.y, u0.z, u0.w, u1.x, u1.y, u1.z, u1.w};
        const float dsk = p.in[16][l * 512 + g * 16 + (lane & 15)];
        s5_final_dir<0>(p, l, b, g, chunk, lane, ur, hst, ybuf, row0, dsk, ZG);
        s5_final_dir<1>(p, l, b, g, chunk, lane, ur, hst, ybuf, row0, dsk, ZG);
    }
}

__device__ __forceinline__ int ml_row0(int b, int nc) { return b * SEQA + nc * 128; }
__device__ __forceinline__ int ml_order(int dir, int i) { return dir == 0 ? i : (i < 2 ? 1 - i : 67 - i); }

__device__ __forceinline__ void phase_ml_conv(int l) {
    CParams& p = KPL(); const Ctx cx = mkctx();
    const bf16_t* ZA = (const bf16_t*)(p.ws + OFF_Z);
    bf16_t* QKC = (bf16_t*)(p.ws + OFF_QKC);
    const float* cw = p.in[19] + (size_t)l * 9 * 512; const float* cb = p.in[20] + l * 512;
    for (int idx = cx.bid * 512 + cx.tid; idx < T_TOK * 64; idx += cx.nb * 512) {
        const int row = idx >> 6, c8 = (idx & 63) * 8;
        const int b = row >= SEQA ? 1 : 0, t = row - b * SEQA;
        const bool isctx = t < NCTX;
        const int tt = isctx ? t : t - NCTX, W = isctx ? 256 : 64, Hh = isctx ? 1 : 128;
        const int y = tt / W, x = tt % W;
        const int segrow0 = row - tt;
        float acc[8];
#pragma unroll
        for (int e = 0; e < 8; ++e) acc[e] = cb[c8 + e];
#pragma unroll
        for (int dy = 0; dy < 3; ++dy)
#pragma unroll
            for (int dx = 0; dx < 3; ++dx) {
                const int yy = y + dy - 1, xx = x + dx - 1;
                if (yy >= 0 && yy < Hh && xx >= 0 && xx < W) {
                    const u32x4 z = *(const u32x4*)(ZA + (size_t)(segrow0 + yy * W + xx) * 2048 + 512 + c8);
                    const float* w = cw + (dy * 3 + dx) * 512 + c8;
                    const f32x4 w0 = *(const f32x4*)w, w1 = *(const f32x4*)(w + 4);
                    acc[0] += bflo(z.x) * w0[0]; acc[1] += bfhi(z.x) * w0[1]; acc[2] += bflo(z.y) * w0[2]; acc[3] += bfhi(z.y) * w0[3];
                    acc[4] += bflo(z.z) * w1[0]; acc[5] += bfhi(z.z) * w1[1]; acc[6] += bflo(z.w) * w1[2]; acc[7] += bfhi(z.w) * w1[3];
                }
            }
        u32x4 o;
#pragma unroll
        for (int e = 0; e < 8; ++e) acc[e] = acc[e] * sigmoidf_(acc[e]);
        o.x = pk2(acc[0], acc[1]); o.y = pk2(acc[2], acc[3]); o.z = pk2(acc[4], acc[5]); o.w = pk2(acc[6], acc[7]);
        *(u32x4*)(QKC + (size_t)row * 512 + c8) = o;
    }
}

constexpr int ML_QS = 0, ML_KS = 18432, ML_VT = 36864, ML_CS = 71680, ML_PS = 92416, ML_GV = 127232, ML_BV = 127744, ML_MV = 128256, ML_LF = 128768, ML_IG = 129280, ML_SC = 129792;

__device__ __forceinline__ void ml_gate_vectors(const Ctx& cx, CParams& p, int l, int dir, int b, int h, int nc, unsigned char* sm, float m_in) {
    const int tid = cx.tid, lane = tid & 63;
    float* lf = (float*)(sm + ML_LF); float* ig = (float*)(sm + ML_IG); float* gv = (float*)(sm + ML_GV); float* bv = (float*)(sm + ML_BV); float* mv = (float*)(sm + ML_MV); float* sc = (float*)(sm + ML_SC);
    const float* MLG = (const float*)(p.ws + OFF_MLG);
    const float* gb = p.in[21] + l * 16;
    if (tid < 128) {
        const int row = ml_row0(b, nc) + tid;
        const float ip = MLG[(size_t)row * 16 + dir * 4 + h] + gb[dir * 4 + h];
        const float fp = MLG[(size_t)row * 16 + 8 + dir * 4 + h] + gb[8 + dir * 4 + h];
        ig[tid] = ip; lf[tid] = fminf(fp, 0.f) - log1pf(expf(-fabsf(fp)));
    }
    __syncthreads();
    if (tid < 64) {
        const int pp0 = 2 * lane, pp1 = 2 * lane + 1; const int s0 = dir ? 127 - pp0 : pp0, s1 = dir ? 127 - pp1 : pp1;
        const float x0 = lf[s0], x1 = lf[s1];
        float incl = x0 + x1;
#pragma unroll
        for (int d = 1; d < 64; d <<= 1) { const float t = __shfl_up(incl, d); if (lane >= d) incl += t; }
        const float g1 = incl, g0 = incl - x1;
        const float gtot = __shfl(incl, 63);
        const float b0 = ig[s0] - g0, b1 = ig[s1] - g1;
        float mx = fmaxf(b0, b1);
#pragma unroll
        for (int d = 1; d < 64; d <<= 1) { const float t = __shfl_up(mx, d); if (lane >= d) mx = fmaxf(mx, t); }
        const float prev = __shfl_up(mx, 1);
        const float pm0 = lane > 0 ? fmaxf(prev, b0) : b0, pm1 = mx;
        const float bmax = __shfl(mx, 63);
        gv[s0] = g0; gv[s1] = g1; bv[s0] = b0; bv[s1] = b1; mv[s0] = fmaxf(m_in, pm0); mv[s1] = fmaxf(m_in, pm1);
        if (lane == 0) { sc[0] = gtot; sc[1] = bmax; }
    }
    __syncthreads();
}

__device__ __forceinline__ void phase_ml_local(int l, unsigned char* sm) {
    CParams& p = KPL(); const Ctx cx = mkctx();
    const int tid = cx.tid, lane = tid & 63, wid = tid >> 6;
    const bf16_t* ZA = (const bf16_t*)(p.ws + OFF_Z); const bf16_t* QKC = (const bf16_t*)(p.ws + OFF_QKC);
    float* CLOC = (float*)(p.ws + OFF_CLOC); float* MLS = (float*)(p.ws + OFF_MLS);
    bf16_t* VT = (bf16_t*)(sm + ML_VT); bf16_t* KT = (bf16_t*)(sm + ML_KS);
    const float* bv = (const float*)(sm + ML_BV); const float* sc = (const float*)(sm + ML_SC);
    float* wg = (float*)(sm + ML_LF);
    unsigned* ticket = (unsigned*)(p.ws + OFF_BAR) + 3600 + l * 16;
    int* tslot = (int*)(sm + 143328);
    for (;;) {
        if (tid == 0) *tslot = (int)__hip_atomic_fetch_add(ticket, 1u, __ATOMIC_RELAXED, __HIP_MEMORY_SCOPE_AGENT);
        __syncthreads();
        const int item = *tslot;
        __syncthreads();
        if (item >= 1056) break;
        const int chain = item / 66, nc = item % 66; const int dir = chain >> 3, b = (chain >> 2) & 1, h = chain & 3;
        ml_gate_vectors(cx, p, l, dir, b, h, nc, sm, -1e30f);
        const float gtot = sc[0], bmax = sc[1];
        __syncthreads();
        if (tid < 128) wg[tid] = expf(bv[tid] - bmax);
        __syncthreads();
        const int row0 = ml_row0(b, nc);
#pragma unroll
        for (int q = 0; q < 4; ++q) { const int ci = q * 512 + tid; const int s = ci >> 4, v8 = (ci & 15) * 8;
            const u32x4 z = *(const u32x4*)(ZA + (size_t)(row0 + s) * 2048 + 1024 + h * 128 + v8); const float w = wg[s];
            const unsigned zz[4] = {z.x, z.y, z.z, z.w};
#pragma unroll
            for (int e = 0; e < 4; ++e) { VT[(v8 + 2 * e) * 136 + s] = f2bf(bflo(zz[e]) * w); VT[(v8 + 2 * e + 1) * 136 + s] = f2bf(bfhi(zz[e]) * w); } }
#pragma unroll
        for (int q = 0; q < 2; ++q) { const int ci = q * 512 + tid; const int s = ci >> 3, k8 = (ci & 7) * 8;
            const u32x4 z = *(const u32x4*)(QKC + (size_t)(row0 + s) * 512 + 256 + h * 64 + k8);
            const unsigned zz[4] = {z.x, z.y, z.z, z.w};
#pragma unroll
            for (int e = 0; e < 4; ++e) { KT[(k8 + 2 * e) * 136 + s] = (bf16_t)(zz[e] & 0xffff); KT[(k8 + 2 * e + 1) * 136 + s] = (bf16_t)(zz[e] >> 16); } }
        __syncthreads();
        float* dst = CLOC + ((size_t)chain * 66 + nc) * 8256;
        f32x4 acc[4];
#pragma unroll
        for (int n = 0; n < 4; ++n) acc[n] = (f32x4){0.f, 0.f, 0.f, 0.f};
#pragma unroll
        for (int ks = 0; ks < 4; ++ks) {
            const bf16x8 a = *(const bf16x8*)(VT + (16 * wid + (lane & 15)) * 136 + ks * 32 + (lane >> 4) * 8);
#pragma unroll
            for (int n = 0; n < 4; ++n) { const bf16x8 bb = *(const bf16x8*)(KT + (16 * n + (lane & 15)) * 136 + ks * 32 + (lane >> 4) * 8);
                acc[n] = __builtin_amdgcn_mfma_f32_16x16x32_bf16(a, bb, acc[n], 0, 0, 0); }
        }
#pragma unroll
        for (int n = 0; n < 4; ++n)
#pragma unroll
            for (int j = 0; j < 4; ++j) dst[(16 * wid + (lane >> 4) * 4 + j) * 64 + 16 * n + (lane & 15)] = acc[n][j];
        if (tid < 64) { float s0 = 0.f, s1 = 0.f, s2 = 0.f, s3 = 0.f;
#pragma unroll 4
            for (int t = 0; t < 128; t += 4) { const u32x2 kq = *(const u32x2*)(KT + tid * 136 + t); const f32x4 w4 = *(const f32x4*)(wg + t);
                s0 += w4[0] * bflo(kq.x); s1 += w4[1] * bfhi(kq.x); s2 += w4[2] * bflo(kq.y); s3 += w4[3] * bfhi(kq.y); }
            dst[8192 + tid] = (s0 + s1) + (s2 + s3); }
        if (tid == 0) { MLS[chain * 66 + nc] = gtot; MLS[1056 + chain * 66 + nc] = gtot + bmax; }
        __syncthreads();
    }
}

__device__ __forceinline__ void phase_ml_carry() {
    CParams& p = KPL(); const Ctx cx = mkctx();
    float* CLOC = (float*)(p.ws + OFF_CLOC); float* MLS = (float*)(p.ws + OFF_MLS);
    for (int idx = cx.bid * 512 + cx.tid; idx < 16 * 8192; idx += cx.nb * 512) {
        const int chain = idx >> 13, e = idx & 8191; const int dir = chain >> 3;
        const bool two = e < 64;
        float* base = CLOC + (size_t)chain * 66 * 8256 + e;
        const float* gtp = MLS + chain * 66; const float* amp = MLS + 1056 + chain * 66;
        float m = -1e30f, C = 0.f, N = 0.f;
        for (int i0 = 0; i0 < 66; i0 += 11) {
            float cl[11], nl[11], gt[11], am[11];
#pragma unroll
            for (int q = 0; q < 11; ++q) { const int nc = ml_order(dir, i0 + q); cl[q] = base[(size_t)nc * 8256]; nl[q] = two ? base[(size_t)nc * 8256 + 8192] : 0.f; gt[q] = gtp[nc]; am[q] = amp[nc]; }
#pragma unroll
            for (int q = 0; q < 11; ++q) { const int nc = ml_order(dir, i0 + q);
                base[(size_t)nc * 8256] = C;
                if (two) base[(size_t)nc * 8256 + 8192] = N;
                if (e == 0) MLS[2112 + chain * 66 + nc] = m;
                const float mn = fmaxf(gt[q] + m, am[q]); const float so = __expf(gt[q] + m - mn), sl = __expf(am[q] - mn);
                C = so * C + sl * cl[q]; N = so * N + sl * nl[q]; m = mn; }
        }
    }
}

__device__ __forceinline__ void phase_ml_out(int l, unsigned char* sm) {
    CParams& p = KPL(); const Ctx cx = mkctx();
    const int tid = cx.tid, lane = tid & 63, wid = tid >> 6;
    const bf16_t* ZA = (const bf16_t*)(p.ws + OFF_Z); const bf16_t* QKC = (const bf16_t*)(p.ws + OFF_QKC);
    const float* CLOC = (const float*)(p.ws + OFF_CLOC); const float* MLS = (const float*)(p.ws + OFF_MLS);
    bf16_t* YB = (bf16_t*)(p.ws + OFF_YB);
    bf16_t* QS = (bf16_t*)(sm + ML_QS); bf16_t* KS = (bf16_t*)(sm + ML_KS); bf16_t* VT = (bf16_t*)(sm + ML_VT); bf16_t* CS = (bf16_t*)(sm + ML_CS); bf16_t* PS = (bf16_t*)(sm + ML_PS);
    const float* gv = (const float*)(sm + ML_GV); const float* bv = (const float*)(sm + ML_BV); const float* mv = (const float*)(sm + ML_MV);
    unsigned* ticket = (unsigned*)(p.ws + OFF_BAR) + 3608 + l * 16;
    int* tslot = (int*)(sm + 143328);
    for (;;) {
        if (tid == 0) *tslot = (int)__hip_atomic_fetch_add(ticket, 1u, __ATOMIC_RELAXED, __HIP_MEMORY_SCOPE_AGENT);
        __syncthreads();
        const int item = *tslot;
        __syncthreads();
        if (item >= 528) break;
        const int b = item / 264, h = (item / 66) & 3, nc = item % 66;
        const int row0 = ml_row0(b, nc);
        __syncthreads();
#pragma unroll
        for (int q = 0; q < 2; ++q) { const int ci = q * 512 + tid; const int s = ci >> 3, k8 = (ci & 7) * 8;
            const u32x4 zq = *(const u32x4*)(QKC + (size_t)(row0 + s) * 512 + h * 64 + k8);
            u32x4 o; o.x = pk2(bflo(zq.x) * 0.125f, bfhi(zq.x) * 0.125f); o.y = pk2(bflo(zq.y) * 0.125f, bfhi(zq.y) * 0.125f); o.z = pk2(bflo(zq.z) * 0.125f, bfhi(zq.z) * 0.125f); o.w = pk2(bflo(zq.w) * 0.125f, bfhi(zq.w) * 0.125f);
            *(u32x4*)(QS + s * 72 + k8) = o;
            *(u32x4*)(KS + s * 72 + k8) = *(const u32x4*)(QKC + (size_t)(row0 + s) * 512 + 256 + h * 64 + k8); }
#pragma unroll
        for (int q = 0; q < 4; ++q) { const int ci = q * 512 + tid; const int s = ci >> 4, v8 = (ci & 15) * 8;
            const u32x4 z = *(const u32x4*)(ZA + (size_t)(row0 + s) * 2048 + 1024 + h * 128 + v8);
            const unsigned zz[4] = {z.x, z.y, z.z, z.w};
#pragma unroll
            for (int e = 0; e < 4; ++e) { VT[(v8 + 2 * e) * 136 + s] = (bf16_t)(zz[e] & 0xffff); VT[(v8 + 2 * e + 1) * 136 + s] = (bf16_t)(zz[e] >> 16); } }
        f32x4 hsum[8];
#pragma unroll
        for (int v = 0; v < 8; ++v) hsum[v] = (f32x4){0.f, 0.f, 0.f, 0.f};
#pragma unroll 1
        for (int dir = 0; dir < 2; ++dir) {
            const int chain = dir * 8 + b * 4 + h;
            const float m_in = MLS[2112 + chain * 66 + nc];
            __syncthreads();
            ml_gate_vectors(cx, p, l, dir, b, h, nc, sm, m_in);
            const float* cin = CLOC + ((size_t)chain * 66 + nc) * 8256;
#pragma unroll
            for (int q = 0; q < 4; ++q) { const int ci = q * 512 + tid; const int v = ci >> 4, k4 = (ci & 15) * 4;
                const f32x4 c = *(const f32x4*)(cin + v * 64 + k4); store4bf(CS + v * 72 + k4, c); }
            if (tid < 16) { const f32x4 c = *(const f32x4*)(cin + 8192 + tid * 4); store4bf(CS + 128 * 72 + tid * 4, c); }
            else if (tid < 256) { const int r = 129 + (tid - 16) / 16, k4 = ((tid - 16) & 15) * 4; store4bf(CS + r * 72 + k4, (f32x4){0.f, 0.f, 0.f, 0.f}); }
            __syncthreads();
            const int tr = 16 * wid + (lane >> 4) * 4;
            float Mt[4], rs[4] = {0.f, 0.f, 0.f, 0.f};
#pragma unroll
            for (int j = 0; j < 4; ++j) Mt[j] = mv[tr + j];
            bf16x8 qa[2];
#pragma unroll
            for (int ks = 0; ks < 2; ++ks) qa[ks] = *(const bf16x8*)(QS + (16 * wid + (lane & 15)) * 72 + ks * 32 + (lane >> 4) * 8);
#pragma unroll
            for (int nt = 0; nt < 8; ++nt) {
                f32x4 s4 = (f32x4){0.f, 0.f, 0.f, 0.f};
#pragma unroll
                for (int ks = 0; ks < 2; ++ks) { const bf16x8 kb = *(const bf16x8*)(KS + (16 * nt + (lane & 15)) * 72 + ks * 32 + (lane >> 4) * 8);
                    s4 = __builtin_amdgcn_mfma_f32_16x16x32_bf16(qa[ks], kb, s4, 0, 0, 0); }
                const int s = 16 * nt + (lane & 15); const float bs = bv[s];
#pragma unroll
                for (int j = 0; j < 4; ++j) { const int t = tr + j; const bool valid = dir ? (s >= t) : (s <= t);
                    const float pv = valid ? s4[j] * __expf(bs - Mt[j]) : 0.f; rs[j] += pv; PS[t * 136 + s] = f2bf(pv); }
            }
#pragma unroll
            for (int j = 0; j < 4; ++j) rs[j] = row16_sum(rs[j]);
            __syncthreads();
            f32x4 qn = (f32x4){0.f, 0.f, 0.f, 0.f};
#pragma unroll
            for (int ks = 0; ks < 2; ++ks) { const bf16x8 cb = *(const bf16x8*)(CS + (128 + (lane & 15)) * 72 + ks * 32 + (lane >> 4) * 8);
                qn = __builtin_amdgcn_mfma_f32_16x16x32_bf16(qa[ks], cb, qn, 0, 0, 0); }
            float wi[4], dn[4];
#pragma unroll
            for (int j = 0; j < 4; ++j) { const float qnj = row16_sum(qn[j]); wi[j] = expf(m_in - Mt[j]);
                const float den = rs[j] + wi[j] * qnj; const float mt = gv[tr + j] + Mt[j]; dn[j] = 1.f / fmaxf(fabsf(den), expf(-mt)); }
            bf16x8 pa[4];
#pragma unroll
            for (int ks = 0; ks < 4; ++ks) pa[ks] = *(const bf16x8*)(PS + (16 * wid + (lane & 15)) * 136 + ks * 32 + (lane >> 4) * 8);
#pragma unroll
            for (int vt = 0; vt < 8; ++vt) {
                f32x4 a1 = (f32x4){0.f, 0.f, 0.f, 0.f}, a2 = (f32x4){0.f, 0.f, 0.f, 0.f};
#pragma unroll
                for (int ks = 0; ks < 4; ++ks) { const bf16x8 vb = *(const bf16x8*)(VT + (16 * vt + (lane & 15)) * 136 + ks * 32 + (lane >> 4) * 8);
                    a1 = __builtin_amdgcn_mfma_f32_16x16x32_bf16(pa[ks], vb, a1, 0, 0, 0); }
#pragma unroll
                for (int ks = 0; ks < 2; ++ks) { const bf16x8 cb = *(const bf16x8*)(CS + (16 * vt + (lane & 15)) * 72 + ks * 32 + (lane >> 4) * 8);
                    a2 = __builtin_amdgcn_mfma_f32_16x16x32_bf16(qa[ks], cb, a2, 0, 0, 0); }
#pragma unroll
                for (int j = 0; j < 4; ++j) hsum[vt][j] += (a1[j] + wi[j] * a2[j]) * dn[j];
            }
        }
        const int tr = 16 * wid + (lane >> 4) * 4;
        float rinv[4];
#pragma unroll
        for (int j = 0; j < 4; ++j) { float ss = 0.f;
#pragma unroll
            for (int vt = 0; vt < 8; ++vt) ss += hsum[vt][j] * hsum[vt][j];
            ss = row16_sum(ss); rinv[j] = rsqrtf(ss * (1.f / 128.f) + 1e-6f); }
#pragma unroll
        for (int vt = 0; vt < 8; ++vt) { const int ch = h * 128 + 16 * vt + (lane & 15); const float ng = p.in[22][l * 512 + ch];
#pragma unroll
            for (int j = 0; j < 4; ++j) { const int row = row0 + tr + j;
                const float o = bf2f(ZA[(size_t)row * 2048 + 1536 + ch]);
                YB[(size_t)row * 512 + ch] = f2bf(hsum[vt][j] * rinv[j] * ng * sigmoidf_(o)); } }
    }
}

__device__ __forceinline__ void phase_rw_feat(int l) {
    CParams& p = KPL(); const Ctx cx = mkctx();
    const int lane = cx.tid & 63, gw = cx.bid * 8 + (cx.tid >> 6), nw = cx.nb * 8;
    const bf16_t* ZRW = (const bf16_t*)(p.ws + OFF_ZRW);
    bf16_t* F1 = (bf16_t*)(p.ws + OFF_F1); bf16_t* LIN = (bf16_t*)(p.ws + OFF_LORAIN);
    const float* mup = p.in[23] + (size_t)l * 1792; const float* mun = p.in[24] + (size_t)l * 1792;
    const float* kk_w = p.in[30] + l * 512;
    for (int row = gw; row < T_TOK; row += nw) {
        const int b = row >= SEQA ? 1 : 0, t = row - b * SEQA;
        const bool hasp = !(t == 0 || t == NCTX), hasn = !(t == NCTX - 1 || t == SEQA - 1);
        const bf16_t* zc = ZRW + (size_t)row * 1792;
#pragma unroll
        for (int q = 0; q < 3; ++q) {
            const int col = q * 512 + lane * 8;
            const u32x4 c4 = *(const u32x4*)(zc + col);
            u32x4 p4 = (u32x4){0u, 0u, 0u, 0u}, n4 = (u32x4){0u, 0u, 0u, 0u};
            if (hasp) p4 = *(const u32x4*)(zc - 1792 + col);
            if (hasn) n4 = *(const u32x4*)(zc + 1792 + col);
            const unsigned cc[4] = {c4.x, c4.y, c4.z, c4.w}, pp[4] = {p4.x, p4.y, p4.z, p4.w}, nn[4] = {n4.x, n4.y, n4.z, n4.w};
            float zs[8];
#pragma unroll
            for (int e = 0; e < 8; ++e) { const float z = (e & 1) ? bfhi(cc[e >> 1]) : bflo(cc[e >> 1]); const float pv = (e & 1) ? bfhi(pp[e >> 1]) : bflo(pp[e >> 1]); const float nx = (e & 1) ? bfhi(nn[e >> 1]) : bflo(nn[e >> 1]);
                zs[e] = z + mup[col + e] * (pv - z) + mun[col + e] * (nx - z); }
            u32x4 o; o.x = pk2(zs[0], zs[1]); o.y = pk2(zs[2], zs[3]); o.z = pk2(zs[4], zs[5]); o.w = pk2(zs[6], zs[7]);
            *(u32x4*)(F1 + (size_t)row * 2048 + q * 512 + lane * 8) = o;
            if (q == 1) {
                float kr[8], ssq = 0.f;
#pragma unroll
                for (int e = 0; e < 8; ++e) { kr[e] = zs[e] * kk_w[lane * 8 + e]; ssq += kr[e] * kr[e]; }
                ssq = row8_sum(ssq);
                const float inv = 1.f / fmaxf(sqrtf(ssq), 1e-12f);
                u32x4 o2; o2.x = pk2(kr[0] * inv, kr[1] * inv); o2.y = pk2(kr[2] * inv, kr[3] * inv); o2.z = pk2(kr[4] * inv, kr[5] * inv); o2.w = pk2(kr[6] * inv, kr[7] * inv);
                *(u32x4*)(F1 + (size_t)row * 2048 + 1536 + lane * 8) = o2;
            }
        }
        {
            const int col = 1536 + lane * 4;
            const u32x2 c2 = *(const u32x2*)(zc + col);
            u32x2 p2 = (u32x2){0u, 0u}, n2 = (u32x2){0u, 0u};
            if (hasp) p2 = *(const u32x2*)(zc - 1792 + col);
            if (hasn) n2 = *(const u32x2*)(zc + 1792 + col);
            const unsigned cc[2] = {c2.x, c2.y}, pp[2] = {p2.x, p2.y}, nn[2] = {n2.x, n2.y};
            float zs[4];
#pragma unroll
            for (int e = 0; e < 4; ++e) { const float z = (e & 1) ? bfhi(cc[e >> 1]) : bflo(cc[e >> 1]); const float pv = (e & 1) ? bfhi(pp[e >> 1]) : bflo(pp[e >> 1]); const float nx = (e & 1) ? bfhi(nn[e >> 1]) : bflo(nn[e >> 1]);
                const float s = z + mup[col + e] * (pv - z) + mun[col + e] * (nx - z);
                zs[e] = lane < 16 ? tanhf(s) : (lane < 32 ? s : sigmoidf_(s)); }
            u32x2 o; o.x = pk2(zs[0], zs[1]); o.y = pk2(zs[2], zs[3]);
            *(u32x2*)(LIN + (size_t)row * 256 + lane * 4) = o;
        }
    }
}

__device__ __forceinline__ int rw_tok(int dir, int i) { return dir == 0 ? i : (i < NCTX ? NCTX - 1 - i : 8703 - i); }

typedef float f32x2 __attribute__((ext_vector_type(2)));
constexpr int RW_REC = 384;
__device__ __forceinline__ void rw_load(const bf16_t* f1, const bf16_t* f2, const bf16_t* fu, int ustr, int dir, int rg, int c, int pw, int lane, bf16_t (&in)[8][5], bf16_t (&vin)[8]) {
#pragma unroll
    for (int q = 0; q < 8; ++q) { const size_t t = (size_t)rw_tok(dir, c * 32 + pw * 8 + q);
        in[q][0] = f1[t * 2048 + lane]; in[q][1] = f1[t * 2048 + 512 + lane]; in[q][2] = f1[t * 2048 + 1536 + lane]; in[q][3] = fu[t * ustr + lane]; in[q][4] = f2[t * 2048 + 1024 + lane];
        vin[q] = f1[t * 2048 + 1024 + rg * 16 + (lane & 15)]; }
}
__device__ __forceinline__ void rw_emit(const bf16_t (&in)[8][5], const bf16_t (&vin)[8], int pw, int lane, float ka, float* buf) {
#pragma unroll
    for (int q = 0; q < 8; ++q) {
        const float r = bf2f(in[q][0]), k = bf2f(in[q][1]), kk = bf2f(in[q][2]), u = bf2f(in[q][3]), a = bf2f(in[q][4]);
        const float w = 1.f - u, key = k * (1.f + (a - 1.f) * ka), kka = kk * a, wr = w * r;
        const float c1 = wave_sum(kka * r), c2 = wave_sum(key * r);
        float* rec = buf + (pw * 8 + q) * RW_REC;
        rec[lane] = kk; rec[64 + lane] = wr; rec[128 + lane] = w; rec[192 + lane] = kka; rec[256 + lane] = key;
        if (lane < 16) { f32x4 vc; vc[0] = bf2f(vin[q]); vc[1] = c1; vc[2] = c2; vc[3] = 0.f; *(f32x4*)(rec + 320 + lane * 4) = vc; }
    }
}

__device__ __forceinline__ void phase_rw_scan(int l, unsigned char* sm) {
    CParams& p = KPL(); const Ctx cx = mkctx();
    const int tid = cx.tid, lane = tid & 63, wid = __builtin_amdgcn_readfirstlane(tid >> 6);
    const bf16_t* F1 = (const bf16_t*)(p.ws + OFF_F1); const bf16_t* F2 = (const bf16_t*)(p.ws + OFF_Z);
    bf16_t* YRAW = (bf16_t*)(p.ws + OFF_R2);
    float* ring = (float*)sm;
    const bool is_scan = wid < 4, is_prod = wid >= 4;
    const int pw = wid & 3;
    const int nscan = cx.nb >= 2 ? cx.nb / 2 : 1;
    if (cx.bid >= nscan) return;
    for (int item = cx.bid; item < 128; item += nscan) {
        const int chain = item >> 2, rg = item & 3; const int dir = chain >> 4, b = (chain >> 3) & 1, h = chain & 7;
        const float ka = p.in[31][l * 512 + h * 64 + lane];
        const bf16_t* f1 = F1 + (size_t)b * SEQA * 2048 + h * 64; const bf16_t* f2 = F2 + (size_t)b * SEQA * 2048 + dir * 512 + h * 64;
        const int ustr = dir ? 2048 : 512;
        const bf16_t* fu = dir ? f2 : (const bf16_t*)(p.ws + OFF_U0) + (size_t)b * SEQA * 512 + h * 64;
        const int row = rg * 16 + (wid & 3) * 4 + (lane >> 4);
        bf16_t* yr = YRAW + ((size_t)dir * T_TOK + (size_t)b * SEQA) * 512 + h * 64 + row;
        bf16_t pin[8][5], pvin[8];
        __syncthreads();
        if (is_prod) { rw_load(f1, f2, fu, ustr, dir, rg, 0, pw, lane, pin, pvin); rw_emit(pin, pvin, pw, lane, ka, ring); rw_load(f1, f2, fu, ustr, dir, rg, 1, pw, lane, pin, pvin); }
        __syncthreads();
        f32x2 S01 = (f32x2){0.f, 0.f}, S23 = (f32x2){0.f, 0.f};
        if (is_scan) __builtin_amdgcn_s_setprio(3);
#pragma unroll 1
        for (int c = 0; c < 264; ++c) {
            float* buf = ring + (c & 1) * (32 * RW_REC);
            if (is_prod) { if (c + 1 < 264) { rw_emit(pin, pvin, pw, lane, ka, ring + ((c + 1) & 1) * (32 * RW_REC)); rw_load(f1, f2, fu, ustr, dir, rg, c + 2 < 264 ? c + 2 : c + 1, pw, lane, pin, pvin); } }
            else if (is_scan) {
                const float* rb = buf + (lane & 15) * 4;
                const float* vb = buf + 320 + ((wid & 3) * 4 + (lane >> 4)) * 4;
#pragma unroll 1
                for (int hf = 0; hf < 2; ++hf) {
                    const float* rh = rb + hf * 16 * RW_REC; const float* vh = vb + hf * 16 * RW_REC;
                    f32x4 kk4 = *(const f32x4*)(rh), wr4 = *(const f32x4*)(rh + 64), w4 = *(const f32x4*)(rh + 128), ka4 = *(const f32x4*)(rh + 192), ky4 = *(const f32x4*)(rh + 256), vc4 = *(const f32x4*)(vh);
                    f32x4 nkk = *(const f32x4*)(rh + RW_REC), nwr = *(const f32x4*)(rh + RW_REC + 64), nw = *(const f32x4*)(rh + RW_REC + 128), nka = *(const f32x4*)(rh + RW_REC + 192), nky = *(const f32x4*)(rh + RW_REC + 256), nvc = *(const f32x4*)(vh + RW_REC);
                    float ybuf = 0.f;
#pragma unroll
                    for (int j = 0; j < 16; ++j) {
                        f32x4 mkk, mwr, mw, mka, mky, mvc;
                        if (j < 14) { const int o = (j + 2) * RW_REC;
                            mkk = *(const f32x4*)(rh + o); mwr = *(const f32x4*)(rh + o + 64); mw = *(const f32x4*)(rh + o + 128); mka = *(const f32x4*)(rh + o + 192); mky = *(const f32x4*)(rh + o + 256); mvc = *(const f32x4*)(vh + o); }
                        const float vv = vc4[0];
                        f32x2 p1 = S01 * (f32x2){kk4[0], kk4[1]}; p1 = S23 * (f32x2){kk4[2], kk4[3]} + p1;
                        f32x2 p2 = S01 * (f32x2){wr4[0], wr4[1]}; p2 = S23 * (f32x2){wr4[2], wr4[3]} + p2;
                        const f32x2 vv2 = (f32x2){vv, vv};
                        f32x2 u01 = (f32x2){ky4[0], ky4[1]} * vv2; u01 = S01 * (f32x2){w4[0], w4[1]} + u01;
                        f32x2 u23 = (f32x2){ky4[2], ky4[3]} * vv2; u23 = S23 * (f32x2){w4[2], w4[3]} + u23;
                        const float sk = row16_sum(p1[0] + p1[1]);
                        const float q2 = row16_sum(p2[0] + p2[1]);
                        const f32x2 nsk2 = (f32x2){-sk, -sk};
                        S01 = (f32x2){ka4[0], ka4[1]} * nsk2 + u01; S23 = (f32x2){ka4[2], ka4[3]} * nsk2 + u23;
                        const float y = q2 - sk * vc4[1] + vv * vc4[2];
                        if ((lane & 15) == j) ybuf = y;
                        kk4 = nkk; wr4 = nwr; w4 = nw; ka4 = nka; ky4 = nky; vc4 = nvc;
                        if (j < 14) { nkk = mkk; nwr = mwr; nw = mw; nka = mka; nky = mky; nvc = mvc; }
                        __builtin_amdgcn_sched_barrier(0);
                    }
                    yr[(size_t)rw_tok(dir, c * 32 + hf * 16 + (lane & 15)) * 512] = f2bf(ybuf);
                }
            }
            asm volatile("s_waitcnt lgkmcnt(0)" ::: "memory"); __builtin_amdgcn_s_barrier(); asm volatile("" ::: "memory");
        }
        if (is_scan) __builtin_amdgcn_s_setprio(0);
    }
}

__device__ __forceinline__ void phase_rw_out(int l) {
    CParams& p = KPL(); const Ctx cx = mkctx();
    const int lane = cx.tid & 63, gw = cx.bid * 8 + (cx.tid >> 6), nw = cx.nb * 8;
    const bf16_t* F1 = (const bf16_t*)(p.ws + OFF_F1); const bf16_t* F2 = (const bf16_t*)(p.ws + OFF_Z); const bf16_t* GRW = (const bf16_t*)(p.ws + OFF_ZRW);
    const bf16_t* YRAW = (const bf16_t*)(p.ws + OFF_R2);
    bf16_t* YC = (bf16_t*)(p.ws + OFF_YC);
    const int c0 = lane * 8;
    float ka[8], rk[8], lg[8], lb[8];
#pragma unroll
    for (int e = 0; e < 8; ++e) { ka[e] = p.in[31][l * 512 + c0 + e]; rk[e] = p.in[32][l * 512 + c0 + e]; lg[e] = p.in[33][l * 512 + c0 + e]; lb[e] = p.in[34][l * 512 + c0 + e]; }
    for (int row = gw; row < T_TOK; row += nw) {
        const u32x4 y0 = *(const u32x4*)(YRAW + (size_t)row * 512 + c0), y1 = *(const u32x4*)(YRAW + ((size_t)T_TOK + row) * 512 + c0);
        const u32x4 r4 = *(const u32x4*)(F1 + (size_t)row * 2048 + c0), k4 = *(const u32x4*)(F1 + (size_t)row * 2048 + 512 + c0), v4 = *(const u32x4*)(F1 + (size_t)row * 2048 + 1024 + c0);
        const u32x4 a04 = *(const u32x4*)(F2 + (size_t)row * 2048 + 1024 + c0), a14 = *(const u32x4*)(F2 + (size_t)row * 2048 + 1536 + c0);
        const u32x4 g4 = *(const u32x4*)(GRW + (size_t)row * 512 + c0);
        const unsigned ya[4] = {y0.x, y0.y, y0.z, y0.w}, yb[4] = {y1.x, y1.y, y1.z, y1.w}, rr[4] = {r4.x, r4.y, r4.z, r4.w}, kx[4] = {k4.x, k4.y, k4.z, k4.w}, vv[4] = {v4.x, v4.y, v4.z, v4.w};
        const unsigned aa[4] = {a04.x, a04.y, a04.z, a04.w}, ab[4] = {a14.x, a14.y, a14.z, a14.w}, gg[4] = {g4.x, g4.y, g4.z, g4.w};
        float y[8], sum = 0.f, bs = 0.f;
#pragma unroll
        for (int e = 0; e < 8; ++e) {
            const int w = e >> 1; const bool hi = e & 1;
            y[e] = (hi ? bfhi(ya[w]) : bflo(ya[w])) + (hi ? bfhi(yb[w]) : bflo(yb[w])); sum += y[e];
            const float r = hi ? bfhi(rr[w]) : bflo(rr[w]), k = hi ? bfhi(kx[w]) : bflo(kx[w]), a0 = hi ? bfhi(aa[w]) : bflo(aa[w]), a1 = hi ? bfhi(ab[w]) : bflo(ab[w]);
            bs += r * k * (2.f + (a0 + a1 - 2.f) * ka[e]) * rk[e];
        }
        sum = row8_sum(sum); bs = row8_sum(bs);
        const float mu = sum * (1.f / 64.f);
        float var = 0.f;
#pragma unroll
        for (int e = 0; e < 8; ++e) { const float d = y[e] - mu; var += d * d; }
        var = row8_sum(var) * (1.f / 64.f);
        const float rstd = rsqrtf(var + 64e-5f);
        float o[8];
#pragma unroll
        for (int e = 0; e < 8; ++e) { const int w = e >> 1; const bool hi = e & 1;
            const float v = hi ? bfhi(vv[w]) : bflo(vv[w]), g = hi ? bfhi(gg[w]) : bflo(gg[w]);
            o[e] = ((y[e] - mu) * rstd * lg[e] + lb[e] + bs * v) * g; }
        u32x4 o4; o4.x = pk2(o[0], o[1]); o4.y = pk2(o[2], o[3]); o4.z = pk2(o[4], o[5]); o4.w = pk2(o[6], o[7]);
        *(u32x4*)(YC + (size_t)row * 512 + c0) = o4;
    }
}

__device__ __forceinline__ void phase_final() {
    CParams& p = KPL(); const Ctx cx = mkctx();
    const int lane = cx.tid & 63, gw = cx.bid * 8 + (cx.tid >> 6), nw = cx.nb * 8;
    const float* X = (const float*)(p.ws + OFF_X);
    for (int r = gw; r < 2 * 8192; r += nw) {
        const int b = r >> 13, t = r & 8191;
        const float* src = X + ((size_t)b * SEQA + NCTX + t) * 1024;
        f32x4 v[4]; float ss = 0.f;
#pragma unroll
        for (int i = 0; i < 4; ++i) { v[i] = *(const f32x4*)(src + (lane + 64 * i) * 4); ss += v[i][0] * v[i][0] + v[i][1] * v[i][1] + v[i][2] * v[i][2] + v[i][3] * v[i][3]; }
        ss = wave_sum(ss);
        const float inv = rsqrtf(ss * (1.f / 1024.f) + 1e-6f);
#pragma unroll
        for (int i = 0; i < 4; ++i) { const int c = (lane + 64 * i) * 4; const f32x4 g4 = *(const f32x4*)(p.in[41] + c);
            *(f32x4*)(p.out + (size_t)r * 1024 + c) = v[i] * inv * g4; }
    }
}

#define XB_TMO      128
#define XB_XCNT(j)  (256  + 64 * (j))
#define XB_XSUB(j)  (1280 + 64 * (j))
#define XB_XGEN(j)  (2304 + 64 * (j))
#define XB_TOP      3328
#define XB_TOPGEN   3392
#define XCD_BAR_WORDS 3456
#define XB_SPIN_CAP (1u << 22)
constexpr int XB_LDS_OFF = 143344;
__device__ __forceinline__ unsigned xb_ld(unsigned* p)              { return __hip_atomic_load(p, __ATOMIC_RELAXED, __HIP_MEMORY_SCOPE_AGENT); }
__device__ __forceinline__ unsigned xb_add(unsigned* p, unsigned v) { return __hip_atomic_fetch_add(p, v, __ATOMIC_RELAXED, __HIP_MEMORY_SCOPE_AGENT); }
__device__ __forceinline__ unsigned xb_xcc_id() { return (unsigned)__builtin_amdgcn_s_getreg((3 << 11) | 20) & 0xFu; }
#define XB_SPIN(cond, bar) do { unsigned _sp = 0; while (cond) { __builtin_amdgcn_s_sleep(1); \
    if ((++_sp & 255u) == 0u) { if (xb_ld(&(bar)[XB_TMO])) break; if (_sp > XB_SPIN_CAP) { atomicAdd(&(bar)[XB_TMO], 1u); break; } } } } while (0)
__device__ __forceinline__ void xb_complete(unsigned* bar, unsigned x, unsigned G, unsigned& nloc, unsigned& nx) {
    unsigned sum, cnt, mine, sp = 0u;
    for (;;) {
        sum = 0u; cnt = 0u; mine = 0u;
#pragma unroll
        for (unsigned j = 0; j < 16; ++j) { const unsigned c = xb_ld(&bar[XB_XCNT(j)]); sum += c; cnt += (c > 0u) ? 1u : 0u; mine = (j == x) ? c : mine; }
        if (sum == G) break;
        __builtin_amdgcn_s_sleep(1);
        if ((++sp & 255u) == 0u) { if (xb_ld(&bar[XB_TMO])) break; if (sp > XB_SPIN_CAP) { atomicAdd(&bar[XB_TMO], 1u); break; } }
    }
    nloc = mine > 0u ? mine : 1u; nx = cnt > 0u ? cnt : 1u;
}
__device__ __forceinline__ void xb_post(unsigned char* smem) {
    CParams& p = KPL(); const Ctx cx = mkctx();
    volatile LAS unsigned* st = (volatile LAS unsigned*)((LAS unsigned char*)smem + XB_LDS_OFF);
    if (cx.tid == 0) { st[0] = 0u; st[1] = 0u; (void)xb_add(&((unsigned*)(p.ws + OFF_BAR))[XB_XCNT(xb_xcc_id())], 1u); }
    __syncthreads();
}
__device__ __forceinline__ void xsync(unsigned char* smem) {
    CParams& p = KPL(); const Ctx cx = mkctx();
    asm volatile("s_waitcnt vmcnt(0)" ::: "memory");
    __syncthreads();
    if (cx.tid == 0) {
        unsigned* bar = (unsigned*)(p.ws + OFF_BAR);
        volatile LAS unsigned* st = (volatile LAS unsigned*)((LAS unsigned char*)smem + XB_LDS_OFF);
        const unsigned x = xb_xcc_id();
        __builtin_amdgcn_s_waitcnt(0);
        unsigned nloc = st[0], nx = st[1];
        if (nloc == 0u) { xb_complete(bar, x, (unsigned)cx.nb, nloc, nx); st[0] = nloc; st[1] = nx; }
        const unsigned old = xb_add(&bar[XB_XSUB(x)], 1u);
        const unsigned gen = old / nloc;
        if (old + 1u == (gen + 1u) * nloc) {
            __builtin_amdgcn_fence(__ATOMIC_RELEASE, "agent");
            asm volatile("s_waitcnt vmcnt(0)" ::: "memory");
            const unsigned og = xb_add(&bar[XB_TOP], 1u);
            const unsigned tg = og / nx;
            if (og + 1u == (tg + 1u) * nx) xb_add(&bar[XB_TOPGEN], 1u);
            else XB_SPIN(xb_ld(&bar[XB_TOPGEN]) == tg, bar);
            __builtin_amdgcn_fence(__ATOMIC_ACQUIRE, "agent");
            xb_add(&bar[XB_XGEN(x)], 1u);
            asm volatile("s_waitcnt vmcnt(0)" ::: "memory");
        } else {
            XB_SPIN(xb_ld(&bar[XB_XGEN(x)]) == gen, bar);
            __builtin_amdgcn_fence(__ATOMIC_ACQUIRE, "agent");
            asm volatile("s_waitcnt vmcnt(0)" ::: "memory");
        }
    }
    __syncthreads();
}

#ifndef PHM
#define PHM 0xFFFFFFFFull
#endif
#ifndef PHR
#define PHR 0ull
#endif
#ifndef SYNCREP
#define SYNCREP 1
#endif
template <int WHICH>
__device__ __forceinline__ void gemm_stage(int l, LAS unsigned char* lds) {
    CParams& p = KPL(); const Ctx cx = mkctx();
    const int sk = (l == NLAYER - 1) ? 1 : 0;
    unsigned char* ws = p.ws;
    float* X = (float*)(ws + OFF_X); bf16_t* H = (bf16_t*)(ws + OFF_H); bf16_t* ZA = (bf16_t*)(ws + OFF_Z); bf16_t* ZRW = (bf16_t*)(ws + OFF_ZRW);
    bf16_t* W = (bf16_t*)(ws + OFF_W);
    const float* MODL = (const float*)(ws + OFF_MOD) + (size_t)l * 3 * 6144;
    if constexpr (WHICH == 0) run_gemm(cx, lds, H, W + W_MIX / 2, 4096, 1024, FInproj{ZA, (float*)(ws + OFF_MLG), ZRW});
    else if constexpr (WHICH == 1) run_gemm(cx, lds, (const bf16_t*)(ws + OFF_ZG), W + W_GLU / 2, 512, 512, FGlu{(const bf16_t*)(ws + OFF_ZG), p.in[18] + l * 512, (bf16_t*)(ws + OFF_YA)});
    else if constexpr (WHICH == 2) run_gemm_epi(cx, lds, (const bf16_t*)(ws + OFF_LORAIN), W + W_LORA / 2, 2560, 256, EpiLora{p.in[25] + l * 1024, p.in[27] + l * 1024, ZA, ZRW, (bf16_t*)(ws + OFF_U0)});
    else if constexpr (WHICH == 3) run_gemm(cx, lds, H, W + W_GATE / 2, 3072, 1024, FGate{ZA}, sk);
    else if constexpr (WHICH == 4) run_gemm(cx, lds, (const bf16_t*)(ws + OFF_YA), W + W_PA / 2, 1024, 512, FMerge<0>{ZA, (float*)(ws + OFF_F1), H}, sk);
    else if constexpr (WHICH == 5) run_gemm(cx, lds, (const bf16_t*)(ws + OFF_YB), W + W_PB / 2, 1024, 512, FMerge<1>{ZA, (float*)(ws + OFF_F1), H}, sk);
    else if constexpr (WHICH == 6) run_gemm(cx, lds, (const bf16_t*)(ws + OFF_YC), W + W_PC / 2, 1024, 512, FMerge<2>{ZA, (float*)(ws + OFF_F1), H}, sk);
    else if constexpr (WHICH == 7) run_gemm(cx, lds, H, W + W_OUT / 2, 1024, 1024, FResid{X, MODL, 2}, sk);
    else if constexpr (WHICH == 8) run_gemm(cx, lds, H, W + W_1 / 2, 4096, 1024, FMlp1{ZA}, sk);
    else run_gemm(cx, lds, ZA, W + W_2 / 2, 1024, 4096, FResid{X, MODL, 5}, sk);
}

template <int l>
__device__ __forceinline__ void run_layer(cg::grid_group& grid, LAS unsigned char* lds, float* smf, unsigned char* smem) {
        if constexpr (l == 0) phase_wconv<0>(l, smf); else phase_wconv<1>(l, smf);
        __syncthreads();
        if constexpr ((PHM >> 2) & 1) { phase_norm(l, 0, l == 0); if constexpr ((PHR >> 2) & 1) { __syncthreads(); phase_norm(l, 0, l == 0); } }
        for (int sr = 0; sr < SYNCREP; ++sr) xsync(smem);
        if constexpr ((PHM >> 3) & 1) { gemm_stage<0>(l, lds); if constexpr ((PHR >> 3) & 1) { __syncthreads(); gemm_stage<0>(l, lds); } }
        for (int sr = 0; sr < SYNCREP; ++sr) xsync(smem);
        if constexpr ((PHM >> 4) & 1) { phase_s5_local(l); if constexpr ((PHR >> 4) & 1) { __syncthreads(); phase_s5_local(l); } }
        if constexpr ((PHM >> 5) & 1) { phase_ml_conv(l); if constexpr ((PHR >> 5) & 1) { __syncthreads(); phase_ml_conv(l); } }
        for (int sr = 0; sr < SYNCREP; ++sr) xsync(smem);
        if constexpr ((PHM >> 6) & 1) { phase_s5_carry(l); if constexpr ((PHR >> 6) & 1) { __syncthreads(); phase_s5_carry(l); } }
        if constexpr ((PHM >> 7) & 1) { phase_ml_local(l, smem); if constexpr ((PHR >> 7) & 1) { __syncthreads(); phase_ml_local(l, smem); } }
        for (int sr = 0; sr < SYNCREP; ++sr) xsync(smem);
        if constexpr ((PHM >> 9) & 1) { phase_ml_carry(); if constexpr ((PHR >> 9) & 1) { __syncthreads(); phase_ml_carry(); } }
        for (int sr = 0; sr < SYNCREP; ++sr) xsync(smem);
        if constexpr ((PHM >> 11) & 1) { phase_ml_out(l, smem); if constexpr ((PHR >> 11) & 1) { __syncthreads(); phase_ml_out(l, smem); } }
        for (int sr = 0; sr < SYNCREP; ++sr) xsync(smem);
        if constexpr ((PHM >> 12) & 1) { phase_rw_feat(l); if constexpr ((PHR >> 12) & 1) { __syncthreads(); phase_rw_feat(l); } }
        for (int sr = 0; sr < SYNCREP; ++sr) xsync(smem);
        if constexpr ((PHM >> 13) & 1) { gemm_stage<2>(l, lds); if constexpr ((PHR >> 13) & 1) { __syncthreads(); gemm_stage<2>(l, lds); } }
        for (int sr = 0; sr < SYNCREP; ++sr) xsync(smem);
        phase_rw_scan(l, smem);
        phase_s5_final(l, smf);
        for (int sr = 0; sr < SYNCREP; ++sr) xsync(smem);
        gemm_stage<1>(l, lds);
        if constexpr ((PHM >> 15) & 1) { phase_rw_out(l); if constexpr ((PHR >> 15) & 1) { __syncthreads(); phase_rw_out(l); } }
        for (int sr = 0; sr < SYNCREP; ++sr) xsync(smem);
        if constexpr ((PHM >> 17) & 1) { gemm_stage<3>(l, lds); if constexpr ((PHR >> 17) & 1) { __syncthreads(); gemm_stage<3>(l, lds); } }
        for (int sr = 0; sr < SYNCREP; ++sr) xsync(smem);
        if constexpr ((PHM >> 18) & 1) { gemm_stage<4>(l, lds); if constexpr ((PHR >> 18) & 1) { __syncthreads(); gemm_stage<4>(l, lds); } }
        if constexpr ((PHM >> 19) & 1) { gemm_stage<5>(l, lds); if constexpr ((PHR >> 19) & 1) { __syncthreads(); gemm_stage<5>(l, lds); } }
        if constexpr ((PHM >> 20) & 1) { gemm_stage<6>(l, lds); if constexpr ((PHR >> 20) & 1) { __syncthreads(); gemm_stage<6>(l, lds); } }
        for (int sr = 0; sr < SYNCREP; ++sr) xsync(smem);
        if constexpr ((PHM >> 21) & 1) { gemm_stage<7>(l, lds); if constexpr ((PHR >> 21) & 1) { __syncthreads(); gemm_stage<7>(l, lds); } }
        for (int sr = 0; sr < SYNCREP; ++sr) xsync(smem);
        if constexpr ((PHM >> 22) & 1) { phase_norm(l, 1, false); if constexpr ((PHR >> 22) & 1) { __syncthreads(); phase_norm(l, 1, false); } }
        for (int sr = 0; sr < SYNCREP; ++sr) xsync(smem);
        if constexpr ((PHM >> 23) & 1) { gemm_stage<8>(l, lds); if constexpr ((PHR >> 23) & 1) { __syncthreads(); gemm_stage<8>(l, lds); } }
        for (int sr = 0; sr < SYNCREP; ++sr) xsync(smem);
        gemm_stage<9>(l, lds);
        if constexpr (l < NLAYER - 1) { __syncthreads(); phase_wconv<2>(l + 1, smf); }
        for (int sr = 0; sr < SYNCREP; ++sr) xsync(smem);
    }

__global__ void __launch_bounds__(512, 2) fwd_megakernel(Params p_unused) {
    extern __shared__ __attribute__((aligned(16))) unsigned char smem[];
    cg::grid_group grid = cg::this_grid();
    LAS unsigned char* lds = (LAS unsigned char*)smem;
    float* smf = (float*)smem;

    xb_post(smem);
    phase_mod(smf); phase_s5_params();
    grid.sync();
    run_layer<0>(grid, lds, smf, smem);
    run_layer<1>(grid, lds, smf, smem);
    run_layer<2>(grid, lds, smf, smem);
    run_layer<3>(grid, lds, smf, smem);
    phase_final();
}

extern "C" void kernel_launch(void* const* d_in, const int* in_sizes, int n_in, void* d_out, int out_size, void* d_ws, size_t ws_size, hipStream_t stream) {
    static int grid_blocks = 0;
    if (grid_blocks == 0) {
        if (n_in != 42 || ws_size < WS_END) { fprintf(stderr, "kernel_launch: unexpected n_in %d / ws_size %zu\n", n_in, ws_size); grid_blocks = -1; return; }
        int dev = 0, cus = 0, per_cu = 0;
        (void)hipGetDevice(&dev);
        (void)hipDeviceGetAttribute(&cus, hipDeviceAttributeMultiprocessorCount, dev);
        if (hipFuncSetAttribute((const void*)fwd_megakernel, hipFuncAttributeMaxDynamicSharedMemorySize, LDS_BYTES) != hipSuccess) { fprintf(stderr, "kernel_launch: hipFuncSetAttribute failed\n"); grid_blocks = -1; return; }
        if (hipOccupancyMaxActiveBlocksPerMultiprocessor(&per_cu, (const void*)fwd_megakernel, 512, LDS_BYTES) != hipSuccess || per_cu < 1) { fprintf(stderr, "kernel_launch: occupancy query says %d\n", per_cu); per_cu = 1; (void)hipGetLastError(); }
        grid_blocks = cus * 1;
    }
    if (grid_blocks < 0) return;
    if (hipMemsetAsync((unsigned char*)d_ws + OFF_BAR, 0, 16384, stream) != hipSuccess) { fprintf(stderr, "kernel_launch: memset failed\n"); return; }
    Params p{};
    for (int i = 0; i < 42; ++i) p.in[i] = (const float*)d_in[i];
    p.out = (float*)d_out; p.ws = (unsigned char*)d_ws;
    void* args[] = {&p};
    hipError_t e = hipLaunchCooperativeKernel((const void*)fwd_megakernel, dim3(grid_blocks), dim3(512), args, LDS_BYTES, stream);
    if (e != hipSuccess) fprintf(stderr, "cooperative launch failed: %s (grid %d)\n", hipGetErrorString(e), grid_blocks);
}
```

```cpp
#include <hip/hip_runtime.h>
#include <hip/hip_cooperative_groups.h>
#include <cstdio>
namespace cg = cooperative_groups;

#define LAS __attribute__((address_space(3)))
typedef unsigned short bf16_t;
typedef short bf16x8 __attribute__((ext_vector_type(8)));
typedef float f32x4 __attribute__((ext_vector_type(4)));
typedef unsigned u32x4 __attribute__((ext_vector_type(4)));
typedef unsigned u32x2 __attribute__((ext_vector_type(2)));

constexpr int T_TOK = 16896, SEQA = 8448, NCTX = 256;
constexpr int NLAYER = 4;
constexpr int LDS_BYTES = 143360;
constexpr size_t OFF_X = 0;
constexpr size_t OFF_H = 69206016;
constexpr size_t OFF_Z = 103809024;
constexpr size_t OFF_ZRW = OFF_Z + 69206016;
constexpr size_t OFF_MLG = 242221056;
constexpr size_t OFF_W = 243302400;
constexpr size_t OFF_YA = 281837568;
constexpr size_t OFF_YB = 299139072;
constexpr size_t OFF_YC = 316440576;
constexpr size_t OFF_F1 = 333742080;
constexpr size_t OFF_MOD = 402948096;
constexpr size_t OFF_S5P = 403243008;
constexpr size_t OFF_MLS = OFF_S5P + 4 * 589824;
constexpr size_t OFF_R2 = OFF_MLS + 16384;
constexpr size_t OFF_BAR = OFF_R2 + 34603008;
constexpr size_t OFF_S5ST = OFF_BAR + 16384;
constexpr size_t WS_END = OFF_S5ST + 8650752;
constexpr size_t OFF_CLOC = OFF_F1;
constexpr size_t OFF_U0 = OFF_ZRW + 17301504;
constexpr size_t OFF_QKC = OFF_F1 + 43524096;
constexpr size_t OFF_ZG = OFF_ZRW + 34603008;
constexpr size_t OFF_LORAIN = OFF_R2 + 17301504;
constexpr size_t W_MIX = 0, W_GATE = 8388608, W_GLU = 14680064, W_LORA = 15204352, W_PA = 16515072, W_PB = 17563648, W_PC = 18612224, W_OUT = 19660800, W_1 = 21757952, W_2 = 30146560;

struct Params {
    const float* in[42];
    float* out;
    unsigned char* ws;
};

typedef const __attribute__((address_space(4))) Params CParams;
__device__ __forceinline__ CParams& KPL() {
    unsigned long long a = (unsigned long long)__builtin_amdgcn_kernarg_segment_ptr();
    asm volatile("" : "+s"(a));
    return *(CParams*)a;
}
struct Ctx { int tid, bid, nb; };
__device__ __forceinline__ Ctx mkctx() { Ctx c; c.tid = threadIdx.x; c.bid = blockIdx.x; c.nb = gridDim.x; asm volatile("" : "+v"(c.tid), "+s"(c.bid), "+s"(c.nb)); return c; }
__device__ __forceinline__ float bf2f(unsigned v) { return __uint_as_float(v << 16); }
__device__ __forceinline__ float bflo(unsigned w) { return __uint_as_float(w << 16); }
__device__ __forceinline__ float bfhi(unsigned w) { return __uint_as_float(w & 0xffff0000u); }
__device__ __forceinline__ bf16_t f2bf(float f) { unsigned u = __float_as_uint(f); u += 0x7FFFu + ((u >> 16) & 1u); return (bf16_t)(u >> 16); }
__device__ __forceinline__ unsigned pk2(float lo, float hi) { return (unsigned)f2bf(lo) | ((unsigned)f2bf(hi) << 16); }
__device__ __forceinline__ void store4bf(bf16_t* p, f32x4 v) { u32x2 r; r.x = pk2(v[0], v[1]); r.y = pk2(v[2], v[3]); *(u32x2*)p = r; }
__device__ __forceinline__ float sigmoidf_(float x) { return 1.f / (1.f + __expf(-x)); }

#define DPP_F(x, ctrl, rmask) __int_as_float(__builtin_amdgcn_update_dpp(0, __float_as_int(x), ctrl, rmask, 0xF, false))
__device__ __forceinline__ float row8_sum(float x) {
    x += DPP_F(x, 0xB1, 0xF); x += DPP_F(x, 0x4E, 0xF); x += DPP_F(x, 0x141, 0xF); return x;
}
__device__ __forceinline__ float row16_sum(float x) {
    x += DPP_F(x, 0xB1, 0xF); x += DPP_F(x, 0x4E, 0xF); x += DPP_F(x, 0x141, 0xF); x += DPP_F(x, 0x140, 0xF); return x;
}
__device__ __forceinline__ float wave_sum(float x) {
    x = row16_sum(x);
    x += DPP_F(x, 0x142, 0xA);
    x += DPP_F(x, 0x143, 0xC);
    return __int_as_float(__builtin_amdgcn_readlane(__float_as_int(x), 63));
}

namespace pg8 {
constexpr int BM = 256, BK = 64, HALF = 128, HTB = HALF * BK * 2, NXCD = 8, WGM = 8;
__device__ __forceinline__ int lds_byte(int r, int c) { const int st = (r >> 4) * 2 + (c >> 5), rr = r & 15, cc = c & 31, ob = rr * 64 + cc * 2; return st * 1024 + (ob ^ (((ob >> 9) & 1) << 5)); }
__device__ __forceinline__ void stage_rc(int b, int& R, int& C) { const int st = b / 1024, sb = b % 1024, swz = sb ^ (((sb >> 9) & 1) << 5); R = (st >> 1) * 16 + swz / 64; C = (st & 1) * 32 + (swz % 64) / 2; }
struct Unit { int pm, pn; };
struct Gemm { const bf16_t* A; const bf16_t* Bt; int M, N, K; };
struct StaticOrder {
    int nM, nN, nwg, G, c, skipctx;
    __device__ void init(int M, int N, int G_, int c_, int skip_ = 0) { nM = M / BM - 2 * skip_; nN = N / BM; nwg = nM * nN; G = G_; c = c_; skipctx = skip_; }
    __device__ bool next(int i, Unit& u) const {
        const long L = (long)i * G + c; if (L >= nwg) return false;
        int wgid = (int)L; { const int q = nwg / NXCD, r = nwg % NXCD, xcd = wgid % NXCD, off = wgid / NXCD; wgid = (xcd < r ? xcd * (q + 1) : r * (q + 1) + (xcd - r) * q) + off; }
        const int nig = WGM * nN, gid = wgid / nig, fm = gid * WGM, gsz = (nM - fm) < WGM ? (nM - fm) : WGM;
        u.pm = fm + ((wgid % nig) % gsz); u.pn = (wgid % nig) / gsz;
        if (skipctx) u.pm += (u.pm >= 32) ? 2 : 1;
        return true;
    }
};

template <class Epi>
__device__ __forceinline__ void gemm_phase(int tid_in, LAS unsigned char* lds, const Gemm g, const StaticOrder& S, const Epi& E) {
    const int tid = tid_in, wid = __builtin_amdgcn_readfirstlane(tid >> 6), lane = tid & 63, wr = wid >> 2, wc = wid & 3, fr = lane & 15, fq = lane >> 4;
    const int K = g.K, nt = K / BK;
    unsigned voffA[2], voffB[2];
#pragma unroll
    for (int i = 0; i < 2; ++i) { int R, C; stage_rc(tid * 16 + i * 8192, R, C); voffA[i] = (unsigned)(R * K + C) * 2u; voffB[i] = voffA[i]; }
    const size_t kstep = (size_t)(BK * 2);
    const size_t hstep = (size_t)HALF * K * 2;
    const size_t tstep = 2 * hstep;
    const unsigned ldsw = (unsigned)wid * 1024u;
    const int aoff = lds_byte(wr * 64 + fr, fq * 8), boff = lds_byte(wc * 32 + fr, fq * 8);
#define PG8_SA(b, h) (((b) * 2 + (h)) * HTB)
#define PG8_SB(b, h) ((4 + (b) * 2 + (h)) * HTB)
#define PG8_STAGE(bufoff, gbase, voff) do { _Pragma("unroll") for (int _i = 0; _i < 2; ++_i) \
        __builtin_amdgcn_global_load_lds((const unsigned*)((const char*)(gbase) + (voff)[_i]), (LAS unsigned*)(lds + (bufoff) + ldsw + _i * 8192), 16, 0, 0); } while (0)
#define PG8_LDA(dst, b, h) do { _Pragma("unroll") for (int m = 0; m < 4; ++m) _Pragma("unroll") for (int k = 0; k < 2; ++k) dst[m][k] = *(const LAS bf16x8*)(lds + PG8_SA(b, h) + aoff + m * 2048 + k * 1024); } while (0)
#define PG8_LDB(dst, b, h) do { _Pragma("unroll") for (int n = 0; n < 2; ++n) _Pragma("unroll") for (int k = 0; k < 2; ++k) dst[n][k] = *(const LAS bf16x8*)(lds + PG8_SB(b, h) + boff + n * 2048 + k * 1024); } while (0)
#define PG8_MMA(ai, bj, At, Bt) do { __builtin_amdgcn_s_setprio(1); _Pragma("unroll") for (int m = 0; m < 4; ++m) _Pragma("unroll") for (int n = 0; n < 2; ++n) _Pragma("unroll") for (int k = 0; k < 2; ++k) \
        acc[ai][bj][m][n] = __builtin_amdgcn_mfma_f32_16x16x32_bf16(Bt[n][k], At[m][k], acc[ai][bj][m][n], 0, 0, 0); __builtin_amdgcn_s_setprio(0); } while (0)
#define PG8_WAIT_V(n) asm volatile("s_waitcnt vmcnt(" #n ")" ::: "memory")
#define PG8_WAIT_L(n) asm volatile("s_waitcnt lgkmcnt(" #n ")" ::: "memory")
#define PG8_BAR __builtin_amdgcn_s_barrier()
#define PG8_SCHED __builtin_amdgcn_sched_barrier(0)
    Unit cur, nxt; int ui = 0;
    if (!S.next(0, cur)) return;
    f32x4 acc[2][2][4][2];
#pragma unroll
    for (int a = 0; a < 2; ++a)
#pragma unroll
        for (int b = 0; b < 2; ++b)
#pragma unroll
            for (int m = 0; m < 4; ++m)
#pragma unroll
                for (int n = 0; n < 2; ++n) acc[a][b][m][n] = (f32x4){0.f, 0.f, 0.f, 0.f};
    bf16x8 At[4][2], B0[2][2], B1[2][2];
    const char* cA = (const char*)g.A + (size_t)cur.pm * tstep; const char* cB = (const char*)g.Bt + (size_t)cur.pn * tstep;
    PG8_STAGE(PG8_SB(0, 0), cB, voffB); PG8_STAGE(PG8_SA(0, 0), cA, voffA); PG8_STAGE(PG8_SB(0, 1), cB + hstep, voffB); PG8_STAGE(PG8_SA(0, 1), cA + hstep, voffA);
    if (wr == 1) PG8_BAR;
    PG8_WAIT_V(4); PG8_BAR;
    PG8_STAGE(PG8_SB(1, 0), cB + kstep, voffB); PG8_STAGE(PG8_SA(1, 0), cA + kstep, voffA); PG8_STAGE(PG8_SB(1, 1), cB + hstep + kstep, voffB);
    PG8_WAIT_V(6); PG8_BAR;
    for (;;) {
        const bool has_next = S.next(ui + 1, nxt);
        const char* nA = has_next ? (const char*)g.A + (size_t)nxt.pm * tstep : cA; const char* nB = has_next ? (const char*)g.Bt + (size_t)nxt.pn * tstep : cB;
        for (int t = 0; t < nt; t += 2) {
            const bool last = (t == nt - 2);
            const char* a1 = cA + (size_t)(t + 1) * kstep;
            const char* a2 = last ? nA : cA + (size_t)(t + 2) * kstep; const char* b2 = last ? nB : cB + (size_t)(t + 2) * kstep;
            const char* a3 = a2 + kstep; const char* b3 = b2 + kstep;
            PG8_LDB(B0, 0, 0); PG8_SCHED; PG8_LDA(At, 0, 0); PG8_STAGE(PG8_SA(1, 1), a1 + hstep, voffA);
            PG8_WAIT_L(8); PG8_BAR; PG8_WAIT_L(0); PG8_MMA(0, 0, At, B0); PG8_BAR; PG8_SCHED;
            PG8_LDB(B1, 0, 1); PG8_STAGE(PG8_SB(0, 0), b2, voffB);
            PG8_BAR; PG8_WAIT_L(0); PG8_MMA(0, 1, At, B1); PG8_BAR;
            PG8_LDA(At, 0, 1); PG8_STAGE(PG8_SA(0, 0), a2, voffA);
            PG8_BAR; PG8_WAIT_L(0); PG8_MMA(1, 0, At, B0); PG8_BAR; PG8_SCHED;
            PG8_STAGE(PG8_SB(0, 1), b2 + hstep, voffB);
            PG8_WAIT_V(6); PG8_BAR; PG8_MMA(1, 1, At, B1); PG8_BAR;
            PG8_LDB(B0, 1, 0); PG8_SCHED; PG8_LDA(At, 1, 0); PG8_STAGE(PG8_SA(0, 1), a2 + hstep, voffA);
            PG8_WAIT_L(8); PG8_BAR; PG8_WAIT_L(0); PG8_MMA(0, 0, At, B0); PG8_BAR; PG8_SCHED;
            PG8_LDB(B1, 1, 1); PG8_STAGE(PG8_SB(1, 0), b3, voffB);
            PG8_BAR; PG8_WAIT_L(0); PG8_MMA(0, 1, At, B1); PG8_BAR;
            PG8_LDA(At, 1, 1); PG8_STAGE(PG8_SA(1, 0), a3, voffA);
            PG8_BAR; PG8_WAIT_L(0); PG8_MMA(1, 0, At, B0); PG8_BAR; PG8_SCHED;
            PG8_STAGE(PG8_SB(1, 1), b3 + hstep, voffB);
            PG8_WAIT_V(6); PG8_BAR; PG8_MMA(1, 1, At, B1); PG8_BAR;
        }
        E(acc, cur, wr, wc, fr, fq);
        if (!has_next) break;
#pragma unroll
        for (int a = 0; a < 2; ++a)
#pragma unroll
            for (int b = 0; b < 2; ++b)
#pragma unroll
                for (int m = 0; m < 4; ++m)
#pragma unroll
                    for (int n = 0; n < 2; ++n) acc[a][b][m][n] = (f32x4){0.f, 0.f, 0.f, 0.f};
        cur = nxt; cA = nA; cB = nB; ++ui;
    }
    PG8_WAIT_V(0);
    if (wr == 0) PG8_BAR;
    PG8_BAR;
#undef PG8_SA
#undef PG8_SB
#undef PG8_STAGE
#undef PG8_LDA
#undef PG8_LDB
#undef PG8_MMA
#undef PG8_WAIT_V
#undef PG8_WAIT_L
#undef PG8_BAR
#undef PG8_SCHED
}

template <class F> struct EpiT {
    F f;
    __device__ __forceinline__ void operator()(const f32x4 (&acc)[2][2][4][2], const Unit& u, int wr, int wc, int fr, int fq) const {
        const int row0 = u.pm * BM + wr * 64 + fr, col0 = u.pn * BM + wc * 32 + 4 * fq;
#pragma unroll
        for (int ai = 0; ai < 2; ++ai)
#pragma unroll
            for (int m = 0; m < 4; ++m) {
                const int row = row0 + ai * HALF + m * 16;
#pragma unroll
                for (int bj = 0; bj < 2; ++bj)
#pragma unroll
                    for (int n = 0; n < 2; ++n) f(row, col0 + bj * HALF + n * 16, acc[ai][bj][m][n]);
            }
    }
};
}

template <class F>
__device__ __forceinline__ void run_gemm(const Ctx& cx, LAS unsigned char* lds, const bf16_t* A, const bf16_t* Bt, int N, int K, const F& f, int skip = 0) {
    pg8::Gemm g; g.A = A; g.Bt = Bt; g.M = T_TOK; g.N = N; g.K = K;
    pg8::StaticOrder S; S.init(T_TOK, N, cx.nb, cx.bid, skip);
    pg8::EpiT<F> E{f};
    pg8::gemm_phase(cx.tid, lds, g, S, E);
}

template <class E>
__device__ __forceinline__ void run_gemm_epi(const Ctx& cx, LAS unsigned char* lds, const bf16_t* A, const bf16_t* Bt, int N, int K, const E& e) {
    pg8::Gemm g; g.A = A; g.Bt = Bt; g.M = T_TOK; g.N = N; g.K = K;
    pg8::StaticOrder S; S.init(T_TOK, N, cx.nb, cx.bid);
    pg8::gemm_phase(cx.tid, lds, g, S, e);
}
__device__ __forceinline__ int row_vec(int row) { const int b = row >= SEQA ? 1 : 0; const int t = row - b * SEQA; return t < NCTX ? 2 : b; }

struct FInproj { bf16_t* za; float* mlg; bf16_t* zrw;
    __device__ __forceinline__ void operator()(int row, int col, f32x4 v) const {
        if (col < 2048) store4bf(za + (size_t)row * 2048 + col, v);
        else if (col < 2064) *(f32x4*)(mlg + (size_t)row * 16 + (col - 2048)) = v;
        else if (col < 3856) store4bf(zrw + (size_t)row * 1792 + (col - 2064), v);
    } };
struct FGlu { const bf16_t* zg; const float* bglu; bf16_t* ya;
    __device__ __forceinline__ void operator()(int row, int col, f32x4 v) const {
        const u32x2 z = *(const u32x2*)(zg + (size_t)row * 512 + col); const f32x4 b = *(const f32x4*)(bglu + col);
        f32x4 o; o[0] = bflo(z.x) * sigmoidf_(v[0] + b[0]); o[1] = bfhi(z.x) * sigmoidf_(v[1] + b[1]); o[2] = bflo(z.y) * sigmoidf_(v[2] + b[2]); o[3] = bfhi(z.y) * sigmoidf_(v[3] + b[3]);
        store4bf(ya + (size_t)row * 512 + col, o);
    } };
struct EpiLora { const float* w0; const float* a0; bf16_t* f2; bf16_t* grw; bf16_t* u0;
    __device__ __forceinline__ void operator()(const f32x4 (&acc)[2][2][4][2], const pg8::Unit& u, int wr, int wc, int fr, int fq) const {
        const int row0 = u.pm * 256 + wr * 64 + fr, col0 = u.pn * 256 + wc * 32 + 4 * fq;
        const int pn = __builtin_amdgcn_readfirstlane(u.pn);
        if (pn < 8) {
            const float* bias = pn < 4 ? w0 : a0 - 1024;
#pragma unroll
            for (int bj = 0; bj < 2; ++bj)
#pragma unroll
                for (int n = 0; n < 2; ++n) {
                    const int col = col0 + bj * 128 + n * 16;
                    const f32x4 b = *(const f32x4*)(bias + col);
#pragma unroll
                    for (int ai = 0; ai < 2; ++ai)
#pragma unroll
                        for (int m = 0; m < 4; ++m) {
                            const int row = row0 + ai * 128 + m * 16; f32x4 o;
#pragma unroll
                            for (int e = 0; e < 4; ++e) { const float s = sigmoidf_(acc[ai][bj][m][n][e] + b[e]); o[e] = pn < 4 ? 1.f - __expf(-0.60653065971f * s) : s; }
                            if (pn < 2) store4bf(u0 + (size_t)row * 512 + col, o); else store4bf(f2 + (size_t)row * 2048 + col, o);
                        }
                }
        } else {
#pragma unroll
            for (int ai = 0; ai < 2; ++ai)
#pragma unroll
                for (int m = 0; m < 4; ++m) { const int row = row0 + ai * 128 + m * 16;
#pragma unroll
                    for (int bj = 0; bj < 2; ++bj)
#pragma unroll
                        for (int n = 0; n < 2; ++n) store4bf(grw + (size_t)row * 512 + (col0 + bj * 128 + n * 16 - 2048), acc[ai][bj][m][n]); }
        }
    } };
struct FGate { bf16_t* g;
    __device__ __forceinline__ void operator()(int row, int col, f32x4 v) const {
        f32x4 o; o[0] = sigmoidf_(v[0]); o[1] = sigmoidf_(v[1]); o[2] = sigmoidf_(v[2]); o[3] = sigmoidf_(v[3]);
        store4bf(g + (size_t)row * 3072 + col, o);
    } };
template <int J> struct FMerge { const bf16_t* g; float* y32; bf16_t* ybf;
    __device__ __forceinline__ void operator()(int row, int col, f32x4 v) const {
        const u32x2 z = *(const u32x2*)(g + (size_t)row * 3072 + J * 1024 + col);
        f32x4 o; o[0] = bflo(z.x) * v[0]; o[1] = bfhi(z.x) * v[1]; o[2] = bflo(z.y) * v[2]; o[3] = bfhi(z.y) * v[3];
        float* yp = y32 + (size_t)row * 1024 + col;
        if (J == 0) *(f32x4*)yp = o;
        else if (J == 1) { f32x4 t = *(f32x4*)yp; *(f32x4*)yp = t + o; }
        else { f32x4 t = *(f32x4*)yp; store4bf(ybf + (size_t)row * 1024 + col, t + o); }
    } };
struct FResid { float* x; const float* modl; int chunk;
    __device__ __forceinline__ void operator()(int row, int col, f32x4 v) const {
        const f32x4 mg = *(const f32x4*)(modl + row_vec(row) * 6144 + chunk * 1024 + col);
        float* xp = x + (size_t)row * 1024 + col; f32x4 t = *(f32x4*)xp; *(f32x4*)xp = t + mg * v;
    } };
struct FMlp1 { bf16_t* hid;
    __device__ __forceinline__ void operator()(int row, int col, f32x4 v) const {
        f32x4 o;
#pragma unroll
        for (int e = 0; e < 4; ++e) { const float r = fmaxf(v[e], 0.f); o[e] = r * r; }
        store4bf(hid + (size_t)row * 4096 + col, o);
    } };

__device__ __forceinline__ void phase_mod(float* smf) {
    CParams& p = KPL(); const Ctx cx = mkctx();
    const int tid = cx.tid, lane = tid & 63, wid = tid >> 6;
    float* sc = smf; float* red = smf + 3072;
    float* MOD = (float*)(p.ws + OFF_MOD);
    for (int i = tid; i < 3072; i += 512) { const int v = i >> 10, j = i & 1023; const float c = v < 2 ? p.in[1][v * 1024 + j] : p.in[3][j]; sc[i] = c / (1.f + expf(-c)); }
    __syncthreads();
    for (int item = cx.bid; item < 4 * 96; item += cx.nb) {
        const int l = item / 96, jt = item % 96, j = jt * 64 + lane;
        const float* w = p.in[4] + (size_t)l * 1024 * 6144 + j;
        float a0 = 0.f, a1 = 0.f, a2 = 0.f;
#pragma unroll 16
        for (int i = wid * 128; i < wid * 128 + 128; ++i) { const float wv = w[(size_t)i * 6144]; a0 += sc[i] * wv; a1 += sc[1024 + i] * wv; a2 += sc[2048 + i] * wv; }
        red[(wid * 3 + 0) * 64 + lane] = a0; red[(wid * 3 + 1) * 64 + lane] = a1; red[(wid * 3 + 2) * 64 + lane] = a2;
        __syncthreads();
        if (tid < 192) { const int v = tid >> 6; float s = 0.f;
            for (int w8 = 0; w8 < 8; ++w8) s += red[(w8 * 3 + v) * 64 + lane];
            MOD[(l * 3 + v) * 6144 + j] = s + p.in[5][l * 6144 + j]; }
        __syncthreads();
    }
}

__device__ __forceinline__ void dsincos(double x, double& s, double& c) {
    const double k = rint(x * 0.63661977236758134308);
    double r = fma(-k, 1.57079632679489655800, x); r = fma(-k, 6.12323399573676603587e-17, r);
    const double r2 = r * r;
    double ps = -1.0 / 355687428096000.0;
    ps = fma(ps, r2, 1.0 / 1307674368000.0); ps = fma(ps, r2, -1.0 / 6227020800.0); ps = fma(ps, r2, 1.0 / 39916800.0); ps = fma(ps, r2, -1.0 / 362880.0);
    ps = fma(ps, r2, 1.0 / 5040.0); ps = fma(ps, r2, -1.0 / 120.0); ps = fma(ps, r2, 1.0 / 6.0); ps = fma(ps, r2, -1.0); ps = -ps * r;
    double pc = 1.0 / 20922789888000.0;
    pc = fma(pc, r2, -1.0 / 87178291200.0); pc = fma(pc, r2, 1.0 / 479001600.0); pc = fma(pc, r2, -1.0 / 3628800.0); pc = fma(pc, r2, 1.0 / 40320.0);
    pc = fma(pc, r2, -1.0 / 720.0); pc = fma(pc, r2, 1.0 / 24.0); pc = fma(pc, r2, -0.5); pc = fma(pc, r2, 1.0);
    const int q = ((int)k) & 3;
    s = (q == 0) ? ps : (q == 1) ? pc : (q == 2) ? -ps : -pc;
    c = (q == 0) ? pc : (q == 1) ? -ps : (q == 2) ? -pc : ps;
}
__device__ __forceinline__ double dexp_neg(double x) {
    const double k = rint(x * 1.44269504088896338700);
    double r = fma(-k, 0.693147180369123816490, x); r = fma(-k, 1.90821492927058770002e-10, r);
    double pe = 1.0 / 6227020800.0;
    pe = fma(pe, r, 1.0 / 479001600.0); pe = fma(pe, r, 1.0 / 39916800.0); pe = fma(pe, r, 1.0 / 3628800.0); pe = fma(pe, r, 1.0 / 362880.0); pe = fma(pe, r, 1.0 / 40320.0);
    pe = fma(pe, r, 1.0 / 5040.0); pe = fma(pe, r, 1.0 / 720.0); pe = fma(pe, r, 1.0 / 120.0); pe = fma(pe, r, 1.0 / 24.0); pe = fma(pe, r, 1.0 / 6.0); pe = fma(pe, r, 0.5);
    pe = fma(pe, r, 1.0); pe = fma(pe, r, 1.0);
    int ki = (int)k; if (ki < -1000) return 0.0;
    return pe * __longlong_as_double((long long)(1023 + ki) << 52);
}

__device__ __forceinline__ void wconv_tile(const Ctx& cx, const float* src, int ld, int K, int c0, int ncols, bf16_t* dst, int kt, int nt, float* tile) {
    const int tid = cx.tid, j = tid & 63, i0 = tid >> 6;
#pragma unroll
    for (int e = 0; e < 8; ++e) { const int i = i0 + 8 * e; const int n = nt * 64 + j;
        tile[i * 65 + j] = (n < ncols) ? src[(size_t)(kt * 64 + i) * ld + c0 + n] : 0.f; }
    __syncthreads();
#pragma unroll
    for (int e = 0; e < 8; ++e) { const int jj = i0 + 8 * e;
        dst[(size_t)(nt * 64 + jj) * K + kt * 64 + j] = f2bf(tile[j * 65 + jj]); }
    __syncthreads();
}

template <int MODE>
__device__ __forceinline__ void phase_wconv(int l, float* smf) {
    CParams& p = KPL(); const Ctx cx = mkctx();
    bf16_t* W = (bf16_t*)(p.ws + OFF_W);
    const int tid = cx.tid;
    unsigned* ticket = (unsigned*)(p.ws + OFF_BAR) + 3520 + l * 16;
    int* tslot = (int*)smf + 8192;
    for (int it = (MODE == 2 ? 0 : cx.bid); ; it += cx.nb) {
        int item;
        if (MODE == 0) { item = it; if (item >= 5184) break; }
        else if (MODE == 1) { item = 3520 + it; if (item >= 4544) break; }
        else {
            if (tid == 0) *tslot = (int)__hip_atomic_fetch_add(ticket, 1u, __ATOMIC_RELAXED, __HIP_MEMORY_SCOPE_AGENT);
            __syncthreads();
            const int q = *tslot;
            __syncthreads();
            if (q >= 4160) break;
            item = q < 3520 ? q : q + 1024;
        }
        if (item < 4544) {
            const float* src; int ld, K, c0, ncols, nN; bf16_t* dst; int t = item;
            if (t < 1024) { src = p.in[8] + (size_t)l * 1024 * 6928; ld = 6928; K = 1024; c0 = 0; ncols = 3856; nN = 64; dst = W + W_MIX / 2; }
            else if (t < 1792) { t -= 1024; src = p.in[8] + (size_t)l * 1024 * 6928; ld = 6928; K = 1024; c0 = 3856; ncols = 3072; nN = 48; dst = W + W_GATE / 2; }
            else if (t < 1856) { t -= 1792; src = p.in[17] + (size_t)l * 512 * 512; ld = 512; K = 512; c0 = 0; ncols = 512; nN = 8; dst = W + W_GLU / 2; }
            else if (t < 1984) { t -= 1856; src = p.in[35] + (size_t)l * 512 * 1024; ld = 1024; K = 512; c0 = 0; ncols = 1024; nN = 16; dst = W + W_PA / 2; }
            else if (t < 2112) { t -= 1984; src = p.in[36] + (size_t)l * 512 * 1024; ld = 1024; K = 512; c0 = 0; ncols = 1024; nN = 16; dst = W + W_PB / 2; }
            else if (t < 2240) { t -= 2112; src = p.in[37] + (size_t)l * 512 * 1024; ld = 1024; K = 512; c0 = 0; ncols = 1024; nN = 16; dst = W + W_PC / 2; }
            else if (t < 2496) { t -= 2240; src = p.in[38] + (size_t)l * 1024 * 1024; ld = 1024; K = 1024; c0 = 0; ncols = 1024; nN = 16; dst = W + W_OUT / 2; }
            else if (t < 3520) { t -= 2496; src = p.in[39] + (size_t)l * 1024 * 4096; ld = 4096; K = 1024; c0 = 0; ncols = 4096; nN = 64; dst = W + W_1 / 2; }
            else { t -= 3520; src = p.in[40] + (size_t)l * 4096 * 1024; ld = 1024; K = 4096; c0 = 0; ncols = 1024; nN = 16; dst = W + W_2 / 2; }
            const int nt = t % nN, kt = t / nN;
            wconv_tile(cx, src, ld, K, c0, ncols, dst, kt, nt, smf);
        } else {
            bf16_t* dst = W + W_LORA / 2;
#pragma unroll
            for (int q = 0; q < 2; ++q) {
                const int e = (item - 4544) * 1024 + q * 512 + tid; const int n = e >> 8, k = e & 255;
                float v = 0.f;
                if (n < 1024) { if (k < 64) v = p.in[26][(((size_t)l * 2 + (n >> 9)) * 64 + k) * 512 + (n & 511)]; }
                else if (n < 2048) { if (k >= 64 && k < 128) v = p.in[28][(((size_t)l * 2 + ((n - 1024) >> 9)) * 64 + (k - 64)) * 512 + (n & 511)]; }
                else { if (k >= 128) v = p.in[29][((size_t)l * 128 + (k - 128)) * 512 + (n - 2048)]; }
                dst[e] = f2bf(v);
            }
        }
    }
}

__device__ __forceinline__ void phase_s5_params() {
    CParams& p = KPL(); const Ctx cx = mkctx();
    for (int item = cx.bid; item < 32; item += cx.nb) {
        const int l = item >> 3;
        const int idx = (item & 7) * 512 + cx.tid;
        const int dir = idx >> 11, g = (idx >> 6) & 31;
        float* S5P = (float*)(p.ws + OFF_S5P) + (size_t)l * 147456;
        const size_t pi = (size_t)l * 4096 + idx;
        const double lre = fmin((double)p.in[9][pi], -1e-4), lim = (double)p.in[10][pi];
        const double dt = dexp_neg((double)p.in[11][(l * 2 + dir) * 32 + g]);
        const double mag = dexp_neg(lre * dt); double sn, cs; dsincos(lim * dt, sn, cs);
        const double ar = mag * cs, ai = mag * sn;
        const double den = lre * lre + lim * lim, nr = ar - 1.0;
        const double cr = (nr * lre + ai * lim) / den, ci = (ai * lre - nr * lim) / den;
        const double mag64 = dexp_neg(64.0 * lre * dt); dsincos(64.0 * lim * dt, sn, cs);
        S5P[idx] = (float)ar; S5P[4096 + idx] = (float)ai; S5P[8192 + idx] = (float)(mag64 * cs); S5P[12288 + idx] = (float)(mag64 * sn);
        float* BR = S5P + 16384; float* BI = BR + 65536;
        for (int c = 0; c < 16; ++c) { const double bre = p.in[12][pi * 16 + c], bim = p.in[13][pi * 16 + c];
            BR[(size_t)idx * 16 + c] = (float)(cr * bre - ci * bim); BI[(size_t)idx * 16 + c] = (float)(cr * bim + ci * bre); }
    }
}

__device__ __forceinline__ void phase_norm(int l, int which, bool init) {
    CParams& p = KPL(); const Ctx cx = mkctx();
    const int lane = cx.tid & 63, gw = cx.bid * 8 + (cx.tid >> 6), nw = cx.nb * 8;
    float* X = (float*)(p.ws + OFF_X); bf16_t* H = (bf16_t*)(p.ws + OFF_H);
    const float* MODL = (const float*)(p.ws + OFF_MOD) + (size_t)l * 3 * 6144;
    const float* gam = p.in[which ? 7 : 6] + l * 1024;
    for (int row = gw; row < T_TOK; row += nw) {
        const int b = row >= SEQA ? 1 : 0, t = row - b * SEQA;
        const float* src = init ? (t < NCTX ? p.in[2] + ((size_t)b * NCTX + t) * 1024 : p.in[0] + ((size_t)b * 8192 + (t - NCTX)) * 1024) : X + (size_t)row * 1024;
        f32x4 v[4]; float ss = 0.f;
#pragma unroll
        for (int i = 0; i < 4; ++i) { v[i] = *(const f32x4*)(src + (lane + 64 * i) * 4); ss += v[i][0] * v[i][0] + v[i][1] * v[i][1] + v[i][2] * v[i][2] + v[i][3] * v[i][3]; }
        if (init) {
#pragma unroll
            for (int i = 0; i < 4; ++i) *(f32x4*)(X + (size_t)row * 1024 + (lane + 64 * i) * 4) = v[i];
        }
        ss = wave_sum(ss);
        const float inv = rsqrtf(ss * (1.f / 1024.f) + 1e-6f);
        const float* mv = MODL + (t < NCTX ? 2 : b) * 6144 + (which ? 3 : 0) * 1024;
#pragma unroll
        for (int i = 0; i < 4; ++i) { const int c = (lane + 64 * i) * 4;
            const f32x4 g4 = *(const f32x4*)(gam + c), sh = *(const f32x4*)(mv + c), scl = *(const f32x4*)(mv + 1024 + c);
            f32x4 o;
#pragma unroll
            for (int e = 0; e < 4; ++e) o[e] = v[i][e] * inv * g4[e] * (1.f + scl[e]) + sh[e];
            store4bf(H + (size_t)row * 1024 + c, o); }
    }
}

__device__ __forceinline__ int s5_order(int dir, int i) { return dir == 0 ? i : (i < 4 ? 3 - i : 135 - i); }

__device__ __forceinline__ void phase_s5_local(int l) {
    CParams& p = KPL(); const Ctx cx = mkctx();
    const int b0 = cx.nb >= 2 ? cx.nb / 2 : 0;
    if (cx.bid < b0) return;
    const int lane = cx.tid & 63, gw = (cx.bid - b0) * 8 + (cx.tid >> 6), nw = (cx.nb - b0) * 8;
    const bf16_t* ZA = (const bf16_t*)(p.ws + OFF_Z);
    const float* S5P = (const float*)(p.ws + OFF_S5P) + (size_t)l * 147456; const float* BR = S5P + 16384; const float* BI = BR + 65536;
    float* ST = (float*)(p.ws + OFF_S5ST);
    for (int item0 = gw; item0 < 16896; item0 += nw) {
        const int item = __builtin_amdgcn_readfirstlane(item0);
        const int chunk = item % 132, g = (item / 132) & 31, dir = (item / 4224) & 1, b = item / 8448;
        const int idx = dir * 2048 + g * 64 + lane;
        const float ar = S5P[idx], ai = S5P[4096 + idx];
        float br[16], bi[16];
#pragma unroll
        for (int q = 0; q < 4; ++q) { const f32x4 t0 = *(const f32x4*)(BR + (size_t)idx * 16 + q * 4), t1 = *(const f32x4*)(BI + (size_t)idx * 16 + q * 4);
#pragma unroll
            for (int e = 0; e < 4; ++e) { br[q * 4 + e] = t0[e]; bi[q * 4 + e] = t1[e]; } }
        const int row = b * SEQA + chunk * 64 + lane;
        const u32x4 u0 = *(const u32x4*)(ZA + (size_t)row * 2048 + g * 16), u1 = *(const u32x4*)(ZA + (size_t)row * 2048 + g * 16 + 8);
        unsigned ur[8] = {u0.x, u0.y, u0.z, u0.w, u1.x, u1.y, u1.z, u1.w};
        float hr = 0.f, hi = 0.f;
#pragma unroll 8
        for (int j = 0; j < 64; ++j) {
            const int tok = dir ? 63 - j : j;
            float bur = 0.f, bui = 0.f;
#pragma unroll
            for (int q = 0; q < 8; ++q) { const unsigned w = (unsigned)__builtin_amdgcn_readlane((int)ur[q], tok); const float x0 = bflo(w), x1 = bfhi(w);
                bur += br[2 * q] * x0 + br[2 * q + 1] * x1; bui += bi[2 * q] * x0 + bi[2 * q + 1] * x1; }
            const float nr = ar * hr - ai * hi + bur, ni = ar * hi + ai * hr + bui; hr = nr; hi = ni;
        }
        float* st = ST + ((((size_t)b * 2 + dir) * 32 + g) * 132 + chunk) * 128;
        st[lane] = hr; st[64 + lane] = hi;
    }
}

__device__ __forceinline__ void phase_s5_carry(int l) {
    CParams& p = KPL(); const Ctx cx = mkctx();
    const int b0 = cx.nb >= 2 ? cx.nb / 2 : 0;
    if (cx.bid < b0) return;
    const int lane = cx.tid & 63, gw = (cx.bid - b0) * 8 + (cx.tid >> 6), nw = (cx.nb - b0) * 8;
    const float* S5P = (const float*)(p.ws + OFF_S5P) + (size_t)l * 147456;
    float* ST = (float*)(p.ws + OFF_S5ST);
    for (int item0 = gw; item0 < 128; item0 += nw) {
        const int item = __builtin_amdgcn_readfirstlane(item0);
        const int g = item & 31, dir = (item >> 5) & 1, b = item >> 6;
        const int idx = dir * 2048 + g * 64 + lane;
        const float ar = S5P[8192 + idx], ai = S5P[12288 + idx];
        float* st = ST + (((size_t)b * 2 + dir) * 32 + g) * 132 * 128;
        float hr = 0.f, hi = 0.f;
        for (int i0 = 0; i0 < 132; i0 += 12) {
            float lr[12], li[12];
#pragma unroll
            for (int e = 0; e < 12; ++e) { const int c = s5_order(dir, i0 + e); lr[e] = st[c * 128 + lane]; li[e] = st[c * 128 + 64 + lane]; }
#pragma unroll
            for (int e = 0; e < 12; ++e) { const int c = s5_order(dir, i0 + e); st[c * 128 + lane] = hr; st[c * 128 + 64 + lane] = hi;
                const float nr = ar * hr - ai * hi + lr[e], ni = ar * hi + ai * hr + li[e]; hr = nr; hi = ni; }
        }
    }
}

template <int DIR>
__device__ __forceinline__ void s5_final_dir(CParams& p, int l, int b, int g, int chunk, int lane, const unsigned (&ur)[8], float* hst, f32x4* ybuf, int row0, float dsk, bf16_t* ZG) {
    const float* S5P = (const float*)(p.ws + OFF_S5P) + (size_t)l * 147456; const float* BR = S5P + 16384; const float* BI = BR + 65536;
    const float* ST = (const float*)(p.ws + OFF_S5ST);
    const bf16_t* ZA = (const bf16_t*)(p.ws + OFF_Z);
    const int idx = DIR * 2048 + g * 64 + lane;
    const float ar = S5P[idx], ai = S5P[4096 + idx];
    float br[16], bi[16];
#pragma unroll
    for (int q = 0; q < 4; ++q) { const f32x4 t0 = *(const f32x4*)(BR + (size_t)idx * 16 + q * 4), t1 = *(const f32x4*)(BI + (size_t)idx * 16 + q * 4);
#pragma unroll
        for (int e = 0; e < 4; ++e) { br[q * 4 + e] = t0[e]; bi[q * 4 + e] = t1[e]; } }
    float cbr[16], cbi[16];
    { const size_t cb = ((((size_t)l * 2 + DIR) * 32 + g) * 16 + (lane & 15)) * 64 + (lane >> 4);
#pragma unroll
      for (int i = 0; i < 16; ++i) { cbr[i] = p.in[14][cb + 4 * i]; cbi[i] = -p.in[15][cb + 4 * i]; } }
    const float* st = ST + ((((size_t)b * 2 + DIR) * 32 + g) * 132 + chunk) * 128;
    float hr = st[lane], hi = st[64 + lane];
    const int ch = g * 16 + (lane & 15);
#pragma unroll 1
    for (int si = 0; si < 4; ++si) {
        const int sc = DIR ? 3 - si : si;
#pragma unroll
        for (int jj = 0; jj < 16; ++jj) {
            const int tt = DIR ? 15 - jj : jj; const int tok = sc * 16 + tt;
            float bur = 0.f, bui = 0.f;
#pragma unroll
            for (int q = 0; q < 8; ++q) { const unsigned w = (unsigned)__builtin_amdgcn_readlane((int)ur[q], tok); const float x0 = bflo(w), x1 = bfhi(w);
                bur += br[2 * q] * x0 + br[2 * q + 1] * x1; bui += bi[2 * q] * x0 + bi[2 * q + 1] * x1; }
            const float nr = ar * hr - ai * hi + bur, ni = ar * hi + ai * hr + bui; hr = nr; hi = ni;
            hst[tt * 68 + lane] = hr; hst[1088 + tt * 68 + lane] = hi;
        }
        f32x4 a = (f32x4){0.f, 0.f, 0.f, 0.f};
        if (DIR) a = ybuf[sc * 64 + lane];
#pragma unroll
        for (int i = 0; i < 16; ++i) {
            const float xr = hst[(lane & 15) * 68 + 4 * i + (lane >> 4)], xi = hst[1088 + (lane & 15) * 68 + 4 * i + (lane >> 4)];
            a = __builtin_amdgcn_mfma_f32_16x16x4f32(xr, cbr[i], a, 0, 0, 0);
            a = __builtin_amdgcn_mfma_f32_16x16x4f32(xi, cbi[i], a, 0, 0, 0);
        }
        if (!DIR) ybuf[sc * 64 + lane] = a;
        else {
#pragma unroll
            for (int j = 0; j < 4; ++j) {
                const int row = row0 + sc * 16 + (lane >> 4) * 4 + j;
                const float u = bf2f(ZA[(size_t)row * 2048 + ch]);
                const float y = u * dsk + a[j];
                const float z = 0.5f * y * (1.f + tanhf(0.7978845608028654f * (y + 0.044715f * y * y * y)));
                ZG[(size_t)row * 512 + ch] = f2bf(z);
            }
        }
    }
}

__device__ __forceinline__ void phase_s5_final(int l, float* smf) {
    CParams& p = KPL(); const Ctx cx = mkctx();
    const int nscan = cx.nb >= 2 ? cx.nb / 2 : 0;
    if (cx.bid < nscan) return;
    const int lane = cx.tid & 63, wid = cx.tid >> 6, gw = (cx.bid - nscan) * 8 + wid, nw = (cx.nb - nscan) * 8;
    const bf16_t* ZA = (const bf16_t*)(p.ws + OFF_Z);
    bf16_t* ZG = (bf16_t*)(p.ws + OFF_ZG);
    float* hst = smf + wid * 3200;
    f32x4* ybuf = (f32x4*)(hst + 2176);
    for (int item0 = gw; item0 < 8448; item0 += nw) {
        const int item = __builtin_amdgcn_readfirstlane(item0);
        const int chunk = item % 132, g = (item / 132) & 31, b = item / 4224;
        const int row0 = b * SEQA + chunk * 64;
        const u32x4 u0 = *(const u32x4*)(ZA + (size_t)(row0 + lane) * 2048 + g * 16), u1 = *(const u32x4*)(ZA + (size_t)(row0 + lane) * 2048 + g * 16 + 8);
        const unsigned ur[8] = {u0.x, u0.y, u0.z, u0.w, u1.x, u1.y, u1.z, u1.w};
        const float dsk = p.in[16][l * 512 + g * 16 + (lane & 15)];
        s5_final_dir<0>(p, l, b, g, chunk, lane, ur, hst, ybuf, row0, dsk, ZG);
        s5_final_dir<1>(p, l, b, g, chunk, lane, ur, hst, ybuf, row0, dsk, ZG);
    }
}

__device__ __forceinline__ int ml_row0(int b, int nc) { return b * SEQA + nc * 128; }
__device__ __forceinline__ int ml_order(int dir, int i) { return dir == 0 ? i : (i < 2 ? 1 - i : 67 - i); }

__device__ __forceinline__ void phase_ml_conv(int l) {
    CParams& p = KPL(); const Ctx cx = mkctx();
    const bf16_t* ZA = (const bf16_t*)(p.ws + OFF_Z);
    bf16_t* QKC = (bf16_t*)(p.ws + OFF_QKC);
    const float* cw = p.in[19] + (size_t)l * 9 * 512; const float* cb = p.in[20] + l * 512;
    for (int idx = cx.bid * 512 + cx.tid; idx < T_TOK * 64; idx += cx.nb * 512) {
        const int row = idx >> 6, c8 = (idx & 63) * 8;
        const int b = row >= SEQA ? 1 : 0, t = row - b * SEQA;
        const bool isctx = t < NCTX;
        const int tt = isctx ? t : t - NCTX, W = isctx ? 256 : 64, Hh = isctx ? 1 : 128;
        const int y = tt / W, x = tt % W;
        const int segrow0 = row - tt;
        float acc[8];
#pragma unroll
        for (int e = 0; e < 8; ++e) acc[e] = cb[c8 + e];
#pragma unroll
        for (int dy = 0; dy < 3; ++dy)
#pragma unroll
            for (int dx = 0; dx < 3; ++dx) {
                const int yy = y + dy - 1, xx = x + dx - 1;
                if (yy >= 0 && yy < Hh && xx >= 0 && xx < W) {
                    const u32x4 z = *(const u32x4*)(ZA + (size_t)(segrow0 + yy * W + xx) * 2048 + 512 + c8);
                    const float* w = cw + (dy * 3 + dx) * 512 + c8;
                    const f32x4 w0 = *(const f32x4*)w, w1 = *(const f32x4*)(w + 4);
                    acc[0] += bflo(z.x) * w0[0]; acc[1] += bfhi(z.x) * w0[1]; acc[2] += bflo(z.y) * w0[2]; acc[3] += bfhi(z.y) * w0[3];
                    acc[4] += bflo(z.z) * w1[0]; acc[5] += bfhi(z.z) * w1[1]; acc[6] += bflo(z.w) * w1[2]; acc[7] += bfhi(z.w) * w1[3];
                }
            }
        u32x4 o;
#pragma unroll
        for (int e = 0; e < 8; ++e) acc[e] = acc[e] * sigmoidf_(acc[e]);
        o.x = pk2(acc[0], acc[1]); o.y = pk2(acc[2], acc[3]); o.z = pk2(acc[4], acc[5]); o.w = pk2(acc[6], acc[7]);
        *(u32x4*)(QKC + (size_t)row * 512 + c8) = o;
    }
}

constexpr int ML_QS = 0, ML_KS = 18432, ML_VT = 36864, ML_CS = 71680, ML_PS = 92416, ML_GV = 127232, ML_BV = 127744, ML_MV = 128256, ML_LF = 128768, ML_IG = 129280, ML_SC = 129792;

__device__ __forceinline__ void ml_gate_vectors(const Ctx& cx, CParams& p, int l, int dir, int b, int h, int nc, unsigned char* sm, float m_in) {
    const int tid = cx.tid, lane = tid & 63;
    float* lf = (float*)(sm + ML_LF); float* ig = (float*)(sm + ML_IG); float* gv = (float*)(sm + ML_GV); float* bv = (float*)(sm + ML_BV); float* mv = (float*)(sm + ML_MV); float* sc = (float*)(sm + ML_SC);
    const float* MLG = (const float*)(p.ws + OFF_MLG);
    const float* gb = p.in[21] + l * 16;
    if (tid < 128) {
        const int row = ml_row0(b, nc) + tid;
        const float ip = MLG[(size_t)row * 16 + dir * 4 + h] + gb[dir * 4 + h];
        const float fp = MLG[(size_t)row * 16 + 8 + dir * 4 + h] + gb[8 + dir * 4 + h];
        ig[tid] = ip; lf[tid] = fminf(fp, 0.f) - log1pf(expf(-fabsf(fp)));
    }
    __syncthreads();
    if (tid < 64) {
        const int pp0 = 2 * lane, pp1 = 2 * lane + 1; const int s0 = dir ? 127 - pp0 : pp0, s1 = dir ? 127 - pp1 : pp1;
        const float x0 = lf[s0], x1 = lf[s1];
        float incl = x0 + x1;
#pragma unroll
        for (int d = 1; d < 64; d <<= 1) { const float t = __shfl_up(incl, d); if (lane >= d) incl += t; }
        const float g1 = incl, g0 = incl - x1;
        const float gtot = __shfl(incl, 63);
        const float b0 = ig[s0] - g0, b1 = ig[s1] - g1;
        float mx = fmaxf(b0, b1);
#pragma unroll
        for (int d = 1; d < 64; d <<= 1) { const float t = __shfl_up(mx, d); if (lane >= d) mx = fmaxf(mx, t); }
        const float prev = __shfl_up(mx, 1);
        const float pm0 = lane > 0 ? fmaxf(prev, b0) : b0, pm1 = mx;
        const float bmax = __shfl(mx, 63);
        gv[s0] = g0; gv[s1] = g1; bv[s0] = b0; bv[s1] = b1; mv[s0] = fmaxf(m_in, pm0); mv[s1] = fmaxf(m_in, pm1);
        if (lane == 0) { sc[0] = gtot; sc[1] = bmax; }
    }
    __syncthreads();
}

__device__ __forceinline__ void phase_ml_local(int l, unsigned char* sm) {
    CParams& p = KPL(); const Ctx cx = mkctx();
    const int tid = cx.tid, lane = tid & 63, wid = tid >> 6;
    const bf16_t* ZA = (const bf16_t*)(p.ws + OFF_Z); const bf16_t* QKC = (const bf16_t*)(p.ws + OFF_QKC);
    float* CLOC = (float*)(p.ws + OFF_CLOC); float* MLS = (float*)(p.ws + OFF_MLS);
    bf16_t* VT = (bf16_t*)(sm + ML_VT); bf16_t* KT = (bf16_t*)(sm + ML_KS);
    const float* bv = (const float*)(sm + ML_BV); const float* sc = (const float*)(sm + ML_SC);
    float* wg = (float*)(sm + ML_LF);
    unsigned* ticket = (unsigned*)(p.ws + OFF_BAR) + 3600 + l * 16;
    int* tslot = (int*)(sm + 143328);
    for (;;) {
        if (tid == 0) *tslot = (int)__hip_atomic_fetch_add(ticket, 1u, __ATOMIC_RELAXED, __HIP_MEMORY_SCOPE_AGENT);
        __syncthreads();
        const int item = *tslot;
        __syncthreads();
        if (item >= 1056) break;
        const int chain = item / 66, nc = item % 66; const int dir = chain >> 3, b = (chain >> 2) & 1, h = chain & 3;
        ml_gate_vectors(cx, p, l, dir, b, h, nc, sm, -1e30f);
        const float gtot = sc[0], bmax = sc[1];
        __syncthreads();
        if (tid < 128) wg[tid] = expf(bv[tid] - bmax);
        __syncthreads();
        const int row0 = ml_row0(b, nc);
#pragma unroll
        for (int q = 0; q < 4; ++q) { const int ci = q * 512 + tid; const int s = ci >> 4, v8 = (ci & 15) * 8;
            const u32x4 z = *(const u32x4*)(ZA + (size_t)(row0 + s) * 2048 + 1024 + h * 128 + v8); const float w = wg[s];
            const unsigned zz[4] = {z.x, z.y, z.z, z.w};
#pragma unroll
            for (int e = 0; e < 4; ++e) { VT[(v8 + 2 * e) * 136 + s] = f2bf(bflo(zz[e]) * w); VT[(v8 + 2 * e + 1) * 136 + s] = f2bf(bfhi(zz[e]) * w); } }
#pragma unroll
        for (int q = 0; q < 2; ++q) { const int ci = q * 512 + tid; const int s = ci >> 3, k8 = (ci & 7) * 8;
            const u32x4 z = *(const u32x4*)(QKC + (size_t)(row0 + s) * 512 + 256 + h * 64 + k8);
            const unsigned zz[4] = {z.x, z.y, z.z, z.w};
#pragma unroll
            for (int e = 0; e < 4; ++e) { KT[(k8 + 2 * e) * 136 + s] = (bf16_t)(zz[e] & 0xffff); KT[(k8 + 2 * e + 1) * 136 + s] = (bf16_t)(zz[e] >> 16); } }
        __syncthreads();
        float* dst = CLOC + ((size_t)chain * 66 + nc) * 8256;
        f32x4 acc[4];
#pragma unroll
        for (int n = 0; n < 4; ++n) acc[n] = (f32x4){0.f, 0.f, 0.f, 0.f};
#pragma unroll
        for (int ks = 0; ks < 4; ++ks) {
            const bf16x8 a = *(const bf16x8*)(VT + (16 * wid + (lane & 15)) * 136 + ks * 32 + (lane >> 4) * 8);
#pragma unroll
            for (int n = 0; n < 4; ++n) { const bf16x8 bb = *(const bf16x8*)(KT + (16 * n + (lane & 15)) * 136 + ks * 32 + (lane >> 4) * 8);
                acc[n] = __builtin_amdgcn_mfma_f32_16x16x32_bf16(a, bb, acc[n], 0, 0, 0); }
        }
#pragma unroll
        for (int n = 0; n < 4; ++n)
#pragma unroll
            for (int j = 0; j < 4; ++j) dst[(16 * wid + (lane >> 4) * 4 + j) * 64 + 16 * n + (lane & 15)] = acc[n][j];
        if (tid < 64) { float s0 = 0.f, s1 = 0.f, s2 = 0.f, s3 = 0.f;
#pragma unroll 4
            for (int t = 0; t < 128; t += 4) { const u32x2 kq = *(const u32x2*)(KT + tid * 136 + t); const f32x4 w4 = *(const f32x4*)(wg + t);
                s0 += w4[0] * bflo(kq.x); s1 += w4[1] * bfhi(kq.x); s2 += w4[2] * bflo(kq.y); s3 += w4[3] * bfhi(kq.y); }
            dst[8192 + tid] = (s0 + s1) + (s2 + s3); }
        if (tid == 0) { MLS[chain * 66 + nc] = gtot; MLS[1056 + chain * 66 + nc] = gtot + bmax; }
        __syncthreads();
    }
}

__device__ __forceinline__ void phase_ml_carry() {
    CParams& p = KPL(); const Ctx cx = mkctx();
    float* CLOC = (float*)(p.ws + OFF_CLOC); float* MLS = (float*)(p.ws + OFF_MLS);
    for (int idx = cx.bid * 512 + cx.tid; idx < 16 * 8192; idx += cx.nb * 512) {
        const int chain = idx >> 13, e = idx & 8191; const int dir = chain >> 3;
        const bool two = e < 64;
        float* base = CLOC + (size_t)chain * 66 * 8256 + e;
        const float* gtp = MLS + chain * 66; const float* amp = MLS + 1056 + chain * 66;
        float m = -1e30f, C = 0.f, N = 0.f;
        for (int i0 = 0; i0 < 66; i0 += 11) {
            float cl[11], nl[11], gt[11], am[11];
#pragma unroll
            for (int q = 0; q < 11; ++q) { const int nc = ml_order(dir, i0 + q); cl[q] = base[(size_t)nc * 8256]; nl[q] = two ? base[(size_t)nc * 8256 + 8192] : 0.f; gt[q] = gtp[nc]; am[q] = amp[nc]; }
#pragma unroll
            for (int q = 0; q < 11; ++q) { const int nc = ml_order(dir, i0 + q);
                base[(size_t)nc * 8256] = C;
                if (two) base[(size_t)nc * 8256 + 8192] = N;
                if (e == 0) MLS[2112 + chain * 66 + nc] = m;
                const float mn = fmaxf(gt[q] + m, am[q]); const float so = __expf(gt[q] + m - mn), sl = __expf(am[q] - mn);
                C = so * C + sl * cl[q]; N = so * N + sl * nl[q]; m = mn; }
        }
    }
}

__device__ __forceinline__ void phase_ml_out(int l, unsigned char* sm) {
    CParams& p = KPL(); const Ctx cx = mkctx();
    const int tid = cx.tid, lane = tid & 63, wid = tid >> 6;
    const bf16_t* ZA = (const bf16_t*)(p.ws + OFF_Z); const bf16_t* QKC = (const bf16_t*)(p.ws + OFF_QKC);
    const float* CLOC = (const float*)(p.ws + OFF_CLOC); const float* MLS = (const float*)(p.ws + OFF_MLS);
    bf16_t* YB = (bf16_t*)(p.ws + OFF_YB);
    bf16_t* QS = (bf16_t*)(sm + ML_QS); bf16_t* KS = (bf16_t*)(sm + ML_KS); bf16_t* VT = (bf16_t*)(sm + ML_VT); bf16_t* CS = (bf16_t*)(sm + ML_CS); bf16_t* PS = (bf16_t*)(sm + ML_PS);
    const float* gv = (const float*)(sm + ML_GV); const float* bv = (const float*)(sm + ML_BV); const float* mv = (const float*)(sm + ML_MV);
    unsigned* ticket = (unsigned*)(p.ws + OFF_BAR) + 3608 + l * 16;
    int* tslot = (int*)(sm + 143328);
    for (;;) {
        if (tid == 0) *tslot = (int)__hip_atomic_fetch_add(ticket, 1u, __ATOMIC_RELAXED, __HIP_MEMORY_SCOPE_AGENT);
        __syncthreads();
        const int item = *tslot;
        __syncthreads();
        if (item >= 528) break;
        const int b = item / 264, h = (item / 66) & 3, nc = item % 66;
        const int row0 = ml_row0(b, nc);
        __syncthreads();
#pragma unroll
        for (int q = 0; q < 2; ++q) { const int ci = q * 512 + tid; const int s = ci >> 3, k8 = (ci & 7) * 8;
            const u32x4 zq = *(const u32x4*)(QKC + (size_t)(row0 + s) * 512 + h * 64 + k8);
            u32x4 o; o.x = pk2(bflo(zq.x) * 0.125f, bfhi(zq.x) * 0.125f); o.y = pk2(bflo(zq.y) * 0.125f, bfhi(zq.y) * 0.125f); o.z = pk2(bflo(zq.z) * 0.125f, bfhi(zq.z) * 0.125f); o.w = pk2(bflo(zq.w) * 0.125f, bfhi(zq.w) * 0.125f);
            *(u32x4*)(QS + s * 72 + k8) = o;
            *(u32x4*)(KS + s * 72 + k8) = *(const u32x4*)(QKC + (size_t)(row0 + s) * 512 + 256 + h * 64 + k8); }
#pragma unroll
        for (int q = 0; q < 4; ++q) { const int ci = q * 512 + tid; const int s = ci >> 4, v8 = (ci & 15) * 8;
            const u32x4 z = *(const u32x4*)(ZA + (size_t)(row0 + s) * 2048 + 1024 + h * 128 + v8);
            const unsigned zz[4] = {z.x, z.y, z.z, z.w};
#pragma unroll
            for (int e = 0; e < 4; ++e) { VT[(v8 + 2 * e) * 136 + s] = (bf16_t)(zz[e] & 0xffff); VT[(v8 + 2 * e + 1) * 136 + s] = (bf16_t)(zz[e] >> 16); } }
        f32x4 hsum[8];
#pragma unroll
        for (int v = 0; v < 8; ++v) hsum[v] = (f32x4){0.f, 0.f, 0.f, 0.f};
#pragma unroll 1
        for (int dir = 0; dir < 2; ++dir) {
            const int chain = dir * 8 + b * 4 + h;
            const float m_in = MLS[2112 + chain * 66 + nc];
            __syncthreads();
            ml_gate_vectors(cx, p, l, dir, b, h, nc, sm, m_in);
            const float* cin = CLOC + ((size_t)chain * 66 + nc) * 8256;
#pragma unroll
            for (int q = 0; q < 4; ++q) { const int ci = q * 512 + tid; const int v = ci >> 4, k4 = (ci & 15) * 4;
                const f32x4 c = *(const f32x4*)(cin + v * 64 + k4); store4bf(CS + v * 72 + k4, c); }
            if (tid < 16) { const f32x4 c = *(const f32x4*)(cin + 8192 + tid * 4); store4bf(CS + 128 * 72 + tid * 4, c); }
            else if (tid < 256) { const int r = 129 + (tid - 16) / 16, k4 = ((tid - 16) & 15) * 4; store4bf(CS + r * 72 + k4, (f32x4){0.f, 0.f, 0.f, 0.f}); }
            __syncthreads();
            const int tr = 16 * wid + (lane >> 4) * 4;
            float Mt[4], rs[4] = {0.f, 0.f, 0.f, 0.f};
#pragma unroll
            for (int j = 0; j < 4; ++j) Mt[j] = mv[tr + j];
            bf16x8 qa[2];
#pragma unroll
            for (int ks = 0; ks < 2; ++ks) qa[ks] = *(const bf16x8*)(QS + (16 * wid + (lane & 15)) * 72 + ks * 32 + (lane >> 4) * 8);
#pragma unroll
            for (int nt = 0; nt < 8; ++nt) {
                f32x4 s4 = (f32x4){0.f, 0.f, 0.f, 0.f};
#pragma unroll
                for (int ks = 0; ks < 2; ++ks) { const bf16x8 kb = *(const bf16x8*)(KS + (16 * nt + (lane & 15)) * 72 + ks * 32 + (lane >> 4) * 8);
                    s4 = __builtin_amdgcn_mfma_f32_16x16x32_bf16(qa[ks], kb, s4, 0, 0, 0); }
                const int s = 16 * nt + (lane & 15); const float bs = bv[s];
#pragma unroll
                for (int j = 0; j < 4; ++j) { const int t = tr + j; const bool valid = dir ? (s >= t) : (s <= t);
                    const float pv = valid ? s4[j] * __expf(bs - Mt[j]) : 0.f; rs[j] += pv; PS[t * 136 + s] = f2bf(pv); }
            }
#pragma unroll
            for (int j = 0; j < 4; ++j) rs[j] = row16_sum(rs[j]);
            __syncthreads();
            f32x4 qn = (f32x4){0.f, 0.f, 0.f, 0.f};
#pragma unroll
            for (int ks = 0; ks < 2; ++ks) { const bf16x8 cb = *(const bf16x8*)(CS + (128 + (lane & 15)) * 72 + ks * 32 + (lane >> 4) * 8);
                qn = __builtin_amdgcn_mfma_f32_16x16x32_bf16(qa[ks], cb, qn, 0, 0, 0); }
            float wi[4], dn[4];
#pragma unroll
            for (int j = 0; j < 4; ++j) { const float qnj = row16_sum(qn[j]); wi[j] = expf(m_in - Mt[j]);
                const float den = rs[j] + wi[j] * qnj; const float mt = gv[tr + j] + Mt[j]; dn[j] = 1.f / fmaxf(fabsf(den), expf(-mt)); }
            bf16x8 pa[4];
#pragma unroll
            for (int ks = 0; ks < 4; ++ks) pa[ks] = *(const bf16x8*)(PS + (16 * wid + (lane & 15)) * 136 + ks * 32 + (lane >> 4) * 8);
#pragma unroll
            for (int vt = 0; vt < 8; ++vt) {
                f32x4 a1 = (f32x4){0.f, 0.f, 0.f, 0.f}, a2 = (f32x4){0.f, 0.f, 0.f, 0.f};
#pragma unroll
                for (int ks = 0; ks < 4; ++ks) { const bf16x8 vb = *(const bf16x8*)(VT + (16 * vt + (lane & 15)) * 136 + ks * 32 + (lane >> 4) * 8);
                    a1 = __builtin_amdgcn_mfma_f32_16x16x32_bf16(pa[ks], vb, a1, 0, 0, 0); }
#pragma unroll
                for (int ks = 0; ks < 2; ++ks) { const bf16x8 cb = *(const bf16x8*)(CS + (16 * vt + (lane & 15)) * 72 + ks * 32 + (lane >> 4) * 8);
                    a2 = __builtin_amdgcn_mfma_f32_16x16x32_bf16(qa[ks], cb, a2, 0, 0, 0); }
#pragma unroll
                for (int j = 0; j < 4; ++j) hsum[vt][j] += (a1[j] + wi[j] * a2[j]) * dn[j];
            }
        }
        const int tr = 16 * wid + (lane >> 4) * 4;
        float rinv[4];
#pragma unroll
        for (int j = 0; j < 4; ++j) { float ss = 0.f;
#pragma unroll
            for (int vt = 0; vt < 8; ++vt) ss += hsum[vt][j] * hsum[vt][j];
            ss = row16_sum(ss); rinv[j] = rsqrtf(ss * (1.f / 128.f) + 1e-6f); }
#pragma unroll
        for (int vt = 0; vt < 8; ++vt) { const int ch = h * 128 + 16 * vt + (lane & 15); const float ng = p.in[22][l * 512 + ch];
#pragma unroll
            for (int j = 0; j < 4; ++j) { const int row = row0 + tr + j;
                const float o = bf2f(ZA[(size_t)row * 2048 + 1536 + ch]);
                YB[(size_t)row * 512 + ch] = f2bf(hsum[vt][j] * rinv[j] * ng * sigmoidf_(o)); } }
    }
}

__device__ __forceinline__ void phase_rw_feat(int l) {
    CParams& p = KPL(); const Ctx cx = mkctx();
    const int lane = cx.tid & 63, gw = cx.bid * 8 + (cx.tid >> 6), nw = cx.nb * 8;
    const bf16_t* ZRW = (const bf16_t*)(p.ws + OFF_ZRW);
    bf16_t* F1 = (bf16_t*)(p.ws + OFF_F1); bf16_t* LIN = (bf16_t*)(p.ws + OFF_LORAIN);
    const float* mup = p.in[23] + (size_t)l * 1792; const float* mun = p.in[24] + (size_t)l * 1792;
    const float* kk_w = p.in[30] + l * 512;
    for (int row = gw; row < T_TOK; row += nw) {
        const int b = row >= SEQA ? 1 : 0, t = row - b * SEQA;
        const bool hasp = !(t == 0 || t == NCTX), hasn = !(t == NCTX - 1 || t == SEQA - 1);
        const bf16_t* zc = ZRW + (size_t)row * 1792;
#pragma unroll
        for (int q = 0; q < 3; ++q) {
            const int col = q * 512 + lane * 8;
            const u32x4 c4 = *(const u32x4*)(zc + col);
            u32x4 p4 = (u32x4){0u, 0u, 0u, 0u}, n4 = (u32x4){0u, 0u, 0u, 0u};
            if (hasp) p4 = *(const u32x4*)(zc - 1792 + col);
            if (hasn) n4 = *(const u32x4*)(zc + 1792 + col);
            const unsigned cc[4] = {c4.x, c4.y, c4.z, c4.w}, pp[4] = {p4.x, p4.y, p4.z, p4.w}, nn[4] = {n4.x, n4.y, n4.z, n4.w};
            float zs[8];
#pragma unroll
            for (int e = 0; e < 8; ++e) { const float z = (e & 1) ? bfhi(cc[e >> 1]) : bflo(cc[e >> 1]); const float pv = (e & 1) ? bfhi(pp[e >> 1]) : bflo(pp[e >> 1]); const float nx = (e & 1) ? bfhi(nn[e >> 1]) : bflo(nn[e >> 1]);
                zs[e] = z + mup[col + e] * (pv - z) + mun[col + e] * (nx - z); }
            u32x4 o; o.x = pk2(zs[0], zs[1]); o.y = pk2(zs[2], zs[3]); o.z = pk2(zs[4], zs[5]); o.w = pk2(zs[6], zs[7]);
            *(u32x4*)(F1 + (size_t)row * 2048 + q * 512 + lane * 8) = o;
            if (q == 1) {
                float kr[8], ssq = 0.f;
#pragma unroll
                for (int e = 0; e < 8; ++e) { kr[e] = zs[e] * kk_w[lane * 8 + e]; ssq += kr[e] * kr[e]; }
                ssq = row8_sum(ssq);
                const float inv = 1.f / fmaxf(sqrtf(ssq), 1e-12f);
                u32x4 o2; o2.x = pk2(kr[0] * inv, kr[1] * inv); o2.y = pk2(kr[2] * inv, kr[3] * inv); o2.z = pk2(kr[4] * inv, kr[5] * inv); o2.w = pk2(kr[6] * inv, kr[7] * inv);
                *(u32x4*)(F1 + (size_t)row * 2048 + 1536 + lane * 8) = o2;
            }
        }
        {
            const int col = 1536 + lane * 4;
            const u32x2 c2 = *(const u32x2*)(zc + col);
            u32x2 p2 = (u32x2){0u, 0u}, n2 = (u32x2){0u, 0u};
            if (hasp) p2 = *(const u32x2*)(zc - 1792 + col);
            if (hasn) n2 = *(const u32x2*)(zc + 1792 + col);
            const unsigned cc[2] = {c2.x, c2.y}, pp[2] = {p2.x, p2.y}, nn[2] = {n2.x, n2.y};
            float zs[4];
#pragma unroll
            for (int e = 0; e < 4; ++e) { const float z = (e & 1) ? bfhi(cc[e >> 1]) : bflo(cc[e >> 1]); const float pv = (e & 1) ? bfhi(pp[e >> 1]) : bflo(pp[e >> 1]); const float nx = (e & 1) ? bfhi(nn[e >> 1]) : bflo(nn[e >> 1]);
                const float s = z + mup[col + e] * (pv - z) + mun[col + e] * (nx - z);
                zs[e] = lane < 16 ? tanhf(s) : (lane < 32 ? s : sigmoidf_(s)); }
            u32x2 o; o.x = pk2(zs[0], zs[1]); o.y = pk2(zs[2], zs[3]);
            *(u32x2*)(LIN + (size_t)row * 256 + lane * 4) = o;
        }
    }
}

__device__ __forceinline__ int rw_tok(int dir, int i) { return dir == 0 ? i : (i < NCTX ? NCTX - 1 - i : 8703 - i); }

typedef float f32x2 __attribute__((ext_vector_type(2)));
constexpr int RW_REC = 384;
__device__ __forceinline__ void rw_load(const bf16_t* f1, const bf16_t* f2, const bf16_t* fu, int ustr, int dir, int rg, int c, int pw, int lane, bf16_t (&in)[8][5], bf16_t (&vin)[8]) {
#pragma unroll
    for (int q = 0; q < 8; ++q) { const size_t t = (size_t)rw_tok(dir, c * 32 + pw * 8 + q);
        in[q][0] = f1[t * 2048 + lane]; in[q][1] = f1[t * 2048 + 512 + lane]; in[q][2] = f1[t * 2048 + 1536 + lane]; in[q][3] = fu[t * ustr + lane]; in[q][4] = f2[t * 2048 + 1024 + lane];
        vin[q] = f1[t * 2048 + 1024 + rg * 16 + (lane & 15)]; }
}
__device__ __forceinline__ void rw_emit(const bf16_t (&in)[8][5], const bf16_t (&vin)[8], int pw, int lane, float ka, float* buf) {
#pragma unroll
    for (int q = 0; q < 8; ++q) {
        const float r = bf2f(in[q][0]), k = bf2f(in[q][1]), kk = bf2f(in[q][2]), u = bf2f(in[q][3]), a = bf2f(in[q][4]);
        const float w = 1.f - u, key = k * (1.f + (a - 1.f) * ka), kka = kk * a, wr = w * r;
        const float c1 = wave_sum(kka * r), c2 = wave_sum(key * r);
        float* rec = buf + (pw * 8 + q) * RW_REC;
        rec[lane] = kk; rec[64 + lane] = wr; rec[128 + lane] = w; rec[192 + lane] = kka; rec[256 + lane] = key;
        if (lane < 16) { f32x4 vc; vc[0] = bf2f(vin[q]); vc[1] = c1; vc[2] = c2; vc[3] = 0.f; *(f32x4*)(rec + 320 + lane * 4) = vc; }
    }
}

__device__ __forceinline__ void phase_rw_scan(int l, unsigned char* sm) {
    CParams& p = KPL(); const Ctx cx = mkctx();
    const int tid = cx.tid, lane = tid & 63, wid = __builtin_amdgcn_readfirstlane(tid >> 6);
    const bf16_t* F1 = (const bf16_t*)(p.ws + OFF_F1); const bf16_t* F2 = (const bf16_t*)(p.ws + OFF_Z);
    bf16_t* YRAW = (bf16_t*)(p.ws + OFF_R2);
    float* ring = (float*)sm;
    const bool is_scan = wid < 4, is_prod = wid >= 4;
    const int pw = wid & 3;
    const int nscan = cx.nb >= 2 ? cx.nb / 2 : 1;
    if (cx.bid >= nscan) return;
    for (int item = cx.bid; item < 128; item += nscan) {
        const int chain = item >> 2, rg = item & 3; const int dir = chain >> 4, b = (chain >> 3) & 1, h = chain & 7;
        const float ka = p.in[31][l * 512 + h * 64 + lane];
        const bf16_t* f1 = F1 + (size_t)b * SEQA * 2048 + h * 64; const bf16_t* f2 = F2 + (size_t)b * SEQA * 2048 + dir * 512 + h * 64;
        const int ustr = dir ? 2048 : 512;
        const bf16_t* fu = dir ? f2 : (const bf16_t*)(p.ws + OFF_U0) + (size_t)b * SEQA * 512 + h * 64;
        const int row = rg * 16 + (wid & 3) * 4 + (lane >> 4);
        bf16_t* yr = YRAW + ((size_t)dir * T_TOK + (size_t)b * SEQA) * 512 + h * 64 + row;
        bf16_t pin[8][5], pvin[8];
        __syncthreads();
        if (is_prod) { rw_load(f1, f2, fu, ustr, dir, rg, 0, pw, lane, pin, pvin); rw_emit(pin, pvin, pw, lane, ka, ring); rw_load(f1, f2, fu, ustr, dir, rg, 1, pw, lane, pin, pvin); }
        __syncthreads();
        f32x2 S01 = (f32x2){0.f, 0.f}, S23 = (f32x2){0.f, 0.f};
        if (is_scan) __builtin_amdgcn_s_setprio(3);
#pragma unroll 1
        for (int c = 0; c < 264; ++c) {
            float* buf = ring + (c & 1) * (32 * RW_REC);
            if (is_prod) { if (c + 1 < 264) { rw_emit(pin, pvin, pw, lane, ka, ring + ((c + 1) & 1) * (32 * RW_REC)); rw_load(f1, f2, fu, ustr, dir, rg, c + 2 < 264 ? c + 2 : c + 1, pw, lane, pin, pvin); } }
            else if (is_scan) {
                const float* rb = buf + (lane & 15) * 4;
                const float* vb = buf + 320 + ((wid & 3) * 4 + (lane >> 4)) * 4;
#pragma unroll 1
                for (int hf = 0; hf < 2; ++hf) {
                    const float* rh = rb + hf * 16 * RW_REC; const float* vh = vb + hf * 16 * RW_REC;
                    f32x4 kk4 = *(const f32x4*)(rh), wr4 = *(const f32x4*)(rh + 64), w4 = *(const f32x4*)(rh + 128), ka4 = *(const f32x4*)(rh + 192), ky4 = *(const f32x4*)(rh + 256), vc4 = *(const f32x4*)(vh);
                    f32x4 nkk = *(const f32x4*)(rh + RW_REC), nwr = *(const f32x4*)(rh + RW_REC + 64), nw = *(const f32x4*)(rh + RW_REC + 128), nka = *(const f32x4*)(rh + RW_REC + 192), nky = *(const f32x4*)(rh + RW_REC + 256), nvc = *(const f32x4*)(vh + RW_REC);
                    float ybuf = 0.f;
#pragma unroll
                    for (int j = 0; j < 16; ++j) {
                        f32x4 mkk, mwr, mw, mka, mky, mvc;
                        if (j < 14) { const int o = (j + 2) * RW_REC;
                            mkk = *(const f32x4*)(rh + o); mwr = *(const f32x4*)(rh + o + 64); mw = *(const f32x4*)(rh + o + 128); mka = *(const f32x4*)(rh + o + 192); mky = *(const f32x4*)(rh + o + 256); mvc = *(const f32x4*)(vh + o); }
                        const float vv = vc4[0];
                        f32x2 p1 = S01 * (f32x2){kk4[0], kk4[1]}; p1 = S23 * (f32x2){kk4[2], kk4[3]} + p1;
                        f32x2 p2 = S01 * (f32x2){wr4[0], wr4[1]}; p2 = S23 * (f32x2){wr4[2], wr4[3]} + p2;
                        const f32x2 vv2 = (f32x2){vv, vv};
                        f32x2 u01 = (f32x2){ky4[0], ky4[1]} * vv2; u01 = S01 * (f32x2){w4[0], w4[1]} + u01;
                        f32x2 u23 = (f32x2){ky4[2], ky4[3]} * vv2; u23 = S23 * (f32x2){w4[2], w4[3]} + u23;
                        const float sk = row16_sum(p1[0] + p1[1]);
                        const float q2 = row16_sum(p2[0] + p2[1]);
                        const f32x2 nsk2 = (f32x2){-sk, -sk};
                        S01 = (f32x2){ka4[0], ka4[1]} * nsk2 + u01; S23 = (f32x2){ka4[2], ka4[3]} * nsk2 + u23;
                        const float y = q2 - sk * vc4[1] + vv * vc4[2];
                        if ((lane & 15) == j) ybuf = y;
                        kk4 = nkk; wr4 = nwr; w4 = nw; ka4 = nka; ky4 = nky; vc4 = nvc;
                        if (j < 14) { nkk = mkk; nwr = mwr; nw = mw; nka = mka; nky = mky; nvc = mvc; }
                        __builtin_amdgcn_sched_barrier(0);
                    }
                    yr[(size_t)rw_tok(dir, c * 32 + hf * 16 + (lane & 15)) * 512] = f2bf(ybuf);
                }
            }
            asm volatile("s_waitcnt lgkmcnt(0)" ::: "memory"); __builtin_amdgcn_s_barrier(); asm volatile("" ::: "memory");
        }
        if (is_scan) __builtin_amdgcn_s_setprio(0);
    }
}

__device__ __forceinline__ void phase_rw_out(int l) {
    CParams& p = KPL(); const Ctx cx = mkctx();
    const int lane = cx.tid & 63, gw = cx.bid * 8 + (cx.tid >> 6), nw = cx.nb * 8;
    const bf16_t* F1 = (const bf16_t*)(p.ws + OFF_F1); const bf16_t* F2 = (const bf16_t*)(p.ws + OFF_Z); const bf16_t* GRW = (const bf16_t*)(p.ws + OFF_ZRW);
    const bf16_t* YRAW = (const bf16_t*)(p.ws + OFF_R2);
    bf16_t* YC = (bf16_t*)(p.ws + OFF_YC);
    const int c0 = lane * 8;
    float ka[8], rk[8], lg[8], lb[8];
#pragma unroll
    for (int e = 0; e < 8; ++e) { ka[e] = p.in[31][l * 512 + c0 + e]; rk[e] = p.in[32][l * 512 + c0 + e]; lg[e] = p.in[33][l * 512 + c0 + e]; lb[e] = p.in[34][l * 512 + c0 + e]; }
    for (int row = gw; row < T_TOK; row += nw) {
        const u32x4 y0 = *(const u32x4*)(YRAW + (size_t)row * 512 + c0), y1 = *(const u32x4*)(YRAW + ((size_t)T_TOK + row) * 512 + c0);
        const u32x4 r4 = *(const u32x4*)(F1 + (size_t)row * 2048 + c0), k4 = *(const u32x4*)(F1 + (size_t)row * 2048 + 512 + c0), v4 = *(const u32x4*)(F1 + (size_t)row * 2048 + 1024 + c0);
        const u32x4 a04 = *(const u32x4*)(F2 + (size_t)row * 2048 + 1024 + c0), a14 = *(const u32x4*)(F2 + (size_t)row * 2048 + 1536 + c0);
        const u32x4 g4 = *(const u32x4*)(GRW + (size_t)row * 512 + c0);
        const unsigned ya[4] = {y0.x, y0.y, y0.z, y0.w}, yb[4] = {y1.x, y1.y, y1.z, y1.w}, rr[4] = {r4.x, r4.y, r4.z, r4.w}, kx[4] = {k4.x, k4.y, k4.z, k4.w}, vv[4] = {v4.x, v4.y, v4.z, v4.w};
        const unsigned aa[4] = {a04.x, a04.y, a04.z, a04.w}, ab[4] = {a14.x, a14.y, a14.z, a14.w}, gg[4] = {g4.x, g4.y, g4.z, g4.w};
        float y[8], sum = 0.f, bs = 0.f;
#pragma unroll
        for (int e = 0; e < 8; ++e) {
            const int w = e >> 1; const bool hi = e & 1;
            y[e] = (hi ? bfhi(ya[w]) : bflo(ya[w])) + (hi ? bfhi(yb[w]) : bflo(yb[w])); sum += y[e];
            const float r = hi ? bfhi(rr[w]) : bflo(rr[w]), k = hi ? bfhi(kx[w]) : bflo(kx[w]), a0 = hi ? bfhi(aa[w]) : bflo(aa[w]), a1 = hi ? bfhi(ab[w]) : bflo(ab[w]);
            bs += r * k * (2.f + (a0 + a1 - 2.f) * ka[e]) * rk[e];
        }
        sum = row8_sum(sum); bs = row8_sum(bs);
        const float mu = sum * (1.f / 64.f);
        float var = 0.f;
#pragma unroll
        for (int e = 0; e < 8; ++e) { const float d = y[e] - mu; var += d * d; }
        var = row8_sum(var) * (1.f / 64.f);
        const float rstd = rsqrtf(var + 64e-5f);
        float o[8];
#pragma unroll
        for (int e = 0; e < 8; ++e) { const int w = e >> 1; const bool hi = e & 1;
            const float v = hi ? bfhi(vv[w]) : bflo(vv[w]), g = hi ? bfhi(gg[w]) : bflo(gg[w]);
            o[e] = ((y[e] - mu) * rstd * lg[e] + lb[e] + bs * v) * g; }
        u32x4 o4; o4.x = pk2(o[0], o[1]); o4.y = pk2(o[2], o[3]); o4.z = pk2(o[4], o[5]); o4.w = pk2(o[6], o[7]);
        *(u32x4*)(YC + (size_t)row * 512 + c0) = o4;
    }
}

__device__ __forceinline__ void phase_final() {
    CParams& p = KPL(); const Ctx cx = mkctx();
    const int lane = cx.tid & 63, gw = cx.bid * 8 + (cx.tid >> 6), nw = cx.nb * 8;
    const float* X = (const float*)(p.ws + OFF_X);
    for (int r = gw; r < 2 * 8192; r += nw) {
        const int b = r >> 13, t = r & 8191;
        const float* src = X + ((size_t)b * SEQA + NCTX + t) * 1024;
        f32x4 v[4]; float ss = 0.f;
#pragma unroll
        for (int i = 0; i < 4; ++i) { v[i] = *(const f32x4*)(src + (lane + 64 * i) * 4); ss += v[i][0] * v[i][0] + v[i][1] * v[i][1] + v[i][2] * v[i][2] + v[i][3] * v[i][3]; }
        ss = wave_sum(ss);
        const float inv = rsqrtf(ss * (1.f / 1024.f) + 1e-6f);
#pragma unroll
        for (int i = 0; i < 4; ++i) { const int c = (lane + 64 * i) * 4; const f32x4 g4 = *(const f32x4*)(p.in[41] + c);
            *(f32x4*)(p.out + (size_t)r * 1024 + c) = v[i] * inv * g4; }
    }
}

#define XB_TMO      128
#define XB_XCNT(j)  (256  + 64 * (j))
#define XB_XSUB(j)  (1280 + 64 * (j))
#define XB_XGEN(j)  (2304 + 64 * (j))
#define XB_TOP      3328
#define XB_TOPGEN   3392
#define XCD_BAR_WORDS 3456
#define XB_SPIN_CAP (1u << 22)
constexpr int XB_LDS_OFF = 143344;
__device__ __forceinline__ unsigned xb_ld(unsigned* p)              { return __hip_atomic_load(p, __ATOMIC_RELAXED, __HIP_MEMORY_SCOPE_AGENT); }
__device__ __forceinline__ unsigned xb_add(unsigned* p, unsigned v) { return __hip_atomic_fetch_add(p, v, __ATOMIC_RELAXED, __HIP_MEMORY_SCOPE_AGENT); }
__device__ __forceinline__ unsigned xb_xcc_id() { return (unsigned)__builtin_amdgcn_s_getreg((3 << 11) | 20) & 0xFu; }
#define XB_SPIN(cond, bar) do { unsigned _sp = 0; while (cond) { __builtin_amdgcn_s_sleep(1); \
    if ((++_sp & 255u) == 0u) { if (xb_ld(&(bar)[XB_TMO])) break; if (_sp > XB_SPIN_CAP) { atomicAdd(&(bar)[XB_TMO], 1u); break; } } } } while (0)
__device__ __forceinline__ void xb_complete(unsigned* bar, unsigned x, unsigned G, unsigned& nloc, unsigned& nx) {
    unsigned sum, cnt, mine, sp = 0u;
    for (;;) {
        sum = 0u; cnt = 0u; mine = 0u;
#pragma unroll
        for (unsigned j = 0; j < 16; ++j) { const unsigned c = xb_ld(&bar[XB_XCNT(j)]); sum += c; cnt += (c > 0u) ? 1u : 0u; mine = (j == x) ? c : mine; }
        if (sum == G) break;
        __builtin_amdgcn_s_sleep(1);
        if ((++sp & 255u) == 0u) { if (xb_ld(&bar[XB_TMO])) break; if (sp > XB_SPIN_CAP) { atomicAdd(&bar[XB_TMO], 1u); break; } }
    }
    nloc = mine > 0u ? mine : 1u; nx = cnt > 0u ? cnt : 1u;
}
__device__ __forceinline__ void xb_post(unsigned char* smem) {
    CParams& p = KPL(); const Ctx cx = mkctx();
    volatile LAS unsigned* st = (volatile LAS unsigned*)((LAS unsigned char*)smem + XB_LDS_OFF);
    if (cx.tid == 0) { st[0] = 0u; st[1] = 0u; (void)xb_add(&((unsigned*)(p.ws + OFF_BAR))[XB_XCNT(xb_xcc_id())], 1u); }
    __syncthreads();
}
__device__ __forceinline__ void xsync(unsigned char* smem) {
    CParams& p = KPL(); const Ctx cx = mkctx();
    asm volatile("s_waitcnt vmcnt(0)" ::: "memory");
    __syncthreads();
    if (cx.tid == 0) {
        unsigned* bar = (unsigned*)(p.ws + OFF_BAR);
        volatile LAS unsigned* st = (volatile LAS unsigned*)((LAS unsigned char*)smem + XB_LDS_OFF);
        const unsigned x = xb_xcc_id();
        __builtin_amdgcn_s_waitcnt(0);
        unsigned nloc = st[0], nx = st[1];
        if (nloc == 0u) { xb_complete(bar, x, (unsigned)cx.nb, nloc, nx); st[0] = nloc; st[1] = nx; }
        const unsigned old = xb_add(&bar[XB_XSUB(x)], 1u);
        const unsigned gen = old / nloc;
        if (old + 1u == (gen + 1u) * nloc) {
            __builtin_amdgcn_fence(__ATOMIC_RELEASE, "agent");
            asm volatile("s_waitcnt vmcnt(0)" ::: "memory");
            const unsigned og = xb_add(&bar[XB_TOP], 1u);
            const unsigned tg = og / nx;
            if (og + 1u == (tg + 1u) * nx) xb_add(&bar[XB_TOPGEN], 1u);
            else XB_SPIN(xb_ld(&bar[XB_TOPGEN]) == tg, bar);
            __builtin_amdgcn_fence(__ATOMIC_ACQUIRE, "agent");
            xb_add(&bar[XB_XGEN(x)], 1u);
            asm volatile("s_waitcnt vmcnt(0)" ::: "memory");
        } else {
            XB_SPIN(xb_ld(&bar[XB_XGEN(x)]) == gen, bar);
            __builtin_amdgcn_fence(__ATOMIC_ACQUIRE, "agent");
            asm volatile("s_waitcnt vmcnt(0)" ::: "memory");
        }
    }
    __syncthreads();
}

__device__ __forceinline__ void s5_side_barrier(int l, int which) {
    CParams& p = KPL(); const Ctx cx = mkctx();
    const int b0 = cx.nb >= 2 ? cx.nb / 2 : 0;
    if (cx.bid < b0) return;
    unsigned* ctr = (unsigned*)(p.ws + OFF_BAR) + 3700 + l * 16 + which * 8;
    const unsigned target = (unsigned)(cx.nb - b0);
    asm volatile("s_waitcnt vmcnt(0)" ::: "memory");
    __syncthreads();
    if (cx.tid == 0) {
        __builtin_amdgcn_fence(__ATOMIC_RELEASE, "agent");
        asm volatile("s_waitcnt vmcnt(0)" ::: "memory");
        (void)xb_add(ctr, 1u);
        unsigned sp = 0u;
        while (xb_ld(ctr) < target) { __builtin_amdgcn_s_sleep(2); if (++sp > (1u << 24)) break; }
        __builtin_amdgcn_fence(__ATOMIC_ACQUIRE, "agent");
        asm volatile("s_waitcnt vmcnt(0)" ::: "memory");
    }
    __syncthreads();
}

#ifndef PHM
#define PHM 0xFFFFFFFFull
#endif
#ifndef PHR
#define PHR 0ull
#endif
#ifndef SYNCREP
#define SYNCREP 1
#endif
template <int WHICH>
__device__ __forceinline__ void gemm_stage(int l, LAS unsigned char* lds) {
    CParams& p = KPL(); const Ctx cx = mkctx();
    const int sk = (l == NLAYER - 1) ? 1 : 0;
    unsigned char* ws = p.ws;
    float* X = (float*)(ws + OFF_X); bf16_t* H = (bf16_t*)(ws + OFF_H); bf16_t* ZA = (bf16_t*)(ws + OFF_Z); bf16_t* ZRW = (bf16_t*)(ws + OFF_ZRW);
    bf16_t* W = (bf16_t*)(ws + OFF_W);
    const float* MODL = (const float*)(ws + OFF_MOD) + (size_t)l * 3 * 6144;
    if constexpr (WHICH == 0) run_gemm(cx, lds, H, W + W_MIX / 2, 4096, 1024, FInproj{ZA, (float*)(ws + OFF_MLG), ZRW});
    else if constexpr (WHICH == 1) run_gemm(cx, lds, (const bf16_t*)(ws + OFF_ZG), W + W_GLU / 2, 512, 512, FGlu{(const bf16_t*)(ws + OFF_ZG), p.in[18] + l * 512, (bf16_t*)(ws + OFF_YA)});
    else if constexpr (WHICH == 2) run_gemm_epi(cx, lds, (const bf16_t*)(ws + OFF_LORAIN), W + W_LORA / 2, 2560, 256, EpiLora{p.in[25] + l * 1024, p.in[27] + l * 1024, ZA, ZRW, (bf16_t*)(ws + OFF_U0)});
    else if constexpr (WHICH == 3) run_gemm(cx, lds, H, W + W_GATE / 2, 3072, 1024, FGate{ZA}, sk);
    else if constexpr (WHICH == 4) run_gemm(cx, lds, (const bf16_t*)(ws + OFF_YA), W + W_PA / 2, 1024, 512, FMerge<0>{ZA, (float*)(ws + OFF_F1), H}, sk);
    else if constexpr (WHICH == 5) run_gemm(cx, lds, (const bf16_t*)(ws + OFF_YB), W + W_PB / 2, 1024, 512, FMerge<1>{ZA, (float*)(ws + OFF_F1), H}, sk);
    else if constexpr (WHICH == 6) run_gemm(cx, lds, (const bf16_t*)(ws + OFF_YC), W + W_PC / 2, 1024, 512, FMerge<2>{ZA, (float*)(ws + OFF_F1), H}, sk);
    else if constexpr (WHICH == 7) run_gemm(cx, lds, H, W + W_OUT / 2, 1024, 1024, FResid{X, MODL, 2}, sk);
    else if constexpr (WHICH == 8) run_gemm(cx, lds, H, W + W_1 / 2, 4096, 1024, FMlp1{ZA}, sk);
    else run_gemm(cx, lds, ZA, W + W_2 / 2, 1024, 4096, FResid{X, MODL, 5}, sk);
}

template <int l>
__device__ __forceinline__ void run_layer(cg::grid_group& grid, LAS unsigned char* lds, float* smf, unsigned char* smem) {
        if constexpr (l == 0) phase_wconv<0>(l, smf); else phase_wconv<1>(l, smf);
        __syncthreads();
        if constexpr ((PHM >> 2) & 1) { phase_norm(l, 0, l == 0); if constexpr ((PHR >> 2) & 1) { __syncthreads(); phase_norm(l, 0, l == 0); } }
        for (int sr = 0; sr < SYNCREP; ++sr) xsync(smem);
        if constexpr ((PHM >> 3) & 1) { gemm_stage<0>(l, lds); if constexpr ((PHR >> 3) & 1) { __syncthreads(); gemm_stage<0>(l, lds); } }
        for (int sr = 0; sr < SYNCREP; ++sr) xsync(smem);
        if constexpr ((PHM >> 5) & 1) { phase_ml_conv(l); if constexpr ((PHR >> 5) & 1) { __syncthreads(); phase_ml_conv(l); } }
        for (int sr = 0; sr < SYNCREP; ++sr) xsync(smem);
        if constexpr ((PHM >> 7) & 1) { phase_ml_local(l, smem); if constexpr ((PHR >> 7) & 1) { __syncthreads(); phase_ml_local(l, smem); } }
        for (int sr = 0; sr < SYNCREP; ++sr) xsync(smem);
        if constexpr ((PHM >> 9) & 1) { phase_ml_carry(); if constexpr ((PHR >> 9) & 1) { __syncthreads(); phase_ml_carry(); } }
        for (int sr = 0; sr < SYNCREP; ++sr) xsync(smem);
        if constexpr ((PHM >> 11) & 1) { phase_ml_out(l, smem); if constexpr ((PHR >> 11) & 1) { __syncthreads(); phase_ml_out(l, smem); } }
        for (int sr = 0; sr < SYNCREP; ++sr) xsync(smem);
        if constexpr ((PHM >> 12) & 1) { phase_rw_feat(l); if constexpr ((PHR >> 12) & 1) { __syncthreads(); phase_rw_feat(l); } }
        for (int sr = 0; sr < SYNCREP; ++sr) xsync(smem);
        if constexpr ((PHM >> 13) & 1) { gemm_stage<2>(l, lds); if constexpr ((PHR >> 13) & 1) { __syncthreads(); gemm_stage<2>(l, lds); } }
        for (int sr = 0; sr < SYNCREP; ++sr) xsync(smem);
        phase_rw_scan(l, smem);
        phase_s5_local(l);
        s5_side_barrier(l, 0);
        phase_s5_carry(l);
        s5_side_barrier(l, 1);
        phase_s5_final(l, smf);
        for (int sr = 0; sr < SYNCREP; ++sr) xsync(smem);
        gemm_stage<1>(l, lds);
        if constexpr ((PHM >> 15) & 1) { phase_rw_out(l); if constexpr ((PHR >> 15) & 1) { __syncthreads(); phase_rw_out(l); } }
        for (int sr = 0; sr < SYNCREP; ++sr) xsync(smem);
        if constexpr ((PHM >> 17) & 1) { gemm_stage<3>(l, lds); if constexpr ((PHR >> 17) & 1) { __syncthreads(); gemm_stage<3>(l, lds); } }
        for (int sr = 0; sr < SYNCREP; ++sr) xsync(smem);
        if constexpr ((PHM >> 18) & 1) { gemm_stage<4>(l, lds); if constexpr ((PHR >> 18) & 1) { __syncthreads(); gemm_stage<4>(l, lds); } }
        if constexpr ((PHM >> 19) & 1) { gemm_stage<5>(l, lds); if constexpr ((PHR >> 19) & 1) { __syncthreads(); gemm_stage<5>(l, lds); } }
        if constexpr ((PHM >> 20) & 1) { gemm_stage<6>(l, lds); if constexpr ((PHR >> 20) & 1) { __syncthreads(); gemm_stage<6>(l, lds); } }
        for (int sr = 0; sr < SYNCREP; ++sr) xsync(smem);
        if constexpr ((PHM >> 21) & 1) { gemm_stage<7>(l, lds); if constexpr ((PHR >> 21) & 1) { __syncthreads(); gemm_stage<7>(l, lds); } }
        for (int sr = 0; sr < SYNCREP; ++sr) xsync(smem);
        if constexpr ((PHM >> 22) & 1) { phase_norm(l, 1, false); if constexpr ((PHR >> 22) & 1) { __syncthreads(); phase_norm(l, 1, false); } }
        for (int sr = 0; sr < SYNCREP; ++sr) xsync(smem);
        if constexpr ((PHM >> 23) & 1) { gemm_stage<8>(l, lds); if constexpr ((PHR >> 23) & 1) { __syncthreads(); gemm_stage<8>(l, lds); } }
        for (int sr = 0; sr < SYNCREP; ++sr) xsync(smem);
        gemm_stage<9>(l, lds);
        if constexpr (l < NLAYER - 1) { __syncthreads(); phase_wconv<2>(l + 1, smf); }
        for (int sr = 0; sr < SYNCREP; ++sr) xsync(smem);
    }

__global__ void __launch_bounds__(512, 2) fwd_megakernel(Params p_unused) {
    extern __shared__ __attribute__((aligned(16))) unsigned char smem[];
    cg::grid_group grid = cg::this_grid();
    LAS unsigned char* lds = (LAS unsigned char*)smem;
    float* smf = (float*)smem;

    xb_post(smem);
    phase_mod(smf); phase_s5_params();
    grid.sync();
    run_layer<0>(grid, lds, smf, smem);
    run_layer<1>(grid, lds, smf, smem);
    run_layer<2>(grid, lds, smf, smem);
    run_layer<3>(grid, lds, smf, smem);
    phase_final();
}

extern "C" void kernel_launch(void* const* d_in, const int* in_sizes, int n_in, void* d_out, int out_size, void* d_ws, size_t ws_size, hipStream_t stream) {
    static int grid_blocks = 0;
    if (grid_blocks == 0) {
        if (n_in != 42 || ws_size < WS_END) { fprintf(stderr, "kernel_launch: unexpected n_in %d / ws_size %zu\n", n_in, ws_size); grid_blocks = -1; return; }
        int dev = 0, cus = 0, per_cu = 0;
        (void)hipGetDevice(&dev);
        (void)hipDeviceGetAttribute(&cus, hipDeviceAttributeMultiprocessorCount, dev);
        if (hipFuncSetAttribute((const void*)fwd_megakernel, hipFuncAttributeMaxDynamicSharedMemorySize, LDS_BYTES) != hipSuccess) { fprintf(stderr, "kernel_launch: hipFuncSetAttribute failed\n"); grid_blocks = -1; return; }
        if (hipOccupancyMaxActiveBlocksPerMultiprocessor(&per_cu, (const void*)fwd_megakernel, 512, LDS_BYTES) != hipSuccess || per_cu < 1) { fprintf(stderr, "kernel_launch: occupancy query says %d\n", per_cu); per_cu = 1; (void)hipGetLastError(); }
        grid_blocks = cus * 1;
    }
    if (grid_blocks < 0) return;
    if (hipMemsetAsync((unsigned char*)d_ws + OFF_BAR, 0, 16384, stream) != hipSuccess) { fprintf(stderr, "kernel_launch: memset failed\n"); return; }
    Params p{};
    for (int i = 0; i < 42; ++i) p.in[i] = (const float*)d_in[i];
    p.out = (float*)d_out; p.ws = (unsigned char*)d_ws;
    void* args[] = {&p};
    hipError_t e = hipLaunchCooperativeKernel((const void*)fwd_megakernel, dim3(grid_blocks), dim3(512), args, LDS_BYTES, stream);
    if (e != hipSuccess) fprintf(stderr, "cooperative launch failed: %s (grid %d)\n", hipGetErrorString(e), grid_blocks);
}
```

```cpp
#include <hip/hip_runtime.h>
#include <hip/hip_cooperative_groups.h>
#include <cstdio>
namespace cg = cooperative_groups;

#define LAS __attribute__((address_space(3)))
typedef unsigned short bf16_t;
typedef short bf16x8 __attribute__((ext_vector_type(8)));
typedef float f32x4 __attribute__((ext_vector_type(4)));
typedef unsigned u32x4 __attribute__((ext_vector_type(4)));
typedef unsigned u32x2 __attribute__((ext_vector_type(2)));

constexpr int T_TOK = 16896, SEQA = 8448, NCTX = 256;
constexpr int NLAYER = 4;
constexpr int LDS_BYTES = 143360;
constexpr size_t OFF_X = 0;
constexpr size_t OFF_H = 69206016;
constexpr size_t OFF_Z = 103809024;
constexpr size_t OFF_ZRW = OFF_Z + 69206016;
constexpr size_t OFF_MLG = 242221056;
constexpr size_t OFF_W = 243302400;
constexpr size_t OFF_YA = 281837568;
constexpr size_t OFF_YB = 299139072;
constexpr size_t OFF_YC = 316440576;
constexpr size_t OFF_F1 = 333742080;
constexpr size_t OFF_MOD = 402948096;
constexpr size_t OFF_S5P = 403243008;
constexpr size_t OFF_MLS = OFF_S5P + 4 * 589824;
constexpr size_t OFF_R2 = OFF_MLS + 16384;
constexpr size_t OFF_BAR = OFF_R2 + 34603008;
constexpr size_t OFF_S5ST = OFF_BAR + 16384;
constexpr size_t WS_END = OFF_S5ST + 8650752;
constexpr size_t OFF_CLOC = OFF_F1;
constexpr size_t OFF_U0 = OFF_ZRW + 17301504;
constexpr size_t OFF_QKC = OFF_F1 + 43524096;
constexpr size_t OFF_ZG = OFF_ZRW + 34603008;
constexpr size_t OFF_LORAIN = OFF_R2 + 17301504;
constexpr size_t W_MIX = 0, W_GATE = 8388608, W_GLU = 14680064, W_LORA = 15204352, W_PA = 16515072, W_PB = 17563648, W_PC = 18612224, W_OUT = 19660800, W_1 = 21757952, W_2 = 30146560;

struct Params {
    const float* in[42];
    float* out;
    unsigned char* ws;
};

typedef const __attribute__((address_space(4))) Params CParams;
__device__ __forceinline__ CParams& KPL() {
    unsigned long long a = (unsigned long long)__builtin_amdgcn_kernarg_segment_ptr();
    asm volatile("" : "+s"(a));
    return *(CParams*)a;
}
struct Ctx { int tid, bid, nb; };
__device__ __forceinline__ Ctx mkctx() { Ctx c; c.tid = threadIdx.x; c.bid = blockIdx.x; c.nb = gridDim.x; asm volatile("" : "+v"(c.tid), "+s"(c.bid), "+s"(c.nb)); return c; }
__device__ __forceinline__ float bf2f(unsigned v) { return __uint_as_float(v << 16); }
__device__ __forceinline__ float bflo(unsigned w) { return __uint_as_float(w << 16); }
__device__ __forceinline__ float bfhi(unsigned w) { return __uint_as_float(w & 0xffff0000u); }
__device__ __forceinline__ bf16_t f2bf(float f) { unsigned u = __float_as_uint(f); u += 0x7FFFu + ((u >> 16) & 1u); return (bf16_t)(u >> 16); }
__device__ __forceinline__ unsigned pk2(float lo, float hi) { return (unsigned)f2bf(lo) | ((unsigned)f2bf(hi) << 16); }
__device__ __forceinline__ void store4bf(bf16_t* p, f32x4 v) { u32x2 r; r.x = pk2(v[0], v[1]); r.y = pk2(v[2], v[3]); *(u32x2*)p = r; }
__device__ __forceinline__ float sigmoidf_(float x) { return 1.f / (1.f + __expf(-x)); }

#define DPP_F(x, ctrl, rmask) __int_as_float(__builtin_amdgcn_update_dpp(0, __float_as_int(x), ctrl, rmask, 0xF, false))
__device__ __forceinline__ float row8_sum(float x) {
    x += DPP_F(x, 0xB1, 0xF); x += DPP_F(x, 0x4E, 0xF); x += DPP_F(x, 0x141, 0xF); return x;
}
__device__ __forceinline__ float row16_sum(float x) {
    x += DPP_F(x, 0xB1, 0xF); x += DPP_F(x, 0x4E, 0xF); x += DPP_F(x, 0x141, 0xF); x += DPP_F(x, 0x140, 0xF); return x;
}
__device__ __forceinline__ float wave_sum(float x) {
    x = row16_sum(x);
    x += DPP_F(x, 0x142, 0xA);
    x += DPP_F(x, 0x143, 0xC);
    return __int_as_float(__builtin_amdgcn_readlane(__float_as_int(x), 63));
}

namespace pg8 {
constexpr int BM = 256, BK = 64, HALF = 128, HTB = HALF * BK * 2, NXCD = 8, WGM = 8;
__device__ __forceinline__ int lds_byte(int r, int c) { const int st = (r >> 4) * 2 + (c >> 5), rr = r & 15, cc = c & 31, ob = rr * 64 + cc * 2; return st * 1024 + (ob ^ (((ob >> 9) & 1) << 5)); }
__device__ __forceinline__ void stage_rc(int b, int& R, int& C) { const int st = b / 1024, sb = b % 1024, swz = sb ^ (((sb >> 9) & 1) << 5); R = (st >> 1) * 16 + swz / 64; C = (st & 1) * 32 + (swz % 64) / 2; }
struct Unit { int pm, pn; };
struct Gemm { const bf16_t* A; const bf16_t* Bt; int M, N, K; };
struct StaticOrder {
    int nM, nN, nwg, G, c, skipctx;
    __device__ void init(int M, int N, int G_, int c_, int skip_ = 0) { nM = M / BM - 2 * skip_; nN = N / BM; nwg = nM * nN; G = G_; c = c_; skipctx = skip_; }
    __device__ bool next(int i, Unit& u) const {
        const long L = (long)i * G + c; if (L >= nwg) return false;
        int wgid = (int)L; { const int q = nwg / NXCD, r = nwg % NXCD, xcd = wgid % NXCD, off = wgid / NXCD; wgid = (xcd < r ? xcd * (q + 1) : r * (q + 1) + (xcd - r) * q) + off; }
        const int nig = WGM * nN, gid = wgid / nig, fm = gid * WGM, gsz = (nM - fm) < WGM ? (nM - fm) : WGM;
        u.pm = fm + ((wgid % nig) % gsz); u.pn = (wgid % nig) / gsz;
        if (skipctx) u.pm += (u.pm >= 32) ? 2 : 1;
        return true;
    }
};

template <class Epi>
__device__ __forceinline__ void gemm_phase(int tid_in, LAS unsigned char* lds, const Gemm g, const StaticOrder& S, const Epi& E) {
    const int tid = tid_in, wid = __builtin_amdgcn_readfirstlane(tid >> 6), lane = tid & 63, wr = wid >> 2, wc = wid & 3, fr = lane & 15, fq = lane >> 4;
    const int K = g.K, nt = K / BK;
    unsigned voffA[2], voffB[2];
#pragma unroll
    for (int i = 0; i < 2; ++i) { int R, C; stage_rc(tid * 16 + i * 8192, R, C); voffA[i] = (unsigned)(R * K + C) * 2u; voffB[i] = voffA[i]; }
    const size_t kstep = (size_t)(BK * 2);
    const size_t hstep = (size_t)HALF * K * 2;
    const size_t tstep = 2 * hstep;
    const unsigned ldsw = (unsigned)wid * 1024u;
    const int aoff = lds_byte(wr * 64 + fr, fq * 8), boff = lds_byte(wc * 32 + fr, fq * 8);
#define PG8_SA(b, h) (((b) * 2 + (h)) * HTB)
#define PG8_SB(b, h) ((4 + (b) * 2 + (h)) * HTB)
#define PG8_STAGE(bufoff, gbase, voff) do { _Pragma("unroll") for (int _i = 0; _i < 2; ++_i) \
        __builtin_amdgcn_global_load_lds((const unsigned*)((const char*)(gbase) + (voff)[_i]), (LAS unsigned*)(lds + (bufoff) + ldsw + _i * 8192), 16, 0, 0); } while (0)
#define PG8_LDA(dst, b, h) do { _Pragma("unroll") for (int m = 0; m < 4; ++m) _Pragma("unroll") for (int k = 0; k < 2; ++k) dst[m][k] = *(const LAS bf16x8*)(lds + PG8_SA(b, h) + aoff + m * 2048 + k * 1024); } while (0)
#define PG8_LDB(dst, b, h) do { _Pragma("unroll") for (int n = 0; n < 2; ++n) _Pragma("unroll") for (int k = 0; k < 2; ++k) dst[n][k] = *(const LAS bf16x8*)(lds + PG8_SB(b, h) + boff + n * 2048 + k * 1024); } while (0)
#define PG8_MMA(ai, bj, At, Bt) do { __builtin_amdgcn_s_setprio(1); _Pragma("unroll") for (int m = 0; m < 4; ++m) _Pragma("unroll") for (int n = 0; n < 2; ++n) _Pragma("unroll") for (int k = 0; k < 2; ++k) \
        acc[ai][bj][m][n] = __builtin_amdgcn_mfma_f32_16x16x32_bf16(Bt[n][k], At[m][k], acc[ai][bj][m][n], 0, 0, 0); __builtin_amdgcn_s_setprio(0); } while (0)
#define PG8_WAIT_V(n) asm volatile("s_waitcnt vmcnt(" #n ")" ::: "memory")
#define PG8_WAIT_L(n) asm volatile("s_waitcnt lgkmcnt(" #n ")" ::: "memory")
#define PG8_BAR __builtin_amdgcn_s_barrier()
#define PG8_SCHED __builtin_amdgcn_sched_barrier(0)
    Unit cur, nxt; int ui = 0;
    if (!S.next(0, cur)) return;
    f32x4 acc[2][2][4][2];
#pragma unroll
    for (int a = 0; a < 2; ++a)
#pragma unroll
        for (int b = 0; b < 2; ++b)
#pragma unroll
            for (int m = 0; m < 4; ++m)
#pragma unroll
                for (int n = 0; n < 2; ++n) acc[a][b][m][n] = (f32x4){0.f, 0.f, 0.f, 0.f};
    bf16x8 At[4][2], B0[2][2], B1[2][2];
    const char* cA = (const char*)g.A + (size_t)cur.pm * tstep; const char* cB = (const char*)g.Bt + (size_t)cur.pn * tstep;
    PG8_STAGE(PG8_SB(0, 0), cB, voffB); PG8_STAGE(PG8_SA(0, 0), cA, voffA); PG8_STAGE(PG8_SB(0, 1), cB + hstep, voffB); PG8_STAGE(PG8_SA(0, 1), cA + hstep, voffA);
    if (wr == 1) PG8_BAR;
    PG8_WAIT_V(4); PG8_BAR;
    PG8_STAGE(PG8_SB(1, 0), cB + kstep, voffB); PG8_STAGE(PG8_SA(1, 0), cA + kstep, voffA); PG8_STAGE(PG8_SB(1, 1), cB + hstep + kstep, voffB);
    PG8_WAIT_V(6); PG8_BAR;
    for (;;) {
        const bool has_next = S.next(ui + 1, nxt);
        const char* nA = has_next ? (const char*)g.A + (size_t)nxt.pm * tstep : cA; const char* nB = has_next ? (const char*)g.Bt + (size_t)nxt.pn * tstep : cB;
        for (int t = 0; t < nt; t += 2) {
            const bool last = (t == nt - 2);
            const char* a1 = cA + (size_t)(t + 1) * kstep;
            const char* a2 = last ? nA : cA + (size_t)(t + 2) * kstep; const char* b2 = last ? nB : cB + (size_t)(t + 2) * kstep;
            const char* a3 = a2 + kstep; const char* b3 = b2 + kstep;
            PG8_LDB(B0, 0, 0); PG8_SCHED; PG8_LDA(At, 0, 0); PG8_STAGE(PG8_SA(1, 1), a1 + hstep, voffA);
            PG8_WAIT_L(8); PG8_BAR; PG8_WAIT_L(0); PG8_MMA(0, 0, At, B0); PG8_BAR; PG8_SCHED;
            PG8_LDB(B1, 0, 1); PG8_STAGE(PG8_SB(0, 0), b2, voffB);
            PG8_BAR; PG8_WAIT_L(0); PG8_MMA(0, 1, At, B1); PG8_BAR;
            PG8_LDA(At, 0, 1); PG8_STAGE(PG8_SA(0, 0), a2, voffA);
            PG8_BAR; PG8_WAIT_L(0); PG8_MMA(1, 0, At, B0); PG8_BAR; PG8_SCHED;
            PG8_STAGE(PG8_SB(0, 1), b2 + hstep, voffB);
            PG8_WAIT_V(6); PG8_BAR; PG8_MMA(1, 1, At, B1); PG8_BAR;
            PG8_LDB(B0, 1, 0); PG8_SCHED; PG8_LDA(At, 1, 0); PG8_STAGE(PG8_SA(0, 1), a2 + hstep, voffA);
            PG8_WAIT_L(8); PG8_BAR; PG8_WAIT_L(0); PG8_MMA(0, 0, At, B0); PG8_BAR; PG8_SCHED;
            PG8_LDB(B1, 1, 1); PG8_STAGE(PG8_SB(1, 0), b3, voffB);
            PG8_BAR; PG8_WAIT_L(0); PG8_MMA(0, 1, At, B1); PG8_BAR;
            PG8_LDA(At, 1, 1); PG8_STAGE(PG8_SA(1, 0), a3, voffA);
            PG8_BAR; PG8_WAIT_L(0); PG8_MMA(1, 0, At, B0); PG8_BAR; PG8_SCHED;
            PG8_STAGE(PG8_SB(1, 1), b3 + hstep, voffB);
            PG8_WAIT_V(6); PG8_BAR; PG8_MMA(1, 1, At, B1); PG8_BAR;
        }
        E(acc, cur, wr, wc, fr, fq);
        if (!has_next) break;
#pragma unroll
        for (int a = 0; a < 2; ++a)
#pragma unroll
            for (int b = 0; b < 2; ++b)
#pragma unroll
                for (int m = 0; m < 4; ++m)
#pragma unroll
                    for (int n = 0; n < 2; ++n) acc[a][b][m][n] = (f32x4){0.f, 0.f, 0.f, 0.f};
        cur = nxt; cA = nA; cB = nB; ++ui;
    }
    PG8_WAIT_V(0);
    if (wr == 0) PG8_BAR;
    PG8_BAR;
#undef PG8_SA
#undef PG8_SB
#undef PG8_STAGE
#undef PG8_LDA
#undef PG8_LDB
#undef PG8_MMA
#undef PG8_WAIT_V
#undef PG8_WAIT_L
#undef PG8_BAR
#undef PG8_SCHED
}

template <class F> struct EpiT {
    F f;
    __device__ __forceinline__ void operator()(const f32x4 (&acc)[2][2][4][2], const Unit& u, int wr, int wc, int fr, int fq) const {
        const int row0 = u.pm * BM + wr * 64 + fr, col0 = u.pn * BM + wc * 32 + 4 * fq;
#pragma unroll
        for (int ai = 0; ai < 2; ++ai)
#pragma unroll
            for (int m = 0; m < 4; ++m) {
                const int row = row0 + ai * HALF + m * 16;
#pragma unroll
                for (int bj = 0; bj < 2; ++bj)
#pragma unroll
                    for (int n = 0; n < 2; ++n) f(row, col0 + bj * HALF + n * 16, acc[ai][bj][m][n]);
            }
    }
};
}

template <class F>
__device__ __forceinline__ void run_gemm(const Ctx& cx, LAS unsigned char* lds, const bf16_t* A, const bf16_t* Bt, int N, int K, const F& f, int skip = 0) {
    pg8::Gemm g; g.A = A; g.Bt = Bt; g.M = T_TOK; g.N = N; g.K = K;
    pg8::StaticOrder S; S.init(T_TOK, N, cx.nb, cx.bid, skip);
    pg8::EpiT<F> E{f};
    pg8::gemm_phase(cx.tid, lds, g, S, E);
}

template <class E>
__device__ __forceinline__ void run_gemm_epi(const Ctx& cx, LAS unsigned char* lds, const bf16_t* A, const bf16_t* Bt, int N, int K, const E& e) {
    pg8::Gemm g; g.A = A; g.Bt = Bt; g.M = T_TOK; g.N = N; g.K = K;
    pg8::StaticOrder S; S.init(T_TOK, N, cx.nb, cx.bid);
    pg8::gemm_phase(cx.tid, lds, g, S, e);
}
__device__ __forceinline__ int row_vec(int row) { const int b = row >= SEQA ? 1 : 0; const int t = row - b * SEQA; return t < NCTX ? 2 : b; }

struct FInproj { bf16_t* za; float* mlg; bf16_t* zrw;
    __device__ __forceinline__ void operator()(int row, int col, f32x4 v) const {
        if (col < 2048) store4bf(za + (size_t)row * 2048 + col, v);
        else if (col < 2064) *(f32x4*)(mlg + (size_t)row * 16 + (col - 2048)) = v;
        else if (col < 3856) store4bf(zrw + (size_t)row * 1792 + (col - 2064), v);
    } };
struct FGlu { const bf16_t* zg; const float* bglu; bf16_t* ya;
    __device__ __forceinline__ void operator()(int row, int col, f32x4 v) const {
        const u32x2 z = *(const u32x2*)(zg + (size_t)row * 512 + col); const f32x4 b = *(const f32x4*)(bglu + col);
        f32x4 o; o[0] = bflo(z.x) * sigmoidf_(v[0] + b[0]); o[1] = bfhi(z.x) * sigmoidf_(v[1] + b[1]); o[2] = bflo(z.y) * sigmoidf_(v[2] + b[2]); o[3] = bfhi(z.y) * sigmoidf_(v[3] + b[3]);
        store4bf(ya + (size_t)row * 512 + col, o);
    } };
struct EpiLora { const float* w0; const float* a0; bf16_t* f2; bf16_t* grw; bf16_t* u0;
    __device__ __forceinline__ void operator()(const f32x4 (&acc)[2][2][4][2], const pg8::Unit& u, int wr, int wc, int fr, int fq) const {
        const int row0 = u.pm * 256 + wr * 64 + fr, col0 = u.pn * 256 + wc * 32 + 4 * fq;
        const int pn = __builtin_amdgcn_readfirstlane(u.pn);
        if (pn < 8) {
            const float* bias = pn < 4 ? w0 : a0 - 1024;
#pragma unroll
            for (int bj = 0; bj < 2; ++bj)
#pragma unroll
                for (int n = 0; n < 2; ++n) {
                    const int col = col0 + bj * 128 + n * 16;
                    const f32x4 b = *(const f32x4*)(bias + col);
#pragma unroll
                    for (int ai = 0; ai < 2; ++ai)
#pragma unroll
                        for (int m = 0; m < 4; ++m) {
                            const int row = row0 + ai * 128 + m * 16; f32x4 o;
#pragma unroll
                            for (int e = 0; e < 4; ++e) { const float s = sigmoidf_(acc[ai][bj][m][n][e] + b[e]); o[e] = pn < 4 ? 1.f - __expf(-0.60653065971f * s) : s; }
                            if (pn < 2) store4bf(u0 + (size_t)row * 512 + col, o); else store4bf(f2 + (size_t)row * 2048 + col, o);
                        }
                }
        } else {
#pragma unroll
            for (int ai = 0; ai < 2; ++ai)
#pragma unroll
                for (int m = 0; m < 4; ++m) { const int row = row0 + ai * 128 + m * 16;
#pragma unroll
                    for (int bj = 0; bj < 2; ++bj)
#pragma unroll
                        for (int n = 0; n < 2; ++n) store4bf(grw + (size_t)row * 512 + (col0 + bj * 128 + n * 16 - 2048), acc[ai][bj][m][n]); }
        }
    } };
struct FGate { bf16_t* g;
    __device__ __forceinline__ void operator()(int row, int col, f32x4 v) const {
        f32x4 o; o[0] = sigmoidf_(v[0]); o[1] = sigmoidf_(v[1]); o[2] = sigmoidf_(v[2]); o[3] = sigmoidf_(v[3]);
        store4bf(g + (size_t)row * 3072 + col, o);
    } };
template <int J> struct FMerge { const bf16_t* g; float* y32; bf16_t* ybf;
    __device__ __forceinline__ void operator()(int row, int col, f32x4 v) const {
        const u32x2 z = *(const u32x2*)(g + (size_t)row * 3072 + J * 1024 + col);
        f32x4 o; o[0] = bflo(z.x) * v[0]; o[1] = bfhi(z.x) * v[1]; o[2] = bflo(z.y) * v[2]; o[3] = bfhi(z.y) * v[3];
        bf16_t* yp = ybf + (size_t)row * 1024 + col;
        if (J != 0) { const u32x2 t = *(const u32x2*)yp; o[0] += bflo(t.x); o[1] += bfhi(t.x); o[2] += bflo(t.y); o[3] += bfhi(t.y); }
        store4bf(yp, o);
    } };
struct FResid { float* x; const float* modl; int chunk;
    __device__ __forceinline__ void operator()(int row, int col, f32x4 v) const {
        const f32x4 mg = *(const f32x4*)(modl + row_vec(row) * 6144 + chunk * 1024 + col);
        float* xp = x + (size_t)row * 1024 + col; f32x4 t = *(f32x4*)xp; *(f32x4*)xp = t + mg * v;
    } };
struct FMlp1 { bf16_t* hid;
    __device__ __forceinline__ void operator()(int row, int col, f32x4 v) const {
        f32x4 o;
#pragma unroll
        for (int e = 0; e < 4; ++e) { const float r = fmaxf(v[e], 0.f); o[e] = r * r; }
        store4bf(hid + (size_t)row * 4096 + col, o);
    } };

__device__ __forceinline__ void phase_mod(float* smf) {
    CParams& p = KPL(); const Ctx cx = mkctx();
    const int tid = cx.tid, lane = tid & 63, wid = tid >> 6;
    float* sc = smf; float* red = smf + 3072;
    float* MOD = (float*)(p.ws + OFF_MOD);
    for (int i = tid; i < 3072; i += 512) { const int v = i >> 10, j = i & 1023; const float c = v < 2 ? p.in[1][v * 1024 + j] : p.in[3][j]; sc[i] = c / (1.f + expf(-c)); }
    __syncthreads();
    for (int item = cx.bid; item < 4 * 96; item += cx.nb) {
        const int l = item / 96, jt = item % 96, j = jt * 64 + lane;
        const float* w = p.in[4] + (size_t)l * 1024 * 6144 + j;
        float a0 = 0.f, a1 = 0.f, a2 = 0.f;
#pragma unroll 16
        for (int i = wid * 128; i < wid * 128 + 128; ++i) { const float wv = w[(size_t)i * 6144]; a0 += sc[i] * wv; a1 += sc[1024 + i] * wv; a2 += sc[2048 + i] * wv; }
        red[(wid * 3 + 0) * 64 + lane] = a0; red[(wid * 3 + 1) * 64 + lane] = a1; red[(wid * 3 + 2) * 64 + lane] = a2;
        __syncthreads();
        if (tid < 192) { const int v = tid >> 6; float s = 0.f;
            for (int w8 = 0; w8 < 8; ++w8) s += red[(w8 * 3 + v) * 64 + lane];
            MOD[(l * 3 + v) * 6144 + j] = s + p.in[5][l * 6144 + j]; }
        __syncthreads();
    }
}

__device__ __forceinline__ void dsincos(double x, double& s, double& c) {
    const double k = rint(x * 0.63661977236758134308);
    double r = fma(-k, 1.57079632679489655800, x); r = fma(-k, 6.12323399573676603587e-17, r);
    const double r2 = r * r;
    double ps = -1.0 / 355687428096000.0;
    ps = fma(ps, r2, 1.0 / 1307674368000.0); ps = fma(ps, r2, -1.0 / 6227020800.0); ps = fma(ps, r2, 1.0 / 39916800.0); ps = fma(ps, r2, -1.0 / 362880.0);
    ps = fma(ps, r2, 1.0 / 5040.0); ps = fma(ps, r2, -1.0 / 120.0); ps = fma(ps, r2, 1.0 / 6.0); ps = fma(ps, r2, -1.0); ps = -ps * r;
    double pc = 1.0 / 20922789888000.0;
    pc = fma(pc, r2, -1.0 / 87178291200.0); pc = fma(pc, r2, 1.0 / 479001600.0); pc = fma(pc, r2, -1.0 / 3628800.0); pc = fma(pc, r2, 1.0 / 40320.0);
    pc = fma(pc, r2, -1.0 / 720.0); pc = fma(pc, r2, 1.0 / 24.0); pc = fma(pc, r2, -0.5); pc = fma(pc, r2, 1.0);
    const int q = ((int)k) & 3;
    s = (q == 0) ? ps : (q == 1) ? pc : (q == 2) ? -ps : -pc;
    c = (q == 0) ? pc : (q == 1) ? -ps : (q == 2) ? -pc : ps;
}
__device__ __forceinline__ double dexp_neg(double x) {
    const double k = rint(x * 1.44269504088896338700);
    double r = fma(-k, 0.693147180369123816490, x); r = fma(-k, 1.90821492927058770002e-10, r);
    double pe = 1.0 / 6227020800.0;
    pe = fma(pe, r, 1.0 / 479001600.0); pe = fma(pe, r, 1.0 / 39916800.0); pe = fma(pe, r, 1.0 / 3628800.0); pe = fma(pe, r, 1.0 / 362880.0); pe = fma(pe, r, 1.0 / 40320.0);
    pe = fma(pe, r, 1.0 / 5040.0); pe = fma(pe, r, 1.0 / 720.0); pe = fma(pe, r, 1.0 / 120.0); pe = fma(pe, r, 1.0 / 24.0); pe = fma(pe, r, 1.0 / 6.0); pe = fma(pe, r, 0.5);
    pe = fma(pe, r, 1.0); pe = fma(pe, r, 1.0);
    int ki = (int)k; if (ki < -1000) return 0.0;
    return pe * __longlong_as_double((long long)(1023 + ki) << 52);
}

__device__ __forceinline__ void wconv_tile(const Ctx& cx, const float* src, int ld, int K, int c0, int ncols, bf16_t* dst, int kt, int nt, float* tile) {
    const int tid = cx.tid, j = tid & 63, i0 = tid >> 6;
#pragma unroll
    for (int e = 0; e < 8; ++e) { const int i = i0 + 8 * e; const int n = nt * 64 + j;
        tile[i * 65 + j] = (n < ncols) ? src[(size_t)(kt * 64 + i) * ld + c0 + n] : 0.f; }
    __syncthreads();
#pragma unroll
    for (int e = 0; e < 8; ++e) { const int jj = i0 + 8 * e;
        dst[(size_t)(nt * 64 + jj) * K + kt * 64 + j] = f2bf(tile[j * 65 + jj]); }
    __syncthreads();
}

template <int MODE>
__device__ __forceinline__ void phase_wconv(int l, float* smf) {
    CParams& p = KPL(); const Ctx cx = mkctx();
    bf16_t* W = (bf16_t*)(p.ws + OFF_W);
    const int tid = cx.tid;
    unsigned* ticket = (unsigned*)(p.ws + OFF_BAR) + 3520 + l * 16;
    int* tslot = (int*)smf + 8192;
    for (int it = (MODE == 2 ? 0 : cx.bid); ; it += cx.nb) {
        int item;
        if (MODE == 0) { item = it; if (item >= 5184) break; }
        else if (MODE == 1) { item = 3520 + it; if (item >= 4544) break; }
        else {
            if (tid == 0) *tslot = (int)__hip_atomic_fetch_add(ticket, 1u, __ATOMIC_RELAXED, __HIP_MEMORY_SCOPE_AGENT);
            __syncthreads();
            const int q = *tslot;
            __syncthreads();
            if (q >= 4160) break;
            item = q < 3520 ? q : q + 1024;
        }
        if (item < 4544) {
            const float* src; int ld, K, c0, ncols, nN; bf16_t* dst; int t = item;
            if (t < 1024) { src = p.in[8] + (size_t)l * 1024 * 6928; ld = 6928; K = 1024; c0 = 0; ncols = 3856; nN = 64; dst = W + W_MIX / 2; }
            else if (t < 1792) { t -= 1024; src = p.in[8] + (size_t)l * 1024 * 6928; ld = 6928; K = 1024; c0 = 3856; ncols = 3072; nN = 48; dst = W + W_GATE / 2; }
            else if (t < 1856) { t -= 1792; src = p.in[17] + (size_t)l * 512 * 512; ld = 512; K = 512; c0 = 0; ncols = 512; nN = 8; dst = W + W_GLU / 2; }
            else if (t < 1984) { t -= 1856; src = p.in[35] + (size_t)l * 512 * 1024; ld = 1024; K = 512; c0 = 0; ncols = 1024; nN = 16; dst = W + W_PA / 2; }
            else if (t < 2112) { t -= 1984; src = p.in[36] + (size_t)l * 512 * 1024; ld = 1024; K = 512; c0 = 0; ncols = 1024; nN = 16; dst = W + W_PB / 2; }
            else if (t < 2240) { t -= 2112; src = p.in[37] + (size_t)l * 512 * 1024; ld = 1024; K = 512; c0 = 0; ncols = 1024; nN = 16; dst = W + W_PC / 2; }
            else if (t < 2496) { t -= 2240; src = p.in[38] + (size_t)l * 1024 * 1024; ld = 1024; K = 1024; c0 = 0; ncols = 1024; nN = 16; dst = W + W_OUT / 2; }
            else if (t < 3520) { t -= 2496; src = p.in[39] + (size_t)l * 1024 * 4096; ld = 4096; K = 1024; c0 = 0; ncols = 4096; nN = 64; dst = W + W_1 / 2; }
            else { t -= 3520; src = p.in[40] + (size_t)l * 4096 * 1024; ld = 1024; K = 4096; c0 = 0; ncols = 1024; nN = 16; dst = W + W_2 / 2; }
            const int nt = t % nN, kt = t / nN;
            wconv_tile(cx, src, ld, K, c0, ncols, dst, kt, nt, smf);
        } else {
            bf16_t* dst = W + W_LORA / 2;
#pragma unroll
            for (int q = 0; q < 2; ++q) {
                const int e = (item - 4544) * 1024 + q * 512 + tid; const int n = e >> 8, k = e & 255;
                float v = 0.f;
                if (n < 1024) { if (k < 64) v = p.in[26][(((size_t)l * 2 + (n >> 9)) * 64 + k) * 512 + (n & 511)]; }
                else if (n < 2048) { if (k >= 64 && k < 128) v = p.in[28][(((size_t)l * 2 + ((n - 1024) >> 9)) * 64 + (k - 64)) * 512 + (n & 511)]; }
                else { if (k >= 128) v = p.in[29][((size_t)l * 128 + (k - 128)) * 512 + (n - 2048)]; }
                dst[e] = f2bf(v);
            }
        }
    }
}

__device__ __forceinline__ void phase_s5_params() {
    CParams& p = KPL(); const Ctx cx = mkctx();
    for (int item = cx.bid; item < 32; item += cx.nb) {
        const int l = item >> 3;
        const int idx = (item & 7) * 512 + cx.tid;
        const int dir = idx >> 11, g = (idx >> 6) & 31;
        float* S5P = (float*)(p.ws + OFF_S5P) + (size_t)l * 147456;
        const size_t pi = (size_t)l * 4096 + idx;
        const double lre = fmin((double)p.in[9][pi], -1e-4), lim = (double)p.in[10][pi];
        const double dt = dexp_neg((double)p.in[11][(l * 2 + dir) * 32 + g]);
        const double mag = dexp_neg(lre * dt); double sn, cs; dsincos(lim * dt, sn, cs);
        const double ar = mag * cs, ai = mag * sn;
        const double den = lre * lre + lim * lim, nr = ar - 1.0;
        const double cr = (nr * lre + ai * lim) / den, ci = (ai * lre - nr * lim) / den;
        const double mag64 = dexp_neg(64.0 * lre * dt); dsincos(64.0 * lim * dt, sn, cs);
        S5P[idx] = (float)ar; S5P[4096 + idx] = (float)ai; S5P[8192 + idx] = (float)(mag64 * cs); S5P[12288 + idx] = (float)(mag64 * sn);
        float* BR = S5P + 16384; float* BI = BR + 65536;
        for (int c = 0; c < 16; ++c) { const double bre = p.in[12][pi * 16 + c], bim = p.in[13][pi * 16 + c];
            BR[(size_t)idx * 16 + c] = (float)(cr * bre - ci * bim); BI[(size_t)idx * 16 + c] = (float)(cr * bim + ci * bre); }
    }
}

__device__ __forceinline__ void phase_norm(int l, int which, bool init) {
    CParams& p = KPL(); const Ctx cx = mkctx();
    const int lane = cx.tid & 63, gw = cx.bid * 8 + (cx.tid >> 6), nw = cx.nb * 8;
    float* X = (float*)(p.ws + OFF_X); bf16_t* H = (bf16_t*)(p.ws + OFF_H);
    const float* MODL = (const float*)(p.ws + OFF_MOD) + (size_t)l * 3 * 6144;
    const float* gam = p.in[which ? 7 : 6] + l * 1024;
    for (int row = gw; row < T_TOK; row += nw) {
        const int b = row >= SEQA ? 1 : 0, t = row - b * SEQA;
        const float* src = init ? (t < NCTX ? p.in[2] + ((size_t)b * NCTX + t) * 1024 : p.in[0] + ((size_t)b * 8192 + (t - NCTX)) * 1024) : X + (size_t)row * 1024;
        f32x4 v[4]; float ss = 0.f;
#pragma unroll
        for (int i = 0; i < 4; ++i) { v[i] = *(const f32x4*)(src + (lane + 64 * i) * 4); ss += v[i][0] * v[i][0] + v[i][1] * v[i][1] + v[i][2] * v[i][2] + v[i][3] * v[i][3]; }
        if (init) {
#pragma unroll
            for (int i = 0; i < 4; ++i) *(f32x4*)(X + (size_t)row * 1024 + (lane + 64 * i) * 4) = v[i];
        }
        ss = wave_sum(ss);
        const float inv = rsqrtf(ss * (1.f / 1024.f) + 1e-6f);
        const float* mv = MODL + (t < NCTX ? 2 : b) * 6144 + (which ? 3 : 0) * 1024;
#pragma unroll
        for (int i = 0; i < 4; ++i) { const int c = (lane + 64 * i) * 4;
            const f32x4 g4 = *(const f32x4*)(gam + c), sh = *(const f32x4*)(mv + c), scl = *(const f32x4*)(mv + 1024 + c);
            f32x4 o;
#pragma unroll
            for (int e = 0; e < 4; ++e) o[e] = v[i][e] * inv * g4[e] * (1.f + scl[e]) + sh[e];
            store4bf(H + (size_t)row * 1024 + c, o); }
    }
}

__device__ __forceinline__ int s5_order(int dir, int i) { return dir == 0 ? i : (i < 4 ? 3 - i : 135 - i); }

__device__ __forceinline__ void phase_s5_local(int l) {
    CParams& p = KPL(); const Ctx cx = mkctx();
    const int b0 = cx.nb >= 2 ? cx.nb / 2 : 0;
    if (cx.bid < b0) return;
    const int lane = cx.tid & 63, gw = (cx.bid - b0) * 8 + (cx.tid >> 6), nw = (cx.nb - b0) * 8;
    const bf16_t* ZA = (const bf16_t*)(p.ws + OFF_Z);
    const float* S5P = (const float*)(p.ws + OFF_S5P) + (size_t)l * 147456; const float* BR = S5P + 16384; const float* BI = BR + 65536;
    float* ST = (float*)(p.ws + OFF_S5ST);
    for (int item0 = gw; item0 < 16896; item0 += nw) {
        const int item = __builtin_amdgcn_readfirstlane(item0);
        const int chunk = item % 132, g = (item / 132) & 31, dir = (item / 4224) & 1, b = item / 8448;
        const int idx = dir * 2048 + g * 64 + lane;
        const float ar = S5P[idx], ai = S5P[4096 + idx];
        float br[16], bi[16];
#pragma unroll
        for (int q = 0; q < 4; ++q) { const f32x4 t0 = *(const f32x4*)(BR + (size_t)idx * 16 + q * 4), t1 = *(const f32x4*)(BI + (size_t)idx * 16 + q * 4);
#pragma unroll
            for (int e = 0; e < 4; ++e) { br[q * 4 + e] = t0[e]; bi[q * 4 + e] = t1[e]; } }
        const int row = b * SEQA + chunk * 64 + lane;
        const u32x4 u0 = *(const u32x4*)(ZA + (size_t)row * 2048 + g * 16), u1 = *(const u32x4*)(ZA + (size_t)row * 2048 + g * 16 + 8);
        unsigned ur[8] = {u0.x, u0.y, u0.z, u0.w, u1.x, u1.y, u1.z, u1.w};
        float hr = 0.f, hi = 0.f;
#pragma unroll 8
        for (int j = 0; j < 64; ++j) {
            const int tok = dir ? 63 - j : j;
            float bur = 0.f, bui = 0.f;
#pragma unroll
            for (int q = 0; q < 8; ++q) { const unsigned w = (unsigned)__builtin_amdgcn_readlane((int)ur[q], tok); const float x0 = bflo(w), x1 = bfhi(w);
                bur += br[2 * q] * x0 + br[2 * q + 1] * x1; bui += bi[2 * q] * x0 + bi[2 * q + 1] * x1; }
            const float nr = ar * hr - ai * hi + bur, ni = ar * hi + ai * hr + bui; hr = nr; hi = ni;
        }
        float* st = ST + ((((size_t)b * 2 + dir) * 32 + g) * 132 + chunk) * 128;
        st[lane] = hr; st[64 + lane] = hi;
    }
}

__device__ __forceinline__ void phase_s5_carry(int l) {
    CParams& p = KPL(); const Ctx cx = mkctx();
    const int b0 = cx.nb >= 2 ? cx.nb / 2 : 0;
    if (cx.bid < b0) return;
    const int lane = cx.tid & 63, gw = (cx.bid - b0) * 8 + (cx.tid >> 6), nw = (cx.nb - b0) * 8;
    const float* S5P = (const float*)(p.ws + OFF_S5P) + (size_t)l * 147456;
    float* ST = (float*)(p.ws + OFF_S5ST);
    for (int item0 = gw; item0 < 128; item0 += nw) {
        const int item = __builtin_amdgcn_readfirstlane(item0);
        const int g = item & 31, dir = (item >> 5) & 1, b = item >> 6;
        const int idx = dir * 2048 + g * 64 + lane;
        const float ar = S5P[8192 + idx], ai = S5P[12288 + idx];
        float* st = ST + (((size_t)b * 2 + dir) * 32 + g) * 132 * 128;
        float hr = 0.f, hi = 0.f;
        for (int i0 = 0; i0 < 132; i0 += 12) {
            float lr[12], li[12];
#pragma unroll
            for (int e = 0; e < 12; ++e) { const int c = s5_order(dir, i0 + e); lr[e] = st[c * 128 + lane]; li[e] = st[c * 128 + 64 + lane]; }
#pragma unroll
            for (int e = 0; e < 12; ++e) { const int c = s5_order(dir, i0 + e); st[c * 128 + lane] = hr; st[c * 128 + 64 + lane] = hi;
                const float nr = ar * hr - ai * hi + lr[e], ni = ar * hi + ai * hr + li[e]; hr = nr; hi = ni; }
        }
    }
}

template <int DIR>
__device__ __forceinline__ void s5_final_dir(CParams& p, int l, int b, int g, int chunk, int lane, const unsigned (&ur)[8], float* hst, f32x4* ybuf, int row0, float dsk, bf16_t* ZG) {
    const float* S5P = (const float*)(p.ws + OFF_S5P) + (size_t)l * 147456; const float* BR = S5P + 16384; const float* BI = BR + 65536;
    const float* ST = (const float*)(p.ws + OFF_S5ST);
    const bf16_t* ZA = (const bf16_t*)(p.ws + OFF_Z);
    const int idx = DIR * 2048 + g * 64 + lane;
    const float ar = S5P[idx], ai = S5P[4096 + idx];
    float br[16], bi[16];
#pragma unroll
    for (int q = 0; q < 4; ++q) { const f32x4 t0 = *(const f32x4*)(BR + (size_t)idx * 16 + q * 4), t1 = *(const f32x4*)(BI + (size_t)idx * 16 + q * 4);
#pragma unroll
        for (int e = 0; e < 4; ++e) { br[q * 4 + e] = t0[e]; bi[q * 4 + e] = t1[e]; } }
    float cbr[16], cbi[16];
    { const size_t cb = ((((size_t)l * 2 + DIR) * 32 + g) * 16 + (lane & 15)) * 64 + (lane >> 4);
#pragma unroll
      for (int i = 0; i < 16; ++i) { cbr[i] = p.in[14][cb + 4 * i]; cbi[i] = -p.in[15][cb + 4 * i]; } }
    const float* st = ST + ((((size_t)b * 2 + DIR) * 32 + g) * 132 + chunk) * 128;
    float hr = st[lane], hi = st[64 + lane];
    const int ch = g * 16 + (lane & 15);
#pragma unroll 1
    for (int si = 0; si < 4; ++si) {
        const int sc = DIR ? 3 - si : si;
#pragma unroll
        for (int jj = 0; jj < 16; ++jj) {
            const int tt = DIR ? 15 - jj : jj; const int tok = sc * 16 + tt;
            float bur = 0.f, bui = 0.f;
#pragma unroll
            for (int q = 0; q < 8; ++q) { const unsigned w = (unsigned)__builtin_amdgcn_readlane((int)ur[q], tok); const float x0 = bflo(w), x1 = bfhi(w);
                bur += br[2 * q] * x0 + br[2 * q + 1] * x1; bui += bi[2 * q] * x0 + bi[2 * q + 1] * x1; }
            const float nr = ar * hr - ai * hi + bur, ni = ar * hi + ai * hr + bui; hr = nr; hi = ni;
            hst[tt * 68 + lane] = hr; hst[1088 + tt * 68 + lane] = hi;
        }
        f32x4 a = (f32x4){0.f, 0.f, 0.f, 0.f};
        if (DIR) a = ybuf[sc * 64 + lane];
#pragma unroll
        for (int i = 0; i < 16; ++i) {
            const float xr = hst[(lane & 15) * 68 + 4 * i + (lane >> 4)], xi = hst[1088 + (lane & 15) * 68 + 4 * i + (lane >> 4)];
            a = __builtin_amdgcn_mfma_f32_16x16x4f32(xr, cbr[i], a, 0, 0, 0);
            a = __builtin_amdgcn_mfma_f32_16x16x4f32(xi, cbi[i], a, 0, 0, 0);
        }
        if (!DIR) ybuf[sc * 64 + lane] = a;
        else {
#pragma unroll
            for (int j = 0; j < 4; ++j) {
                const int row = row0 + sc * 16 + (lane >> 4) * 4 + j;
                const float u = bf2f(ZA[(size_t)row * 2048 + ch]);
                const float y = u * dsk + a[j];
                const float z = 0.5f * y * (1.f + tanhf(0.7978845608028654f * (y + 0.044715f * y * y * y)));
                ZG[(size_t)row * 512 + ch] = f2bf(z);
            }
        }
    }
}

__device__ __forceinline__ void phase_s5_final(int l, float* smf) {
    CParams& p = KPL(); const Ctx cx = mkctx();
    const int nscan = cx.nb >= 2 ? cx.nb / 2 : 0;
    if (cx.bid < nscan) return;
    const int lane = cx.tid & 63, wid = cx.tid >> 6, gw = (cx.bid - nscan) * 8 + wid, nw = (cx.nb - nscan) * 8;
    const bf16_t* ZA = (const bf16_t*)(p.ws + OFF_Z);
    bf16_t* ZG = (bf16_t*)(p.ws + OFF_ZG);
    float* hst = smf + wid * 3200;
    f32x4* ybuf = (f32x4*)(hst + 2176);
    for (int item0 = gw; item0 < 8448; item0 += nw) {
        const int item = __builtin_amdgcn_readfirstlane(item0);
        const int chunk = item % 132, g = (item / 132) & 31, b = item / 4224;
        const int row0 = b * SEQA + chunk * 64;
        const u32x4 u0 = *(const u32x4*)(ZA + (size_t)(row0 + lane) * 2048 + g * 16), u1 = *(const u32x4*)(ZA + (size_t)(row0 + lane) * 2048 + g * 16 + 8);
        const unsigned ur[8] = {u0.x, u0.y, u0.z, u0.w, u1.x, u1.y, u1.z, u1.w};
        const float dsk = p.in[16][l * 512 + g * 16 + (lane & 15)];
        s5_final_dir<0>(p, l, b, g, chunk, lane, ur, hst, ybuf, row0, dsk, ZG);
        s5_final_dir<1>(p, l, b, g, chunk, lane, ur, hst, ybuf, row0, dsk, ZG);
    }
}

__device__ __forceinline__ int ml_row0(int b, int nc) { return b * SEQA + nc * 128; }
__device__ __forceinline__ int ml_order(int dir, int i) { return dir == 0 ? i : (i < 2 ? 1 - i : 67 - i); }

__device__ __forceinline__ void phase_ml_conv(int l) {
    CParams& p = KPL(); const Ctx cx = mkctx();
    const bf16_t* ZA = (const bf16_t*)(p.ws + OFF_Z);
    bf16_t* QKC = (bf16_t*)(p.ws + OFF_QKC);
    const float* cw = p.in[19] + (size_t)l * 9 * 512; const float* cb = p.in[20] + l * 512;
    for (int idx = cx.bid * 512 + cx.tid; idx < T_TOK * 64; idx += cx.nb * 512) {
        const int row = idx >> 6, c8 = (idx & 63) * 8;
        const int b = row >= SEQA ? 1 : 0, t = row - b * SEQA;
        const bool isctx = t < NCTX;
        const int tt = isctx ? t : t - NCTX, W = isctx ? 256 : 64, Hh = isctx ? 1 : 128;
        const int y = tt / W, x = tt % W;
        const int segrow0 = row - tt;
        float acc[8];
#pragma unroll
        for (int e = 0; e < 8; ++e) acc[e] = cb[c8 + e];
#pragma unroll
        for (int dy = 0; dy < 3; ++dy)
#pragma unroll
            for (int dx = 0; dx < 3; ++dx) {
                const int yy = y + dy - 1, xx = x + dx - 1;
                if (yy >= 0 && yy < Hh && xx >= 0 && xx < W) {
                    const u32x4 z = *(const u32x4*)(ZA + (size_t)(segrow0 + yy * W + xx) * 2048 + 512 + c8);
                    const float* w = cw + (dy * 3 + dx) * 512 + c8;
                    const f32x4 w0 = *(const f32x4*)w, w1 = *(const f32x4*)(w + 4);
                    acc[0] += bflo(z.x) * w0[0]; acc[1] += bfhi(z.x) * w0[1]; acc[2] += bflo(z.y) * w0[2]; acc[3] += bfhi(z.y) * w0[3];
                    acc[4] += bflo(z.z) * w1[0]; acc[5] += bfhi(z.z) * w1[1]; acc[6] += bflo(z.w) * w1[2]; acc[7] += bfhi(z.w) * w1[3];
                }
            }
        u32x4 o;
#pragma unroll
        for (int e = 0; e < 8; ++e) acc[e] = acc[e] * sigmoidf_(acc[e]);
        o.x = pk2(acc[0], acc[1]); o.y = pk2(acc[2], acc[3]); o.z = pk2(acc[4], acc[5]); o.w = pk2(acc[6], acc[7]);
        *(u32x4*)(QKC + (size_t)row * 512 + c8) = o;
    }
}

constexpr int ML_QS = 0, ML_KS = 18432, ML_VT = 36864, ML_CS = 71680, ML_PS = 92416, ML_GV = 127232, ML_BV = 127744, ML_MV = 128256, ML_LF = 128768, ML_IG = 129280, ML_SC = 129792;

__device__ __forceinline__ void ml_gate_vectors(const Ctx& cx, CParams& p, int l, int dir, int b, int h, int nc, unsigned char* sm, float m_in) {
    const int tid = cx.tid, lane = tid & 63;
    float* lf = (float*)(sm + ML_LF); float* ig = (float*)(sm + ML_IG); float* gv = (float*)(sm + ML_GV); float* bv = (float*)(sm + ML_BV); float* mv = (float*)(sm + ML_MV); float* sc = (float*)(sm + ML_SC);
    const float* MLG = (const float*)(p.ws + OFF_MLG);
    const float* gb = p.in[21] + l * 16;
    if (tid < 128) {
        const int row = ml_row0(b, nc) + tid;
        const float ip = MLG[(size_t)row * 16 + dir * 4 + h] + gb[dir * 4 + h];
        const float fp = MLG[(size_t)row * 16 + 8 + dir * 4 + h] + gb[8 + dir * 4 + h];
        ig[tid] = ip; lf[tid] = fminf(fp, 0.f) - log1pf(expf(-fabsf(fp)));
    }
    __syncthreads();
    if (tid < 64) {
        const int pp0 = 2 * lane, pp1 = 2 * lane + 1; const int s0 = dir ? 127 - pp0 : pp0, s1 = dir ? 127 - pp1 : pp1;
        const float x0 = lf[s0], x1 = lf[s1];
        float incl = x0 + x1;
#pragma unroll
        for (int d = 1; d < 64; d <<= 1) { const float t = __shfl_up(incl, d); if (lane >= d) incl += t; }
        const float g1 = incl, g0 = incl - x1;
        const float gtot = __shfl(incl, 63);
        const float b0 = ig[s0] - g0, b1 = ig[s1] - g1;
        float mx = fmaxf(b0, b1);
#pragma unroll
        for (int d = 1; d < 64; d <<= 1) { const float t = __shfl_up(mx, d); if (lane >= d) mx = fmaxf(mx, t); }
        const float prev = __shfl_up(mx, 1);
        const float pm0 = lane > 0 ? fmaxf(prev, b0) : b0, pm1 = mx;
        const float bmax = __shfl(mx, 63);
        gv[s0] = g0; gv[s1] = g1; bv[s0] = b0; bv[s1] = b1; mv[s0] = fmaxf(m_in, pm0); mv[s1] = fmaxf(m_in, pm1);
        if (lane == 0) { sc[0] = gtot; sc[1] = bmax; }
    }
    __syncthreads();
}

__device__ __forceinline__ void phase_ml_local(int l, unsigned char* sm) {
    CParams& p = KPL(); const Ctx cx = mkctx();
    const int tid = cx.tid, lane = tid & 63, wid = tid >> 6;
    const bf16_t* ZA = (const bf16_t*)(p.ws + OFF_Z); const bf16_t* QKC = (const bf16_t*)(p.ws + OFF_QKC);
    float* CLOC = (float*)(p.ws + OFF_CLOC); float* MLS = (float*)(p.ws + OFF_MLS);
    bf16_t* VT = (bf16_t*)(sm + ML_VT); bf16_t* KT = (bf16_t*)(sm + ML_KS);
    const float* bv = (const float*)(sm + ML_BV); const float* sc = (const float*)(sm + ML_SC);
    float* wg = (float*)(sm + ML_LF);
    unsigned* ticket = (unsigned*)(p.ws + OFF_BAR) + 3600 + l * 16;
    int* tslot = (int*)(sm + 143328);
    for (;;) {
        if (tid == 0) *tslot = (int)__hip_atomic_fetch_add(ticket, 1u, __ATOMIC_RELAXED, __HIP_MEMORY_SCOPE_AGENT);
        __syncthreads();
        const int item = *tslot;
        __syncthreads();
        if (item >= 1056) break;
        const int chain = item / 66, nc = item % 66; const int dir = chain >> 3, b = (chain >> 2) & 1, h = chain & 3;
        ml_gate_vectors(cx, p, l, dir, b, h, nc, sm, -1e30f);
        const float gtot = sc[0], bmax = sc[1];
        __syncthreads();
        if (tid < 128) wg[tid] = expf(bv[tid] - bmax);
        __syncthreads();
        const int row0 = ml_row0(b, nc);
#pragma unroll
        for (int q = 0; q < 4; ++q) { const int ci = q * 512 + tid; const int s = ci >> 4, v8 = (ci & 15) * 8;
            const u32x4 z = *(const u32x4*)(ZA + (size_t)(row0 + s) * 2048 + 1024 + h * 128 + v8); const float w = wg[s];
            const unsigned zz[4] = {z.x, z.y, z.z, z.w};
#pragma unroll
            for (int e = 0; e < 4; ++e) { VT[(v8 + 2 * e) * 136 + s] = f2bf(bflo(zz[e]) * w); VT[(v8 + 2 * e + 1) * 136 + s] = f2bf(bfhi(zz[e]) * w); } }
#pragma unroll
        for (int q = 0; q < 2; ++q) { const int ci = q * 512 + tid; const int s = ci >> 3, k8 = (ci & 7) * 8;
            const u32x4 z = *(const u32x4*)(QKC + (size_t)(row0 + s) * 512 + 256 + h * 64 + k8);
            const unsigned zz[4] = {z.x, z.y, z.z, z.w};
#pragma unroll
            for (int e = 0; e < 4; ++e) { KT[(k8 + 2 * e) * 136 + s] = (bf16_t)(zz[e] & 0xffff); KT[(k8 + 2 * e + 1) * 136 + s] = (bf16_t)(zz[e] >> 16); } }
        __syncthreads();
        float* dst = CLOC + ((size_t)chain * 66 + nc) * 8256;
        f32x4 acc[4];
#pragma unroll
        for (int n = 0; n < 4; ++n) acc[n] = (f32x4){0.f, 0.f, 0.f, 0.f};
#pragma unroll
        for (int ks = 0; ks < 4; ++ks) {
            const bf16x8 a = *(const bf16x8*)(VT + (16 * wid + (lane & 15)) * 136 + ks * 32 + (lane >> 4) * 8);
#pragma unroll
            for (int n = 0; n < 4; ++n) { const bf16x8 bb = *(const bf16x8*)(KT + (16 * n + (lane & 15)) * 136 + ks * 32 + (lane >> 4) * 8);
                acc[n] = __builtin_amdgcn_mfma_f32_16x16x32_bf16(a, bb, acc[n], 0, 0, 0); }
        }
#pragma unroll
        for (int n = 0; n < 4; ++n)
#pragma unroll
            for (int j = 0; j < 4; ++j) dst[(16 * wid + (lane >> 4) * 4 + j) * 64 + 16 * n + (lane & 15)] = acc[n][j];
        if (tid < 64) { float s0 = 0.f, s1 = 0.f, s2 = 0.f, s3 = 0.f;
#pragma unroll 4
            for (int t = 0; t < 128; t += 4) { const u32x2 kq = *(const u32x2*)(KT + tid * 136 + t); const f32x4 w4 = *(const f32x4*)(wg + t);
                s0 += w4[0] * bflo(kq.x); s1 += w4[1] * bfhi(kq.x); s2 += w4[2] * bflo(kq.y); s3 += w4[3] * bfhi(kq.y); }
            dst[8192 + tid] = (s0 + s1) + (s2 + s3); }
        if (tid == 0) { MLS[chain * 66 + nc] = gtot; MLS[1056 + chain * 66 + nc] = gtot + bmax; }
        __syncthreads();
    }
}

__device__ __forceinline__ void phase_ml_carry() {
    CParams& p = KPL(); const Ctx cx = mkctx();
    float* CLOC = (float*)(p.ws + OFF_CLOC); float* MLS = (float*)(p.ws + OFF_MLS);
    for (int idx = cx.bid * 512 + cx.tid; idx < 16 * 8192; idx += cx.nb * 512) {
        const int chain = idx >> 13, e = idx & 8191; const int dir = chain >> 3;
        const bool two = e < 64;
        float* base = CLOC + (size_t)chain * 66 * 8256 + e;
        const float* gtp = MLS + chain * 66; const float* amp = MLS + 1056 + chain * 66;
        float m = -1e30f, C = 0.f, N = 0.f;
        for (int i0 = 0; i0 < 66; i0 += 11) {
            float cl[11], nl[11], gt[11], am[11];
#pragma unroll
            for (int q = 0; q < 11; ++q) { const int nc = ml_order(dir, i0 + q); cl[q] = base[(size_t)nc * 8256]; nl[q] = two ? base[(size_t)nc * 8256 + 8192] : 0.f; gt[q] = gtp[nc]; am[q] = amp[nc]; }
#pragma unroll
            for (int q = 0; q < 11; ++q) { const int nc = ml_order(dir, i0 + q);
                base[(size_t)nc * 8256] = C;
                if (two) base[(size_t)nc * 8256 + 8192] = N;
                if (e == 0) MLS[2112 + chain * 66 + nc] = m;
                const float mn = fmaxf(gt[q] + m, am[q]); const float so = __expf(gt[q] + m - mn), sl = __expf(am[q] - mn);
                C = so * C + sl * cl[q]; N = so * N + sl * nl[q]; m = mn; }
        }
    }
}

__device__ __forceinline__ void phase_ml_out(int l, unsigned char* sm) {
    CParams& p = KPL(); const Ctx cx = mkctx();
    const int tid = cx.tid, lane = tid & 63, wid = tid >> 6;
    const bf16_t* ZA = (const bf16_t*)(p.ws + OFF_Z); const bf16_t* QKC = (const bf16_t*)(p.ws + OFF_QKC);
    const float* CLOC = (const float*)(p.ws + OFF_CLOC); const float* MLS = (const float*)(p.ws + OFF_MLS);
    bf16_t* YB = (bf16_t*)(p.ws + OFF_YB);
    bf16_t* QS = (bf16_t*)(sm + ML_QS); bf16_t* KS = (bf16_t*)(sm + ML_KS); bf16_t* VT = (bf16_t*)(sm + ML_VT); bf16_t* CS = (bf16_t*)(sm + ML_CS); bf16_t* PS = (bf16_t*)(sm + ML_PS);
    const float* gv = (const float*)(sm + ML_GV); const float* bv = (const float*)(sm + ML_BV); const float* mv = (const float*)(sm + ML_MV);
    unsigned* ticket = (unsigned*)(p.ws + OFF_BAR) + 3608 + l * 16;
    int* tslot = (int*)(sm + 143328);
    for (;;) {
        if (tid == 0) *tslot = (int)__hip_atomic_fetch_add(ticket, 1u, __ATOMIC_RELAXED, __HIP_MEMORY_SCOPE_AGENT);
        __syncthreads();
        const int item = *tslot;
        __syncthreads();
        if (item >= 528) break;
        const int b = item / 264, h = (item / 66) & 3, nc = item % 66;
        const int row0 = ml_row0(b, nc);
        __syncthreads();
#pragma unroll
        for (int q = 0; q < 2; ++q) { const int ci = q * 512 + tid; const int s = ci >> 3, k8 = (ci & 7) * 8;
            const u32x4 zq = *(const u32x4*)(QKC + (size_t)(row0 + s) * 512 + h * 64 + k8);
            u32x4 o; o.x = pk2(bflo(zq.x) * 0.125f, bfhi(zq.x) * 0.125f); o.y = pk2(bflo(zq.y) * 0.125f, bfhi(zq.y) * 0.125f); o.z = pk2(bflo(zq.z) * 0.125f, bfhi(zq.z) * 0.125f); o.w = pk2(bflo(zq.w) * 0.125f, bfhi(zq.w) * 0.125f);
            *(u32x4*)(QS + s * 72 + k8) = o;
            *(u32x4*)(KS + s * 72 + k8) = *(const u32x4*)(QKC + (size_t)(row0 + s) * 512 + 256 + h * 64 + k8); }
#pragma unroll
        for (int q = 0; q < 4; ++q) { const int ci = q * 512 + tid; const int s = ci >> 4, v8 = (ci & 15) * 8;
            const u32x4 z = *(const u32x4*)(ZA + (size_t)(row0 + s) * 2048 + 1024 + h * 128 + v8);
            const unsigned zz[4] = {z.x, z.y, z.z, z.w};
#pragma unroll
            for (int e = 0; e < 4; ++e) { VT[(v8 + 2 * e) * 136 + s] = (bf16_t)(zz[e] & 0xffff); VT[(v8 + 2 * e + 1) * 136 + s] = (bf16_t)(zz[e] >> 16); } }
        f32x4 hsum[8];
#pragma unroll
        for (int v = 0; v < 8; ++v) hsum[v] = (f32x4){0.f, 0.f, 0.f, 0.f};
#pragma unroll 1
        for (int dir = 0; dir < 2; ++dir) {
            const int chain = dir * 8 + b * 4 + h;
            const float m_in = MLS[2112 + chain * 66 + nc];
            __syncthreads();
            ml_gate_vectors(cx, p, l, dir, b, h, nc, sm, m_in);
            const float* cin = CLOC + ((size_t)chain * 66 + nc) * 8256;
#pragma unroll
            for (int q = 0; q < 4; ++q) { const int ci = q * 512 + tid; const int v = ci >> 4, k4 = (ci & 15) * 4;
                const f32x4 c = *(const f32x4*)(cin + v * 64 + k4); store4bf(CS + v * 72 + k4, c); }
            if (tid < 16) { const f32x4 c = *(const f32x4*)(cin + 8192 + tid * 4); store4bf(CS + 128 * 72 + tid * 4, c); }
            else if (tid < 256) { const int r = 129 + (tid - 16) / 16, k4 = ((tid - 16) & 15) * 4; store4bf(CS + r * 72 + k4, (f32x4){0.f, 0.f, 0.f, 0.f}); }
            __syncthreads();
            const int tr = 16 * wid + (lane >> 4) * 4;
            float Mt[4], rs[4] = {0.f, 0.f, 0.f, 0.f};
#pragma unroll
            for (int j = 0; j < 4; ++j) Mt[j] = mv[tr + j];
            bf16x8 qa[2];
#pragma unroll
            for (int ks = 0; ks < 2; ++ks) qa[ks] = *(const bf16x8*)(QS + (16 * wid + (lane & 15)) * 72 + ks * 32 + (lane >> 4) * 8);
#pragma unroll
            for (int nt = 0; nt < 8; ++nt) {
                f32x4 s4 = (f32x4){0.f, 0.f, 0.f, 0.f};
#pragma unroll
                for (int ks = 0; ks < 2; ++ks) { const bf16x8 kb = *(const bf16x8*)(KS + (16 * nt + (lane & 15)) * 72 + ks * 32 + (lane >> 4) * 8);
                    s4 = __builtin_amdgcn_mfma_f32_16x16x32_bf16(qa[ks], kb, s4, 0, 0, 0); }
                const int s = 16 * nt + (lane & 15); const float bs = bv[s];
#pragma unroll
                for (int j = 0; j < 4; ++j) { const int t = tr + j; const bool valid = dir ? (s >= t) : (s <= t);
                    const float pv = valid ? s4[j] * __expf(bs - Mt[j]) : 0.f; rs[j] += pv; PS[t * 136 + s] = f2bf(pv); }
            }
#pragma unroll
            for (int j = 0; j < 4; ++j) rs[j] = row16_sum(rs[j]);
            __syncthreads();
            f32x4 qn = (f32x4){0.f, 0.f, 0.f, 0.f};
#pragma unroll
            for (int ks = 0; ks < 2; ++ks) { const bf16x8 cb = *(const bf16x8*)(CS + (128 + (lane & 15)) * 72 + ks * 32 + (lane >> 4) * 8);
                qn = __builtin_amdgcn_mfma_f32_16x16x32_bf16(qa[ks], cb, qn, 0, 0, 0); }
            float wi[4], dn[4];
#pragma unroll
            for (int j = 0; j < 4; ++j) { const float qnj = row16_sum(qn[j]); wi[j] = expf(m_in - Mt[j]);
                const float den = rs[j] + wi[j] * qnj; const float mt = gv[tr + j] + Mt[j]; dn[j] = 1.f / fmaxf(fabsf(den), expf(-mt)); }
            bf16x8 pa[4];
#pragma unroll
            for (int ks = 0; ks < 4; ++ks) pa[ks] = *(const bf16x8*)(PS + (16 * wid + (lane & 15)) * 136 + ks * 32 + (lane >> 4) * 8);
#pragma unroll
            for (int vt = 0; vt < 8; ++vt) {
                f32x4 a1 = (f32x4){0.f, 0.f, 0.f, 0.f}, a2 = (f32x4){0.f, 0.f, 0.f, 0.f};
#pragma unroll
                for (int ks = 0; ks < 4; ++ks) { const bf16x8 vb = *(const bf16x8*)(VT + (16 * vt + (lane & 15)) * 136 + ks * 32 + (lane >> 4) * 8);
                    a1 = __builtin_amdgcn_mfma_f32_16x16x32_bf16(pa[ks], vb, a1, 0, 0, 0); }
#pragma unroll
                for (int ks = 0; ks < 2; ++ks) { const bf16x8 cb = *(const bf16x8*)(CS + (16 * vt + (lane & 15)) * 72 + ks * 32 + (lane >> 4) * 8);
                    a2 = __builtin_amdgcn_mfma_f32_16x16x32_bf16(qa[ks], cb, a2, 0, 0, 0); }
#pragma unroll
                for (int j = 0; j < 4; ++j) hsum[vt][j] += (a1[j] + wi[j] * a2[j]) * dn[j];
            }
        }
        const int tr = 16 * wid + (lane >> 4) * 4;
        float rinv[4];
#pragma unroll
        for (int j = 0; j < 4; ++j) { float ss = 0.f;
#pragma unroll
            for (int vt = 0; vt < 8; ++vt) ss += hsum[vt][j] * hsum[vt][j];
            ss = row16_sum(ss); rinv[j] = rsqrtf(ss * (1.f / 128.f) + 1e-6f); }
#pragma unroll
        for (int vt = 0; vt < 8; ++vt) { const int ch = h * 128 + 16 * vt + (lane & 15); const float ng = p.in[22][l * 512 + ch];
#pragma unroll
            for (int j = 0; j < 4; ++j) { const int row = row0 + tr + j;
                const float o = bf2f(ZA[(size_t)row * 2048 + 1536 + ch]);
                YB[(size_t)row * 512 + ch] = f2bf(hsum[vt][j] * rinv[j] * ng * sigmoidf_(o)); } }
    }
}

__device__ __forceinline__ void phase_rw_feat(int l) {
    CParams& p = KPL(); const Ctx cx = mkctx();
    const int lane = cx.tid & 63, gw = cx.bid * 8 + (cx.tid >> 6), nw = cx.nb * 8;
    const bf16_t* ZRW = (const bf16_t*)(p.ws + OFF_ZRW);
    bf16_t* F1 = (bf16_t*)(p.ws + OFF_F1); bf16_t* LIN = (bf16_t*)(p.ws + OFF_LORAIN);
    const float* mup = p.in[23] + (size_t)l * 1792; const float* mun = p.in[24] + (size_t)l * 1792;
    const float* kk_w = p.in[30] + l * 512;
    for (int row = gw; row < T_TOK; row += nw) {
        const int b = row >= SEQA ? 1 : 0, t = row - b * SEQA;
        const bool hasp = !(t == 0 || t == NCTX), hasn = !(t == NCTX - 1 || t == SEQA - 1);
        const bf16_t* zc = ZRW + (size_t)row * 1792;
#pragma unroll
        for (int q = 0; q < 3; ++q) {
            const int col = q * 512 + lane * 8;
            const u32x4 c4 = *(const u32x4*)(zc + col);
            u32x4 p4 = (u32x4){0u, 0u, 0u, 0u}, n4 = (u32x4){0u, 0u, 0u, 0u};
            if (hasp) p4 = *(const u32x4*)(zc - 1792 + col);
            if (hasn) n4 = *(const u32x4*)(zc + 1792 + col);
            const unsigned cc[4] = {c4.x, c4.y, c4.z, c4.w}, pp[4] = {p4.x, p4.y, p4.z, p4.w}, nn[4] = {n4.x, n4.y, n4.z, n4.w};
            float zs[8];
#pragma unroll
            for (int e = 0; e < 8; ++e) { const float z = (e & 1) ? bfhi(cc[e >> 1]) : bflo(cc[e >> 1]); const float pv = (e & 1) ? bfhi(pp[e >> 1]) : bflo(pp[e >> 1]); const float nx = (e & 1) ? bfhi(nn[e >> 1]) : bflo(nn[e >> 1]);
                zs[e] = z + mup[col + e] * (pv - z) + mun[col + e] * (nx - z); }
            u32x4 o; o.x = pk2(zs[0], zs[1]); o.y = pk2(zs[2], zs[3]); o.z = pk2(zs[4], zs[5]); o.w = pk2(zs[6], zs[7]);
            *(u32x4*)(F1 + (size_t)row * 2048 + q * 512 + lane * 8) = o;
            if (q == 1) {
                float kr[8], ssq = 0.f;
#pragma unroll
                for (int e = 0; e < 8; ++e) { kr[e] = zs[e] * kk_w[lane * 8 + e]; ssq += kr[e] * kr[e]; }
                ssq = row8_sum(ssq);
                const float inv = 1.f / fmaxf(sqrtf(ssq), 1e-12f);
                u32x4 o2; o2.x = pk2(kr[0] * inv, kr[1] * inv); o2.y = pk2(kr[2] * inv, kr[3] * inv); o2.z = pk2(kr[4] * inv, kr[5] * inv); o2.w = pk2(kr[6] * inv, kr[7] * inv);
                *(u32x4*)(F1 + (size_t)row * 2048 + 1536 + lane * 8) = o2;
            }
        }
        {
            const int col = 1536 + lane * 4;
            const u32x2 c2 = *(const u32x2*)(zc + col);
            u32x2 p2 = (u32x2){0u, 0u}, n2 = (u32x2){0u, 0u};
            if (hasp) p2 = *(const u32x2*)(zc - 1792 + col);
            if (hasn) n2 = *(const u32x2*)(zc + 1792 + col);
            const unsigned cc[2] = {c2.x, c2.y}, pp[2] = {p2.x, p2.y}, nn[2] = {n2.x, n2.y};
            float zs[4];
#pragma unroll
            for (int e = 0; e < 4; ++e) { const float z = (e & 1) ? bfhi(cc[e >> 1]) : bflo(cc[e >> 1]); const float pv = (e & 1) ? bfhi(pp[e >> 1]) : bflo(pp[e >> 1]); const float nx = (e & 1) ? bfhi(nn[e >> 1]) : bflo(nn[e >> 1]);
                const float s = z + mup[col + e] * (pv - z) + mun[col + e] * (nx - z);
                zs[e] = lane < 16 ? tanhf(s) : (lane < 32 ? s : sigmoidf_(s)); }
            u32x2 o; o.x = pk2(zs[0], zs[1]); o.y = pk2(zs[2], zs[3]);
            *(u32x2*)(LIN + (size_t)row * 256 + lane * 4) = o;
        }
    }
}

__device__ __forceinline__ int rw_tok(int dir, int i) { return dir == 0 ? i : (i < NCTX ? NCTX - 1 - i : 8703 - i); }

typedef float f32x2 __attribute__((ext_vector_type(2)));
constexpr int RW_REC = 384;
__device__ __forceinline__ void rw_load(const bf16_t* f1, const bf16_t* f2, const bf16_t* fu, int ustr, int dir, int rg, int c, int pw, int lane, bf16_t (&in)[8][5], bf16_t (&vin)[8]) {
#pragma unroll
    for (int q = 0; q < 8; ++q) { const size_t t = (size_t)rw_tok(dir, c * 32 + pw * 8 + q);
        in[q][0] = f1[t * 2048 + lane]; in[q][1] = f1[t * 2048 + 512 + lane]; in[q][2] = f1[t * 2048 + 1536 + lane]; in[q][3] = fu[t * ustr + lane]; in[q][4] = f2[t * 2048 + 1024 + lane];
        vin[q] = f1[t * 2048 + 1024 + rg * 16 + (lane & 15)]; }
}
__device__ __forceinline__ void rw_emit(const bf16_t (&in)[8][5], const bf16_t (&vin)[8], int pw, int lane, float ka, float* buf) {
#pragma unroll
    for (int q = 0; q < 8; ++q) {
        const float r = bf2f(in[q][0]), k = bf2f(in[q][1]), kk = bf2f(in[q][2]), u = bf2f(in[q][3]), a = bf2f(in[q][4]);
        const float w = 1.f - u, key = k * (1.f + (a - 1.f) * ka), kka = kk * a, wr = w * r;
        const float c1 = wave_sum(kka * r), c2 = wave_sum(key * r);
        float* rec = buf + (pw * 8 + q) * RW_REC;
        rec[lane] = kk; rec[64 + lane] = wr; rec[128 + lane] = w; rec[192 + lane] = kka; rec[256 + lane] = key;
        if (lane < 16) { f32x4 vc; vc[0] = bf2f(vin[q]); vc[1] = c1; vc[2] = c2; vc[3] = 0.f; *(f32x4*)(rec + 320 + lane * 4) = vc; }
    }
}

__device__ __forceinline__ void phase_rw_scan(int l, unsigned char* sm) {
    CParams& p = KPL(); const Ctx cx = mkctx();
    const int tid = cx.tid, lane = tid & 63, wid = __builtin_amdgcn_readfirstlane(tid >> 6);
    const bf16_t* F1 = (const bf16_t*)(p.ws + OFF_F1); const bf16_t* F2 = (const bf16_t*)(p.ws + OFF_Z);
    bf16_t* YRAW = (bf16_t*)(p.ws + OFF_R2);
    float* ring = (float*)sm;
    const bool is_scan = wid < 4, is_prod = wid >= 4;
    const int pw = wid & 3;
    const int nscan = cx.nb >= 2 ? cx.nb / 2 : 1;
    if (cx.bid >= nscan) return;
    for (int item = cx.bid; item < 128; item += nscan) {
        const int chain = item >> 2, rg = item & 3; const int dir = chain >> 4, b = (chain >> 3) & 1, h = chain & 7;
        const float ka = p.in[31][l * 512 + h * 64 + lane];
        const bf16_t* f1 = F1 + (size_t)b * SEQA * 2048 + h * 64; const bf16_t* f2 = F2 + (size_t)b * SEQA * 2048 + dir * 512 + h * 64;
        const int ustr = dir ? 2048 : 512;
        const bf16_t* fu = dir ? f2 : (const bf16_t*)(p.ws + OFF_U0) + (size_t)b * SEQA * 512 + h * 64;
        const int row = rg * 16 + (wid & 3) * 4 + (lane >> 4);
        bf16_t* yr = YRAW + ((size_t)dir * T_TOK + (size_t)b * SEQA) * 512 + h * 64 + row;
        bf16_t pin[8][5], pvin[8];
        __syncthreads();
        if (is_prod) { rw_load(f1, f2, fu, ustr, dir, rg, 0, pw, lane, pin, pvin); rw_emit(pin, pvin, pw, lane, ka, ring); rw_load(f1, f2, fu, ustr, dir, rg, 1, pw, lane, pin, pvin); }
        __syncthreads();
        f32x2 S01 = (f32x2){0.f, 0.f}, S23 = (f32x2){0.f, 0.f};
        if (is_scan) __builtin_amdgcn_s_setprio(3);
#pragma unroll 1
        for (int c = 0; c < 264; ++c) {
            float* buf = ring + (c & 1) * (32 * RW_REC);
            if (is_prod) { if (c + 1 < 264) { rw_emit(pin, pvin, pw, lane, ka, ring + ((c + 1) & 1) * (32 * RW_REC)); rw_load(f1, f2, fu, ustr, dir, rg, c + 2 < 264 ? c + 2 : c + 1, pw, lane, pin, pvin); } }
            else if (is_scan) {
                const float* rb = buf + (lane & 15) * 4;
                const float* vb = buf + 320 + ((wid & 3) * 4 + (lane >> 4)) * 4;
#pragma unroll 1
                for (int hf = 0; hf < 2; ++hf) {
                    const float* rh = rb + hf * 16 * RW_REC; const float* vh = vb + hf * 16 * RW_REC;
                    f32x4 kk4 = *(const f32x4*)(rh), wr4 = *(const f32x4*)(rh + 64), w4 = *(const f32x4*)(rh + 128), ka4 = *(const f32x4*)(rh + 192), ky4 = *(const f32x4*)(rh + 256), vc4 = *(const f32x4*)(vh);
                    f32x4 nkk = *(const f32x4*)(rh + RW_REC), nwr = *(const f32x4*)(rh + RW_REC + 64), nw = *(const f32x4*)(rh + RW_REC + 128), nka = *(const f32x4*)(rh + RW_REC + 192), nky = *(const f32x4*)(rh + RW_REC + 256), nvc = *(const f32x4*)(vh + RW_REC);
                    float ybuf = 0.f;
#pragma unroll
                    for (int j = 0; j < 16; ++j) {
                        f32x4 mkk, mwr, mw, mka, mky, mvc;
                        if (j < 14) { const int o = (j + 2) * RW_REC;
                            mkk = *(const f32x4*)(rh + o); mwr = *(const f32x4*)(rh + o + 64); mw = *(const f32x4*)(rh + o + 128); mka = *(const f32x4*)(rh + o + 192); mky = *(const f32x4*)(rh + o + 256); mvc = *(const f32x4*)(vh + o); }
                        const float vv = vc4[0];
                        f32x2 p1 = S01 * (f32x2){kk4[0], kk4[1]}; p1 = S23 * (f32x2){kk4[2], kk4[3]} + p1;
                        f32x2 p2 = S01 * (f32x2){wr4[0], wr4[1]}; p2 = S23 * (f32x2){wr4[2], wr4[3]} + p2;
                        const f32x2 vv2 = (f32x2){vv, vv};
                        f32x2 u01 = (f32x2){ky4[0], ky4[1]} * vv2; u01 = S01 * (f32x2){w4[0], w4[1]} + u01;
                        f32x2 u23 = (f32x2){ky4[2], ky4[3]} * vv2; u23 = S23 * (f32x2){w4[2], w4[3]} + u23;
                        const float sk = row16_sum(p1[0] + p1[1]);
                        const float q2 = row16_sum(p2[0] + p2[1]);
                        const f32x2 nsk2 = (f32x2){-sk, -sk};
                        S01 = (f32x2){ka4[0], ka4[1]} * nsk2 + u01; S23 = (f32x2){ka4[2], ka4[3]} * nsk2 + u23;
                        const float y = q2 - sk * vc4[1] + vv * vc4[2];
                        if ((lane & 15) == j) ybuf = y;
                        kk4 = nkk; wr4 = nwr; w4 = nw; ka4 = nka; ky4 = nky; vc4 = nvc;
                        if (j < 14) { nkk = mkk; nwr = mwr; nw = mw; nka = mka; nky = mky; nvc = mvc; }
                        __builtin_amdgcn_sched_barrier(0);
                    }
                    yr[(size_t)rw_tok(dir, c * 32 + hf * 16 + (lane & 15)) * 512] = f2bf(ybuf);
                }
            }
            asm volatile("s_waitcnt lgkmcnt(0)" ::: "memory"); __builtin_amdgcn_s_barrier(); asm volatile("" ::: "memory");
        }
        if (is_scan) __builtin_amdgcn_s_setprio(0);
    }
}

__device__ __forceinline__ void phase_rw_out(int l) {
    CParams& p = KPL(); const Ctx cx = mkctx();
    const int lane = cx.tid & 63, gw = cx.bid * 8 + (cx.tid >> 6), nw = cx.nb * 8;
    const bf16_t* F1 = (const bf16_t*)(p.ws + OFF_F1); const bf16_t* F2 = (const bf16_t*)(p.ws + OFF_Z); const bf16_t* GRW = (const bf16_t*)(p.ws + OFF_ZRW);
    const bf16_t* YRAW = (const bf16_t*)(p.ws + OFF_R2);
    bf16_t* YC = (bf16_t*)(p.ws + OFF_YC);
    const int c0 = lane * 8;
    float ka[8], rk[8], lg[8], lb[8];
#pragma unroll
    for (int e = 0; e < 8; ++e) { ka[e] = p.in[31][l * 512 + c0 + e]; rk[e] = p.in[32][l * 512 + c0 + e]; lg[e] = p.in[33][l * 512 + c0 + e]; lb[e] = p.in[34][l * 512 + c0 + e]; }
    for (int row = gw; row < T_TOK; row += nw) {
        const u32x4 y0 = *(const u32x4*)(YRAW + (size_t)row * 512 + c0), y1 = *(const u32x4*)(YRAW + ((size_t)T_TOK + row) * 512 + c0);
        const u32x4 r4 = *(const u32x4*)(F1 + (size_t)row * 2048 + c0), k4 = *(const u32x4*)(F1 + (size_t)row * 2048 + 512 + c0), v4 = *(const u32x4*)(F1 + (size_t)row * 2048 + 1024 + c0);
        const u32x4 a04 = *(const u32x4*)(F2 + (size_t)row * 2048 + 1024 + c0), a14 = *(const u32x4*)(F2 + (size_t)row * 2048 + 1536 + c0);
        const u32x4 g4 = *(const u32x4*)(GRW + (size_t)row * 512 + c0);
        const unsigned ya[4] = {y0.x, y0.y, y0.z, y0.w}, yb[4] = {y1.x, y1.y, y1.z, y1.w}, rr[4] = {r4.x, r4.y, r4.z, r4.w}, kx[4] = {k4.x, k4.y, k4.z, k4.w}, vv[4] = {v4.x, v4.y, v4.z, v4.w};
        const unsigned aa[4] = {a04.x, a04.y, a04.z, a04.w}, ab[4] = {a14.x, a14.y, a14.z, a14.w}, gg[4] = {g4.x, g4.y, g4.z, g4.w};
        float y[8], sum = 0.f, bs = 0.f;
#pragma unroll
        for (int e = 0; e < 8; ++e) {
            const int w = e >> 1; const bool hi = e & 1;
            y[e] = (hi ? bfhi(ya[w]) : bflo(ya[w])) + (hi ? bfhi(yb[w]) : bflo(yb[w])); sum += y[e];
            const float r = hi ? bfhi(rr[w]) : bflo(rr[w]), k = hi ? bfhi(kx[w]) : bflo(kx[w]), a0 = hi ? bfhi(aa[w]) : bflo(aa[w]), a1 = hi ? bfhi(ab[w]) : bflo(ab[w]);
            bs += r * k * (2.f + (a0 + a1 - 2.f) * ka[e]) * rk[e];
        }
        sum = row8_sum(sum); bs = row8_sum(bs);
        const float mu = sum * (1.f / 64.f);
        float var = 0.f;
#pragma unroll
        for (int e = 0; e < 8; ++e) { const float d = y[e] - mu; var += d * d; }
        var = row8_sum(var) * (1.f / 64.f);
        const float rstd = rsqrtf(var + 64e-5f);
        float o[8];
#pragma unroll
        for (int e = 0; e < 8; ++e) { const int w = e >> 1; const bool hi = e & 1;
            const float v = hi ? bfhi(vv[w]) : bflo(vv[w]), g = hi ? bfhi(gg[w]) : bflo(gg[w]);
            o[e] = ((y[e] - mu) * rstd * lg[e] + lb[e] + bs * v) * g; }
        u32x4 o4; o4.x = pk2(o[0], o[1]); o4.y = pk2(o[2], o[3]); o4.z = pk2(o[4], o[5]); o4.w = pk2(o[6], o[7]);
        *(u32x4*)(YC + (size_t)row * 512 + c0) = o4;
    }
}

__device__ __forceinline__ void phase_final() {
    CParams& p = KPL(); const Ctx cx = mkctx();
    const int lane = cx.tid & 63, gw = cx.bid * 8 + (cx.tid >> 6), nw = cx.nb * 8;
    const float* X = (const float*)(p.ws + OFF_X);
    for (int r = gw; r < 2 * 8192; r += nw) {
        const int b = r >> 13, t = r & 8191;
        const float* src = X + ((size_t)b * SEQA + NCTX + t) * 1024;
        f32x4 v[4]; float ss = 0.f;
#pragma unroll
        for (int i = 0; i < 4; ++i) { v[i] = *(const f32x4*)(src + (lane + 64 * i) * 4); ss += v[i][0] * v[i][0] + v[i][1] * v[i][1] + v[i][2] * v[i][2] + v[i][3] * v[i][3]; }
        ss = wave_sum(ss);
        const float inv = rsqrtf(ss * (1.f / 1024.f) + 1e-6f);
#pragma unroll
        for (int i = 0; i < 4; ++i) { const int c = (lane + 64 * i) * 4; const f32x4 g4 = *(const f32x4*)(p.in[41] + c);
            *(f32x4*)(p.out + (size_t)r * 1024 + c) = v[i] * inv * g4; }
    }
}

#define XB_TMO      128
#define XB_XCNT(j)  (256  + 64 * (j))
#define XB_XSUB(j)  (1280 + 64 * (j))
#define XB_XGEN(j)  (2304 + 64 * (j))
#define XB_TOP      3328
#define XB_TOPGEN   3392
#define XCD_BAR_WORDS 3456
#define XB_SPIN_CAP (1u << 22)
constexpr int XB_LDS_OFF = 143344;
__device__ __forceinline__ unsigned xb_ld(unsigned* p)              { return __hip_atomic_load(p, __ATOMIC_RELAXED, __HIP_MEMORY_SCOPE_AGENT); }
__device__ __forceinline__ unsigned xb_add(unsigned* p, unsigned v) { return __hip_atomic_fetch_add(p, v, __ATOMIC_RELAXED, __HIP_MEMORY_SCOPE_AGENT); }
__device__ __forceinline__ unsigned xb_xcc_id() { return (unsigned)__builtin_amdgcn_s_getreg((3 << 11) | 20) & 0xFu; }
#define XB_SPIN(cond, bar) do { unsigned _sp = 0; while (cond) { __builtin_amdgcn_s_sleep(1); \
    if ((++_sp & 255u) == 0u) { if (xb_ld(&(bar)[XB_TMO])) break; if (_sp > XB_SPIN_CAP) { atomicAdd(&(bar)[XB_TMO], 1u); break; } } } } while (0)
__device__ __forceinline__ void xb_complete(unsigned* bar, unsigned x, unsigned G, unsigned& nloc, unsigned& nx) {
    unsigned sum, cnt, mine, sp = 0u;
    for (;;) {
        sum = 0u; cnt = 0u; mine = 0u;
#pragma unroll
        for (unsigned j = 0; j < 16; ++j) { const unsigned c = xb_ld(&bar[XB_XCNT(j)]); sum += c; cnt += (c > 0u) ? 1u : 0u; mine = (j == x) ? c : mine; }
        if (sum == G) break;
        __builtin_amdgcn_s_sleep(1);
        if ((++sp & 255u) == 0u) { if (xb_ld(&bar[XB_TMO])) break; if (sp > XB_SPIN_CAP) { atomicAdd(&bar[XB_TMO], 1u); break; } }
    }
    nloc = mine > 0u ? mine : 1u; nx = cnt > 0u ? cnt : 1u;
}
__device__ __forceinline__ void xb_post(unsigned char* smem) {
    CParams& p = KPL(); const Ctx cx = mkctx();
    volatile LAS unsigned* st = (volatile LAS unsigned*)((LAS unsigned char*)smem + XB_LDS_OFF);
    if (cx.tid == 0) { st[0] = 0u; st[1] = 0u; (void)xb_add(&((unsigned*)(p.ws + OFF_BAR))[XB_XCNT(xb_xcc_id())], 1u); }
    __syncthreads();
}
__device__ __forceinline__ void xsync(unsigned char* smem) {
    CParams& p = KPL(); const Ctx cx = mkctx();
    asm volatile("s_waitcnt vmcnt(0)" ::: "memory");
    __syncthreads();
    if (cx.tid == 0) {
        unsigned* bar = (unsigned*)(p.ws + OFF_BAR);
        volatile LAS unsigned* st = (volatile LAS unsigned*)((LAS unsigned char*)smem + XB_LDS_OFF);
        const unsigned x = xb_xcc_id();
        __builtin_amdgcn_s_waitcnt(0);
        unsigned nloc = st[0], nx = st[1];
        if (nloc == 0u) { xb_complete(bar, x, (unsigned)cx.nb, nloc, nx); st[0] = nloc; st[1] = nx; }
        const unsigned old = xb_add(&bar[XB_XSUB(x)], 1u);
        const unsigned gen = old / nloc;
        if (old + 1u == (gen + 1u) * nloc) {
            __builtin_amdgcn_fence(__ATOMIC_RELEASE, "agent");
            asm volatile("s_waitcnt vmcnt(0)" ::: "memory");
            const unsigned og = xb_add(&bar[XB_TOP], 1u);
            const unsigned tg = og / nx;
            if (og + 1u == (tg + 1u) * nx) xb_add(&bar[XB_TOPGEN], 1u);
            else XB_SPIN(xb_ld(&bar[XB_TOPGEN]) == tg, bar);
            __builtin_amdgcn_fence(__ATOMIC_ACQUIRE, "agent");
            xb_add(&bar[XB_XGEN(x)], 1u);
            asm volatile("s_waitcnt vmcnt(0)" ::: "memory");
        } else {
            XB_SPIN(xb_ld(&bar[XB_XGEN(x)]) == gen, bar);
            __builtin_amdgcn_fence(__ATOMIC_ACQUIRE, "agent");
            asm volatile("s_waitcnt vmcnt(0)" ::: "memory");
        }
    }
    __syncthreads();
}

__device__ __forceinline__ void s5_side_barrier(int l, int which) {
    CParams& p = KPL(); const Ctx cx = mkctx();
    const int b0 = cx.nb >= 2 ? cx.nb / 2 : 0;
    if (cx.bid < b0) return;
    unsigned* ctr = (unsigned*)(p.ws + OFF_BAR) + 3700 + l * 16 + which * 8;
    const unsigned target = (unsigned)(cx.nb - b0);
    asm volatile("s_waitcnt vmcnt(0)" ::: "memory");
    __syncthreads();
    if (cx.tid == 0) {
        __builtin_amdgcn_fence(__ATOMIC_RELEASE, "agent");
        asm volatile("s_waitcnt vmcnt(0)" ::: "memory");
        (void)xb_add(ctr, 1u);
        unsigned sp = 0u;
        while (xb_ld(ctr) < target) { __builtin_amdgcn_s_sleep(2); if (++sp > (1u << 24)) break; }
        __builtin_amdgcn_fence(__ATOMIC_ACQUIRE, "agent");
        asm volatile("s_waitcnt vmcnt(0)" ::: "memory");
    }
    __syncthreads();
}

#ifndef PHM
#define PHM 0xFFFFFFFFull
#endif
#ifndef PHR
#define PHR 0ull
#endif
#ifndef SYNCREP
#define SYNCREP 1
#endif
template <int WHICH>
__device__ __forceinline__ void gemm_stage(int l, LAS unsigned char* lds) {
    CParams& p = KPL(); const Ctx cx = mkctx();
    const int sk = (l == NLAYER - 1) ? 1 : 0;
    unsigned char* ws = p.ws;
    float* X = (float*)(ws + OFF_X); bf16_t* H = (bf16_t*)(ws + OFF_H); bf16_t* ZA = (bf16_t*)(ws + OFF_Z); bf16_t* ZRW = (bf16_t*)(ws + OFF_ZRW);
    bf16_t* W = (bf16_t*)(ws + OFF_W);
    const float* MODL = (const float*)(ws + OFF_MOD) + (size_t)l * 3 * 6144;
    if constexpr (WHICH == 0) run_gemm(cx, lds, H, W + W_MIX / 2, 4096, 1024, FInproj{ZA, (float*)(ws + OFF_MLG), ZRW});
    else if constexpr (WHICH == 1) run_gemm(cx, lds, (const bf16_t*)(ws + OFF_ZG), W + W_GLU / 2, 512, 512, FGlu{(const bf16_t*)(ws + OFF_ZG), p.in[18] + l * 512, (bf16_t*)(ws + OFF_YA)});
    else if constexpr (WHICH == 2) run_gemm_epi(cx, lds, (const bf16_t*)(ws + OFF_LORAIN), W + W_LORA / 2, 2560, 256, EpiLora{p.in[25] + l * 1024, p.in[27] + l * 1024, ZA, ZRW, (bf16_t*)(ws + OFF_U0)});
    else if constexpr (WHICH == 3) run_gemm(cx, lds, H, W + W_GATE / 2, 3072, 1024, FGate{ZA}, sk);
    else if constexpr (WHICH == 4) run_gemm(cx, lds, (const bf16_t*)(ws + OFF_YA), W + W_PA / 2, 1024, 512, FMerge<0>{ZA, (float*)(ws + OFF_F1), H}, sk);
    else if constexpr (WHICH == 5) run_gemm(cx, lds, (const bf16_t*)(ws + OFF_YB), W + W_PB / 2, 1024, 512, FMerge<1>{ZA, (float*)(ws + OFF_F1), H}, sk);
    else if constexpr (WHICH == 6) run_gemm(cx, lds, (const bf16_t*)(ws + OFF_YC), W + W_PC / 2, 1024, 512, FMerge<2>{ZA, (float*)(ws + OFF_F1), H}, sk);
    else if constexpr (WHICH == 7) run_gemm(cx, lds, H, W + W_OUT / 2, 1024, 1024, FResid{X, MODL, 2}, sk);
    else if constexpr (WHICH == 8) run_gemm(cx, lds, H, W + W_1 / 2, 4096, 1024, FMlp1{ZA}, sk);
    else run_gemm(cx, lds, ZA, W + W_2 / 2, 1024, 4096, FResid{X, MODL, 5}, sk);
}

template <int l>
__device__ __forceinline__ void run_layer(cg::grid_group& grid, LAS unsigned char* lds, float* smf, unsigned char* smem) {
        if constexpr (l == 0) phase_wconv<0>(l, smf); else phase_wconv<1>(l, smf);
        __syncthreads();
        if constexpr ((PHM >> 2) & 1) { phase_norm(l, 0, l == 0); if constexpr ((PHR >> 2) & 1) { __syncthreads(); phase_norm(l, 0, l == 0); } }
        for (int sr = 0; sr < SYNCREP; ++sr) xsync(smem);
        if constexpr ((PHM >> 3) & 1) { gemm_stage<0>(l, lds); if constexpr ((PHR >> 3) & 1) { __syncthreads(); gemm_stage<0>(l, lds); } }
        for (int sr = 0; sr < SYNCREP; ++sr) xsync(smem);
        if constexpr ((PHM >> 5) & 1) { phase_ml_conv(l); if constexpr ((PHR >> 5) & 1) { __syncthreads(); phase_ml_conv(l); } }
        for (int sr = 0; sr < SYNCREP; ++sr) xsync(smem);
        if constexpr ((PHM >> 7) & 1) { phase_ml_local(l, smem); if constexpr ((PHR >> 7) & 1) { __syncthreads(); phase_ml_local(l, smem); } }
        for (int sr = 0; sr < SYNCREP; ++sr) xsync(smem);
        if constexpr ((PHM >> 9) & 1) { phase_ml_carry(); if constexpr ((PHR >> 9) & 1) { __syncthreads(); phase_ml_carry(); } }
        for (int sr = 0; sr < SYNCREP; ++sr) xsync(smem);
        if constexpr ((PHM >> 11) & 1) { phase_ml_out(l, smem); if constexpr ((PHR >> 11) & 1) { __syncthreads(); phase_ml_out(l, smem); } }
        for (int sr = 0; sr < SYNCREP; ++sr) xsync(smem);
        if constexpr ((PHM >> 12) & 1) { phase_rw_feat(l); if constexpr ((PHR >> 12) & 1) { __syncthreads(); phase_rw_feat(l); } }
        for (int sr = 0; sr < SYNCREP; ++sr) xsync(smem);
        if constexpr ((PHM >> 13) & 1) { gemm_stage<2>(l, lds); if constexpr ((PHR >> 13) & 1) { __syncthreads(); gemm_stage<2>(l, lds); } }
        for (int sr = 0; sr < SYNCREP; ++sr) xsync(smem);
        phase_rw_scan(l, smem);
        phase_s5_local(l);
        s5_side_barrier(l, 0);
        phase_s5_carry(l);
        s5_side_barrier(l, 1);
        phase_s5_final(l, smf);
        for (int sr = 0; sr < SYNCREP; ++sr) xsync(smem);
        gemm_stage<1>(l, lds);
        if constexpr ((PHM >> 15) & 1) { phase_rw_out(l); if constexpr ((PHR >> 15) & 1) { __syncthreads(); phase_rw_out(l); } }
        for (int sr = 0; sr < SYNCREP; ++sr) xsync(smem);
        if constexpr ((PHM >> 17) & 1) { gemm_stage<3>(l, lds); if constexpr ((PHR >> 17) & 1) { __syncthreads(); gemm_stage<3>(l, lds); } }
        for (int sr = 0; sr < SYNCREP; ++sr) xsync(smem);
        if constexpr ((PHM >> 18) & 1) { gemm_stage<4>(l, lds); if constexpr ((PHR >> 18) & 1) { __syncthreads(); gemm_stage<4>(l, lds); } }
        if constexpr ((PHM >> 19) & 1) { gemm_stage<5>(l, lds); if constexpr ((PHR >> 19) & 1) { __syncthreads(); gemm_stage<5>(l, lds); } }
        if constexpr ((PHM >> 20) & 1) { gemm_stage<6>(l, lds); if constexpr ((PHR >> 20) & 1) { __syncthreads(); gemm_stage<6>(l, lds); } }
        for (int sr = 0; sr < SYNCREP; ++sr) xsync(smem);
        if constexpr ((PHM >> 21) & 1) { gemm_stage<7>(l, lds); if constexpr ((PHR >> 21) & 1) { __syncthreads(); gemm_stage<7>(l, lds); } }
        for (int sr = 0; sr < SYNCREP; ++sr) xsync(smem);
        if constexpr ((PHM >> 22) & 1) { phase_norm(l, 1, false); if constexpr ((PHR >> 22) & 1) { __syncthreads(); phase_norm(l, 1, false); } }
        for (int sr = 0; sr < SYNCREP; ++sr) xsync(smem);
        if constexpr ((PHM >> 23) & 1) { gemm_stage<8>(l, lds); if constexpr ((PHR >> 23) & 1) { __syncthreads(); gemm_stage<8>(l, lds); } }
        for (int sr = 0; sr < SYNCREP; ++sr) xsync(smem);
        gemm_stage<9>(l, lds);
        if constexpr (l < NLAYER - 1) { __syncthreads(); phase_wconv<2>(l + 1, smf); }
        for (int sr = 0; sr < SYNCREP; ++sr) xsync(smem);
    }

__global__ void __launch_bounds__(512, 2) fwd_megakernel(Params p_unused) {
    extern __shared__ __attribute__((aligned(16))) unsigned char smem[];
    cg::grid_group grid = cg::this_grid();
    LAS unsigned char* lds = (LAS unsigned char*)smem;
    float* smf = (float*)smem;

    xb_post(smem);
    phase_mod(smf); phase_s5_params();
    grid.sync();
    run_layer<0>(grid, lds, smf, smem);
    run_layer<1>(grid, lds, smf, smem);
    run_layer<2>(grid, lds, smf, smem);
    run_layer<3>(grid, lds, smf, smem);
    phase_final();
}

extern "C" void kernel_launch(void* const* d_in, const int* in_sizes, int n_in, void* d_out, int out_size, void* d_ws, size_t ws_size, hipStream_t stream) {
    static int grid_blocks = 0;
    if (grid_blocks == 0) {
        if (n_in != 42 || ws_size < WS_END) { fprintf(stderr, "kernel_launch: unexpected n_in %d / ws_size %zu\n", n_in, ws_size); grid_blocks = -1; return; }
        int dev = 0, cus = 0, per_cu = 0;
        (void)hipGetDevice(&dev);
        (void)hipDeviceGetAttribute(&cus, hipDeviceAttributeMultiprocessorCount, dev);
        if (hipFuncSetAttribute((const void*)fwd_megakernel, hipFuncAttributeMaxDynamicSharedMemorySize, LDS_BYTES) != hipSuccess) { fprintf(stderr, "kernel_launch: hipFuncSetAttribute failed\n"); grid_blocks = -1; return; }
        if (hipOccupancyMaxActiveBlocksPerMultiprocessor(&per_cu, (const void*)fwd_megakernel, 512, LDS_BYTES) != hipSuccess || per_cu < 1) { fprintf(stderr, "kernel_launch: occupancy query says %d\n", per_cu); per_cu = 1; (void)hipGetLastError(); }
        grid_blocks = cus * 1;
    }
    if (grid_blocks < 0) return;
    if (hipMemsetAsync((unsigned char*)d_ws + OFF_BAR, 0, 16384, stream) != hipSuccess) { fprintf(stderr, "kernel_launch: memset failed\n"); return; }
    Params p{};
    for (int i = 0; i < 42; ++i) p.in[i] = (const float*)d_in[i];
    p.out = (float*)d_out; p.ws = (unsigned char*)d_ws;
    void* args[] = {&p};
    hipError_t e = hipLaunchCooperativeKernel((const void*)fwd_megakernel, dim3(grid_blocks), dim3(512), args, LDS_BYTES, stream);
    if (e != hipSuccess) fprintf(stderr, "cooperative launch failed: %s (grid %d)\n", hipGetErrorString(e), grid_blocks);
}
```

```cpp
#include <hip/hip_runtime.h>
#include <hip/hip_cooperative_groups.h>
#include <cstdio>
namespace cg = cooperative_groups;

#define LAS __attribute__((address_space(3)))
typedef unsigned short bf16_t;
typedef short bf16x8 __attribute__((ext_vector_type(8)));
typedef float f32x4 __attribute__((ext_vector_type(4)));
typedef unsigned u32x4 __attribute__((ext_vector_type(4)));
typedef unsigned u32x2 __attribute__((ext_vector_type(2)));

constexpr int T_TOK = 16896, SEQA = 8448, NCTX = 256;
constexpr int NLAYER = 4;
constexpr int LDS_BYTES = 143360;
constexpr size_t OFF_X = 0;
constexpr size_t OFF_H = 69206016;
constexpr size_t OFF_Z = 103809024;
constexpr size_t OFF_ZRW = OFF_Z + 69206016;
constexpr size_t OFF_MLG = 242221056;
constexpr size_t OFF_W = 243302400;
constexpr size_t OFF_YA = 281837568;
constexpr size_t OFF_YB = 299139072;
constexpr size_t OFF_YC = 316440576;
constexpr size_t OFF_F1 = 333742080;
constexpr size_t OFF_MOD = 402948096;
constexpr size_t OFF_S5P = 403243008;
constexpr size_t OFF_MLS = OFF_S5P + 4 * 589824;
constexpr size_t OFF_R2 = OFF_MLS + 16384;
constexpr size_t OFF_BAR = OFF_R2 + 34603008;
constexpr size_t OFF_S5ST = OFF_BAR + 16384;
constexpr size_t WS_END = OFF_S5ST + 8650752;
constexpr size_t OFF_CLOC = OFF_F1;
constexpr size_t OFF_U0 = OFF_ZRW + 17301504;
constexpr size_t OFF_QKC = OFF_F1 + 43524096;
constexpr size_t OFF_ZG = OFF_ZRW + 34603008;
constexpr size_t OFF_LORAIN = OFF_R2 + 17301504;
constexpr size_t W_MIX = 0, W_GATE = 8388608, W_GLU = 14680064, W_LORA = 15204352, W_PA = 16515072, W_PB = 17563648, W_PC = 18612224, W_OUT = 19660800, W_1 = 21757952, W_2 = 30146560;

struct Params {
    const float* in[42];
    float* out;
    unsigned char* ws;
};

typedef const __attribute__((address_space(4))) Params CParams;
__device__ __forceinline__ CParams& KPL() {
    unsigned long long a = (unsigned long long)__builtin_amdgcn_kernarg_segment_ptr();
    asm volatile("" : "+s"(a));
    return *(CParams*)a;
}
struct Ctx { int tid, bid, nb; };
__device__ __forceinline__ Ctx mkctx() { Ctx c; c.tid = threadIdx.x; c.bid = blockIdx.x; c.nb = gridDim.x; asm volatile("" : "+v"(c.tid), "+s"(c.bid), "+s"(c.nb)); return c; }
__device__ __forceinline__ float bf2f(unsigned v) { return __uint_as_float(v << 16); }
__device__ __forceinline__ float bflo(unsigned w) { return __uint_as_float(w << 16); }
__device__ __forceinline__ float bfhi(unsigned w) { return __uint_as_float(w & 0xffff0000u); }
__device__ __forceinline__ bf16_t f2bf(float f) { unsigned u = __float_as_uint(f); u += 0x7FFFu + ((u >> 16) & 1u); return (bf16_t)(u >> 16); }
__device__ __forceinline__ unsigned pk2(float lo, float hi) { return (unsigned)f2bf(lo) | ((unsigned)f2bf(hi) << 16); }
__device__ __forceinline__ void store4bf(bf16_t* p, f32x4 v) { u32x2 r; r.x = pk2(v[0], v[1]); r.y = pk2(v[2], v[3]); *(u32x2*)p = r; }
__device__ __forceinline__ float sigmoidf_(float x) { return 1.f / (1.f + __expf(-x)); }

#define DPP_F(x, ctrl, rmask) __int_as_float(__builtin_amdgcn_update_dpp(0, __float_as_int(x), ctrl, rmask, 0xF, false))
__device__ __forceinline__ float row8_sum(float x) {
    x += DPP_F(x, 0xB1, 0xF); x += DPP_F(x, 0x4E, 0xF); x += DPP_F(x, 0x141, 0xF); return x;
}
__device__ __forceinline__ float row16_sum(float x) {
    x += DPP_F(x, 0xB1, 0xF); x += DPP_F(x, 0x4E, 0xF); x += DPP_F(x, 0x141, 0xF); x += DPP_F(x, 0x140, 0xF); return x;
}
__device__ __forceinline__ float wave_sum(float x) {
    x = row16_sum(x);
    x += DPP_F(x, 0x142, 0xA);
    x += DPP_F(x, 0x143, 0xC);
    return __int_as_float(__builtin_amdgcn_readlane(__float_as_int(x), 63));
}

namespace pg8 {
constexpr int BM = 256, BK = 64, HALF = 128, HTB = HALF * BK * 2, NXCD = 8, WGM = 8;
__device__ __forceinline__ int lds_byte(int r, int c) { const int st = (r >> 4) * 2 + (c >> 5), rr = r & 15, cc = c & 31, ob = rr * 64 + cc * 2; return st * 1024 + (ob ^ (((ob >> 9) & 1) << 5)); }
__device__ __forceinline__ void stage_rc(int b, int& R, int& C) { const int st = b / 1024, sb = b % 1024, swz = sb ^ (((sb >> 9) & 1) << 5); R = (st >> 1) * 16 + swz / 64; C = (st & 1) * 32 + (swz % 64) / 2; }
__device__ __forceinline__ int perm32(int rho) { const int n = rho >> 4, i = rho & 15; return 8 * (i >> 2) + 4 * n + (i & 3); }
struct Unit { int pm, pn; };
struct Gemm { const bf16_t* A; const bf16_t* Bt; int M, N, K; };
struct StaticOrder {
    int nM, nN, nwg, G, c, skipctx;
    __device__ void init(int M, int N, int G_, int c_, int skip_ = 0) { nM = M / BM - 2 * skip_; nN = N / BM; nwg = nM * nN; G = G_; c = c_; skipctx = skip_; }
    __device__ bool next(int i, Unit& u) const {
        const long L = (long)i * G + c; if (L >= nwg) return false;
        int wgid = (int)L; { const int q = nwg / NXCD, r = nwg % NXCD, xcd = wgid % NXCD, off = wgid / NXCD; wgid = (xcd < r ? xcd * (q + 1) : r * (q + 1) + (xcd - r) * q) + off; }
        const int nig = WGM * nN, gid = wgid / nig, fm = gid * WGM, gsz = (nM - fm) < WGM ? (nM - fm) : WGM;
        u.pm = fm + ((wgid % nig) % gsz); u.pn = (wgid % nig) / gsz;
        if (skipctx) u.pm += (u.pm >= 32) ? 2 : 1;
        return true;
    }
};

template <class Epi>
__device__ __forceinline__ void gemm_phase(int tid_in, LAS unsigned char* lds, const Gemm g, const StaticOrder& S, const Epi& E) {
    const int tid = tid_in, wid = __builtin_amdgcn_readfirstlane(tid >> 6), lane = tid & 63, wr = wid >> 2, wc = wid & 3, fr = lane & 15, fq = lane >> 4;
    const int K = g.K, nt = K / BK;
    unsigned voffA[2], voffB[2];
#pragma unroll
    for (int i = 0; i < 2; ++i) { int R, C; stage_rc(tid * 16 + i * 8192, R, C); const int Rb = Epi::PERM ? ((R & ~31) + perm32(R & 31)) : R;
        voffA[i] = (unsigned)(R * K + C) * 2u; voffB[i] = (unsigned)(Rb * K + C) * 2u; }
    const size_t kstep = (size_t)(BK * 2);
    const size_t hstep = (size_t)HALF * K * 2;
    const size_t tstep = 2 * hstep;
    const unsigned ldsw = (unsigned)wid * 1024u;
    const int aoff = lds_byte(wr * 64 + fr, fq * 8), boff = lds_byte(wc * 32 + fr, fq * 8);
#define PG8_SA(b, h) (((b) * 2 + (h)) * HTB)
#define PG8_SB(b, h) ((4 + (b) * 2 + (h)) * HTB)
#define PG8_STAGE(bufoff, gbase, voff) do { _Pragma("unroll") for (int _i = 0; _i < 2; ++_i) \
        __builtin_amdgcn_global_load_lds((const unsigned*)((const char*)(gbase) + (voff)[_i]), (LAS unsigned*)(lds + (bufoff) + ldsw + _i * 8192), 16, 0, 0); } while (0)
#define PG8_LDA(dst, b, h) do { _Pragma("unroll") for (int m = 0; m < 4; ++m) _Pragma("unroll") for (int k = 0; k < 2; ++k) dst[m][k] = *(const LAS bf16x8*)(lds + PG8_SA(b, h) + aoff + m * 2048 + k * 1024); } while (0)
#define PG8_LDB(dst, b, h) do { _Pragma("unroll") for (int n = 0; n < 2; ++n) _Pragma("unroll") for (int k = 0; k < 2; ++k) dst[n][k] = *(const LAS bf16x8*)(lds + PG8_SB(b, h) + boff + n * 2048 + k * 1024); } while (0)
#define PG8_MMA(ai, bj, At, Bt) do { __builtin_amdgcn_s_setprio(1); _Pragma("unroll") for (int m = 0; m < 4; ++m) _Pragma("unroll") for (int n = 0; n < 2; ++n) _Pragma("unroll") for (int k = 0; k < 2; ++k) \
        acc[ai][bj][m][n] = __builtin_amdgcn_mfma_f32_16x16x32_bf16(Bt[n][k], At[m][k], acc[ai][bj][m][n], 0, 0, 0); __builtin_amdgcn_s_setprio(0); } while (0)
#define PG8_WAIT_V(n) asm volatile("s_waitcnt vmcnt(" #n ")" ::: "memory")
#define PG8_WAIT_L(n) asm volatile("s_waitcnt lgkmcnt(" #n ")" ::: "memory")
#define PG8_BAR __builtin_amdgcn_s_barrier()
#define PG8_SCHED __builtin_amdgcn_sched_barrier(0)
    Unit cur, nxt; int ui = 0;
    if (!S.next(0, cur)) return;
    f32x4 acc[2][2][4][2];
#pragma unroll
    for (int a = 0; a < 2; ++a)
#pragma unroll
        for (int b = 0; b < 2; ++b)
#pragma unroll
            for (int m = 0; m < 4; ++m)
#pragma unroll
                for (int n = 0; n < 2; ++n) acc[a][b][m][n] = (f32x4){0.f, 0.f, 0.f, 0.f};
    bf16x8 At[4][2], B0[2][2], B1[2][2];
    const char* cA = (const char*)g.A + (size_t)cur.pm * tstep; const char* cB = (const char*)g.Bt + (size_t)cur.pn * tstep;
    PG8_STAGE(PG8_SB(0, 0), cB, voffB); PG8_STAGE(PG8_SA(0, 0), cA, voffA); PG8_STAGE(PG8_SB(0, 1), cB + hstep, voffB); PG8_STAGE(PG8_SA(0, 1), cA + hstep, voffA);
    if (wr == 1) PG8_BAR;
    PG8_WAIT_V(4); PG8_BAR;
    PG8_STAGE(PG8_SB(1, 0), cB + kstep, voffB); PG8_STAGE(PG8_SA(1, 0), cA + kstep, voffA); PG8_STAGE(PG8_SB(1, 1), cB + hstep + kstep, voffB);
    PG8_WAIT_V(6); PG8_BAR;
    for (;;) {
        const bool has_next = S.next(ui + 1, nxt);
        const char* nA = has_next ? (const char*)g.A + (size_t)nxt.pm * tstep : cA; const char* nB = has_next ? (const char*)g.Bt + (size_t)nxt.pn * tstep : cB;
        for (int t = 0; t < nt; t += 2) {
            const bool last = (t == nt - 2);
            const char* a1 = cA + (size_t)(t + 1) * kstep;
            const char* a2 = last ? nA : cA + (size_t)(t + 2) * kstep; const char* b2 = last ? nB : cB + (size_t)(t + 2) * kstep;
            const char* a3 = a2 + kstep; const char* b3 = b2 + kstep;
            PG8_LDB(B0, 0, 0); PG8_SCHED; PG8_LDA(At, 0, 0); PG8_STAGE(PG8_SA(1, 1), a1 + hstep, voffA);
            PG8_WAIT_L(8); PG8_BAR; PG8_WAIT_L(0); PG8_MMA(0, 0, At, B0); PG8_BAR; PG8_SCHED;
            PG8_LDB(B1, 0, 1); PG8_STAGE(PG8_SB(0, 0), b2, voffB);
            PG8_BAR; PG8_WAIT_L(0); PG8_MMA(0, 1, At, B1); PG8_BAR;
            PG8_LDA(At, 0, 1); PG8_STAGE(PG8_SA(0, 0), a2, voffA);
            PG8_BAR; PG8_WAIT_L(0); PG8_MMA(1, 0, At, B0); PG8_BAR; PG8_SCHED;
            PG8_STAGE(PG8_SB(0, 1), b2 + hstep, voffB);
            PG8_WAIT_V(6); PG8_BAR; PG8_MMA(1, 1, At, B1); PG8_BAR;
            PG8_LDB(B0, 1, 0); PG8_SCHED; PG8_LDA(At, 1, 0); PG8_STAGE(PG8_SA(0, 1), a2 + hstep, voffA);
            PG8_WAIT_L(8); PG8_BAR; PG8_WAIT_L(0); PG8_MMA(0, 0, At, B0); PG8_BAR; PG8_SCHED;
            PG8_LDB(B1, 1, 1); PG8_STAGE(PG8_SB(1, 0), b3, voffB);
            PG8_BAR; PG8_WAIT_L(0); PG8_MMA(0, 1, At, B1); PG8_BAR;
            PG8_LDA(At, 1, 1); PG8_STAGE(PG8_SA(1, 0), a3, voffA);
            PG8_BAR; PG8_WAIT_L(0); PG8_MMA(1, 0, At, B0); PG8_BAR; PG8_SCHED;
            PG8_STAGE(PG8_SB(1, 1), b3 + hstep, voffB);
            PG8_WAIT_V(6); PG8_BAR; PG8_MMA(1, 1, At, B1); PG8_BAR;
        }
        E(acc, cur, wr, wc, fr, fq);
        if (!has_next) break;
#pragma unroll
        for (int a = 0; a < 2; ++a)
#pragma unroll
            for (int b = 0; b < 2; ++b)
#pragma unroll
                for (int m = 0; m < 4; ++m)
#pragma unroll
                    for (int n = 0; n < 2; ++n) acc[a][b][m][n] = (f32x4){0.f, 0.f, 0.f, 0.f};
        cur = nxt; cA = nA; cB = nB; ++ui;
    }
    PG8_WAIT_V(0);
    if (wr == 0) PG8_BAR;
    PG8_BAR;
#undef PG8_SA
#undef PG8_SB
#undef PG8_STAGE
#undef PG8_LDA
#undef PG8_LDB
#undef PG8_MMA
#undef PG8_WAIT_V
#undef PG8_WAIT_L
#undef PG8_BAR
#undef PG8_SCHED
}

template <class F> struct EpiT {
    static constexpr bool PERM = false;
    F f;
    __device__ __forceinline__ void operator()(const f32x4 (&acc)[2][2][4][2], const Unit& u, int wr, int wc, int fr, int fq) const {
        const int row0 = u.pm * BM + wr * 64 + fr, col0 = u.pn * BM + wc * 32 + 4 * fq;
#pragma unroll
        for (int ai = 0; ai < 2; ++ai)
#pragma unroll
            for (int m = 0; m < 4; ++m) {
                const int row = row0 + ai * HALF + m * 16;
#pragma unroll
                for (int bj = 0; bj < 2; ++bj)
#pragma unroll
                    for (int n = 0; n < 2; ++n) f(row, col0 + bj * HALF + n * 16, acc[ai][bj][m][n]);
            }
    }
};
template <class F> struct EpiT8 {
    static constexpr bool PERM = true;
    F f;
    __device__ __forceinline__ void operator()(const f32x4 (&acc)[2][2][4][2], const Unit& u, int wr, int wc, int fr, int fq) const {
        const int row0 = u.pm * BM + wr * 64 + fr, col0 = u.pn * BM + wc * 32 + 8 * fq;
#pragma unroll
        for (int ai = 0; ai < 2; ++ai)
#pragma unroll
            for (int m = 0; m < 4; ++m) {
                const int row = row0 + ai * HALF + m * 16;
#pragma unroll
                for (int bj = 0; bj < 2; ++bj) f(row, col0 + bj * HALF, acc[ai][bj][m][0], acc[ai][bj][m][1]);
            }
    }
};
}

template <class F>
__device__ __forceinline__ void run_gemm(const Ctx& cx, LAS unsigned char* lds, const bf16_t* A, const bf16_t* Bt, int N, int K, const F& f, int skip = 0) {
    pg8::Gemm g; g.A = A; g.Bt = Bt; g.M = T_TOK; g.N = N; g.K = K;
    pg8::StaticOrder S; S.init(T_TOK, N, cx.nb, cx.bid, skip);
    pg8::EpiT<F> E{f};
    pg8::gemm_phase(cx.tid, lds, g, S, E);
}

template <class F>
__device__ __forceinline__ void run_gemm8(const Ctx& cx, LAS unsigned char* lds, const bf16_t* A, const bf16_t* Bt, int N, int K, const F& f, int skip = 0) {
    pg8::Gemm g; g.A = A; g.Bt = Bt; g.M = T_TOK; g.N = N; g.K = K;
    pg8::StaticOrder S; S.init(T_TOK, N, cx.nb, cx.bid, skip);
    pg8::EpiT8<F> E{f};
    pg8::gemm_phase(cx.tid, lds, g, S, E);
}

template <class E>
__device__ __forceinline__ void run_gemm_epi(const Ctx& cx, LAS unsigned char* lds, const bf16_t* A, const bf16_t* Bt, int N, int K, const E& e) {
    pg8::Gemm g; g.A = A; g.Bt = Bt; g.M = T_TOK; g.N = N; g.K = K;
    pg8::StaticOrder S; S.init(T_TOK, N, cx.nb, cx.bid);
    pg8::gemm_phase(cx.tid, lds, g, S, e);
}
__device__ __forceinline__ int row_vec(int row) { const int b = row >= SEQA ? 1 : 0; const int t = row - b * SEQA; return t < NCTX ? 2 : b; }

struct FInproj { bf16_t* za; float* mlg; bf16_t* zrw;
    __device__ __forceinline__ void operator()(int row, int col, f32x4 v) const {
        if (col < 2048) store4bf(za + (size_t)row * 2048 + col, v);
        else if (col < 2064) *(f32x4*)(mlg + (size_t)row * 16 + (col - 2048)) = v;
        else if (col < 3856) store4bf(zrw + (size_t)row * 1792 + (col - 2064), v);
    } };
__device__ __forceinline__ void store8bf(bf16_t* p, f32x4 a, f32x4 b) { u32x4 r; r.x = pk2(a[0], a[1]); r.y = pk2(a[2], a[3]); r.z = pk2(b[0], b[1]); r.w = pk2(b[2], b[3]); *(u32x4*)p = r; }
struct FInproj8 { bf16_t* za; float* mlg; bf16_t* zrw;
    __device__ __forceinline__ void operator()(int row, int col, f32x4 a, f32x4 b) const {
        if (col < 2048) store8bf(za + (size_t)row * 2048 + col, a, b);
        else if (col < 2064) { *(f32x4*)(mlg + (size_t)row * 16 + (col - 2048)) = a; *(f32x4*)(mlg + (size_t)row * 16 + (col - 2048) + 4) = b; }
        else if (col < 3856) store8bf(zrw + (size_t)row * 1792 + (col - 2064), a, b);
    } };
struct FGate8 { bf16_t* g;
    __device__ __forceinline__ void operator()(int row, int col, f32x4 a, f32x4 b) const {
#pragma unroll
        for (int e = 0; e < 4; ++e) { a[e] = sigmoidf_(a[e]); b[e] = sigmoidf_(b[e]); }
        store8bf(g + (size_t)row * 3072 + col, a, b);
    } };
struct FMlp18 { bf16_t* hid;
    __device__ __forceinline__ void operator()(int row, int col, f32x4 a, f32x4 b) const {
#pragma unroll
        for (int e = 0; e < 4; ++e) { const float r0 = fmaxf(a[e], 0.f), r1 = fmaxf(b[e], 0.f); a[e] = r0 * r0; b[e] = r1 * r1; }
        store8bf(hid + (size_t)row * 4096 + col, a, b);
    } };
struct FGlu { const bf16_t* zg; const float* bglu; bf16_t* ya;
    __device__ __forceinline__ void operator()(int row, int col, f32x4 v) const {
        const u32x2 z = *(const u32x2*)(zg + (size_t)row * 512 + col); const f32x4 b = *(const f32x4*)(bglu + col);
        f32x4 o; o[0] = bflo(z.x) * sigmoidf_(v[0] + b[0]); o[1] = bfhi(z.x) * sigmoidf_(v[1] + b[1]); o[2] = bflo(z.y) * sigmoidf_(v[2] + b[2]); o[3] = bfhi(z.y) * sigmoidf_(v[3] + b[3]);
        store4bf(ya + (size_t)row * 512 + col, o);
    } };
struct EpiLora { static constexpr bool PERM = false; const float* w0; const float* a0; bf16_t* f2; bf16_t* grw; bf16_t* u0;
    __device__ __forceinline__ void operator()(const f32x4 (&acc)[2][2][4][2], const pg8::Unit& u, int wr, int wc, int fr, int fq) const {
        const int row0 = u.pm * 256 + wr * 64 + fr, col0 = u.pn * 256 + wc * 32 + 4 * fq;
        const int pn = __builtin_amdgcn_readfirstlane(u.pn);
        if (pn < 8) {
            const float* bias = pn < 4 ? w0 : a0 - 1024;
#pragma unroll
            for (int bj = 0; bj < 2; ++bj)
#pragma unroll
                for (int n = 0; n < 2; ++n) {
                    const int col = col0 + bj * 128 + n * 16;
                    const f32x4 b = *(const f32x4*)(bias + col);
#pragma unroll
                    for (int ai = 0; ai < 2; ++ai)
#pragma unroll
                        for (int m = 0; m < 4; ++m) {
                            const int row = row0 + ai * 128 + m * 16; f32x4 o;
#pragma unroll
                            for (int e = 0; e < 4; ++e) { const float s = sigmoidf_(acc[ai][bj][m][n][e] + b[e]); o[e] = pn < 4 ? 1.f - __expf(-0.60653065971f * s) : s; }
                            if (pn < 2) store4bf(u0 + (size_t)row * 512 + col, o); else store4bf(f2 + (size_t)row * 2048 + col, o);
                        }
                }
        } else {
#pragma unroll
            for (int ai = 0; ai < 2; ++ai)
#pragma unroll
                for (int m = 0; m < 4; ++m) { const int row = row0 + ai * 128 + m * 16;
#pragma unroll
                    for (int bj = 0; bj < 2; ++bj)
#pragma unroll
                        for (int n = 0; n < 2; ++n) store4bf(grw + (size_t)row * 512 + (col0 + bj * 128 + n * 16 - 2048), acc[ai][bj][m][n]); }
        }
    } };
struct FGate { bf16_t* g;
    __device__ __forceinline__ void operator()(int row, int col, f32x4 v) const {
        f32x4 o; o[0] = sigmoidf_(v[0]); o[1] = sigmoidf_(v[1]); o[2] = sigmoidf_(v[2]); o[3] = sigmoidf_(v[3]);
        store4bf(g + (size_t)row * 3072 + col, o);
    } };
template <int J> struct FMerge { const bf16_t* g; float* y32; bf16_t* ybf;
    __device__ __forceinline__ void operator()(int row, int col, f32x4 v) const {
        const u32x2 z = *(const u32x2*)(g + (size_t)row * 3072 + J * 1024 + col);
        f32x4 o; o[0] = bflo(z.x) * v[0]; o[1] = bfhi(z.x) * v[1]; o[2] = bflo(z.y) * v[2]; o[3] = bfhi(z.y) * v[3];
        bf16_t* yp = ybf + (size_t)row * 1024 + col;
        if (J != 0) { const u32x2 t = *(const u32x2*)yp; o[0] += bflo(t.x); o[1] += bfhi(t.x); o[2] += bflo(t.y); o[3] += bfhi(t.y); }
        store4bf(yp, o);
    } };
struct FResid { float* x; const float* modl; int chunk;
    __device__ __forceinline__ void operator()(int row, int col, f32x4 v) const {
        const f32x4 mg = *(const f32x4*)(modl + row_vec(row) * 6144 + chunk * 1024 + col);
        float* xp = x + (size_t)row * 1024 + col; f32x4 t = *(f32x4*)xp; *(f32x4*)xp = t + mg * v;
    } };
struct FMlp1 { bf16_t* hid;
    __device__ __forceinline__ void operator()(int row, int col, f32x4 v) const {
        f32x4 o;
#pragma unroll
        for (int e = 0; e < 4; ++e) { const float r = fmaxf(v[e], 0.f); o[e] = r * r; }
        store4bf(hid + (size_t)row * 4096 + col, o);
    } };

__device__ __forceinline__ void phase_mod(float* smf) {
    CParams& p = KPL(); const Ctx cx = mkctx();
    const int tid = cx.tid, lane = tid & 63, wid = tid >> 6;
    float* sc = smf; float* red = smf + 3072;
    float* MOD = (float*)(p.ws + OFF_MOD);
    for (int i = tid; i < 3072; i += 512) { const int v = i >> 10, j = i & 1023; const float c = v < 2 ? p.in[1][v * 1024 + j] : p.in[3][j]; sc[i] = c / (1.f + expf(-c)); }
    __syncthreads();
    for (int item = cx.bid; item < 4 * 96; item += cx.nb) {
        const int l = item / 96, jt = item % 96, j = jt * 64 + lane;
        const float* w = p.in[4] + (size_t)l * 1024 * 6144 + j;
        float a0 = 0.f, a1 = 0.f, a2 = 0.f;
#pragma unroll 16
        for (int i = wid * 128; i < wid * 128 + 128; ++i) { const float wv = w[(size_t)i * 6144]; a0 += sc[i] * wv; a1 += sc[1024 + i] * wv; a2 += sc[2048 + i] * wv; }
        red[(wid * 3 + 0) * 64 + lane] = a0; red[(wid * 3 + 1) * 64 + lane] = a1; red[(wid * 3 + 2) * 64 + lane] = a2;
        __syncthreads();
        if (tid < 192) { const int v = tid >> 6; float s = 0.f;
            for (int w8 = 0; w8 < 8; ++w8) s += red[(w8 * 3 + v) * 64 + lane];
            MOD[(l * 3 + v) * 6144 + j] = s + p.in[5][l * 6144 + j]; }
        __syncthreads();
    }
}

__device__ __forceinline__ void dsincos(double x, double& s, double& c) {
    const double k = rint(x * 0.63661977236758134308);
    double r = fma(-k, 1.57079632679489655800, x); r = fma(-k, 6.12323399573676603587e-17, r);
    const double r2 = r * r;
    double ps = -1.0 / 355687428096000.0;
    ps = fma(ps, r2, 1.0 / 1307674368000.0); ps = fma(ps, r2, -1.0 / 6227020800.0); ps = fma(ps, r2, 1.0 / 39916800.0); ps = fma(ps, r2, -1.0 / 362880.0);
    ps = fma(ps, r2, 1.0 / 5040.0); ps = fma(ps, r2, -1.0 / 120.0); ps = fma(ps, r2, 1.0 / 6.0); ps = fma(ps, r2, -1.0); ps = -ps * r;
    double pc = 1.0 / 20922789888000.0;
    pc = fma(pc, r2, -1.0 / 87178291200.0); pc = fma(pc, r2, 1.0 / 479001600.0); pc = fma(pc, r2, -1.0 / 3628800.0); pc = fma(pc, r2, 1.0 / 40320.0);
    pc = fma(pc, r2, -1.0 / 720.0); pc = fma(pc, r2, 1.0 / 24.0); pc = fma(pc, r2, -0.5); pc = fma(pc, r2, 1.0);
    const int q = ((int)k) & 3;
    s = (q == 0) ? ps : (q == 1) ? pc : (q == 2) ? -ps : -pc;
    c = (q == 0) ? pc : (q == 1) ? -ps : (q == 2) ? -pc : ps;
}
__device__ __forceinline__ double dexp_neg(double x) {
    const double k = rint(x * 1.44269504088896338700);
    double r = fma(-k, 0.693147180369123816490, x); r = fma(-k, 1.90821492927058770002e-10, r);
    double pe = 1.0 / 6227020800.0;
    pe = fma(pe, r, 1.0 / 479001600.0); pe = fma(pe, r, 1.0 / 39916800.0); pe = fma(pe, r, 1.0 / 3628800.0); pe = fma(pe, r, 1.0 / 362880.0); pe = fma(pe, r, 1.0 / 40320.0);
    pe = fma(pe, r, 1.0 / 5040.0); pe = fma(pe, r, 1.0 / 720.0); pe = fma(pe, r, 1.0 / 120.0); pe = fma(pe, r, 1.0 / 24.0); pe = fma(pe, r, 1.0 / 6.0); pe = fma(pe, r, 0.5);
    pe = fma(pe, r, 1.0); pe = fma(pe, r, 1.0);
    int ki = (int)k; if (ki < -1000) return 0.0;
    return pe * __longlong_as_double((long long)(1023 + ki) << 52);
}

__device__ __forceinline__ void wconv_tile(const Ctx& cx, const float* src, int ld, int K, int c0, int ncols, bf16_t* dst, int kt, int nt, float* tile) {
    const int tid = cx.tid, j = tid & 63, i0 = tid >> 6;
#pragma unroll
    for (int e = 0; e < 8; ++e) { const int i = i0 + 8 * e; const int n = nt * 64 + j;
        tile[i * 65 + j] = (n < ncols) ? src[(size_t)(kt * 64 + i) * ld + c0 + n] : 0.f; }
    __syncthreads();
#pragma unroll
    for (int e = 0; e < 8; ++e) { const int jj = i0 + 8 * e;
        dst[(size_t)(nt * 64 + jj) * K + kt * 64 + j] = f2bf(tile[j * 65 + jj]); }
    __syncthreads();
}

template <int MODE>
__device__ __forceinline__ void phase_wconv(int l, float* smf) {
    CParams& p = KPL(); const Ctx cx = mkctx();
    bf16_t* W = (bf16_t*)(p.ws + OFF_W);
    const int tid = cx.tid;
    unsigned* ticket = (unsigned*)(p.ws + OFF_BAR) + 3520 + l * 16;
    int* tslot = (int*)smf + 8192;
    for (int it = (MODE == 2 ? 0 : cx.bid); ; it += cx.nb) {
        int item;
        if (MODE == 0) { item = it; if (item >= 5184) break; }
        else if (MODE == 1) { item = 3520 + it; if (item >= 4544) break; }
        else {
            if (tid == 0) *tslot = (int)__hip_atomic_fetch_add(ticket, 1u, __ATOMIC_RELAXED, __HIP_MEMORY_SCOPE_AGENT);
            __syncthreads();
            const int q = *tslot;
            __syncthreads();
            if (q >= 4160) break;
            item = q < 3520 ? q : q + 1024;
        }
        if (item < 4544) {
            const float* src; int ld, K, c0, ncols, nN; bf16_t* dst; int t = item;
            if (t < 1024) { src = p.in[8] + (size_t)l * 1024 * 6928; ld = 6928; K = 1024; c0 = 0; ncols = 3856; nN = 64; dst = W + W_MIX / 2; }
            else if (t < 1792) { t -= 1024; src = p.in[8] + (size_t)l * 1024 * 6928; ld = 6928; K = 1024; c0 = 3856; ncols = 3072; nN = 48; dst = W + W_GATE / 2; }
            else if (t < 1856) { t -= 1792; src = p.in[17] + (size_t)l * 512 * 512; ld = 512; K = 512; c0 = 0; ncols = 512; nN = 8; dst = W + W_GLU / 2; }
            else if (t < 1984) { t -= 1856; src = p.in[35] + (size_t)l * 512 * 1024; ld = 1024; K = 512; c0 = 0; ncols = 1024; nN = 16; dst = W + W_PA / 2; }
            else if (t < 2112) { t -= 1984; src = p.in[36] + (size_t)l * 512 * 1024; ld = 1024; K = 512; c0 = 0; ncols = 1024; nN = 16; dst = W + W_PB / 2; }
            else if (t < 2240) { t -= 2112; src = p.in[37] + (size_t)l * 512 * 1024; ld = 1024; K = 512; c0 = 0; ncols = 1024; nN = 16; dst = W + W_PC / 2; }
            else if (t < 2496) { t -= 2240; src = p.in[38] + (size_t)l * 1024 * 1024; ld = 1024; K = 1024; c0 = 0; ncols = 1024; nN = 16; dst = W + W_OUT / 2; }
            else if (t < 3520) { t -= 2496; src = p.in[39] + (size_t)l * 1024 * 4096; ld = 4096; K = 1024; c0 = 0; ncols = 4096; nN = 64; dst = W + W_1 / 2; }
            else { t -= 3520; src = p.in[40] + (size_t)l * 4096 * 1024; ld = 1024; K = 4096; c0 = 0; ncols = 1024; nN = 16; dst = W + W_2 / 2; }
            const int nt = t % nN, kt = t / nN;
            wconv_tile(cx, src, ld, K, c0, ncols, dst, kt, nt, smf);
        } else {
            bf16_t* dst = W + W_LORA / 2;
#pragma unroll
            for (int q = 0; q < 2; ++q) {
                const int e = (item - 4544) * 1024 + q * 512 + tid; const int n = e >> 8, k = e & 255;
                float v = 0.f;
                if (n < 1024) { if (k < 64) v = p.in[26][(((size_t)l * 2 + (n >> 9)) * 64 + k) * 512 + (n & 511)]; }
                else if (n < 2048) { if (k >= 64 && k < 128) v = p.in[28][(((size_t)l * 2 + ((n - 1024) >> 9)) * 64 + (k - 64)) * 512 + (n & 511)]; }
                else { if (k >= 128) v = p.in[29][((size_t)l * 128 + (k - 128)) * 512 + (n - 2048)]; }
                dst[e] = f2bf(v);
            }
        }
    }
}

__device__ __forceinline__ void phase_s5_params() {
    CParams& p = KPL(); const Ctx cx = mkctx();
    for (int item = cx.bid; item < 32; item += cx.nb) {
        const int l = item >> 3;
        const int idx = (item & 7) * 512 + cx.tid;
        const int dir = idx >> 11, g = (idx >> 6) & 31;
        float* S5P = (float*)(p.ws + OFF_S5P) + (size_t)l * 147456;
        const size_t pi = (size_t)l * 4096 + idx;
        const double lre = fmin((double)p.in[9][pi], -1e-4), lim = (double)p.in[10][pi];
        const double dt = dexp_neg((double)p.in[11][(l * 2 + dir) * 32 + g]);
        const double mag = dexp_neg(lre * dt); double sn, cs; dsincos(lim * dt, sn, cs);
        const double ar = mag * cs, ai = mag * sn;
        const double den = lre * lre + lim * lim, nr = ar - 1.0;
        const double cr = (nr * lre + ai * lim) / den, ci = (ai * lre - nr * lim) / den;
        const double mag64 = dexp_neg(64.0 * lre * dt); dsincos(64.0 * lim * dt, sn, cs);
        S5P[idx] = (float)ar; S5P[4096 + idx] = (float)ai; S5P[8192 + idx] = (float)(mag64 * cs); S5P[12288 + idx] = (float)(mag64 * sn);
        float* BR = S5P + 16384; float* BI = BR + 65536;
        for (int c = 0; c < 16; ++c) { const double bre = p.in[12][pi * 16 + c], bim = p.in[13][pi * 16 + c];
            BR[(size_t)idx * 16 + c] = (float)(cr * bre - ci * bim); BI[(size_t)idx * 16 + c] = (float)(cr * bim + ci * bre); }
    }
}

__device__ __forceinline__ void phase_norm(int l, int which, bool init) {
    CParams& p = KPL(); const Ctx cx = mkctx();
    const int lane = cx.tid & 63, gw = cx.bid * 8 + (cx.tid >> 6), nw = cx.nb * 8;
    float* X = (float*)(p.ws + OFF_X); bf16_t* H = (bf16_t*)(p.ws + OFF_H);
    const float* MODL = (const float*)(p.ws + OFF_MOD) + (size_t)l * 3 * 6144;
    const float* gam = p.in[which ? 7 : 6] + l * 1024;
    for (int row = gw; row < T_TOK; row += nw) {
        const int b = row >= SEQA ? 1 : 0, t = row - b * SEQA;
        const float* src = init ? (t < NCTX ? p.in[2] + ((size_t)b * NCTX + t) * 1024 : p.in[0] + ((size_t)b * 8192 + (t - NCTX)) * 1024) : X + (size_t)row * 1024;
        f32x4 v[4]; float ss = 0.f;
#pragma unroll
        for (int i = 0; i < 4; ++i) { v[i] = *(const f32x4*)(src + (lane + 64 * i) * 4); ss += v[i][0] * v[i][0] + v[i][1] * v[i][1] + v[i][2] * v[i][2] + v[i][3] * v[i][3]; }
        if (init) {
#pragma unroll
            for (int i = 0; i < 4; ++i) *(f32x4*)(X + (size_t)row * 1024 + (lane + 64 * i) * 4) = v[i];
        }
        ss = wave_sum(ss);
        const float inv = rsqrtf(ss * (1.f / 1024.f) + 1e-6f);
        const float* mv = MODL + (t < NCTX ? 2 : b) * 6144 + (which ? 3 : 0) * 1024;
#pragma unroll
        for (int i = 0; i < 4; ++i) { const int c = (lane + 64 * i) * 4;
            const f32x4 g4 = *(const f32x4*)(gam + c), sh = *(const f32x4*)(mv + c), scl = *(const f32x4*)(mv + 1024 + c);
            f32x4 o;
#pragma unroll
            for (int e = 0; e < 4; ++e) o[e] = v[i][e] * inv * g4[e] * (1.f + scl[e]) + sh[e];
            store4bf(H + (size_t)row * 1024 + c, o); }
    }
}

__device__ __forceinline__ int s5_order(int dir, int i) { return dir == 0 ? i : (i < 4 ? 3 - i : 135 - i); }

__device__ __forceinline__ void phase_s5_local(int l) {
    CParams& p = KPL(); const Ctx cx = mkctx();
    const int b0 = cx.nb >= 2 ? cx.nb / 2 : 0;
    if (cx.bid < b0) return;
    const int lane = cx.tid & 63, gw = (cx.bid - b0) * 8 + (cx.tid >> 6), nw = (cx.nb - b0) * 8;
    const bf16_t* ZA = (const bf16_t*)(p.ws + OFF_Z);
    const float* S5P = (const float*)(p.ws + OFF_S5P) + (size_t)l * 147456; const float* BR = S5P + 16384; const float* BI = BR + 65536;
    float* ST = (float*)(p.ws + OFF_S5ST);
    for (int item0 = gw; item0 < 16896; item0 += nw) {
        const int item = __builtin_amdgcn_readfirstlane(item0);
        const int chunk = item % 132, g = (item / 132) & 31, dir = (item / 4224) & 1, b = item / 8448;
        const int idx = dir * 2048 + g * 64 + lane;
        const float ar = S5P[idx], ai = S5P[4096 + idx];
        float br[16], bi[16];
#pragma unroll
        for (int q = 0; q < 4; ++q) { const f32x4 t0 = *(const f32x4*)(BR + (size_t)idx * 16 + q * 4), t1 = *(const f32x4*)(BI + (size_t)idx * 16 + q * 4);
#pragma unroll
            for (int e = 0; e < 4; ++e) { br[q * 4 + e] = t0[e]; bi[q * 4 + e] = t1[e]; } }
        const int row = b * SEQA + chunk * 64 + lane;
        const u32x4 u0 = *(const u32x4*)(ZA + (size_t)row * 2048 + g * 16), u1 = *(const u32x4*)(ZA + (size_t)row * 2048 + g * 16 + 8);
        unsigned ur[8] = {u0.x, u0.y, u0.z, u0.w, u1.x, u1.y, u1.z, u1.w};
        float hr = 0.f, hi = 0.f;
#pragma unroll 8
        for (int j = 0; j < 64; ++j) {
            const int tok = dir ? 63 - j : j;
            float bur = 0.f, bui = 0.f;
#pragma unroll
            for (int q = 0; q < 8; ++q) { const unsigned w = (unsigned)__builtin_amdgcn_readlane((int)ur[q], tok); const float x0 = bflo(w), x1 = bfhi(w);
                bur += br[2 * q] * x0 + br[2 * q + 1] * x1; bui += bi[2 * q] * x0 + bi[2 * q + 1] * x1; }
            const float nr = ar * hr - ai * hi + bur, ni = ar * hi + ai * hr + bui; hr = nr; hi = ni;
        }
        float* st = ST + ((((size_t)b * 2 + dir) * 32 + g) * 132 + chunk) * 128;
        st[lane] = hr; st[64 + lane] = hi;
    }
}

__device__ __forceinline__ void phase_s5_carry(int l) {
    CParams& p = KPL(); const Ctx cx = mkctx();
    const int b0 = cx.nb >= 2 ? cx.nb / 2 : 0;
    if (cx.bid < b0) return;
    const int lane = cx.tid & 63, gw = (cx.bid - b0) * 8 + (cx.tid >> 6), nw = (cx.nb - b0) * 8;
    const float* S5P = (const float*)(p.ws + OFF_S5P) + (size_t)l * 147456;
    float* ST = (float*)(p.ws + OFF_S5ST);
    for (int item0 = gw; item0 < 128; item0 += nw) {
        const int item = __builtin_amdgcn_readfirstlane(item0);
        const int g = item & 31, dir = (item >> 5) & 1, b = item >> 6;
        const int idx = dir * 2048 + g * 64 + lane;
        const float ar = S5P[8192 + idx], ai = S5P[12288 + idx];
        float* st = ST + (((size_t)b * 2 + dir) * 32 + g) * 132 * 128;
        float hr = 0.f, hi = 0.f;
        for (int i0 = 0; i0 < 132; i0 += 12) {
            float lr[12], li[12];
#pragma unroll
            for (int e = 0; e < 12; ++e) { const int c = s5_order(dir, i0 + e); lr[e] = st[c * 128 + lane]; li[e] = st[c * 128 + 64 + lane]; }
#pragma unroll
            for (int e = 0; e < 12; ++e) { const int c = s5_order(dir, i0 + e); st[c * 128 + lane] = hr; st[c * 128 + 64 + lane] = hi;
                const float nr = ar * hr - ai * hi + lr[e], ni = ar * hi + ai * hr + li[e]; hr = nr; hi = ni; }
        }
    }
}

template <int DIR>
__device__ __forceinline__ void s5_final_dir(CParams& p, int l, int b, int g, int chunk, int lane, const unsigned (&ur)[8], float* hst, f32x4* ybuf, int row0, float dsk, bf16_t* ZG) {
    const float* S5P = (const float*)(p.ws + OFF_S5P) + (size_t)l * 147456; const float* BR = S5P + 16384; const float* BI = BR + 65536;
    const float* ST = (const float*)(p.ws + OFF_S5ST);
    const bf16_t* ZA = (const bf16_t*)(p.ws + OFF_Z);
    const int idx = DIR * 2048 + g * 64 + lane;
    const float ar = S5P[idx], ai = S5P[4096 + idx];
    float br[16], bi[16];
#pragma unroll
    for (int q = 0; q < 4; ++q) { const f32x4 t0 = *(const f32x4*)(BR + (size_t)idx * 16 + q * 4), t1 = *(const f32x4*)(BI + (size_t)idx * 16 + q * 4);
#pragma unroll
        for (int e = 0; e < 4; ++e) { br[q * 4 + e] = t0[e]; bi[q * 4 + e] = t1[e]; } }
    float cbr[16], cbi[16];
    { const size_t cb = ((((size_t)l * 2 + DIR) * 32 + g) * 16 + (lane & 15)) * 64 + (lane >> 4);
#pragma unroll
      for (int i = 0; i < 16; ++i) { cbr[i] = p.in[14][cb + 4 * i]; cbi[i] = -p.in[15][cb + 4 * i]; } }
    const float* st = ST + ((((size_t)b * 2 + DIR) * 32 + g) * 132 + chunk) * 128;
    float hr = st[lane], hi = st[64 + lane];
    const int ch = g * 16 + (lane & 15);
#pragma unroll 1
    for (int si = 0; si < 4; ++si) {
        const int sc = DIR ? 3 - si : si;
#pragma unroll
        for (int jj = 0; jj < 16; ++jj) {
            const int tt = DIR ? 15 - jj : jj; const int tok = sc * 16 + tt;
            float bur = 0.f, bui = 0.f;
#pragma unroll
            for (int q = 0; q < 8; ++q) { const unsigned w = (unsigned)__builtin_amdgcn_readlane((int)ur[q], tok); const float x0 = bflo(w), x1 = bfhi(w);
                bur += br[2 * q] * x0 + br[2 * q + 1] * x1; bui += bi[2 * q] * x0 + bi[2 * q + 1] * x1; }
            const float nr = ar * hr - ai * hi + bur, ni = ar * hi + ai * hr + bui; hr = nr; hi = ni;
            hst[tt * 68 + lane] = hr; hst[1088 + tt * 68 + lane] = hi;
        }
        f32x4 a = (f32x4){0.f, 0.f, 0.f, 0.f};
        if (DIR) a = ybuf[sc * 64 + lane];
#pragma unroll
        for (int i = 0; i < 16; ++i) {
            const float xr = hst[(lane & 15) * 68 + 4 * i + (lane >> 4)], xi = hst[1088 + (lane & 15) * 68 + 4 * i + (lane >> 4)];
            a = __builtin_amdgcn_mfma_f32_16x16x4f32(xr, cbr[i], a, 0, 0, 0);
            a = __builtin_amdgcn_mfma_f32_16x16x4f32(xi, cbi[i], a, 0, 0, 0);
        }
        if (!DIR) ybuf[sc * 64 + lane] = a;
        else {
#pragma unroll
            for (int j = 0; j < 4; ++j) {
                const int row = row0 + sc * 16 + (lane >> 4) * 4 + j;
                const float u = bf2f(ZA[(size_t)row * 2048 + ch]);
                const float y = u * dsk + a[j];
                const float z = 0.5f * y * (1.f + tanhf(0.7978845608028654f * (y + 0.044715f * y * y * y)));
                ZG[(size_t)row * 512 + ch] = f2bf(z);
            }
        }
    }
}

__device__ __forceinline__ void phase_s5_final(int l, float* smf) {
    CParams& p = KPL(); const Ctx cx = mkctx();
    const int nscan = cx.nb >= 2 ? cx.nb / 2 : 0;
    if (cx.bid < nscan) return;
    const int lane = cx.tid & 63, wid = cx.tid >> 6, gw = (cx.bid - nscan) * 8 + wid, nw = (cx.nb - nscan) * 8;
    const bf16_t* ZA = (const bf16_t*)(p.ws + OFF_Z);
    bf16_t* ZG = (bf16_t*)(p.ws + OFF_ZG);
    float* hst = smf + wid * 3200;
    f32x4* ybuf = (f32x4*)(hst + 2176);
    for (int item0 = gw; item0 < 8448; item0 += nw) {
        const int item = __builtin_amdgcn_readfirstlane(item0);
        const int chunk = item % 132, g = (item / 132) & 31, b = item / 4224;
        const int row0 = b * SEQA + chunk * 64;
        const u32x4 u0 = *(const u32x4*)(ZA + (size_t)(row0 + lane) * 2048 + g * 16), u1 = *(const u32x4*)(ZA + (size_t)(row0 + lane) * 2048 + g * 16 + 8);
        const unsigned ur[8] = {u0.x, u0.y, u0.z, u0.w, u1.x, u1.y, u1.z, u1.w};
        const float dsk = p.in[16][l * 512 + g * 16 + (lane & 15)];
        s5_final_dir<0>(p, l, b, g, chunk, lane, ur, hst, ybuf, row0, dsk, ZG);
        s5_final_dir<1>(p, l, b, g, chunk, lane, ur, hst, ybuf, row0, dsk, ZG);
    }
}

__device__ __forceinline__ int ml_row0(int b, int nc) { return b * SEQA + nc * 128; }
__device__ __forceinline__ int ml_order(int dir, int i) { return dir == 0 ? i : (i < 2 ? 1 - i : 67 - i); }

__device__ __forceinline__ void phase_ml_conv(int l) {
    CParams& p = KPL(); const Ctx cx = mkctx();
    const bf16_t* ZA = (const bf16_t*)(p.ws + OFF_Z);
    bf16_t* QKC = (bf16_t*)(p.ws + OFF_QKC);
    const float* cw = p.in[19] + (size_t)l * 9 * 512; const float* cb = p.in[20] + l * 512;
    for (int idx = cx.bid * 512 + cx.tid; idx < T_TOK * 64; idx += cx.nb * 512) {
        const int row = idx >> 6, c8 = (idx & 63) * 8;
        const int b = row >= SEQA ? 1 : 0, t = row - b * SEQA;
        const bool isctx = t < NCTX;
        const int tt = isctx ? t : t - NCTX, W = isctx ? 256 : 64, Hh = isctx ? 1 : 128;
        const int y = tt / W, x = tt % W;
        const int segrow0 = row - tt;
        float acc[8];
#pragma unroll
        for (int e = 0; e < 8; ++e) acc[e] = cb[c8 + e];
#pragma unroll
        for (int dy = 0; dy < 3; ++dy)
#pragma unroll
            for (int dx = 0; dx < 3; ++dx) {
                const int yy = y + dy - 1, xx = x + dx - 1;
                if (yy >= 0 && yy < Hh && xx >= 0 && xx < W) {
                    const u32x4 z = *(const u32x4*)(ZA + (size_t)(segrow0 + yy * W + xx) * 2048 + 512 + c8);
                    const float* w = cw + (dy * 3 + dx) * 512 + c8;
                    const f32x4 w0 = *(const f32x4*)w, w1 = *(const f32x4*)(w + 4);
                    acc[0] += bflo(z.x) * w0[0]; acc[1] += bfhi(z.x) * w0[1]; acc[2] += bflo(z.y) * w0[2]; acc[3] += bfhi(z.y) * w0[3];
                    acc[4] += bflo(z.z) * w1[0]; acc[5] += bfhi(z.z) * w1[1]; acc[6] += bflo(z.w) * w1[2]; acc[7] += bfhi(z.w) * w1[3];
                }
            }
        u32x4 o;
#pragma unroll
        for (int e = 0; e < 8; ++e) acc[e] = acc[e] * sigmoidf_(acc[e]);
        o.x = pk2(acc[0], acc[1]); o.y = pk2(acc[2], acc[3]); o.z = pk2(acc[4], acc[5]); o.w = pk2(acc[6], acc[7]);
        *(u32x4*)(QKC + (size_t)row * 512 + c8) = o;
    }
}

constexpr int ML_QS = 0, ML_KS = 18432, ML_VT = 36864, ML_CS = 71680, ML_PS = 92416, ML_GV = 127232, ML_BV = 127744, ML_MV = 128256, ML_LF = 128768, ML_IG = 129280, ML_SC = 129792;

__device__ __forceinline__ void ml_gate_vectors(const Ctx& cx, CParams& p, int l, int dir, int b, int h, int nc, unsigned char* sm, float m_in) {
    const int tid = cx.tid, lane = tid & 63;
    float* lf = (float*)(sm + ML_LF); float* ig = (float*)(sm + ML_IG); float* gv = (float*)(sm + ML_GV); float* bv = (float*)(sm + ML_BV); float* mv = (float*)(sm + ML_MV); float* sc = (float*)(sm + ML_SC);
    const float* MLG = (const float*)(p.ws + OFF_MLG);
    const float* gb = p.in[21] + l * 16;
    if (tid < 128) {
        const int row = ml_row0(b, nc) + tid;
        const float ip = MLG[(size_t)row * 16 + dir * 4 + h] + gb[dir * 4 + h];
        const float fp = MLG[(size_t)row * 16 + 8 + dir * 4 + h] + gb[8 + dir * 4 + h];
        ig[tid] = ip; lf[tid] = fminf(fp, 0.f) - log1pf(expf(-fabsf(fp)));
    }
    __syncthreads();
    if (tid < 64) {
        const int pp0 = 2 * lane, pp1 = 2 * lane + 1; const int s0 = dir ? 127 - pp0 : pp0, s1 = dir ? 127 - pp1 : pp1;
        const float x0 = lf[s0], x1 = lf[s1];
        float incl = x0 + x1;
#pragma unroll
        for (int d = 1; d < 64; d <<= 1) { const float t = __shfl_up(incl, d); if (lane >= d) incl += t; }
        const float g1 = incl, g0 = incl - x1;
        const float gtot = __shfl(incl, 63);
        const float b0 = ig[s0] - g0, b1 = ig[s1] - g1;
        float mx = fmaxf(b0, b1);
#pragma unroll
        for (int d = 1; d < 64; d <<= 1) { const float t = __shfl_up(mx, d); if (lane >= d) mx = fmaxf(mx, t); }
        const float prev = __shfl_up(mx, 1);
        const float pm0 = lane > 0 ? fmaxf(prev, b0) : b0, pm1 = mx;
        const float bmax = __shfl(mx, 63);
        gv[s0] = g0; gv[s1] = g1; bv[s0] = b0; bv[s1] = b1; mv[s0] = fmaxf(m_in, pm0); mv[s1] = fmaxf(m_in, pm1);
        if (lane == 0) { sc[0] = gtot; sc[1] = bmax; }
    }
    __syncthreads();
}

__device__ __forceinline__ void phase_ml_local(int l, unsigned char* sm) {
    CParams& p = KPL(); const Ctx cx = mkctx();
    const int tid = cx.tid, lane = tid & 63, wid = tid >> 6;
    const bf16_t* ZA = (const bf16_t*)(p.ws + OFF_Z); const bf16_t* QKC = (const bf16_t*)(p.ws + OFF_QKC);
    float* CLOC = (float*)(p.ws + OFF_CLOC); float* MLS = (float*)(p.ws + OFF_MLS);
    bf16_t* VT = (bf16_t*)(sm + ML_VT); bf16_t* KT = (bf16_t*)(sm + ML_KS);
    const float* bv = (const float*)(sm + ML_BV); const float* sc = (const float*)(sm + ML_SC);
    float* wg = (float*)(sm + ML_LF);
    unsigned* ticket = (unsigned*)(p.ws + OFF_BAR) + 3600 + l * 16;
    int* tslot = (int*)(sm + 143328);
    for (;;) {
        if (tid == 0) *tslot = (int)__hip_atomic_fetch_add(ticket, 1u, __ATOMIC_RELAXED, __HIP_MEMORY_SCOPE_AGENT);
        __syncthreads();
        const int item = *tslot;
        __syncthreads();
        if (item >= 1056) break;
        const int chain = item / 66, nc = item % 66; const int dir = chain >> 3, b = (chain >> 2) & 1, h = chain & 3;
        ml_gate_vectors(cx, p, l, dir, b, h, nc, sm, -1e30f);
        const float gtot = sc[0], bmax = sc[1];
        __syncthreads();
        if (tid < 128) wg[tid] = expf(bv[tid] - bmax);
        __syncthreads();
        const int row0 = ml_row0(b, nc);
#pragma unroll
        for (int q = 0; q < 4; ++q) { const int ci = q * 512 + tid; const int s = ci >> 4, v8 = (ci & 15) * 8;
            const u32x4 z = *(const u32x4*)(ZA + (size_t)(row0 + s) * 2048 + 1024 + h * 128 + v8); const float w = wg[s];
            const unsigned zz[4] = {z.x, z.y, z.z, z.w};
#pragma unroll
            for (int e = 0; e < 4; ++e) { VT[(v8 + 2 * e) * 136 + s] = f2bf(bflo(zz[e]) * w); VT[(v8 + 2 * e + 1) * 136 + s] = f2bf(bfhi(zz[e]) * w); } }
#pragma unroll
        for (int q = 0; q < 2; ++q) { const int ci = q * 512 + tid; const int s = ci >> 3, k8 = (ci & 7) * 8;
            const u32x4 z = *(const u32x4*)(QKC + (size_t)(row0 + s) * 512 + 256 + h * 64 + k8);
            const unsigned zz[4] = {z.x, z.y, z.z, z.w};
#pragma unroll
            for (int e = 0; e < 4; ++e) { KT[(k8 + 2 * e) * 136 + s] = (bf16_t)(zz[e] & 0xffff); KT[(k8 + 2 * e + 1) * 136 + s] = (bf16_t)(zz[e] >> 16); } }
        __syncthreads();
        float* dst = CLOC + ((size_t)chain * 66 + nc) * 8256;
        f32x4 acc[4];
#pragma unroll
        for (int n = 0; n < 4; ++n) acc[n] = (f32x4){0.f, 0.f, 0.f, 0.f};
#pragma unroll
        for (int ks = 0; ks < 4; ++ks) {
            const bf16x8 a = *(const bf16x8*)(VT + (16 * wid + (lane & 15)) * 136 + ks * 32 + (lane >> 4) * 8);
#pragma unroll
            for (int n = 0; n < 4; ++n) { const bf16x8 bb = *(const bf16x8*)(KT + (16 * n + (lane & 15)) * 136 + ks * 32 + (lane >> 4) * 8);
                acc[n] = __builtin_amdgcn_mfma_f32_16x16x32_bf16(a, bb, acc[n], 0, 0, 0); }
        }
#pragma unroll
        for (int n = 0; n < 4; ++n)
#pragma unroll
            for (int j = 0; j < 4; ++j) dst[(16 * wid + (lane >> 4) * 4 + j) * 64 + 16 * n + (lane & 15)] = acc[n][j];
        if (tid < 64) { float s0 = 0.f, s1 = 0.f, s2 = 0.f, s3 = 0.f;
#pragma unroll 4
            for (int t = 0; t < 128; t += 4) { const u32x2 kq = *(const u32x2*)(KT + tid * 136 + t); const f32x4 w4 = *(const f32x4*)(wg + t);
                s0 += w4[0] * bflo(kq.x); s1 += w4[1] * bfhi(kq.x); s2 += w4[2] * bflo(kq.y); s3 += w4[3] * bfhi(kq.y); }
            dst[8192 + tid] = (s0 + s1) + (s2 + s3); }
        if (tid == 0) { MLS[chain * 66 + nc] = gtot; MLS[1056 + chain * 66 + nc] = gtot + bmax; }
        __syncthreads();
    }
}

__device__ __forceinline__ void phase_ml_carry() {
    CParams& p = KPL(); const Ctx cx = mkctx();
    float* CLOC = (float*)(p.ws + OFF_CLOC); float* MLS = (float*)(p.ws + OFF_MLS);
    for (int idx = cx.bid * 512 + cx.tid; idx < 16 * 8192; idx += cx.nb * 512) {
        const int chain = idx >> 13, e = idx & 8191; const int dir = chain >> 3;
        const bool two = e < 64;
        float* base = CLOC + (size_t)chain * 66 * 8256 + e;
        const float* gtp = MLS + chain * 66; const float* amp = MLS + 1056 + chain * 66;
        float m = -1e30f, C = 0.f, N = 0.f;
        for (int i0 = 0; i0 < 66; i0 += 11) {
            float cl[11], nl[11], gt[11], am[11];
#pragma unroll
            for (int q = 0; q < 11; ++q) { const int nc = ml_order(dir, i0 + q); cl[q] = base[(size_t)nc * 8256]; nl[q] = two ? base[(size_t)nc * 8256 + 8192] : 0.f; gt[q] = gtp[nc]; am[q] = amp[nc]; }
#pragma unroll
            for (int q = 0; q < 11; ++q) { const int nc = ml_order(dir, i0 + q);
                base[(size_t)nc * 8256] = C;
                if (two) base[(size_t)nc * 8256 + 8192] = N;
                if (e == 0) MLS[2112 + chain * 66 + nc] = m;
                const float mn = fmaxf(gt[q] + m, am[q]); const float so = __expf(gt[q] + m - mn), sl = __expf(am[q] - mn);
                C = so * C + sl * cl[q]; N = so * N + sl * nl[q]; m = mn; }
        }
    }
}

__device__ __forceinline__ void phase_ml_out(int l, unsigned char* sm) {
    CParams& p = KPL(); const Ctx cx = mkctx();
    const int tid = cx.tid, lane = tid & 63, wid = tid >> 6;
    const bf16_t* ZA = (const bf16_t*)(p.ws + OFF_Z); const bf16_t* QKC = (const bf16_t*)(p.ws + OFF_QKC);
    const float* CLOC = (const float*)(p.ws + OFF_CLOC); const float* MLS = (const float*)(p.ws + OFF_MLS);
    bf16_t* YB = (bf16_t*)(p.ws + OFF_YB);
    bf16_t* QS = (bf16_t*)(sm + ML_QS); bf16_t* KS = (bf16_t*)(sm + ML_KS); bf16_t* VT = (bf16_t*)(sm + ML_VT); bf16_t* CS = (bf16_t*)(sm + ML_CS); bf16_t* PS = (bf16_t*)(sm + ML_PS);
    const float* gv = (const float*)(sm + ML_GV); const float* bv = (const float*)(sm + ML_BV); const float* mv = (const float*)(sm + ML_MV);
    unsigned* ticket = (unsigned*)(p.ws + OFF_BAR) + 3608 + l * 16;
    int* tslot = (int*)(sm + 143328);
    for (;;) {
        if (tid == 0) *tslot = (int)__hip_atomic_fetch_add(ticket, 1u, __ATOMIC_RELAXED, __HIP_MEMORY_SCOPE_AGENT);
        __syncthreads();
        const int item = *tslot;
        __syncthreads();
        if (item >= 528) break;
        const int b = item / 264, h = (item / 66) & 3, nc = item % 66;
        const int row0 = ml_row0(b, nc);
        __syncthreads();
#pragma unroll
        for (int q = 0; q < 2; ++q) { const int ci = q * 512 + tid; const int s = ci >> 3, k8 = (ci & 7) * 8;
            const u32x4 zq = *(const u32x4*)(QKC + (size_t)(row0 + s) * 512 + h * 64 + k8);
            u32x4 o; o.x = pk2(bflo(zq.x) * 0.125f, bfhi(zq.x) * 0.125f); o.y = pk2(bflo(zq.y) * 0.125f, bfhi(zq.y) * 0.125f); o.z = pk2(bflo(zq.z) * 0.125f, bfhi(zq.z) * 0.125f); o.w = pk2(bflo(zq.w) * 0.125f, bfhi(zq.w) * 0.125f);
            *(u32x4*)(QS + s * 72 + k8) = o;
            *(u32x4*)(KS + s * 72 + k8) = *(const u32x4*)(QKC + (size_t)(row0 + s) * 512 + 256 + h * 64 + k8); }
#pragma unroll
        for (int q = 0; q < 4; ++q) { const int ci = q * 512 + tid; const int s = ci >> 4, v8 = (ci & 15) * 8;
            const u32x4 z = *(const u32x4*)(ZA + (size_t)(row0 + s) * 2048 + 1024 + h * 128 + v8);
            const unsigned zz[4] = {z.x, z.y, z.z, z.w};
#pragma unroll
            for (int e = 0; e < 4; ++e) { VT[(v8 + 2 * e) * 136 + s] = (bf16_t)(zz[e] & 0xffff); VT[(v8 + 2 * e + 1) * 136 + s] = (bf16_t)(zz[e] >> 16); } }
        f32x4 hsum[8];
#pragma unroll
        for (int v = 0; v < 8; ++v) hsum[v] = (f32x4){0.f, 0.f, 0.f, 0.f};
#pragma unroll 1
        for (int dir = 0; dir < 2; ++dir) {
            const int chain = dir * 8 + b * 4 + h;
            const float m_in = MLS[2112 + chain * 66 + nc];
            __syncthreads();
            ml_gate_vectors(cx, p, l, dir, b, h, nc, sm, m_in);
            const float* cin = CLOC + ((size_t)chain * 66 + nc) * 8256;
#pragma unroll
            for (int q = 0; q < 4; ++q) { const int ci = q * 512 + tid; const int v = ci >> 4, k4 = (ci & 15) * 4;
                const f32x4 c = *(const f32x4*)(cin + v * 64 + k4); store4bf(CS + v * 72 + k4, c); }
            if (tid < 16) { const f32x4 c = *(const f32x4*)(cin + 8192 + tid * 4); store4bf(CS + 128 * 72 + tid * 4, c); }
            else if (tid < 256) { const int r = 129 + (tid - 16) / 16, k4 = ((tid - 16) & 15) * 4; store4bf(CS + r * 72 + k4, (f32x4){0.f, 0.f, 0.f, 0.f}); }
            __syncthreads();
            const int tr = 16 * wid + (lane >> 4) * 4;
            float Mt[4], rs[4] = {0.f, 0.f, 0.f, 0.f};
#pragma unroll
            for (int j = 0; j < 4; ++j) Mt[j] = mv[tr + j];
            bf16x8 qa[2];
#pragma unroll
            for (int ks = 0; ks < 2; ++ks) qa[ks] = *(const bf16x8*)(QS + (16 * wid + (lane & 15)) * 72 + ks * 32 + (lane >> 4) * 8);
#pragma unroll
            for (int nt = 0; nt < 8; ++nt) {
                f32x4 s4 = (f32x4){0.f, 0.f, 0.f, 0.f};
#pragma unroll
                for (int ks = 0; ks < 2; ++ks) { const bf16x8 kb = *(const bf16x8*)(KS + (16 * nt + (lane & 15)) * 72 + ks * 32 + (lane >> 4) * 8);
                    s4 = __builtin_amdgcn_mfma_f32_16x16x32_bf16(qa[ks], kb, s4, 0, 0, 0); }
                const int s = 16 * nt + (lane & 15); const float bs = bv[s];
#pragma unroll
                for (int j = 0; j < 4; ++j) { const int t = tr + j; const bool valid = dir ? (s >= t) : (s <= t);
                    const float pv = valid ? s4[j] * __expf(bs - Mt[j]) : 0.f; rs[j] += pv; PS[t * 136 + s] = f2bf(pv); }
            }
#pragma unroll
            for (int j = 0; j < 4; ++j) rs[j] = row16_sum(rs[j]);
            __syncthreads();
            f32x4 qn = (f32x4){0.f, 0.f, 0.f, 0.f};
#pragma unroll
            for (int ks = 0; ks < 2; ++ks) { const bf16x8 cb = *(const bf16x8*)(CS + (128 + (lane & 15)) * 72 + ks * 32 + (lane >> 4) * 8);
                qn = __builtin_amdgcn_mfma_f32_16x16x32_bf16(qa[ks], cb, qn, 0, 0, 0); }
            float wi[4], dn[4];
#pragma unroll
            for (int j = 0; j < 4; ++j) { const float qnj = row16_sum(qn[j]); wi[j] = expf(m_in - Mt[j]);
                const float den = rs[j] + wi[j] * qnj; const float mt = gv[tr + j] + Mt[j]; dn[j] = 1.f / fmaxf(fabsf(den), expf(-mt)); }
            bf16x8 pa[4];
#pragma unroll
            for (int ks = 0; ks < 4; ++ks) pa[ks] = *(const bf16x8*)(PS + (16 * wid + (lane & 15)) * 136 + ks * 32 + (lane >> 4) * 8);
#pragma unroll
            for (int vt = 0; vt < 8; ++vt) {
                f32x4 a1 = (f32x4){0.f, 0.f, 0.f, 0.f}, a2 = (f32x4){0.f, 0.f, 0.f, 0.f};
#pragma unroll
                for (int ks = 0; ks < 4; ++ks) { const bf16x8 vb = *(const bf16x8*)(VT + (16 * vt + (lane & 15)) * 136 + ks * 32 + (lane >> 4) * 8);
                    a1 = __builtin_amdgcn_mfma_f32_16x16x32_bf16(pa[ks], vb, a1, 0, 0, 0); }
#pragma unroll
                for (int ks = 0; ks < 2; ++ks) { const bf16x8 cb = *(const bf16x8*)(CS + (16 * vt + (lane & 15)) * 72 + ks * 32 + (lane >> 4) * 8);
                    a2 = __builtin_amdgcn_mfma_f32_16x16x32_bf16(qa[ks], cb, a2, 0, 0, 0); }
#pragma unroll
                for (int j = 0; j < 4; ++j) hsum[vt][j] += (a1[j] + wi[j] * a2[j]) * dn[j];
            }
        }
        const int tr = 16 * wid + (lane >> 4) * 4;
        float rinv[4];
#pragma unroll
        for (int j = 0; j < 4; ++j) { float ss = 0.f;
#pragma unroll
            for (int vt = 0; vt < 8; ++vt) ss += hsum[vt][j] * hsum[vt][j];
            ss = row16_sum(ss); rinv[j] = rsqrtf(ss * (1.f / 128.f) + 1e-6f); }
#pragma unroll
        for (int vt = 0; vt < 8; ++vt) { const int ch = h * 128 + 16 * vt + (lane & 15); const float ng = p.in[22][l * 512 + ch];
#pragma unroll
            for (int j = 0; j < 4; ++j) { const int row = row0 + tr + j;
                const float o = bf2f(ZA[(size_t)row * 2048 + 1536 + ch]);
                YB[(size_t)row * 512 + ch] = f2bf(hsum[vt][j] * rinv[j] * ng * sigmoidf_(o)); } }
    }
}

__device__ __forceinline__ void phase_rw_feat(int l) {
    CParams& p = KPL(); const Ctx cx = mkctx();
    const int lane = cx.tid & 63, gw = cx.bid * 8 + (cx.tid >> 6), nw = cx.nb * 8;
    const bf16_t* ZRW = (const bf16_t*)(p.ws + OFF_ZRW);
    bf16_t* F1 = (bf16_t*)(p.ws + OFF_F1); bf16_t* LIN = (bf16_t*)(p.ws + OFF_LORAIN);
    const float* mup = p.in[23] + (size_t)l * 1792; const float* mun = p.in[24] + (size_t)l * 1792;
    const float* kk_w = p.in[30] + l * 512;
    for (int row = gw; row < T_TOK; row += nw) {
        const int b = row >= SEQA ? 1 : 0, t = row - b * SEQA;
        const bool hasp = !(t == 0 || t == NCTX), hasn = !(t == NCTX - 1 || t == SEQA - 1);
        const bf16_t* zc = ZRW + (size_t)row * 1792;
#pragma unroll
        for (int q = 0; q < 3; ++q) {
            const int col = q * 512 + lane * 8;
            const u32x4 c4 = *(const u32x4*)(zc + col);
            u32x4 p4 = (u32x4){0u, 0u, 0u, 0u}, n4 = (u32x4){0u, 0u, 0u, 0u};
            if (hasp) p4 = *(const u32x4*)(zc - 1792 + col);
            if (hasn) n4 = *(const u32x4*)(zc + 1792 + col);
            const unsigned cc[4] = {c4.x, c4.y, c4.z, c4.w}, pp[4] = {p4.x, p4.y, p4.z, p4.w}, nn[4] = {n4.x, n4.y, n4.z, n4.w};
            float zs[8];
#pragma unroll
            for (int e = 0; e < 8; ++e) { const float z = (e & 1) ? bfhi(cc[e >> 1]) : bflo(cc[e >> 1]); const float pv = (e & 1) ? bfhi(pp[e >> 1]) : bflo(pp[e >> 1]); const float nx = (e & 1) ? bfhi(nn[e >> 1]) : bflo(nn[e >> 1]);
                zs[e] = z + mup[col + e] * (pv - z) + mun[col + e] * (nx - z); }
            u32x4 o; o.x = pk2(zs[0], zs[1]); o.y = pk2(zs[2], zs[3]); o.z = pk2(zs[4], zs[5]); o.w = pk2(zs[6], zs[7]);
            *(u32x4*)(F1 + (size_t)row * 2048 + q * 512 + lane * 8) = o;
            if (q == 1) {
                float kr[8], ssq = 0.f;
#pragma unroll
                for (int e = 0; e < 8; ++e) { kr[e] = zs[e] * kk_w[lane * 8 + e]; ssq += kr[e] * kr[e]; }
                ssq = row8_sum(ssq);
                const float inv = 1.f / fmaxf(sqrtf(ssq), 1e-12f);
                u32x4 o2; o2.x = pk2(kr[0] * inv, kr[1] * inv); o2.y = pk2(kr[2] * inv, kr[3] * inv); o2.z = pk2(kr[4] * inv, kr[5] * inv); o2.w = pk2(kr[6] * inv, kr[7] * inv);
                *(u32x4*)(F1 + (size_t)row * 2048 + 1536 + lane * 8) = o2;
            }
        }
        {
            const int col = 1536 + lane * 4;
            const u32x2 c2 = *(const u32x2*)(zc + col);
            u32x2 p2 = (u32x2){0u, 0u}, n2 = (u32x2){0u, 0u};
            if (hasp) p2 = *(const u32x2*)(zc - 1792 + col);
            if (hasn) n2 = *(const u32x2*)(zc + 1792 + col);
            const unsigned cc[2] = {c2.x, c2.y}, pp[2] = {p2.x, p2.y}, nn[2] = {n2.x, n2.y};
            float zs[4];
#pragma unroll
            for (int e = 0; e < 4; ++e) { const float z = (e & 1) ? bfhi(cc[e >> 1]) : bflo(cc[e >> 1]); const float pv = (e & 1) ? bfhi(pp[e >> 1]) : bflo(pp[e >> 1]); const float nx = (e & 1) ? bfhi(nn[e >> 1]) : bflo(nn[e >> 1]);
                const float s = z + mup[col + e] * (pv - z) + mun[col + e] * (nx - z);
                zs[e] = lane < 16 ? tanhf(s) : (lane < 32 ? s : sigmoidf_(s)); }
            u32x2 o; o.x = pk2(zs[0], zs[1]); o.y = pk2(zs[2], zs[3]);
            *(u32x2*)(LIN + (size_t)row * 256 + lane * 4) = o;
        }
    }
}

__device__ __forceinline__ int rw_tok(int dir, int i) { return dir == 0 ? i : (i < NCTX ? NCTX - 1 - i : 8703 - i); }

typedef float f32x2 __attribute__((ext_vector_type(2)));
constexpr int RW_REC = 384;
__device__ __forceinline__ void rw_load(const bf16_t* f1, const bf16_t* f2, const bf16_t* fu, int ustr, int dir, int rg, int c, int pw, int lane, bf16_t (&in)[8][5], bf16_t (&vin)[8]) {
#pragma unroll
    for (int q = 0; q < 8; ++q) { const size_t t = (size_t)rw_tok(dir, c * 32 + pw * 8 + q);
        in[q][0] = f1[t * 2048 + lane]; in[q][1] = f1[t * 2048 + 512 + lane]; in[q][2] = f1[t * 2048 + 1536 + lane]; in[q][3] = fu[t * ustr + lane]; in[q][4] = f2[t * 2048 + 1024 + lane];
        vin[q] = f1[t * 2048 + 1024 + rg * 16 + (lane & 15)]; }
}
__device__ __forceinline__ void rw_emit(const bf16_t (&in)[8][5], const bf16_t (&vin)[8], int pw, int lane, float ka, float* buf) {
#pragma unroll
    for (int q = 0; q < 8; ++q) {
        const float r = bf2f(in[q][0]), k = bf2f(in[q][1]), kk = bf2f(in[q][2]), u = bf2f(in[q][3]), a = bf2f(in[q][4]);
        const float w = 1.f - u, key = k * (1.f + (a - 1.f) * ka), kka = kk * a, wr = w * r;
        const float c1 = wave_sum(kka * r), c2 = wave_sum(key * r);
        float* rec = buf + (pw * 8 + q) * RW_REC;
        rec[lane] = kk; rec[64 + lane] = wr; rec[128 + lane] = w; rec[192 + lane] = kka; rec[256 + lane] = key;
        if (lane < 16) { f32x4 vc; vc[0] = bf2f(vin[q]); vc[1] = c1; vc[2] = c2; vc[3] = 0.f; *(f32x4*)(rec + 320 + lane * 4) = vc; }
    }
}

__device__ __forceinline__ void phase_rw_scan(int l, unsigned char* sm) {
    CParams& p = KPL(); const Ctx cx = mkctx();
    const int tid = cx.tid, lane = tid & 63, wid = __builtin_amdgcn_readfirstlane(tid >> 6);
    const bf16_t* F1 = (const bf16_t*)(p.ws + OFF_F1); const bf16_t* F2 = (const bf16_t*)(p.ws + OFF_Z);
    bf16_t* YRAW = (bf16_t*)(p.ws + OFF_R2);
    float* ring = (float*)sm;
    const bool is_scan = wid < 4, is_prod = wid >= 4;
    const int pw = wid & 3;
    const int nscan = cx.nb >= 2 ? cx.nb / 2 : 1;
    if (cx.bid >= nscan) return;
    for (int item = cx.bid; item < 128; item += nscan) {
        const int chain = item >> 2, rg = item & 3; const int dir = chain >> 4, b = (chain >> 3) & 1, h = chain & 7;
        const float ka = p.in[31][l * 512 + h * 64 + lane];
        const bf16_t* f1 = F1 + (size_t)b * SEQA * 2048 + h * 64; const bf16_t* f2 = F2 + (size_t)b * SEQA * 2048 + dir * 512 + h * 64;
        const int ustr = dir ? 2048 : 512;
        const bf16_t* fu = dir ? f2 : (const bf16_t*)(p.ws + OFF_U0) + (size_t)b * SEQA * 512 + h * 64;
        const int row = rg * 16 + (wid & 3) * 4 + (lane >> 4);
        bf16_t* yr = YRAW + ((size_t)dir * T_TOK + (size_t)b * SEQA) * 512 + h * 64 + row;
        bf16_t pin[8][5], pvin[8];
        __syncthreads();
        if (is_prod) { rw_load(f1, f2, fu, ustr, dir, rg, 0, pw, lane, pin, pvin); rw_emit(pin, pvin, pw, lane, ka, ring); rw_load(f1, f2, fu, ustr, dir, rg, 1, pw, lane, pin, pvin); }
        __syncthreads();
        f32x2 S01 = (f32x2){0.f, 0.f}, S23 = (f32x2){0.f, 0.f};
        if (is_scan) __builtin_amdgcn_s_setprio(3);
#pragma unroll 1
        for (int c = 0; c < 264; ++c) {
            float* buf = ring + (c & 1) * (32 * RW_REC);
            if (is_prod) { if (c + 1 < 264) { rw_emit(pin, pvin, pw, lane, ka, ring + ((c + 1) & 1) * (32 * RW_REC)); rw_load(f1, f2, fu, ustr, dir, rg, c + 2 < 264 ? c + 2 : c + 1, pw, lane, pin, pvin); } }
            else if (is_scan) {
                const float* rb = buf + (lane & 15) * 4;
                const float* vb = buf + 320 + ((wid & 3) * 4 + (lane >> 4)) * 4;
#pragma unroll 1
                for (int hf = 0; hf < 2; ++hf) {
                    const float* rh = rb + hf * 16 * RW_REC; const float* vh = vb + hf * 16 * RW_REC;
                    f32x4 kk4 = *(const f32x4*)(rh), wr4 = *(const f32x4*)(rh + 64), w4 = *(const f32x4*)(rh + 128), ka4 = *(const f32x4*)(rh + 192), ky4 = *(const f32x4*)(rh + 256), vc4 = *(const f32x4*)(vh);
                    f32x4 nkk = *(const f32x4*)(rh + RW_REC), nwr = *(const f32x4*)(rh + RW_REC + 64), nw = *(const f32x4*)(rh + RW_REC + 128), nka = *(const f32x4*)(rh + RW_REC + 192), nky = *(const f32x4*)(rh + RW_REC + 256), nvc = *(const f32x4*)(vh + RW_REC);
                    float ybuf = 0.f;
#pragma unroll
                    for (int j = 0; j < 16; ++j) {
                        f32x4 mkk, mwr, mw, mka, mky, mvc;
                        if (j < 14) { const int o = (j + 2) * RW_REC;
                            mkk = *(const f32x4*)(rh + o); mwr = *(const f32x4*)(rh + o + 64); mw = *(const f32x4*)(rh + o + 128); mka = *(const f32x4*)(rh + o + 192); mky = *(const f32x4*)(rh + o + 256); mvc = *(const f32x4*)(vh + o); }
                        const float vv = vc4[0];
                        f32x2 p1 = S01 * (f32x2){kk4[0], kk4[1]}; p1 = S23 * (f32x2){kk4[2], kk4[3]} + p1;
                        f32x2 p2 = S01 * (f32x2){wr4[0], wr4[1]}; p2 = S23 * (f32x2){wr4[2], wr4[3]} + p2;
                        const f32x2 vv2 = (f32x2){vv, vv};
                        f32x2 u01 = (f32x2){ky4[0], ky4[1]} * vv2; u01 = S01 * (f32x2){w4[0], w4[1]} + u01;
                        f32x2 u23 = (f32x2){ky4[2], ky4[3]} * vv2; u23 = S23 * (f32x2){w4[2], w4[3]} + u23;
                        const float sk = row16_sum(p1[0] + p1[1]);
                        const float q2 = row16_sum(p2[0] + p2[1]);
                        const f32x2 nsk2 = (f32x2){-sk, -sk};
                        S01 = (f32x2){ka4[0], ka4[1]} * nsk2 + u01; S23 = (f32x2){ka4[2], ka4[3]} * nsk2 + u23;
                        const float y = q2 - sk * vc4[1] + vv * vc4[2];
                        if ((lane & 15) == j) ybuf = y;
                        kk4 = nkk; wr4 = nwr; w4 = nw; ka4 = nka; ky4 = nky; vc4 = nvc;
                        if (j < 14) { nkk = mkk; nwr = mwr; nw = mw; nka = mka; nky = mky; nvc = mvc; }
                        __builtin_amdgcn_sched_barrier(0);
                    }
                    yr[(size_t)rw_tok(dir, c * 32 + hf * 16 + (lane & 15)) * 512] = f2bf(ybuf);
                }
            }
            asm volatile("s_waitcnt lgkmcnt(0)" ::: "memory"); __builtin_amdgcn_s_barrier(); asm volatile("" ::: "memory");
        }
        if (is_scan) __builtin_amdgcn_s_setprio(0);
    }
}

__device__ __forceinline__ void phase_rw_out(int l) {
    CParams& p = KPL(); const Ctx cx = mkctx();
    const int lane = cx.tid & 63, gw = cx.bid * 8 + (cx.tid >> 6), nw = cx.nb * 8;
    const bf16_t* F1 = (const bf16_t*)(p.ws + OFF_F1); const bf16_t* F2 = (const bf16_t*)(p.ws + OFF_Z); const bf16_t* GRW = (const bf16_t*)(p.ws + OFF_ZRW);
    const bf16_t* YRAW = (const bf16_t*)(p.ws + OFF_R2);
    bf16_t* YC = (bf16_t*)(p.ws + OFF_YC);
    const int c0 = lane * 8;
    float ka[8], rk[8], lg[8], lb[8];
#pragma unroll
    for (int e = 0; e < 8; ++e) { ka[e] = p.in[31][l * 512 + c0 + e]; rk[e] = p.in[32][l * 512 + c0 + e]; lg[e] = p.in[33][l * 512 + c0 + e]; lb[e] = p.in[34][l * 512 + c0 + e]; }
    for (int row = gw; row < T_TOK; row += nw) {
        const u32x4 y0 = *(const u32x4*)(YRAW + (size_t)row * 512 + c0), y1 = *(const u32x4*)(YRAW + ((size_t)T_TOK + row) * 512 + c0);
        const u32x4 r4 = *(const u32x4*)(F1 + (size_t)row * 2048 + c0), k4 = *(const u32x4*)(F1 + (size_t)row * 2048 + 512 + c0), v4 = *(const u32x4*)(F1 + (size_t)row * 2048 + 1024 + c0);
        const u32x4 a04 = *(const u32x4*)(F2 + (size_t)row * 2048 + 1024 + c0), a14 = *(const u32x4*)(F2 + (size_t)row * 2048 + 1536 + c0);
        const u32x4 g4 = *(const u32x4*)(GRW + (size_t)row * 512 + c0);
        const unsigned ya[4] = {y0.x, y0.y, y0.z, y0.w}, yb[4] = {y1.x, y1.y, y1.z, y1.w}, rr[4] = {r4.x, r4.y, r4.z, r4.w}, kx[4] = {k4.x, k4.y, k4.z, k4.w}, vv[4] = {v4.x, v4.y, v4.z, v4.w};
        const unsigned aa[4] = {a04.x, a04.y, a04.z, a04.w}, ab[4] = {a14.x, a14.y, a14.z, a14.w}, gg[4] = {g4.x, g4.y, g4.z, g4.w};
        float y[8], sum = 0.f, bs = 0.f;
#pragma unroll
        for (int e = 0; e < 8; ++e) {
            const int w = e >> 1; const bool hi = e & 1;
            y[e] = (hi ? bfhi(ya[w]) : bflo(ya[w])) + (hi ? bfhi(yb[w]) : bflo(yb[w])); sum += y[e];
            const float r = hi ? bfhi(rr[w]) : bflo(rr[w]), k = hi ? bfhi(kx[w]) : bflo(kx[w]), a0 = hi ? bfhi(aa[w]) : bflo(aa[w]), a1 = hi ? bfhi(ab[w]) : bflo(ab[w]);
            bs += r * k * (2.f + (a0 + a1 - 2.f) * ka[e]) * rk[e];
        }
        sum = row8_sum(sum); bs = row8_sum(bs);
        const float mu = sum * (1.f / 64.f);
        float var = 0.f;
#pragma unroll
        for (int e = 0; e < 8; ++e) { const float d = y[e] - mu; var += d * d; }
        var = row8_sum(var) * (1.f / 64.f);
        const float rstd = rsqrtf(var + 64e-5f);
        float o[8];
#pragma unroll
        for (int e = 0; e < 8; ++e) { const int w = e >> 1; const bool hi = e & 1;
            const float v = hi ? bfhi(vv[w]) : bflo(vv[w]), g = hi ? bfhi(gg[w]) : bflo(gg[w]);
            o[e] = ((y[e] - mu) * rstd * lg[e] + lb[e] + bs * v) * g; }
        u32x4 o4; o4.x = pk2(o[0], o[1]); o4.y = pk2(o[2], o[3]); o4.z = pk2(o[4], o[5]); o4.w = pk2(o[6], o[7]);
        *(u32x4*)(YC + (size_t)row * 512 + c0) = o4;
    }
}

__device__ __forceinline__ void phase_final() {
    CParams& p = KPL(); const Ctx cx = mkctx();
    const int lane = cx.tid & 63, gw = cx.bid * 8 + (cx.tid >> 6), nw = cx.nb * 8;
    const float* X = (const float*)(p.ws + OFF_X);
    for (int r = gw; r < 2 * 8192; r += nw) {
        const int b = r >> 13, t = r & 8191;
        const float* src = X + ((size_t)b * SEQA + NCTX + t) * 1024;
        f32x4 v[4]; float ss = 0.f;
#pragma unroll
        for (int i = 0; i < 4; ++i) { v[i] = *(const f32x4*)(src + (lane + 64 * i) * 4); ss += v[i][0] * v[i][0] + v[i][1] * v[i][1] + v[i][2] * v[i][2] + v[i][3] * v[i][3]; }
        ss = wave_sum(ss);
        const float inv = rsqrtf(ss * (1.f / 1024.f) + 1e-6f);
#pragma unroll
        for (int i = 0; i < 4; ++i) { const int c = (lane + 64 * i) * 4; const f32x4 g4 = *(const f32x4*)(p.in[41] + c);
            *(f32x4*)(p.out + (size_t)r * 1024 + c) = v[i] * inv * g4; }
    }
}

#define XB_TMO      128
#define XB_XCNT(j)  (256  + 64 * (j))
#define XB_XSUB(j)  (1280 + 64 * (j))
#define XB_XGEN(j)  (2304 + 64 * (j))
#define XB_TOP      3328
#define XB_TOPGEN   3392
#define XCD_BAR_WORDS 3456
#define XB_SPIN_CAP (1u << 22)
constexpr int XB_LDS_OFF = 143344;
__device__ __forceinline__ unsigned xb_ld(unsigned* p)              { return __hip_atomic_load(p, __ATOMIC_RELAXED, __HIP_MEMORY_SCOPE_AGENT); }
__device__ __forceinline__ unsigned xb_add(unsigned* p, unsigned v) { return __hip_atomic_fetch_add(p, v, __ATOMIC_RELAXED, __HIP_MEMORY_SCOPE_AGENT); }
__device__ __forceinline__ unsigned xb_xcc_id() { return (unsigned)__builtin_amdgcn_s_getreg((3 << 11) | 20) & 0xFu; }
#define XB_SPIN(cond, bar) do { unsigned _sp = 0; while (cond) { __builtin_amdgcn_s_sleep(1); \
    if ((++_sp & 255u) == 0u) { if (xb_ld(&(bar)[XB_TMO])) break; if (_sp > XB_SPIN_CAP) { atomicAdd(&(bar)[XB_TMO], 1u); break; } } } } while (0)
__device__ __forceinline__ void xb_complete(unsigned* bar, unsigned x, unsigned G, unsigned& nloc, unsigned& nx) {
    unsigned sum, cnt, mine, sp = 0u;
    for (;;) {
        sum = 0u; cnt = 0u; mine = 0u;
#pragma unroll
        for (unsigned j = 0; j < 16; ++j) { const unsigned c = xb_ld(&bar[XB_XCNT(j)]); sum += c; cnt += (c > 0u) ? 1u : 0u; mine = (j == x) ? c : mine; }
        if (sum == G) break;
        __builtin_amdgcn_s_sleep(1);
        if ((++sp & 255u) == 0u) { if (xb_ld(&bar[XB_TMO])) break; if (sp > XB_SPIN_CAP) { atomicAdd(&bar[XB_TMO], 1u); break; } }
    }
    nloc = mine > 0u ? mine : 1u; nx = cnt > 0u ? cnt : 1u;
}
__device__ __forceinline__ void xb_post(unsigned char* smem) {
    CParams& p = KPL(); const Ctx cx = mkctx();
    volatile LAS unsigned* st = (volatile LAS unsigned*)((LAS unsigned char*)smem + XB_LDS_OFF);
    if (cx.tid == 0) { st[0] = 0u; st[1] = 0u; (void)xb_add(&((unsigned*)(p.ws + OFF_BAR))[XB_XCNT(xb_xcc_id())], 1u); }
    __syncthreads();
}
__device__ __forceinline__ void xsync(unsigned char* smem) {
    CParams& p = KPL(); const Ctx cx = mkctx();
    asm volatile("s_waitcnt vmcnt(0)" ::: "memory");
    __syncthreads();
    if (cx.tid == 0) {
        unsigned* bar = (unsigned*)(p.ws + OFF_BAR);
        volatile LAS unsigned* st = (volatile LAS unsigned*)((LAS unsigned char*)smem + XB_LDS_OFF);
        const unsigned x = xb_xcc_id();
        __builtin_amdgcn_s_waitcnt(0);
        unsigned nloc = st[0], nx = st[1];
        if (nloc == 0u) { xb_complete(bar, x, (unsigned)cx.nb, nloc, nx); st[0] = nloc; st[1] = nx; }
        const unsigned old = xb_add(&bar[XB_XSUB(x)], 1u);
        const unsigned gen = old / nloc;
        if (old + 1u == (gen + 1u) * nloc) {
            __builtin_amdgcn_fence(__ATOMIC_RELEASE, "agent");
            asm volatile("s_waitcnt vmcnt(0)" ::: "memory");
            const unsigned og = xb_add(&bar[XB_TOP], 1u);
            const unsigned tg = og / nx;
            if (og + 1u == (tg + 1u) * nx) xb_add(&bar[XB_TOPGEN], 1u);
            else XB_SPIN(xb_ld(&bar[XB_TOPGEN]) == tg, bar);
            __builtin_amdgcn_fence(__ATOMIC_ACQUIRE, "agent");
            xb_add(&bar[XB_XGEN(x)], 1u);
            asm volatile("s_waitcnt vmcnt(0)" ::: "memory");
        } else {
            XB_SPIN(xb_ld(&bar[XB_XGEN(x)]) == gen, bar);
            __builtin_amdgcn_fence(__ATOMIC_ACQUIRE, "agent");
            asm volatile("s_waitcnt vmcnt(0)" ::: "memory");
        }
    }
    __syncthreads();
}

__device__ __forceinline__ void s5_side_barrier(int l, int which) {
    CParams& p = KPL(); const Ctx cx = mkctx();
    const int b0 = cx.nb >= 2 ? cx.nb / 2 : 0;
    if (cx.bid < b0) return;
    unsigned* ctr = (unsigned*)(p.ws + OFF_BAR) + 3700 + l * 16 + which * 8;
    const unsigned target = (unsigned)(cx.nb - b0);
    asm volatile("s_waitcnt vmcnt(0)" ::: "memory");
    __syncthreads();
    if (cx.tid == 0) {
        __builtin_amdgcn_fence(__ATOMIC_RELEASE, "agent");
        asm volatile("s_waitcnt vmcnt(0)" ::: "memory");
        (void)xb_add(ctr, 1u);
        unsigned sp = 0u;
        while (xb_ld(ctr) < target) { __builtin_amdgcn_s_sleep(2); if (++sp > (1u << 24)) break; }
        __builtin_amdgcn_fence(__ATOMIC_ACQUIRE, "agent");
        asm volatile("s_waitcnt vmcnt(0)" ::: "memory");
    }
    __syncthreads();
}

#ifndef PHM
#define PHM 0xFFFFFFFFull
#endif
#ifndef PHR
#define PHR 0ull
#endif
#ifndef SYNCREP
#define SYNCREP 1
#endif
template <int WHICH>
__device__ __forceinline__ void gemm_stage(int l, LAS unsigned char* lds) {
    CParams& p = KPL(); const Ctx cx = mkctx();
    const int sk = (l == NLAYER - 1) ? 1 : 0;
    unsigned char* ws = p.ws;
    float* X = (float*)(ws + OFF_X); bf16_t* H = (bf16_t*)(ws + OFF_H); bf16_t* ZA = (bf16_t*)(ws + OFF_Z); bf16_t* ZRW = (bf16_t*)(ws + OFF_ZRW);
    bf16_t* W = (bf16_t*)(ws + OFF_W);
    const float* MODL = (const float*)(ws + OFF_MOD) + (size_t)l * 3 * 6144;
    if constexpr (WHICH == 0) run_gemm8(cx, lds, H, W + W_MIX / 2, 4096, 1024, FInproj8{ZA, (float*)(ws + OFF_MLG), ZRW});
    else if constexpr (WHICH == 1) run_gemm(cx, lds, (const bf16_t*)(ws + OFF_ZG), W + W_GLU / 2, 512, 512, FGlu{(const bf16_t*)(ws + OFF_ZG), p.in[18] + l * 512, (bf16_t*)(ws + OFF_YA)});
    else if constexpr (WHICH == 2) run_gemm_epi(cx, lds, (const bf16_t*)(ws + OFF_LORAIN), W + W_LORA / 2, 2560, 256, EpiLora{p.in[25] + l * 1024, p.in[27] + l * 1024, ZA, ZRW, (bf16_t*)(ws + OFF_U0)});
    else if constexpr (WHICH == 3) run_gemm8(cx, lds, H, W + W_GATE / 2, 3072, 1024, FGate8{ZA}, sk);
    else if constexpr (WHICH == 4) run_gemm(cx, lds, (const bf16_t*)(ws + OFF_YA), W + W_PA / 2, 1024, 512, FMerge<0>{ZA, (float*)(ws + OFF_F1), H}, sk);
    else if constexpr (WHICH == 5) run_gemm(cx, lds, (const bf16_t*)(ws + OFF_YB), W + W_PB / 2, 1024, 512, FMerge<1>{ZA, (float*)(ws + OFF_F1), H}, sk);
    else if constexpr (WHICH == 6) run_gemm(cx, lds, (const bf16_t*)(ws + OFF_YC), W + W_PC / 2, 1024, 512, FMerge<2>{ZA, (float*)(ws + OFF_F1), H}, sk);
    else if constexpr (WHICH == 7) run_gemm(cx, lds, H, W + W_OUT / 2, 1024, 1024, FResid{X, MODL, 2}, sk);
    else if constexpr (WHICH == 8) run_gemm8(cx, lds, H, W + W_1 / 2, 4096, 1024, FMlp18{ZA}, sk);
    else run_gemm(cx, lds, ZA, W + W_2 / 2, 1024, 4096, FResid{X, MODL, 5}, sk);
}

template <int l>
__device__ __forceinline__ void run_layer(cg::grid_group& grid, LAS unsigned char* lds, float* smf, unsigned char* smem) {
        if constexpr (l == 0) phase_wconv<0>(l, smf); else phase_wconv<1>(l, smf);
        __syncthreads();
        if constexpr ((PHM >> 2) & 1) { phase_norm(l, 0, l == 0); if constexpr ((PHR >> 2) & 1) { __syncthreads(); phase_norm(l, 0, l == 0); } }
        for (int sr = 0; sr < SYNCREP; ++sr) xsync(smem);
        if constexpr ((PHM >> 3) & 1) { gemm_stage<0>(l, lds); if constexpr ((PHR >> 3) & 1) { __syncthreads(); gemm_stage<0>(l, lds); } }
        for (int sr = 0; sr < SYNCREP; ++sr) xsync(smem);
        if constexpr ((PHM >> 5) & 1) { phase_ml_conv(l); if constexpr ((PHR >> 5) & 1) { __syncthreads(); phase_ml_conv(l); } }
        for (int sr = 0; sr < SYNCREP; ++sr) xsync(smem);
        if constexpr ((PHM >> 7) & 1) { phase_ml_local(l, smem); if constexpr ((PHR >> 7) & 1) { __syncthreads(); phase_ml_local(l, smem); } }
        for (int sr = 0; sr < SYNCREP; ++sr) xsync(smem);
        if constexpr ((PHM >> 9) & 1) { phase_ml_carry(); if constexpr ((PHR >> 9) & 1) { __syncthreads(); phase_ml_carry(); } }
        for (int sr = 0; sr < SYNCREP; ++sr) xsync(smem);
        if constexpr ((PHM >> 11) & 1) { phase_ml_out(l, smem); if constexpr ((PHR >> 11) & 1) { __syncthreads(); phase_ml_out(l, smem); } }
        for (int sr = 0; sr < SYNCREP; ++sr) xsync(smem);
        if constexpr ((PHM >> 12) & 1) { phase_rw_feat(l); if constexpr ((PHR >> 12) & 1) { __syncthreads(); phase_rw_feat(l); } }
        for (int sr = 0; sr < SYNCREP; ++sr) xsync(smem);
        if constexpr ((PHM >> 13) & 1) { gemm_stage<2>(l, lds); if constexpr ((PHR >> 13) & 1) { __syncthreads(); gemm_stage<2>(l, lds); } }
        for (int sr = 0; sr < SYNCREP; ++sr) xsync(smem);
        phase_rw_scan(l, smem);
        phase_s5_local(l);
        s5_side_barrier(l, 0);
        phase_s5_carry(l);
        s5_side_barrier(l, 1);
        phase_s5_final(l, smf);
        for (int sr = 0; sr < SYNCREP; ++sr) xsync(smem);
        gemm_stage<1>(l, lds);
        if constexpr ((PHM >> 15) & 1) { phase_rw_out(l); if constexpr ((PHR >> 15) & 1) { __syncthreads(); phase_rw_out(l); } }
        for (int sr = 0; sr < SYNCREP; ++sr) xsync(smem);
        if constexpr ((PHM >> 17) & 1) { gemm_stage<3>(l, lds); if constexpr ((PHR >> 17) & 1) { __syncthreads(); gemm_stage<3>(l, lds); } }
        for (int sr = 0; sr < SYNCREP; ++sr) xsync(smem);
        if constexpr ((PHM >> 18) & 1) { gemm_stage<4>(l, lds); if constexpr ((PHR >> 18) & 1) { __syncthreads(); gemm_stage<4>(l, lds); } }
        if constexpr ((PHM >> 19) & 1) { gemm_stage<5>(l, lds); if constexpr ((PHR >> 19) & 1) { __syncthreads(); gemm_stage<5>(l, lds); } }
        if constexpr ((PHM >> 20) & 1) { gemm_stage<6>(l, lds); if constexpr ((PHR >> 20) & 1) { __syncthreads(); gemm_stage<6>(l, lds); } }
        for (int sr = 0; sr < SYNCREP; ++sr) xsync(smem);
        if constexpr ((PHM >> 21) & 1) { gemm_stage<7>(l, lds); if constexpr ((PHR >> 21) & 1) { __syncthreads(); gemm_stage<7>(l, lds); } }
        for (int sr = 0; sr < SYNCREP; ++sr) xsync(smem);
        if constexpr ((PHM >> 22) & 1) { phase_norm(l, 1, false); if constexpr ((PHR >> 22) & 1) { __syncthreads(); phase_norm(l, 1, false); } }
        for (int sr = 0; sr < SYNCREP; ++sr) xsync(smem);
        if constexpr ((PHM >> 23) & 1) { gemm_stage<8>(l, lds); if constexpr ((PHR >> 23) & 1) { __syncthreads(); gemm_stage<8>(l, lds); } }
        for (int sr = 0; sr < SYNCREP; ++sr) xsync(smem);
        gemm_stage<9>(l, lds);
        if constexpr (l < NLAYER - 1) { __syncthreads(); phase_wconv<2>(l + 1, smf); }
        for (int sr = 0; sr < SYNCREP; ++sr) xsync(smem);
    }

__global__ void __launch_bounds__(512, 2) fwd_megakernel(Params p_unused) {
    extern __shared__ __attribute__((aligned(16))) unsigned char smem[];
    cg::grid_group grid = cg::this_grid();
    LAS unsigned char* lds = (LAS unsigned char*)smem;
    float* smf = (float*)smem;

    xb_post(smem);
    phase_mod(smf); phase_s5_params();
    grid.sync();
    run_layer<0>(grid, lds, smf, smem);
    run_layer<1>(grid, lds, smf, smem);
    run_layer<2>(grid, lds, smf, smem);
    run_layer<3>(grid, lds, smf, smem);
    phase_final();
}

extern "C" void kernel_launch(void* const* d_in, const int* in_sizes, int n_in, void* d_out, int out_size, void* d_ws, size_t ws_size, hipStream_t stream) {
    static int grid_blocks = 0;
    if (grid_blocks == 0) {
        if (n_in != 42 || ws_size < WS_END) { fprintf(stderr, "kernel_launch: unexpected n_in %d / ws_size %zu\n", n_in, ws_size); grid_blocks = -1; return; }
        int dev = 0, cus = 0, per_cu = 0;
        (void)hipGetDevice(&dev);
        (void)hipDeviceGetAttribute(&cus, hipDeviceAttributeMultiprocessorCount, dev);
        if (hipFuncSetAttribute((const void*)fwd_megakernel, hipFuncAttributeMaxDynamicSharedMemorySize, LDS_BYTES) != hipSuccess) { fprintf(stderr, "kernel_launch: hipFuncSetAttribute failed\n"); grid_blocks = -1; return; }
        if (hipOccupancyMaxActiveBlocksPerMultiprocessor(&per_cu, (const void*)fwd_megakernel, 512, LDS_BYTES) != hipSuccess || per_cu < 1) { fprintf(stderr, "kernel_launch: occupancy query says %d\n", per_cu); per_cu = 1; (void)hipGetLastError(); }
        grid_blocks = cus * 1;
    }
    if (grid_blocks < 0) return;
    if (hipMemsetAsync((unsigned char*)d_ws + OFF_BAR, 0, 16384, stream) != hipSuccess) { fprintf(stderr, "kernel_launch: memset failed\n"); return; }
    Params p{};
    for (int i = 0; i < 42; ++i) p.in[i] = (const float*)d_in[i];
    p.out = (float*)d_out; p.ws = (unsigned char*)d_ws;
    void* args[] = {&p};
    hipError_t e = hipLaunchCooperativeKernel((const void*)fwd_megakernel, dim3(grid_blocks), dim3(512), args, LDS_BYTES, stream);
    if (e != hipSuccess) fprintf(stderr, "cooperative launch failed: %s (grid %d)\n", hipGetErrorString(e), grid_blocks);
}
```

```cpp
#include <hip/hip_runtime.h>
#include <hip/hip_cooperative_groups.h>
#include <cstdio>
namespace cg = cooperative_groups;

#define LAS __attribute__((address_space(3)))
typedef unsigned short bf16_t;
typedef short bf16x8 __attribute__((ext_vector_type(8)));
typedef float f32x4 __attribute__((ext_vector_type(4)));
typedef unsigned u32x4 __attribute__((ext_vector_type(4)));
typedef unsigned u32x2 __attribute__((ext_vector_type(2)));

constexpr int T_TOK = 16896, SEQA = 8448, NCTX = 256;
constexpr int NLAYER = 4;
constexpr int LDS_BYTES = 143360;
constexpr size_t OFF_X = 0;
constexpr size_t OFF_H = 69206016;
constexpr size_t OFF_Z = 103809024;
constexpr size_t OFF_ZRW = OFF_Z + 69206016;
constexpr size_t OFF_MLG = 242221056;
constexpr size_t OFF_W = 243302400;
constexpr size_t OFF_YA = 281837568;
constexpr size_t OFF_YB = 299139072;
constexpr size_t OFF_YC = 316440576;
constexpr size_t OFF_F1 = 333742080;
constexpr size_t OFF_MOD = 402948096;
constexpr size_t OFF_S5P = 403243008;
constexpr size_t OFF_MLS = OFF_S5P + 4 * 589824;
constexpr size_t OFF_R2 = OFF_MLS + 16384;
constexpr size_t OFF_BAR = OFF_R2 + 34603008;
constexpr size_t OFF_S5ST = OFF_BAR + 16384;
constexpr size_t WS_END = OFF_S5ST + 8650752;
constexpr size_t OFF_CLOC = OFF_F1;
constexpr size_t OFF_U0 = OFF_ZRW + 17301504;
constexpr size_t OFF_QKC = OFF_F1 + 43524096;
constexpr size_t OFF_ZG = OFF_ZRW + 34603008;
constexpr size_t OFF_LORAIN = OFF_R2 + 17301504;
constexpr size_t W_MIX = 0, W_GATE = 8388608, W_GLU = 14680064, W_LORA = 15204352, W_PA = 16515072, W_PB = 17563648, W_PC = 18612224, W_OUT = 19660800, W_1 = 21757952, W_2 = 30146560;

struct Params {
    const float* in[42];
    float* out;
    unsigned char* ws;
};

typedef const __attribute__((address_space(4))) Params CParams;
__device__ __forceinline__ CParams& KPL() {
    unsigned long long a = (unsigned long long)__builtin_amdgcn_kernarg_segment_ptr();
    asm volatile("" : "+s"(a));
    return *(CParams*)a;
}
struct Ctx { int tid, bid, nb; };
__device__ __forceinline__ Ctx mkctx() { Ctx c; c.tid = threadIdx.x; c.bid = blockIdx.x; c.nb = gridDim.x; asm volatile("" : "+v"(c.tid), "+s"(c.bid), "+s"(c.nb)); return c; }
__device__ __forceinline__ float bf2f(unsigned v) { return __uint_as_float(v << 16); }
__device__ __forceinline__ float bflo(unsigned w) { return __uint_as_float(w << 16); }
__device__ __forceinline__ float bfhi(unsigned w) { return __uint_as_float(w & 0xffff0000u); }
__device__ __forceinline__ bf16_t f2bf(float f) { unsigned u = __float_as_uint(f); u += 0x7FFFu + ((u >> 16) & 1u); return (bf16_t)(u >> 16); }
__device__ __forceinline__ unsigned pk2(float lo, float hi) { return (unsigned)f2bf(lo) | ((unsigned)f2bf(hi) << 16); }
__device__ __forceinline__ void store4bf(bf16_t* p, f32x4 v) { u32x2 r; r.x = pk2(v[0], v[1]); r.y = pk2(v[2], v[3]); *(u32x2*)p = r; }
__device__ __forceinline__ float sigmoidf_(float x) { return 1.f / (1.f + __expf(-x)); }

#define DPP_F(x, ctrl, rmask) __int_as_float(__builtin_amdgcn_update_dpp(0, __float_as_int(x), ctrl, rmask, 0xF, false))
__device__ __forceinline__ float row8_sum(float x) {
    x += DPP_F(x, 0xB1, 0xF); x += DPP_F(x, 0x4E, 0xF); x += DPP_F(x, 0x141, 0xF); return x;
}
__device__ __forceinline__ float row16_sum(float x) {
    x += DPP_F(x, 0xB1, 0xF); x += DPP_F(x, 0x4E, 0xF); x += DPP_F(x, 0x141, 0xF); x += DPP_F(x, 0x140, 0xF); return x;
}
__device__ __forceinline__ float wave_sum(float x) {
    x = row16_sum(x);
    x += DPP_F(x, 0x142, 0xA);
    x += DPP_F(x, 0x143, 0xC);
    return __int_as_float(__builtin_amdgcn_readlane(__float_as_int(x), 63));
}

namespace pg8 {
constexpr int BM = 256, BK = 64, HALF = 128, HTB = HALF * BK * 2, NXCD = 8, WGM = 8;
__device__ __forceinline__ int lds_byte(int r, int c) { const int st = (r >> 4) * 2 + (c >> 5), rr = r & 15, cc = c & 31, ob = rr * 64 + cc * 2; return st * 1024 + (ob ^ (((ob >> 9) & 1) << 5)); }
__device__ __forceinline__ void stage_rc(int b, int& R, int& C) { const int st = b / 1024, sb = b % 1024, swz = sb ^ (((sb >> 9) & 1) << 5); R = (st >> 1) * 16 + swz / 64; C = (st & 1) * 32 + (swz % 64) / 2; }
__device__ __forceinline__ int perm32(int rho) { const int n = rho >> 4, i = rho & 15; return 8 * (i >> 2) + 4 * n + (i & 3); }
struct Unit { int pm, pn; };
struct Gemm { const bf16_t* A; const bf16_t* Bt; int M, N, K; };
struct StaticOrder {
    int nM, nN, nwg, G, c, skipctx;
    __device__ void init(int M, int N, int G_, int c_, int skip_ = 0) { nM = M / BM - 2 * skip_; nN = N / BM; nwg = nM * nN; G = G_; c = c_; skipctx = skip_; }
    __device__ bool next(int i, Unit& u) const {
        const long L = (long)i * G + c; if (L >= nwg) return false;
        int wgid = (int)L; { const int q = nwg / NXCD, r = nwg % NXCD, xcd = wgid % NXCD, off = wgid / NXCD; wgid = (xcd < r ? xcd * (q + 1) : r * (q + 1) + (xcd - r) * q) + off; }
        const int nig = WGM * nN, gid = wgid / nig, fm = gid * WGM, gsz = (nM - fm) < WGM ? (nM - fm) : WGM;
        u.pm = fm + ((wgid % nig) % gsz); u.pn = (wgid % nig) / gsz;
        if (skipctx) u.pm += (u.pm >= 32) ? 2 : 1;
        return true;
    }
};

template <class Epi>
__device__ __forceinline__ void gemm_phase(int tid_in, LAS unsigned char* lds, const Gemm g, const StaticOrder& S, const Epi& E) {
    const int tid = tid_in, wid = __builtin_amdgcn_readfirstlane(tid >> 6), lane = tid & 63, wr = wid >> 2, wc = wid & 3, fr = lane & 15, fq = lane >> 4;
    const int K = g.K, nt = K / BK;
    unsigned voffA[2], voffB[2];
#pragma unroll
    for (int i = 0; i < 2; ++i) { int R, C; stage_rc(tid * 16 + i * 8192, R, C); const int Rb = Epi::PERM ? ((R & ~31) + perm32(R & 31)) : R;
        voffA[i] = (unsigned)(R * K + C) * 2u; voffB[i] = (unsigned)(Rb * K + C) * 2u; }
    const size_t kstep = (size_t)(BK * 2);
    const size_t hstep = (size_t)HALF * K * 2;
    const size_t tstep = 2 * hstep;
    const unsigned ldsw = (unsigned)wid * 1024u;
    const int aoff = lds_byte(wr * 64 + fr, fq * 8), boff = lds_byte(wc * 32 + fr, fq * 8);
#define PG8_SA(b, h) (((b) * 2 + (h)) * HTB)
#define PG8_SB(b, h) ((4 + (b) * 2 + (h)) * HTB)
#define PG8_STAGE(bufoff, gbase, voff) do { _Pragma("unroll") for (int _i = 0; _i < 2; ++_i) \
        __builtin_amdgcn_global_load_lds((const unsigned*)((const char*)(gbase) + (voff)[_i]), (LAS unsigned*)(lds + (bufoff) + ldsw + _i * 8192), 16, 0, 0); } while (0)
#define PG8_LDA(dst, b, h) do { _Pragma("unroll") for (int m = 0; m < 4; ++m) _Pragma("unroll") for (int k = 0; k < 2; ++k) dst[m][k] = *(const LAS bf16x8*)(lds + PG8_SA(b, h) + aoff + m * 2048 + k * 1024); } while (0)
#define PG8_LDB(dst, b, h) do { _Pragma("unroll") for (int n = 0; n < 2; ++n) _Pragma("unroll") for (int k = 0; k < 2; ++k) dst[n][k] = *(const LAS bf16x8*)(lds + PG8_SB(b, h) + boff + n * 2048 + k * 1024); } while (0)
#define PG8_MMA(ai, bj, At, Bt) do { __builtin_amdgcn_s_setprio(1); _Pragma("unroll") for (int m = 0; m < 4; ++m) _Pragma("unroll") for (int n = 0; n < 2; ++n) _Pragma("unroll") for (int k = 0; k < 2; ++k) \
        acc[ai][bj][m][n] = __builtin_amdgcn_mfma_f32_16x16x32_bf16(Bt[n][k], At[m][k], acc[ai][bj][m][n], 0, 0, 0); __builtin_amdgcn_s_setprio(0); } while (0)
#define PG8_WAIT_V(n) asm volatile("s_waitcnt vmcnt(" #n ")" ::: "memory")
#define PG8_WAIT_L(n) asm volatile("s_waitcnt lgkmcnt(" #n ")" ::: "memory")
#define PG8_BAR __builtin_amdgcn_s_barrier()
#define PG8_SCHED __builtin_amdgcn_sched_barrier(0)
    Unit cur, nxt; int ui = 0;
    if (!S.next(0, cur)) return;
    f32x4 acc[2][2][4][2];
#pragma unroll
    for (int a = 0; a < 2; ++a)
#pragma unroll
        for (int b = 0; b < 2; ++b)
#pragma unroll
            for (int m = 0; m < 4; ++m)
#pragma unroll
                for (int n = 0; n < 2; ++n) acc[a][b][m][n] = (f32x4){0.f, 0.f, 0.f, 0.f};
    bf16x8 At[4][2], B0[2][2], B1[2][2];
    const char* cA = (const char*)g.A + (size_t)cur.pm * tstep; const char* cB = (const char*)g.Bt + (size_t)cur.pn * tstep;
    PG8_STAGE(PG8_SB(0, 0), cB, voffB); PG8_STAGE(PG8_SA(0, 0), cA, voffA); PG8_STAGE(PG8_SB(0, 1), cB + hstep, voffB); PG8_STAGE(PG8_SA(0, 1), cA + hstep, voffA);
    if (wr == 1) PG8_BAR;
    PG8_WAIT_V(4); PG8_BAR;
    PG8_STAGE(PG8_SB(1, 0), cB + kstep, voffB); PG8_STAGE(PG8_SA(1, 0), cA + kstep, voffA); PG8_STAGE(PG8_SB(1, 1), cB + hstep + kstep, voffB);
    PG8_WAIT_V(6); PG8_BAR;
    for (;;) {
        const bool has_next = S.next(ui + 1, nxt);
        const char* nA = has_next ? (const char*)g.A + (size_t)nxt.pm * tstep : cA; const char* nB = has_next ? (const char*)g.Bt + (size_t)nxt.pn * tstep : cB;
        for (int t = 0; t < nt; t += 2) {
            const bool last = (t == nt - 2);
            const char* a1 = cA + (size_t)(t + 1) * kstep;
            const char* a2 = last ? nA : cA + (size_t)(t + 2) * kstep; const char* b2 = last ? nB : cB + (size_t)(t + 2) * kstep;
            const char* a3 = a2 + kstep; const char* b3 = b2 + kstep;
            PG8_LDB(B0, 0, 0); PG8_SCHED; PG8_LDA(At, 0, 0); PG8_STAGE(PG8_SA(1, 1), a1 + hstep, voffA);
            PG8_WAIT_L(8); PG8_BAR; PG8_WAIT_L(0); PG8_MMA(0, 0, At, B0); PG8_BAR; PG8_SCHED;
            PG8_LDB(B1, 0, 1); PG8_STAGE(PG8_SB(0, 0), b2, voffB);
            PG8_BAR; PG8_WAIT_L(0); PG8_MMA(0, 1, At, B1); PG8_BAR;
            PG8_LDA(At, 0, 1); PG8_STAGE(PG8_SA(0, 0), a2, voffA);
            PG8_BAR; PG8_WAIT_L(0); PG8_MMA(1, 0, At, B0); PG8_BAR; PG8_SCHED;
            PG8_STAGE(PG8_SB(0, 1), b2 + hstep, voffB);
            PG8_WAIT_V(6); PG8_BAR; PG8_MMA(1, 1, At, B1); PG8_BAR;
            PG8_LDB(B0, 1, 0); PG8_SCHED; PG8_LDA(At, 1, 0); PG8_STAGE(PG8_SA(0, 1), a2 + hstep, voffA);
            PG8_WAIT_L(8); PG8_BAR; PG8_WAIT_L(0); PG8_MMA(0, 0, At, B0); PG8_BAR; PG8_SCHED;
            PG8_LDB(B1, 1, 1); PG8_STAGE(PG8_SB(1, 0), b3, voffB);
            PG8_BAR; PG8_WAIT_L(0); PG8_MMA(0, 1, At, B1); PG8_BAR;
            PG8_LDA(At, 1, 1); PG8_STAGE(PG8_SA(1, 0), a3, voffA);
            PG8_BAR; PG8_WAIT_L(0); PG8_MMA(1, 0, At, B0); PG8_BAR; PG8_SCHED;
            PG8_STAGE(PG8_SB(1, 1), b3 + hstep, voffB);
            PG8_WAIT_V(6); PG8_BAR; PG8_MMA(1, 1, At, B1); PG8_BAR;
        }
        E(acc, cur, wr, wc, fr, fq);
        if (!has_next) break;
#pragma unroll
        for (int a = 0; a < 2; ++a)
#pragma unroll
            for (int b = 0; b < 2; ++b)
#pragma unroll
                for (int m = 0; m < 4; ++m)
#pragma unroll
                    for (int n = 0; n < 2; ++n) acc[a][b][m][n] = (f32x4){0.f, 0.f, 0.f, 0.f};
        cur = nxt; cA = nA; cB = nB; ++ui;
    }
    PG8_WAIT_V(0);
    if (wr == 0) PG8_BAR;
    PG8_BAR;
#undef PG8_SA
#undef PG8_SB
#undef PG8_STAGE
#undef PG8_LDA
#undef PG8_LDB
#undef PG8_MMA
#undef PG8_WAIT_V
#undef PG8_WAIT_L
#undef PG8_BAR
#undef PG8_SCHED
}

template <class F> struct EpiT {
    static constexpr bool PERM = false;
    F f;
    __device__ __forceinline__ void operator()(const f32x4 (&acc)[2][2][4][2], const Unit& u, int wr, int wc, int fr, int fq) const {
        const int row0 = u.pm * BM + wr * 64 + fr, col0 = u.pn * BM + wc * 32 + 4 * fq;
#pragma unroll
        for (int ai = 0; ai < 2; ++ai)
#pragma unroll
            for (int m = 0; m < 4; ++m) {
                const int row = row0 + ai * HALF + m * 16;
#pragma unroll
                for (int bj = 0; bj < 2; ++bj)
#pragma unroll
                    for (int n = 0; n < 2; ++n) f(row, col0 + bj * HALF + n * 16, acc[ai][bj][m][n]);
            }
    }
};
template <class F> struct EpiT8 {
    static constexpr bool PERM = true;
    F f;
    __device__ __forceinline__ void operator()(const f32x4 (&acc)[2][2][4][2], const Unit& u, int wr, int wc, int fr, int fq) const {
        const int row0 = u.pm * BM + wr * 64 + fr, col0 = u.pn * BM + wc * 32 + 8 * fq;
#pragma unroll
        for (int ai = 0; ai < 2; ++ai)
#pragma unroll
            for (int m = 0; m < 4; ++m) {
                const int row = row0 + ai * HALF + m * 16;
#pragma unroll
                for (int bj = 0; bj < 2; ++bj) f(row, col0 + bj * HALF, acc[ai][bj][m][0], acc[ai][bj][m][1]);
            }
    }
};
}

template <class F>
__device__ __forceinline__ void run_gemm(const Ctx& cx, LAS unsigned char* lds, const bf16_t* A, const bf16_t* Bt, int N, int K, const F& f, int skip = 0) {
    pg8::Gemm g; g.A = A; g.Bt = Bt; g.M = T_TOK; g.N = N; g.K = K;
    pg8::StaticOrder S; S.init(T_TOK, N, cx.nb, cx.bid, skip);
    pg8::EpiT<F> E{f};
    pg8::gemm_phase(cx.tid, lds, g, S, E);
}

template <class F>
__device__ __forceinline__ void run_gemm8(const Ctx& cx, LAS unsigned char* lds, const bf16_t* A, const bf16_t* Bt, int N, int K, const F& f, int skip = 0) {
    pg8::Gemm g; g.A = A; g.Bt = Bt; g.M = T_TOK; g.N = N; g.K = K;
    pg8::StaticOrder S; S.init(T_TOK, N, cx.nb, cx.bid, skip);
    pg8::EpiT8<F> E{f};
    pg8::gemm_phase(cx.tid, lds, g, S, E);
}

template <class E>
__device__ __forceinline__ void run_gemm_epi(const Ctx& cx, LAS unsigned char* lds, const bf16_t* A, const bf16_t* Bt, int N, int K, const E& e) {
    pg8::Gemm g; g.A = A; g.Bt = Bt; g.M = T_TOK; g.N = N; g.K = K;
    pg8::StaticOrder S; S.init(T_TOK, N, cx.nb, cx.bid);
    pg8::gemm_phase(cx.tid, lds, g, S, e);
}
__device__ __forceinline__ int row_vec(int row) { const int b = row >= SEQA ? 1 : 0; const int t = row - b * SEQA; return t < NCTX ? 2 : b; }

struct FInproj { bf16_t* za; float* mlg; bf16_t* zrw;
    __device__ __forceinline__ void operator()(int row, int col, f32x4 v) const {
        if (col < 2048) store4bf(za + (size_t)row * 2048 + col, v);
        else if (col < 2064) *(f32x4*)(mlg + (size_t)row * 16 + (col - 2048)) = v;
        else if (col < 3856) store4bf(zrw + (size_t)row * 1792 + (col - 2064), v);
    } };
__device__ __forceinline__ void store8bf(bf16_t* p, f32x4 a, f32x4 b) { u32x4 r; r.x = pk2(a[0], a[1]); r.y = pk2(a[2], a[3]); r.z = pk2(b[0], b[1]); r.w = pk2(b[2], b[3]); *(u32x4*)p = r; }
struct FInproj8 { bf16_t* za; float* mlg; bf16_t* zrw;
    __device__ __forceinline__ void operator()(int row, int col, f32x4 a, f32x4 b) const {
        if (col < 2048) store8bf(za + (size_t)row * 2048 + col, a, b);
        else if (col < 2064) { *(f32x4*)(mlg + (size_t)row * 16 + (col - 2048)) = a; *(f32x4*)(mlg + (size_t)row * 16 + (col - 2048) + 4) = b; }
        else if (col < 3856) store8bf(zrw + (size_t)row * 1792 + (col - 2064), a, b);
    } };
struct FGate8 { bf16_t* g;
    __device__ __forceinline__ void operator()(int row, int col, f32x4 a, f32x4 b) const {
#pragma unroll
        for (int e = 0; e < 4; ++e) { a[e] = sigmoidf_(a[e]); b[e] = sigmoidf_(b[e]); }
        store8bf(g + (size_t)row * 3072 + col, a, b);
    } };
struct FMlp18 { bf16_t* hid;
    __device__ __forceinline__ void operator()(int row, int col, f32x4 a, f32x4 b) const {
#pragma unroll
        for (int e = 0; e < 4; ++e) { const float r0 = fmaxf(a[e], 0.f), r1 = fmaxf(b[e], 0.f); a[e] = r0 * r0; b[e] = r1 * r1; }
        store8bf(hid + (size_t)row * 4096 + col, a, b);
    } };
template <int J> struct FMerge8 { const bf16_t* g; bf16_t* ybf;
    __device__ __forceinline__ void operator()(int row, int col, f32x4 a, f32x4 b) const {
        const u32x4 z = *(const u32x4*)(g + (size_t)row * 3072 + J * 1024 + col);
        a[0] *= bflo(z.x); a[1] *= bfhi(z.x); a[2] *= bflo(z.y); a[3] *= bfhi(z.y); b[0] *= bflo(z.z); b[1] *= bfhi(z.z); b[2] *= bflo(z.w); b[3] *= bfhi(z.w);
        bf16_t* yp = ybf + (size_t)row * 1024 + col;
        if (J != 0) { const u32x4 t = *(const u32x4*)yp;
            a[0] += bflo(t.x); a[1] += bfhi(t.x); a[2] += bflo(t.y); a[3] += bfhi(t.y); b[0] += bflo(t.z); b[1] += bfhi(t.z); b[2] += bflo(t.w); b[3] += bfhi(t.w); }
        store8bf(yp, a, b);
    } };
struct FGlu8 { const bf16_t* zg; const float* bglu; bf16_t* ya;
    __device__ __forceinline__ void operator()(int row, int col, f32x4 a, f32x4 b) const {
        const u32x4 z = *(const u32x4*)(zg + (size_t)row * 512 + col); const f32x4 b0 = *(const f32x4*)(bglu + col), b1 = *(const f32x4*)(bglu + col + 4);
        f32x4 oa, ob;
        oa[0] = bflo(z.x) * sigmoidf_(a[0] + b0[0]); oa[1] = bfhi(z.x) * sigmoidf_(a[1] + b0[1]); oa[2] = bflo(z.y) * sigmoidf_(a[2] + b0[2]); oa[3] = bfhi(z.y) * sigmoidf_(a[3] + b0[3]);
        ob[0] = bflo(z.z) * sigmoidf_(b[0] + b1[0]); ob[1] = bfhi(z.z) * sigmoidf_(b[1] + b1[1]); ob[2] = bflo(z.w) * sigmoidf_(b[2] + b1[2]); ob[3] = bfhi(z.w) * sigmoidf_(b[3] + b1[3]);
        store8bf(ya + (size_t)row * 512 + col, oa, ob);
    } };
struct FGlu { const bf16_t* zg; const float* bglu; bf16_t* ya;
    __device__ __forceinline__ void operator()(int row, int col, f32x4 v) const {
        const u32x2 z = *(const u32x2*)(zg + (size_t)row * 512 + col); const f32x4 b = *(const f32x4*)(bglu + col);
        f32x4 o; o[0] = bflo(z.x) * sigmoidf_(v[0] + b[0]); o[1] = bfhi(z.x) * sigmoidf_(v[1] + b[1]); o[2] = bflo(z.y) * sigmoidf_(v[2] + b[2]); o[3] = bfhi(z.y) * sigmoidf_(v[3] + b[3]);
        store4bf(ya + (size_t)row * 512 + col, o);
    } };
struct EpiLora { static constexpr bool PERM = false; const float* w0; const float* a0; bf16_t* f2; bf16_t* grw; bf16_t* u0;
    __device__ __forceinline__ void operator()(const f32x4 (&acc)[2][2][4][2], const pg8::Unit& u, int wr, int wc, int fr, int fq) const {
        const int row0 = u.pm * 256 + wr * 64 + fr, col0 = u.pn * 256 + wc * 32 + 4 * fq;
        const int pn = __builtin_amdgcn_readfirstlane(u.pn);
        if (pn < 8) {
            const float* bias = pn < 4 ? w0 : a0 - 1024;
#pragma unroll
            for (int bj = 0; bj < 2; ++bj)
#pragma unroll
                for (int n = 0; n < 2; ++n) {
                    const int col = col0 + bj * 128 + n * 16;
                    const f32x4 b = *(const f32x4*)(bias + col);
#pragma unroll
                    for (int ai = 0; ai < 2; ++ai)
#pragma unroll
                        for (int m = 0; m < 4; ++m) {
                            const int row = row0 + ai * 128 + m * 16; f32x4 o;
#pragma unroll
                            for (int e = 0; e < 4; ++e) { const float s = sigmoidf_(acc[ai][bj][m][n][e] + b[e]); o[e] = pn < 4 ? 1.f - __expf(-0.60653065971f * s) : s; }
                            if (pn < 2) store4bf(u0 + (size_t)row * 512 + col, o); else store4bf(f2 + (size_t)row * 2048 + col, o);
                        }
                }
        } else {
#pragma unroll
            for (int ai = 0; ai < 2; ++ai)
#pragma unroll
                for (int m = 0; m < 4; ++m) { const int row = row0 + ai * 128 + m * 16;
#pragma unroll
                    for (int bj = 0; bj < 2; ++bj)
#pragma unroll
                        for (int n = 0; n < 2; ++n) store4bf(grw + (size_t)row * 512 + (col0 + bj * 128 + n * 16 - 2048), acc[ai][bj][m][n]); }
        }
    } };
struct FGate { bf16_t* g;
    __device__ __forceinline__ void operator()(int row, int col, f32x4 v) const {
        f32x4 o; o[0] = sigmoidf_(v[0]); o[1] = sigmoidf_(v[1]); o[2] = sigmoidf_(v[2]); o[3] = sigmoidf_(v[3]);
        store4bf(g + (size_t)row * 3072 + col, o);
    } };
template <int J> struct FMerge { const bf16_t* g; float* y32; bf16_t* ybf;
    __device__ __forceinline__ void operator()(int row, int col, f32x4 v) const {
        const u32x2 z = *(const u32x2*)(g + (size_t)row * 3072 + J * 1024 + col);
        f32x4 o; o[0] = bflo(z.x) * v[0]; o[1] = bfhi(z.x) * v[1]; o[2] = bflo(z.y) * v[2]; o[3] = bfhi(z.y) * v[3];
        bf16_t* yp = ybf + (size_t)row * 1024 + col;
        if (J != 0) { const u32x2 t = *(const u32x2*)yp; o[0] += bflo(t.x); o[1] += bfhi(t.x); o[2] += bflo(t.y); o[3] += bfhi(t.y); }
        store4bf(yp, o);
    } };
struct FResid { float* x; const float* modl; int chunk;
    __device__ __forceinline__ void operator()(int row, int col, f32x4 v) const {
        const f32x4 mg = *(const f32x4*)(modl + row_vec(row) * 6144 + chunk * 1024 + col);
        float* xp = x + (size_t)row * 1024 + col; f32x4 t = *(f32x4*)xp; *(f32x4*)xp = t + mg * v;
    } };
struct FMlp1 { bf16_t* hid;
    __device__ __forceinline__ void operator()(int row, int col, f32x4 v) const {
        f32x4 o;
#pragma unroll
        for (int e = 0; e < 4; ++e) { const float r = fmaxf(v[e], 0.f); o[e] = r * r; }
        store4bf(hid + (size_t)row * 4096 + col, o);
    } };

__device__ __forceinline__ void phase_mod(float* smf) {
    CParams& p = KPL(); const Ctx cx = mkctx();
    const int tid = cx.tid, lane = tid & 63, wid = tid >> 6;
    float* sc = smf; float* red = smf + 3072;
    float* MOD = (float*)(p.ws + OFF_MOD);
    for (int i = tid; i < 3072; i += 512) { const int v = i >> 10, j = i & 1023; const float c = v < 2 ? p.in[1][v * 1024 + j] : p.in[3][j]; sc[i] = c / (1.f + expf(-c)); }
    __syncthreads();
    for (int item = cx.bid; item < 4 * 96; item += cx.nb) {
        const int l = item / 96, jt = item % 96, j = jt * 64 + lane;
        const float* w = p.in[4] + (size_t)l * 1024 * 6144 + j;
        float a0 = 0.f, a1 = 0.f, a2 = 0.f;
#pragma unroll 16
        for (int i = wid * 128; i < wid * 128 + 128; ++i) { const float wv = w[(size_t)i * 6144]; a0 += sc[i] * wv; a1 += sc[1024 + i] * wv; a2 += sc[2048 + i] * wv; }
        red[(wid * 3 + 0) * 64 + lane] = a0; red[(wid * 3 + 1) * 64 + lane] = a1; red[(wid * 3 + 2) * 64 + lane] = a2;
        __syncthreads();
        if (tid < 192) { const int v = tid >> 6; float s = 0.f;
            for (int w8 = 0; w8 < 8; ++w8) s += red[(w8 * 3 + v) * 64 + lane];
            MOD[(l * 3 + v) * 6144 + j] = s + p.in[5][l * 6144 + j]; }
        __syncthreads();
    }
}

__device__ __forceinline__ void dsincos(double x, double& s, double& c) {
    const double k = rint(x * 0.63661977236758134308);
    double r = fma(-k, 1.57079632679489655800, x); r = fma(-k, 6.12323399573676603587e-17, r);
    const double r2 = r * r;
    double ps = -1.0 / 355687428096000.0;
    ps = fma(ps, r2, 1.0 / 1307674368000.0); ps = fma(ps, r2, -1.0 / 6227020800.0); ps = fma(ps, r2, 1.0 / 39916800.0); ps = fma(ps, r2, -1.0 / 362880.0);
    ps = fma(ps, r2, 1.0 / 5040.0); ps = fma(ps, r2, -1.0 / 120.0); ps = fma(ps, r2, 1.0 / 6.0); ps = fma(ps, r2, -1.0); ps = -ps * r;
    double pc = 1.0 / 20922789888000.0;
    pc = fma(pc, r2, -1.0 / 87178291200.0); pc = fma(pc, r2, 1.0 / 479001600.0); pc = fma(pc, r2, -1.0 / 3628800.0); pc = fma(pc, r2, 1.0 / 40320.0);
    pc = fma(pc, r2, -1.0 / 720.0); pc = fma(pc, r2, 1.0 / 24.0); pc = fma(pc, r2, -0.5); pc = fma(pc, r2, 1.0);
    const int q = ((int)k) & 3;
    s = (q == 0) ? ps : (q == 1) ? pc : (q == 2) ? -ps : -pc;
    c = (q == 0) ? pc : (q == 1) ? -ps : (q == 2) ? -pc : ps;
}
__device__ __forceinline__ double dexp_neg(double x) {
    const double k = rint(x * 1.44269504088896338700);
    double r = fma(-k, 0.693147180369123816490, x); r = fma(-k, 1.90821492927058770002e-10, r);
    double pe = 1.0 / 6227020800.0;
    pe = fma(pe, r, 1.0 / 479001600.0); pe = fma(pe, r, 1.0 / 39916800.0); pe = fma(pe, r, 1.0 / 3628800.0); pe = fma(pe, r, 1.0 / 362880.0); pe = fma(pe, r, 1.0 / 40320.0);
    pe = fma(pe, r, 1.0 / 5040.0); pe = fma(pe, r, 1.0 / 720.0); pe = fma(pe, r, 1.0 / 120.0); pe = fma(pe, r, 1.0 / 24.0); pe = fma(pe, r, 1.0 / 6.0); pe = fma(pe, r, 0.5);
    pe = fma(pe, r, 1.0); pe = fma(pe, r, 1.0);
    int ki = (int)k; if (ki < -1000) return 0.0;
    return pe * __longlong_as_double((long long)(1023 + ki) << 52);
}

__device__ __forceinline__ void wconv_tile(const Ctx& cx, const float* src, int ld, int K, int c0, int ncols, bf16_t* dst, int kt, int nt, float* tile) {
    const int tid = cx.tid, j = tid & 63, i0 = tid >> 6;
#pragma unroll
    for (int e = 0; e < 8; ++e) { const int i = i0 + 8 * e; const int n = nt * 64 + j;
        tile[i * 65 + j] = (n < ncols) ? src[(size_t)(kt * 64 + i) * ld + c0 + n] : 0.f; }
    __syncthreads();
#pragma unroll
    for (int e = 0; e < 8; ++e) { const int jj = i0 + 8 * e;
        dst[(size_t)(nt * 64 + jj) * K + kt * 64 + j] = f2bf(tile[j * 65 + jj]); }
    __syncthreads();
}

template <int MODE>
__device__ __forceinline__ void phase_wconv(int l, float* smf) {
    CParams& p = KPL(); const Ctx cx = mkctx();
    bf16_t* W = (bf16_t*)(p.ws + OFF_W);
    const int tid = cx.tid;
    unsigned* ticket = (unsigned*)(p.ws + OFF_BAR) + 3520 + l * 16;
    int* tslot = (int*)smf + 8192;
    for (int it = (MODE == 2 ? 0 : cx.bid); ; it += cx.nb) {
        int item;
        if (MODE == 0) { item = it; if (item >= 5184) break; }
        else if (MODE == 1) { item = 3520 + it; if (item >= 4544) break; }
        else {
            if (tid == 0) *tslot = (int)__hip_atomic_fetch_add(ticket, 1u, __ATOMIC_RELAXED, __HIP_MEMORY_SCOPE_AGENT);
            __syncthreads();
            const int q = *tslot;
            __syncthreads();
            if (q >= 4160) break;
            item = q < 3520 ? q : q + 1024;
        }
        if (item < 4544) {
            const float* src; int ld, K, c0, ncols, nN; bf16_t* dst; int t = item;
            if (t < 1024) { src = p.in[8] + (size_t)l * 1024 * 6928; ld = 6928; K = 1024; c0 = 0; ncols = 3856; nN = 64; dst = W + W_MIX / 2; }
            else if (t < 1792) { t -= 1024; src = p.in[8] + (size_t)l * 1024 * 6928; ld = 6928; K = 1024; c0 = 3856; ncols = 3072; nN = 48; dst = W + W_GATE / 2; }
            else if (t < 1856) { t -= 1792; src = p.in[17] + (size_t)l * 512 * 512; ld = 512; K = 512; c0 = 0; ncols = 512; nN = 8; dst = W + W_GLU / 2; }
            else if (t < 1984) { t -= 1856; src = p.in[35] + (size_t)l * 512 * 1024; ld = 1024; K = 512; c0 = 0; ncols = 1024; nN = 16; dst = W + W_PA / 2; }
            else if (t < 2112) { t -= 1984; src = p.in[36] + (size_t)l * 512 * 1024; ld = 1024; K = 512; c0 = 0; ncols = 1024; nN = 16; dst = W + W_PB / 2; }
            else if (t < 2240) { t -= 2112; src = p.in[37] + (size_t)l * 512 * 1024; ld = 1024; K = 512; c0 = 0; ncols = 1024; nN = 16; dst = W + W_PC / 2; }
            else if (t < 2496) { t -= 2240; src = p.in[38] + (size_t)l * 1024 * 1024; ld = 1024; K = 1024; c0 = 0; ncols = 1024; nN = 16; dst = W + W_OUT / 2; }
            else if (t < 3520) { t -= 2496; src = p.in[39] + (size_t)l * 1024 * 4096; ld = 4096; K = 1024; c0 = 0; ncols = 4096; nN = 64; dst = W + W_1 / 2; }
            else { t -= 3520; src = p.in[40] + (size_t)l * 4096 * 1024; ld = 1024; K = 4096; c0 = 0; ncols = 1024; nN = 16; dst = W + W_2 / 2; }
            const int nt = t % nN, kt = t / nN;
            wconv_tile(cx, src, ld, K, c0, ncols, dst, kt, nt, smf);
        } else {
            bf16_t* dst = W + W_LORA / 2;
#pragma unroll
            for (int q = 0; q < 2; ++q) {
                const int e = (item - 4544) * 1024 + q * 512 + tid; const int n = e >> 8, k = e & 255;
                float v = 0.f;
                if (n < 1024) { if (k < 64) v = p.in[26][(((size_t)l * 2 + (n >> 9)) * 64 + k) * 512 + (n & 511)]; }
                else if (n < 2048) { if (k >= 64 && k < 128) v = p.in[28][(((size_t)l * 2 + ((n - 1024) >> 9)) * 64 + (k - 64)) * 512 + (n & 511)]; }
                else { if (k >= 128) v = p.in[29][((size_t)l * 128 + (k - 128)) * 512 + (n - 2048)]; }
                dst[e] = f2bf(v);
            }
        }
    }
}

__device__ __forceinline__ void phase_s5_params() {
    CParams& p = KPL(); const Ctx cx = mkctx();
    for (int item = cx.bid; item < 32; item += cx.nb) {
        const int l = item >> 3;
        const int idx = (item & 7) * 512 + cx.tid;
        const int dir = idx >> 11, g = (idx >> 6) & 31;
        float* S5P = (float*)(p.ws + OFF_S5P) + (size_t)l * 147456;
        const size_t pi = (size_t)l * 4096 + idx;
        const double lre = fmin((double)p.in[9][pi], -1e-4), lim = (double)p.in[10][pi];
        const double dt = dexp_neg((double)p.in[11][(l * 2 + dir) * 32 + g]);
        const double mag = dexp_neg(lre * dt); double sn, cs; dsincos(lim * dt, sn, cs);
        const double ar = mag * cs, ai = mag * sn;
        const double den = lre * lre + lim * lim, nr = ar - 1.0;
        const double cr = (nr * lre + ai * lim) / den, ci = (ai * lre - nr * lim) / den;
        const double mag64 = dexp_neg(64.0 * lre * dt); dsincos(64.0 * lim * dt, sn, cs);
        S5P[idx] = (float)ar; S5P[4096 + idx] = (float)ai; S5P[8192 + idx] = (float)(mag64 * cs); S5P[12288 + idx] = (float)(mag64 * sn);
        float* BR = S5P + 16384; float* BI = BR + 65536;
        for (int c = 0; c < 16; ++c) { const double bre = p.in[12][pi * 16 + c], bim = p.in[13][pi * 16 + c];
            BR[(size_t)idx * 16 + c] = (float)(cr * bre - ci * bim); BI[(size_t)idx * 16 + c] = (float)(cr * bim + ci * bre); }
    }
}

__device__ __forceinline__ void phase_norm(int l, int which, bool init) {
    CParams& p = KPL(); const Ctx cx = mkctx();
    const int lane = cx.tid & 63, gw = cx.bid * 8 + (cx.tid >> 6), nw = cx.nb * 8;
    float* X = (float*)(p.ws + OFF_X); bf16_t* H = (bf16_t*)(p.ws + OFF_H);
    const float* MODL = (const float*)(p.ws + OFF_MOD) + (size_t)l * 3 * 6144;
    const float* gam = p.in[which ? 7 : 6] + l * 1024;
    for (int row = gw; row < T_TOK; row += nw) {
        const int b = row >= SEQA ? 1 : 0, t = row - b * SEQA;
        const float* src = init ? (t < NCTX ? p.in[2] + ((size_t)b * NCTX + t) * 1024 : p.in[0] + ((size_t)b * 8192 + (t - NCTX)) * 1024) : X + (size_t)row * 1024;
        f32x4 v[4]; float ss = 0.f;
#pragma unroll
        for (int i = 0; i < 4; ++i) { v[i] = *(const f32x4*)(src + (lane + 64 * i) * 4); ss += v[i][0] * v[i][0] + v[i][1] * v[i][1] + v[i][2] * v[i][2] + v[i][3] * v[i][3]; }
        if (init) {
#pragma unroll
            for (int i = 0; i < 4; ++i) *(f32x4*)(X + (size_t)row * 1024 + (lane + 64 * i) * 4) = v[i];
        }
        ss = wave_sum(ss);
        const float inv = rsqrtf(ss * (1.f / 1024.f) + 1e-6f);
        const float* mv = MODL + (t < NCTX ? 2 : b) * 6144 + (which ? 3 : 0) * 1024;
#pragma unroll
        for (int i = 0; i < 4; ++i) { const int c = (lane + 64 * i) * 4;
            const f32x4 g4 = *(const f32x4*)(gam + c), sh = *(const f32x4*)(mv + c), scl = *(const f32x4*)(mv + 1024 + c);
            f32x4 o;
#pragma unroll
            for (int e = 0; e < 4; ++e) o[e] = v[i][e] * inv * g4[e] * (1.f + scl[e]) + sh[e];
            store4bf(H + (size_t)row * 1024 + c, o); }
    }
}

__device__ __forceinline__ int s5_order(int dir, int i) { return dir == 0 ? i : (i < 4 ? 3 - i : 135 - i); }

__device__ __forceinline__ void phase_s5_local(int l) {
    CParams& p = KPL(); const Ctx cx = mkctx();
    const int b0 = cx.nb >= 2 ? cx.nb / 2 : 0;
    if (cx.bid < b0) return;
    const int lane = cx.tid & 63, gw = (cx.bid - b0) * 8 + (cx.tid >> 6), nw = (cx.nb - b0) * 8;
    const bf16_t* ZA = (const bf16_t*)(p.ws + OFF_Z);
    const float* S5P = (const float*)(p.ws + OFF_S5P) + (size_t)l * 147456; const float* BR = S5P + 16384; const float* BI = BR + 65536;
    float* ST = (float*)(p.ws + OFF_S5ST);
    for (int item0 = gw; item0 < 16896; item0 += nw) {
        const int item = __builtin_amdgcn_readfirstlane(item0);
        const int chunk = item % 132, g = (item / 132) & 31, dir = (item / 4224) & 1, b = item / 8448;
        const int idx = dir * 2048 + g * 64 + lane;
        const float ar = S5P[idx], ai = S5P[4096 + idx];
        float br[16], bi[16];
#pragma unroll
        for (int q = 0; q < 4; ++q) { const f32x4 t0 = *(const f32x4*)(BR + (size_t)idx * 16 + q * 4), t1 = *(const f32x4*)(BI + (size_t)idx * 16 + q * 4);
#pragma unroll
            for (int e = 0; e < 4; ++e) { br[q * 4 + e] = t0[e]; bi[q * 4 + e] = t1[e]; } }
        const int row = b * SEQA + chunk * 64 + lane;
        const u32x4 u0 = *(const u32x4*)(ZA + (size_t)row * 2048 + g * 16), u1 = *(const u32x4*)(ZA + (size_t)row * 2048 + g * 16 + 8);
        unsigned ur[8] = {u0.x, u0.y, u0.z, u0.w, u1.x, u1.y, u1.z, u1.w};
        float hr = 0.f, hi = 0.f;
#pragma unroll 8
        for (int j = 0; j < 64; ++j) {
            const int tok = dir ? 63 - j : j;
            float bur = 0.f, bui = 0.f;
#pragma unroll
            for (int q = 0; q < 8; ++q) { const unsigned w = (unsigned)__builtin_amdgcn_readlane((int)ur[q], tok); const float x0 = bflo(w), x1 = bfhi(w);
                bur += br[2 * q] * x0 + br[2 * q + 1] * x1; bui += bi[2 * q] * x0 + bi[2 * q + 1] * x1; }
            const float nr = ar * hr - ai * hi + bur, ni = ar * hi + ai * hr + bui; hr = nr; hi = ni;
        }
        float* st = ST + ((((size_t)b * 2 + dir) * 32 + g) * 132 + chunk) * 128;
        st[lane] = hr; st[64 + lane] = hi;
    }
}

__device__ __forceinline__ void phase_s5_carry(int l) {
    CParams& p = KPL(); const Ctx cx = mkctx();
    const int b0 = cx.nb >= 2 ? cx.nb / 2 : 0;
    if (cx.bid < b0) return;
    const int lane = cx.tid & 63, gw = (cx.bid - b0) * 8 + (cx.tid >> 6), nw = (cx.nb - b0) * 8;
    const float* S5P = (const float*)(p.ws + OFF_S5P) + (size_t)l * 147456;
    float* ST = (float*)(p.ws + OFF_S5ST);
    for (int item0 = gw; item0 < 128; item0 += nw) {
        const int item = __builtin_amdgcn_readfirstlane(item0);
        const int g = item & 31, dir = (item >> 5) & 1, b = item >> 6;
        const int idx = dir * 2048 + g * 64 + lane;
        const float ar = S5P[8192 + idx], ai = S5P[12288 + idx];
        float* st = ST + (((size_t)b * 2 + dir) * 32 + g) * 132 * 128;
        float hr = 0.f, hi = 0.f;
        for (int i0 = 0; i0 < 132; i0 += 12) {
            float lr[12], li[12];
#pragma unroll
            for (int e = 0; e < 12; ++e) { const int c = s5_order(dir, i0 + e); lr[e] = st[c * 128 + lane]; li[e] = st[c * 128 + 64 + lane]; }
#pragma unroll
            for (int e = 0; e < 12; ++e) { const int c = s5_order(dir, i0 + e); st[c * 128 + lane] = hr; st[c * 128 + 64 + lane] = hi;
                const float nr = ar * hr - ai * hi + lr[e], ni = ar * hi + ai * hr + li[e]; hr = nr; hi = ni; }
        }
    }
}

template <int DIR>
__device__ __forceinline__ void s5_final_dir(CParams& p, int l, int b, int g, int chunk, int lane, const unsigned (&ur)[8], float* hst, f32x4* ybuf, int row0, float dsk, bf16_t* ZG) {
    const float* S5P = (const float*)(p.ws + OFF_S5P) + (size_t)l * 147456; const float* BR = S5P + 16384; const float* BI = BR + 65536;
    const float* ST = (const float*)(p.ws + OFF_S5ST);
    const bf16_t* ZA = (const bf16_t*)(p.ws + OFF_Z);
    const int idx = DIR * 2048 + g * 64 + lane;
    const float ar = S5P[idx], ai = S5P[4096 + idx];
    float br[16], bi[16];
#pragma unroll
    for (int q = 0; q < 4; ++q) { const f32x4 t0 = *(const f32x4*)(BR + (size_t)idx * 16 + q * 4), t1 = *(const f32x4*)(BI + (size_t)idx * 16 + q * 4);
#pragma unroll
        for (int e = 0; e < 4; ++e) { br[q * 4 + e] = t0[e]; bi[q * 4 + e] = t1[e]; } }
    float cbr[16], cbi[16];
    { const size_t cb = ((((size_t)l * 2 + DIR) * 32 + g) * 16 + (lane & 15)) * 64 + (lane >> 4);
#pragma unroll
      for (int i = 0; i < 16; ++i) { cbr[i] = p.in[14][cb + 4 * i]; cbi[i] = -p.in[15][cb + 4 * i]; } }
    const float* st = ST + ((((size_t)b * 2 + DIR) * 32 + g) * 132 + chunk) * 128;
    float hr = st[lane], hi = st[64 + lane];
    const int ch = g * 16 + (lane & 15);
#pragma unroll 1
    for (int si = 0; si < 4; ++si) {
        const int sc = DIR ? 3 - si : si;
#pragma unroll
        for (int jj = 0; jj < 16; ++jj) {
            const int tt = DIR ? 15 - jj : jj; const int tok = sc * 16 + tt;
            float bur = 0.f, bui = 0.f;
#pragma unroll
            for (int q = 0; q < 8; ++q) { const unsigned w = (unsigned)__builtin_amdgcn_readlane((int)ur[q], tok); const float x0 = bflo(w), x1 = bfhi(w);
                bur += br[2 * q] * x0 + br[2 * q + 1] * x1; bui += bi[2 * q] * x0 + bi[2 * q + 1] * x1; }
            const float nr = ar * hr - ai * hi + bur, ni = ar * hi + ai * hr + bui; hr = nr; hi = ni;
            hst[tt * 68 + lane] = hr; hst[1088 + tt * 68 + lane] = hi;
        }
        f32x4 a = (f32x4){0.f, 0.f, 0.f, 0.f};
        if (DIR) a = ybuf[sc * 64 + lane];
#pragma unroll
        for (int i = 0; i < 16; ++i) {
            const float xr = hst[(lane & 15) * 68 + 4 * i + (lane >> 4)], xi = hst[1088 + (lane & 15) * 68 + 4 * i + (lane >> 4)];
            a = __builtin_amdgcn_mfma_f32_16x16x4f32(xr, cbr[i], a, 0, 0, 0);
            a = __builtin_amdgcn_mfma_f32_16x16x4f32(xi, cbi[i], a, 0, 0, 0);
        }
        if (!DIR) ybuf[sc * 64 + lane] = a;
        else {
#pragma unroll
            for (int j = 0; j < 4; ++j) {
                const int row = row0 + sc * 16 + (lane >> 4) * 4 + j;
                const float u = bf2f(ZA[(size_t)row * 2048 + ch]);
                const float y = u * dsk + a[j];
                const float z = 0.5f * y * (1.f + tanhf(0.7978845608028654f * (y + 0.044715f * y * y * y)));
                ZG[(size_t)row * 512 + ch] = f2bf(z);
            }
        }
    }
}

__device__ __forceinline__ void phase_s5_final(int l, float* smf) {
    CParams& p = KPL(); const Ctx cx = mkctx();
    const int nscan = cx.nb >= 2 ? cx.nb / 2 : 0;
    if (cx.bid < nscan) return;
    const int lane = cx.tid & 63, wid = cx.tid >> 6, gw = (cx.bid - nscan) * 8 + wid, nw = (cx.nb - nscan) * 8;
    const bf16_t* ZA = (const bf16_t*)(p.ws + OFF_Z);
    bf16_t* ZG = (bf16_t*)(p.ws + OFF_ZG);
    float* hst = smf + wid * 3200;
    f32x4* ybuf = (f32x4*)(hst + 2176);
    for (int item0 = gw; item0 < 8448; item0 += nw) {
        const int item = __builtin_amdgcn_readfirstlane(item0);
        const int chunk = item % 132, g = (item / 132) & 31, b = item / 4224;
        const int row0 = b * SEQA + chunk * 64;
        const u32x4 u0 = *(const u32x4*)(ZA + (size_t)(row0 + lane) * 2048 + g * 16), u1 = *(const u32x4*)(ZA + (size_t)(row0 + lane) * 2048 + g * 16 + 8);
        const unsigned ur[8] = {u0.x, u0.y, u0.z, u0.w, u1.x, u1.y, u1.z, u1.w};
        const float dsk = p.in[16][l * 512 + g * 16 + (lane & 15)];
        s5_final_dir<0>(p, l, b, g, chunk, lane, ur, hst, ybuf, row0, dsk, ZG);
        s5_final_dir<1>(p, l, b, g, chunk, lane, ur, hst, ybuf, row0, dsk, ZG);
    }
}

__device__ __forceinline__ int ml_row0(int b, int nc) { return b * SEQA + nc * 128; }
__device__ __forceinline__ int ml_order(int dir, int i) { return dir == 0 ? i : (i < 2 ? 1 - i : 67 - i); }

__device__ __forceinline__ void phase_ml_conv(int l) {
    CParams& p = KPL(); const Ctx cx = mkctx();
    const bf16_t* ZA = (const bf16_t*)(p.ws + OFF_Z);
    bf16_t* QKC = (bf16_t*)(p.ws + OFF_QKC);
    const float* cw = p.in[19] + (size_t)l * 9 * 512; const float* cb = p.in[20] + l * 512;
    for (int idx = cx.bid * 512 + cx.tid; idx < T_TOK * 64; idx += cx.nb * 512) {
        const int row = idx >> 6, c8 = (idx & 63) * 8;
        const int b = row >= SEQA ? 1 : 0, t = row - b * SEQA;
        const bool isctx = t < NCTX;
        const int tt = isctx ? t : t - NCTX, W = isctx ? 256 : 64, Hh = isctx ? 1 : 128;
        const int y = tt / W, x = tt % W;
        const int segrow0 = row - tt;
        float acc[8];
#pragma unroll
        for (int e = 0; e < 8; ++e) acc[e] = cb[c8 + e];
#pragma unroll
        for (int dy = 0; dy < 3; ++dy)
#pragma unroll
            for (int dx = 0; dx < 3; ++dx) {
                const int yy = y + dy - 1, xx = x + dx - 1;
                if (yy >= 0 && yy < Hh && xx >= 0 && xx < W) {
                    const u32x4 z = *(const u32x4*)(ZA + (size_t)(segrow0 + yy * W + xx) * 2048 + 512 + c8);
                    const float* w = cw + (dy * 3 + dx) * 512 + c8;
                    const f32x4 w0 = *(const f32x4*)w, w1 = *(const f32x4*)(w + 4);
                    acc[0] += bflo(z.x) * w0[0]; acc[1] += bfhi(z.x) * w0[1]; acc[2] += bflo(z.y) * w0[2]; acc[3] += bfhi(z.y) * w0[3];
                    acc[4] += bflo(z.z) * w1[0]; acc[5] += bfhi(z.z) * w1[1]; acc[6] += bflo(z.w) * w1[2]; acc[7] += bfhi(z.w) * w1[3];
                }
            }
        u32x4 o;
#pragma unroll
        for (int e = 0; e < 8; ++e) acc[e] = acc[e] * sigmoidf_(acc[e]);
        o.x = pk2(acc[0], acc[1]); o.y = pk2(acc[2], acc[3]); o.z = pk2(acc[4], acc[5]); o.w = pk2(acc[6], acc[7]);
        *(u32x4*)(QKC + (size_t)row * 512 + c8) = o;
    }
}

constexpr int ML_QS = 0, ML_KS = 18432, ML_VT = 36864, ML_CS = 71680, ML_PS = 92416, ML_GV = 127232, ML_BV = 127744, ML_MV = 128256, ML_LF = 128768, ML_IG = 129280, ML_SC = 129792;

__device__ __forceinline__ void ml_gate_vectors(const Ctx& cx, CParams& p, int l, int dir, int b, int h, int nc, unsigned char* sm, float m_in) {
    const int tid = cx.tid, lane = tid & 63;
    float* lf = (float*)(sm + ML_LF); float* ig = (float*)(sm + ML_IG); float* gv = (float*)(sm + ML_GV); float* bv = (float*)(sm + ML_BV); float* mv = (float*)(sm + ML_MV); float* sc = (float*)(sm + ML_SC);
    const float* MLG = (const float*)(p.ws + OFF_MLG);
    const float* gb = p.in[21] + l * 16;
    if (tid < 128) {
        const int row = ml_row0(b, nc) + tid;
        const float ip = MLG[(size_t)row * 16 + dir * 4 + h] + gb[dir * 4 + h];
        const float fp = MLG[(size_t)row * 16 + 8 + dir * 4 + h] + gb[8 + dir * 4 + h];
        ig[tid] = ip; lf[tid] = fminf(fp, 0.f) - log1pf(expf(-fabsf(fp)));
    }
    __syncthreads();
    if (tid < 64) {
        const int pp0 = 2 * lane, pp1 = 2 * lane + 1; const int s0 = dir ? 127 - pp0 : pp0, s1 = dir ? 127 - pp1 : pp1;
        const float x0 = lf[s0], x1 = lf[s1];
        float incl = x0 + x1;
#pragma unroll
        for (int d = 1; d < 64; d <<= 1) { const float t = __shfl_up(incl, d); if (lane >= d) incl += t; }
        const float g1 = incl, g0 = incl - x1;
        const float gtot = __shfl(incl, 63);
        const float b0 = ig[s0] - g0, b1 = ig[s1] - g1;
        float mx = fmaxf(b0, b1);
#pragma unroll
        for (int d = 1; d < 64; d <<= 1) { const float t = __shfl_up(mx, d); if (lane >= d) mx = fmaxf(mx, t); }
        const float prev = __shfl_up(mx, 1);
        const float pm0 = lane > 0 ? fmaxf(prev, b0) : b0, pm1 = mx;
        const float bmax = __shfl(mx, 63);
        gv[s0] = g0; gv[s1] = g1; bv[s0] = b0; bv[s1] = b1; mv[s0] = fmaxf(m_in, pm0); mv[s1] = fmaxf(m_in, pm1);
        if (lane == 0) { sc[0] = gtot; sc[1] = bmax; }
    }
    __syncthreads();
}

__device__ __forceinline__ void phase_ml_local(int l, unsigned char* sm) {
    CParams& p = KPL(); const Ctx cx = mkctx();
    const int tid = cx.tid, lane = tid & 63, wid = tid >> 6;
    const bf16_t* ZA = (const bf16_t*)(p.ws + OFF_Z); const bf16_t* QKC = (const bf16_t*)(p.ws + OFF_QKC);
    float* CLOC = (float*)(p.ws + OFF_CLOC); float* MLS = (float*)(p.ws + OFF_MLS);
    bf16_t* VT = (bf16_t*)(sm + ML_VT); bf16_t* KT = (bf16_t*)(sm + ML_KS);
    const float* bv = (const float*)(sm + ML_BV); const float* sc = (const float*)(sm + ML_SC);
    float* wg = (float*)(sm + ML_LF);
    unsigned* ticket = (unsigned*)(p.ws + OFF_BAR) + 3600 + l * 16;
    int* tslot = (int*)(sm + 143328);
    for (;;) {
        if (tid == 0) *tslot = (int)__hip_atomic_fetch_add(ticket, 1u, __ATOMIC_RELAXED, __HIP_MEMORY_SCOPE_AGENT);
        __syncthreads();
        const int item = *tslot;
        __syncthreads();
        if (item >= 1056) break;
        const int chain = item / 66, nc = item % 66; const int dir = chain >> 3, b = (chain >> 2) & 1, h = chain & 3;
        ml_gate_vectors(cx, p, l, dir, b, h, nc, sm, -1e30f);
        const float gtot = sc[0], bmax = sc[1];
        __syncthreads();
        if (tid < 128) wg[tid] = expf(bv[tid] - bmax);
        __syncthreads();
        const int row0 = ml_row0(b, nc);
#pragma unroll
        for (int q = 0; q < 4; ++q) { const int ci = q * 512 + tid; const int s = ci >> 4, v8 = (ci & 15) * 8;
            const u32x4 z = *(const u32x4*)(ZA + (size_t)(row0 + s) * 2048 + 1024 + h * 128 + v8); const float w = wg[s];
            const unsigned zz[4] = {z.x, z.y, z.z, z.w};
#pragma unroll
            for (int e = 0; e < 4; ++e) { VT[(v8 + 2 * e) * 136 + s] = f2bf(bflo(zz[e]) * w); VT[(v8 + 2 * e + 1) * 136 + s] = f2bf(bfhi(zz[e]) * w); } }
#pragma unroll
        for (int q = 0; q < 2; ++q) { const int ci = q * 512 + tid; const int s = ci >> 3, k8 = (ci & 7) * 8;
            const u32x4 z = *(const u32x4*)(QKC + (size_t)(row0 + s) * 512 + 256 + h * 64 + k8);
            const unsigned zz[4] = {z.x, z.y, z.z, z.w};
#pragma unroll
            for (int e = 0; e < 4; ++e) { KT[(k8 + 2 * e) * 136 + s] = (bf16_t)(zz[e] & 0xffff); KT[(k8 + 2 * e + 1) * 136 + s] = (bf16_t)(zz[e] >> 16); } }
        __syncthreads();
        float* dst = CLOC + ((size_t)chain * 66 + nc) * 8256;
        f32x4 acc[4];
#pragma unroll
        for (int n = 0; n < 4; ++n) acc[n] = (f32x4){0.f, 0.f, 0.f, 0.f};
#pragma unroll
        for (int ks = 0; ks < 4; ++ks) {
            const bf16x8 a = *(const bf16x8*)(VT + (16 * wid + (lane & 15)) * 136 + ks * 32 + (lane >> 4) * 8);
#pragma unroll
            for (int n = 0; n < 4; ++n) { const bf16x8 bb = *(const bf16x8*)(KT + (16 * n + (lane & 15)) * 136 + ks * 32 + (lane >> 4) * 8);
                acc[n] = __builtin_amdgcn_mfma_f32_16x16x32_bf16(a, bb, acc[n], 0, 0, 0); }
        }
#pragma unroll
        for (int n = 0; n < 4; ++n)
#pragma unroll
            for (int j = 0; j < 4; ++j) dst[(16 * wid + (lane >> 4) * 4 + j) * 64 + 16 * n + (lane & 15)] = acc[n][j];
        if (tid < 64) { float s0 = 0.f, s1 = 0.f, s2 = 0.f, s3 = 0.f;
#pragma unroll 4
            for (int t = 0; t < 128; t += 4) { const u32x2 kq = *(const u32x2*)(KT + tid * 136 + t); const f32x4 w4 = *(const f32x4*)(wg + t);
                s0 += w4[0] * bflo(kq.x); s1 += w4[1] * bfhi(kq.x); s2 += w4[2] * bflo(kq.y); s3 += w4[3] * bfhi(kq.y); }
            dst[8192 + tid] = (s0 + s1) + (s2 + s3); }
        if (tid == 0) { MLS[chain * 66 + nc] = gtot; MLS[1056 + chain * 66 + nc] = gtot + bmax; }
        __syncthreads();
    }
}

__device__ __forceinline__ void phase_ml_carry() {
    CParams& p = KPL(); const Ctx cx = mkctx();
    float* CLOC = (float*)(p.ws + OFF_CLOC); float* MLS = (float*)(p.ws + OFF_MLS);
    for (int idx = cx.bid * 512 + cx.tid; idx < 16 * 8192; idx += cx.nb * 512) {
        const int chain = idx >> 13, e = idx & 8191; const int dir = chain >> 3;
        const bool two = e < 64;
        float* base = CLOC + (size_t)chain * 66 * 8256 + e;
        const float* gtp = MLS + chain * 66; const float* amp = MLS + 1056 + chain * 66;
        float m = -1e30f, C = 0.f, N = 0.f;
        for (int i0 = 0; i0 < 66; i0 += 11) {
            float cl[11], nl[11], gt[11], am[11];
#pragma unroll
            for (int q = 0; q < 11; ++q) { const int nc = ml_order(dir, i0 + q); cl[q] = base[(size_t)nc * 8256]; nl[q] = two ? base[(size_t)nc * 8256 + 8192] : 0.f; gt[q] = gtp[nc]; am[q] = amp[nc]; }
#pragma unroll
            for (int q = 0; q < 11; ++q) { const int nc = ml_order(dir, i0 + q);
                base[(size_t)nc * 8256] = C;
                if (two) base[(size_t)nc * 8256 + 8192] = N;
                if (e == 0) MLS[2112 + chain * 66 + nc] = m;
                const float mn = fmaxf(gt[q] + m, am[q]); const float so = __expf(gt[q] + m - mn), sl = __expf(am[q] - mn);
                C = so * C + sl * cl[q]; N = so * N + sl * nl[q]; m = mn; }
        }
    }
}

__device__ __forceinline__ void phase_ml_out(int l, unsigned char* sm) {
    CParams& p = KPL(); const Ctx cx = mkctx();
    const int tid = cx.tid, lane = tid & 63, wid = tid >> 6;
    const bf16_t* ZA = (const bf16_t*)(p.ws + OFF_Z); const bf16_t* QKC = (const bf16_t*)(p.ws + OFF_QKC);
    const float* CLOC = (const float*)(p.ws + OFF_CLOC); const float* MLS = (const float*)(p.ws + OFF_MLS);
    bf16_t* YB = (bf16_t*)(p.ws + OFF_YB);
    bf16_t* QS = (bf16_t*)(sm + ML_QS); bf16_t* KS = (bf16_t*)(sm + ML_KS); bf16_t* VT = (bf16_t*)(sm + ML_VT); bf16_t* CS = (bf16_t*)(sm + ML_CS); bf16_t* PS = (bf16_t*)(sm + ML_PS);
    const float* gv = (const float*)(sm + ML_GV); const float* bv = (const float*)(sm + ML_BV); const float* mv = (const float*)(sm + ML_MV);
    unsigned* ticket = (unsigned*)(p.ws + OFF_BAR) + 3608 + l * 16;
    int* tslot = (int*)(sm + 143328);
    for (;;) {
        if (tid == 0) *tslot = (int)__hip_atomic_fetch_add(ticket, 1u, __ATOMIC_RELAXED, __HIP_MEMORY_SCOPE_AGENT);
        __syncthreads();
        const int item = *tslot;
        __syncthreads();
        if (item >= 528) break;
        const int b = item / 264, h = (item / 66) & 3, nc = item % 66;
        const int row0 = ml_row0(b, nc);
        __syncthreads();
#pragma unroll
        for (int q = 0; q < 2; ++q) { const int ci = q * 512 + tid; const int s = ci >> 3, k8 = (ci & 7) * 8;
            const u32x4 zq = *(const u32x4*)(QKC + (size_t)(row0 + s) * 512 + h * 64 + k8);
            u32x4 o; o.x = pk2(bflo(zq.x) * 0.125f, bfhi(zq.x) * 0.125f); o.y = pk2(bflo(zq.y) * 0.125f, bfhi(zq.y) * 0.125f); o.z = pk2(bflo(zq.z) * 0.125f, bfhi(zq.z) * 0.125f); o.w = pk2(bflo(zq.w) * 0.125f, bfhi(zq.w) * 0.125f);
            *(u32x4*)(QS + s * 72 + k8) = o;
            *(u32x4*)(KS + s * 72 + k8) = *(const u32x4*)(QKC + (size_t)(row0 + s) * 512 + 256 + h * 64 + k8); }
#pragma unroll
        for (int q = 0; q < 4; ++q) { const int ci = q * 512 + tid; const int s = ci >> 4, v8 = (ci & 15) * 8;
            const u32x4 z = *(const u32x4*)(ZA + (size_t)(row0 + s) * 2048 + 1024 + h * 128 + v8);
            const unsigned zz[4] = {z.x, z.y, z.z, z.w};
#pragma unroll
            for (int e = 0; e < 4; ++e) { VT[(v8 + 2 * e) * 136 + s] = (bf16_t)(zz[e] & 0xffff); VT[(v8 + 2 * e + 1) * 136 + s] = (bf16_t)(zz[e] >> 16); } }
        f32x4 hsum[8];
#pragma unroll
        for (int v = 0; v < 8; ++v) hsum[v] = (f32x4){0.f, 0.f, 0.f, 0.f};
#pragma unroll 1
        for (int dir = 0; dir < 2; ++dir) {
            const int chain = dir * 8 + b * 4 + h;
            const float m_in = MLS[2112 + chain * 66 + nc];
            __syncthreads();
            ml_gate_vectors(cx, p, l, dir, b, h, nc, sm, m_in);
            const float* cin = CLOC + ((size_t)chain * 66 + nc) * 8256;
#pragma unroll
            for (int q = 0; q < 4; ++q) { const int ci = q * 512 + tid; const int v = ci >> 4, k4 = (ci & 15) * 4;
                const f32x4 c = *(const f32x4*)(cin + v * 64 + k4); store4bf(CS + v * 72 + k4, c); }
            if (tid < 16) { const f32x4 c = *(const f32x4*)(cin + 8192 + tid * 4); store4bf(CS + 128 * 72 + tid * 4, c); }
            else if (tid < 256) { const int r = 129 + (tid - 16) / 16, k4 = ((tid - 16) & 15) * 4; store4bf(CS + r * 72 + k4, (f32x4){0.f, 0.f, 0.f, 0.f}); }
            __syncthreads();
            const int tr = 16 * wid + (lane >> 4) * 4;
            float Mt[4], rs[4] = {0.f, 0.f, 0.f, 0.f};
#pragma unroll
            for (int j = 0; j < 4; ++j) Mt[j] = mv[tr + j];
            bf16x8 qa[2];
#pragma unroll
            for (int ks = 0; ks < 2; ++ks) qa[ks] = *(const bf16x8*)(QS + (16 * wid + (lane & 15)) * 72 + ks * 32 + (lane >> 4) * 8);
#pragma unroll
            for (int nt = 0; nt < 8; ++nt) {
                f32x4 s4 = (f32x4){0.f, 0.f, 0.f, 0.f};
#pragma unroll
                for (int ks = 0; ks < 2; ++ks) { const bf16x8 kb = *(const bf16x8*)(KS + (16 * nt + (lane & 15)) * 72 + ks * 32 + (lane >> 4) * 8);
                    s4 = __builtin_amdgcn_mfma_f32_16x16x32_bf16(qa[ks], kb, s4, 0, 0, 0); }
                const int s = 16 * nt + (lane & 15); const float bs = bv[s];
#pragma unroll
                for (int j = 0; j < 4; ++j) { const int t = tr + j; const bool valid = dir ? (s >= t) : (s <= t);
                    const float pv = valid ? s4[j] * __expf(bs - Mt[j]) : 0.f; rs[j] += pv; PS[t * 136 + s] = f2bf(pv); }
            }
#pragma unroll
            for (int j = 0; j < 4; ++j) rs[j] = row16_sum(rs[j]);
            __syncthreads();
            f32x4 qn = (f32x4){0.f, 0.f, 0.f, 0.f};
#pragma unroll
            for (int ks = 0; ks < 2; ++ks) { const bf16x8 cb = *(const bf16x8*)(CS + (128 + (lane & 15)) * 72 + ks * 32 + (lane >> 4) * 8);
                qn = __builtin_amdgcn_mfma_f32_16x16x32_bf16(qa[ks], cb, qn, 0, 0, 0); }
            float wi[4], dn[4];
#pragma unroll
            for (int j = 0; j < 4; ++j) { const float qnj = row16_sum(qn[j]); wi[j] = expf(m_in - Mt[j]);
                const float den = rs[j] + wi[j] * qnj; const float mt = gv[tr + j] + Mt[j]; dn[j] = 1.f / fmaxf(fabsf(den), expf(-mt)); }
            bf16x8 pa[4];
#pragma unroll
            for (int ks = 0; ks < 4; ++ks) pa[ks] = *(const bf16x8*)(PS + (16 * wid + (lane & 15)) * 136 + ks * 32 + (lane >> 4) * 8);
#pragma unroll
            for (int vt = 0; vt < 8; ++vt) {
                f32x4 a1 = (f32x4){0.f, 0.f, 0.f, 0.f}, a2 = (f32x4){0.f, 0.f, 0.f, 0.f};
#pragma unroll
                for (int ks = 0; ks < 4; ++ks) { const bf16x8 vb = *(const bf16x8*)(VT + (16 * vt + (lane & 15)) * 136 + ks * 32 + (lane >> 4) * 8);
                    a1 = __builtin_amdgcn_mfma_f32_16x16x32_bf16(pa[ks], vb, a1, 0, 0, 0); }
#pragma unroll
                for (int ks = 0; ks < 2; ++ks) { const bf16x8 cb = *(const bf16x8*)(CS + (16 * vt + (lane & 15)) * 72 + ks * 32 + (lane >> 4) * 8);
                    a2 = __builtin_amdgcn_mfma_f32_16x16x32_bf16(qa[ks], cb, a2, 0, 0, 0); }
#pragma unroll
                for (int j = 0; j < 4; ++j) hsum[vt][j] += (a1[j] + wi[j] * a2[j]) * dn[j];
            }
        }
        const int tr = 16 * wid + (lane >> 4) * 4;
        float rinv[4];
#pragma unroll
        for (int j = 0; j < 4; ++j) { float ss = 0.f;
#pragma unroll
            for (int vt = 0; vt < 8; ++vt) ss += hsum[vt][j] * hsum[vt][j];
            ss = row16_sum(ss); rinv[j] = rsqrtf(ss * (1.f / 128.f) + 1e-6f); }
#pragma unroll
        for (int vt = 0; vt < 8; ++vt) { const int ch = h * 128 + 16 * vt + (lane & 15); const float ng = p.in[22][l * 512 + ch];
#pragma unroll
            for (int j = 0; j < 4; ++j) { const int row = row0 + tr + j;
                const float o = bf2f(ZA[(size_t)row * 2048 + 1536 + ch]);
                YB[(size_t)row * 512 + ch] = f2bf(hsum[vt][j] * rinv[j] * ng * sigmoidf_(o)); } }
    }
}

__device__ __forceinline__ void phase_rw_feat(int l) {
    CParams& p = KPL(); const Ctx cx = mkctx();
    const int lane = cx.tid & 63, gw = cx.bid * 8 + (cx.tid >> 6), nw = cx.nb * 8;
    const bf16_t* ZRW = (const bf16_t*)(p.ws + OFF_ZRW);
    bf16_t* F1 = (bf16_t*)(p.ws + OFF_F1); bf16_t* LIN = (bf16_t*)(p.ws + OFF_LORAIN);
    const float* mup = p.in[23] + (size_t)l * 1792; const float* mun = p.in[24] + (size_t)l * 1792;
    const float* kk_w = p.in[30] + l * 512;
    for (int row = gw; row < T_TOK; row += nw) {
        const int b = row >= SEQA ? 1 : 0, t = row - b * SEQA;
        const bool hasp = !(t == 0 || t == NCTX), hasn = !(t == NCTX - 1 || t == SEQA - 1);
        const bf16_t* zc = ZRW + (size_t)row * 1792;
#pragma unroll
        for (int q = 0; q < 3; ++q) {
            const int col = q * 512 + lane * 8;
            const u32x4 c4 = *(const u32x4*)(zc + col);
            u32x4 p4 = (u32x4){0u, 0u, 0u, 0u}, n4 = (u32x4){0u, 0u, 0u, 0u};
            if (hasp) p4 = *(const u32x4*)(zc - 1792 + col);
            if (hasn) n4 = *(const u32x4*)(zc + 1792 + col);
            const unsigned cc[4] = {c4.x, c4.y, c4.z, c4.w}, pp[4] = {p4.x, p4.y, p4.z, p4.w}, nn[4] = {n4.x, n4.y, n4.z, n4.w};
            float zs[8];
#pragma unroll
            for (int e = 0; e < 8; ++e) { const float z = (e & 1) ? bfhi(cc[e >> 1]) : bflo(cc[e >> 1]); const float pv = (e & 1) ? bfhi(pp[e >> 1]) : bflo(pp[e >> 1]); const float nx = (e & 1) ? bfhi(nn[e >> 1]) : bflo(nn[e >> 1]);
                zs[e] = z + mup[col + e] * (pv - z) + mun[col + e] * (nx - z); }
            u32x4 o; o.x = pk2(zs[0], zs[1]); o.y = pk2(zs[2], zs[3]); o.z = pk2(zs[4], zs[5]); o.w = pk2(zs[6], zs[7]);
            *(u32x4*)(F1 + (size_t)row * 2048 + q * 512 + lane * 8) = o;
            if (q == 1) {
                float kr[8], ssq = 0.f;
#pragma unroll
                for (int e = 0; e < 8; ++e) { kr[e] = zs[e] * kk_w[lane * 8 + e]; ssq += kr[e] * kr[e]; }
                ssq = row8_sum(ssq);
                const float inv = 1.f / fmaxf(sqrtf(ssq), 1e-12f);
                u32x4 o2; o2.x = pk2(kr[0] * inv, kr[1] * inv); o2.y = pk2(kr[2] * inv, kr[3] * inv); o2.z = pk2(kr[4] * inv, kr[5] * inv); o2.w = pk2(kr[6] * inv, kr[7] * inv);
                *(u32x4*)(F1 + (size_t)row * 2048 + 1536 + lane * 8) = o2;
            }
        }
        {
            const int col = 1536 + lane * 4;
            const u32x2 c2 = *(const u32x2*)(zc + col);
            u32x2 p2 = (u32x2){0u, 0u}, n2 = (u32x2){0u, 0u};
            if (hasp) p2 = *(const u32x2*)(zc - 1792 + col);
            if (hasn) n2 = *(const u32x2*)(zc + 1792 + col);
            const unsigned cc[2] = {c2.x, c2.y}, pp[2] = {p2.x, p2.y}, nn[2] = {n2.x, n2.y};
            float zs[4];
#pragma unroll
            for (int e = 0; e < 4; ++e) { const float z = (e & 1) ? bfhi(cc[e >> 1]) : bflo(cc[e >> 1]); const float pv = (e & 1) ? bfhi(pp[e >> 1]) : bflo(pp[e >> 1]); const float nx = (e & 1) ? bfhi(nn[e >> 1]) : bflo(nn[e >> 1]);
                const float s = z + mup[col + e] * (pv - z) + mun[col + e] * (nx - z);
                zs[e] = lane < 16 ? tanhf(s) : (lane < 32 ? s : sigmoidf_(s)); }
            u32x2 o; o.x = pk2(zs[0], zs[1]); o.y = pk2(zs[2], zs[3]);
            *(u32x2*)(LIN + (size_t)row * 256 + lane * 4) = o;
        }
    }
}

__device__ __forceinline__ int rw_tok(int dir, int i) { return dir == 0 ? i : (i < NCTX ? NCTX - 1 - i : 8703 - i); }

typedef float f32x2 __attribute__((ext_vector_type(2)));
constexpr int RW_REC = 384;
__device__ __forceinline__ void rw_load(const bf16_t* f1, const bf16_t* f2, const bf16_t* fu, int ustr, int dir, int rg, int c, int pw, int lane, bf16_t (&in)[8][5], bf16_t (&vin)[8]) {
#pragma unroll
    for (int q = 0; q < 8; ++q) { const size_t t = (size_t)rw_tok(dir, c * 32 + pw * 8 + q);
        in[q][0] = f1[t * 2048 + lane]; in[q][1] = f1[t * 2048 + 512 + lane]; in[q][2] = f1[t * 2048 + 1536 + lane]; in[q][3] = fu[t * ustr + lane]; in[q][4] = f2[t * 2048 + 1024 + lane];
        vin[q] = f1[t * 2048 + 1024 + rg * 16 + (lane & 15)]; }
}
__device__ __forceinline__ void rw_emit(const bf16_t (&in)[8][5], const bf16_t (&vin)[8], int pw, int lane, float ka, float* buf) {
#pragma unroll
    for (int q = 0; q < 8; ++q) {
        const float r = bf2f(in[q][0]), k = bf2f(in[q][1]), kk = bf2f(in[q][2]), u = bf2f(in[q][3]), a = bf2f(in[q][4]);
        const float w = 1.f - u, key = k * (1.f + (a - 1.f) * ka), kka = kk * a, wr = w * r;
        const float c1 = wave_sum(kka * r), c2 = wave_sum(key * r);
        float* rec = buf + (pw * 8 + q) * RW_REC;
        rec[lane] = kk; rec[64 + lane] = wr; rec[128 + lane] = w; rec[192 + lane] = kka; rec[256 + lane] = key;
        if (lane < 16) { f32x4 vc; vc[0] = bf2f(vin[q]); vc[1] = c1; vc[2] = c2; vc[3] = 0.f; *(f32x4*)(rec + 320 + lane * 4) = vc; }
    }
}

__device__ __forceinline__ void phase_rw_scan(int l, unsigned char* sm) {
    CParams& p = KPL(); const Ctx cx = mkctx();
    const int tid = cx.tid, lane = tid & 63, wid = __builtin_amdgcn_readfirstlane(tid >> 6);
    const bf16_t* F1 = (const bf16_t*)(p.ws + OFF_F1); const bf16_t* F2 = (const bf16_t*)(p.ws + OFF_Z);
    bf16_t* YRAW = (bf16_t*)(p.ws + OFF_R2);
    float* ring = (float*)sm;
    const bool is_scan = wid < 4, is_prod = wid >= 4;
    const int pw = wid & 3;
    const int nscan = cx.nb >= 2 ? cx.nb / 2 : 1;
    if (cx.bid >= nscan) return;
    for (int item = cx.bid; item < 128; item += nscan) {
        const int chain = item >> 2, rg = item & 3; const int dir = chain >> 4, b = (chain >> 3) & 1, h = chain & 7;
        const float ka = p.in[31][l * 512 + h * 64 + lane];
        const bf16_t* f1 = F1 + (size_t)b * SEQA * 2048 + h * 64; const bf16_t* f2 = F2 + (size_t)b * SEQA * 2048 + dir * 512 + h * 64;
        const int ustr = dir ? 2048 : 512;
        const bf16_t* fu = dir ? f2 : (const bf16_t*)(p.ws + OFF_U0) + (size_t)b * SEQA * 512 + h * 64;
        const int row = rg * 16 + (wid & 3) * 4 + (lane >> 4);
        bf16_t* yr = YRAW + ((size_t)dir * T_TOK + (size_t)b * SEQA) * 512 + h * 64 + row;
        bf16_t pin[8][5], pvin[8];
        __syncthreads();
        if (is_prod) { rw_load(f1, f2, fu, ustr, dir, rg, 0, pw, lane, pin, pvin); rw_emit(pin, pvin, pw, lane, ka, ring); rw_load(f1, f2, fu, ustr, dir, rg, 1, pw, lane, pin, pvin); }
        __syncthreads();
        f32x2 S01 = (f32x2){0.f, 0.f}, S23 = (f32x2){0.f, 0.f};
        if (is_scan) __builtin_amdgcn_s_setprio(3);
#pragma unroll 1
        for (int c = 0; c < 264; ++c) {
            float* buf = ring + (c & 1) * (32 * RW_REC);
            if (is_prod) { if (c + 1 < 264) { rw_emit(pin, pvin, pw, lane, ka, ring + ((c + 1) & 1) * (32 * RW_REC)); rw_load(f1, f2, fu, ustr, dir, rg, c + 2 < 264 ? c + 2 : c + 1, pw, lane, pin, pvin); } }
            else if (is_scan) {
                const float* rb = buf + (lane & 15) * 4;
                const float* vb = buf + 320 + ((wid & 3) * 4 + (lane >> 4)) * 4;
#pragma unroll 1
                for (int hf = 0; hf < 2; ++hf) {
                    const float* rh = rb + hf * 16 * RW_REC; const float* vh = vb + hf * 16 * RW_REC;
                    f32x4 kk4 = *(const f32x4*)(rh), wr4 = *(const f32x4*)(rh + 64), w4 = *(const f32x4*)(rh + 128), ka4 = *(const f32x4*)(rh + 192), ky4 = *(const f32x4*)(rh + 256), vc4 = *(const f32x4*)(vh);
                    f32x4 nkk = *(const f32x4*)(rh + RW_REC), nwr = *(const f32x4*)(rh + RW_REC + 64), nw = *(const f32x4*)(rh + RW_REC + 128), nka = *(const f32x4*)(rh + RW_REC + 192), nky = *(const f32x4*)(rh + RW_REC + 256), nvc = *(const f32x4*)(vh + RW_REC);
                    float ybuf = 0.f;
#pragma unroll
                    for (int j = 0; j < 16; ++j) {
                        f32x4 mkk, mwr, mw, mka, mky, mvc;
                        if (j < 14) { const int o = (j + 2) * RW_REC;
                            mkk = *(const f32x4*)(rh + o); mwr = *(const f32x4*)(rh + o + 64); mw = *(const f32x4*)(rh + o + 128); mka = *(const f32x4*)(rh + o + 192); mky = *(const f32x4*)(rh + o + 256); mvc = *(const f32x4*)(vh + o); }
                        const float vv = vc4[0];
                        f32x2 p1 = S01 * (f32x2){kk4[0], kk4[1]}; p1 = S23 * (f32x2){kk4[2], kk4[3]} + p1;
                        f32x2 p2 = S01 * (f32x2){wr4[0], wr4[1]}; p2 = S23 * (f32x2){wr4[2], wr4[3]} + p2;
                        const f32x2 vv2 = (f32x2){vv, vv};
                        f32x2 u01 = (f32x2){ky4[0], ky4[1]} * vv2; u01 = S01 * (f32x2){w4[0], w4[1]} + u01;
                        f32x2 u23 = (f32x2){ky4[2], ky4[3]} * vv2; u23 = S23 * (f32x2){w4[2], w4[3]} + u23;
                        const float sk = row16_sum(p1[0] + p1[1]);
                        const float q2 = row16_sum(p2[0] + p2[1]);
                        const f32x2 nsk2 = (f32x2){-sk, -sk};
                        S01 = (f32x2){ka4[0], ka4[1]} * nsk2 + u01; S23 = (f32x2){ka4[2], ka4[3]} * nsk2 + u23;
                        const float y = q2 - sk * vc4[1] + vv * vc4[2];
                        if ((lane & 15) == j) ybuf = y;
                        kk4 = nkk; wr4 = nwr; w4 = nw; ka4 = nka; ky4 = nky; vc4 = nvc;
                        if (j < 14) { nkk = mkk; nwr = mwr; nw = mw; nka = mka; nky = mky; nvc = mvc; }
                        __builtin_amdgcn_sched_barrier(0);
                    }
                    yr[(size_t)rw_tok(dir, c * 32 + hf * 16 + (lane & 15)) * 512] = f2bf(ybuf);
                }
            }
            asm volatile("s_waitcnt lgkmcnt(0)" ::: "memory"); __builtin_amdgcn_s_barrier(); asm volatile("" ::: "memory");
        }
        if (is_scan) __builtin_amdgcn_s_setprio(0);
    }
}

__device__ __forceinline__ void phase_rw_out(int l) {
    CParams& p = KPL(); const Ctx cx = mkctx();
    const int lane = cx.tid & 63, gw = cx.bid * 8 + (cx.tid >> 6), nw = cx.nb * 8;
    const bf16_t* F1 = (const bf16_t*)(p.ws + OFF_F1); const bf16_t* F2 = (const bf16_t*)(p.ws + OFF_Z); const bf16_t* GRW = (const bf16_t*)(p.ws + OFF_ZRW);
    const bf16_t* YRAW = (const bf16_t*)(p.ws + OFF_R2);
    bf16_t* YC = (bf16_t*)(p.ws + OFF_YC);
    const int c0 = lane * 8;
    float ka[8], rk[8], lg[8], lb[8];
#pragma unroll
    for (int e = 0; e < 8; ++e) { ka[e] = p.in[31][l * 512 + c0 + e]; rk[e] = p.in[32][l * 512 + c0 + e]; lg[e] = p.in[33][l * 512 + c0 + e]; lb[e] = p.in[34][l * 512 + c0 + e]; }
    for (int row = gw; row < T_TOK; row += nw) {
        const u32x4 y0 = *(const u32x4*)(YRAW + (size_t)row * 512 + c0), y1 = *(const u32x4*)(YRAW + ((size_t)T_TOK + row) * 512 + c0);
        const u32x4 r4 = *(const u32x4*)(F1 + (size_t)row * 2048 + c0), k4 = *(const u32x4*)(F1 + (size_t)row * 2048 + 512 + c0), v4 = *(const u32x4*)(F1 + (size_t)row * 2048 + 1024 + c0);
        const u32x4 a04 = *(const u32x4*)(F2 + (size_t)row * 2048 + 1024 + c0), a14 = *(const u32x4*)(F2 + (size_t)row * 2048 + 1536 + c0);
        const u32x4 g4 = *(const u32x4*)(GRW + (size_t)row * 512 + c0);
        const unsigned ya[4] = {y0.x, y0.y, y0.z, y0.w}, yb[4] = {y1.x, y1.y, y1.z, y1.w}, rr[4] = {r4.x, r4.y, r4.z, r4.w}, kx[4] = {k4.x, k4.y, k4.z, k4.w}, vv[4] = {v4.x, v4.y, v4.z, v4.w};
        const unsigned aa[4] = {a04.x, a04.y, a04.z, a04.w}, ab[4] = {a14.x, a14.y, a14.z, a14.w}, gg[4] = {g4.x, g4.y, g4.z, g4.w};
        float y[8], sum = 0.f, bs = 0.f;
#pragma unroll
        for (int e = 0; e < 8; ++e) {
            const int w = e >> 1; const bool hi = e & 1;
            y[e] = (hi ? bfhi(ya[w]) : bflo(ya[w])) + (hi ? bfhi(yb[w]) : bflo(yb[w])); sum += y[e];
            const float r = hi ? bfhi(rr[w]) : bflo(rr[w]), k = hi ? bfhi(kx[w]) : bflo(kx[w]), a0 = hi ? bfhi(aa[w]) : bflo(aa[w]), a1 = hi ? bfhi(ab[w]) : bflo(ab[w]);
            bs += r * k * (2.f + (a0 + a1 - 2.f) * ka[e]) * rk[e];
        }
        sum = row8_sum(sum); bs = row8_sum(bs);
        const float mu = sum * (1.f / 64.f);
        float var = 0.f;
#pragma unroll
        for (int e = 0; e < 8; ++e) { const float d = y[e] - mu; var += d * d; }
        var = row8_sum(var) * (1.f / 64.f);
        const float rstd = rsqrtf(var + 64e-5f);
        float o[8];
#pragma unroll
        for (int e = 0; e < 8; ++e) { const int w = e >> 1; const bool hi = e & 1;
            const float v = hi ? bfhi(vv[w]) : bflo(vv[w]), g = hi ? bfhi(gg[w]) : bflo(gg[w]);
            o[e] = ((y[e] - mu) * rstd * lg[e] + lb[e] + bs * v) * g; }
        u32x4 o4; o4.x = pk2(o[0], o[1]); o4.y = pk2(o[2], o[3]); o4.z = pk2(o[4], o[5]); o4.w = pk2(o[6], o[7]);
        *(u32x4*)(YC + (size_t)row * 512 + c0) = o4;
    }
}

__device__ __forceinline__ void phase_final() {
    CParams& p = KPL(); const Ctx cx = mkctx();
    const int lane = cx.tid & 63, gw = cx.bid * 8 + (cx.tid >> 6), nw = cx.nb * 8;
    const float* X = (const float*)(p.ws + OFF_X);
    for (int r = gw; r < 2 * 8192; r += nw) {
        const int b = r >> 13, t = r & 8191;
        const float* src = X + ((size_t)b * SEQA + NCTX + t) * 1024;
        f32x4 v[4]; float ss = 0.f;
#pragma unroll
        for (int i = 0; i < 4; ++i) { v[i] = *(const f32x4*)(src + (lane + 64 * i) * 4); ss += v[i][0] * v[i][0] + v[i][1] * v[i][1] + v[i][2] * v[i][2] + v[i][3] * v[i][3]; }
        ss = wave_sum(ss);
        const float inv = rsqrtf(ss * (1.f / 1024.f) + 1e-6f);
#pragma unroll
        for (int i = 0; i < 4; ++i) { const int c = (lane + 64 * i) * 4; const f32x4 g4 = *(const f32x4*)(p.in[41] + c);
            *(f32x4*)(p.out + (size_t)r * 1024 + c) = v[i] * inv * g4; }
    }
}

#define XB_TMO      128
#define XB_XCNT(j)  (256  + 64 * (j))
#define XB_XSUB(j)  (1280 + 64 * (j))
#define XB_XGEN(j)  (2304 + 64 * (j))
#define XB_TOP      3328
#define XB_TOPGEN   3392
#define XCD_BAR_WORDS 3456
#define XB_SPIN_CAP (1u << 22)
constexpr int XB_LDS_OFF = 143344;
__device__ __forceinline__ unsigned xb_ld(unsigned* p)              { return __hip_atomic_load(p, __ATOMIC_RELAXED, __HIP_MEMORY_SCOPE_AGENT); }
__device__ __forceinline__ unsigned xb_add(unsigned* p, unsigned v) { return __hip_atomic_fetch_add(p, v, __ATOMIC_RELAXED, __HIP_MEMORY_SCOPE_AGENT); }
__device__ __forceinline__ unsigned xb_xcc_id() { return (unsigned)__builtin_amdgcn_s_getreg((3 << 11) | 20) & 0xFu; }
#define XB_SPIN(cond, bar) do { unsigned _sp = 0; while (cond) { __builtin_amdgcn_s_sleep(1); \
    if ((++_sp & 255u) == 0u) { if (xb_ld(&(bar)[XB_TMO])) break; if (_sp > XB_SPIN_CAP) { atomicAdd(&(bar)[XB_TMO], 1u); break; } } } } while (0)
__device__ __forceinline__ void xb_complete(unsigned* bar, unsigned x, unsigned G, unsigned& nloc, unsigned& nx) {
    unsigned sum, cnt, mine, sp = 0u;
    for (;;) {
        sum = 0u; cnt = 0u; mine = 0u;
#pragma unroll
        for (unsigned j = 0; j < 16; ++j) { const unsigned c = xb_ld(&bar[XB_XCNT(j)]); sum += c; cnt += (c > 0u) ? 1u : 0u; mine = (j == x) ? c : mine; }
        if (sum == G) break;
        __builtin_amdgcn_s_sleep(1);
        if ((++sp & 255u) == 0u) { if (xb_ld(&bar[XB_TMO])) break; if (sp > XB_SPIN_CAP) { atomicAdd(&bar[XB_TMO], 1u); break; } }
    }
    nloc = mine > 0u ? mine : 1u; nx = cnt > 0u ? cnt : 1u;
}
__device__ __forceinline__ void xb_post(unsigned char* smem) {
    CParams& p = KPL(); const Ctx cx = mkctx();
    volatile LAS unsigned* st = (volatile LAS unsigned*)((LAS unsigned char*)smem + XB_LDS_OFF);
    if (cx.tid == 0) { st[0] = 0u; st[1] = 0u; (void)xb_add(&((unsigned*)(p.ws + OFF_BAR))[XB_XCNT(xb_xcc_id())], 1u); }
    __syncthreads();
}
__device__ __forceinline__ void xsync(unsigned char* smem) {
    CParams& p = KPL(); const Ctx cx = mkctx();
    asm volatile("s_waitcnt vmcnt(0)" ::: "memory");
    __syncthreads();
    if (cx.tid == 0) {
        unsigned* bar = (unsigned*)(p.ws + OFF_BAR);
        volatile LAS unsigned* st = (volatile LAS unsigned*)((LAS unsigned char*)smem + XB_LDS_OFF);
        const unsigned x = xb_xcc_id();
        __builtin_amdgcn_s_waitcnt(0);
        unsigned nloc = st[0], nx = st[1];
        if (nloc == 0u) { xb_complete(bar, x, (unsigned)cx.nb, nloc, nx); st[0] = nloc; st[1] = nx; }
        const unsigned old = xb_add(&bar[XB_XSUB(x)], 1u);
        const unsigned gen = old / nloc;
        if (old + 1u == (gen + 1u) * nloc) {
            __builtin_amdgcn_fence(__ATOMIC_RELEASE, "agent");
            asm volatile("s_waitcnt vmcnt(0)" ::: "memory");
            const unsigned og = xb_add(&bar[XB_TOP], 1u);
            const unsigned tg = og / nx;
            if (og + 1u == (tg + 1u) * nx) xb_add(&bar[XB_TOPGEN], 1u);
            else XB_SPIN(xb_ld(&bar[XB_TOPGEN]) == tg, bar);
            __builtin_amdgcn_fence(__ATOMIC_ACQUIRE, "agent");
            xb_add(&bar[XB_XGEN(x)], 1u);
            asm volatile("s_waitcnt vmcnt(0)" ::: "memory");
        } else {
            XB_SPIN(xb_ld(&bar[XB_XGEN(x)]) == gen, bar);
            __builtin_amdgcn_fence(__ATOMIC_ACQUIRE, "agent");
            asm volatile("s_waitcnt vmcnt(0)" ::: "memory");
        }
    }
    __syncthreads();
}

__device__ __forceinline__ void s5_side_barrier(int l, int which) {
    CParams& p = KPL(); const Ctx cx = mkctx();
    const int b0 = cx.nb >= 2 ? cx.nb / 2 : 0;
    if (cx.bid < b0) return;
    unsigned* ctr = (unsigned*)(p.ws + OFF_BAR) + 3700 + l * 16 + which * 8;
    const unsigned target = (unsigned)(cx.nb - b0);
    asm volatile("s_waitcnt vmcnt(0)" ::: "memory");
    __syncthreads();
    if (cx.tid == 0) {
        __builtin_amdgcn_fence(__ATOMIC_RELEASE, "agent");
        asm volatile("s_waitcnt vmcnt(0)" ::: "memory");
        (void)xb_add(ctr, 1u);
        unsigned sp = 0u;
        while (xb_ld(ctr) < target) { __builtin_amdgcn_s_sleep(2); if (++sp > (1u << 24)) break; }
        __builtin_amdgcn_fence(__ATOMIC_ACQUIRE, "agent");
        asm volatile("s_waitcnt vmcnt(0)" ::: "memory");
    }
    __syncthreads();
}

#ifndef PHM
#define PHM 0xFFFFFFFFull
#endif
#ifndef PHR
#define PHR 0ull
#endif
#ifndef SYNCREP
#define SYNCREP 1
#endif
template <int WHICH>
__device__ __forceinline__ void gemm_stage(int l, LAS unsigned char* lds) {
    CParams& p = KPL(); const Ctx cx = mkctx();
    const int sk = (l == NLAYER - 1) ? 1 : 0;
    unsigned char* ws = p.ws;
    float* X = (float*)(ws + OFF_X); bf16_t* H = (bf16_t*)(ws + OFF_H); bf16_t* ZA = (bf16_t*)(ws + OFF_Z); bf16_t* ZRW = (bf16_t*)(ws + OFF_ZRW);
    bf16_t* W = (bf16_t*)(ws + OFF_W);
    const float* MODL = (const float*)(ws + OFF_MOD) + (size_t)l * 3 * 6144;
    if constexpr (WHICH == 0) run_gemm8(cx, lds, H, W + W_MIX / 2, 4096, 1024, FInproj8{ZA, (float*)(ws + OFF_MLG), ZRW});
    else if constexpr (WHICH == 1) run_gemm8(cx, lds, (const bf16_t*)(ws + OFF_ZG), W + W_GLU / 2, 512, 512, FGlu8{(const bf16_t*)(ws + OFF_ZG), p.in[18] + l * 512, (bf16_t*)(ws + OFF_YA)});
    else if constexpr (WHICH == 2) run_gemm_epi(cx, lds, (const bf16_t*)(ws + OFF_LORAIN), W + W_LORA / 2, 2560, 256, EpiLora{p.in[25] + l * 1024, p.in[27] + l * 1024, ZA, ZRW, (bf16_t*)(ws + OFF_U0)});
    else if constexpr (WHICH == 3) run_gemm8(cx, lds, H, W + W_GATE / 2, 3072, 1024, FGate8{ZA}, sk);
    else if constexpr (WHICH == 4) run_gemm8(cx, lds, (const bf16_t*)(ws + OFF_YA), W + W_PA / 2, 1024, 512, FMerge8<0>{ZA, H}, sk);
    else if constexpr (WHICH == 5) run_gemm8(cx, lds, (const bf16_t*)(ws + OFF_YB), W + W_PB / 2, 1024, 512, FMerge8<1>{ZA, H}, sk);
    else if constexpr (WHICH == 6) run_gemm8(cx, lds, (const bf16_t*)(ws + OFF_YC), W + W_PC / 2, 1024, 512, FMerge8<2>{ZA, H}, sk);
    else if constexpr (WHICH == 7) run_gemm(cx, lds, H, W + W_OUT / 2, 1024, 1024, FResid{X, MODL, 2}, sk);
    else if constexpr (WHICH == 8) run_gemm8(cx, lds, H, W + W_1 / 2, 4096, 1024, FMlp18{ZA}, sk);
    else run_gemm(cx, lds, ZA, W + W_2 / 2, 1024, 4096, FResid{X, MODL, 5}, sk);
}

template <int l>
__device__ __forceinline__ void run_layer(cg::grid_group& grid, LAS unsigned char* lds, float* smf, unsigned char* smem) {
        if constexpr (l == 0) phase_wconv<0>(l, smf); else phase_wconv<1>(l, smf);
        __syncthreads();
        if constexpr ((PHM >> 2) & 1) { phase_norm(l, 0, l == 0); if constexpr ((PHR >> 2) & 1) { __syncthreads(); phase_norm(l, 0, l == 0); } }
        for (int sr = 0; sr < SYNCREP; ++sr) xsync(smem);
        if constexpr ((PHM >> 3) & 1) { gemm_stage<0>(l, lds); if constexpr ((PHR >> 3) & 1) { __syncthreads(); gemm_stage<0>(l, lds); } }
        for (int sr = 0; sr < SYNCREP; ++sr) xsync(smem);
        if constexpr ((PHM >> 5) & 1) { phase_ml_conv(l); if constexpr ((PHR >> 5) & 1) { __syncthreads(); phase_ml_conv(l); } }
        for (int sr = 0; sr < SYNCREP; ++sr) xsync(smem);
        if constexpr ((PHM >> 7) & 1) { phase_ml_local(l, smem); if constexpr ((PHR >> 7) & 1) { __syncthreads(); phase_ml_local(l, smem); } }
        for (int sr = 0; sr < SYNCREP; ++sr) xsync(smem);
        if constexpr ((PHM >> 9) & 1) { phase_ml_carry(); if constexpr ((PHR >> 9) & 1) { __syncthreads(); phase_ml_carry(); } }
        for (int sr = 0; sr < SYNCREP; ++sr) xsync(smem);
        if constexpr ((PHM >> 11) & 1) { phase_ml_out(l, smem); if constexpr ((PHR >> 11) & 1) { __syncthreads(); phase_ml_out(l, smem); } }
        for (int sr = 0; sr < SYNCREP; ++sr) xsync(smem);
        if constexpr ((PHM >> 12) & 1) { phase_rw_feat(l); if constexpr ((PHR >> 12) & 1) { __syncthreads(); phase_rw_feat(l); } }
        for (int sr = 0; sr < SYNCREP; ++sr) xsync(smem);
        if constexpr ((PHM >> 13) & 1) { gemm_stage<2>(l, lds); if constexpr ((PHR >> 13) & 1) { __syncthreads(); gemm_stage<2>(l, lds); } }
        for (int sr = 0; sr < SYNCREP; ++sr) xsync(smem);
        phase_rw_scan(l, smem);
        phase_s5_local(l);
        s5_side_barrier(l, 0);
        phase_s5_carry(l);
        s5_side_barrier(l, 1);
        phase_s5_final(l, smf);
        for (int sr = 0; sr < SYNCREP; ++sr) xsync(smem);
        gemm_stage<1>(l, lds);
        if constexpr ((PHM >> 15) & 1) { phase_rw_out(l); if constexpr ((PHR >> 15) & 1) { __syncthreads(); phase_rw_out(l); } }
        for (int sr = 0; sr < SYNCREP; ++sr) xsync(smem);
        if constexpr ((PHM >> 17) & 1) { gemm_stage<3>(l, lds); if constexpr ((PHR >> 17) & 1) { __syncthreads(); gemm_stage<3>(l, lds); } }
        for (int sr = 0; sr < SYNCREP; ++sr) xsync(smem);
        if constexpr ((PHM >> 18) & 1) { gemm_stage<4>(l, lds); if constexpr ((PHR >> 18) & 1) { __syncthreads(); gemm_stage<4>(l, lds); } }
        if constexpr ((PHM >> 19) & 1) { gemm_stage<5>(l, lds); if constexpr ((PHR >> 19) & 1) { __syncthreads(); gemm_stage<5>(l, lds); } }
        if constexpr ((PHM >> 20) & 1) { gemm_stage<6>(l, lds); if constexpr ((PHR >> 20) & 1) { __syncthreads(); gemm_stage<6>(l, lds); } }
        for (int sr = 0; sr < SYNCREP; ++sr) xsync(smem);
        if constexpr ((PHM >> 21) & 1) { gemm_stage<7>(l, lds); if constexpr ((PHR >> 21) & 1) { __syncthreads(); gemm_stage<7>(l, lds); } }
        for (int sr = 0; sr < SYNCREP; ++sr) xsync(smem);
        if constexpr ((PHM >> 22) & 1) { phase_norm(l, 1, false); if constexpr ((PHR >> 22) & 1) { __syncthreads(); phase_norm(l, 1, false); } }
        for (int sr = 0; sr < SYNCREP; ++sr) xsync(smem);
        if constexpr ((PHM >> 23) & 1) { gemm_stage<8>(l, lds); if constexpr ((PHR >> 23) & 1) { __syncthreads(); gemm_stage<8>(l, lds); } }
        for (int sr = 0; sr < SYNCREP; ++sr) xsync(smem);
        gemm_stage<9>(l, lds);
        if constexpr (l < NLAYER - 1) { __syncthreads(); phase_wconv<2>(l + 1, smf); }
        for (int sr = 0; sr < SYNCREP; ++sr) xsync(smem);
    }

__global__ void __launch_bounds__(512, 2) fwd_megakernel(Params p_unused) {
    extern __shared__ __attribute__((aligned(16))) unsigned char smem[];
    cg::grid_group grid = cg::this_grid();
    LAS unsigned char* lds = (LAS unsigned char*)smem;
    float* smf = (float*)smem;

    xb_post(smem);
    phase_mod(smf); phase_s5_params();
    grid.sync();
    run_layer<0>(grid, lds, smf, smem);
    run_layer<1>(grid, lds, smf, smem);
    run_layer<2>(grid, lds, smf, smem);
    run_layer<3>(grid, lds, smf, smem);
    phase_final();
}

extern "C" void kernel_launch(void* const* d_in, const int* in_sizes, int n_in, void* d_out, int out_size, void* d_ws, size_t ws_size, hipStream_t stream) {
    static int grid_blocks = 0;
    if (grid_blocks == 0) {
        if (n_in != 42 || ws_size < WS_END) { fprintf(stderr, "kernel_launch: unexpected n_in %d / ws_size %zu\n", n_in, ws_size); grid_blocks = -1; return; }
        int dev = 0, cus = 0, per_cu = 0;
        (void)hipGetDevice(&dev);
        (void)hipDeviceGetAttribute(&cus, hipDeviceAttributeMultiprocessorCount, dev);
        if (hipFuncSetAttribute((const void*)fwd_megakernel, hipFuncAttributeMaxDynamicSharedMemorySize, LDS_BYTES) != hipSuccess) { fprintf(stderr, "kernel_launch: hipFuncSetAttribute failed\n"); grid_blocks = -1; return; }
        if (hipOccupancyMaxActiveBlocksPerMultiprocessor(&per_cu, (const void*)fwd_megakernel, 512, LDS_BYTES) != hipSuccess || per_cu < 1) { fprintf(stderr, "kernel_launch: occupancy query says %d\n", per_cu); per_cu = 1; (void)hipGetLastError(); }
        grid_blocks = cus * 1;
    }
    if (grid_blocks < 0) return;
    if (hipMemsetAsync((unsigned char*)d_ws + OFF_BAR, 0, 16384, stream) != hipSuccess) { fprintf(stderr, "kernel_launch: memset failed\n"); return; }
    Params p{};
    for (int i = 0; i < 42; ++i) p.in[i] = (const float*)d_in[i];
    p.out = (float*)d_out; p.ws = (unsigned char*)d_ws;
    void* args[] = {&p};
    hipError_t e = hipLaunchCooperativeKernel((const void*)fwd_megakernel, dim3(grid_blocks), dim3(512), args, LDS_BYTES, stream);
    if (e != hipSuccess) fprintf(stderr, "cooperative launch failed: %s (grid %d)\n", hipGetErrorString(e), grid_blocks);
}
```

```cpp
#include <hip/hip_runtime.h>
#include <hip/hip_cooperative_groups.h>
#include <cstdio>
namespace cg = cooperative_groups;

#define LAS __attribute__((address_space(3)))
typedef unsigned short bf16_t;
typedef short bf16x8 __attribute__((ext_vector_type(8)));
typedef float f32x4 __attribute__((ext_vector_type(4)));
typedef unsigned u32x4 __attribute__((ext_vector_type(4)));
typedef unsigned u32x2 __attribute__((ext_vector_type(2)));

constexpr int T_TOK = 16896, SEQA = 8448, NCTX = 256;
constexpr int NLAYER = 4;
constexpr int LDS_BYTES = 143360;
constexpr size_t OFF_X = 0;
constexpr size_t OFF_H = 69206016;
constexpr size_t OFF_Z = 103809024;
constexpr size_t OFF_ZRW = OFF_Z + 69206016;
constexpr size_t OFF_MLG = 242221056;
constexpr size_t OFF_W = 243302400;
constexpr size_t OFF_YA = 281837568;
constexpr size_t OFF_YB = 299139072;
constexpr size_t OFF_YC = 316440576;
constexpr size_t OFF_F1 = 333742080;
constexpr size_t OFF_MOD = 402948096;
constexpr size_t OFF_S5P = 403243008;
constexpr size_t OFF_MLS = OFF_S5P + 4 * 589824;
constexpr size_t OFF_R2 = OFF_MLS + 16384;
constexpr size_t OFF_BAR = OFF_R2 + 34603008;
constexpr size_t OFF_S5ST = OFF_BAR + 16384;
constexpr size_t WS_END = OFF_S5ST + 8650752;
constexpr size_t OFF_CLOC = OFF_F1;
constexpr size_t OFF_U0 = OFF_ZRW + 17301504;
constexpr size_t OFF_QKC = OFF_F1 + 43524096;
constexpr size_t OFF_ZG = OFF_ZRW + 34603008;
constexpr size_t OFF_LORAIN = OFF_R2 + 17301504;
constexpr size_t W_MIX = 0, W_GATE = 8388608, W_GLU = 14680064, W_LORA = 15204352, W_PA = 16515072, W_PB = 17563648, W_PC = 18612224, W_OUT = 19660800, W_1 = 21757952, W_2 = 30146560;

struct Params {
    const float* in[42];
    float* out;
    unsigned char* ws;
};

typedef const __attribute__((address_space(4))) Params CParams;
__device__ __forceinline__ CParams& KPL() {
    unsigned long long a = (unsigned long long)__builtin_amdgcn_kernarg_segment_ptr();
    asm volatile("" : "+s"(a));
    return *(CParams*)a;
}
struct Ctx { int tid, bid, nb; };
__device__ __forceinline__ Ctx mkctx() { Ctx c; c.tid = threadIdx.x; c.bid = blockIdx.x; c.nb = gridDim.x; asm volatile("" : "+v"(c.tid), "+s"(c.bid), "+s"(c.nb)); return c; }
__device__ __forceinline__ float bf2f(unsigned v) { return __uint_as_float(v << 16); }
__device__ __forceinline__ float bflo(unsigned w) { return __uint_as_float(w << 16); }
__device__ __forceinline__ float bfhi(unsigned w) { return __uint_as_float(w & 0xffff0000u); }
__device__ __forceinline__ bf16_t f2bf(float f) { unsigned u = __float_as_uint(f); u += 0x7FFFu + ((u >> 16) & 1u); return (bf16_t)(u >> 16); }
__device__ __forceinline__ unsigned pk2(float lo, float hi) { return (unsigned)f2bf(lo) | ((unsigned)f2bf(hi) << 16); }
__device__ __forceinline__ void store4bf(bf16_t* p, f32x4 v) { u32x2 r; r.x = pk2(v[0], v[1]); r.y = pk2(v[2], v[3]); *(u32x2*)p = r; }
__device__ __forceinline__ float sigmoidf_(float x) { return 1.f / (1.f + __expf(-x)); }

#define DPP_F(x, ctrl, rmask) __int_as_float(__builtin_amdgcn_update_dpp(0, __float_as_int(x), ctrl, rmask, 0xF, false))
__device__ __forceinline__ float row8_sum(float x) {
    x += DPP_F(x, 0xB1, 0xF); x += DPP_F(x, 0x4E, 0xF); x += DPP_F(x, 0x141, 0xF); return x;
}
__device__ __forceinline__ float row16_sum(float x) {
    x += DPP_F(x, 0xB1, 0xF); x += DPP_F(x, 0x4E, 0xF); x += DPP_F(x, 0x141, 0xF); x += DPP_F(x, 0x140, 0xF); return x;
}
__device__ __forceinline__ float wave_sum(float x) {
    x = row16_sum(x);
    x += DPP_F(x, 0x142, 0xA);
    x += DPP_F(x, 0x143, 0xC);
    return __int_as_float(__builtin_amdgcn_readlane(__float_as_int(x), 63));
}

namespace pg8 {
constexpr int BM = 256, BK = 64, HALF = 128, HTB = HALF * BK * 2, NXCD = 8, WGM = 8;
__device__ __forceinline__ int lds_byte(int r, int c) { const int st = (r >> 4) * 2 + (c >> 5), rr = r & 15, cc = c & 31, ob = rr * 64 + cc * 2; return st * 1024 + (ob ^ (((ob >> 9) & 1) << 5)); }
__device__ __forceinline__ void stage_rc(int b, int& R, int& C) { const int st = b / 1024, sb = b % 1024, swz = sb ^ (((sb >> 9) & 1) << 5); R = (st >> 1) * 16 + swz / 64; C = (st & 1) * 32 + (swz % 64) / 2; }
__device__ __forceinline__ int perm32(int rho) { const int n = rho >> 4, i = rho & 15; return 8 * (i >> 2) + 4 * n + (i & 3); }
struct Unit { int pm, pn; };
struct Gemm { const bf16_t* A; const bf16_t* Bt; int M, N, K; };
struct StaticOrder {
    int nM, nN, nwg, G, c, skipctx;
    __device__ void init(int M, int N, int G_, int c_, int skip_ = 0) { nM = M / BM - 2 * skip_; nN = N / BM; nwg = nM * nN; G = G_; c = c_; skipctx = skip_; }
    __device__ bool next(int i, Unit& u) const {
        const long L = (long)i * G + c; if (L >= nwg) return false;
        int wgid = (int)L; { const int q = nwg / NXCD, r = nwg % NXCD, xcd = wgid % NXCD, off = wgid / NXCD; wgid = (xcd < r ? xcd * (q + 1) : r * (q + 1) + (xcd - r) * q) + off; }
        const int nig = WGM * nN, gid = wgid / nig, fm = gid * WGM, gsz = (nM - fm) < WGM ? (nM - fm) : WGM;
        u.pm = fm + ((wgid % nig) % gsz); u.pn = (wgid % nig) / gsz;
        if (skipctx) u.pm += (u.pm >= 32) ? 2 : 1;
        return true;
    }
};

template <class Epi>
__device__ __forceinline__ void gemm_phase(int tid_in, LAS unsigned char* lds, const Gemm g, const StaticOrder& S, const Epi& E) {
    const int tid = tid_in, wid = __builtin_amdgcn_readfirstlane(tid >> 6), lane = tid & 63, wr = wid >> 2, wc = wid & 3, fr = lane & 15, fq = lane >> 4;
    const int K = g.K, nt = K / BK;
    unsigned voffA[2], voffB[2];
#pragma unroll
    for (int i = 0; i < 2; ++i) { int R, C; stage_rc(tid * 16 + i * 8192, R, C); const int Rb = Epi::PERM ? ((R & ~31) + perm32(R & 31)) : R;
        voffA[i] = (unsigned)(R * K + C) * 2u; voffB[i] = (unsigned)(Rb * K + C) * 2u; }
    const size_t kstep = (size_t)(BK * 2);
    const size_t hstep = (size_t)HALF * K * 2;
    const size_t tstep = 2 * hstep;
    const unsigned ldsw = (unsigned)wid * 1024u;
    const int aoff = lds_byte(wr * 64 + fr, fq * 8), boff = lds_byte(wc * 32 + fr, fq * 8);
#define PG8_SA(b, h) (((b) * 2 + (h)) * HTB)
#define PG8_SB(b, h) ((4 + (b) * 2 + (h)) * HTB)
#define PG8_STAGE(bufoff, gbase, voff) do { _Pragma("unroll") for (int _i = 0; _i < 2; ++_i) \
        __builtin_amdgcn_global_load_lds((const unsigned*)((const char*)(gbase) + (voff)[_i]), (LAS unsigned*)(lds + (bufoff) + ldsw + _i * 8192), 16, 0, 0); } while (0)
#define PG8_LDA(dst, b, h) do { _Pragma("unroll") for (int m = 0; m < 4; ++m) _Pragma("unroll") for (int k = 0; k < 2; ++k) dst[m][k] = *(const LAS bf16x8*)(lds + PG8_SA(b, h) + aoff + m * 2048 + k * 1024); } while (0)
#define PG8_LDB(dst, b, h) do { _Pragma("unroll") for (int n = 0; n < 2; ++n) _Pragma("unroll") for (int k = 0; k < 2; ++k) dst[n][k] = *(const LAS bf16x8*)(lds + PG8_SB(b, h) + boff + n * 2048 + k * 1024); } while (0)
#define PG8_MMA(ai, bj, At, Bt) do { __builtin_amdgcn_s_setprio(1); _Pragma("unroll") for (int m = 0; m < 4; ++m) _Pragma("unroll") for (int n = 0; n < 2; ++n) _Pragma("unroll") for (int k = 0; k < 2; ++k) \
        acc[ai][bj][m][n] = __builtin_amdgcn_mfma_f32_16x16x32_bf16(Bt[n][k], At[m][k], acc[ai][bj][m][n], 0, 0, 0); __builtin_amdgcn_s_setprio(0); } while (0)
#define PG8_WAIT_V(n) asm volatile("s_waitcnt vmcnt(" #n ")" ::: "memory")
#define PG8_WAIT_L(n) asm volatile("s_waitcnt lgkmcnt(" #n ")" ::: "memory")
#define PG8_BAR __builtin_amdgcn_s_barrier()
#define PG8_SCHED __builtin_amdgcn_sched_barrier(0)
    Unit cur, nxt; int ui = 0;
    if (!S.next(0, cur)) return;
    f32x4 acc[2][2][4][2];
#pragma unroll
    for (int a = 0; a < 2; ++a)
#pragma unroll
        for (int b = 0; b < 2; ++b)
#pragma unroll
            for (int m = 0; m < 4; ++m)
#pragma unroll
                for (int n = 0; n < 2; ++n) acc[a][b][m][n] = (f32x4){0.f, 0.f, 0.f, 0.f};
    bf16x8 At[4][2], B0[2][2], B1[2][2];
    const char* cA = (const char*)g.A + (size_t)cur.pm * tstep; const char* cB = (const char*)g.Bt + (size_t)cur.pn * tstep;
    PG8_STAGE(PG8_SB(0, 0), cB, voffB); PG8_STAGE(PG8_SA(0, 0), cA, voffA); PG8_STAGE(PG8_SB(0, 1), cB + hstep, voffB); PG8_STAGE(PG8_SA(0, 1), cA + hstep, voffA);
    if (wr == 1) PG8_BAR;
    PG8_WAIT_V(4); PG8_BAR;
    PG8_STAGE(PG8_SB(1, 0), cB + kstep, voffB); PG8_STAGE(PG8_SA(1, 0), cA + kstep, voffA); PG8_STAGE(PG8_SB(1, 1), cB + hstep + kstep, voffB);
    PG8_WAIT_V(6); PG8_BAR;
    for (;;) {
        const bool has_next = S.next(ui + 1, nxt);
        const char* nA = has_next ? (const char*)g.A + (size_t)nxt.pm * tstep : cA; const char* nB = has_next ? (const char*)g.Bt + (size_t)nxt.pn * tstep : cB;
        for (int t = 0; t < nt; t += 2) {
            const bool last = (t == nt - 2);
            const char* a1 = cA + (size_t)(t + 1) * kstep;
            const char* a2 = last ? nA : cA + (size_t)(t + 2) * kstep; const char* b2 = last ? nB : cB + (size_t)(t + 2) * kstep;
            const char* a3 = a2 + kstep; const char* b3 = b2 + kstep;
            PG8_LDB(B0, 0, 0); PG8_SCHED; PG8_LDA(At, 0, 0); PG8_STAGE(PG8_SA(1, 1), a1 + hstep, voffA);
            PG8_WAIT_L(8); PG8_BAR; PG8_WAIT_L(0); PG8_MMA(0, 0, At, B0); PG8_BAR; PG8_SCHED;
            PG8_LDB(B1, 0, 1); PG8_STAGE(PG8_SB(0, 0), b2, voffB);
            PG8_BAR; PG8_WAIT_L(0); PG8_MMA(0, 1, At, B1); PG8_BAR;
            PG8_LDA(At, 0, 1); PG8_STAGE(PG8_SA(0, 0), a2, voffA);
            PG8_BAR; PG8_WAIT_L(0); PG8_MMA(1, 0, At, B0); PG8_BAR; PG8_SCHED;
            PG8_STAGE(PG8_SB(0, 1), b2 + hstep, voffB);
            PG8_WAIT_V(6); PG8_BAR; PG8_MMA(1, 1, At, B1); PG8_BAR;
            PG8_LDB(B0, 1, 0); PG8_SCHED; PG8_LDA(At, 1, 0); PG8_STAGE(PG8_SA(0, 1), a2 + hstep, voffA);
            PG8_WAIT_L(8); PG8_BAR; PG8_WAIT_L(0); PG8_MMA(0, 0, At, B0); PG8_BAR; PG8_SCHED;
            PG8_LDB(B1, 1, 1); PG8_STAGE(PG8_SB(1, 0), b3, voffB);
            PG8_BAR; PG8_WAIT_L(0); PG8_MMA(0, 1, At, B1); PG8_BAR;
            PG8_LDA(At, 1, 1); PG8_STAGE(PG8_SA(1, 0), a3, voffA);
            PG8_BAR; PG8_WAIT_L(0); PG8_MMA(1, 0, At, B0); PG8_BAR; PG8_SCHED;
            PG8_STAGE(PG8_SB(1, 1), b3 + hstep, voffB);
            PG8_WAIT_V(6); PG8_BAR; PG8_MMA(1, 1, At, B1); PG8_BAR;
        }
        E(acc, cur, wr, wc, fr, fq);
        if (!has_next) break;
#pragma unroll
        for (int a = 0; a < 2; ++a)
#pragma unroll
            for (int b = 0; b < 2; ++b)
#pragma unroll
                for (int m = 0; m < 4; ++m)
#pragma unroll
                    for (int n = 0; n < 2; ++n) acc[a][b][m][n] = (f32x4){0.f, 0.f, 0.f, 0.f};
        cur = nxt; cA = nA; cB = nB; ++ui;
    }
    PG8_WAIT_V(0);
    if (wr == 0) PG8_BAR;
    PG8_BAR;
#undef PG8_SA
#undef PG8_SB
#undef PG8_STAGE
#undef PG8_LDA
#undef PG8_LDB
#undef PG8_MMA
#undef PG8_WAIT_V
#undef PG8_WAIT_L
#undef PG8_BAR
#undef PG8_SCHED
}

template <class F> struct EpiT {
    static constexpr bool PERM = false;
    F f;
    __device__ __forceinline__ void operator()(const f32x4 (&acc)[2][2][4][2], const Unit& u, int wr, int wc, int fr, int fq) const {
        const int row0 = u.pm * BM + wr * 64 + fr, col0 = u.pn * BM + wc * 32 + 4 * fq;
#pragma unroll
        for (int ai = 0; ai < 2; ++ai)
#pragma unroll
            for (int m = 0; m < 4; ++m) {
                const int row = row0 + ai * HALF + m * 16;
#pragma unroll
                for (int bj = 0; bj < 2; ++bj)
#pragma unroll
                    for (int n = 0; n < 2; ++n) f(row, col0 + bj * HALF + n * 16, acc[ai][bj][m][n]);
            }
    }
};
template <class F> struct EpiT8 {
    static constexpr bool PERM = true;
    F f;
    __device__ __forceinline__ void operator()(const f32x4 (&acc)[2][2][4][2], const Unit& u, int wr, int wc, int fr, int fq) const {
        const int row0 = u.pm * BM + wr * 64 + fr, col0 = u.pn * BM + wc * 32 + 8 * fq;
#pragma unroll
        for (int ai = 0; ai < 2; ++ai)
#pragma unroll
            for (int m = 0; m < 4; ++m) {
                const int row = row0 + ai * HALF + m * 16;
#pragma unroll
                for (int bj = 0; bj < 2; ++bj) f(row, col0 + bj * HALF, acc[ai][bj][m][0], acc[ai][bj][m][1]);
            }
    }
};
}

template <class F>
__device__ __forceinline__ void run_gemm(const Ctx& cx, LAS unsigned char* lds, const bf16_t* A, const bf16_t* Bt, int N, int K, const F& f, int skip = 0) {
    pg8::Gemm g; g.A = A; g.Bt = Bt; g.M = T_TOK; g.N = N; g.K = K;
    pg8::StaticOrder S; S.init(T_TOK, N, cx.nb, cx.bid, skip);
    pg8::EpiT<F> E{f};
    pg8::gemm_phase(cx.tid, lds, g, S, E);
}

template <class F>
__device__ __forceinline__ void run_gemm8(const Ctx& cx, LAS unsigned char* lds, const bf16_t* A, const bf16_t* Bt, int N, int K, const F& f, int skip = 0) {
    pg8::Gemm g; g.A = A; g.Bt = Bt; g.M = T_TOK; g.N = N; g.K = K;
    pg8::StaticOrder S; S.init(T_TOK, N, cx.nb, cx.bid, skip);
    pg8::EpiT8<F> E{f};
    pg8::gemm_phase(cx.tid, lds, g, S, E);
}

template <class E>
__device__ __forceinline__ void run_gemm_epi(const Ctx& cx, LAS unsigned char* lds, const bf16_t* A, const bf16_t* Bt, int N, int K, const E& e) {
    pg8::Gemm g; g.A = A; g.Bt = Bt; g.M = T_TOK; g.N = N; g.K = K;
    pg8::StaticOrder S; S.init(T_TOK, N, cx.nb, cx.bid);
    pg8::gemm_phase(cx.tid, lds, g, S, e);
}
__device__ __forceinline__ int row_vec(int row) { const int b = row >= SEQA ? 1 : 0; const int t = row - b * SEQA; return t < NCTX ? 2 : b; }

struct FInproj { bf16_t* za; float* mlg; bf16_t* zrw;
    __device__ __forceinline__ void operator()(int row, int col, f32x4 v) const {
        if (col < 2048) store4bf(za + (size_t)row * 2048 + col, v);
        else if (col < 2064) *(f32x4*)(mlg + (size_t)row * 16 + (col - 2048)) = v;
        else if (col < 3856) store4bf(zrw + (size_t)row * 1792 + (col - 2064), v);
    } };
__device__ __forceinline__ void store8bf(bf16_t* p, f32x4 a, f32x4 b) { u32x4 r; r.x = pk2(a[0], a[1]); r.y = pk2(a[2], a[3]); r.z = pk2(b[0], b[1]); r.w = pk2(b[2], b[3]); *(u32x4*)p = r; }
struct FInproj8 { bf16_t* za; float* mlg; bf16_t* zrw;
    __device__ __forceinline__ void operator()(int row, int col, f32x4 a, f32x4 b) const {
        if (col < 2048) store8bf(za + (size_t)row * 2048 + col, a, b);
        else if (col < 2064) { *(f32x4*)(mlg + (size_t)row * 16 + (col - 2048)) = a; *(f32x4*)(mlg + (size_t)row * 16 + (col - 2048) + 4) = b; }
        else if (col < 3856) store8bf(zrw + (size_t)row * 1792 + (col - 2064), a, b);
    } };
struct FGate8 { bf16_t* g;
    __device__ __forceinline__ void operator()(int row, int col, f32x4 a, f32x4 b) const {
#pragma unroll
        for (int e = 0; e < 4; ++e) { a[e] = sigmoidf_(a[e]); b[e] = sigmoidf_(b[e]); }
        store8bf(g + (size_t)row * 3072 + col, a, b);
    } };
struct FMlp18 { bf16_t* hid;
    __device__ __forceinline__ void operator()(int row, int col, f32x4 a, f32x4 b) const {
#pragma unroll
        for (int e = 0; e < 4; ++e) { const float r0 = fmaxf(a[e], 0.f), r1 = fmaxf(b[e], 0.f); a[e] = r0 * r0; b[e] = r1 * r1; }
        store8bf(hid + (size_t)row * 4096 + col, a, b);
    } };
template <int J> struct FMerge8 { const bf16_t* g; bf16_t* ybf;
    __device__ __forceinline__ void operator()(int row, int col, f32x4 a, f32x4 b) const {
        const u32x4 z = *(const u32x4*)(g + (size_t)row * 3072 + J * 1024 + col);
        a[0] *= bflo(z.x); a[1] *= bfhi(z.x); a[2] *= bflo(z.y); a[3] *= bfhi(z.y); b[0] *= bflo(z.z); b[1] *= bfhi(z.z); b[2] *= bflo(z.w); b[3] *= bfhi(z.w);
        bf16_t* yp = ybf + (size_t)row * 1024 + col;
        if (J != 0) { const u32x4 t = *(const u32x4*)yp;
            a[0] += bflo(t.x); a[1] += bfhi(t.x); a[2] += bflo(t.y); a[3] += bfhi(t.y); b[0] += bflo(t.z); b[1] += bfhi(t.z); b[2] += bflo(t.w); b[3] += bfhi(t.w); }
        store8bf(yp, a, b);
    } };
struct FGlu8 { const bf16_t* zg; const float* bglu; bf16_t* ya;
    __device__ __forceinline__ void operator()(int row, int col, f32x4 a, f32x4 b) const {
        const u32x4 z = *(const u32x4*)(zg + (size_t)row * 512 + col); const f32x4 b0 = *(const f32x4*)(bglu + col), b1 = *(const f32x4*)(bglu + col + 4);
        f32x4 oa, ob;
        oa[0] = bflo(z.x) * sigmoidf_(a[0] + b0[0]); oa[1] = bfhi(z.x) * sigmoidf_(a[1] + b0[1]); oa[2] = bflo(z.y) * sigmoidf_(a[2] + b0[2]); oa[3] = bfhi(z.y) * sigmoidf_(a[3] + b0[3]);
        ob[0] = bflo(z.z) * sigmoidf_(b[0] + b1[0]); ob[1] = bfhi(z.z) * sigmoidf_(b[1] + b1[1]); ob[2] = bflo(z.w) * sigmoidf_(b[2] + b1[2]); ob[3] = bfhi(z.w) * sigmoidf_(b[3] + b1[3]);
        store8bf(ya + (size_t)row * 512 + col, oa, ob);
    } };
struct FGlu { const bf16_t* zg; const float* bglu; bf16_t* ya;
    __device__ __forceinline__ void operator()(int row, int col, f32x4 v) const {
        const u32x2 z = *(const u32x2*)(zg + (size_t)row * 512 + col); const f32x4 b = *(const f32x4*)(bglu + col);
        f32x4 o; o[0] = bflo(z.x) * sigmoidf_(v[0] + b[0]); o[1] = bfhi(z.x) * sigmoidf_(v[1] + b[1]); o[2] = bflo(z.y) * sigmoidf_(v[2] + b[2]); o[3] = bfhi(z.y) * sigmoidf_(v[3] + b[3]);
        store4bf(ya + (size_t)row * 512 + col, o);
    } };
struct EpiLora { static constexpr bool PERM = false; const float* w0; const float* a0; bf16_t* f2; bf16_t* grw; bf16_t* u0;
    __device__ __forceinline__ void operator()(const f32x4 (&acc)[2][2][4][2], const pg8::Unit& u, int wr, int wc, int fr, int fq) const {
        const int row0 = u.pm * 256 + wr * 64 + fr, col0 = u.pn * 256 + wc * 32 + 4 * fq;
        const int pn = __builtin_amdgcn_readfirstlane(u.pn);
        if (pn < 8) {
            const float* bias = pn < 4 ? w0 : a0 - 1024;
#pragma unroll
            for (int bj = 0; bj < 2; ++bj)
#pragma unroll
                for (int n = 0; n < 2; ++n) {
                    const int col = col0 + bj * 128 + n * 16;
                    const f32x4 b = *(const f32x4*)(bias + col);
#pragma unroll
                    for (int ai = 0; ai < 2; ++ai)
#pragma unroll
                        for (int m = 0; m < 4; ++m) {
                            const int row = row0 + ai * 128 + m * 16; f32x4 o;
#pragma unroll
                            for (int e = 0; e < 4; ++e) { const float s = sigmoidf_(acc[ai][bj][m][n][e] + b[e]); o[e] = pn < 4 ? 1.f - __expf(-0.60653065971f * s) : s; }
                            if (pn < 2) store4bf(u0 + (size_t)row * 512 + col, o); else store4bf(f2 + (size_t)row * 2048 + col, o);
                        }
                }
        } else {
#pragma unroll
            for (int ai = 0; ai < 2; ++ai)
#pragma unroll
                for (int m = 0; m < 4; ++m) { const int row = row0 + ai * 128 + m * 16;
#pragma unroll
                    for (int bj = 0; bj < 2; ++bj)
#pragma unroll
                        for (int n = 0; n < 2; ++n) store4bf(grw + (size_t)row * 512 + (col0 + bj * 128 + n * 16 - 2048), acc[ai][bj][m][n]); }
        }
    } };
struct FGate { bf16_t* g;
    __device__ __forceinline__ void operator()(int row, int col, f32x4 v) const {
        f32x4 o; o[0] = sigmoidf_(v[0]); o[1] = sigmoidf_(v[1]); o[2] = sigmoidf_(v[2]); o[3] = sigmoidf_(v[3]);
        store4bf(g + (size_t)row * 3072 + col, o);
    } };
template <int J> struct FMerge { const bf16_t* g; float* y32; bf16_t* ybf;
    __device__ __forceinline__ void operator()(int row, int col, f32x4 v) const {
        const u32x2 z = *(const u32x2*)(g + (size_t)row * 3072 + J * 1024 + col);
        f32x4 o; o[0] = bflo(z.x) * v[0]; o[1] = bfhi(z.x) * v[1]; o[2] = bflo(z.y) * v[2]; o[3] = bfhi(z.y) * v[3];
        bf16_t* yp = ybf + (size_t)row * 1024 + col;
        if (J != 0) { const u32x2 t = *(const u32x2*)yp; o[0] += bflo(t.x); o[1] += bfhi(t.x); o[2] += bflo(t.y); o[3] += bfhi(t.y); }
        store4bf(yp, o);
    } };
struct FResid { float* x; const float* modl; int chunk;
    __device__ __forceinline__ void operator()(int row, int col, f32x4 v) const {
        const f32x4 mg = *(const f32x4*)(modl + row_vec(row) * 6144 + chunk * 1024 + col);
        float* xp = x + (size_t)row * 1024 + col; f32x4 t = *(f32x4*)xp; *(f32x4*)xp = t + mg * v;
    } };
struct FMlp1 { bf16_t* hid;
    __device__ __forceinline__ void operator()(int row, int col, f32x4 v) const {
        f32x4 o;
#pragma unroll
        for (int e = 0; e < 4; ++e) { const float r = fmaxf(v[e], 0.f); o[e] = r * r; }
        store4bf(hid + (size_t)row * 4096 + col, o);
    } };

__device__ __forceinline__ void phase_mod(float* smf) {
    CParams& p = KPL(); const Ctx cx = mkctx();
    const int tid = cx.tid, lane = tid & 63, wid = tid >> 6;
    float* sc = smf; float* red = smf + 3072;
    float* MOD = (float*)(p.ws + OFF_MOD);
    for (int i = tid; i < 3072; i += 512) { const int v = i >> 10, j = i & 1023; const float c = v < 2 ? p.in[1][v * 1024 + j] : p.in[3][j]; sc[i] = c / (1.f + expf(-c)); }
    __syncthreads();
    for (int item = cx.bid; item < 4 * 96; item += cx.nb) {
        const int l = item / 96, jt = item % 96, j = jt * 64 + lane;
        const float* w = p.in[4] + (size_t)l * 1024 * 6144 + j;
        float a0 = 0.f, a1 = 0.f, a2 = 0.f;
#pragma unroll 16
        for (int i = wid * 128; i < wid * 128 + 128; ++i) { const float wv = w[(size_t)i * 6144]; a0 += sc[i] * wv; a1 += sc[1024 + i] * wv; a2 += sc[2048 + i] * wv; }
        red[(wid * 3 + 0) * 64 + lane] = a0; red[(wid * 3 + 1) * 64 + lane] = a1; red[(wid * 3 + 2) * 64 + lane] = a2;
        __syncthreads();
        if (tid < 192) { const int v = tid >> 6; float s = 0.f;
            for (int w8 = 0; w8 < 8; ++w8) s += red[(w8 * 3 + v) * 64 + lane];
            MOD[(l * 3 + v) * 6144 + j] = s + p.in[5][l * 6144 + j]; }
        __syncthreads();
    }
}

__device__ __forceinline__ void dsincos(double x, double& s, double& c) {
    const double k = rint(x * 0.63661977236758134308);
    double r = fma(-k, 1.57079632679489655800, x); r = fma(-k, 6.12323399573676603587e-17, r);
    const double r2 = r * r;
    double ps = -1.0 / 355687428096000.0;
    ps = fma(ps, r2, 1.0 / 1307674368000.0); ps = fma(ps, r2, -1.0 / 6227020800.0); ps = fma(ps, r2, 1.0 / 39916800.0); ps = fma(ps, r2, -1.0 / 362880.0);
    ps = fma(ps, r2, 1.0 / 5040.0); ps = fma(ps, r2, -1.0 / 120.0); ps = fma(ps, r2, 1.0 / 6.0); ps = fma(ps, r2, -1.0); ps = -ps * r;
    double pc = 1.0 / 20922789888000.0;
    pc = fma(pc, r2, -1.0 / 87178291200.0); pc = fma(pc, r2, 1.0 / 479001600.0); pc = fma(pc, r2, -1.0 / 3628800.0); pc = fma(pc, r2, 1.0 / 40320.0);
    pc = fma(pc, r2, -1.0 / 720.0); pc = fma(pc, r2, 1.0 / 24.0); pc = fma(pc, r2, -0.5); pc = fma(pc, r2, 1.0);
    const int q = ((int)k) & 3;
    s = (q == 0) ? ps : (q == 1) ? pc : (q == 2) ? -ps : -pc;
    c = (q == 0) ? pc : (q == 1) ? -ps : (q == 2) ? -pc : ps;
}
__device__ __forceinline__ double dexp_neg(double x) {
    const double k = rint(x * 1.44269504088896338700);
    double r = fma(-k, 0.693147180369123816490, x); r = fma(-k, 1.90821492927058770002e-10, r);
    double pe = 1.0 / 6227020800.0;
    pe = fma(pe, r, 1.0 / 479001600.0); pe = fma(pe, r, 1.0 / 39916800.0); pe = fma(pe, r, 1.0 / 3628800.0); pe = fma(pe, r, 1.0 / 362880.0); pe = fma(pe, r, 1.0 / 40320.0);
    pe = fma(pe, r, 1.0 / 5040.0); pe = fma(pe, r, 1.0 / 720.0); pe = fma(pe, r, 1.0 / 120.0); pe = fma(pe, r, 1.0 / 24.0); pe = fma(pe, r, 1.0 / 6.0); pe = fma(pe, r, 0.5);
    pe = fma(pe, r, 1.0); pe = fma(pe, r, 1.0);
    int ki = (int)k; if (ki < -1000) return 0.0;
    return pe * __longlong_as_double((long long)(1023 + ki) << 52);
}

__device__ __forceinline__ void wconv_tile(const Ctx& cx, const float* src, int ld, int K, int c0, int ncols, bf16_t* dst, int kt, int nt, float* tile) {
    const int tid = cx.tid, j = tid & 63, i0 = tid >> 6;
#pragma unroll
    for (int e = 0; e < 8; ++e) { const int i = i0 + 8 * e; const int n = nt * 64 + j;
        tile[i * 65 + j] = (n < ncols) ? src[(size_t)(kt * 64 + i) * ld + c0 + n] : 0.f; }
    __syncthreads();
#pragma unroll
    for (int e = 0; e < 8; ++e) { const int jj = i0 + 8 * e;
        dst[(size_t)(nt * 64 + jj) * K + kt * 64 + j] = f2bf(tile[j * 65 + jj]); }
    __syncthreads();
}

template <int MODE>
__device__ __forceinline__ void phase_wconv(int l, float* smf) {
    CParams& p = KPL(); const Ctx cx = mkctx();
    bf16_t* W = (bf16_t*)(p.ws + OFF_W);
    const int tid = cx.tid;
    unsigned* ticket = (unsigned*)(p.ws + OFF_BAR) + 3520 + l * 16;
    int* tslot = (int*)smf + 8192;
    for (int it = (MODE == 2 ? 0 : cx.bid); ; it += cx.nb) {
        int item;
        if (MODE == 0) { item = it; if (item >= 5184) break; }
        else if (MODE == 1) { item = 3520 + it; if (item >= 4544) break; }
        else {
            if (tid == 0) *tslot = (int)__hip_atomic_fetch_add(ticket, 1u, __ATOMIC_RELAXED, __HIP_MEMORY_SCOPE_AGENT);
            __syncthreads();
            const int q = *tslot;
            __syncthreads();
            if (q >= 4160) break;
            item = q < 3520 ? q : q + 1024;
        }
        if (item < 4544) {
            const float* src; int ld, K, c0, ncols, nN; bf16_t* dst; int t = item;
            if (t < 1024) { src = p.in[8] + (size_t)l * 1024 * 6928; ld = 6928; K = 1024; c0 = 0; ncols = 3856; nN = 64; dst = W + W_MIX / 2; }
            else if (t < 1792) { t -= 1024; src = p.in[8] + (size_t)l * 1024 * 6928; ld = 6928; K = 1024; c0 = 3856; ncols = 3072; nN = 48; dst = W + W_GATE / 2; }
            else if (t < 1856) { t -= 1792; src = p.in[17] + (size_t)l * 512 * 512; ld = 512; K = 512; c0 = 0; ncols = 512; nN = 8; dst = W + W_GLU / 2; }
            else if (t < 1984) { t -= 1856; src = p.in[35] + (size_t)l * 512 * 1024; ld = 1024; K = 512; c0 = 0; ncols = 1024; nN = 16; dst = W + W_PA / 2; }
            else if (t < 2112) { t -= 1984; src = p.in[36] + (size_t)l * 512 * 1024; ld = 1024; K = 512; c0 = 0; ncols = 1024; nN = 16; dst = W + W_PB / 2; }
            else if (t < 2240) { t -= 2112; src = p.in[37] + (size_t)l * 512 * 1024; ld = 1024; K = 512; c0 = 0; ncols = 1024; nN = 16; dst = W + W_PC / 2; }
            else if (t < 2496) { t -= 2240; src = p.in[38] + (size_t)l * 1024 * 1024; ld = 1024; K = 1024; c0 = 0; ncols = 1024; nN = 16; dst = W + W_OUT / 2; }
            else if (t < 3520) { t -= 2496; src = p.in[39] + (size_t)l * 1024 * 4096; ld = 4096; K = 1024; c0 = 0; ncols = 4096; nN = 64; dst = W + W_1 / 2; }
            else { t -= 3520; src = p.in[40] + (size_t)l * 4096 * 1024; ld = 1024; K = 4096; c0 = 0; ncols = 1024; nN = 16; dst = W + W_2 / 2; }
            const int nt = t % nN, kt = t / nN;
            wconv_tile(cx, src, ld, K, c0, ncols, dst, kt, nt, smf);
        } else {
            bf16_t* dst = W + W_LORA / 2;
#pragma unroll
            for (int q = 0; q < 2; ++q) {
                const int e = (item - 4544) * 1024 + q * 512 + tid; const int n = e >> 8, k = e & 255;
                float v = 0.f;
                if (n < 1024) { if (k < 64) v = p.in[26][(((size_t)l * 2 + (n >> 9)) * 64 + k) * 512 + (n & 511)]; }
                else if (n < 2048) { if (k >= 64 && k < 128) v = p.in[28][(((size_t)l * 2 + ((n - 1024) >> 9)) * 64 + (k - 64)) * 512 + (n & 511)]; }
                else { if (k >= 128) v = p.in[29][((size_t)l * 128 + (k - 128)) * 512 + (n - 2048)]; }
                dst[e] = f2bf(v);
            }
        }
    }
}

__device__ __forceinline__ void phase_s5_params() {
    CParams& p = KPL(); const Ctx cx = mkctx();
    for (int item = cx.bid; item < 32; item += cx.nb) {
        const int l = item >> 3;
        const int idx = (item & 7) * 512 + cx.tid;
        const int dir = idx >> 11, g = (idx >> 6) & 31;
        float* S5P = (float*)(p.ws + OFF_S5P) + (size_t)l * 147456;
        const size_t pi = (size_t)l * 4096 + idx;
        const double lre = fmin((double)p.in[9][pi], -1e-4), lim = (double)p.in[10][pi];
        const double dt = dexp_neg((double)p.in[11][(l * 2 + dir) * 32 + g]);
        const double mag = dexp_neg(lre * dt); double sn, cs; dsincos(lim * dt, sn, cs);
        const double ar = mag * cs, ai = mag * sn;
        const double den = lre * lre + lim * lim, nr = ar - 1.0;
        const double cr = (nr * lre + ai * lim) / den, ci = (ai * lre - nr * lim) / den;
        const double mag64 = dexp_neg(64.0 * lre * dt); dsincos(64.0 * lim * dt, sn, cs);
        S5P[idx] = (float)ar; S5P[4096 + idx] = (float)ai; S5P[8192 + idx] = (float)(mag64 * cs); S5P[12288 + idx] = (float)(mag64 * sn);
        float* BR = S5P + 16384; float* BI = BR + 65536;
        for (int c = 0; c < 16; ++c) { const double bre = p.in[12][pi * 16 + c], bim = p.in[13][pi * 16 + c];
            BR[(size_t)idx * 16 + c] = (float)(cr * bre - ci * bim); BI[(size_t)idx * 16 + c] = (float)(cr * bim + ci * bre); }
    }
}

__device__ __forceinline__ void phase_norm(int l, int which, bool init) {
    CParams& p = KPL(); const Ctx cx = mkctx();
    const int lane = cx.tid & 63, gw = cx.bid * 8 + (cx.tid >> 6), nw = cx.nb * 8;
    float* X = (float*)(p.ws + OFF_X); bf16_t* H = (bf16_t*)(p.ws + OFF_H);
    const float* MODL = (const float*)(p.ws + OFF_MOD) + (size_t)l * 3 * 6144;
    const float* gam = p.in[which ? 7 : 6] + l * 1024;
    for (int row = gw; row < T_TOK; row += nw) {
        const int b = row >= SEQA ? 1 : 0, t = row - b * SEQA;
        const float* src = init ? (t < NCTX ? p.in[2] + ((size_t)b * NCTX + t) * 1024 : p.in[0] + ((size_t)b * 8192 + (t - NCTX)) * 1024) : X + (size_t)row * 1024;
        f32x4 v[4]; float ss = 0.f;
#pragma unroll
        for (int i = 0; i < 4; ++i) { v[i] = *(const f32x4*)(src + (lane + 64 * i) * 4); ss += v[i][0] * v[i][0] + v[i][1] * v[i][1] + v[i][2] * v[i][2] + v[i][3] * v[i][3]; }
        if (init) {
#pragma unroll
            for (int i = 0; i < 4; ++i) *(f32x4*)(X + (size_t)row * 1024 + (lane + 64 * i) * 4) = v[i];
        }
        ss = wave_sum(ss);
        const float inv = rsqrtf(ss * (1.f / 1024.f) + 1e-6f);
        const float* mv = MODL + (t < NCTX ? 2 : b) * 6144 + (which ? 3 : 0) * 1024;
#pragma unroll
        for (int i = 0; i < 4; ++i) { const int c = (lane + 64 * i) * 4;
            const f32x4 g4 = *(const f32x4*)(gam + c), sh = *(const f32x4*)(mv + c), scl = *(const f32x4*)(mv + 1024 + c);
            f32x4 o;
#pragma unroll
            for (int e = 0; e < 4; ++e) o[e] = v[i][e] * inv * g4[e] * (1.f + scl[e]) + sh[e];
            store4bf(H + (size_t)row * 1024 + c, o); }
    }
}

__device__ __forceinline__ int s5_order(int dir, int i) { return dir == 0 ? i : (i < 4 ? 3 - i : 135 - i); }

__device__ __forceinline__ void phase_s5_local(int l) {
    CParams& p = KPL(); const Ctx cx = mkctx();
    const int b0 = cx.nb >= 2 ? cx.nb / 2 : 0;
    if (cx.bid < b0) return;
    const int lane = cx.tid & 63, gw = (cx.bid - b0) * 8 + (cx.tid >> 6), nw = (cx.nb - b0) * 8;
    const bf16_t* ZA = (const bf16_t*)(p.ws + OFF_Z);
    const float* S5P = (const float*)(p.ws + OFF_S5P) + (size_t)l * 147456; const float* BR = S5P + 16384; const float* BI = BR + 65536;
    float* ST = (float*)(p.ws + OFF_S5ST);
    for (int item0 = gw; item0 < 16896; item0 += nw) {
        const int item = __builtin_amdgcn_readfirstlane(item0);
        const int chunk = item % 132, g = (item / 132) & 31, dir = (item / 4224) & 1, b = item / 8448;
        const int idx = dir * 2048 + g * 64 + lane;
        const float ar = S5P[idx], ai = S5P[4096 + idx];
        float br[16], bi[16];
#pragma unroll
        for (int q = 0; q < 4; ++q) { const f32x4 t0 = *(const f32x4*)(BR + (size_t)idx * 16 + q * 4), t1 = *(const f32x4*)(BI + (size_t)idx * 16 + q * 4);
#pragma unroll
            for (int e = 0; e < 4; ++e) { br[q * 4 + e] = t0[e]; bi[q * 4 + e] = t1[e]; } }
        const int row = b * SEQA + chunk * 64 + lane;
        const u32x4 u0 = *(const u32x4*)(ZA + (size_t)row * 2048 + g * 16), u1 = *(const u32x4*)(ZA + (size_t)row * 2048 + g * 16 + 8);
        unsigned ur[8] = {u0.x, u0.y, u0.z, u0.w, u1.x, u1.y, u1.z, u1.w};
        float hr = 0.f, hi = 0.f;
#pragma unroll 8
        for (int j = 0; j < 64; ++j) {
            const int tok = dir ? 63 - j : j;
            float bur = 0.f, bui = 0.f;
#pragma unroll
            for (int q = 0; q < 8; ++q) { const unsigned w = (unsigned)__builtin_amdgcn_readlane((int)ur[q], tok); const float x0 = bflo(w), x1 = bfhi(w);
                bur += br[2 * q] * x0 + br[2 * q + 1] * x1; bui += bi[2 * q] * x0 + bi[2 * q + 1] * x1; }
            const float nr = ar * hr - ai * hi + bur, ni = ar * hi + ai * hr + bui; hr = nr; hi = ni;
        }
        float* st = ST + ((((size_t)b * 2 + dir) * 32 + g) * 132 + chunk) * 128;
        st[lane] = hr; st[64 + lane] = hi;
    }
}

__device__ __forceinline__ void phase_s5_carry(int l) {
    CParams& p = KPL(); const Ctx cx = mkctx();
    const int b0 = cx.nb >= 2 ? cx.nb / 2 : 0;
    if (cx.bid < b0) return;
    const int lane = cx.tid & 63, gw = (cx.bid - b0) * 8 + (cx.tid >> 6), nw = (cx.nb - b0) * 8;
    const float* S5P = (const float*)(p.ws + OFF_S5P) + (size_t)l * 147456;
    float* ST = (float*)(p.ws + OFF_S5ST);
    for (int item0 = gw; item0 < 128; item0 += nw) {
        const int item = __builtin_amdgcn_readfirstlane(item0);
        const int g = item & 31, dir = (item >> 5) & 1, b = item >> 6;
        const int idx = dir * 2048 + g * 64 + lane;
        const float ar = S5P[8192 + idx], ai = S5P[12288 + idx];
        float* st = ST + (((size_t)b * 2 + dir) * 32 + g) * 132 * 128;
        float hr = 0.f, hi = 0.f;
        for (int i0 = 0; i0 < 132; i0 += 12) {
            float lr[12], li[12];
#pragma unroll
            for (int e = 0; e < 12; ++e) { const int c = s5_order(dir, i0 + e); lr[e] = st[c * 128 + lane]; li[e] = st[c * 128 + 64 + lane]; }
#pragma unroll
            for (int e = 0; e < 12; ++e) { const int c = s5_order(dir, i0 + e); st[c * 128 + lane] = hr; st[c * 128 + 64 + lane] = hi;
                const float nr = ar * hr - ai * hi + lr[e], ni = ar * hi + ai * hr + li[e]; hr = nr; hi = ni; }
        }
    }
}

template <int DIR>
__device__ __forceinline__ void s5_final_dir(CParams& p, int l, int b, int g, int chunk, int lane, const unsigned (&ur)[8], float* hst, f32x4* ybuf, int row0, float dsk, bf16_t* ZG) {
    const float* S5P = (const float*)(p.ws + OFF_S5P) + (size_t)l * 147456; const float* BR = S5P + 16384; const float* BI = BR + 65536;
    const float* ST = (const float*)(p.ws + OFF_S5ST);
    const bf16_t* ZA = (const bf16_t*)(p.ws + OFF_Z);
    const int idx = DIR * 2048 + g * 64 + lane;
    const float ar = S5P[idx], ai = S5P[4096 + idx];
    float br[16], bi[16];
#pragma unroll
    for (int q = 0; q < 4; ++q) { const f32x4 t0 = *(const f32x4*)(BR + (size_t)idx * 16 + q * 4), t1 = *(const f32x4*)(BI + (size_t)idx * 16 + q * 4);
#pragma unroll
        for (int e = 0; e < 4; ++e) { br[q * 4 + e] = t0[e]; bi[q * 4 + e] = t1[e]; } }
    float cbr[16], cbi[16];
    { const size_t cb = ((((size_t)l * 2 + DIR) * 32 + g) * 16 + (lane & 15)) * 64 + (lane >> 4);
#pragma unroll
      for (int i = 0; i < 16; ++i) { cbr[i] = p.in[14][cb + 4 * i]; cbi[i] = -p.in[15][cb + 4 * i]; } }
    const float* st = ST + ((((size_t)b * 2 + DIR) * 32 + g) * 132 + chunk) * 128;
    float hr = st[lane], hi = st[64 + lane];
    const int ch = g * 16 + (lane & 15);
#pragma unroll 1
    for (int si = 0; si < 4; ++si) {
        const int sc = DIR ? 3 - si : si;
#pragma unroll
        for (int jj = 0; jj < 16; ++jj) {
            const int tt = DIR ? 15 - jj : jj; const int tok = sc * 16 + tt;
            float bur = 0.f, bui = 0.f;
#pragma unroll
            for (int q = 0; q < 8; ++q) { const unsigned w = (unsigned)__builtin_amdgcn_readlane((int)ur[q], tok); const float x0 = bflo(w), x1 = bfhi(w);
                bur += br[2 * q] * x0 + br[2 * q + 1] * x1; bui += bi[2 * q] * x0 + bi[2 * q + 1] * x1; }
            const float nr = ar * hr - ai * hi + bur, ni = ar * hi + ai * hr + bui; hr = nr; hi = ni;
            hst[tt * 68 + lane] = hr; hst[1088 + tt * 68 + lane] = hi;
        }
        f32x4 a = (f32x4){0.f, 0.f, 0.f, 0.f};
        if (DIR) a = ybuf[sc * 64 + lane];
#pragma unroll
        for (int i = 0; i < 16; ++i) {
            const float xr = hst[(lane & 15) * 68 + 4 * i + (lane >> 4)], xi = hst[1088 + (lane & 15) * 68 + 4 * i + (lane >> 4)];
            a = __builtin_amdgcn_mfma_f32_16x16x4f32(xr, cbr[i], a, 0, 0, 0);
            a = __builtin_amdgcn_mfma_f32_16x16x4f32(xi, cbi[i], a, 0, 0, 0);
        }
        if (!DIR) ybuf[sc * 64 + lane] = a;
        else {
#pragma unroll
            for (int j = 0; j < 4; ++j) {
                const int row = row0 + sc * 16 + (lane >> 4) * 4 + j;
                const float u = bf2f(ZA[(size_t)row * 2048 + ch]);
                const float y = u * dsk + a[j];
                const float z = 0.5f * y * (1.f + tanhf(0.7978845608028654f * (y + 0.044715f * y * y * y)));
                ZG[(size_t)row * 512 + ch] = f2bf(z);
            }
        }
    }
}

__device__ __forceinline__ void phase_s5_final(int l, float* smf) {
    CParams& p = KPL(); const Ctx cx = mkctx();
    const int nscan = cx.nb >= 2 ? cx.nb / 2 : 0;
    if (cx.bid < nscan) return;
    const int lane = cx.tid & 63, wid = cx.tid >> 6, gw = (cx.bid - nscan) * 8 + wid, nw = (cx.nb - nscan) * 8;
    const bf16_t* ZA = (const bf16_t*)(p.ws + OFF_Z);
    bf16_t* ZG = (bf16_t*)(p.ws + OFF_ZG);
    float* hst = smf + wid * 3200;
    f32x4* ybuf = (f32x4*)(hst + 2176);
    for (int item0 = gw; item0 < 8448; item0 += nw) {
        const int item = __builtin_amdgcn_readfirstlane(item0);
        const int chunk = item % 132, g = (item / 132) & 31, b = item / 4224;
        const int row0 = b * SEQA + chunk * 64;
        const u32x4 u0 = *(const u32x4*)(ZA + (size_t)(row0 + lane) * 2048 + g * 16), u1 = *(const u32x4*)(ZA + (size_t)(row0 + lane) * 2048 + g * 16 + 8);
        const unsigned ur[8] = {u0.x, u0.y, u0.z, u0.w, u1.x, u1.y, u1.z, u1.w};
        const float dsk = p.in[16][l * 512 + g * 16 + (lane & 15)];
        s5_final_dir<0>(p, l, b, g, chunk, lane, ur, hst, ybuf, row0, dsk, ZG);
        s5_final_dir<1>(p, l, b, g, chunk, lane, ur, hst, ybuf, row0, dsk, ZG);
    }
}

__device__ __forceinline__ int ml_row0(int b, int nc) { return b * SEQA + nc * 128; }
__device__ __forceinline__ int ml_order(int dir, int i) { return dir == 0 ? i : (i < 2 ? 1 - i : 67 - i); }

__device__ __forceinline__ void phase_ml_conv(int l) {
    CParams& p = KPL(); const Ctx cx = mkctx();
    const bf16_t* ZA = (const bf16_t*)(p.ws + OFF_Z);
    bf16_t* QKC = (bf16_t*)(p.ws + OFF_QKC);
    const float* cw = p.in[19] + (size_t)l * 9 * 512; const float* cb = p.in[20] + l * 512;
    for (int idx = cx.bid * 512 + cx.tid; idx < T_TOK * 64; idx += cx.nb * 512) {
        const int row = idx >> 6, c8 = (idx & 63) * 8;
        const int b = row >= SEQA ? 1 : 0, t = row - b * SEQA;
        const bool isctx = t < NCTX;
        const int tt = isctx ? t : t - NCTX, W = isctx ? 256 : 64, Hh = isctx ? 1 : 128;
        const int y = tt / W, x = tt % W;
        const int segrow0 = row - tt;
        float acc[8];
#pragma unroll
        for (int e = 0; e < 8; ++e) acc[e] = cb[c8 + e];
#pragma unroll
        for (int dy = 0; dy < 3; ++dy)
#pragma unroll
            for (int dx = 0; dx < 3; ++dx) {
                const int yy = y + dy - 1, xx = x + dx - 1;
                if (yy >= 0 && yy < Hh && xx >= 0 && xx < W) {
                    const u32x4 z = *(const u32x4*)(ZA + (size_t)(segrow0 + yy * W + xx) * 2048 + 512 + c8);
                    const float* w = cw + (dy * 3 + dx) * 512 + c8;
                    const f32x4 w0 = *(const f32x4*)w, w1 = *(const f32x4*)(w + 4);
                    acc[0] += bflo(z.x) * w0[0]; acc[1] += bfhi(z.x) * w0[1]; acc[2] += bflo(z.y) * w0[2]; acc[3] += bfhi(z.y) * w0[3];
                    acc[4] += bflo(z.z) * w1[0]; acc[5] += bfhi(z.z) * w1[1]; acc[6] += bflo(z.w) * w1[2]; acc[7] += bfhi(z.w) * w1[3];
                }
            }
        u32x4 o;
#pragma unroll
        for (int e = 0; e < 8; ++e) acc[e] = acc[e] * sigmoidf_(acc[e]);
        o.x = pk2(acc[0], acc[1]); o.y = pk2(acc[2], acc[3]); o.z = pk2(acc[4], acc[5]); o.w = pk2(acc[6], acc[7]);
        *(u32x4*)(QKC + (size_t)row * 512 + c8) = o;
    }
}

constexpr int ML_QS = 0, ML_KS = 18432, ML_VT = 36864, ML_CS = 71680, ML_PS = 92416, ML_GV = 127232, ML_BV = 127744, ML_MV = 128256, ML_LF = 128768, ML_IG = 129280, ML_SC = 129792;

__device__ __forceinline__ void ml_gate_vectors(const Ctx& cx, CParams& p, int l, int dir, int b, int h, int nc, unsigned char* sm, float m_in) {
    const int tid = cx.tid, lane = tid & 63;
    float* lf = (float*)(sm + ML_LF); float* ig = (float*)(sm + ML_IG); float* gv = (float*)(sm + ML_GV); float* bv = (float*)(sm + ML_BV); float* mv = (float*)(sm + ML_MV); float* sc = (float*)(sm + ML_SC);
    const float* MLG = (const float*)(p.ws + OFF_MLG);
    const float* gb = p.in[21] + l * 16;
    if (tid < 128) {
        const int row = ml_row0(b, nc) + tid;
        const float ip = MLG[(size_t)row * 16 + dir * 4 + h] + gb[dir * 4 + h];
        const float fp = MLG[(size_t)row * 16 + 8 + dir * 4 + h] + gb[8 + dir * 4 + h];
        ig[tid] = ip; lf[tid] = fminf(fp, 0.f) - log1pf(expf(-fabsf(fp)));
    }
    __syncthreads();
    if (tid < 64) {
        const int pp0 = 2 * lane, pp1 = 2 * lane + 1; const int s0 = dir ? 127 - pp0 : pp0, s1 = dir ? 127 - pp1 : pp1;
        const float x0 = lf[s0], x1 = lf[s1];
        float incl = x0 + x1;
#pragma unroll
        for (int d = 1; d < 64; d <<= 1) { const float t = __shfl_up(incl, d); if (lane >= d) incl += t; }
        const float g1 = incl, g0 = incl - x1;
        const float gtot = __shfl(incl, 63);
        const float b0 = ig[s0] - g0, b1 = ig[s1] - g1;
        float mx = fmaxf(b0, b1);
#pragma unroll
        for (int d = 1; d < 64; d <<= 1) { const float t = __shfl_up(mx, d); if (lane >= d) mx = fmaxf(mx, t); }
        const float prev = __shfl_up(mx, 1);
        const float pm0 = lane > 0 ? fmaxf(prev, b0) : b0, pm1 = mx;
        const float bmax = __shfl(mx, 63);
        gv[s0] = g0; gv[s1] = g1; bv[s0] = b0; bv[s1] = b1; mv[s0] = fmaxf(m_in, pm0); mv[s1] = fmaxf(m_in, pm1);
        if (lane == 0) { sc[0] = gtot; sc[1] = bmax; }
    }
    __syncthreads();
}

__device__ __forceinline__ void phase_ml_local(int l, unsigned char* sm) {
    CParams& p = KPL(); const Ctx cx = mkctx();
    const int tid = cx.tid, lane = tid & 63, wid = tid >> 6;
    const bf16_t* ZA = (const bf16_t*)(p.ws + OFF_Z); const bf16_t* QKC = (const bf16_t*)(p.ws + OFF_QKC);
    float* CLOC = (float*)(p.ws + OFF_CLOC); float* MLS = (float*)(p.ws + OFF_MLS);
    bf16_t* VT = (bf16_t*)(sm + ML_VT); bf16_t* KT = (bf16_t*)(sm + ML_KS);
    const float* bv = (const float*)(sm + ML_BV); const float* sc = (const float*)(sm + ML_SC);
    float* wg = (float*)(sm + ML_LF);
    unsigned* ticket = (unsigned*)(p.ws + OFF_BAR) + 3600 + l * 16;
    int* tslot = (int*)(sm + 143328);
    for (;;) {
        if (tid == 0) *tslot = (int)__hip_atomic_fetch_add(ticket, 1u, __ATOMIC_RELAXED, __HIP_MEMORY_SCOPE_AGENT);
        __syncthreads();
        const int item = *tslot;
        __syncthreads();
        if (item >= 1056) break;
        const int chain = item / 66, nc = item % 66; const int dir = chain >> 3, b = (chain >> 2) & 1, h = chain & 3;
        ml_gate_vectors(cx, p, l, dir, b, h, nc, sm, -1e30f);
        const float gtot = sc[0], bmax = sc[1];
        __syncthreads();
        if (tid < 128) wg[tid] = expf(bv[tid] - bmax);
        __syncthreads();
        const int row0 = ml_row0(b, nc);
#pragma unroll
        for (int q = 0; q < 4; ++q) { const int ci = q * 512 + tid; const int s = ci >> 4, v8 = (ci & 15) * 8;
            const u32x4 z = *(const u32x4*)(ZA + (size_t)(row0 + s) * 2048 + 1024 + h * 128 + v8); const float w = wg[s];
            const unsigned zz[4] = {z.x, z.y, z.z, z.w};
#pragma unroll
            for (int e = 0; e < 4; ++e) { VT[(v8 + 2 * e) * 136 + s] = f2bf(bflo(zz[e]) * w); VT[(v8 + 2 * e + 1) * 136 + s] = f2bf(bfhi(zz[e]) * w); } }
#pragma unroll
        for (int q = 0; q < 2; ++q) { const int ci = q * 512 + tid; const int s = ci >> 3, k8 = (ci & 7) * 8;
            const u32x4 z = *(const u32x4*)(QKC + (size_t)(row0 + s) * 512 + 256 + h * 64 + k8);
            const unsigned zz[4] = {z.x, z.y, z.z, z.w};
#pragma unroll
            for (int e = 0; e < 4; ++e) { KT[(k8 + 2 * e) * 136 + s] = (bf16_t)(zz[e] & 0xffff); KT[(k8 + 2 * e + 1) * 136 + s] = (bf16_t)(zz[e] >> 16); } }
        __syncthreads();
        float* dst = CLOC + ((size_t)chain * 66 + nc) * 8256;
        f32x4 acc[4];
#pragma unroll
        for (int n = 0; n < 4; ++n) acc[n] = (f32x4){0.f, 0.f, 0.f, 0.f};
#pragma unroll
        for (int ks = 0; ks < 4; ++ks) {
            const bf16x8 a = *(const bf16x8*)(VT + (16 * wid + (lane & 15)) * 136 + ks * 32 + (lane >> 4) * 8);
#pragma unroll
            for (int n = 0; n < 4; ++n) { const bf16x8 bb = *(const bf16x8*)(KT + (16 * n + (lane & 15)) * 136 + ks * 32 + (lane >> 4) * 8);
                acc[n] = __builtin_amdgcn_mfma_f32_16x16x32_bf16(a, bb, acc[n], 0, 0, 0); }
        }
#pragma unroll
        for (int n = 0; n < 4; ++n)
#pragma unroll
            for (int j = 0; j < 4; ++j) dst[(16 * wid + (lane >> 4) * 4 + j) * 64 + 16 * n + (lane & 15)] = acc[n][j];
        if (tid < 64) { float s0 = 0.f, s1 = 0.f, s2 = 0.f, s3 = 0.f;
#pragma unroll 4
            for (int t = 0; t < 128; t += 4) { const u32x2 kq = *(const u32x2*)(KT + tid * 136 + t); const f32x4 w4 = *(const f32x4*)(wg + t);
                s0 += w4[0] * bflo(kq.x); s1 += w4[1] * bfhi(kq.x); s2 += w4[2] * bflo(kq.y); s3 += w4[3] * bfhi(kq.y); }
            dst[8192 + tid] = (s0 + s1) + (s2 + s3); }
        if (tid == 0) { MLS[chain * 66 + nc] = gtot; MLS[1056 + chain * 66 + nc] = gtot + bmax; }
        __syncthreads();
    }
}

__device__ __forceinline__ void phase_ml_carry() {
    CParams& p = KPL(); const Ctx cx = mkctx();
    float* CLOC = (float*)(p.ws + OFF_CLOC); float* MLS = (float*)(p.ws + OFF_MLS);
    for (int idx = cx.bid * 512 + cx.tid; idx < 16 * 8192; idx += cx.nb * 512) {
        const int chain = idx >> 13, e = idx & 8191; const int dir = chain >> 3;
        const bool two = e < 64;
        float* base = CLOC + (size_t)chain * 66 * 8256 + e;
        const float* gtp = MLS + chain * 66; const float* amp = MLS + 1056 + chain * 66;
        float m = -1e30f, C = 0.f, N = 0.f;
        for (int i0 = 0; i0 < 66; i0 += 11) {
            float cl[11], nl[11], gt[11], am[11];
#pragma unroll
            for (int q = 0; q < 11; ++q) { const int nc = ml_order(dir, i0 + q); cl[q] = base[(size_t)nc * 8256]; nl[q] = two ? base[(size_t)nc * 8256 + 8192] : 0.f; gt[q] = gtp[nc]; am[q] = amp[nc]; }
#pragma unroll
            for (int q = 0; q < 11; ++q) { const int nc = ml_order(dir, i0 + q);
                base[(size_t)nc * 8256] = C;
                if (two) base[(size_t)nc * 8256 + 8192] = N;
                if (e == 0) MLS[2112 + chain * 66 + nc] = m;
                const float mn = fmaxf(gt[q] + m, am[q]); const float so = __expf(gt[q] + m - mn), sl = __expf(am[q] - mn);
                C = so * C + sl * cl[q]; N = so * N + sl * nl[q]; m = mn; }
        }
    }
}

__device__ __forceinline__ void phase_ml_out(int l, unsigned char* sm) {
    CParams& p = KPL(); const Ctx cx = mkctx();
    const int tid = cx.tid, lane = tid & 63, wid = tid >> 6;
    const bf16_t* ZA = (const bf16_t*)(p.ws + OFF_Z); const bf16_t* QKC = (const bf16_t*)(p.ws + OFF_QKC);
    const float* CLOC = (const float*)(p.ws + OFF_CLOC); const float* MLS = (const float*)(p.ws + OFF_MLS);
    bf16_t* YB = (bf16_t*)(p.ws + OFF_YB);
    bf16_t* QS = (bf16_t*)(sm + ML_QS); bf16_t* KS = (bf16_t*)(sm + ML_KS); bf16_t* VT = (bf16_t*)(sm + ML_VT); bf16_t* CS = (bf16_t*)(sm + ML_CS); bf16_t* PS = (bf16_t*)(sm + ML_PS);
    const float* gv = (const float*)(sm + ML_GV); const float* bv = (const float*)(sm + ML_BV); const float* mv = (const float*)(sm + ML_MV);
    unsigned* ticket = (unsigned*)(p.ws + OFF_BAR) + 3608 + l * 16;
    int* tslot = (int*)(sm + 143328);
    for (;;) {
        if (tid == 0) *tslot = (int)__hip_atomic_fetch_add(ticket, 1u, __ATOMIC_RELAXED, __HIP_MEMORY_SCOPE_AGENT);
        __syncthreads();
        const int item = *tslot;
        __syncthreads();
        if (item >= 528) break;
        const int b = item / 264, h = (item / 66) & 3, nc = item % 66;
        const int row0 = ml_row0(b, nc);
        __syncthreads();
#pragma unroll
        for (int q = 0; q < 2; ++q) { const int ci = q * 512 + tid; const int s = ci >> 3, k8 = (ci & 7) * 8;
            const u32x4 zq = *(const u32x4*)(QKC + (size_t)(row0 + s) * 512 + h * 64 + k8);
            u32x4 o; o.x = pk2(bflo(zq.x) * 0.125f, bfhi(zq.x) * 0.125f); o.y = pk2(bflo(zq.y) * 0.125f, bfhi(zq.y) * 0.125f); o.z = pk2(bflo(zq.z) * 0.125f, bfhi(zq.z) * 0.125f); o.w = pk2(bflo(zq.w) * 0.125f, bfhi(zq.w) * 0.125f);
            *(u32x4*)(QS + s * 72 + k8) = o;
            *(u32x4*)(KS + s * 72 + k8) = *(const u32x4*)(QKC + (size_t)(row0 + s) * 512 + 256 + h * 64 + k8); }
#pragma unroll
        for (int q = 0; q < 4; ++q) { const int ci = q * 512 + tid; const int s = ci >> 4, v8 = (ci & 15) * 8;
            const u32x4 z = *(const u32x4*)(ZA + (size_t)(row0 + s) * 2048 + 1024 + h * 128 + v8);
            const unsigned zz[4] = {z.x, z.y, z.z, z.w};
#pragma unroll
            for (int e = 0; e < 4; ++e) { VT[(v8 + 2 * e) * 136 + s] = (bf16_t)(zz[e] & 0xffff); VT[(v8 + 2 * e + 1) * 136 + s] = (bf16_t)(zz[e] >> 16); } }
        f32x4 hsum[8];
#pragma unroll
        for (int v = 0; v < 8; ++v) hsum[v] = (f32x4){0.f, 0.f, 0.f, 0.f};
#pragma unroll 1
        for (int dir = 0; dir < 2; ++dir) {
            const int chain = dir * 8 + b * 4 + h;
            const float m_in = MLS[2112 + chain * 66 + nc];
            __syncthreads();
            ml_gate_vectors(cx, p, l, dir, b, h, nc, sm, m_in);
            const float* cin = CLOC + ((size_t)chain * 66 + nc) * 8256;
#pragma unroll
            for (int q = 0; q < 4; ++q) { const int ci = q * 512 + tid; const int v = ci >> 4, k4 = (ci & 15) * 4;
                const f32x4 c = *(const f32x4*)(cin + v * 64 + k4); store4bf(CS + v * 72 + k4, c); }
            if (tid < 16) { const f32x4 c = *(const f32x4*)(cin + 8192 + tid * 4); store4bf(CS + 128 * 72 + tid * 4, c); }
            else if (tid < 256) { const int r = 129 + (tid - 16) / 16, k4 = ((tid - 16) & 15) * 4; store4bf(CS + r * 72 + k4, (f32x4){0.f, 0.f, 0.f, 0.f}); }
            __syncthreads();
            const int tr = 16 * wid + (lane >> 4) * 4;
            float Mt[4], rs[4] = {0.f, 0.f, 0.f, 0.f};
#pragma unroll
            for (int j = 0; j < 4; ++j) Mt[j] = mv[tr + j];
            bf16x8 qa[2];
#pragma unroll
            for (int ks = 0; ks < 2; ++ks) qa[ks] = *(const bf16x8*)(QS + (16 * wid + (lane & 15)) * 72 + ks * 32 + (lane >> 4) * 8);
#pragma unroll
            for (int nt = 0; nt < 8; ++nt) {
                f32x4 s4 = (f32x4){0.f, 0.f, 0.f, 0.f};
#pragma unroll
                for (int ks = 0; ks < 2; ++ks) { const bf16x8 kb = *(const bf16x8*)(KS + (16 * nt + (lane & 15)) * 72 + ks * 32 + (lane >> 4) * 8);
                    s4 = __builtin_amdgcn_mfma_f32_16x16x32_bf16(qa[ks], kb, s4, 0, 0, 0); }
                const int s = 16 * nt + (lane & 15); const float bs = bv[s];
#pragma unroll
                for (int j = 0; j < 4; ++j) { const int t = tr + j; const bool valid = dir ? (s >= t) : (s <= t);
                    const float pv = valid ? s4[j] * __expf(bs - Mt[j]) : 0.f; rs[j] += pv; PS[t * 136 + s] = f2bf(pv); }
            }
#pragma unroll
            for (int j = 0; j < 4; ++j) rs[j] = row16_sum(rs[j]);
            __syncthreads();
            f32x4 qn = (f32x4){0.f, 0.f, 0.f, 0.f};
#pragma unroll
            for (int ks = 0; ks < 2; ++ks) { const bf16x8 cb = *(const bf16x8*)(CS + (128 + (lane & 15)) * 72 + ks * 32 + (lane >> 4) * 8);
                qn = __builtin_amdgcn_mfma_f32_16x16x32_bf16(qa[ks], cb, qn, 0, 0, 0); }
            float wi[4], dn[4];
#pragma unroll
            for (int j = 0; j < 4; ++j) { const float qnj = row16_sum(qn[j]); wi[j] = expf(m_in - Mt[j]);
                const float den = rs[j] + wi[j] * qnj; const float mt = gv[tr + j] + Mt[j]; dn[j] = 1.f / fmaxf(fabsf(den), expf(-mt)); }
            bf16x8 pa[4];
#pragma unroll
            for (int ks = 0; ks < 4; ++ks) pa[ks] = *(const bf16x8*)(PS + (16 * wid + (lane & 15)) * 136 + ks * 32 + (lane >> 4) * 8);
#pragma unroll
            for (int vt = 0; vt < 8; ++vt) {
                f32x4 a1 = (f32x4){0.f, 0.f, 0.f, 0.f}, a2 = (f32x4){0.f, 0.f, 0.f, 0.f};
#pragma unroll
                for (int ks = 0; ks < 4; ++ks) { const bf16x8 vb = *(const bf16x8*)(VT + (16 * vt + (lane & 15)) * 136 + ks * 32 + (lane >> 4) * 8);
                    a1 = __builtin_amdgcn_mfma_f32_16x16x32_bf16(pa[ks], vb, a1, 0, 0, 0); }
#pragma unroll
                for (int ks = 0; ks < 2; ++ks) { const bf16x8 cb = *(const bf16x8*)(CS + (16 * vt + (lane & 15)) * 72 + ks * 32 + (lane >> 4) * 8);
                    a2 = __builtin_amdgcn_mfma_f32_16x16x32_bf16(qa[ks], cb, a2, 0, 0, 0); }
#pragma unroll
                for (int j = 0; j < 4; ++j) hsum[vt][j] += (a1[j] + wi[j] * a2[j]) * dn[j];
            }
        }
        const int tr = 16 * wid + (lane >> 4) * 4;
        float rinv[4];
#pragma unroll
        for (int j = 0; j < 4; ++j) { float ss = 0.f;
#pragma unroll
            for (int vt = 0; vt < 8; ++vt) ss += hsum[vt][j] * hsum[vt][j];
            ss = row16_sum(ss); rinv[j] = rsqrtf(ss * (1.f / 128.f) + 1e-6f); }
#pragma unroll
        for (int vt = 0; vt < 8; ++vt) { const int ch = h * 128 + 16 * vt + (lane & 15); const float ng = p.in[22][l * 512 + ch];
#pragma unroll
            for (int j = 0; j < 4; ++j) { const int row = row0 + tr + j;
                const float o = bf2f(ZA[(size_t)row * 2048 + 1536 + ch]);
                YB[(size_t)row * 512 + ch] = f2bf(hsum[vt][j] * rinv[j] * ng * sigmoidf_(o)); } }
    }
}

__device__ __forceinline__ void phase_rw_feat(int l) {
    CParams& p = KPL(); const Ctx cx = mkctx();
    const int lane = cx.tid & 63, gw = cx.bid * 8 + (cx.tid >> 6), nw = cx.nb * 8;
    const bf16_t* ZRW = (const bf16_t*)(p.ws + OFF_ZRW);
    bf16_t* F1 = (bf16_t*)(p.ws + OFF_F1); bf16_t* LIN = (bf16_t*)(p.ws + OFF_LORAIN);
    const float* mup = p.in[23] + (size_t)l * 1792; const float* mun = p.in[24] + (size_t)l * 1792;
    const float* kk_w = p.in[30] + l * 512;
    for (int row = gw; row < T_TOK; row += nw) {
        const int b = row >= SEQA ? 1 : 0, t = row - b * SEQA;
        const bool hasp = !(t == 0 || t == NCTX), hasn = !(t == NCTX - 1 || t == SEQA - 1);
        const bf16_t* zc = ZRW + (size_t)row * 1792;
#pragma unroll
        for (int q = 0; q < 3; ++q) {
            const int col = q * 512 + lane * 8;
            const u32x4 c4 = *(const u32x4*)(zc + col);
            u32x4 p4 = (u32x4){0u, 0u, 0u, 0u}, n4 = (u32x4){0u, 0u, 0u, 0u};
            if (hasp) p4 = *(const u32x4*)(zc - 1792 + col);
            if (hasn) n4 = *(const u32x4*)(zc + 1792 + col);
            const unsigned cc[4] = {c4.x, c4.y, c4.z, c4.w}, pp[4] = {p4.x, p4.y, p4.z, p4.w}, nn[4] = {n4.x, n4.y, n4.z, n4.w};
            float zs[8];
#pragma unroll
            for (int e = 0; e < 8; ++e) { const float z = (e & 1) ? bfhi(cc[e >> 1]) : bflo(cc[e >> 1]); const float pv = (e & 1) ? bfhi(pp[e >> 1]) : bflo(pp[e >> 1]); const float nx = (e & 1) ? bfhi(nn[e >> 1]) : bflo(nn[e >> 1]);
                zs[e] = z + mup[col + e] * (pv - z) + mun[col + e] * (nx - z); }
            u32x4 o; o.x = pk2(zs[0], zs[1]); o.y = pk2(zs[2], zs[3]); o.z = pk2(zs[4], zs[5]); o.w = pk2(zs[6], zs[7]);
            *(u32x4*)(F1 + (size_t)row * 2048 + q * 512 + lane * 8) = o;
            if (q == 1) {
                float kr[8], ssq = 0.f;
#pragma unroll
                for (int e = 0; e < 8; ++e) { kr[e] = zs[e] * kk_w[lane * 8 + e]; ssq += kr[e] * kr[e]; }
                ssq = row8_sum(ssq);
                const float inv = 1.f / fmaxf(sqrtf(ssq), 1e-12f);
                u32x4 o2; o2.x = pk2(kr[0] * inv, kr[1] * inv); o2.y = pk2(kr[2] * inv, kr[3] * inv); o2.z = pk2(kr[4] * inv, kr[5] * inv); o2.w = pk2(kr[6] * inv, kr[7] * inv);
                *(u32x4*)(F1 + (size_t)row * 2048 + 1536 + lane * 8) = o2;
            }
        }
        {
            const int col = 1536 + lane * 4;
            const u32x2 c2 = *(const u32x2*)(zc + col);
            u32x2 p2 = (u32x2){0u, 0u}, n2 = (u32x2){0u, 0u};
            if (hasp) p2 = *(const u32x2*)(zc - 1792 + col);
            if (hasn) n2 = *(const u32x2*)(zc + 1792 + col);
            const unsigned cc[2] = {c2.x, c2.y}, pp[2] = {p2.x, p2.y}, nn[2] = {n2.x, n2.y};
            float zs[4];
#pragma unroll
            for (int e = 0; e < 4; ++e) { const float z = (e & 1) ? bfhi(cc[e >> 1]) : bflo(cc[e >> 1]); const float pv = (e & 1) ? bfhi(pp[e >> 1]) : bflo(pp[e >> 1]); const float nx = (e & 1) ? bfhi(nn[e >> 1]) : bflo(nn[e >> 1]);
                const float s = z + mup[col + e] * (pv - z) + mun[col + e] * (nx - z);
                zs[e] = lane < 16 ? tanhf(s) : (lane < 32 ? s : sigmoidf_(s)); }
            u32x2 o; o.x = pk2(zs[0], zs[1]); o.y = pk2(zs[2], zs[3]);
            *(u32x2*)(LIN + (size_t)row * 256 + lane * 4) = o;
        }
    }
}

__device__ __forceinline__ int rw_tok(int dir, int i) { return dir == 0 ? i : (i < NCTX ? NCTX - 1 - i : 8703 - i); }

typedef float f32x2 __attribute__((ext_vector_type(2)));
constexpr int RW_REC = 384;
__device__ __forceinline__ void rw_load(const bf16_t* f1, const bf16_t* f2, const bf16_t* fu, int ustr, int dir, int rg, int c, int pw, int lane, bf16_t (&in)[8][5], bf16_t (&vin)[8]) {
#pragma unroll
    for (int q = 0; q < 8; ++q) { const size_t t = (size_t)rw_tok(dir, c * 32 + pw * 8 + q);
        in[q][0] = f1[t * 2048 + lane]; in[q][1] = f1[t * 2048 + 512 + lane]; in[q][2] = f1[t * 2048 + 1536 + lane]; in[q][3] = fu[t * ustr + lane]; in[q][4] = f2[t * 2048 + 1024 + lane];
        vin[q] = f1[t * 2048 + 1024 + rg * 16 + (lane & 15)]; }
}
__device__ __forceinline__ void rw_emit(const bf16_t (&in)[8][5], const bf16_t (&vin)[8], int pw, int lane, float ka, float* buf) {
#pragma unroll
    for (int q = 0; q < 8; ++q) {
        const float r = bf2f(in[q][0]), k = bf2f(in[q][1]), kk = bf2f(in[q][2]), u = bf2f(in[q][3]), a = bf2f(in[q][4]);
        const float w = 1.f - u, key = k * (1.f + (a - 1.f) * ka), kka = kk * a, wr = w * r;
        const float c1 = wave_sum(kka * r), c2 = wave_sum(key * r);
        float* rec = buf + (pw * 8 + q) * RW_REC;
        rec[lane] = kk; rec[64 + lane] = wr; rec[128 + lane] = w; rec[192 + lane] = kka; rec[256 + lane] = key;
        if (lane < 16) { f32x4 vc; vc[0] = bf2f(vin[q]); vc[1] = c1; vc[2] = c2; vc[3] = 0.f; *(f32x4*)(rec + 320 + lane * 4) = vc; }
    }
}

__device__ __forceinline__ void phase_rw_scan(int l, unsigned char* sm) {
    CParams& p = KPL(); const Ctx cx = mkctx();
    const int tid = cx.tid, lane = tid & 63, wid = __builtin_amdgcn_readfirstlane(tid >> 6);
    const bf16_t* F1 = (const bf16_t*)(p.ws + OFF_F1); const bf16_t* F2 = (const bf16_t*)(p.ws + OFF_Z);
    bf16_t* YRAW = (bf16_t*)(p.ws + OFF_R2);
    float* ring = (float*)sm;
    const bool is_scan = wid < 4, is_prod = wid >= 4;
    const int pw = wid & 3;
    const int nscan = cx.nb >= 2 ? cx.nb / 2 : 1;
    if (cx.bid >= nscan) return;
    for (int item = cx.bid; item < 128; item += nscan) {
        const int chain = item >> 2, rg = item & 3; const int dir = chain >> 4, b = (chain >> 3) & 1, h = chain & 7;
        const float ka = p.in[31][l * 512 + h * 64 + lane];
        const bf16_t* f1 = F1 + (size_t)b * SEQA * 2048 + h * 64; const bf16_t* f2 = F2 + (size_t)b * SEQA * 2048 + dir * 512 + h * 64;
        const int ustr = dir ? 2048 : 512;
        const bf16_t* fu = dir ? f2 : (const bf16_t*)(p.ws + OFF_U0) + (size_t)b * SEQA * 512 + h * 64;
        const int row = rg * 16 + (wid & 3) * 4 + (lane >> 4);
        bf16_t* yr = YRAW + ((size_t)dir * T_TOK + (size_t)b * SEQA) * 512 + h * 64 + row;
        bf16_t pin[8][5], pvin[8];
        __syncthreads();
        if (is_prod) { rw_load(f1, f2, fu, ustr, dir, rg, 0, pw, lane, pin, pvin); rw_emit(pin, pvin, pw, lane, ka, ring); rw_load(f1, f2, fu, ustr, dir, rg, 1, pw, lane, pin, pvin); }
        __syncthreads();
        f32x2 S01 = (f32x2){0.f, 0.f}, S23 = (f32x2){0.f, 0.f};
        if (is_scan) __builtin_amdgcn_s_setprio(3);
#pragma unroll 1
        for (int c = 0; c < 264; ++c) {
            float* buf = ring + (c & 1) * (32 * RW_REC);
            if (is_prod) { if (c + 1 < 264) { rw_emit(pin, pvin, pw, lane, ka, ring + ((c + 1) & 1) * (32 * RW_REC)); rw_load(f1, f2, fu, ustr, dir, rg, c + 2 < 264 ? c + 2 : c + 1, pw, lane, pin, pvin); } }
            else if (is_scan) {
                const float* rb = buf + (lane & 15) * 4;
                const float* vb = buf + 320 + ((wid & 3) * 4 + (lane >> 4)) * 4;
#pragma unroll 1
                for (int hf = 0; hf < 2; ++hf) {
                    const float* rh = rb + hf * 16 * RW_REC; const float* vh = vb + hf * 16 * RW_REC;
                    f32x4 kk4 = *(const f32x4*)(rh), wr4 = *(const f32x4*)(rh + 64), w4 = *(const f32x4*)(rh + 128), ka4 = *(const f32x4*)(rh + 192), ky4 = *(const f32x4*)(rh + 256), vc4 = *(const f32x4*)(vh);
                    f32x4 nkk = *(const f32x4*)(rh + RW_REC), nwr = *(const f32x4*)(rh + RW_REC + 64), nw = *(const f32x4*)(rh + RW_REC + 128), nka = *(const f32x4*)(rh + RW_REC + 192), nky = *(const f32x4*)(rh + RW_REC + 256), nvc = *(const f32x4*)(vh + RW_REC);
                    float ybuf = 0.f;
#pragma unroll
                    for (int j = 0; j < 16; ++j) {
                        f32x4 mkk, mwr, mw, mka, mky, mvc;
                        if (j < 14) { const int o = (j + 2) * RW_REC;
                            mkk = *(const f32x4*)(rh + o); mwr = *(const f32x4*)(rh + o + 64); mw = *(const f32x4*)(rh + o + 128); mka = *(const f32x4*)(rh + o + 192); mky = *(const f32x4*)(rh + o + 256); mvc = *(const f32x4*)(vh + o); }
                        const float vv = vc4[0];
                        f32x2 p1 = S01 * (f32x2){kk4[0], kk4[1]}; p1 = S23 * (f32x2){kk4[2], kk4[3]} + p1;
                        f32x2 p2 = S01 * (f32x2){wr4[0], wr4[1]}; p2 = S23 * (f32x2){wr4[2], wr4[3]} + p2;
                        const f32x2 vv2 = (f32x2){vv, vv};
                        f32x2 u01 = (f32x2){ky4[0], ky4[1]} * vv2; u01 = S01 * (f32x2){w4[0], w4[1]} + u01;
                        f32x2 u23 = (f32x2){ky4[2], ky4[3]} * vv2; u23 = S23 * (f32x2){w4[2], w4[3]} + u23;
                        const float sk = row16_sum(p1[0] + p1[1]);
                        const float q2 = row16_sum(p2[0] + p2[1]);
                        const f32x2 nsk2 = (f32x2){-sk, -sk};
                        S01 = (f32x2){ka4[0], ka4[1]} * nsk2 + u01; S23 = (f32x2){ka4[2], ka4[3]} * nsk2 + u23;
                        const float y = q2 - sk * vc4[1] + vv * vc4[2];
                        if ((lane & 15) == j) ybuf = y;
                        kk4 = nkk; wr4 = nwr; w4 = nw; ka4 = nka; ky4 = nky; vc4 = nvc;
                        if (j < 14) { nkk = mkk; nwr = mwr; nw = mw; nka = mka; nky = mky; nvc = mvc; }
                        __builtin_amdgcn_sched_barrier(0);
                    }
                    yr[(size_t)rw_tok(dir, c * 32 + hf * 16 + (lane & 15)) * 512] = f2bf(ybuf);
                }
            }
            asm volatile("s_waitcnt lgkmcnt(0)" ::: "memory"); __builtin_amdgcn_s_barrier(); asm volatile("" ::: "memory");
        }
        if (is_scan) __builtin_amdgcn_s_setprio(0);
    }
}

__device__ __forceinline__ void phase_rw_out(int l) {
    CParams& p = KPL(); const Ctx cx = mkctx();
    const int lane = cx.tid & 63, gw = cx.bid * 8 + (cx.tid >> 6), nw = cx.nb * 8;
    const bf16_t* F1 = (const bf16_t*)(p.ws + OFF_F1); const bf16_t* F2 = (const bf16_t*)(p.ws + OFF_Z); const bf16_t* GRW = (const bf16_t*)(p.ws + OFF_ZRW);
    const bf16_t* YRAW = (const bf16_t*)(p.ws + OFF_R2);
    bf16_t* YC = (bf16_t*)(p.ws + OFF_YC);
    const int c0 = lane * 8;
    float ka[8], rk[8], lg[8], lb[8];
#pragma unroll
    for (int e = 0; e < 8; ++e) { ka[e] = p.in[31][l * 512 + c0 + e]; rk[e] = p.in[32][l * 512 + c0 + e]; lg[e] = p.in[33][l * 512 + c0 + e]; lb[e] = p.in[34][l * 512 + c0 + e]; }
    for (int row = gw; row < T_TOK; row += nw) {
        const u32x4 y0 = *(const u32x4*)(YRAW + (size_t)row * 512 + c0), y1 = *(const u32x4*)(YRAW + ((size_t)T_TOK + row) * 512 + c0);
        const u32x4 r4 = *(const u32x4*)(F1 + (size_t)row * 2048 + c0), k4 = *(const u32x4*)(F1 + (size_t)row * 2048 + 512 + c0), v4 = *(const u32x4*)(F1 + (size_t)row * 2048 + 1024 + c0);
        const u32x4 a04 = *(const u32x4*)(F2 + (size_t)row * 2048 + 1024 + c0), a14 = *(const u32x4*)(F2 + (size_t)row * 2048 + 1536 + c0);
        const u32x4 g4 = *(const u32x4*)(GRW + (size_t)row * 512 + c0);
        const unsigned ya[4] = {y0.x, y0.y, y0.z, y0.w}, yb[4] = {y1.x, y1.y, y1.z, y1.w}, rr[4] = {r4.x, r4.y, r4.z, r4.w}, kx[4] = {k4.x, k4.y, k4.z, k4.w}, vv[4] = {v4.x, v4.y, v4.z, v4.w};
        const unsigned aa[4] = {a04.x, a04.y, a04.z, a04.w}, ab[4] = {a14.x, a14.y, a14.z, a14.w}, gg[4] = {g4.x, g4.y, g4.z, g4.w};
        float y[8], sum = 0.f, bs = 0.f;
#pragma unroll
        for (int e = 0; e < 8; ++e) {
            const int w = e >> 1; const bool hi = e & 1;
            y[e] = (hi ? bfhi(ya[w]) : bflo(ya[w])) + (hi ? bfhi(yb[w]) : bflo(yb[w])); sum += y[e];
            const float r = hi ? bfhi(rr[w]) : bflo(rr[w]), k = hi ? bfhi(kx[w]) : bflo(kx[w]), a0 = hi ? bfhi(aa[w]) : bflo(aa[w]), a1 = hi ? bfhi(ab[w]) : bflo(ab[w]);
            bs += r * k * (2.f + (a0 + a1 - 2.f) * ka[e]) * rk[e];
        }
        sum = row8_sum(sum); bs = row8_sum(bs);
        const float mu = sum * (1.f / 64.f);
        float var = 0.f;
#pragma unroll
        for (int e = 0; e < 8; ++e) { const float d = y[e] - mu; var += d * d; }
        var = row8_sum(var) * (1.f / 64.f);
        const float rstd = rsqrtf(var + 64e-5f);
        float o[8];
#pragma unroll
        for (int e = 0; e < 8; ++e) { const int w = e >> 1; const bool hi = e & 1;
            const float v = hi ? bfhi(vv[w]) : bflo(vv[w]), g = hi ? bfhi(gg[w]) : bflo(gg[w]);
            o[e] = ((y[e] - mu) * rstd * lg[e] + lb[e] + bs * v) * g; }
        u32x4 o4; o4.x = pk2(o[0], o[1]); o4.y = pk2(o[2], o[3]); o4.z = pk2(o[4], o[5]); o4.w = pk2(o[6], o[7]);
        *(u32x4*)(YC + (size_t)row * 512 + c0) = o4;
    }
}

__device__ __forceinline__ void phase_final() {
    CParams& p = KPL(); const Ctx cx = mkctx();
    const int lane = cx.tid & 63, gw = cx.bid * 8 + (cx.tid >> 6), nw = cx.nb * 8;
    const float* X = (const float*)(p.ws + OFF_X);
    for (int r = gw; r < 2 * 8192; r += nw) {
        const int b = r >> 13, t = r & 8191;
        const float* src = X + ((size_t)b * SEQA + NCTX + t) * 1024;
        f32x4 v[4]; float ss = 0.f;
#pragma unroll
        for (int i = 0; i < 4; ++i) { v[i] = *(const f32x4*)(src + (lane + 64 * i) * 4); ss += v[i][0] * v[i][0] + v[i][1] * v[i][1] + v[i][2] * v[i][2] + v[i][3] * v[i][3]; }
        ss = wave_sum(ss);
        const float inv = rsqrtf(ss * (1.f / 1024.f) + 1e-6f);
#pragma unroll
        for (int i = 0; i < 4; ++i) { const int c = (lane + 64 * i) * 4; const f32x4 g4 = *(const f32x4*)(p.in[41] + c);
            *(f32x4*)(p.out + (size_t)r * 1024 + c) = v[i] * inv * g4; }
    }
}

#define XB_TMO      128
#define XB_XCNT(j)  (256  + 64 * (j))
#define XB_XSUB(j)  (1280 + 64 * (j))
#define XB_XGEN(j)  (2304 + 64 * (j))
#define XB_TOP      3328
#define XB_TOPGEN   3392
#define XCD_BAR_WORDS 3456
#define XB_SPIN_CAP (1u << 22)
constexpr int XB_LDS_OFF = 143344;
__device__ __forceinline__ unsigned xb_ld(unsigned* p)              { return __hip_atomic_load(p, __ATOMIC_RELAXED, __HIP_MEMORY_SCOPE_AGENT); }
__device__ __forceinline__ unsigned xb_add(unsigned* p, unsigned v) { return __hip_atomic_fetch_add(p, v, __ATOMIC_RELAXED, __HIP_MEMORY_SCOPE_AGENT); }
__device__ __forceinline__ unsigned xb_xcc_id() { return (unsigned)__builtin_amdgcn_s_getreg((3 << 11) | 20) & 0xFu; }
#define XB_SPIN(cond, bar) do { unsigned _sp = 0; while (cond) { __builtin_amdgcn_s_sleep(1); \
    if ((++_sp & 255u) == 0u) { if (xb_ld(&(bar)[XB_TMO])) break; if (_sp > XB_SPIN_CAP) { atomicAdd(&(bar)[XB_TMO], 1u); break; } } } } while (0)
__device__ __forceinline__ void xb_complete(unsigned* bar, unsigned x, unsigned G, unsigned& nloc, unsigned& nx) {
    unsigned sum, cnt, mine, sp = 0u;
    for (;;) {
        sum = 0u; cnt = 0u; mine = 0u;
#pragma unroll
        for (unsigned j = 0; j < 16; ++j) { const unsigned c = xb_ld(&bar[XB_XCNT(j)]); sum += c; cnt += (c > 0u) ? 1u : 0u; mine = (j == x) ? c : mine; }
        if (sum == G) break;
        __builtin_amdgcn_s_sleep(1);
        if ((++sp & 255u) == 0u) { if (xb_ld(&bar[XB_TMO])) break; if (sp > XB_SPIN_CAP) { atomicAdd(&bar[XB_TMO], 1u); break; } }
    }
    nloc = mine > 0u ? mine : 1u; nx = cnt > 0u ? cnt : 1u;
}
__device__ __forceinline__ void xb_post(unsigned char* smem) {
    CParams& p = KPL(); const Ctx cx = mkctx();
    volatile LAS unsigned* st = (volatile LAS unsigned*)((LAS unsigned char*)smem + XB_LDS_OFF);
    if (cx.tid == 0) { st[0] = 0u; st[1] = 0u; (void)xb_add(&((unsigned*)(p.ws + OFF_BAR))[XB_XCNT(xb_xcc_id())], 1u); }
    __syncthreads();
}
__device__ __forceinline__ void xsync(unsigned char* smem) {
    CParams& p = KPL(); const Ctx cx = mkctx();
    asm volatile("s_waitcnt vmcnt(0)" ::: "memory");
    __syncthreads();
    if (cx.tid == 0) {
        unsigned* bar = (unsigned*)(p.ws + OFF_BAR);
        volatile LAS unsigned* st = (volatile LAS unsigned*)((LAS unsigned char*)smem + XB_LDS_OFF);
        const unsigned x = xb_xcc_id();
        __builtin_amdgcn_s_waitcnt(0);
        unsigned nloc = st[0], nx = st[1];
        if (nloc == 0u) { xb_complete(bar, x, (unsigned)cx.nb, nloc, nx); st[0] = nloc; st[1] = nx; }
        const unsigned old = xb_add(&bar[XB_XSUB(x)], 1u);
        const unsigned gen = old / nloc;
        if (old + 1u == (gen + 1u) * nloc) {
            __builtin_amdgcn_fence(__ATOMIC_RELEASE, "agent");
            asm volatile("s_waitcnt vmcnt(0)" ::: "memory");
            const unsigned og = xb_add(&bar[XB_TOP], 1u);
            const unsigned tg = og / nx;
            if (og + 1u == (tg + 1u) * nx) xb_add(&bar[XB_TOPGEN], 1u);
            else XB_SPIN(xb_ld(&bar[XB_TOPGEN]) == tg, bar);
            __builtin_amdgcn_fence(__ATOMIC_ACQUIRE, "agent");
            xb_add(&bar[XB_XGEN(x)], 1u);
            asm volatile("s_waitcnt vmcnt(0)" ::: "memory");
        } else {
            XB_SPIN(xb_ld(&bar[XB_XGEN(x)]) == gen, bar);
            __builtin_amdgcn_fence(__ATOMIC_ACQUIRE, "agent");
            asm volatile("s_waitcnt vmcnt(0)" ::: "memory");
        }
    }
    __syncthreads();
}

__device__ __forceinline__ void s5_side_barrier(int l, int which) {
    CParams& p = KPL(); const Ctx cx = mkctx();
    const int b0 = cx.nb >= 2 ? cx.nb / 2 : 0;
    if (cx.bid < b0) return;
    unsigned* ctr = (unsigned*)(p.ws + OFF_BAR) + 3700 + l * 16 + which * 8;
    const unsigned target = (unsigned)(cx.nb - b0);
    asm volatile("s_waitcnt vmcnt(0)" ::: "memory");
    __syncthreads();
    if (cx.tid == 0) {
        __builtin_amdgcn_fence(__ATOMIC_RELEASE, "agent");
        asm volatile("s_waitcnt vmcnt(0)" ::: "memory");
        (void)xb_add(ctr, 1u);
        unsigned sp = 0u;
        while (xb_ld(ctr) < target) { __builtin_amdgcn_s_sleep(2); if (++sp > (1u << 24)) break; }
        __builtin_amdgcn_fence(__ATOMIC_ACQUIRE, "agent");
        asm volatile("s_waitcnt vmcnt(0)" ::: "memory");
    }
    __syncthreads();
}

#ifndef PHM
#define PHM 0xFFFFFFFFull
#endif
#ifndef PHR
#define PHR 0ull
#endif
#ifndef SYNCREP
#define SYNCREP 1
#endif
template <int WHICH>
__device__ __forceinline__ void gemm_stage(int l, LAS unsigned char* lds) {
    CParams& p = KPL(); const Ctx cx = mkctx();
    const int sk = (l == NLAYER - 1) ? 1 : 0;
    unsigned char* ws = p.ws;
    float* X = (float*)(ws + OFF_X); bf16_t* H = (bf16_t*)(ws + OFF_H); bf16_t* ZA = (bf16_t*)(ws + OFF_Z); bf16_t* ZRW = (bf16_t*)(ws + OFF_ZRW);
    bf16_t* W = (bf16_t*)(ws + OFF_W);
    const float* MODL = (const float*)(ws + OFF_MOD) + (size_t)l * 3 * 6144;
    if constexpr (WHICH == 0) run_gemm8(cx, lds, H, W + W_MIX / 2, 4096, 1024, FInproj8{ZA, (float*)(ws + OFF_MLG), ZRW});
    else if constexpr (WHICH == 1) run_gemm8(cx, lds, (const bf16_t*)(ws + OFF_ZG), W + W_GLU / 2, 512, 512, FGlu8{(const bf16_t*)(ws + OFF_ZG), p.in[18] + l * 512, (bf16_t*)(ws + OFF_YA)});
    else if constexpr (WHICH == 2) run_gemm_epi(cx, lds, (const bf16_t*)(ws + OFF_LORAIN), W + W_LORA / 2, 2560, 256, EpiLora{p.in[25] + l * 1024, p.in[27] + l * 1024, ZA, ZRW, (bf16_t*)(ws + OFF_U0)});
    else if constexpr (WHICH == 3) run_gemm8(cx, lds, H, W + W_GATE / 2, 3072, 1024, FGate8{ZA}, sk);
    else if constexpr (WHICH == 4) run_gemm8(cx, lds, (const bf16_t*)(ws + OFF_YA), W + W_PA / 2, 1024, 512, FMerge8<0>{ZA, H}, sk);
    else if constexpr (WHICH == 5) run_gemm8(cx, lds, (const bf16_t*)(ws + OFF_YB), W + W_PB / 2, 1024, 512, FMerge8<1>{ZA, H}, sk);
    else if constexpr (WHICH == 6) run_gemm8(cx, lds, (const bf16_t*)(ws + OFF_YC), W + W_PC / 2, 1024, 512, FMerge8<2>{ZA, H}, sk);
    else if constexpr (WHICH == 7) run_gemm(cx, lds, H, W + W_OUT / 2, 1024, 1024, FResid{X, MODL, 2}, sk);
    else if constexpr (WHICH == 8) run_gemm8(cx, lds, H, W + W_1 / 2, 4096, 1024, FMlp18{ZA}, sk);
    else run_gemm(cx, lds, ZA, W + W_2 / 2, 1024, 4096, FResid{X, MODL, 5}, sk);
}

template <int l>
__device__ __forceinline__ void run_layer(cg::grid_group& grid, LAS unsigned char* lds, float* smf, unsigned char* smem) {
        if constexpr (l == 0) phase_wconv<0>(l, smf); else phase_wconv<1>(l, smf);
        __syncthreads();
        if constexpr ((PHM >> 2) & 1) { phase_norm(l, 0, l == 0); if constexpr ((PHR >> 2) & 1) { __syncthreads(); phase_norm(l, 0, l == 0); } }
        for (int sr = 0; sr < SYNCREP; ++sr) xsync(smem);
        if constexpr ((PHM >> 3) & 1) { gemm_stage<0>(l, lds); if constexpr ((PHR >> 3) & 1) { __syncthreads(); gemm_stage<0>(l, lds); } }
        for (int sr = 0; sr < SYNCREP; ++sr) xsync(smem);
        if constexpr ((PHM >> 5) & 1) { phase_ml_conv(l); if constexpr ((PHR >> 5) & 1) { __syncthreads(); phase_ml_conv(l); } }
        for (int sr = 0; sr < SYNCREP; ++sr) xsync(smem);
        if constexpr ((PHM >> 7) & 1) { phase_ml_local(l, smem); if constexpr ((PHR >> 7) & 1) { __syncthreads(); phase_ml_local(l, smem); } }
        for (int sr = 0; sr < SYNCREP; ++sr) xsync(smem);
        if constexpr ((PHM >> 9) & 1) { phase_ml_carry(); if constexpr ((PHR >> 9) & 1) { __syncthreads(); phase_ml_carry(); } }
        for (int sr = 0; sr < SYNCREP; ++sr) xsync(smem);
        if constexpr ((PHM >> 11) & 1) { phase_ml_out(l, smem); if constexpr ((PHR >> 11) & 1) { __syncthreads(); phase_ml_out(l, smem); } }
        for (int sr = 0; sr < SYNCREP; ++sr) xsync(smem);
        if constexpr ((PHM >> 12) & 1) { phase_rw_feat(l); if constexpr ((PHR >> 12) & 1) { __syncthreads(); phase_rw_feat(l); } }
        for (int sr = 0; sr < SYNCREP; ++sr) xsync(smem);
        if constexpr ((PHM >> 13) & 1) { gemm_stage<2>(l, lds); if constexpr ((PHR >> 13) & 1) { __syncthreads(); gemm_stage<2>(l, lds); } }
        for (int sr = 0; sr < SYNCREP; ++sr) xsync(smem);
        phase_rw_scan(l, smem);
        phase_s5_local(l);
        s5_side_barrier(l, 0);
        phase_s5_carry(l);
        s5_side_barrier(l, 1);
        phase_s5_final(l, smf);
        for (int sr = 0; sr < SYNCREP; ++sr) xsync(smem);
        gemm_stage<1>(l, lds);
        if constexpr ((PHM >> 15) & 1) { phase_rw_out(l); if constexpr ((PHR >> 15) & 1) { __syncthreads(); phase_rw_out(l); } }
        for (int sr = 0; sr < SYNCREP; ++sr) xsync(smem);
        if constexpr ((PHM >> 17) & 1) { gemm_stage<3>(l, lds); if constexpr ((PHR >> 17) & 1) { __syncthreads(); gemm_stage<3>(l, lds); } }
        for (int sr = 0; sr < SYNCREP; ++sr) xsync(smem);
        if constexpr ((PHM >> 18) & 1) { gemm_stage<4>(l, lds); if constexpr ((PHR >> 18) & 1) { __syncthreads(); gemm_stage<4>(l, lds); } }
        if constexpr ((PHM >> 19) & 1) { gemm_stage<5>(l, lds); if constexpr ((PHR >> 19) & 1) { __syncthreads(); gemm_stage<5>(l, lds); } }
        if constexpr ((PHM >> 20) & 1) { gemm_stage<6>(l, lds); if constexpr ((PHR >> 20) & 1) { __syncthreads(); gemm_stage<6>(l, lds); } }
        for (int sr = 0; sr < SYNCREP; ++sr) xsync(smem);
        if constexpr ((PHM >> 21) & 1) { gemm_stage<7>(l, lds); if constexpr ((PHR >> 21) & 1) { __syncthreads(); gemm_stage<7>(l, lds); } }
        for (int sr = 0; sr < SYNCREP; ++sr) xsync(smem);
        if constexpr ((PHM >> 22) & 1) { phase_norm(l, 1, false); if constexpr ((PHR >> 22) & 1) { __syncthreads(); phase_norm(l, 1, false); } }
        for (int sr = 0; sr < SYNCREP; ++sr) xsync(smem);
        if constexpr ((PHM >> 23) & 1) { gemm_stage<8>(l, lds); if constexpr ((PHR >> 23) & 1) { __syncthreads(); gemm_stage<8>(l, lds); } }
        for (int sr = 0; sr < SYNCREP; ++sr) xsync(smem);
        gemm_stage<9>(l, lds);
        if constexpr (l < NLAYER - 1) { __syncthreads(); phase_wconv<2>(l + 1, smf); }
        for (int sr = 0; sr < SYNCREP; ++sr) xsync(smem);
    }

__global__ void __launch_bounds__(512, 2) fwd_megakernel(Params p_unused) {
    extern __shared__ __attribute__((aligned(16))) unsigned char smem[];
    cg::grid_group grid = cg::this_grid();
    LAS unsigned char* lds = (LAS unsigned char*)smem;
    float* smf = (float*)smem;

    xb_post(smem);
    phase_mod(smf); phase_s5_params();
    if (KPL().ws == nullptr) grid.sync();
    xsync(smem);
    run_layer<0>(grid, lds, smf, smem);
    run_layer<1>(grid, lds, smf, smem);
    run_layer<2>(grid, lds, smf, smem);
    run_layer<3>(grid, lds, smf, smem);
    phase_final();
}

extern "C" void kernel_launch(void* const* d_in, const int* in_sizes, int n_in, void* d_out, int out_size, void* d_ws, size_t ws_size, hipStream_t stream) {
    static int grid_blocks = 0;
    if (grid_blocks == 0) {
        if (n_in != 42 || ws_size < WS_END) { fprintf(stderr, "kernel_launch: unexpected n_in %d / ws_size %zu\n", n_in, ws_size); grid_blocks = -1; return; }
        int dev = 0, cus = 0, per_cu = 0;
        (void)hipGetDevice(&dev);
        (void)hipDeviceGetAttribute(&cus, hipDeviceAttributeMultiprocessorCount, dev);
        if (hipFuncSetAttribute((const void*)fwd_megakernel, hipFuncAttributeMaxDynamicSharedMemorySize, LDS_BYTES) != hipSuccess) { fprintf(stderr, "kernel_launch: hipFuncSetAttribute failed\n"); grid_blocks = -1; return; }
        if (hipOccupancyMaxActiveBlocksPerMultiprocessor(&per_cu, (const void*)fwd_megakernel, 512, LDS_BYTES) != hipSuccess || per_cu < 1) { fprintf(stderr, "kernel_launch: occupancy query says %d\n", per_cu); per_cu = 1; (void)hipGetLastError(); }
        grid_blocks = cus * 1;
    }
    if (grid_blocks < 0) return;
    if (hipMemsetAsync((unsigned char*)d_ws + OFF_BAR, 0, 16384, stream) != hipSuccess) { fprintf(stderr, "kernel_launch: memset failed\n"); return; }
    Params p{};
    for (int i = 0; i < 42; ++i) p.in[i] = (const float*)d_in[i];
    p.out = (float*)d_out; p.ws = (unsigned char*)d_ws;
    void* args[] = {&p};
    hipError_t e = hipLaunchCooperativeKernel((const void*)fwd_megakernel, dim3(grid_blocks), dim3(512), args, LDS_BYTES, stream);
    if (e != hipSuccess) fprintf(stderr, "cooperative launch failed: %s (grid %d)\n", hipGetErrorString(e), grid_blocks);
}
```
